# Optimizing an MI355X kernel written in HIP

```python
import jax
import jax.numpy as jnp
from jax import lax
import numpy as np

D_MODEL = 1024
BATCH = 2
SEQ = 8192
DEPTH = 2

GRID_W = 64
CTX_LEN = 256
N_GROUPS = 4
GROUP_WIDTH = D_MODEL // N_GROUPS
HEAD_DIM = 64
BLOCK = 128
ROPE_THETA = 10000.0
EPS = 1e-6

A_HEADS = GROUP_WIDTH // HEAD_DIM
A_KV_HEADS = 2
A_GROUP = A_HEADS // A_KV_HEADS
WINDOW = 128
B_HEADS = GROUP_WIDTH // HEAD_DIM
B_KV_HEADS = 2
B_GROUP = B_HEADS // B_KV_HEADS
C_HEADS = GROUP_WIDTH // HEAD_DIM
NA_KH = 8
NA_KW = 16
D_HEADS = 4
MLA_V = GROUP_WIDTH // D_HEADS
MLA_NOPE = 64
MLA_ROPE = 32
MLA_Q_RANK = 192
MLA_KV_RANK = 128
D_FF = 2816
N_EXPERTS = 8
TOP_K = 2
D_FF_EXPERT = 3584
MOE_BLOCK = 512
N_DENSE = (DEPTH + 1) // 2
N_MOE = DEPTH // 2

IN_SIZES = (A_HEADS * HEAD_DIM, A_KV_HEADS * HEAD_DIM, A_KV_HEADS * HEAD_DIM,
            B_HEADS * HEAD_DIM, B_KV_HEADS * HEAD_DIM, B_KV_HEADS * HEAD_DIM,
            C_HEADS * HEAD_DIM, C_HEADS * HEAD_DIM, C_HEADS * HEAD_DIM,
            MLA_Q_RANK, MLA_KV_RANK, MLA_ROPE)
IN_WIDTH = sum(IN_SIZES)
SCALE_HEAD = HEAD_DIM ** -0.5
SCALE_MLA = (MLA_NOPE + MLA_ROPE) ** -0.5

kernel_name = 'hybrid_parallel_group_dit_block'


def rms_norm(x, g):
    xf = x.astype(jnp.float32)
    y = xf * lax.rsqrt(jnp.mean(xf * xf, axis=-1, keepdims=True) + EPS)
    return (y * g.astype(jnp.float32)).astype(x.dtype)


def modulate(h, shift, scale):
    return h * (1 + scale) + shift


def axial_rope_tables(n_tokens, rot_dim, dtype):
    t = jnp.arange(n_tokens)
    row = (t // GRID_W).astype(jnp.float32)[:, None]
    col = (t % GRID_W).astype(jnp.float32)[:, None]
    half = rot_dim // 2
    inv_freq = ROPE_THETA ** (-jnp.arange(0, half, 2, dtype=jnp.float32) / half)
    ang = jnp.concatenate([row * inv_freq, row * inv_freq, col * inv_freq, col * inv_freq], axis=-1)
    return jnp.cos(ang).astype(dtype), jnp.sin(ang).astype(dtype)


def apply_rope(t, cos, sin):
    r1, r2, c1, c2 = jnp.split(t, 4, axis=-1)
    rot = jnp.concatenate([-r2, r1, -c2, c1], axis=-1)
    return t * cos + rot * sin


def rope_full(t, rope):
    return t if rope is None else apply_rope(t, *rope)


def rope_tail(t, rope):
    if rope is None:
        return t
    return jnp.concatenate([t[..., :MLA_NOPE], apply_rope(t[..., MLA_NOPE:], *rope)], axis=-1)


def split_heads_q(t, n_kv, group):
    b, n, _ = t.shape
    return t.reshape(b, n, n_kv, group, -1).transpose(0, 2, 3, 1, 4)


def split_heads_kv(t, n_kv):
    b, n, _ = t.shape
    return t.reshape(b, n, n_kv, -1).transpose(0, 2, 1, 3)


def merge_heads(o):
    b, hk, g, n, d = o.shape
    return o.transpose(0, 3, 1, 2, 4).reshape(b, n, hk * g * d)


def softmax_attend(q, k, v, scale, sink=None):
    s = jnp.einsum('bhgqd,bhkd->bhgqk', q, k).astype(jnp.float32) * scale
    if sink is None:
        p = jax.nn.softmax(s, axis=-1)
    else:
        sk = jnp.broadcast_to(sink.astype(jnp.float32)[None, :, :, None, None], s.shape[:-1] + (1,))
        p = jax.nn.softmax(jnp.concatenate([s, sk], axis=-1), axis=-1)[..., :-1]
    return jnp.einsum('bhgqk,bhkd->bhgqd', p.astype(v.dtype), v)


def blockwise_dense(q, k, v, scale):
    b, hk, g, s, d = q.shape
    nb = s // BLOCK
    qb = q.reshape(b, hk, g, nb, BLOCK, d).transpose(3, 0, 1, 2, 4, 5)
    ob = lax.map(lambda qi: softmax_attend(qi, k, v, scale), qb)
    return ob.transpose(1, 2, 3, 0, 4, 5).reshape(b, hk, g, s, -1)


def window_attn_latent(q, k, v, kc, vc, sink):
    b, hk, g, s, d = q.shape
    nb = s // BLOCK
    qb = q.reshape(b, hk, g, nb, BLOCK, d)

    def band(t):
        tp = jnp.pad(t, ((0, 0), (0, 0), (BLOCK, BLOCK), (0, 0)))
        tb = tp.reshape(b, hk, nb + 2, BLOCK, t.shape[-1])
        return jnp.concatenate([tb[:, :, :-2], tb[:, :, 1:-1], tb[:, :, 2:]], axis=3)

    kb, vb = band(k), band(v)
    s_loc = jnp.einsum('bhgnqd,bhnkd->bhgnqk', qb, kb).astype(jnp.float32) * SCALE_HEAD
    qpos = jnp.arange(nb)[:, None, None] * BLOCK + jnp.arange(BLOCK)[None, :, None]
    kpos = jnp.arange(nb)[:, None, None] * BLOCK - BLOCK + jnp.arange(3 * BLOCK)[None, None, :]
    valid = (jnp.abs(kpos - qpos) <= WINDOW) & (kpos >= 0) & (kpos < s)
    s_loc = jnp.where(valid, s_loc, -jnp.inf)
    s_ctx = jnp.einsum('bhgnqd,bhcd->bhgnqc', qb, kc).astype(jnp.float32) * SCALE_HEAD
    s_sink = jnp.broadcast_to(sink.astype(jnp.float32)[None, :, :, None, None, None], s_ctx.shape[:-1] + (1,))
    p = jax.nn.softmax(jnp.concatenate([s_loc, s_ctx, s_sink], axis=-1), axis=-1)
    n_loc = 3 * BLOCK
    p_loc = p[..., :n_loc].astype(v.dtype)
    p_ctx = p[..., n_loc:n_loc + kc.shape[2]].astype(v.dtype)
    o = jnp.einsum('bhgnqk,bhnkd->bhgnqd', p_loc, vb) + jnp.einsum('bhgnqc,bhcd->bhgnqd', p_ctx, vc)
    return o.reshape(b, hk, g, s, d)


def neighbourhood_attn_latent(q, k, v, kc, vc, rpb):
    b, h, s, d = q.shape
    rows = s // GRID_W
    kh = min(NA_KH, rows)
    kw = NA_KW
    qg = q.reshape(b, h, rows, GRID_W, d)
    kg = k.reshape(b, h, rows, GRID_W, d)
    vg = v.reshape(b, h, rows, GRID_W, d)
    j = jnp.arange(GRID_W)
    col_idx = jnp.clip(j - kw // 2, 0, GRID_W - kw)[:, None] + jnp.arange(kw)[None, :]
    dc = col_idx - j[:, None] + NA_KW - 1

    def row_step(r):
        rs = jnp.clip(r - kh // 2, 0, rows - kh)
        q_r = lax.dynamic_index_in_dim(qg, r, axis=2, keepdims=False)
        k_win = lax.dynamic_slice_in_dim(kg, rs, kh, axis=2)[:, :, :, col_idx]
        v_win = lax.dynamic_slice_in_dim(vg, rs, kh, axis=2)[:, :, :, col_idx]
        dr = rs + jnp.arange(kh) - r + NA_KH - 1
        bias = rpb[:, dr[:, None, None], dc[None, :, :]].transpose(0, 2, 1, 3)
        s_win = (jnp.einsum('bhjd,bhrjcd->bhjrc', q_r, k_win).astype(jnp.float32) * SCALE_HEAD
                 + bias[None].astype(jnp.float32)).reshape(b, h, GRID_W, kh * kw)
        s_ctx = jnp.einsum('bhjd,bhcd->bhjc', q_r, kc).astype(jnp.float32) * SCALE_HEAD
        p = jax.nn.softmax(jnp.concatenate([s_win, s_ctx], axis=-1), axis=-1)
        p_win = p[..., :kh * kw].reshape(b, h, GRID_W, kh, kw).astype(v.dtype)
        p_ctx = p[..., kh * kw:].astype(v.dtype)
        return (jnp.einsum('bhjrc,bhrjcd->bhjd', p_win, v_win)
                + jnp.einsum('bhjc,bhcd->bhjd', p_ctx, vc))

    o = lax.map(row_step, jnp.arange(rows))
    return o.transpose(1, 2, 0, 3, 4).reshape(b, h, 1, s, d)


def project_streams(h, w_in, a_qn, a_kn, b_qn, b_kn, c_qn, c_kn, d_q_norm, d_w_uq, d_kv_norm, d_w_ukv,
                    d_qn, d_kn, rope64, rope32, with_q):
    offs = np.cumsum(IN_SIZES)[:-1].tolist()
    a_q, a_k, a_v, b_q, b_k, b_v, c_q, c_k, c_v, d_cq, d_ckv, d_kr = jnp.split(h @ w_in, offs, axis=-1)
    bsz, n, _ = h.shape
    out = {}
    out['a_k'] = rope_full(rms_norm(split_heads_kv(a_k, A_KV_HEADS), a_kn), rope64)
    out['a_v'] = split_heads_kv(a_v, A_KV_HEADS)
    out['b_k'] = rope_full(rms_norm(split_heads_kv(b_k, B_KV_HEADS), b_kn), rope64)
    out['b_v'] = split_heads_kv(b_v, B_KV_HEADS)
    out['c_k'] = rms_norm(split_heads_kv(c_k, C_HEADS), c_kn)
    out['c_v'] = split_heads_kv(c_v, C_HEADS)
    kv = (rms_norm(d_ckv, d_kv_norm) @ d_w_ukv).reshape(bsz, n, D_HEADS, MLA_NOPE + MLA_V)
    kr = jnp.broadcast_to(d_kr[:, :, None, :], (bsz, n, D_HEADS, MLA_ROPE))
    k_mla = rms_norm(jnp.concatenate([kv[..., :MLA_NOPE], kr], axis=-1), d_kn).transpose(0, 2, 1, 3)
    out['d_k'] = rope_tail(k_mla, rope32)
    out['d_v'] = kv[..., MLA_NOPE:].transpose(0, 2, 1, 3)
    if with_q:
        out['a_q'] = rope_full(rms_norm(split_heads_q(a_q, A_KV_HEADS, A_GROUP), a_qn), rope64)
        out['b_q'] = rope_full(rms_norm(split_heads_q(b_q, B_KV_HEADS, B_GROUP), b_qn), rope64)
        out['c_q'] = rms_norm(split_heads_kv(c_q, C_HEADS), c_qn)
        q_mla = (rms_norm(d_cq, d_q_norm) @ d_w_uq).reshape(bsz, n, D_HEADS, MLA_NOPE + MLA_ROPE)
        q_mla = rms_norm(q_mla, d_qn).transpose(0, 2, 1, 3)[:, :, None]
        out['d_q'] = rope_tail(q_mla, rope32)
    return out


def merge_groups(o_a, o_b, o_c, o_d, g, w_out):
    y = jnp.stack([merge_heads(o_a), merge_heads(o_b), merge_heads(o_c), merge_heads(o_d)], axis=2)
    y = rms_norm(y, g.reshape(N_GROUPS, GROUP_WIDTH))
    return y.reshape(y.shape[0], y.shape[1], D_MODEL) @ w_out


def token_mixers(n_lat, n_ctx, w_in, a_qn, a_kn, a_sink, b_qn, b_kn, c_qn, c_kn, c_rpb, d_q_norm, d_w_uq,
                 d_kv_norm, d_w_ukv, d_qn, d_kn, out_norm_g, w_out, rope64, rope32, with_ctx_out):
    proj = (a_qn, a_kn, b_qn, b_kn, c_qn, c_kn, d_q_norm, d_w_uq, d_kv_norm, d_w_ukv, d_qn, d_kn)
    lat = project_streams(n_lat, w_in, *proj, rope64, rope32, True)
    cx = project_streams(n_ctx, w_in, *proj, None, None, with_ctx_out)
    sink = a_sink.reshape(A_KV_HEADS, A_GROUP)

    def cat(name):
        return jnp.concatenate([cx[name], lat[name]], axis=2)

    o_a = window_attn_latent(lat['a_q'], lat['a_k'], lat['a_v'], cx['a_k'], cx['a_v'], sink)
    o_b = blockwise_dense(lat['b_q'], cat('b_k'), cat('b_v'), SCALE_HEAD)
    o_c = neighbourhood_attn_latent(lat['c_q'], lat['c_k'], lat['c_v'], cx['c_k'], cx['c_v'], c_rpb)
    o_d = blockwise_dense(lat['d_q'], cat('d_k'), cat('d_v'), SCALE_MLA)
    out_lat = merge_groups(o_a, o_b, o_c, o_d, out_norm_g, w_out)
    if not with_ctx_out:
        return out_lat, None
    oc_a = softmax_attend(cx['a_q'], cx['a_k'], cx['a_v'], SCALE_HEAD, sink)
    oc_b = softmax_attend(cx['b_q'], cx['b_k'], cx['b_v'], SCALE_HEAD)
    oc_c = softmax_attend(cx['c_q'][:, :, None], cx['c_k'], cx['c_v'], SCALE_HEAD)
    oc_d = softmax_attend(cx['d_q'], cx['d_k'], cx['d_v'], SCALE_MLA)
    out_ctx = merge_groups(oc_a, oc_b, oc_c, oc_d, out_norm_g, w_out)
    return out_lat, out_ctx


def swiglu(h, w_gate, w_up, w_down):
    return (jax.nn.silu(h @ w_gate) * (h @ w_up)) @ w_down


def moe_swiglu(h, router, w_gate, w_up, w_down):
    bsz, n, d = h.shape
    hf = h.reshape(-1, d)
    n_tok = hf.shape[0]
    logits = (hf @ router).astype(jnp.float32)
    top_v, top_e = lax.top_k(logits, TOP_K)
    gates = jax.nn.softmax(top_v, axis=-1)
    m = n_tok * TOP_K
    e_flat = top_e.reshape(-1)
    tok_flat = jnp.repeat(jnp.arange(n_tok, dtype=jnp.int32), TOP_K)
    g_flat = gates.reshape(-1)
    order = jnp.argsort(e_flat)
    e_s, tok_s, g_s = e_flat[order], tok_flat[order], g_flat[order]
    counts = jnp.bincount(e_flat, length=N_EXPERTS)
    starts = jnp.cumsum(counts) - counts
    padded = (counts + MOE_BLOCK - 1) // MOE_BLOCK * MOE_BLOCK
    pends = jnp.cumsum(padded)
    pstarts = pends - padded
    dest = pstarts[e_s] + jnp.arange(m) - starts[e_s]
    n_blocks = (m + N_EXPERTS * (MOE_BLOCK - 1) + MOE_BLOCK - 1) // MOE_BLOCK
    n_rows = n_blocks * MOE_BLOCK
    buf_tok = jnp.zeros((n_rows,), jnp.int32).at[dest].set(tok_s)
    buf_gate = jnp.zeros((n_rows,), jnp.float32).at[dest].set(g_s)
    block_e = jnp.clip(jnp.searchsorted(pends, jnp.arange(n_blocks) * MOE_BLOCK, side='right'), 0, N_EXPERTS - 1)

    def run_block(args):
        e, toks = args
        xb = hf[toks]
        return (jax.nn.silu(xb @ w_gate[e]) * (xb @ w_up[e])) @ w_down[e]

    yb = lax.map(run_block, (block_e, buf_tok.reshape(n_blocks, MOE_BLOCK)))
    contrib = yb.reshape(n_rows, d) * buf_gate[:, None].astype(hf.dtype)
    return jnp.zeros_like(hf).at[buf_tok].add(contrib).reshape(bsz, n, d)


def setup_inputs(seed: int = 0) -> dict:
    key = jax.random.key(seed)
    ks = jax.random.split(key, 32)

    def nrm(i, shape, scale):
        return jax.random.normal(ks[i], shape, jnp.float32) * scale

    def gain(i, shape):
        return 1.0 + 0.05 * jax.random.normal(ks[i], shape, jnp.float32)

    L, d = DEPTH, D_MODEL
    return {
        'x': nrm(0, (BATCH, SEQ, d), 1.0),
        'c': nrm(1, (BATCH, d), 1.0),
        'ctx': nrm(2, (BATCH, CTX_LEN, d), 1.0),
        'c_ctx': nrm(3, (d,), 1.0),
        'ada_w': nrm(4, (L, d, 6 * d), 0.5 * d ** -0.5),
        'ada_b': nrm(5, (L, 6 * d), 0.02),
        'norm1_g': gain(6, (L, d)),
        'norm2_g': gain(7, (L, d)),
        'w_in': nrm(8, (L, d, IN_WIDTH), d ** -0.5),
        'a_qn': gain(9, (L, HEAD_DIM)),
        'a_kn': gain(10, (L, HEAD_DIM)),
        'a_sink': nrm(11, (L, A_HEADS), 0.5),
        'b_qn': gain(12, (L, HEAD_DIM)),
        'b_kn': gain(13, (L, HEAD_DIM)),
        'c_qn': gain(14, (L, HEAD_DIM)),
        'c_kn': gain(15, (L, HEAD_DIM)),
        'c_rpb': nrm(16, (L, C_HEADS, 2 * NA_KH - 1, 2 * NA_KW - 1), 0.1),
        'd_q_norm': gain(17, (L, MLA_Q_RANK)),
        'd_w_uq': nrm(18, (L, MLA_Q_RANK, D_HEADS * (MLA_NOPE + MLA_ROPE)), MLA_Q_RANK ** -0.5),
        'd_kv_norm': gain(19, (L, MLA_KV_RANK)),
        'd_w_ukv': nrm(20, (L, MLA_KV_RANK, D_HEADS * (MLA_NOPE + MLA_V)), MLA_KV_RANK ** -0.5),
        'd_qn': gain(21, (L, MLA_NOPE + MLA_ROPE)),
        'd_kn': gain(22, (L, MLA_NOPE + MLA_ROPE)),
        'out_norm_g': gain(23, (L, d)),
        'w_out': nrm(24, (L, d, d), d ** -0.5),
        'ffn_w_gate': nrm(25, (N_DENSE, d, D_FF), d ** -0.5),
        'ffn_w_up': nrm(26, (N_DENSE, d, D_FF), d ** -0.5),
        'ffn_w_down': nrm(27, (N_DENSE, D_FF, d), D_FF ** -0.5),
        'moe_router': nrm(28, (N_MOE, d, N_EXPERTS), d ** -0.5),
        'moe_w_gate': nrm(29, (N_MOE, N_EXPERTS, d, D_FF_EXPERT), d ** -0.5),
        'moe_w_up': nrm(30, (N_MOE, N_EXPERTS, d, D_FF_EXPERT), d ** -0.5),
        'moe_w_down': nrm(31, (N_MOE, N_EXPERTS, D_FF_EXPERT, d), D_FF_EXPERT ** -0.5),
    }


def reference(x, c, ctx, c_ctx, ada_w, ada_b, norm1_g, norm2_g, w_in, a_qn, a_kn, a_sink, b_qn, b_kn,
              c_qn, c_kn, c_rpb, d_q_norm, d_w_uq, d_kv_norm, d_w_ukv, d_qn, d_kn, out_norm_g, w_out,
              ffn_w_gate, ffn_w_up, ffn_w_down, moe_router, moe_w_gate, moe_w_up, moe_w_down):
    n_lat_tokens = x.shape[1]
    rope64 = axial_rope_tables(n_lat_tokens, HEAD_DIM, x.dtype)
    rope32 = axial_rope_tables(n_lat_tokens, MLA_ROPE, x.dtype)
    h_lat, h_ctx = x, ctx
    for layer in range(DEPTH):
        last = layer == DEPTH - 1
        mod_lat = jax.nn.silu(c) @ ada_w[layer] + ada_b[layer]
        mod_ctx = jax.nn.silu(c_ctx) @ ada_w[layer] + ada_b[layer]
        sh1, sc1, g1, sh2, sc2, g2 = jnp.split(mod_lat[:, None, :], 6, axis=-1)
        csh1, csc1, cg1, csh2, csc2, cg2 = jnp.split(mod_ctx, 6, axis=-1)
        mix_lat, mix_ctx = token_mixers(
            modulate(rms_norm(h_lat, norm1_g[layer]), sh1, sc1),
            modulate(rms_norm(h_ctx, norm1_g[layer]), csh1, csc1),
            w_in[layer], a_qn[layer], a_kn[layer], a_sink[layer], b_qn[layer], b_kn[layer],
            c_qn[layer], c_kn[layer], c_rpb[layer], d_q_norm[layer], d_w_uq[layer], d_kv_norm[layer],
            d_w_ukv[layer], d_qn[layer], d_kn[layer], out_norm_g[layer], w_out[layer],
            rope64, rope32, not last)
        h_lat = h_lat + g1 * mix_lat
        if not last:
            h_ctx = h_ctx + cg1 * mix_ctx
        f_lat = modulate(rms_norm(h_lat, norm2_g[layer]), sh2, sc2)
        j = layer // 2
        if layer % 2 == 0:
            h_lat = h_lat + g2 * swiglu(f_lat, ffn_w_gate[j], ffn_w_up[j], ffn_w_down[j])
            if not last:
                f_ctx = modulate(rms_norm(h_ctx, norm2_g[layer]), csh2, csc2)
                h_ctx = h_ctx + cg2 * swiglu(f_ctx, ffn_w_gate[j], ffn_w_up[j], ffn_w_down[j])
        else:
            h_lat = h_lat + g2 * moe_swiglu(f_lat, moe_router[j], moe_w_gate[j], moe_w_up[j], moe_w_down[j])
            if not last:
                f_ctx = modulate(rms_norm(h_ctx, norm2_g[layer]), csh2, csc2)
                h_ctx = h_ctx + cg2 * moe_swiglu(f_ctx, moe_router[j], moe_w_gate[j], moe_w_up[j], moe_w_down[j])
    return h_lat
```

```cpp
#include <hip/hip_runtime.h>
#include <stdint.h>
#include <cstdio>

typedef unsigned short bf16_t;
typedef float f32x4 __attribute__((ext_vector_type(4)));
typedef unsigned u32x4 __attribute__((ext_vector_type(4)));
typedef unsigned u32x2 __attribute__((ext_vector_type(2)));

constexpr int D = 1024, NB = 2, SEQ = 8192, CTX = 256, TL = NB * SEQ, TC = NB * CTX, MALL = TL + TC;
constexpr int NIN = 2144, NINP = 2304, DFF = 2816, NE = 8, DFFE = 3584, KEYS = CTX + SEQ;
constexpr int OFF_AQ = 0, OFF_AK = 256, OFF_AV = 384, OFF_BQ = 512, OFF_BK = 768, OFF_BV = 896, OFF_CQ = 1024, OFF_CK = 1280,
              OFF_CV = 1536, OFF_DCQ = 1792, OFF_DCKV = 1984, OFF_DKR = 2112;
constexpr int MOE_ROWS = 34816;
constexpr float EPS = 1e-6f;

constexpr size_t MiB = 1u << 20;
constexpr size_t WS_CTL = 0;
constexpr size_t WS_MOD = 1 * MiB;
constexpr size_t WS_ROPE = WS_MOD + 256 * 1024;
constexpr size_t WS_TOKE = WS_ROPE + 64 * 1024;
constexpr size_t WS_TOKP = WS_TOKE + TL * 8;
constexpr size_t WS_TOKG = WS_TOKP + TL * 8;
constexpr size_t WS_TEXP = WS_TOKG + TL * 8;
constexpr size_t WS_HCTX = 2 * MiB;
constexpr size_t WS_MODP = 4 * MiB;
constexpr size_t WS_WMGU = 6 * MiB;
constexpr size_t WS_WMDN = WS_WMGU + 112 * MiB;
constexpr size_t WS_WDEAD = WS_WMDN + 56 * MiB;
constexpr size_t WS_WIN = WS_WDEAD;
constexpr size_t WS_WOUT = WS_WIN + 9 * MiB;
constexpr size_t WS_WUQ = WS_WOUT + 4 * MiB;
constexpr size_t WS_WUKV = WS_WUQ + 512 * 1024;
constexpr size_t WS_WFGU = WS_WUKV + 512 * 1024;
constexpr size_t WS_WFDN = WS_WFGU + 11 * MiB;
constexpr size_t WS_ACT = 205 * MiB;
static_assert(WS_WFDN + (size_t)1024 * 2816 * 2 <= WS_ACT, "weights fit");
constexpr size_t WS_ACT1 = WS_ACT;
constexpr size_t WS_P = WS_ACT + 33 * MiB;
constexpr size_t WS_QKV = WS_ACT + 108 * MiB;
constexpr size_t WS_HIDF = WS_P;
constexpr size_t WS_HIDM = WS_WDEAD;
constexpr size_t WS_ASORT = WS_HIDM + 238 * MiB;
constexpr size_t WS_END = WS_ASORT + 68 * MiB;
static_assert(WS_QKV + 91 * MiB <= WS_END, "qkv fits");

struct Params { const float* in[32]; float* out; unsigned char* ws; };

struct QKVB { bf16_t *QA, *KA, *VA, *QB, *KB, *VB, *QC, *KC, *VC, *QD, *KD, *VD, *QAc, *QBc, *QCc, *QDc; };
__host__ __device__ inline QKVB make_qkv(unsigned char* ws) {
    QKVB q; bf16_t* p = (bf16_t*)(ws + WS_QKV);
    q.QA = p; p += (size_t)NB * 4 * SEQ * 64; q.KA = p; p += (size_t)NB * 2 * KEYS * 64; q.VA = p; p += (size_t)NB * 2 * KEYS * 64;
    q.QB = p; p += (size_t)NB * 4 * SEQ * 64; q.KB = p; p += (size_t)NB * 2 * KEYS * 64; q.VB = p; p += (size_t)NB * 2 * KEYS * 64;
    q.QC = p; p += (size_t)NB * 4 * SEQ * 64; q.KC = p; p += (size_t)NB * 4 * KEYS * 64; q.VC = p; p += (size_t)NB * 4 * KEYS * 64;
    q.QD = p; p += (size_t)NB * 4 * SEQ * 96; q.KD = p; p += (size_t)NB * 4 * KEYS * 96; q.VD = p; p += (size_t)NB * 4 * KEYS * 64;
    q.QAc = p; p += (size_t)NB * 4 * CTX * 64; q.QBc = p; p += (size_t)NB * 4 * CTX * 64; q.QCc = p; p += (size_t)NB * 4 * CTX * 64;
    q.QDc = p; p += (size_t)NB * 4 * CTX * 96;
    return q;
}

__device__ __forceinline__ float bf2f(unsigned v) { return __uint_as_float(v << 16); }
__device__ __forceinline__ float bflo(unsigned w) { return __uint_as_float(w << 16); }
__device__ __forceinline__ float bfhi(unsigned w) { return __uint_as_float(w & 0xffff0000u); }
__device__ __forceinline__ unsigned f2bf(float f) { unsigned u = __float_as_uint(f); return (u + 0x7fffu + ((u >> 16) & 1u)) >> 16; }
__device__ __forceinline__ unsigned pk2(float lo, float hi) { return f2bf(lo) | (f2bf(hi) << 16); }
__device__ __forceinline__ float wave_sum(float v) {
#pragma unroll
    for (int o = 1; o < 64; o <<= 1) v += __shfl_xor(v, o);
    return v;
}
__device__ __forceinline__ float silu_f(float x) { return x / (1.f + expf(-x)); }

__global__ void __launch_bounds__(512) k_mods_partial(Params p) {
    __shared__ float sv[3][128];
    const int item = blockIdx.x;
    const int kc = item % 8, nch = (item / 8) % 12, l = item / 96;
    const int tid = threadIdx.x;
    if (tid < 384) { const int v = tid / 128, k = kc * 128 + tid % 128; const float x = (v < 2) ? p.in[1][v * D + k] : p.in[3][k]; sv[v][tid % 128] = silu_f(x); }
    __syncthreads();
    const int n = nch * 512 + tid;
    const float* w = p.in[4] + ((size_t)l * D + kc * 128) * 6144 + n;
    float a0 = 0.f, a1 = 0.f, a2 = 0.f;
#pragma unroll 8
    for (int k = 0; k < 128; ++k) { const float wv = w[(size_t)k * 6144]; a0 += sv[0][k] * wv; a1 += sv[1][k] * wv; a2 += sv[2][k] * wv; }
    float* o = (float*)(p.ws + WS_MODP) + (((size_t)kc * 2 + l) * 3) * 6144 + n;
    o[0] = a0; o[6144] = a1; o[2 * 6144] = a2;
}
__global__ void __launch_bounds__(512) k_mods_final(Params p) {
    const int idx = blockIdx.x * 512 + threadIdx.x;
    if (idx >= 2 * 3 * 6144) return;
    const int n = idx % 6144, l = idx / (3 * 6144);
    float s = p.in[5][l * 6144 + n];
    const float* pp = (const float*)(p.ws + WS_MODP) + idx;
#pragma unroll
    for (int kc = 0; kc < 8; ++kc) s += pp[(size_t)kc * 2 * 3 * 6144];
    ((float*)(p.ws + WS_MOD))[idx] = s;
}

__device__ __forceinline__ void sincos_d(double a, double& s, double& c) {
    const double k = rint(a * 0.63661977236758134308);
    double r = a - k * 1.57079632679489655800e+00; r -= k * 6.12323399573676603587e-17;
    const double r2 = r * r;
    double sp = 1.0 / 121645100408832000.0;
    sp = sp * r2 - 1.0 / 355687428096000.0; sp = sp * r2 + 1.0 / 1307674368000.0; sp = sp * r2 - 1.0 / 6227020800.0; sp = sp * r2 + 1.0 / 39916800.0;
    sp = sp * r2 - 1.0 / 362880.0; sp = sp * r2 + 1.0 / 5040.0; sp = sp * r2 - 1.0 / 120.0; sp = sp * r2 + 1.0 / 6.0; sp = -sp * r2 + 1.0;
    const double sr = r * sp;
    double cp = 1.0 / 6402373705728000.0;
    cp = cp * r2 - 1.0 / 20922789888000.0; cp = cp * r2 + 1.0 / 87178291200.0; cp = cp * r2 - 1.0 / 479001600.0; cp = cp * r2 + 1.0 / 3628800.0;
    cp = cp * r2 - 1.0 / 40320.0; cp = cp * r2 + 1.0 / 720.0; cp = cp * r2 - 1.0 / 24.0; cp = cp * r2 + 0.5; const double cr = 1.0 - cp * r2;
    const int q = ((int)k) & 3;
    s = (q == 0) ? sr : (q == 1) ? cr : (q == 2) ? -sr : -cr;
    c = (q == 0) ? cr : (q == 1) ? -sr : (q == 2) ? -cr : sr;
}
constexpr int RT_R64 = 0, RT_C64 = 2048, RT_R32 = 3072, RT_C32 = 4096, RT_N = 4608;
__global__ void k_rope_tables(Params p) {
    const int idx = blockIdx.x * blockDim.x + threadIdx.x;
    if (idx >= RT_N) return;
    int pos, i, nf;
    if (idx < RT_C64) { pos = idx / 16; i = idx % 16; nf = 16; }
    else if (idx < RT_R32) { pos = (idx - RT_C64) / 16; i = idx % 16; nf = 16; }
    else if (idx < RT_C32) { pos = (idx - RT_R32) / 8; i = idx % 8; nf = 8; }
    else { pos = (idx - RT_C32) / 8; i = idx % 8; nf = 8; }
    const float inv = powf(10000.0f, -(float)i / (float)nf);
    const float ang = (float)pos * inv;
    double s, c; sincos_d((double)ang, s, c);
    ((float2*)(p.ws + WS_ROPE))[idx] = make_float2((float)c, (float)s);
}

struct SrcPlain { const float* W; int N; int pad; __device__ float operator()(int k, int nb) const { return W[(size_t)k * N + nb]; } };
struct SrcPerm { const float* W; int N, nvalid;
    __device__ float operator()(int k, int nb) const { const int col = (nb & ~31) + 8 * ((nb >> 2) & 3) + 4 * ((nb >> 4) & 1) + (nb & 3); return col < nvalid ? W[(size_t)k * N + col] : 0.f; } };
struct SrcGU { const float* G; const float* U; int F; int pad;
    __device__ float operator()(int k, int nb) const { const int col = 16 * (nb >> 5) + (nb & 15); return ((nb >> 4) & 1) ? U[(size_t)k * F + col] : G[(size_t)k * F + col]; } };
template <class Src> __device__ __forceinline__ void convT_tile(bf16_t* dst, int K, Src src, float* lds, int nt, int kt) {
    const int tid = threadIdx.x, n0 = nt * 64, k0 = kt * 64;
    __syncthreads();
#pragma unroll
    for (int r = 0; r < 8; ++r) { const int i = (tid >> 6) + 8 * r, j = tid & 63; lds[i * 65 + j] = src(k0 + i, n0 + j); }
    __syncthreads();
    const int n = tid >> 3, kc = (tid & 7) * 8;
    u32x4 o; o.x = pk2(lds[(kc + 0) * 65 + n], lds[(kc + 1) * 65 + n]); o.y = pk2(lds[(kc + 2) * 65 + n], lds[(kc + 3) * 65 + n]);
    o.z = pk2(lds[(kc + 4) * 65 + n], lds[(kc + 5) * 65 + n]); o.w = pk2(lds[(kc + 6) * 65 + n], lds[(kc + 7) * 65 + n]);
    *(u32x4*)(dst + (size_t)(n0 + n) * K + k0 + kc) = o;
}
template <class Src> __global__ void __launch_bounds__(512) k_convT(bf16_t* dst, int Nd, int K, Src src) {
    __shared__ float lds[64 * 65];
    const int ntl = Nd / 64, ktl = K / 64;
    for (int t = blockIdx.x; t < ntl * ktl; t += gridDim.x) convT_tile(dst, K, src, lds, t / ktl, t % ktl);
}
__global__ void __launch_bounds__(512) k_convT_gu_e(bf16_t* dst, const float* G, const float* U) {
    __shared__ float lds[64 * 65];
    const int e = blockIdx.y; SrcGU s{G + (size_t)e * D * DFFE, U + (size_t)e * D * DFFE, DFFE};
    bf16_t* d = dst + (size_t)e * 2 * DFFE * D; const int ntl = 2 * DFFE / 64, ktl = D / 64;
    for (int t = blockIdx.x; t < ntl * ktl; t += gridDim.x) convT_tile(d, D, s, lds, t / ktl, t % ktl);
}
__global__ void __launch_bounds__(512) k_convT_perm_e(bf16_t* dst, const float* W) {
    __shared__ float lds[64 * 65];
    const int e = blockIdx.y; SrcPerm s{W + (size_t)e * DFFE * D, D, D};
    bf16_t* d = dst + (size_t)e * D * DFFE; const int ntl = D / 64, ktl = DFFE / 64;
    for (int t = blockIdx.x; t < ntl * ktl; t += gridDim.x) convT_tile(d, DFFE, s, lds, t / ktl, t % ktl);
}

template <int WHICH, bool ROUTER> __global__ void __launch_bounds__(512) k_norm(Params p, int layer, int nrows) {
    const int lane = threadIdx.x & 63, gw = (blockIdx.x * 512 + threadIdx.x) >> 6, ngw = (gridDim.x * 512) >> 6;
    const float* hl = (layer == 0 && WHICH == 1) ? p.in[0] : p.out;
    const float* hc = (layer == 0 && WHICH == 1) ? p.in[2] : (const float*)(p.ws + WS_HCTX);
    const float* gain = p.in[WHICH == 1 ? 6 : 7] + layer * D;
    const float* mod = (const float*)(p.ws + WS_MOD) + (size_t)layer * 3 * 6144;
    bf16_t* dst = (bf16_t*)(p.ws + WS_ACT1);
    for (int m = gw; m < nrows; m += ngw) {
        const float* src = (m < TL) ? hl + (size_t)m * D : hc + (size_t)(m - TL) * D;
        const float* mv = mod + (m < TL ? m / SEQ : 2) * 6144;
        const float* shp = mv + (WHICH == 1 ? 0 : 3) * D; const float* scp = mv + (WHICH == 1 ? 1 : 4) * D;
        f32x4 v[4]; float ss = 0.f;
#pragma unroll
        for (int j = 0; j < 4; ++j) { v[j] = *(const f32x4*)(src + 256 * j + 4 * lane); ss += v[j].x * v[j].x + v[j].y * v[j].y + v[j].z * v[j].z + v[j].w * v[j].w; }
        const float rstd = rsqrtf(wave_sum(ss) * (1.f / D) + EPS);
        float lg[8];
#pragma unroll
        for (int e = 0; e < 8; ++e) lg[e] = 0.f;
#pragma unroll
        for (int j = 0; j < 4; ++j) {
            const int c = 256 * j + 4 * lane;
            const f32x4 g = *(const f32x4*)(gain + c), sh = *(const f32x4*)(shp + c), sc = *(const f32x4*)(scp + c);
            f32x4 f = v[j] * rstd * g * (sc + 1.f) + sh;
            u32x2 w; w.x = pk2(f.x, f.y); w.y = pk2(f.z, f.w);
            *(u32x2*)(dst + (size_t)m * D + c) = w;
            if (ROUTER) {
                const float* rt = p.in[28] + (size_t)c * 8;
#pragma unroll
                for (int i = 0; i < 4; ++i) { const f32x4 r0 = *(const f32x4*)(rt + 8 * i), r1 = *(const f32x4*)(rt + 8 * i + 4); const float fv = f[i];
                    lg[0] += fv * r0.x; lg[1] += fv * r0.y; lg[2] += fv * r0.z; lg[3] += fv * r0.w; lg[4] += fv * r1.x; lg[5] += fv * r1.y; lg[6] += fv * r1.z; lg[7] += fv * r1.w; }
            }
        }
        if (ROUTER) {
#pragma unroll
            for (int e = 0; e < 8; ++e) lg[e] = wave_sum(lg[e]);
            if (lane == 0) {
                int e0 = 0; float v0 = lg[0];
#pragma unroll
                for (int e = 1; e < 8; ++e) if (lg[e] > v0) { v0 = lg[e]; e0 = e; }
                int e1 = -1; float v1 = -INFINITY;
#pragma unroll
                for (int e = 0; e < 8; ++e) if (e != e0 && lg[e] > v1) { v1 = lg[e]; e1 = e; }
                const float t = expf(v1 - v0), g0 = 1.f / (1.f + t), g1 = t / (1.f + t);
                unsigned* cnt = (unsigned*)(p.ws + WS_CTL);
                const int p0 = (int)atomicAdd(cnt + e0, 1u), p1 = (int)atomicAdd(cnt + e1, 1u);
                ((int2*)(p.ws + WS_TOKE))[m] = make_int2(e0, e1); ((int2*)(p.ws + WS_TOKP))[m] = make_int2(p0, p1); ((float2*)(p.ws + WS_TOKG))[m] = make_float2(g0, g1);
            }
        }
    }
}

struct EpiBf16Perm { bf16_t* O; int ldo; int pad;
    __device__ __forceinline__ void operator()(int row, int g, int fq, f32x4 v0, f32x4 v1) const {
        u32x4 w; w.x = pk2(v0.x, v0.y); w.y = pk2(v0.z, v0.w); w.z = pk2(v1.x, v1.y); w.w = pk2(v1.z, v1.w);
        *(u32x4*)(O + (size_t)row * ldo + 32 * g + 8 * fq) = w; } };
struct EpiResid { const float* hl_in; const float* hc_in; float* hl_out; float* hc_out; const float* mod; int goff; int pad;
    __device__ __forceinline__ void operator()(int row, int g, int fq, f32x4 v0, f32x4 v1) const {
        const int c0 = 32 * g + 4 * fq; const float* hin; float* hout; const float* gv;
        if (row < TL) { hin = hl_in + (size_t)row * D; hout = hl_out + (size_t)row * D; gv = mod + (row / SEQ) * 6144 + goff; }
        else { hin = hc_in + (size_t)(row - TL) * D; hout = hc_out + (size_t)(row - TL) * D; gv = mod + 2 * 6144 + goff; }
        *(f32x4*)(hout + c0) = *(const f32x4*)(hin + c0) + *(const f32x4*)(gv + c0) * v0;
        *(f32x4*)(hout + c0 + 16) = *(const f32x4*)(hin + c0 + 16) + *(const f32x4*)(gv + c0 + 16) * v1; } };
struct EpiSwiglu { bf16_t* H; int ldh; int pad;
    __device__ __forceinline__ void operator()(int row, int g, int fq, f32x4 v0, f32x4 v1) const {
        u32x2 w; w.x = pk2(silu_f(v0.x) * v1.x, silu_f(v0.y) * v1.y); w.y = pk2(silu_f(v0.z) * v1.z, silu_f(v0.w) * v1.w);
        *(u32x2*)(H + (size_t)row * ldh + 16 * g + 4 * fq) = w; } };

template <class Epi> __global__ void __launch_bounds__(512) k_gemm(const bf16_t* A, const bf16_t* Bt, const int* texp, size_t bstride, Epi epi, int K, int mt, int nt, int pad_) {
    __shared__ float As[32 * 132]; __shared__ float Bs[32 * 132];
    const int tid = threadIdx.x, rq = tid >> 4, cg = tid & 15, g = cg >> 2, fq = cg & 3, r0 = rq * 4, c0 = 32 * g + 4 * fq;
    const int lrow = tid >> 2, lkc = (tid & 3) * 8;
    for (int tile = blockIdx.x; tile < mt * nt; tile += gridDim.x) {
        const int tm = tile / nt, tn = tile % nt;
        const bf16_t* Bb = Bt;
        if (texp) { const int e = texp[tm >> 1]; if (e < 0) continue; Bb += (size_t)e * bstride; }
        const bf16_t* ap = A + (size_t)(tm * 128 + lrow) * K + lkc; const bf16_t* bp = Bb + (size_t)(tn * 128 + lrow) * K + lkc;
        f32x4 acc0[4], acc1[4];
#pragma unroll
        for (int i = 0; i < 4; ++i) { acc0[i] = (f32x4){0.f, 0.f, 0.f, 0.f}; acc1[i] = (f32x4){0.f, 0.f, 0.f, 0.f}; }
        for (int k0 = 0; k0 < K; k0 += 32) {
            const u32x4 va = *(const u32x4*)(ap + k0), vb = *(const u32x4*)(bp + k0);
            __syncthreads();
            As[(lkc + 0) * 132 + lrow] = bflo(va.x); As[(lkc + 1) * 132 + lrow] = bfhi(va.x); As[(lkc + 2) * 132 + lrow] = bflo(va.y); As[(lkc + 3) * 132 + lrow] = bfhi(va.y);
            As[(lkc + 4) * 132 + lrow] = bflo(va.z); As[(lkc + 5) * 132 + lrow] = bfhi(va.z); As[(lkc + 6) * 132 + lrow] = bflo(va.w); As[(lkc + 7) * 132 + lrow] = bfhi(va.w);
            Bs[(lkc + 0) * 132 + lrow] = bflo(vb.x); Bs[(lkc + 1) * 132 + lrow] = bfhi(vb.x); Bs[(lkc + 2) * 132 + lrow] = bflo(vb.y); Bs[(lkc + 3) * 132 + lrow] = bfhi(vb.y);
            Bs[(lkc + 4) * 132 + lrow] = bflo(vb.z); Bs[(lkc + 5) * 132 + lrow] = bfhi(vb.z); Bs[(lkc + 6) * 132 + lrow] = bflo(vb.w); Bs[(lkc + 7) * 132 + lrow] = bfhi(vb.w);
            __syncthreads();
#pragma unroll 8
            for (int kk = 0; kk < 32; ++kk) {
                const f32x4 a = *(const f32x4*)(As + kk * 132 + r0), b0 = *(const f32x4*)(Bs + kk * 132 + c0), b1 = *(const f32x4*)(Bs + kk * 132 + c0 + 16);
                acc0[0] += b0 * a.x; acc0[1] += b0 * a.y; acc0[2] += b0 * a.z; acc0[3] += b0 * a.w;
                acc1[0] += b1 * a.x; acc1[1] += b1 * a.y; acc1[2] += b1 * a.z; acc1[3] += b1 * a.w;
            }
        }
#pragma unroll
        for (int i = 0; i < 4; ++i) epi(tm * 128 + r0 + i, tn * 4 + g, fq, acc0[i], acc1[i]);
    }
}

__device__ __forceinline__ void store_row_bf16(bf16_t* dst, const float* src, int n) {
    for (int c = 0; c < n; c += 8) { u32x4 w; w.x = pk2(src[c], src[c + 1]); w.y = pk2(src[c + 2], src[c + 3]); w.z = pk2(src[c + 4], src[c + 5]); w.w = pk2(src[c + 6], src[c + 7]); *(u32x4*)(dst + c) = w; }
}
__global__ void __launch_bounds__(512) k_postproj(Params p, int layer, int pad_) {
    extern __shared__ __attribute__((aligned(16))) unsigned char smem[];
    float* X = (float*)smem;
    float* QM = X + 8 * NIN;
    float* KV = QM + 8 * 384;
    float* KDN = KV + 8 * 512;
    const int tid = threadIdx.x;
    const bf16_t* P = (const bf16_t*)(p.ws + WS_P);
    const QKVB qb = make_qkv(p.ws);
    const bf16_t* Wuq = (const bf16_t*)(p.ws + WS_WUQ) + (size_t)layer * 384 * 192;
    const bf16_t* Wukv = (const bf16_t*)(p.ws + WS_WUKV) + (size_t)layer * 512 * 128;
    const float2* rope = (const float2*)(p.ws + WS_ROPE);
    for (int tile = blockIdx.x; tile < MALL / 8; tile += gridDim.x) {
        const int m0 = tile * 8;
        __syncthreads();
        for (int i = tid; i < 8 * NIN / 8; i += 512) { const int t = i / (NIN / 8), c = (i % (NIN / 8)) * 8;
            const u32x4 v = *(const u32x4*)(P + (size_t)(m0 + t) * NINP + c); float* x = X + t * NIN + c;
            x[0] = bflo(v.x); x[1] = bfhi(v.x); x[2] = bflo(v.y); x[3] = bfhi(v.y); x[4] = bflo(v.z); x[5] = bfhi(v.z); x[6] = bflo(v.w); x[7] = bfhi(v.w); }
        __syncthreads();
        if (tid < 16) { const int t = tid >> 1, which = tid & 1; float* x = X + t * NIN + (which ? OFF_DCKV : OFF_DCQ); const int n = which ? 128 : 192;
            const float* g = which ? p.in[19] + layer * 128 : p.in[17] + layer * 192; float ss = 0.f;
            for (int i = 0; i < n; ++i) ss += x[i] * x[i];
            const float r = rsqrtf(ss / n + EPS); for (int i = 0; i < n; ++i) x[i] = x[i] * r * g[i]; }
        __syncthreads();
        if (tid < 384) { float acc[8];
#pragma unroll
            for (int t = 0; t < 8; ++t) acc[t] = 0.f;
            const bf16_t* w = Wuq + (size_t)tid * 192;
            for (int k = 0; k < 192; k += 8) { const u32x4 wv = *(const u32x4*)(w + k); const float w0 = bflo(wv.x), w1 = bfhi(wv.x), w2 = bflo(wv.y), w3 = bfhi(wv.y), w4 = bflo(wv.z), w5 = bfhi(wv.z), w6 = bflo(wv.w), w7 = bfhi(wv.w);
#pragma unroll
                for (int t = 0; t < 8; ++t) { const float* x = X + t * NIN + OFF_DCQ + k; acc[t] += x[0] * w0 + x[1] * w1 + x[2] * w2 + x[3] * w3 + x[4] * w4 + x[5] * w5 + x[6] * w6 + x[7] * w7; } }
#pragma unroll
            for (int t = 0; t < 8; ++t) QM[t * 384 + tid] = acc[t]; }
        { float acc[8];
#pragma unroll
            for (int t = 0; t < 8; ++t) acc[t] = 0.f;
            const bf16_t* w = Wukv + (size_t)tid * 128;
            for (int k = 0; k < 128; k += 8) { const u32x4 wv = *(const u32x4*)(w + k); const float w0 = bflo(wv.x), w1 = bfhi(wv.x), w2 = bflo(wv.y), w3 = bfhi(wv.y), w4 = bflo(wv.z), w5 = bfhi(wv.z), w6 = bflo(wv.w), w7 = bfhi(wv.w);
#pragma unroll
                for (int t = 0; t < 8; ++t) { const float* x = X + t * NIN + OFF_DCKV + k; acc[t] += x[0] * w0 + x[1] * w1 + x[2] * w2 + x[3] * w3 + x[4] * w4 + x[5] * w5 + x[6] * w6 + x[7] * w7; } }
#pragma unroll
            for (int t = 0; t < 8; ++t) KV[t * 512 + tid] = acc[t]; }
        __syncthreads();
        if (tid < 224) {
            const int t = tid / 28, j = tid % 28, m = m0 + t; const bool lat = m < TL;
            const int b = lat ? m / SEQ : (m - TL) / CTX, s = lat ? m % SEQ : (m - TL) % CTX, key = lat ? CTX + s : s;
            const int prow = s / 64, pcol = s % 64;
            float* src; const float* gn; int n = 64; bf16_t* dst; int ropemode = 0;
            if (j < 4)       { src = X + t * NIN + OFF_AQ + 64 * j; gn = p.in[9] + layer * 64; ropemode = 1; dst = lat ? qb.QA + ((size_t)(b * 4 + j) * SEQ + s) * 64 : qb.QAc + ((size_t)(b * 4 + j) * CTX + s) * 64; }
            else if (j < 6)  { const int h = j - 4; src = X + t * NIN + OFF_AK + 64 * h; gn = p.in[10] + layer * 64; ropemode = 1; dst = qb.KA + ((size_t)(b * 2 + h) * KEYS + key) * 64; }
            else if (j < 10) { const int h = j - 6; src = X + t * NIN + OFF_BQ + 64 * h; gn = p.in[12] + layer * 64; ropemode = 1; dst = lat ? qb.QB + ((size_t)(b * 4 + h) * SEQ + s) * 64 : qb.QBc + ((size_t)(b * 4 + h) * CTX + s) * 64; }
            else if (j < 12) { const int h = j - 10; src = X + t * NIN + OFF_BK + 64 * h; gn = p.in[13] + layer * 64; ropemode = 1; dst = qb.KB + ((size_t)(b * 2 + h) * KEYS + key) * 64; }
            else if (j < 16) { const int h = j - 12; src = X + t * NIN + OFF_CQ + 64 * h; gn = p.in[14] + layer * 64; dst = lat ? qb.QC + ((size_t)(b * 4 + h) * SEQ + s) * 64 : qb.QCc + ((size_t)(b * 4 + h) * CTX + s) * 64; }
            else if (j < 20) { const int h = j - 16; src = X + t * NIN + OFF_CK + 64 * h; gn = p.in[15] + layer * 64; dst = qb.KC + ((size_t)(b * 4 + h) * KEYS + key) * 64; }
            else if (j < 24) { const int h = j - 20; src = QM + t * 384 + 96 * h; gn = p.in[21] + layer * 96; n = 96; ropemode = 2; dst = lat ? qb.QD + ((size_t)(b * 4 + h) * SEQ + s) * 96 : qb.QDc + ((size_t)(b * 4 + h) * CTX + s) * 96; }
            else { const int h = j - 24; float* kd = KDN + (t * 4 + h) * 96; const float* kn = KV + t * 512 + 128 * h; const float* kr = X + t * NIN + OFF_DKR;
                for (int i = 0; i < 64; ++i) kd[i] = kn[i];
                for (int i = 0; i < 32; ++i) kd[64 + i] = kr[i];
                src = kd; gn = p.in[22] + layer * 96; n = 96; ropemode = 2; dst = qb.KD + ((size_t)(b * 4 + h) * KEYS + key) * 96; }
            float ss = 0.f; for (int i = 0; i < n; ++i) ss += src[i] * src[i];
            const float r = rsqrtf(ss / n + EPS);
            for (int i = 0; i < n; ++i) src[i] = src[i] * r * gn[i];
            if (lat && ropemode == 1) {
                for (int i = 0; i < 16; ++i) { const float2 cr = rope[RT_R64 + prow * 16 + i], cc = rope[RT_C64 + pcol * 16 + i];
                    const float a = src[i], bq = src[16 + i]; src[i] = a * cr.x - bq * cr.y; src[16 + i] = bq * cr.x + a * cr.y;
                    const float c1 = src[32 + i], c2 = src[48 + i]; src[32 + i] = c1 * cc.x - c2 * cc.y; src[48 + i] = c2 * cc.x + c1 * cc.y; }
            } else if (lat && ropemode == 2) {
                for (int i = 0; i < 8; ++i) { const float2 cr = rope[RT_R32 + prow * 8 + i], cc = rope[RT_C32 + pcol * 8 + i];
                    const float a = src[64 + i], bq = src[72 + i]; src[64 + i] = a * cr.x - bq * cr.y; src[72 + i] = bq * cr.x + a * cr.y;
                    const float c1 = src[80 + i], c2 = src[88 + i]; src[80 + i] = c1 * cc.x - c2 * cc.y; src[88 + i] = c2 * cc.x + c1 * cc.y; }
            }
            store_row_bf16(dst, src, n);
        } else if (tid >= 256 && tid < 256 + 96) {
            const int u = tid - 256, t = u / 12, j = u % 12, m = m0 + t; const bool lat = m < TL;
            const int b = lat ? m / SEQ : (m - TL) / CTX, s = lat ? m % SEQ : (m - TL) % CTX, key = lat ? CTX + s : s;
            const float* src; bf16_t* dst;
            if (j < 2) { src = X + t * NIN + OFF_AV + 64 * j; dst = qb.VA + ((size_t)(b * 2 + j) * KEYS + key) * 64; }
            else if (j < 4) { src = X + t * NIN + OFF_BV + 64 * (j - 2); dst = qb.VB + ((size_t)(b * 2 + j - 2) * KEYS + key) * 64; }
            else if (j < 8) { src = X + t * NIN + OFF_CV + 64 * (j - 4); dst = qb.VC + ((size_t)(b * 4 + j - 4) * KEYS + key) * 64; }
            else { src = KV + t * 512 + 128 * (j - 8) + 64; dst = qb.VD + ((size_t)(b * 4 + j - 8) * KEYS + key) * 64; }
            store_row_bf16(dst, src, 64);
        }
    }
}

template <int DQK> __device__ __forceinline__ void load_q(float (&q)[DQK], const bf16_t* qp) {
#pragma unroll
    for (int c = 0; c < DQK / 8; ++c) { const u32x4 u = *(const u32x4*)(qp + 8 * c); q[8 * c] = bflo(u.x); q[8 * c + 1] = bfhi(u.x); q[8 * c + 2] = bflo(u.y); q[8 * c + 3] = bfhi(u.y); q[8 * c + 4] = bflo(u.z); q[8 * c + 5] = bfhi(u.z); q[8 * c + 6] = bflo(u.w); q[8 * c + 7] = bfhi(u.w); }
}
template <int DQK> __device__ __forceinline__ void attn_step(const float (&q)[DQK], const bf16_t* kr, const bf16_t* vr, float scale, float bias, float& m, float& l, float (&o)[64]) {
    float s = 0.f;
#pragma unroll
    for (int c = 0; c < DQK / 8; ++c) { const u32x4 u = *(const u32x4*)(kr + 8 * c);
        s += q[8 * c] * bflo(u.x) + q[8 * c + 1] * bfhi(u.x) + q[8 * c + 2] * bflo(u.y) + q[8 * c + 3] * bfhi(u.y) + q[8 * c + 4] * bflo(u.z) + q[8 * c + 5] * bfhi(u.z) + q[8 * c + 6] * bflo(u.w) + q[8 * c + 7] * bfhi(u.w); }
    s = s * scale + bias;
    const float mn = fmaxf(m, s), corr = expf(m - mn), pw = expf(s - mn);
    l = l * corr + pw; m = mn;
#pragma unroll
    for (int c = 0; c < 8; ++c) { const u32x4 u = *(const u32x4*)(vr + 8 * c);
        o[8 * c] = o[8 * c] * corr + pw * bflo(u.x); o[8 * c + 1] = o[8 * c + 1] * corr + pw * bfhi(u.x); o[8 * c + 2] = o[8 * c + 2] * corr + pw * bflo(u.y); o[8 * c + 3] = o[8 * c + 3] * corr + pw * bfhi(u.y);
        o[8 * c + 4] = o[8 * c + 4] * corr + pw * bflo(u.z); o[8 * c + 5] = o[8 * c + 5] * corr + pw * bfhi(u.z); o[8 * c + 6] = o[8 * c + 6] * corr + pw * bflo(u.w); o[8 * c + 7] = o[8 * c + 7] * corr + pw * bfhi(u.w); }
}
__device__ __forceinline__ void attn_finish(float (&o)[64], float m, float l, bool has_sink, float sink, bf16_t* dst) {
    float f = 1.f;
    if (has_sink) { const float mn = fmaxf(m, sink); f = expf(m - mn); l = l * f + expf(sink - mn); }
    const float inv = f / l;
#pragma unroll
    for (int c = 0; c < 8; ++c) { u32x4 w; w.x = pk2(o[8 * c] * inv, o[8 * c + 1] * inv); w.y = pk2(o[8 * c + 2] * inv, o[8 * c + 3] * inv); w.z = pk2(o[8 * c + 4] * inv, o[8 * c + 5] * inv); w.w = pk2(o[8 * c + 6] * inv, o[8 * c + 7] * inv); *(u32x4*)(dst + 8 * c) = w; }
}
template <int DQK, int MODE> __global__ void __launch_bounds__(256) k_attn_lat(Params p, const bf16_t* Q, const bf16_t* Kb, const bf16_t* Vb, int layer, int kvdiv, float scale, int ocol0) {
    const int idx = blockIdx.x * 256 + threadIdx.x; const int s = idx % SEQ, h = (idx / SEQ) % 4, b = idx / (4 * SEQ);
    const int nhk = 4 / kvdiv, hk = h / kvdiv;
    const bf16_t* K = Kb + (size_t)(b * nhk + hk) * KEYS * DQK; const bf16_t* V = Vb + (size_t)(b * nhk + hk) * KEYS * 64;
    float q[DQK]; load_q<DQK>(q, Q + ((size_t)(b * 4 + h) * SEQ + s) * DQK);
    float o[64]; float m = -INFINITY, l = 0.f;
#pragma unroll
    for (int i = 0; i < 64; ++i) o[i] = 0.f;
    if (MODE == 0) {
        for (int k = 0; k < KEYS; ++k) attn_step<DQK>(q, K + (size_t)k * DQK, V + (size_t)k * 64, scale, 0.f, m, l, o);
    } else if (MODE == 1) {
        for (int k = 0; k < CTX; ++k) attn_step<DQK>(q, K + (size_t)k * DQK, V + (size_t)k * 64, scale, 0.f, m, l, o);
        const int lo = max(0, s - 128), hi = min(SEQ - 1, s + 128);
        for (int k = CTX + lo; k <= CTX + hi; ++k) attn_step<DQK>(q, K + (size_t)k * DQK, V + (size_t)k * 64, scale, 0.f, m, l, o);
    } else {
        for (int k = 0; k < CTX; ++k) attn_step<DQK>(q, K + (size_t)k * DQK, V + (size_t)k * 64, scale, 0.f, m, l, o);
        const int r = s / 64, j = s % 64, rs = min(max(r - 4, 0), 120), cs = min(max(j - 8, 0), 48);
        const float* rpb = p.in[16] + ((size_t)layer * 4 + h) * 15 * 31;
        for (int i = 0; i < 8; ++i) for (int c = 0; c < 16; ++c) { const int k = CTX + (rs + i) * 64 + cs + c;
            attn_step<DQK>(q, K + (size_t)k * DQK, V + (size_t)k * 64, scale, rpb[(rs + i - r + 7) * 31 + (cs + c - j + 15)], m, l, o); }
    }
    const float sink = (MODE == 1) ? p.in[11][layer * 4 + h] : 0.f;
    attn_finish(o, m, l, MODE == 1, sink, (bf16_t*)(p.ws + WS_P) + (size_t)(b * SEQ + s) * D + ocol0 + h * 64);
}
template <int DQK> __global__ void __launch_bounds__(256) k_attn_ctx(Params p, const bf16_t* Qc, const bf16_t* Kb, const bf16_t* Vb, int layer, int kvdiv, float scale, int ocol0, int use_sink, int pad_) {
    const int idx = blockIdx.x * 256 + threadIdx.x; const int c = idx % CTX, h = (idx / CTX) % 4, b = idx / (4 * CTX);
    const int nhk = 4 / kvdiv, hk = h / kvdiv;
    const bf16_t* K = Kb + (size_t)(b * nhk + hk) * KEYS * DQK; const bf16_t* V = Vb + (size_t)(b * nhk + hk) * KEYS * 64;
    float q[DQK]; load_q<DQK>(q, Qc + ((size_t)(b * 4 + h) * CTX + c) * DQK);
    float o[64]; float m = -INFINITY, l = 0.f;
#pragma unroll
    for (int i = 0; i < 64; ++i) o[i] = 0.f;
    for (int k = 0; k < CTX; ++k) attn_step<DQK>(q, K + (size_t)k * DQK, V + (size_t)k * 64, scale, 0.f, m, l, o);
    const float sink = use_sink ? p.in[11][layer * 4 + h] : 0.f;
    attn_finish(o, m, l, use_sink != 0, sink, (bf16_t*)(p.ws + WS_P) + (size_t)(TL + b * CTX + c) * D + ocol0 + h * 64);
}

__global__ void __launch_bounds__(512) k_gnorm(Params p, int layer, int nrows) {
    const int lane = threadIdx.x & 63, gw = (blockIdx.x * 512 + threadIdx.x) >> 6, ngw = (gridDim.x * 512) >> 6;
    const bf16_t* O = (const bf16_t*)(p.ws + WS_P); bf16_t* Y = (bf16_t*)(p.ws + WS_ACT1); const float* g = p.in[23] + layer * D;
    for (int m = gw; m < nrows; m += ngw) {
#pragma unroll
        for (int grp = 0; grp < 4; ++grp) { const int c = grp * 256 + 4 * lane; const u32x2 w = *(const u32x2*)(O + (size_t)m * D + c);
            const float a0 = bflo(w.x), a1 = bfhi(w.x), a2 = bflo(w.y), a3 = bfhi(w.y);
            const float r = rsqrtf(wave_sum(a0 * a0 + a1 * a1 + a2 * a2 + a3 * a3) * (1.f / 256.f) + EPS);
            const f32x4 gv = *(const f32x4*)(g + c); u32x2 o; o.x = pk2(a0 * r * gv.x, a1 * r * gv.y); o.y = pk2(a2 * r * gv.z, a3 * r * gv.w);
            *(u32x2*)(Y + (size_t)m * D + c) = o; }
    }
}

__device__ __forceinline__ void moe_bases(const unsigned* cnt, int (&base)[9]) {
    int acc = 0;
#pragma unroll
    for (int e = 0; e < 8; ++e) { base[e] = acc; acc += ((int)cnt[e] + 255) / 256 * 256; }
    base[8] = acc;
}
__global__ void __launch_bounds__(512) k_moe_gather(Params p) {
    const int lane = threadIdx.x & 63, gw = (blockIdx.x * 512 + threadIdx.x) >> 6, ngw = (gridDim.x * 512) >> 6;
    const unsigned* cnt = (const unsigned*)(p.ws + WS_CTL); int base[9]; moe_bases(cnt, base);
    if (blockIdx.x == 0 && threadIdx.x < 136) { const int r = threadIdx.x * 256; int e = -1;
#pragma unroll
        for (int i = 0; i < 8; ++i) if (r >= base[i] && r < base[i + 1]) e = i;
        ((int*)(p.ws + WS_TEXP))[threadIdx.x] = e; }
    const bf16_t* F = (const bf16_t*)(p.ws + WS_ACT1); bf16_t* A = (bf16_t*)(p.ws + WS_ASORT);
    for (int m = gw; m < TL; m += ngw) {
        const int2 e = ((const int2*)(p.ws + WS_TOKE))[m]; const int2 ps = ((const int2*)(p.ws + WS_TOKP))[m];
        int b0 = 0, b1 = 0;
#pragma unroll
        for (int i = 0; i < 8; ++i) { if (e.x == i) b0 = base[i]; if (e.y == i) b1 = base[i]; }
        const int s0 = b0 + ps.x, s1 = b1 + ps.y;
        const u32x4 v0 = *(const u32x4*)(F + (size_t)m * D + lane * 16), v1 = *(const u32x4*)(F + (size_t)m * D + lane * 16 + 8);
        *(u32x4*)(A + (size_t)s0 * D + lane * 16) = v0; *(u32x4*)(A + (size_t)s0 * D + lane * 16 + 8) = v1;
        *(u32x4*)(A + (size_t)s1 * D + lane * 16) = v0; *(u32x4*)(A + (size_t)s1 * D + lane * 16 + 8) = v1;
        if (lane == 0) ((int2*)(p.ws + WS_TOKP))[m] = make_int2(s0, s1);
    }
}
__global__ void __launch_bounds__(512) k_moe_combine(Params p, int layer, int pad_) {
    const size_t idx = (size_t)blockIdx.x * 512 + threadIdx.x;
    const int m = (int)(idx >> 8), c = (int)(idx & 255) * 4;
    const int2 sl = ((const int2*)(p.ws + WS_TOKP))[m]; const float2 g = ((const float2*)(p.ws + WS_TOKG))[m];
    const bf16_t* Y = (const bf16_t*)(p.ws + WS_ASORT);
    const u32x2 a = *(const u32x2*)(Y + (size_t)sl.x * D + c), b = *(const u32x2*)(Y + (size_t)sl.y * D + c);
    const f32x4 ya = {bflo(a.x), bfhi(a.x), bflo(a.y), bfhi(a.y)}, yb = {bflo(b.x), bfhi(b.x), bflo(b.y), bfhi(b.y)};
    const float* mod = (const float*)(p.ws + WS_MOD) + (size_t)layer * 3 * 6144 + (m / SEQ) * 6144 + 5 * D;
    f32x4* o = (f32x4*)(p.out + (size_t)m * D + c);
    *o = *o + *(const f32x4*)(mod + c) * (ya * g.x + yb * g.y);
}

template <class Epi> static void launch_gemm(hipStream_t st, const bf16_t* A, const bf16_t* Bt, int K, int M, int N, const int* texp, size_t bstride, Epi epi) {
    const int mt = M / 128, nt = N / 128; int grid = mt * nt; if (grid > 4096) grid = 4096;
    hipLaunchKernelGGL(k_gemm<Epi>, dim3(grid), dim3(512), 0, st, A, Bt, texp, bstride, epi, K, mt, nt, 0);
}

extern "C" void kernel_launch(void* const* d_in, const int* in_sizes, int n_in, void* d_out, int out_size, void* d_ws, size_t ws_size, hipStream_t stream) {
    if (n_in != 32 || ws_size < WS_END) { fprintf(stderr, "kernel_launch: need 32 inputs and %zu bytes of workspace (got %d, %zu)\n", (size_t)WS_END, n_in, ws_size); return; }
    Params p{}; for (int i = 0; i < 32; ++i) p.in[i] = (const float*)d_in[i]; p.out = (float*)d_out; p.ws = (unsigned char*)d_ws;
    unsigned char* ws = p.ws; const QKVB qb = make_qkv(ws);
    static bool attr_done = false;
    constexpr int PP_LDS = (8 * NIN + 8 * 384 + 8 * 512 + 8 * 4 * 96) * 4;
    if (!attr_done) { (void)hipFuncSetAttribute((const void*)k_postproj, hipFuncAttributeMaxDynamicSharedMemorySize, PP_LDS); attr_done = true; }
    (void)hipMemsetAsync(ws + WS_CTL, 0, 4096, stream);
    hipLaunchKernelGGL(k_mods_partial, dim3(192), dim3(512), 0, stream, p);
    hipLaunchKernelGGL(k_mods_final, dim3(72), dim3(512), 0, stream, p);
    hipLaunchKernelGGL(k_rope_tables, dim3(18), dim3(256), 0, stream, p);
    for (int l = 0; l < 2; ++l) {
        hipLaunchKernelGGL(k_convT<SrcPerm>, dim3(576), dim3(512), 0, stream, (bf16_t*)(ws + WS_WIN) + (size_t)l * NINP * D, NINP, D, SrcPerm{p.in[8] + (size_t)l * D * NIN, NIN, NIN});
        hipLaunchKernelGGL(k_convT<SrcPlain>, dim3(256), dim3(512), 0, stream, (bf16_t*)(ws + WS_WOUT) + (size_t)l * D * D, D, D, SrcPlain{p.in[24] + (size_t)l * D * D, D});
        hipLaunchKernelGGL(k_convT<SrcPlain>, dim3(18), dim3(512), 0, stream, (bf16_t*)(ws + WS_WUQ) + (size_t)l * 384 * 192, 384, 192, SrcPlain{p.in[18] + (size_t)l * 192 * 384, 384});
        hipLaunchKernelGGL(k_convT<SrcPlain>, dim3(16), dim3(512), 0, stream, (bf16_t*)(ws + WS_WUKV) + (size_t)l * 512 * 128, 512, 128, SrcPlain{p.in[20] + (size_t)l * 128 * 512, 512});
    }
    hipLaunchKernelGGL(k_convT<SrcGU>, dim3(1408), dim3(512), 0, stream, (bf16_t*)(ws + WS_WFGU), 2 * DFF, D, SrcGU{p.in[25], p.in[26], DFF});
    hipLaunchKernelGGL(k_convT<SrcPlain>, dim3(704), dim3(512), 0, stream, (bf16_t*)(ws + WS_WFDN), D, DFF, SrcPlain{p.in[27], D});
    hipLaunchKernelGGL(k_convT_gu_e, dim3(1792, 8), dim3(512), 0, stream, (bf16_t*)(ws + WS_WMGU), p.in[29], p.in[30]);
    hipLaunchKernelGGL(k_convT_perm_e, dim3(896, 8), dim3(512), 0, stream, (bf16_t*)(ws + WS_WMDN), p.in[31]);

    const float* mod = (const float*)(ws + WS_MOD);
    for (int l = 0; l < 2; ++l) {
        const bool last = (l == 1);
        const float* hl_in = (l == 0) ? p.in[0] : p.out; const float* hc_in = (l == 0) ? p.in[2] : (const float*)(ws + WS_HCTX);
        hipLaunchKernelGGL((k_norm<1, false>), dim3(1056), dim3(512), 0, stream, p, l, MALL);
        launch_gemm(stream, (const bf16_t*)(ws + WS_ACT1), (const bf16_t*)(ws + WS_WIN) + (size_t)l * NINP * D, D, MALL, NINP, nullptr, 0, EpiBf16Perm{(bf16_t*)(ws + WS_P), NINP});
        hipLaunchKernelGGL(k_postproj, dim3(2112), dim3(512), PP_LDS, stream, p, l, 0);
        hipLaunchKernelGGL((k_attn_lat<64, 1>), dim3(256), dim3(256), 0, stream, p, qb.QA, qb.KA, qb.VA, l, 2, 0.125f, 0);
        hipLaunchKernelGGL((k_attn_lat<64, 0>), dim3(256), dim3(256), 0, stream, p, qb.QB, qb.KB, qb.VB, l, 2, 0.125f, 256);
        hipLaunchKernelGGL((k_attn_lat<64, 2>), dim3(256), dim3(256), 0, stream, p, qb.QC, qb.KC, qb.VC, l, 1, 0.125f, 512);
        hipLaunchKernelGGL((k_attn_lat<96, 0>), dim3(256), dim3(256), 0, stream, p, qb.QD, qb.KD, qb.VD, l, 1, 0.10206207261596575f, 768);
        if (!last) {
            hipLaunchKernelGGL((k_attn_ctx<64>), dim3(8), dim3(256), 0, stream, p, qb.QAc, qb.KA, qb.VA, l, 2, 0.125f, 0, 1, 0);
            hipLaunchKernelGGL((k_attn_ctx<64>), dim3(8), dim3(256), 0, stream, p, qb.QBc, qb.KB, qb.VB, l, 2, 0.125f, 256, 0, 0);
            hipLaunchKernelGGL((k_attn_ctx<64>), dim3(8), dim3(256), 0, stream, p, qb.QCc, qb.KC, qb.VC, l, 1, 0.125f, 512, 0, 0);
            hipLaunchKernelGGL((k_attn_ctx<96>), dim3(8), dim3(256), 0, stream, p, qb.QDc, qb.KD, qb.VD, l, 1, 0.10206207261596575f, 768, 0, 0);
        }
        const int nrows = last ? TL : MALL;
        hipLaunchKernelGGL(k_gnorm, dim3(1056), dim3(512), 0, stream, p, l, nrows);
        launch_gemm(stream, (const bf16_t*)(ws + WS_ACT1), (const bf16_t*)(ws + WS_WOUT) + (size_t)l * D * D, D, nrows, D, nullptr, 0,
                    EpiResid{hl_in, hc_in, p.out, (float*)(ws + WS_HCTX), mod + (size_t)l * 3 * 6144, 2 * D});
        if (!last) {
            hipLaunchKernelGGL((k_norm<2, false>), dim3(1056), dim3(512), 0, stream, p, l, MALL);
            launch_gemm(stream, (const bf16_t*)(ws + WS_ACT1), (const bf16_t*)(ws + WS_WFGU), D, MALL, 2 * DFF, nullptr, 0, EpiSwiglu{(bf16_t*)(ws + WS_HIDF), DFF});
            launch_gemm(stream, (const bf16_t*)(ws + WS_HIDF), (const bf16_t*)(ws + WS_WFDN), DFF, MALL, D, nullptr, 0,
                        EpiResid{p.out, (const float*)(ws + WS_HCTX), p.out, (float*)(ws + WS_HCTX), mod + (size_t)l * 3 * 6144, 5 * D});
        } else {
            hipLaunchKernelGGL((k_norm<2, true>), dim3(1024), dim3(512), 0, stream, p, l, TL);
            hipLaunchKernelGGL(k_moe_gather, dim3(1024), dim3(512), 0, stream, p);
            launch_gemm(stream, (const bf16_t*)(ws + WS_ASORT), (const bf16_t*)(ws + WS_WMGU), D, MOE_ROWS, 2 * DFFE, (const int*)(ws + WS_TEXP), (size_t)2 * DFFE * D, EpiSwiglu{(bf16_t*)(ws + WS_HIDM), DFFE});
            launch_gemm(stream, (const bf16_t*)(ws + WS_HIDM), (const bf16_t*)(ws + WS_WMDN), DFFE, MOE_ROWS, D, (const int*)(ws + WS_TEXP), (size_t)D * DFFE, EpiBf16Perm{(bf16_t*)(ws + WS_ASORT), D});
            hipLaunchKernelGGL(k_moe_combine, dim3(TL * 256 / 512), dim3(512), 0, stream, p, l, 0);
        }
    }
}
```

```cpp
#include <hip/hip_runtime.h>
#include <stdint.h>
#include <cstdio>

typedef unsigned short bf16_t;
typedef float f32x4 __attribute__((ext_vector_type(4)));
typedef unsigned u32x4 __attribute__((ext_vector_type(4)));
typedef unsigned u32x2 __attribute__((ext_vector_type(2)));

constexpr int D = 1024, NB = 2, SEQ = 8192, CTX = 256, TL = NB * SEQ, TC = NB * CTX, MALL = TL + TC;
constexpr int NIN = 2144, NINP = 2304, DFF = 2816, NE = 8, DFFE = 3584, KEYS = CTX + SEQ;
constexpr int OFF_AQ = 0, OFF_AK = 256, OFF_AV = 384, OFF_BQ = 512, OFF_BK = 768, OFF_BV = 896, OFF_CQ = 1024, OFF_CK = 1280,
              OFF_CV = 1536, OFF_DCQ = 1792, OFF_DCKV = 1984, OFF_DKR = 2112;
constexpr int MOE_ROWS = 34816;
constexpr float EPS = 1e-6f;

constexpr size_t MiB = 1u << 20;
constexpr size_t WS_CTL = 0;
constexpr size_t WS_MOD = 1 * MiB;
constexpr size_t WS_ROPE = WS_MOD + 256 * 1024;
constexpr size_t WS_TOKE = WS_ROPE + 64 * 1024;
constexpr size_t WS_TOKP = WS_TOKE + TL * 8;
constexpr size_t WS_TOKG = WS_TOKP + TL * 8;
constexpr size_t WS_TEXP = WS_TOKG + TL * 8;
constexpr size_t WS_TOKS = WS_TEXP + 1024;
constexpr size_t WS_HCTX = 2 * MiB;
constexpr size_t WS_WMGU = 6 * MiB;
constexpr size_t WS_WMDN = WS_WMGU + 112 * MiB;
constexpr size_t WS_WDEAD = WS_WMDN + 56 * MiB;
constexpr size_t WS_WIN = WS_WDEAD;
constexpr size_t WS_WOUT = WS_WIN + 9 * MiB;
constexpr size_t WS_WUQ = WS_WOUT + 4 * MiB;
constexpr size_t WS_WUKV = WS_WUQ + 512 * 1024;
constexpr size_t WS_WFGU = WS_WUKV + 512 * 1024;
constexpr size_t WS_WFDN = WS_WFGU + 11 * MiB;
constexpr size_t WS_ACT = 205 * MiB;
static_assert(WS_WFDN + (size_t)1024 * 2816 * 2 <= WS_ACT, "weights fit");
constexpr size_t WS_ACT1 = WS_ACT;
constexpr size_t WS_P = WS_ACT + 33 * MiB;
constexpr size_t WS_QKV = WS_ACT + 108 * MiB;
constexpr size_t WS_HIDF = WS_P;
constexpr size_t WS_HIDM = WS_WDEAD;
constexpr size_t WS_ASORT = WS_HIDM + 238 * MiB;
constexpr size_t WS_END = WS_ASORT + 68 * MiB;
static_assert(WS_QKV + 91 * MiB <= WS_END, "qkv fits");

struct Params { const float* in[32]; float* out; unsigned char* ws; };

struct QKVB { bf16_t *QA, *KA, *VA, *QB, *KB, *VB, *QC, *KC, *VC, *QD, *KD, *VD, *QAc, *QBc, *QCc, *QDc; };
__host__ __device__ inline QKVB make_qkv(unsigned char* ws) {
    QKVB q; bf16_t* p = (bf16_t*)(ws + WS_QKV);
    q.QA = p; p += (size_t)NB * 4 * SEQ * 64; q.KA = p; p += (size_t)NB * 2 * KEYS * 64; q.VA = p; p += (size_t)NB * 2 * KEYS * 64;
    q.QB = p; p += (size_t)NB * 4 * SEQ * 64; q.KB = p; p += (size_t)NB * 2 * KEYS * 64; q.VB = p; p += (size_t)NB * 2 * KEYS * 64;
    q.QC = p; p += (size_t)NB * 4 * SEQ * 64; q.KC = p; p += (size_t)NB * 4 * KEYS * 64; q.VC = p; p += (size_t)NB * 4 * KEYS * 64;
    q.QD = p; p += (size_t)NB * 4 * SEQ * 96; q.KD = p; p += (size_t)NB * 4 * KEYS * 96; q.VD = p; p += (size_t)NB * 4 * KEYS * 64;
    q.QAc = p; p += (size_t)NB * 4 * CTX * 64; q.QBc = p; p += (size_t)NB * 4 * CTX * 64; q.QCc = p; p += (size_t)NB * 4 * CTX * 64;
    q.QDc = p; p += (size_t)NB * 4 * CTX * 96;
    return q;
}

__device__ __forceinline__ float bf2f(unsigned v) { return __uint_as_float(v << 16); }
__device__ __forceinline__ float bflo(unsigned w) { return __uint_as_float(w << 16); }
__device__ __forceinline__ float bfhi(unsigned w) { return __uint_as_float(w & 0xffff0000u); }
__device__ __forceinline__ unsigned f2bf(float f) { unsigned u = __float_as_uint(f); return (u + 0x7fffu + ((u >> 16) & 1u)) >> 16; }
__device__ __forceinline__ unsigned pk2(float lo, float hi) { return f2bf(lo) | (f2bf(hi) << 16); }
__device__ __forceinline__ float wave_sum(float v) {
#pragma unroll
    for (int o = 1; o < 64; o <<= 1) v += __shfl_xor(v, o);
    return v;
}
__device__ __forceinline__ int opq(int v) { asm volatile("" : "+v"(v)); return v; }
template <class T> __device__ __forceinline__ T* opqp(T* p) { asm volatile("" : "+s"(p)); return p; }
__device__ __forceinline__ float silu_f(float x) { return x / (1.f + expf(-x)); }

__device__ __forceinline__ void sincos_d(double a, double& s, double& c) {
    const double k = rint(a * 0.63661977236758134308);
    double r = a - k * 1.57079632679489655800e+00; r -= k * 6.12323399573676603587e-17;
    const double r2 = r * r;
    double sp = 1.0 / 121645100408832000.0;
    sp = sp * r2 - 1.0 / 355687428096000.0; sp = sp * r2 + 1.0 / 1307674368000.0; sp = sp * r2 - 1.0 / 6227020800.0; sp = sp * r2 + 1.0 / 39916800.0;
    sp = sp * r2 - 1.0 / 362880.0; sp = sp * r2 + 1.0 / 5040.0; sp = sp * r2 - 1.0 / 120.0; sp = sp * r2 + 1.0 / 6.0; sp = -sp * r2 + 1.0;
    const double sr = r * sp;
    double cp = 1.0 / 6402373705728000.0;
    cp = cp * r2 - 1.0 / 20922789888000.0; cp = cp * r2 + 1.0 / 87178291200.0; cp = cp * r2 - 1.0 / 479001600.0; cp = cp * r2 + 1.0 / 3628800.0;
    cp = cp * r2 - 1.0 / 40320.0; cp = cp * r2 + 1.0 / 720.0; cp = cp * r2 - 1.0 / 24.0; cp = cp * r2 + 0.5; const double cr = 1.0 - cp * r2;
    const int q = ((int)k) & 3;
    s = (q == 0) ? sr : (q == 1) ? cr : (q == 2) ? -sr : -cr;
    c = (q == 0) ? cr : (q == 1) ? -sr : (q == 2) ? -cr : sr;
}
constexpr int RT_R64 = 0, RT_C64 = 2048, RT_R32 = 3072, RT_C32 = 4096, RT_N = 4608;

namespace pg8 {
#define PG8_LAS __attribute__((address_space(3)))
typedef unsigned short bf16_t;
typedef short bf16x8 __attribute__((ext_vector_type(8)));
typedef float f32x4 __attribute__((ext_vector_type(4)));
typedef unsigned u32x4 __attribute__((ext_vector_type(4)));
constexpr int BM = 256, BK = 64, HALF = 128, HTB = HALF * BK * 2  , STAGE_BYTES = 8 * HTB, NXCD = 8, WGM = 8;

__host__ __device__ __forceinline__ int lds_byte(int r, int c) { const int st = (r >> 4) * 2 + (c >> 5), rr = r & 15, cc = c & 31, ob = rr * 64 + cc * 2; return st * 1024 + (ob ^ (((ob >> 9) & 1) << 5)); }
__host__ __device__ __forceinline__ void stage_rc(int b, int& R, int& C) { const int st = b / 1024, sb = b % 1024, swz = sb ^ (((sb >> 9) & 1) << 5); R = (st >> 1) * 16 + swz / 64; C = (st & 1) * 32 + (swz % 64) / 2; }
__host__ __device__ __forceinline__ int perm32(int rho) { const int n = rho >> 4, i = rho & 15; return 8 * (i >> 2) + 4 * n + (i & 3); }

struct Unit { int pm, pn, e; };
struct Gemm { const bf16_t* A; const bf16_t* Bt; int K; size_t estride; };

struct StaticOrder {
    int nM, nN, nwg, G, c; const int* texp;
    __host__ __device__ void init(int nM_, int nN_, int G_, int c_, const int* texp_) { nM = nM_; nN = nN_; nwg = nM * nN; G = G_; c = c_; texp = texp_; }
    __host__ __device__ bool next(int i, Unit& u) const {
        const long L = (long)i * G + c; if (L >= nwg) return false;
        int wgid = (int)L; { const int q = nwg / NXCD, r = nwg % NXCD, xcd = wgid % NXCD, off = wgid / NXCD; wgid = (xcd < r ? xcd * (q + 1) : r * (q + 1) + (xcd - r) * q) + off; }
        const int nig = WGM * nN, gid = wgid / nig, fm = gid * WGM, gsz = (nM - fm) < WGM ? (nM - fm) : WGM;
        u.pm = fm + ((wgid % nig) % gsz); u.pn = (wgid % nig) / gsz; u.e = texp ? texp[u.pm] : 0; return true;
    }
    __device__ __forceinline__ void a_ready(const Unit&) const {}
    __device__ __forceinline__ void done(const Unit&) const {}
};

template <class Epi, class Sched, bool ALIGN_EPI = false, bool SP2 = false>
__device__ __forceinline__ void gemm_phase(PG8_LAS unsigned char* lds, const Gemm g, const Sched& S, const Epi& E) {
    const int tid = opq((int)threadIdx.x), wid = __builtin_amdgcn_readfirstlane(tid >> 6), lane = tid & 63, wr = wid >> 2, wc = wid & 3, fr = lane & 15, fq = lane >> 4;
    const int K = g.K, nt = K / BK;
    unsigned voffA[2], voffB[2];
#pragma unroll
    for (int i = 0; i < 2; ++i) { int R, C; stage_rc(tid * 16 + i * 8192, R, C); const int Rb = Epi::PERM ? ((R & ~31) + perm32(R & 31)) : R;
        voffA[i] = (unsigned)(R * K + C) * 2u; voffB[i] = (unsigned)(Rb * K + C) * 2u; }
    const size_t kstep = (size_t)(BK * 2);
    const size_t hstep = (size_t)HALF * K * 2;
    const size_t tstep = 2 * hstep;
    const unsigned ldsw = (unsigned)wid * 1024u;
    const int aoff = lds_byte(wr * 64 + fr, fq * 8), boff = lds_byte(wc * 32 + fr, fq * 8);
#define PG8_SA(b, h) (((b) * 2 + (h)) * HTB)
#define PG8_SB(b, h) ((4 + (b) * 2 + (h)) * HTB)
#define PG8_STAGE(bufoff, gbase, voff) do { _Pragma("unroll") for (int _i = 0; _i < 2; ++_i) \
        __builtin_amdgcn_global_load_lds((const unsigned*)((const char*)(gbase) + (voff)[_i]), (PG8_LAS unsigned*)(lds + (bufoff) + ldsw + _i * 8192), 16, 0, 0); } while (0)
#define PG8_LDA(dst, b, h) do { _Pragma("unroll") for (int m = 0; m < 4; ++m) _Pragma("unroll") for (int k = 0; k < 2; ++k) dst[m][k] = *(const PG8_LAS bf16x8*)(lds + PG8_SA(b, h) + aoff + m * 2048 + k * 1024); } while (0)
#define PG8_LDB(dst, b, h) do { _Pragma("unroll") for (int n = 0; n < 2; ++n) _Pragma("unroll") for (int k = 0; k < 2; ++k) dst[n][k] = *(const PG8_LAS bf16x8*)(lds + PG8_SB(b, h) + boff + n * 2048 + k * 1024); } while (0)
#define PG8_MMA(ai, bj, At, Bt) do { __builtin_amdgcn_s_setprio(1); _Pragma("unroll") for (int m = 0; m < 4; ++m) _Pragma("unroll") for (int n = 0; n < 2; ++n) _Pragma("unroll") for (int k = 0; k < 2; ++k) \
        acc[ai][bj][m][n] = __builtin_amdgcn_mfma_f32_16x16x32_bf16(Bt[n][k], At[m][k], acc[ai][bj][m][n], 0, 0, 0); __builtin_amdgcn_s_setprio(0); } while (0)
#define PG8_WAIT_V(n) asm volatile("s_waitcnt vmcnt(" #n ")" ::: "memory")
#define PG8_WAIT_L(n) asm volatile("s_waitcnt lgkmcnt(" #n ")" ::: "memory")
#define PG8_BAR __builtin_amdgcn_s_barrier()
#define PG8_SCHED __builtin_amdgcn_sched_barrier(0)
    Unit cur, nxt; int ui = 0;
    if (!S.next(0, cur)) return;
    f32x4 acc[2][2][4][2];
#pragma unroll
    for (int a = 0; a < 2; ++a)
#pragma unroll
        for (int b = 0; b < 2; ++b)
#pragma unroll
            for (int m = 0; m < 4; ++m)
#pragma unroll
                for (int n = 0; n < 2; ++n) acc[a][b][m][n] = (f32x4){0.f, 0.f, 0.f, 0.f};
    bf16x8 At[4][2], B0[2][2], B1[2][2];
    const char* cA = (const char*)g.A + (size_t)cur.pm * tstep; const char* cB = (const char*)g.Bt + (size_t)cur.e * g.estride + (size_t)cur.pn * tstep;
    S.a_ready(cur);
    if constexpr (SP2) {
        PG8_STAGE(PG8_SB(0, 0), cB, voffB); PG8_STAGE(PG8_SB(0, 1), cB + hstep, voffB); PG8_STAGE(PG8_SA(0, 0), cA, voffA); PG8_STAGE(PG8_SA(0, 1), cA + hstep, voffA);
        if (wr == 1) PG8_BAR;
        PG8_WAIT_V(2); PG8_BAR;
        PG8_STAGE(PG8_SB(1, 0), cB + kstep, voffB); PG8_STAGE(PG8_SA(1, 0), cA + kstep, voffA); PG8_STAGE(PG8_SB(1, 1), cB + hstep + kstep, voffB);
        PG8_WAIT_V(6); PG8_BAR;
    } else {
        PG8_STAGE(PG8_SB(0, 0), cB, voffB); PG8_STAGE(PG8_SA(0, 0), cA, voffA); PG8_STAGE(PG8_SB(0, 1), cB + hstep, voffB); PG8_STAGE(PG8_SA(0, 1), cA + hstep, voffA);
        if (wr == 1) PG8_BAR;
        PG8_WAIT_V(4); PG8_BAR;
        PG8_STAGE(PG8_SB(1, 0), cB + kstep, voffB); PG8_STAGE(PG8_SA(1, 0), cA + kstep, voffA); PG8_STAGE(PG8_SB(1, 1), cB + hstep + kstep, voffB);
        PG8_WAIT_V(6); PG8_BAR;
    }
    for (;;) {
        const bool has_next = S.next(ui + 1, nxt);
        const char* nA = has_next ? (const char*)g.A + (size_t)nxt.pm * tstep : cA; const char* nB = has_next ? (const char*)g.Bt + (size_t)nxt.e * g.estride + (size_t)nxt.pn * tstep : cB;
        for (int t = 0; t < nt; t += 2) {
            const bool last = (t == nt - 2);
            const char* a1 = cA + (size_t)(t + 1) * kstep;
            const char* a2 = last ? nA : cA + (size_t)(t + 2) * kstep; const char* b2 = last ? nB : cB + (size_t)(t + 2) * kstep;
            const char* a3 = a2 + kstep; const char* b3 = b2 + kstep;
            if (last && has_next) S.a_ready(nxt);
            if constexpr (SP2) {
            PG8_LDB(B0, 0, 0); PG8_LDB(B1, 0, 1); PG8_SCHED; PG8_LDA(At, 0, 0); PG8_STAGE(PG8_SA(1, 1), a1 + hstep, voffA);
            PG8_WAIT_V(8); PG8_WAIT_L(0); PG8_BAR; PG8_MMA(0, 0, At, B0); PG8_MMA(0, 1, At, B1); PG8_BAR; PG8_SCHED;
            PG8_LDA(At, 0, 1); PG8_STAGE(PG8_SB(0, 0), b2, voffB); PG8_STAGE(PG8_SB(0, 1), b2 + hstep, voffB); PG8_STAGE(PG8_SA(0, 0), a2, voffA);
            PG8_WAIT_V(8); PG8_WAIT_L(0); PG8_BAR; PG8_MMA(1, 0, At, B0); PG8_MMA(1, 1, At, B1); PG8_BAR; PG8_SCHED;
            PG8_LDB(B0, 1, 0); PG8_LDB(B1, 1, 1); PG8_SCHED; PG8_LDA(At, 1, 0); PG8_STAGE(PG8_SA(0, 1), a2 + hstep, voffA);
            PG8_WAIT_V(8); PG8_WAIT_L(0); PG8_BAR; PG8_MMA(0, 0, At, B0); PG8_MMA(0, 1, At, B1); PG8_BAR; PG8_SCHED;
            PG8_LDA(At, 1, 1); PG8_STAGE(PG8_SB(1, 0), b3, voffB); PG8_STAGE(PG8_SB(1, 1), b3 + hstep, voffB); PG8_STAGE(PG8_SA(1, 0), a3, voffA);
            PG8_WAIT_V(8); PG8_WAIT_L(0); PG8_BAR; PG8_MMA(1, 0, At, B0); PG8_MMA(1, 1, At, B1); PG8_BAR; PG8_SCHED;
            } else {
            PG8_LDB(B0, 0, 0); PG8_SCHED; PG8_LDA(At, 0, 0); PG8_STAGE(PG8_SA(1, 1), a1 + hstep, voffA);
            PG8_WAIT_L(8); PG8_BAR; PG8_WAIT_L(0); PG8_MMA(0, 0, At, B0); PG8_BAR; PG8_SCHED;
            PG8_LDB(B1, 0, 1); PG8_STAGE(PG8_SB(0, 0), b2, voffB);
            PG8_BAR; PG8_WAIT_L(0); PG8_MMA(0, 1, At, B1); PG8_BAR;
            PG8_LDA(At, 0, 1); PG8_STAGE(PG8_SA(0, 0), a2, voffA);
            PG8_BAR; PG8_WAIT_L(0); PG8_MMA(1, 0, At, B0); PG8_BAR; PG8_SCHED;
            PG8_STAGE(PG8_SB(0, 1), b2 + hstep, voffB);
            PG8_WAIT_V(6); PG8_BAR; PG8_MMA(1, 1, At, B1); PG8_BAR;
            PG8_LDB(B0, 1, 0); PG8_SCHED; PG8_LDA(At, 1, 0); PG8_STAGE(PG8_SA(0, 1), a2 + hstep, voffA);
            PG8_WAIT_L(8); PG8_BAR; PG8_WAIT_L(0); PG8_MMA(0, 0, At, B0); PG8_BAR; PG8_SCHED;
            PG8_LDB(B1, 1, 1); PG8_STAGE(PG8_SB(1, 0), b3, voffB);
            PG8_BAR; PG8_WAIT_L(0); PG8_MMA(0, 1, At, B1); PG8_BAR;
            PG8_LDA(At, 1, 1); PG8_STAGE(PG8_SA(1, 0), a3, voffA);
            PG8_BAR; PG8_WAIT_L(0); PG8_MMA(1, 0, At, B0); PG8_BAR; PG8_SCHED;
            PG8_STAGE(PG8_SB(1, 1), b3 + hstep, voffB);
            PG8_WAIT_V(6); PG8_BAR; PG8_MMA(1, 1, At, B1); PG8_BAR;
            }
        }
        if constexpr (ALIGN_EPI) { if (wr == 0) PG8_BAR; }
        if constexpr (!Epi::AFTER_DRAIN) { E(acc, cur, wr, wc, fr, fq); S.done(cur); }
        if (!has_next) break;
#pragma unroll
        for (int a = 0; a < 2; ++a)
#pragma unroll
            for (int b = 0; b < 2; ++b)
#pragma unroll
                for (int m = 0; m < 4; ++m)
#pragma unroll
                    for (int n = 0; n < 2; ++n) acc[a][b][m][n] = (f32x4){0.f, 0.f, 0.f, 0.f};
        cur = nxt; cA = nA; cB = nB; ++ui;
        if constexpr (ALIGN_EPI) { if (wr == 1) PG8_BAR; }
    }
    PG8_WAIT_V(0);
    if constexpr (!ALIGN_EPI) { if (wr == 0) PG8_BAR; }
    PG8_BAR;
    if constexpr (Epi::AFTER_DRAIN) { E.fused(acc, cur, wr, wc, fr, fq, lds, wid, lane); S.done(cur); }
#undef PG8_SA
#undef PG8_SB
#undef PG8_STAGE
#undef PG8_LDA
#undef PG8_LDB
#undef PG8_MMA
#undef PG8_WAIT_V
#undef PG8_WAIT_L
#undef PG8_BAR
#undef PG8_SCHED
}
}

#define GAS __attribute__((address_space(1)))
#define LAS __attribute__((address_space(3)))
typedef GAS unsigned gu32;
#define RLX_AGENT __ATOMIC_RELAXED, __HIP_MEMORY_SCOPE_AGENT
constexpr int NWAVES = 8;
constexpr int CW_BAR = 4096;
constexpr int RING_BYTES = 131072, LDSCTL_OFF = RING_BYTES, MISC_OFF = LDSCTL_OFF + 320, LDS_BYTES = 147456;
constexpr size_t CTL_ZERO_BYTES = 65536;

#define XB_TMO      128
#define XB_XCNT(j)  (256  + 64 * (j))
#define XB_XSUB(j)  (1280 + 64 * (j))
#define XB_XGEN(j)  (2304 + 64 * (j))
#define XB_TOP      3328
#define XB_TOPGEN   3392
#define XCD_BAR_WORDS 3456
#define XB_SPIN_CAP (1u << 18)

__device__ __forceinline__ unsigned xb_ld(unsigned* p)              { return __hip_atomic_load(p, __ATOMIC_RELAXED, __HIP_MEMORY_SCOPE_AGENT); }
__device__ __forceinline__ unsigned xb_add(unsigned* p, unsigned v) { return __hip_atomic_fetch_add(p, v, __ATOMIC_RELAXED, __HIP_MEMORY_SCOPE_AGENT); }
__device__ __forceinline__ unsigned xb_xcc_id() { return (unsigned)__builtin_amdgcn_s_getreg((3 << 11) | 20) & 0xFu; }
#define XB_SPIN(cond, bar) do { unsigned _sp = 0; while (cond) { __builtin_amdgcn_s_sleep(1); \
    if ((++_sp & 255u) == 0u) { if (xb_ld(&(bar)[XB_TMO])) break; if (_sp > XB_SPIN_CAP) { atomicAdd(&(bar)[XB_TMO], 1u); break; } } } } while (0)

struct XcdBarrier {
    unsigned* bar; unsigned x;
    volatile LAS unsigned* st;
};

__device__ __forceinline__ XcdBarrier xcd_barrier_post(unsigned* bar, volatile LAS unsigned* st) {
    XcdBarrier b; b.bar = bar; b.x = xb_xcc_id(); b.st = st;
    if (threadIdx.x == 0) (void)xb_add(&bar[XB_XCNT(b.x)], 1u);
    return b;
}
__device__ __forceinline__ void xcd_barrier_complete(unsigned* bar, unsigned x, unsigned& nloc, unsigned& nx) {
    const unsigned G = gridDim.x * gridDim.y * gridDim.z;
    unsigned sum, cnt, mine, sp = 0u;
    for (;;) {
        sum = 0u; cnt = 0u; mine = 0u;
#pragma unroll
        for (unsigned j = 0; j < 16; ++j) { const unsigned c = xb_ld(&bar[XB_XCNT(j)]); sum += c; cnt += (c > 0u) ? 1u : 0u; mine = (j == x) ? c : mine; }
        if (sum == G) break;
        __builtin_amdgcn_s_sleep(1);
        if ((++sp & 255u) == 0u) { if (xb_ld(&bar[XB_TMO])) break; if (sp > XB_SPIN_CAP) { atomicAdd(&bar[XB_TMO], 1u); break; } }
    }
    nloc = mine > 0u ? mine : 1u; nx = cnt > 0u ? cnt : 1u;
}

__device__ __forceinline__ void xcd_barrier(const XcdBarrier& b) {
    asm volatile("s_waitcnt vmcnt(0)" ::: "memory");
    __syncthreads();
    if (threadIdx.x == 0) {
        unsigned* bar = b.bar;
        __builtin_amdgcn_s_waitcnt(0);
        unsigned nloc = b.st[0], nx = b.st[1];
        if (nloc == 0u) { xcd_barrier_complete(bar, b.x, nloc, nx); b.st[0] = nloc; b.st[1] = nx; }
        const unsigned old = xb_add(&bar[XB_XSUB(b.x)], 1u);
        const unsigned gen = old / nloc;
        if (old + 1u == (gen + 1u) * nloc) {
            __builtin_amdgcn_fence(__ATOMIC_RELEASE, "agent");
            asm volatile("s_waitcnt vmcnt(0)" ::: "memory");
            const unsigned og = xb_add(&bar[XB_TOP], 1u);
            const unsigned tg = og / nx;
            if (og + 1u == (tg + 1u) * nx) xb_add(&bar[XB_TOPGEN], 1u);
            else XB_SPIN(xb_ld(&bar[XB_TOPGEN]) == tg, bar);
            __builtin_amdgcn_fence(__ATOMIC_ACQUIRE, "agent");
            xb_add(&bar[XB_XGEN(b.x)], 1u);
            asm volatile("s_waitcnt vmcnt(0)" ::: "memory");
        } else {
            XB_SPIN(xb_ld(&bar[XB_XGEN(b.x)]) == gen, bar);
            __builtin_amdgcn_fence(__ATOMIC_ACQUIRE, "agent");
            asm volatile("s_waitcnt vmcnt(0)" ::: "memory");
        }
    }
    __syncthreads();
}


template <class F> struct EpiAdapt {
    static constexpr bool PERM = false, AFTER_DRAIN = false; F f;
    __device__ __forceinline__ void operator()(const pg8::f32x4 (&acc)[2][2][4][2], const pg8::Unit& u, int wr, int wc, int fr, int fq) const {
#pragma unroll
        for (int ai = 0; ai < 2; ++ai)
#pragma unroll
            for (int m = 0; m < 4; ++m) { const int row = u.pm * 256 + ai * 128 + wr * 64 + m * 16 + fr;
#pragma unroll
                for (int bj = 0; bj < 2; ++bj) f(row, u.pn * 8 + bj * 4 + wc, fq, acc[ai][bj][m][0], acc[ai][bj][m][1]);
                asm volatile("" ::: "memory"); }
    }
};
struct EpiBf16Perm { bf16_t* O; int ldo; int pad;
    __device__ __forceinline__ void operator()(int row, int g, int fq, f32x4 v0, f32x4 v1) const {
        u32x4 w; w.x = pk2(v0.x, v0.y); w.y = pk2(v0.z, v0.w); w.z = pk2(v1.x, v1.y); w.w = pk2(v1.z, v1.w);
        *(u32x4*)(O + (size_t)row * ldo + 32 * g + 8 * fq) = w; } };
struct EpiResid { const float* hl_in; const float* hc_in; float* hl_out; float* hc_out; const float* mod; int goff; int pad;
    __device__ __forceinline__ void operator()(int row, int g, int fq, f32x4 v0, f32x4 v1) const {
        const int c0 = 32 * g + 4 * fq; const float* hin; float* hout; const float* gv;
        if (row < TL) { hin = hl_in + (size_t)row * D; hout = hl_out + (size_t)row * D; gv = mod + (row / SEQ) * 6144 + goff; }
        else { hin = hc_in + (size_t)(row - TL) * D; hout = hc_out + (size_t)(row - TL) * D; gv = mod + 2 * 6144 + goff; }
        *(f32x4*)(hout + c0) = *(const f32x4*)(hin + c0) + *(const f32x4*)(gv + c0) * v0;
        *(f32x4*)(hout + c0 + 16) = *(const f32x4*)(hin + c0 + 16) + *(const f32x4*)(gv + c0 + 16) * v1; } };
struct EpiSwiglu { bf16_t* H; int ldh; int pad;
    __device__ __forceinline__ void operator()(int row, int g, int fq, f32x4 v0, f32x4 v1) const {
        u32x2 w; w.x = pk2(silu_f(v0.x) * v1.x, silu_f(v0.y) * v1.y); w.y = pk2(silu_f(v0.z) * v1.z, silu_f(v0.w) * v1.w);
        *(u32x2*)(H + (size_t)row * ldh + 16 * g + 4 * fq) = w; } };

template <class F> __device__ __forceinline__ void run_gemm(LAS unsigned char* lds, const bf16_t* A, const bf16_t* Bt, int K, int nM, int nN, const int* texp, size_t estride_bytes, const F& f) {
    pg8::Gemm g{A, Bt, K, estride_bytes}; pg8::StaticOrder S; S.init(nM, nN, (int)gridDim.x, (int)blockIdx.x, texp);
    EpiAdapt<F> E{f};
    pg8::gemm_phase<EpiAdapt<F>, pg8::StaticOrder, true, true>(lds, g, S, E);
}

__device__ __forceinline__ float conv_src(const Params& p, int mode, const float* W0, const float* W1, int N, int nvalid, int k, int nb) {
    if (mode == 0) return W0[(size_t)k * N + nb];
    if (mode == 1) { const int col = (nb & ~31) + 8 * ((nb >> 2) & 3) + 4 * ((nb >> 4) & 1) + (nb & 3); return col < nvalid ? W0[(size_t)k * N + col] : 0.f; }
    const int col = 16 * (nb >> 5) + (nb & 15); return ((nb >> 4) & 1) ? W1[(size_t)k * N + col] : W0[(size_t)k * N + col];
}
constexpr int CT_WIN = 0, CT_WOUT = 1152, CT_WUQ = 1664, CT_WUKV = 1700, CT_WFGU = 1732, CT_WFDN = 3140, CT_WMGU = 3844, CT_WMDN = 18180, CT_END = 25348;
constexpr int IT_MODS = 192, IT_ROPE = 9, IT_TOTAL = IT_MODS + IT_ROPE + CT_END;
__device__ __forceinline__ void ph_prologue(const Params& p, float* lds) {
    const int tid = opq((int)threadIdx.x);
    for (int it = blockIdx.x; it < IT_TOTAL; it += gridDim.x) {
        if (it < IT_MODS) {
            const int l = it / 96, n0 = (it % 96) * 64, nn = tid & 63, kc = tid >> 6;
            float* sv = lds; float* red = lds + 3 * 1024;
            __syncthreads();
            for (int i = tid; i < 3 * 1024; i += 512) { const int v = i >> 10, k = i & 1023; const float x = (v < 2) ? p.in[1][v * D + k] : p.in[3][k]; sv[i] = silu_f(x); }
            __syncthreads();
            const float* w = p.in[4] + ((size_t)l * D + kc * 128) * 6144 + n0 + nn;
            float a0 = 0.f, a1 = 0.f, a2 = 0.f;
#pragma unroll 8
            for (int k = 0; k < 128; ++k) { const float wv = w[(size_t)k * 6144]; a0 += sv[kc * 128 + k] * wv; a1 += sv[1024 + kc * 128 + k] * wv; a2 += sv[2048 + kc * 128 + k] * wv; }
            red[(kc * 3 + 0) * 64 + nn] = a0; red[(kc * 3 + 1) * 64 + nn] = a1; red[(kc * 3 + 2) * 64 + nn] = a2;
            __syncthreads();
            if (tid < 192) { const int v = tid >> 6; float s = p.in[5][l * 6144 + n0 + nn];
#pragma unroll
                for (int q = 0; q < 8; ++q) s += red[(q * 3 + v) * 64 + nn];
                ((float*)(p.ws + WS_MOD))[((size_t)l * 3 + v) * 6144 + n0 + nn] = s; }
        } else if (it < IT_MODS + IT_ROPE) {
            const int idx = (it - IT_MODS) * 512 + tid;
            if (idx < RT_N) {
                int pos, i, nf;
                if (idx < RT_C64) { pos = idx / 16; i = idx % 16; nf = 16; }
                else if (idx < RT_R32) { pos = (idx - RT_C64) / 16; i = idx % 16; nf = 16; }
                else if (idx < RT_C32) { pos = (idx - RT_R32) / 8; i = idx % 8; nf = 8; }
                else { pos = (idx - RT_C32) / 8; i = idx % 8; nf = 8; }
                const float inv = powf(10000.0f, -(float)i / (float)nf);
                const float ang = (float)pos * inv;
                double s, c; sincos_d((double)ang, s, c);
                ((float2*)(p.ws + WS_ROPE))[idx] = make_float2((float)c, (float)s);
            }
        } else {
            int t = it - IT_MODS - IT_ROPE;
            bf16_t* dst; const float* W0; const float* W1 = nullptr; int K, N, nvalid = 0, mode, ktl;
            if (t < CT_WOUT) { const int l = t / 576; t %= 576; dst = (bf16_t*)(p.ws + WS_WIN) + (size_t)l * NINP * D; W0 = p.in[8] + (size_t)l * D * NIN; K = D; N = NIN; nvalid = NIN; mode = 1; }
            else if (t < CT_WUQ) { t -= CT_WOUT; const int l = t / 256; t %= 256; dst = (bf16_t*)(p.ws + WS_WOUT) + (size_t)l * D * D; W0 = p.in[24] + (size_t)l * D * D; K = D; N = D; mode = 0; }
            else if (t < CT_WUKV) { t -= CT_WUQ; const int l = t / 18; t %= 18; dst = (bf16_t*)(p.ws + WS_WUQ) + (size_t)l * 384 * 192; W0 = p.in[18] + (size_t)l * 192 * 384; K = 192; N = 384; mode = 0; }
            else if (t < CT_WFGU) { t -= CT_WUKV; const int l = t / 16; t %= 16; dst = (bf16_t*)(p.ws + WS_WUKV) + (size_t)l * 512 * 128; W0 = p.in[20] + (size_t)l * 128 * 512; K = 128; N = 512; mode = 0; }
            else if (t < CT_WFDN) { t -= CT_WFGU; dst = (bf16_t*)(p.ws + WS_WFGU); W0 = p.in[25]; W1 = p.in[26]; K = D; N = DFF; mode = 2; }
            else if (t < CT_WMGU) { t -= CT_WFDN; dst = (bf16_t*)(p.ws + WS_WFDN); W0 = p.in[27]; K = DFF; N = D; mode = 0; }
            else if (t < CT_WMDN) { t -= CT_WMGU; const int e = t / 1792; t %= 1792; dst = (bf16_t*)(p.ws + WS_WMGU) + (size_t)e * 2 * DFFE * D; W0 = p.in[29] + (size_t)e * D * DFFE; W1 = p.in[30] + (size_t)e * D * DFFE; K = D; N = DFFE; mode = 2; }
            else { t -= CT_WMDN; const int e = t / 896; t %= 896; dst = (bf16_t*)(p.ws + WS_WMDN) + (size_t)e * D * DFFE; W0 = p.in[31] + (size_t)e * DFFE * D; K = DFFE; N = D; nvalid = D; mode = 1; }
            ktl = K / 64; const int n0 = (t / ktl) * 64, k0 = (t % ktl) * 64;
            __syncthreads();
#pragma unroll
            for (int r = 0; r < 8; ++r) { const int i = (tid >> 6) + 8 * r, j = tid & 63; lds[i * 65 + j] = conv_src(p, mode, W0, W1, N, nvalid, k0 + i, n0 + j); }
            __syncthreads();
            const int n = tid >> 3, kc = (tid & 7) * 8;
            u32x4 o; o.x = pk2(lds[(kc + 0) * 65 + n], lds[(kc + 1) * 65 + n]); o.y = pk2(lds[(kc + 2) * 65 + n], lds[(kc + 3) * 65 + n]);
            o.z = pk2(lds[(kc + 4) * 65 + n], lds[(kc + 5) * 65 + n]); o.w = pk2(lds[(kc + 6) * 65 + n], lds[(kc + 7) * 65 + n]);
            *(u32x4*)(dst + (size_t)(n0 + n) * K + k0 + kc) = o;
        }
    }
    __syncthreads();
}

template <int WHICH, bool ROUTER> __device__ __forceinline__ void ph_norm(const Params& p, int layer, int nrows) {
    const int tx = opq((int)threadIdx.x), lane = tx & 63, gw = (blockIdx.x * 512 + tx) >> 6, ngw = (gridDim.x * 512) >> 6;
    const float* hl = (layer == 0 && WHICH == 1) ? p.in[0] : p.out;
    const float* hc = (layer == 0 && WHICH == 1) ? p.in[2] : (const float*)(p.ws + WS_HCTX);
    const float* gain = p.in[WHICH == 1 ? 6 : 7] + layer * D;
    const float* mod = (const float*)(p.ws + WS_MOD) + (size_t)layer * 3 * 6144;
    bf16_t* dst = (bf16_t*)(p.ws + WS_ACT1);
    for (int m = gw; m < nrows; m += ngw) {
        const float* src = (m < TL) ? hl + (size_t)m * D : hc + (size_t)(m - TL) * D;
        const float* mv = mod + (m < TL ? m / SEQ : 2) * 6144;
        const float* shp = mv + (WHICH == 1 ? 0 : 3) * D; const float* scp = mv + (WHICH == 1 ? 1 : 4) * D;
        f32x4 v[4]; float ss = 0.f;
#pragma unroll
        for (int j = 0; j < 4; ++j) { v[j] = *(const f32x4*)(src + 256 * j + 4 * lane); ss += v[j].x * v[j].x + v[j].y * v[j].y + v[j].z * v[j].z + v[j].w * v[j].w; }
        const float rstd = rsqrtf(wave_sum(ss) * (1.f / D) + EPS);
        float lg[8];
#pragma unroll
        for (int e = 0; e < 8; ++e) lg[e] = 0.f;
#pragma unroll
        for (int j = 0; j < 4; ++j) {
            const int c = 256 * j + 4 * lane;
            const f32x4 g = *(const f32x4*)(gain + c), sh = *(const f32x4*)(shp + c), sc = *(const f32x4*)(scp + c);
            f32x4 f = v[j] * rstd * g * (sc + 1.f) + sh;
            u32x2 w; w.x = pk2(f.x, f.y); w.y = pk2(f.z, f.w);
            *(u32x2*)(dst + (size_t)m * D + c) = w;
            if (ROUTER) {
                const float* rt = p.in[28] + (size_t)c * 8;
#pragma unroll
                for (int i = 0; i < 4; ++i) { const f32x4 r0 = *(const f32x4*)(rt + 8 * i), r1 = *(const f32x4*)(rt + 8 * i + 4); const float fv = f[i];
                    lg[0] += fv * r0.x; lg[1] += fv * r0.y; lg[2] += fv * r0.z; lg[3] += fv * r0.w; lg[4] += fv * r1.x; lg[5] += fv * r1.y; lg[6] += fv * r1.z; lg[7] += fv * r1.w; }
            }
        }
        if (ROUTER) {
#pragma unroll
            for (int e = 0; e < 8; ++e) lg[e] = wave_sum(lg[e]);
            if (lane == 0) {
                int e0 = 0; float v0 = lg[0];
#pragma unroll
                for (int e = 1; e < 8; ++e) if (lg[e] > v0) { v0 = lg[e]; e0 = e; }
                int e1 = -1; float v1 = -INFINITY;
#pragma unroll
                for (int e = 0; e < 8; ++e) if (e != e0 && lg[e] > v1) { v1 = lg[e]; e1 = e; }
                const float t = expf(v1 - v0), g0 = 1.f / (1.f + t), g1 = t / (1.f + t);
                unsigned* cnt = (unsigned*)(p.ws + WS_CTL);
                const int p0 = (int)atomicAdd(cnt + e0, 1u), p1 = (int)atomicAdd(cnt + e1, 1u);
                ((int2*)(p.ws + WS_TOKE))[m] = make_int2(e0, e1); ((int2*)(p.ws + WS_TOKP))[m] = make_int2(p0, p1); ((float2*)(p.ws + WS_TOKG))[m] = make_float2(g0, g1);
            }
        }
    }
}

__device__ __forceinline__ void store_row_bf16(bf16_t* dst, const float* src, int n) {
    for (int c = 0; c < n; c += 8) { u32x4 w; w.x = pk2(src[c], src[c + 1]); w.y = pk2(src[c + 2], src[c + 3]); w.z = pk2(src[c + 4], src[c + 5]); w.w = pk2(src[c + 6], src[c + 7]); *(u32x4*)(dst + c) = w; }
}
__device__ __forceinline__ void ph_postproj(const Params& p, int layer, float* smem) {
    float* X = smem;
    float* QM = X + 8 * NIN;
    float* KV = QM + 8 * 384;
    float* KDN = KV + 8 * 512;
    const int tid = opq((int)threadIdx.x);
    const bf16_t* P = (const bf16_t*)(p.ws + WS_P);
    const QKVB qb = make_qkv(p.ws);
    const bf16_t* Wuq = (const bf16_t*)(p.ws + WS_WUQ) + (size_t)layer * 384 * 192;
    const bf16_t* Wukv = (const bf16_t*)(p.ws + WS_WUKV) + (size_t)layer * 512 * 128;
    const float2* rope = (const float2*)(p.ws + WS_ROPE);
    for (int tile = blockIdx.x; tile < MALL / 8; tile += gridDim.x) {
        const int m0 = tile * 8;
        __syncthreads();
        for (int i = tid; i < 8 * NIN / 8; i += 512) { const int t = i / (NIN / 8), c = (i % (NIN / 8)) * 8;
            const u32x4 v = *(const u32x4*)(P + (size_t)(m0 + t) * NINP + c); float* x = X + t * NIN + c;
            x[0] = bflo(v.x); x[1] = bfhi(v.x); x[2] = bflo(v.y); x[3] = bfhi(v.y); x[4] = bflo(v.z); x[5] = bfhi(v.z); x[6] = bflo(v.w); x[7] = bfhi(v.w); }
        __syncthreads();
        if (tid < 16) { const int t = tid >> 1, which = tid & 1; float* x = X + t * NIN + (which ? OFF_DCKV : OFF_DCQ); const int n = which ? 128 : 192;
            const float* g = which ? p.in[19] + layer * 128 : p.in[17] + layer * 192; float ss = 0.f;
            for (int i = 0; i < n; ++i) ss += x[i] * x[i];
            const float r = rsqrtf(ss / n + EPS); for (int i = 0; i < n; ++i) x[i] = x[i] * r * g[i]; }
        __syncthreads();
        if (tid < 384) { float acc[8];
#pragma unroll
            for (int t = 0; t < 8; ++t) acc[t] = 0.f;
            const bf16_t* w = Wuq + (size_t)tid * 192;
            for (int k = 0; k < 192; k += 8) { const u32x4 wv = *(const u32x4*)(w + k); const float w0 = bflo(wv.x), w1 = bfhi(wv.x), w2 = bflo(wv.y), w3 = bfhi(wv.y), w4 = bflo(wv.z), w5 = bfhi(wv.z), w6 = bflo(wv.w), w7 = bfhi(wv.w);
#pragma unroll
                for (int t = 0; t < 8; ++t) { const float* x = X + t * NIN + OFF_DCQ + k; acc[t] += x[0] * w0 + x[1] * w1 + x[2] * w2 + x[3] * w3 + x[4] * w4 + x[5] * w5 + x[6] * w6 + x[7] * w7; } }
#pragma unroll
            for (int t = 0; t < 8; ++t) QM[t * 384 + tid] = acc[t]; }
        { float acc[8];
#pragma unroll
            for (int t = 0; t < 8; ++t) acc[t] = 0.f;
            const bf16_t* w = Wukv + (size_t)tid * 128;
            for (int k = 0; k < 128; k += 8) { const u32x4 wv = *(const u32x4*)(w + k); const float w0 = bflo(wv.x), w1 = bfhi(wv.x), w2 = bflo(wv.y), w3 = bfhi(wv.y), w4 = bflo(wv.z), w5 = bfhi(wv.z), w6 = bflo(wv.w), w7 = bfhi(wv.w);
#pragma unroll
                for (int t = 0; t < 8; ++t) { const float* x = X + t * NIN + OFF_DCKV + k; acc[t] += x[0] * w0 + x[1] * w1 + x[2] * w2 + x[3] * w3 + x[4] * w4 + x[5] * w5 + x[6] * w6 + x[7] * w7; } }
#pragma unroll
            for (int t = 0; t < 8; ++t) KV[t * 512 + tid] = acc[t]; }
        __syncthreads();
        if (tid < 224) {
            const int t = tid / 28, j = tid % 28, m = m0 + t; const bool lat = m < TL;
            const int b = lat ? m / SEQ : (m - TL) / CTX, s = lat ? m % SEQ : (m - TL) % CTX, key = lat ? CTX + s : s;
            const int prow = s / 64, pcol = s % 64;
            float* src; const float* gn; int n = 64; bf16_t* dst; int ropemode = 0;
            if (j < 4)       { src = X + t * NIN + OFF_AQ + 64 * j; gn = p.in[9] + layer * 64; ropemode = 1; dst = lat ? qb.QA + ((size_t)(b * 4 + j) * SEQ + s) * 64 : qb.QAc + ((size_t)(b * 4 + j) * CTX + s) * 64; }
            else if (j < 6)  { const int h = j - 4; src = X + t * NIN + OFF_AK + 64 * h; gn = p.in[10] + layer * 64; ropemode = 1; dst = qb.KA + ((size_t)(b * 2 + h) * KEYS + key) * 64; }
            else if (j < 10) { const int h = j - 6; src = X + t * NIN + OFF_BQ + 64 * h; gn = p.in[12] + layer * 64; ropemode = 1; dst = lat ? qb.QB + ((size_t)(b * 4 + h) * SEQ + s) * 64 : qb.QBc + ((size_t)(b * 4 + h) * CTX + s) * 64; }
            else if (j < 12) { const int h = j - 10; src = X + t * NIN + OFF_BK + 64 * h; gn = p.in[13] + layer * 64; ropemode = 1; dst = qb.KB + ((size_t)(b * 2 + h) * KEYS + key) * 64; }
            else if (j < 16) { const int h = j - 12; src = X + t * NIN + OFF_CQ + 64 * h; gn = p.in[14] + layer * 64; dst = lat ? qb.QC + ((size_t)(b * 4 + h) * SEQ + s) * 64 : qb.QCc + ((size_t)(b * 4 + h) * CTX + s) * 64; }
            else if (j < 20) { const int h = j - 16; src = X + t * NIN + OFF_CK + 64 * h; gn = p.in[15] + layer * 64; dst = qb.KC + ((size_t)(b * 4 + h) * KEYS + key) * 64; }
            else if (j < 24) { const int h = j - 20; src = QM + t * 384 + 96 * h; gn = p.in[21] + layer * 96; n = 96; ropemode = 2; dst = lat ? qb.QD + ((size_t)(b * 4 + h) * SEQ + s) * 96 : qb.QDc + ((size_t)(b * 4 + h) * CTX + s) * 96; }
            else { const int h = j - 24; float* kd = KDN + (t * 4 + h) * 96; const float* kn = KV + t * 512 + 128 * h; const float* kr = X + t * NIN + OFF_DKR;
                for (int i = 0; i < 64; ++i) kd[i] = kn[i];
                for (int i = 0; i < 32; ++i) kd[64 + i] = kr[i];
                src = kd; gn = p.in[22] + layer * 96; n = 96; ropemode = 2; dst = qb.KD + ((size_t)(b * 4 + h) * KEYS + key) * 96; }
            float ss = 0.f; for (int i = 0; i < n; ++i) ss += src[i] * src[i];
            const float r = rsqrtf(ss / n + EPS);
            for (int i = 0; i < n; ++i) src[i] = src[i] * r * gn[i];
            if (lat && ropemode == 1) {
                for (int i = 0; i < 16; ++i) { const float2 cr = rope[RT_R64 + prow * 16 + i], cc = rope[RT_C64 + pcol * 16 + i];
                    const float a = src[i], bq = src[16 + i]; src[i] = a * cr.x - bq * cr.y; src[16 + i] = bq * cr.x + a * cr.y;
                    const float c1 = src[32 + i], c2 = src[48 + i]; src[32 + i] = c1 * cc.x - c2 * cc.y; src[48 + i] = c2 * cc.x + c1 * cc.y; }
            } else if (lat && ropemode == 2) {
                for (int i = 0; i < 8; ++i) { const float2 cr = rope[RT_R32 + prow * 8 + i], cc = rope[RT_C32 + pcol * 8 + i];
                    const float a = src[64 + i], bq = src[72 + i]; src[64 + i] = a * cr.x - bq * cr.y; src[72 + i] = bq * cr.x + a * cr.y;
                    const float c1 = src[80 + i], c2 = src[88 + i]; src[80 + i] = c1 * cc.x - c2 * cc.y; src[88 + i] = c2 * cc.x + c1 * cc.y; }
            }
            store_row_bf16(dst, src, n);
        } else if (tid >= 256 && tid < 256 + 96) {
            const int u = tid - 256, t = u / 12, j = u % 12, m = m0 + t; const bool lat = m < TL;
            const int b = lat ? m / SEQ : (m - TL) / CTX, s = lat ? m % SEQ : (m - TL) % CTX, key = lat ? CTX + s : s;
            const float* src; bf16_t* dst;
            if (j < 2) { src = X + t * NIN + OFF_AV + 64 * j; dst = qb.VA + ((size_t)(b * 2 + j) * KEYS + key) * 64; }
            else if (j < 4) { src = X + t * NIN + OFF_BV + 64 * (j - 2); dst = qb.VB + ((size_t)(b * 2 + j - 2) * KEYS + key) * 64; }
            else if (j < 8) { src = X + t * NIN + OFF_CV + 64 * (j - 4); dst = qb.VC + ((size_t)(b * 4 + j - 4) * KEYS + key) * 64; }
            else { src = KV + t * 512 + 128 * (j - 8) + 64; dst = qb.VD + ((size_t)(b * 4 + j - 8) * KEYS + key) * 64; }
            store_row_bf16(dst, src, 64);
        }
    }
    __syncthreads();
}

template <int DQK> __device__ __forceinline__ void load_q(float (&q)[DQK], const bf16_t* qp) {
#pragma unroll
    for (int c = 0; c < DQK / 8; ++c) { const u32x4 u = *(const u32x4*)(qp + 8 * c); q[8 * c] = bflo(u.x); q[8 * c + 1] = bfhi(u.x); q[8 * c + 2] = bflo(u.y); q[8 * c + 3] = bfhi(u.y); q[8 * c + 4] = bflo(u.z); q[8 * c + 5] = bfhi(u.z); q[8 * c + 6] = bflo(u.w); q[8 * c + 7] = bfhi(u.w); }
}
template <int DQK> __device__ __forceinline__ void attn_step(const float (&q)[DQK], const bf16_t* kr, const bf16_t* vr, float scale, float bias, float& m, float& l, float (&o)[64]) {
    float s = 0.f;
#pragma unroll
    for (int c = 0; c < DQK / 8; ++c) { const u32x4 u = *(const u32x4*)(kr + 8 * c);
        s += q[8 * c] * bflo(u.x) + q[8 * c + 1] * bfhi(u.x) + q[8 * c + 2] * bflo(u.y) + q[8 * c + 3] * bfhi(u.y) + q[8 * c + 4] * bflo(u.z) + q[8 * c + 5] * bfhi(u.z) + q[8 * c + 6] * bflo(u.w) + q[8 * c + 7] * bfhi(u.w); }
    s = s * scale + bias;
    const float mn = fmaxf(m, s), corr = expf(m - mn), pw = expf(s - mn);
    l = l * corr + pw; m = mn;
#pragma unroll
    for (int c = 0; c < 8; ++c) { const u32x4 u = *(const u32x4*)(vr + 8 * c);
        o[8 * c] = o[8 * c] * corr + pw * bflo(u.x); o[8 * c + 1] = o[8 * c + 1] * corr + pw * bfhi(u.x); o[8 * c + 2] = o[8 * c + 2] * corr + pw * bflo(u.y); o[8 * c + 3] = o[8 * c + 3] * corr + pw * bfhi(u.y);
        o[8 * c + 4] = o[8 * c + 4] * corr + pw * bflo(u.z); o[8 * c + 5] = o[8 * c + 5] * corr + pw * bfhi(u.z); o[8 * c + 6] = o[8 * c + 6] * corr + pw * bflo(u.w); o[8 * c + 7] = o[8 * c + 7] * corr + pw * bfhi(u.w); }
}
__device__ __forceinline__ void attn_finish(float (&o)[64], float m, float l, bool has_sink, float sink, bf16_t* dst) {
    float f = 1.f;
    if (has_sink) { const float mn = fmaxf(m, sink); f = expf(m - mn); l = l * f + expf(sink - mn); }
    const float inv = f / l;
#pragma unroll
    for (int c = 0; c < 8; ++c) { u32x4 w; w.x = pk2(o[8 * c] * inv, o[8 * c + 1] * inv); w.y = pk2(o[8 * c + 2] * inv, o[8 * c + 3] * inv); w.z = pk2(o[8 * c + 4] * inv, o[8 * c + 5] * inv); w.w = pk2(o[8 * c + 6] * inv, o[8 * c + 7] * inv); *(u32x4*)(dst + 8 * c) = w; }
}

template <int DQK, int MODE> __device__ __forceinline__ void attn_lat_thread(const Params& p, int layer, int idx, const bf16_t* Q, const bf16_t* Kb, const bf16_t* Vb, int kvdiv, float scale, int ocol0) {
    const int s = idx % SEQ, h = (idx / SEQ) % 4, b = idx / (4 * SEQ);
    const int nhk = 4 / kvdiv, hk = h / kvdiv;
    const bf16_t* K = Kb + (size_t)(b * nhk + hk) * KEYS * DQK; const bf16_t* V = Vb + (size_t)(b * nhk + hk) * KEYS * 64;
    float q[DQK]; load_q<DQK>(q, Q + ((size_t)(b * 4 + h) * SEQ + s) * DQK);
    float o[64]; float m = -INFINITY, l = 0.f;
#pragma unroll
    for (int i = 0; i < 64; ++i) o[i] = 0.f;
    if (MODE == 0) {
        for (int k = 0; k < KEYS; ++k) attn_step<DQK>(q, K + (size_t)k * DQK, V + (size_t)k * 64, scale, 0.f, m, l, o);
    } else if (MODE == 1) {
        for (int k = 0; k < CTX; ++k) attn_step<DQK>(q, K + (size_t)k * DQK, V + (size_t)k * 64, scale, 0.f, m, l, o);
        const int lo = max(0, s - 128), hi = min(SEQ - 1, s + 128);
        for (int k = CTX + lo; k <= CTX + hi; ++k) attn_step<DQK>(q, K + (size_t)k * DQK, V + (size_t)k * 64, scale, 0.f, m, l, o);
    } else {
        for (int k = 0; k < CTX; ++k) attn_step<DQK>(q, K + (size_t)k * DQK, V + (size_t)k * 64, scale, 0.f, m, l, o);
        const int r = s / 64, j = s % 64, rs = min(max(r - 4, 0), 120), cs = min(max(j - 8, 0), 48);
        const float* rpb = p.in[16] + ((size_t)layer * 4 + h) * 15 * 31;
        for (int i = 0; i < 8; ++i) for (int c = 0; c < 16; ++c) { const int k = CTX + (rs + i) * 64 + cs + c;
            attn_step<DQK>(q, K + (size_t)k * DQK, V + (size_t)k * 64, scale, rpb[(rs + i - r + 7) * 31 + (cs + c - j + 15)], m, l, o); }
    }
    const float sink = (MODE == 1) ? p.in[11][layer * 4 + h] : 0.f;
    attn_finish(o, m, l, MODE == 1, sink, (bf16_t*)(p.ws + WS_P) + (size_t)(b * SEQ + s) * D + ocol0 + h * 64);
}
template <int DQK> __device__ __forceinline__ void attn_ctx_thread(const Params& p, int layer, int idx, const bf16_t* Qc, const bf16_t* Kb, const bf16_t* Vb, int kvdiv, float scale, int ocol0, bool use_sink) {
    const int c = idx % CTX, h = (idx / CTX) % 4, b = idx / (4 * CTX);
    const int nhk = 4 / kvdiv, hk = h / kvdiv;
    const bf16_t* K = Kb + (size_t)(b * nhk + hk) * KEYS * DQK; const bf16_t* V = Vb + (size_t)(b * nhk + hk) * KEYS * 64;
    float q[DQK]; load_q<DQK>(q, Qc + ((size_t)(b * 4 + h) * CTX + c) * DQK);
    float o[64]; float m = -INFINITY, l = 0.f;
#pragma unroll
    for (int i = 0; i < 64; ++i) o[i] = 0.f;
    for (int k = 0; k < CTX; ++k) attn_step<DQK>(q, K + (size_t)k * DQK, V + (size_t)k * 64, scale, 0.f, m, l, o);
    const float sink = use_sink ? p.in[11][layer * 4 + h] : 0.f;
    attn_finish(o, m, l, use_sink, sink, (bf16_t*)(p.ws + WS_P) + (size_t)(TL + b * CTX + c) * D + ocol0 + h * 64);
}
constexpr float SCALE_MLA = 0.10206207261596575f;
__device__ __forceinline__ void ph_attn_oracle(const Params& p, int layer, bool with_ctx) {
    const QKVB qb = make_qkv(p.ws);
    const int nitems = 512 + (with_ctx ? 16 : 0);
    for (int it = blockIdx.x; it < nitems; it += gridDim.x) {
        const int tid = opq((int)threadIdx.x);
        if (it < 128) attn_lat_thread<96, 0>(p, layer, it * 512 + tid, qb.QD, qb.KD, qb.VD, 1, SCALE_MLA, 768);
        else if (it < 256) attn_lat_thread<64, 0>(p, layer, (it - 128) * 512 + tid, qb.QB, qb.KB, qb.VB, 2, 0.125f, 256);
        else if (it < 384) attn_lat_thread<64, 1>(p, layer, (it - 256) * 512 + tid, qb.QA, qb.KA, qb.VA, 2, 0.125f, 0);
        else if (it < 512) attn_lat_thread<64, 2>(p, layer, (it - 384) * 512 + tid, qb.QC, qb.KC, qb.VC, 1, 0.125f, 512);
        else { const int j = it - 512, ty = j >> 2, idx = (j & 3) * 512 + tid;
            if (ty == 0) attn_ctx_thread<64>(p, layer, idx, qb.QAc, qb.KA, qb.VA, 2, 0.125f, 0, true);
            else if (ty == 1) attn_ctx_thread<64>(p, layer, idx, qb.QBc, qb.KB, qb.VB, 2, 0.125f, 256, false);
            else if (ty == 2) attn_ctx_thread<64>(p, layer, idx, qb.QCc, qb.KC, qb.VC, 1, 0.125f, 512, false);
            else attn_ctx_thread<96>(p, layer, idx, qb.QDc, qb.KD, qb.VD, 1, SCALE_MLA, 768, false); }
    }
}

__device__ __forceinline__ void ph_gnorm(const Params& p, int layer, int nrows) {
    const int tx = opq((int)threadIdx.x), lane = tx & 63, gw = (blockIdx.x * 512 + tx) >> 6, ngw = (gridDim.x * 512) >> 6;
    const bf16_t* O = (const bf16_t*)(p.ws + WS_P); bf16_t* Y = (bf16_t*)(p.ws + WS_ACT1); const float* g = p.in[23] + layer * D;
    for (int m = gw; m < nrows; m += ngw) {
#pragma unroll
        for (int grp = 0; grp < 4; ++grp) { const int c = grp * 256 + 4 * lane; const u32x2 w = *(const u32x2*)(O + (size_t)m * D + c);
            const float a0 = bflo(w.x), a1 = bfhi(w.x), a2 = bflo(w.y), a3 = bfhi(w.y);
            const float r = rsqrtf(wave_sum(a0 * a0 + a1 * a1 + a2 * a2 + a3 * a3) * (1.f / 256.f) + EPS);
            const f32x4 gv = *(const f32x4*)(g + c); u32x2 o; o.x = pk2(a0 * r * gv.x, a1 * r * gv.y); o.y = pk2(a2 * r * gv.z, a3 * r * gv.w);
            *(u32x2*)(Y + (size_t)m * D + c) = o; }
    }
}

__device__ __forceinline__ void moe_bases(const unsigned* cnt, int (&base)[9]) {
    int acc = 0;
#pragma unroll
    for (int e = 0; e < 8; ++e) { base[e] = acc; acc += ((int)cnt[e] + 255) / 256 * 256; }
    base[8] = acc;
}
__device__ __forceinline__ void ph_moe_gather(const Params& p) {
    const int tx = opq((int)threadIdx.x), lane = tx & 63, gw = (blockIdx.x * 512 + tx) >> 6, ngw = (gridDim.x * 512) >> 6;
    const unsigned* cnt = (const unsigned*)(p.ws + WS_CTL); int base[9]; moe_bases(cnt, base);
    if (blockIdx.x == 0 && tx < 136) { const int r = tx * 256; int e = -1;
#pragma unroll
        for (int i = 0; i < 8; ++i) if (r >= base[i] && r < base[i + 1]) e = i;
        ((int*)(p.ws + WS_TEXP))[tx] = e < 0 ? 0 : e; }
    const bf16_t* F = (const bf16_t*)(p.ws + WS_ACT1); bf16_t* A = (bf16_t*)(p.ws + WS_ASORT);
    for (int m = gw; m < TL; m += ngw) {
        const int2 e = ((const int2*)(p.ws + WS_TOKE))[m]; const int2 ps = ((const int2*)(p.ws + WS_TOKP))[m];
        int b0 = 0, b1 = 0;
#pragma unroll
        for (int i = 0; i < 8; ++i) { if (e.x == i) b0 = base[i]; if (e.y == i) b1 = base[i]; }
        const int s0 = b0 + ps.x, s1 = b1 + ps.y;
        const u32x4 v0 = *(const u32x4*)(F + (size_t)m * D + lane * 16), v1 = *(const u32x4*)(F + (size_t)m * D + lane * 16 + 8);
        *(u32x4*)(A + (size_t)s0 * D + lane * 16) = v0; *(u32x4*)(A + (size_t)s0 * D + lane * 16 + 8) = v1;
        *(u32x4*)(A + (size_t)s1 * D + lane * 16) = v0; *(u32x4*)(A + (size_t)s1 * D + lane * 16 + 8) = v1;
        if (lane == 0) ((int2*)(p.ws + WS_TOKS))[m] = make_int2(s0, s1);
    }
}
__device__ __forceinline__ void ph_moe_combine(const Params& p, int layer) {
    const size_t nthr = (size_t)gridDim.x * 512;
    for (size_t idx = (size_t)blockIdx.x * 512 + opq((int)threadIdx.x); idx < (size_t)TL * 256; idx += nthr) {
        const int m = (int)(idx >> 8), c = (int)(idx & 255) * 4;
        const int2 sl = ((const int2*)(p.ws + WS_TOKS))[m]; const float2 g = ((const float2*)(p.ws + WS_TOKG))[m];
        const bf16_t* Y = (const bf16_t*)(p.ws + WS_ASORT);
        const u32x2 a = *(const u32x2*)(Y + (size_t)sl.x * D + c), b = *(const u32x2*)(Y + (size_t)sl.y * D + c);
        const f32x4 ya = {bflo(a.x), bfhi(a.x), bflo(a.y), bfhi(a.y)}, yb = {bflo(b.x), bfhi(b.x), bflo(b.y), bfhi(b.y)};
        const float* mod = (const float*)(p.ws + WS_MOD) + (size_t)layer * 3 * 6144 + (m / SEQ) * 6144 + 5 * D;
        f32x4* o = (f32x4*)(p.out + (size_t)m * D + c);
        *o = *o + *(const f32x4*)(mod + c) * (ya * g.x + yb * g.y);
    }
}

struct Args { Params p; int ph_lo, ph_hi; };
__global__ void __launch_bounds__(NWAVES * 64, 2) mega_fwd(Args args) {
    extern __shared__ __attribute__((aligned(16))) unsigned char lds[];
    LAS unsigned char* ldsl = (LAS unsigned char*)lds;
    for (int u = threadIdx.x; u < (LDS_BYTES - LDSCTL_OFF) / 4; u += NWAVES * 64) ((LAS unsigned*)(ldsl + LDSCTL_OFF))[u] = 0u;
    __syncthreads();
    XcdBarrier bar = xcd_barrier_post((unsigned*)(args.p.ws + WS_CTL) + CW_BAR, (volatile LAS unsigned*)(ldsl + MISC_OFF) + 8);
    const int lo = args.ph_lo, hi = args.ph_hi; int ph = 0;
#define PHASE(body) do { if (lo <= ph && ph < hi) { Params q = args.p; q.ws = opqp(args.p.ws); q.out = opqp(args.p.out); LAS unsigned char* ldq = (LAS unsigned char*)lds; (void)ldq; body; if (ph + 1 < hi) xcd_barrier(bar); } ++ph; } while (0)
#define QMOD(l) ((const float*)(q.ws + WS_MOD) + (size_t)(l) * 3 * 6144)
    PHASE(ph_prologue(q, (float*)lds));
#pragma unroll 1
    for (int l = 0; l < 2; ++l) {
        const bool last = (l == 1);
        const int nrows = last ? TL : MALL;
        PHASE((ph_norm<1, false>(q, l, MALL)));
        PHASE(run_gemm(ldq, (const bf16_t*)(q.ws + WS_ACT1), (const bf16_t*)(q.ws + WS_WIN) + (size_t)l * NINP * D, D, MALL / 256, NINP / 256, nullptr, 0, EpiBf16Perm{(bf16_t*)(q.ws + WS_P), NINP, 0}));
        PHASE(ph_postproj(q, l, (float*)lds));
        PHASE(ph_attn_oracle(q, l, !last));
        PHASE(ph_gnorm(q, l, nrows));
        PHASE(run_gemm(ldq, (const bf16_t*)(q.ws + WS_ACT1), (const bf16_t*)(q.ws + WS_WOUT) + (size_t)l * D * D, D, nrows / 256, D / 256, nullptr, 0,
                       EpiResid{(l == 0) ? q.in[0] : q.out, (l == 0) ? q.in[2] : (const float*)(q.ws + WS_HCTX), q.out, (float*)(q.ws + WS_HCTX), QMOD(l), 2 * D, 0}));
        if (!last) {
            PHASE((ph_norm<2, false>(q, l, MALL)));
            PHASE(run_gemm(ldq, (const bf16_t*)(q.ws + WS_ACT1), (const bf16_t*)(q.ws + WS_WFGU), D, MALL / 256, 2 * DFF / 256, nullptr, 0, EpiSwiglu{(bf16_t*)(q.ws + WS_HIDF), DFF, 0}));
            PHASE(run_gemm(ldq, (const bf16_t*)(q.ws + WS_HIDF), (const bf16_t*)(q.ws + WS_WFDN), DFF, MALL / 256, D / 256, nullptr, 0,
                           EpiResid{q.out, (const float*)(q.ws + WS_HCTX), q.out, (float*)(q.ws + WS_HCTX), QMOD(l), 5 * D, 0}));
        } else {
            PHASE((ph_norm<2, true>(q, l, TL)));
            PHASE(ph_moe_gather(q));
            PHASE({ int base[9]; moe_bases((const unsigned*)(q.ws + WS_CTL), base); run_gemm(ldq, (const bf16_t*)(q.ws + WS_ASORT), (const bf16_t*)(q.ws + WS_WMGU), D, base[8] / 256, 2 * DFFE / 256, (const int*)(q.ws + WS_TEXP), (size_t)2 * DFFE * D * 2, EpiSwiglu{(bf16_t*)(q.ws + WS_HIDM), DFFE, 0}); });
            PHASE({ int base[9]; moe_bases((const unsigned*)(q.ws + WS_CTL), base); run_gemm(ldq, (const bf16_t*)(q.ws + WS_HIDM), (const bf16_t*)(q.ws + WS_WMDN), DFFE, base[8] / 256, D / 256, (const int*)(q.ws + WS_TEXP), (size_t)D * DFFE * 2, EpiBf16Perm{(bf16_t*)(q.ws + WS_ASORT), D, 0}); });
            PHASE(ph_moe_combine(q, l));
        }
    }
#undef QMOD
#undef PHASE
}

#ifndef MK_CUTS
#define MK_CUTS 0
#endif
extern "C" void kernel_launch(void* const* d_in, const int* in_sizes, int n_in, void* d_out, int out_size, void* d_ws, size_t ws_size, hipStream_t stream) {
    static int grid = 0;
    if (grid == 0) {
        if (n_in != 32 || ws_size < WS_END) { fprintf(stderr, "kernel_launch: need 32 inputs and %zu bytes of workspace (got %d, %zu)\n", (size_t)WS_END, n_in, ws_size); grid = -1; return; }
        int dev = 0, cus = 0, per_cu = 0;
        if (hipGetDevice(&dev) != hipSuccess || hipDeviceGetAttribute(&cus, hipDeviceAttributeMultiprocessorCount, dev) != hipSuccess) { grid = -1; return; }
        if (hipFuncSetAttribute((const void*)mega_fwd, hipFuncAttributeMaxDynamicSharedMemorySize, LDS_BYTES) != hipSuccess) { fprintf(stderr, "kernel_launch: hipFuncSetAttribute failed\n"); grid = -1; return; }
        if (hipOccupancyMaxActiveBlocksPerMultiprocessor(&per_cu, (const void*)mega_fwd, NWAVES * 64, LDS_BYTES) != hipSuccess || per_cu < 1) fprintf(stderr, "kernel_launch: occupancy query says %d blocks per CU\n", per_cu);
        (void)hipGetLastError();
        grid = cus;
    }
    if (grid < 0) return;
    (void)hipMemsetAsync((char*)d_ws + WS_CTL, 0, CTL_ZERO_BYTES, stream);
    Args a{}; for (int i = 0; i < 32; ++i) a.p.in[i] = (const float*)d_in[i]; a.p.out = (float*)d_out; a.p.ws = (unsigned char*)d_ws;
#if MK_CUTS
    for (int ph = 0; ph < 24; ++ph) { a.ph_lo = ph; a.ph_hi = ph + 1; hipLaunchKernelGGL(mega_fwd, dim3(grid), dim3(NWAVES * 64), LDS_BYTES, stream, a); }
#else
    a.ph_lo = 0; a.ph_hi = 21;
    hipLaunchKernelGGL(mega_fwd, dim3(grid), dim3(NWAVES * 64), LDS_BYTES, stream, a);
#endif
}
```

```cpp
#include <hip/hip_runtime.h>
#include <stdint.h>
#include <cstdio>

typedef unsigned short bf16_t;
typedef float f32x4 __attribute__((ext_vector_type(4)));
typedef unsigned u32x4 __attribute__((ext_vector_type(4)));
typedef unsigned u32x2 __attribute__((ext_vector_type(2)));

constexpr int D = 1024, NB = 2, SEQ = 8192, CTX = 256, TL = NB * SEQ, TC = NB * CTX, MALL = TL + TC;
constexpr int NIN = 2144, NINP = 2304, DFF = 2816, NE = 8, DFFE = 3584, KEYS = CTX + SEQ;
constexpr int OFF_AQ = 0, OFF_AK = 256, OFF_AV = 384, OFF_BQ = 512, OFF_BK = 768, OFF_BV = 896, OFF_CQ = 1024, OFF_CK = 1280,
              OFF_CV = 1536, OFF_DCQ = 1792, OFF_DCKV = 1984, OFF_DKR = 2112;
constexpr int MOE_ROWS = 34816;
constexpr float EPS = 1e-6f;

constexpr size_t MiB = 1u << 20;
constexpr size_t WS_CTL = 0;
constexpr size_t WS_MOD = 1 * MiB;
constexpr size_t WS_ROPE = WS_MOD + 256 * 1024;
constexpr size_t WS_TOKE = WS_ROPE + 64 * 1024;
constexpr size_t WS_TOKP = WS_TOKE + TL * 8;
constexpr size_t WS_TOKG = WS_TOKP + TL * 8;
constexpr size_t WS_TEXP = WS_TOKG + TL * 8;
constexpr size_t WS_TOKS = WS_TEXP + 1024;
constexpr size_t WS_HCTX = 2 * MiB;
constexpr size_t WS_WMGU = 6 * MiB;
constexpr size_t WS_WMDN = WS_WMGU + 112 * MiB;
constexpr size_t WS_WDEAD = WS_WMDN + 56 * MiB;
constexpr size_t WS_WIN = WS_WDEAD;
constexpr size_t WS_WOUT = WS_WIN + 9 * MiB;
constexpr size_t WS_WUQ = WS_WOUT + 4 * MiB;
constexpr size_t WS_WUKV = WS_WUQ + 512 * 1024;
constexpr size_t WS_WFGU = WS_WUKV + 512 * 1024;
constexpr size_t WS_WFDN = WS_WFGU + 11 * MiB;
constexpr size_t WS_ACT = 205 * MiB;
static_assert(WS_WFDN + (size_t)1024 * 2816 * 2 <= WS_ACT, "weights fit");
constexpr size_t WS_ACT1 = WS_ACT;
constexpr size_t WS_P = WS_ACT + 33 * MiB;
constexpr size_t WS_QKV = WS_ACT + 108 * MiB;
constexpr size_t WS_HIDF = WS_P;
constexpr size_t WS_HIDM = WS_WDEAD;
constexpr size_t WS_ASORT = WS_HIDM + 238 * MiB;
constexpr size_t WS_END = WS_ASORT + 68 * MiB;
static_assert(WS_QKV + 91 * MiB <= WS_END, "qkv fits");

struct Params { const float* in[32]; float* out; unsigned char* ws; };

struct QKVB { bf16_t *QA, *KA, *VA, *QB, *KB, *VB, *QC, *KC, *VC, *QD, *KD, *VD, *QAc, *QBc, *QCc, *QDc; };
__host__ __device__ inline QKVB make_qkv(unsigned char* ws) {
    QKVB q; bf16_t* p = (bf16_t*)(ws + WS_QKV);
    q.QA = p; p += (size_t)NB * 4 * SEQ * 64; q.KA = p; p += (size_t)NB * 2 * KEYS * 64; q.VA = p; p += (size_t)NB * 2 * KEYS * 64;
    q.QB = p; p += (size_t)NB * 4 * SEQ * 64; q.KB = p; p += (size_t)NB * 2 * KEYS * 64; q.VB = p; p += (size_t)NB * 2 * KEYS * 64;
    q.QC = p; p += (size_t)NB * 4 * SEQ * 64; q.KC = p; p += (size_t)NB * 4 * KEYS * 64; q.VC = p; p += (size_t)NB * 4 * KEYS * 64;
    q.QD = p; p += (size_t)NB * 4 * SEQ * 96; q.KD = p; p += (size_t)NB * 4 * KEYS * 96; q.VD = p; p += (size_t)NB * 4 * KEYS * 64;
    q.QAc = p; p += (size_t)NB * 4 * CTX * 64; q.QBc = p; p += (size_t)NB * 4 * CTX * 64; q.QCc = p; p += (size_t)NB * 4 * CTX * 64;
    q.QDc = p; p += (size_t)NB * 4 * CTX * 96;
    return q;
}

__device__ __forceinline__ float bf2f(unsigned v) { return __uint_as_float(v << 16); }
__device__ __forceinline__ float bflo(unsigned w) { return __uint_as_float(w << 16); }
__device__ __forceinline__ float bfhi(unsigned w) { return __uint_as_float(w & 0xffff0000u); }
__device__ __forceinline__ unsigned f2bf(float f) { unsigned u = __float_as_uint(f); return (u + 0x7fffu + ((u >> 16) & 1u)) >> 16; }
__device__ __forceinline__ unsigned pk2(float lo, float hi) { return f2bf(lo) | (f2bf(hi) << 16); }
__device__ __forceinline__ float wave_sum(float v) {
#pragma unroll
    for (int o = 1; o < 64; o <<= 1) v += __shfl_xor(v, o);
    return v;
}
__device__ __forceinline__ int opq(int v) { asm volatile("" : "+v"(v)); return v; }
template <class T> __device__ __forceinline__ T* opqp(T* p) { asm volatile("" : "+s"(p)); return p; }
__device__ __forceinline__ float silu_f(float x) { return x / (1.f + expf(-x)); }

__device__ __forceinline__ void sincos_d(double a, double& s, double& c) {
    const double k = rint(a * 0.63661977236758134308);
    double r = a - k * 1.57079632679489655800e+00; r -= k * 6.12323399573676603587e-17;
    const double r2 = r * r;
    double sp = 1.0 / 121645100408832000.0;
    sp = sp * r2 - 1.0 / 355687428096000.0; sp = sp * r2 + 1.0 / 1307674368000.0; sp = sp * r2 - 1.0 / 6227020800.0; sp = sp * r2 + 1.0 / 39916800.0;
    sp = sp * r2 - 1.0 / 362880.0; sp = sp * r2 + 1.0 / 5040.0; sp = sp * r2 - 1.0 / 120.0; sp = sp * r2 + 1.0 / 6.0; sp = -sp * r2 + 1.0;
    const double sr = r * sp;
    double cp = 1.0 / 6402373705728000.0;
    cp = cp * r2 - 1.0 / 20922789888000.0; cp = cp * r2 + 1.0 / 87178291200.0; cp = cp * r2 - 1.0 / 479001600.0; cp = cp * r2 + 1.0 / 3628800.0;
    cp = cp * r2 - 1.0 / 40320.0; cp = cp * r2 + 1.0 / 720.0; cp = cp * r2 - 1.0 / 24.0; cp = cp * r2 + 0.5; const double cr = 1.0 - cp * r2;
    const int q = ((int)k) & 3;
    s = (q == 0) ? sr : (q == 1) ? cr : (q == 2) ? -sr : -cr;
    c = (q == 0) ? cr : (q == 1) ? -sr : (q == 2) ? -cr : sr;
}
constexpr int RT_R64 = 0, RT_C64 = 2048, RT_R32 = 3072, RT_C32 = 4096, RT_N = 4608;

namespace pg8 {
#define PG8_LAS __attribute__((address_space(3)))
typedef unsigned short bf16_t;
typedef short bf16x8 __attribute__((ext_vector_type(8)));
typedef float f32x4 __attribute__((ext_vector_type(4)));
typedef unsigned u32x4 __attribute__((ext_vector_type(4)));
constexpr int BM = 256, BK = 64, HALF = 128, HTB = HALF * BK * 2  , STAGE_BYTES = 8 * HTB, NXCD = 8, WGM = 8;

__host__ __device__ __forceinline__ int lds_byte(int r, int c) { const int st = (r >> 4) * 2 + (c >> 5), rr = r & 15, cc = c & 31, ob = rr * 64 + cc * 2; return st * 1024 + (ob ^ (((ob >> 9) & 1) << 5)); }
__host__ __device__ __forceinline__ void stage_rc(int b, int& R, int& C) { const int st = b / 1024, sb = b % 1024, swz = sb ^ (((sb >> 9) & 1) << 5); R = (st >> 1) * 16 + swz / 64; C = (st & 1) * 32 + (swz % 64) / 2; }
__host__ __device__ __forceinline__ int perm32(int rho) { const int n = rho >> 4, i = rho & 15; return 8 * (i >> 2) + 4 * n + (i & 3); }

struct Unit { int pm, pn, e; };
struct Gemm { const bf16_t* A; const bf16_t* Bt; int K; size_t estride; };

struct StaticOrder {
    int nM, nN, nwg, G, c; const int* texp;
    __host__ __device__ void init(int nM_, int nN_, int G_, int c_, const int* texp_) { nM = nM_; nN = nN_; nwg = nM * nN; G = G_; c = c_; texp = texp_; }
    __host__ __device__ bool next(int i, Unit& u) const {
        const long L = (long)i * G + c; if (L >= nwg) return false;
        int wgid = (int)L; { const int q = nwg / NXCD, r = nwg % NXCD, xcd = wgid % NXCD, off = wgid / NXCD; wgid = (xcd < r ? xcd * (q + 1) : r * (q + 1) + (xcd - r) * q) + off; }
        const int nig = WGM * nN, gid = wgid / nig, fm = gid * WGM, gsz = (nM - fm) < WGM ? (nM - fm) : WGM;
        u.pm = fm + ((wgid % nig) % gsz); u.pn = (wgid % nig) / gsz; u.e = texp ? texp[u.pm] : 0; return true;
    }
    __device__ __forceinline__ void a_ready(const Unit&) const {}
    __device__ __forceinline__ void done(const Unit&) const {}
};

template <class Epi, class Sched, bool ALIGN_EPI = false, bool SP2 = false>
__device__ __forceinline__ void gemm_phase(PG8_LAS unsigned char* lds, const Gemm g, const Sched& S, const Epi& E) {
    const int tid = opq((int)threadIdx.x), wid = __builtin_amdgcn_readfirstlane(tid >> 6), lane = tid & 63, wr = wid >> 2, wc = wid & 3, fr = lane & 15, fq = lane >> 4;
    const int K = g.K, nt = K / BK;
    unsigned voffA[2], voffB[2];
#pragma unroll
    for (int i = 0; i < 2; ++i) { int R, C; stage_rc(tid * 16 + i * 8192, R, C); const int Rb = Epi::PERM ? ((R & ~31) + perm32(R & 31)) : R;
        voffA[i] = (unsigned)(R * K + C) * 2u; voffB[i] = (unsigned)(Rb * K + C) * 2u; }
    const size_t kstep = (size_t)(BK * 2);
    const size_t hstep = (size_t)HALF * K * 2;
    const size_t tstep = 2 * hstep;
    const unsigned ldsw = (unsigned)wid * 1024u;
    const int aoff = lds_byte(wr * 64 + fr, fq * 8), boff = lds_byte(wc * 32 + fr, fq * 8);
#define PG8_SA(b, h) (((b) * 2 + (h)) * HTB)
#define PG8_SB(b, h) ((4 + (b) * 2 + (h)) * HTB)
#define PG8_STAGE(bufoff, gbase, voff) do { _Pragma("unroll") for (int _i = 0; _i < 2; ++_i) \
        __builtin_amdgcn_global_load_lds((const unsigned*)((const char*)(gbase) + (voff)[_i]), (PG8_LAS unsigned*)(lds + (bufoff) + ldsw + _i * 8192), 16, 0, 0); } while (0)
#define PG8_LDA(dst, b, h) do { _Pragma("unroll") for (int m = 0; m < 4; ++m) _Pragma("unroll") for (int k = 0; k < 2; ++k) dst[m][k] = *(const PG8_LAS bf16x8*)(lds + PG8_SA(b, h) + aoff + m * 2048 + k * 1024); } while (0)
#define PG8_LDB(dst, b, h) do { _Pragma("unroll") for (int n = 0; n < 2; ++n) _Pragma("unroll") for (int k = 0; k < 2; ++k) dst[n][k] = *(const PG8_LAS bf16x8*)(lds + PG8_SB(b, h) + boff + n * 2048 + k * 1024); } while (0)
#define PG8_MMA(ai, bj, At, Bt) do { __builtin_amdgcn_s_setprio(1); _Pragma("unroll") for (int m = 0; m < 4; ++m) _Pragma("unroll") for (int n = 0; n < 2; ++n) _Pragma("unroll") for (int k = 0; k < 2; ++k) \
        acc[ai][bj][m][n] = __builtin_amdgcn_mfma_f32_16x16x32_bf16(Bt[n][k], At[m][k], acc[ai][bj][m][n], 0, 0, 0); __builtin_amdgcn_s_setprio(0); } while (0)
#define PG8_WAIT_V(n) asm volatile("s_waitcnt vmcnt(" #n ")" ::: "memory")
#define PG8_WAIT_L(n) asm volatile("s_waitcnt lgkmcnt(" #n ")" ::: "memory")
#define PG8_BAR __builtin_amdgcn_s_barrier()
#define PG8_SCHED __builtin_amdgcn_sched_barrier(0)
    Unit cur, nxt; int ui = 0;
    if (!S.next(0, cur)) return;
    f32x4 acc[2][2][4][2];
#pragma unroll
    for (int a = 0; a < 2; ++a)
#pragma unroll
        for (int b = 0; b < 2; ++b)
#pragma unroll
            for (int m = 0; m < 4; ++m)
#pragma unroll
                for (int n = 0; n < 2; ++n) acc[a][b][m][n] = (f32x4){0.f, 0.f, 0.f, 0.f};
    bf16x8 At[4][2], B0[2][2], B1[2][2];
    const char* cA = (const char*)g.A + (size_t)cur.pm * tstep; const char* cB = (const char*)g.Bt + (size_t)cur.e * g.estride + (size_t)cur.pn * tstep;
    S.a_ready(cur);
    if constexpr (SP2) {
        PG8_STAGE(PG8_SB(0, 0), cB, voffB); PG8_STAGE(PG8_SB(0, 1), cB + hstep, voffB); PG8_STAGE(PG8_SA(0, 0), cA, voffA); PG8_STAGE(PG8_SA(0, 1), cA + hstep, voffA);
        if (wr == 1) PG8_BAR;
        PG8_WAIT_V(2); PG8_BAR;
        PG8_STAGE(PG8_SB(1, 0), cB + kstep, voffB); PG8_STAGE(PG8_SA(1, 0), cA + kstep, voffA); PG8_STAGE(PG8_SB(1, 1), cB + hstep + kstep, voffB);
        PG8_WAIT_V(6); PG8_BAR;
    } else {
        PG8_STAGE(PG8_SB(0, 0), cB, voffB); PG8_STAGE(PG8_SA(0, 0), cA, voffA); PG8_STAGE(PG8_SB(0, 1), cB + hstep, voffB); PG8_STAGE(PG8_SA(0, 1), cA + hstep, voffA);
        if (wr == 1) PG8_BAR;
        PG8_WAIT_V(4); PG8_BAR;
        PG8_STAGE(PG8_SB(1, 0), cB + kstep, voffB); PG8_STAGE(PG8_SA(1, 0), cA + kstep, voffA); PG8_STAGE(PG8_SB(1, 1), cB + hstep + kstep, voffB);
        PG8_WAIT_V(6); PG8_BAR;
    }
    for (;;) {
        const bool has_next = S.next(ui + 1, nxt);
        const char* nA = has_next ? (const char*)g.A + (size_t)nxt.pm * tstep : cA; const char* nB = has_next ? (const char*)g.Bt + (size_t)nxt.e * g.estride + (size_t)nxt.pn * tstep : cB;
        for (int t = 0; t < nt; t += 2) {
            const bool last = (t == nt - 2);
            const char* a1 = cA + (size_t)(t + 1) * kstep;
            const char* a2 = last ? nA : cA + (size_t)(t + 2) * kstep; const char* b2 = last ? nB : cB + (size_t)(t + 2) * kstep;
            const char* a3 = a2 + kstep; const char* b3 = b2 + kstep;
            if (last && has_next) S.a_ready(nxt);
            if constexpr (SP2) {
            PG8_LDB(B0, 0, 0); PG8_LDB(B1, 0, 1); PG8_SCHED; PG8_LDA(At, 0, 0); PG8_STAGE(PG8_SA(1, 1), a1 + hstep, voffA);
            PG8_WAIT_V(8); PG8_WAIT_L(0); PG8_BAR; PG8_MMA(0, 0, At, B0); PG8_MMA(0, 1, At, B1); PG8_BAR; PG8_SCHED;
            PG8_LDA(At, 0, 1); PG8_STAGE(PG8_SB(0, 0), b2, voffB); PG8_STAGE(PG8_SB(0, 1), b2 + hstep, voffB); PG8_STAGE(PG8_SA(0, 0), a2, voffA);
            PG8_WAIT_V(8); PG8_WAIT_L(0); PG8_BAR; PG8_MMA(1, 0, At, B0); PG8_MMA(1, 1, At, B1); PG8_BAR; PG8_SCHED;
            PG8_LDB(B0, 1, 0); PG8_LDB(B1, 1, 1); PG8_SCHED; PG8_LDA(At, 1, 0); PG8_STAGE(PG8_SA(0, 1), a2 + hstep, voffA);
            PG8_WAIT_V(8); PG8_WAIT_L(0); PG8_BAR; PG8_MMA(0, 0, At, B0); PG8_MMA(0, 1, At, B1); PG8_BAR; PG8_SCHED;
            PG8_LDA(At, 1, 1); PG8_STAGE(PG8_SB(1, 0), b3, voffB); PG8_STAGE(PG8_SB(1, 1), b3 + hstep, voffB); PG8_STAGE(PG8_SA(1, 0), a3, voffA);
            PG8_WAIT_V(8); PG8_WAIT_L(0); PG8_BAR; PG8_MMA(1, 0, At, B0); PG8_MMA(1, 1, At, B1); PG8_BAR; PG8_SCHED;
            } else {
            PG8_LDB(B0, 0, 0); PG8_SCHED; PG8_LDA(At, 0, 0); PG8_STAGE(PG8_SA(1, 1), a1 + hstep, voffA);
            PG8_WAIT_L(8); PG8_BAR; PG8_WAIT_L(0); PG8_MMA(0, 0, At, B0); PG8_BAR; PG8_SCHED;
            PG8_LDB(B1, 0, 1); PG8_STAGE(PG8_SB(0, 0), b2, voffB);
            PG8_BAR; PG8_WAIT_L(0); PG8_MMA(0, 1, At, B1); PG8_BAR;
            PG8_LDA(At, 0, 1); PG8_STAGE(PG8_SA(0, 0), a2, voffA);
            PG8_BAR; PG8_WAIT_L(0); PG8_MMA(1, 0, At, B0); PG8_BAR; PG8_SCHED;
            PG8_STAGE(PG8_SB(0, 1), b2 + hstep, voffB);
            PG8_WAIT_V(6); PG8_BAR; PG8_MMA(1, 1, At, B1); PG8_BAR;
            PG8_LDB(B0, 1, 0); PG8_SCHED; PG8_LDA(At, 1, 0); PG8_STAGE(PG8_SA(0, 1), a2 + hstep, voffA);
            PG8_WAIT_L(8); PG8_BAR; PG8_WAIT_L(0); PG8_MMA(0, 0, At, B0); PG8_BAR; PG8_SCHED;
            PG8_LDB(B1, 1, 1); PG8_STAGE(PG8_SB(1, 0), b3, voffB);
            PG8_BAR; PG8_WAIT_L(0); PG8_MMA(0, 1, At, B1); PG8_BAR;
            PG8_LDA(At, 1, 1); PG8_STAGE(PG8_SA(1, 0), a3, voffA);
            PG8_BAR; PG8_WAIT_L(0); PG8_MMA(1, 0, At, B0); PG8_BAR; PG8_SCHED;
            PG8_STAGE(PG8_SB(1, 1), b3 + hstep, voffB);
            PG8_WAIT_V(6); PG8_BAR; PG8_MMA(1, 1, At, B1); PG8_BAR;
            }
        }
        if constexpr (ALIGN_EPI) { if (wr == 0) PG8_BAR; }
        if constexpr (!Epi::AFTER_DRAIN) { E(acc, cur, wr, wc, fr, fq); S.done(cur); }
        if (!has_next) break;
#pragma unroll
        for (int a = 0; a < 2; ++a)
#pragma unroll
            for (int b = 0; b < 2; ++b)
#pragma unroll
                for (int m = 0; m < 4; ++m)
#pragma unroll
                    for (int n = 0; n < 2; ++n) acc[a][b][m][n] = (f32x4){0.f, 0.f, 0.f, 0.f};
        cur = nxt; cA = nA; cB = nB; ++ui;
        if constexpr (ALIGN_EPI) { if (wr == 1) PG8_BAR; }
    }
    PG8_WAIT_V(0);
    if constexpr (!ALIGN_EPI) { if (wr == 0) PG8_BAR; }
    PG8_BAR;
    if constexpr (Epi::AFTER_DRAIN) { E.fused(acc, cur, wr, wc, fr, fq, lds, wid, lane); S.done(cur); }
#undef PG8_SA
#undef PG8_SB
#undef PG8_STAGE
#undef PG8_LDA
#undef PG8_LDB
#undef PG8_MMA
#undef PG8_WAIT_V
#undef PG8_WAIT_L
#undef PG8_BAR
#undef PG8_SCHED
}
}

#define GAS __attribute__((address_space(1)))
#define LAS __attribute__((address_space(3)))
typedef GAS unsigned gu32;
#define RLX_AGENT __ATOMIC_RELAXED, __HIP_MEMORY_SCOPE_AGENT
constexpr int NWAVES = 8;
constexpr int CW_BAR = 4096;
constexpr int RING_BYTES = 131072, LDSCTL_OFF = RING_BYTES, MISC_OFF = LDSCTL_OFF + 320, LDS_BYTES = 147456;
constexpr size_t CTL_ZERO_BYTES = 65536;

#define XB_TMO      128
#define XB_XCNT(j)  (256  + 64 * (j))
#define XB_XSUB(j)  (1280 + 64 * (j))
#define XB_XGEN(j)  (2304 + 64 * (j))
#define XB_TOP      3328
#define XB_TOPGEN   3392
#define XCD_BAR_WORDS 3456
#define XB_SPIN_CAP (1u << 18)

__device__ __forceinline__ unsigned xb_ld(unsigned* p)              { return __hip_atomic_load(p, __ATOMIC_RELAXED, __HIP_MEMORY_SCOPE_AGENT); }
__device__ __forceinline__ unsigned xb_add(unsigned* p, unsigned v) { return __hip_atomic_fetch_add(p, v, __ATOMIC_RELAXED, __HIP_MEMORY_SCOPE_AGENT); }
__device__ __forceinline__ unsigned xb_xcc_id() { return (unsigned)__builtin_amdgcn_s_getreg((3 << 11) | 20) & 0xFu; }
#define XB_SPIN(cond, bar) do { unsigned _sp = 0; while (cond) { __builtin_amdgcn_s_sleep(1); \
    if ((++_sp & 255u) == 0u) { if (xb_ld(&(bar)[XB_TMO])) break; if (_sp > XB_SPIN_CAP) { atomicAdd(&(bar)[XB_TMO], 1u); break; } } } } while (0)

struct XcdBarrier {
    unsigned* bar; unsigned x;
    volatile LAS unsigned* st;
};

__device__ __forceinline__ XcdBarrier xcd_barrier_post(unsigned* bar, volatile LAS unsigned* st) {
    XcdBarrier b; b.bar = bar; b.x = xb_xcc_id(); b.st = st;
    if (threadIdx.x == 0) (void)xb_add(&bar[XB_XCNT(b.x)], 1u);
    return b;
}
__device__ __forceinline__ void xcd_barrier_complete(unsigned* bar, unsigned x, unsigned& nloc, unsigned& nx) {
    const unsigned G = gridDim.x * gridDim.y * gridDim.z;
    unsigned sum, cnt, mine, sp = 0u;
    for (;;) {
        sum = 0u; cnt = 0u; mine = 0u;
#pragma unroll
        for (unsigned j = 0; j < 16; ++j) { const unsigned c = xb_ld(&bar[XB_XCNT(j)]); sum += c; cnt += (c > 0u) ? 1u : 0u; mine = (j == x) ? c : mine; }
        if (sum == G) break;
        __builtin_amdgcn_s_sleep(1);
        if ((++sp & 255u) == 0u) { if (xb_ld(&bar[XB_TMO])) break; if (sp > XB_SPIN_CAP) { atomicAdd(&bar[XB_TMO], 1u); break; } }
    }
    nloc = mine > 0u ? mine : 1u; nx = cnt > 0u ? cnt : 1u;
}

__device__ __forceinline__ void xcd_barrier(const XcdBarrier& b) {
    asm volatile("s_waitcnt vmcnt(0)" ::: "memory");
    __syncthreads();
    if (threadIdx.x == 0) {
        unsigned* bar = b.bar;
        __builtin_amdgcn_s_waitcnt(0);
        unsigned nloc = b.st[0], nx = b.st[1];
        if (nloc == 0u) { xcd_barrier_complete(bar, b.x, nloc, nx); b.st[0] = nloc; b.st[1] = nx; }
        const unsigned old = xb_add(&bar[XB_XSUB(b.x)], 1u);
        const unsigned gen = old / nloc;
        if (old + 1u == (gen + 1u) * nloc) {
            __builtin_amdgcn_fence(__ATOMIC_RELEASE, "agent");
            asm volatile("s_waitcnt vmcnt(0)" ::: "memory");
            const unsigned og = xb_add(&bar[XB_TOP], 1u);
            const unsigned tg = og / nx;
            if (og + 1u == (tg + 1u) * nx) xb_add(&bar[XB_TOPGEN], 1u);
            else XB_SPIN(xb_ld(&bar[XB_TOPGEN]) == tg, bar);
            __builtin_amdgcn_fence(__ATOMIC_ACQUIRE, "agent");
            xb_add(&bar[XB_XGEN(b.x)], 1u);
            asm volatile("s_waitcnt vmcnt(0)" ::: "memory");
        } else {
            XB_SPIN(xb_ld(&bar[XB_XGEN(b.x)]) == gen, bar);
            __builtin_amdgcn_fence(__ATOMIC_ACQUIRE, "agent");
            asm volatile("s_waitcnt vmcnt(0)" ::: "memory");
        }
    }
    __syncthreads();
}


template <class F> struct EpiAdapt {
    static constexpr bool PERM = false, AFTER_DRAIN = false; F f;
    __device__ __forceinline__ void operator()(const pg8::f32x4 (&acc)[2][2][4][2], const pg8::Unit& u, int wr, int wc, int fr, int fq) const {
#pragma unroll
        for (int ai = 0; ai < 2; ++ai)
#pragma unroll
            for (int m = 0; m < 4; ++m) { const int row = u.pm * 256 + ai * 128 + wr * 64 + m * 16 + fr;
#pragma unroll
                for (int bj = 0; bj < 2; ++bj) f(row, u.pn * 8 + bj * 4 + wc, fq, acc[ai][bj][m][0], acc[ai][bj][m][1]);
                asm volatile("" ::: "memory"); }
    }
};
struct EpiBf16Perm { bf16_t* O; int ldo; int pad;
    __device__ __forceinline__ void operator()(int row, int g, int fq, f32x4 v0, f32x4 v1) const {
        u32x4 w; w.x = pk2(v0.x, v0.y); w.y = pk2(v0.z, v0.w); w.z = pk2(v1.x, v1.y); w.w = pk2(v1.z, v1.w);
        *(u32x4*)(O + (size_t)row * ldo + 32 * g + 8 * fq) = w; } };
struct EpiResid { const float* hl_in; const float* hc_in; float* hl_out; float* hc_out; const float* mod; int goff; int pad;
    __device__ __forceinline__ void operator()(int row, int g, int fq, f32x4 v0, f32x4 v1) const {
        const int c0 = 32 * g + 4 * fq; const float* hin; float* hout; const float* gv;
        if (row < TL) { hin = hl_in + (size_t)row * D; hout = hl_out + (size_t)row * D; gv = mod + (row / SEQ) * 6144 + goff; }
        else { hin = hc_in + (size_t)(row - TL) * D; hout = hc_out + (size_t)(row - TL) * D; gv = mod + 2 * 6144 + goff; }
        *(f32x4*)(hout + c0) = *(const f32x4*)(hin + c0) + *(const f32x4*)(gv + c0) * v0;
        *(f32x4*)(hout + c0 + 16) = *(const f32x4*)(hin + c0 + 16) + *(const f32x4*)(gv + c0 + 16) * v1; } };
struct EpiSwiglu { bf16_t* H; int ldh; int pad;
    __device__ __forceinline__ void operator()(int row, int g, int fq, f32x4 v0, f32x4 v1) const {
        u32x2 w; w.x = pk2(silu_f(v0.x) * v1.x, silu_f(v0.y) * v1.y); w.y = pk2(silu_f(v0.z) * v1.z, silu_f(v0.w) * v1.w);
        *(u32x2*)(H + (size_t)row * ldh + 16 * g + 4 * fq) = w; } };

template <class F> __device__ __forceinline__ void run_gemm(LAS unsigned char* lds, const bf16_t* A, const bf16_t* Bt, int K, int nM, int nN, const int* texp, size_t estride_bytes, const F& f) {
    pg8::Gemm g{A, Bt, K, estride_bytes}; pg8::StaticOrder S; S.init(nM, nN, (int)gridDim.x, (int)blockIdx.x, texp);
    EpiAdapt<F> E{f};
    pg8::gemm_phase<EpiAdapt<F>, pg8::StaticOrder, true, true>(lds, g, S, E);
}

__device__ __forceinline__ float conv_src(const Params& p, int mode, const float* W0, const float* W1, int N, int nvalid, int k, int nb) {
    if (mode == 0) return W0[(size_t)k * N + nb];
    if (mode == 1) { const int col = (nb & ~31) + 8 * ((nb >> 2) & 3) + 4 * ((nb >> 4) & 1) + (nb & 3); return col < nvalid ? W0[(size_t)k * N + col] : 0.f; }
    const int col = 16 * (nb >> 5) + (nb & 15); return ((nb >> 4) & 1) ? W1[(size_t)k * N + col] : W0[(size_t)k * N + col];
}
constexpr int CT_WIN = 0, CT_WOUT = 1152, CT_WUQ = 1664, CT_WUKV = 1700, CT_WFGU = 1732, CT_WFDN = 3140, CT_WMGU = 3844, CT_WMDN = 18180, CT_END = 25348;
constexpr int IT_MODS = 192, IT_ROPE = 9, IT_TOTAL = IT_MODS + IT_ROPE + CT_END;
__device__ __forceinline__ void ph_prologue(const Params& p, float* lds) {
    const int tid = opq((int)threadIdx.x);
    for (int it = blockIdx.x; it < IT_TOTAL; it += gridDim.x) {
        if (it < IT_MODS) {
            const int l = it / 96, n0 = (it % 96) * 64, nn = tid & 63, kc = tid >> 6;
            float* sv = lds; float* red = lds + 3 * 1024;
            __syncthreads();
            for (int i = tid; i < 3 * 1024; i += 512) { const int v = i >> 10, k = i & 1023; const float x = (v < 2) ? p.in[1][v * D + k] : p.in[3][k]; sv[i] = silu_f(x); }
            __syncthreads();
            const float* w = p.in[4] + ((size_t)l * D + kc * 128) * 6144 + n0 + nn;
            float a0 = 0.f, a1 = 0.f, a2 = 0.f;
#pragma unroll 8
            for (int k = 0; k < 128; ++k) { const float wv = w[(size_t)k * 6144]; a0 += sv[kc * 128 + k] * wv; a1 += sv[1024 + kc * 128 + k] * wv; a2 += sv[2048 + kc * 128 + k] * wv; }
            red[(kc * 3 + 0) * 64 + nn] = a0; red[(kc * 3 + 1) * 64 + nn] = a1; red[(kc * 3 + 2) * 64 + nn] = a2;
            __syncthreads();
            if (tid < 192) { const int v = tid >> 6; float s = p.in[5][l * 6144 + n0 + nn];
#pragma unroll
                for (int q = 0; q < 8; ++q) s += red[(q * 3 + v) * 64 + nn];
                ((float*)(p.ws + WS_MOD))[((size_t)l * 3 + v) * 6144 + n0 + nn] = s; }
        } else if (it < IT_MODS + IT_ROPE) {
            const int idx = (it - IT_MODS) * 512 + tid;
            if (idx < RT_N) {
                int pos, i, nf;
                if (idx < RT_C64) { pos = idx / 16; i = idx % 16; nf = 16; }
                else if (idx < RT_R32) { pos = (idx - RT_C64) / 16; i = idx % 16; nf = 16; }
                else if (idx < RT_C32) { pos = (idx - RT_R32) / 8; i = idx % 8; nf = 8; }
                else { pos = (idx - RT_C32) / 8; i = idx % 8; nf = 8; }
                const float inv = powf(10000.0f, -(float)i / (float)nf);
                const float ang = (float)pos * inv;
                double s, c; sincos_d((double)ang, s, c);
                ((float2*)(p.ws + WS_ROPE))[idx] = make_float2((float)c, (float)s);
            }
        } else {
            int t = it - IT_MODS - IT_ROPE;
            bf16_t* dst; const float* W0; const float* W1 = nullptr; int K, N, nvalid = 0, mode, ktl;
            if (t < CT_WOUT) { const int l = t / 576; t %= 576; dst = (bf16_t*)(p.ws + WS_WIN) + (size_t)l * NINP * D; W0 = p.in[8] + (size_t)l * D * NIN; K = D; N = NIN; nvalid = NIN; mode = 1; }
            else if (t < CT_WUQ) { t -= CT_WOUT; const int l = t / 256; t %= 256; dst = (bf16_t*)(p.ws + WS_WOUT) + (size_t)l * D * D; W0 = p.in[24] + (size_t)l * D * D; K = D; N = D; mode = 0; }
            else if (t < CT_WUKV) { t -= CT_WUQ; const int l = t / 18; t %= 18; dst = (bf16_t*)(p.ws + WS_WUQ) + (size_t)l * 384 * 192; W0 = p.in[18] + (size_t)l * 192 * 384; K = 192; N = 384; mode = 0; }
            else if (t < CT_WFGU) { t -= CT_WUKV; const int l = t / 16; t %= 16; dst = (bf16_t*)(p.ws + WS_WUKV) + (size_t)l * 512 * 128; W0 = p.in[20] + (size_t)l * 128 * 512; K = 128; N = 512; mode = 0; }
            else if (t < CT_WFDN) { t -= CT_WFGU; dst = (bf16_t*)(p.ws + WS_WFGU); W0 = p.in[25]; W1 = p.in[26]; K = D; N = DFF; mode = 2; }
            else if (t < CT_WMGU) { t -= CT_WFDN; dst = (bf16_t*)(p.ws + WS_WFDN); W0 = p.in[27]; K = DFF; N = D; mode = 0; }
            else if (t < CT_WMDN) { t -= CT_WMGU; const int e = t / 1792; t %= 1792; dst = (bf16_t*)(p.ws + WS_WMGU) + (size_t)e * 2 * DFFE * D; W0 = p.in[29] + (size_t)e * D * DFFE; W1 = p.in[30] + (size_t)e * D * DFFE; K = D; N = DFFE; mode = 2; }
            else { t -= CT_WMDN; const int e = t / 896; t %= 896; dst = (bf16_t*)(p.ws + WS_WMDN) + (size_t)e * D * DFFE; W0 = p.in[31] + (size_t)e * DFFE * D; K = DFFE; N = D; nvalid = D; mode = 1; }
            ktl = K / 64; const int n0 = (t / ktl) * 64, k0 = (t % ktl) * 64;
            __syncthreads();
#pragma unroll
            for (int r = 0; r < 8; ++r) { const int i = (tid >> 6) + 8 * r, j = tid & 63; lds[i * 65 + j] = conv_src(p, mode, W0, W1, N, nvalid, k0 + i, n0 + j); }
            __syncthreads();
            const int n = tid >> 3, kc = (tid & 7) * 8;
            u32x4 o; o.x = pk2(lds[(kc + 0) * 65 + n], lds[(kc + 1) * 65 + n]); o.y = pk2(lds[(kc + 2) * 65 + n], lds[(kc + 3) * 65 + n]);
            o.z = pk2(lds[(kc + 4) * 65 + n], lds[(kc + 5) * 65 + n]); o.w = pk2(lds[(kc + 6) * 65 + n], lds[(kc + 7) * 65 + n]);
            *(u32x4*)(dst + (size_t)(n0 + n) * K + k0 + kc) = o;
        }
    }
    __syncthreads();
}

template <int WHICH, bool ROUTER> __device__ __forceinline__ void ph_norm(const Params& p, int layer, int nrows) {
    const int tx = opq((int)threadIdx.x), lane = tx & 63, gw = (blockIdx.x * 512 + tx) >> 6, ngw = (gridDim.x * 512) >> 6;
    const float* hl = (layer == 0 && WHICH == 1) ? p.in[0] : p.out;
    const float* hc = (layer == 0 && WHICH == 1) ? p.in[2] : (const float*)(p.ws + WS_HCTX);
    const float* gain = p.in[WHICH == 1 ? 6 : 7] + layer * D;
    const float* mod = (const float*)(p.ws + WS_MOD) + (size_t)layer * 3 * 6144;
    bf16_t* dst = (bf16_t*)(p.ws + WS_ACT1);
    for (int m = gw; m < nrows; m += ngw) {
        const float* src = (m < TL) ? hl + (size_t)m * D : hc + (size_t)(m - TL) * D;
        const float* mv = mod + (m < TL ? m / SEQ : 2) * 6144;
        const float* shp = mv + (WHICH == 1 ? 0 : 3) * D; const float* scp = mv + (WHICH == 1 ? 1 : 4) * D;
        f32x4 v[4]; float ss = 0.f;
#pragma unroll
        for (int j = 0; j < 4; ++j) { v[j] = *(const f32x4*)(src + 256 * j + 4 * lane); ss += v[j].x * v[j].x + v[j].y * v[j].y + v[j].z * v[j].z + v[j].w * v[j].w; }
        const float rstd = rsqrtf(wave_sum(ss) * (1.f / D) + EPS);
        float lg[8];
#pragma unroll
        for (int e = 0; e < 8; ++e) lg[e] = 0.f;
#pragma unroll
        for (int j = 0; j < 4; ++j) {
            const int c = 256 * j + 4 * lane;
            const f32x4 g = *(const f32x4*)(gain + c), sh = *(const f32x4*)(shp + c), sc = *(const f32x4*)(scp + c);
            f32x4 f = v[j] * rstd * g * (sc + 1.f) + sh;
            u32x2 w; w.x = pk2(f.x, f.y); w.y = pk2(f.z, f.w);
            *(u32x2*)(dst + (size_t)m * D + c) = w;
            if (ROUTER) {
                const float* rt = p.in[28] + (size_t)c * 8;
#pragma unroll
                for (int i = 0; i < 4; ++i) { const f32x4 r0 = *(const f32x4*)(rt + 8 * i), r1 = *(const f32x4*)(rt + 8 * i + 4); const float fv = f[i];
                    lg[0] += fv * r0.x; lg[1] += fv * r0.y; lg[2] += fv * r0.z; lg[3] += fv * r0.w; lg[4] += fv * r1.x; lg[5] += fv * r1.y; lg[6] += fv * r1.z; lg[7] += fv * r1.w; }
            }
        }
        if (ROUTER) {
#pragma unroll
            for (int e = 0; e < 8; ++e) lg[e] = wave_sum(lg[e]);
            if (lane == 0) {
                int e0 = 0; float v0 = lg[0];
#pragma unroll
                for (int e = 1; e < 8; ++e) if (lg[e] > v0) { v0 = lg[e]; e0 = e; }
                int e1 = -1; float v1 = -INFINITY;
#pragma unroll
                for (int e = 0; e < 8; ++e) if (e != e0 && lg[e] > v1) { v1 = lg[e]; e1 = e; }
                const float t = expf(v1 - v0), g0 = 1.f / (1.f + t), g1 = t / (1.f + t);
                unsigned* cnt = (unsigned*)(p.ws + WS_CTL);
                const int p0 = (int)atomicAdd(cnt + e0, 1u), p1 = (int)atomicAdd(cnt + e1, 1u);
                ((int2*)(p.ws + WS_TOKE))[m] = make_int2(e0, e1); ((int2*)(p.ws + WS_TOKP))[m] = make_int2(p0, p1); ((float2*)(p.ws + WS_TOKG))[m] = make_float2(g0, g1);
            }
        }
    }
}

__device__ __forceinline__ void store_row_bf16(bf16_t* dst, const float* src, int n) {
    for (int c = 0; c < n; c += 8) { u32x4 w; w.x = pk2(src[c], src[c + 1]); w.y = pk2(src[c + 2], src[c + 3]); w.z = pk2(src[c + 4], src[c + 5]); w.w = pk2(src[c + 6], src[c + 7]); *(u32x4*)(dst + c) = w; }
}
__device__ __forceinline__ void ph_postproj(const Params& p, int layer, float* smem) {
    float* X = smem;
    float* QM = X + 8 * NIN;
    float* KV = QM + 8 * 384;
    float* KDN = KV + 8 * 512;
    const int tid = opq((int)threadIdx.x);
    const bf16_t* P = (const bf16_t*)(p.ws + WS_P);
    const QKVB qb = make_qkv(p.ws);
    const bf16_t* Wuq = (const bf16_t*)(p.ws + WS_WUQ) + (size_t)layer * 384 * 192;
    const bf16_t* Wukv = (const bf16_t*)(p.ws + WS_WUKV) + (size_t)layer * 512 * 128;
    const float2* rope = (const float2*)(p.ws + WS_ROPE);
    for (int tile = blockIdx.x; tile < MALL / 8; tile += gridDim.x) {
        const int m0 = tile * 8;
        __syncthreads();
        for (int i = tid; i < 8 * NIN / 8; i += 512) { const int t = i / (NIN / 8), c = (i % (NIN / 8)) * 8;
            const u32x4 v = *(const u32x4*)(P + (size_t)(m0 + t) * NINP + c); float* x = X + t * NIN + c;
            x[0] = bflo(v.x); x[1] = bfhi(v.x); x[2] = bflo(v.y); x[3] = bfhi(v.y); x[4] = bflo(v.z); x[5] = bfhi(v.z); x[6] = bflo(v.w); x[7] = bfhi(v.w); }
        __syncthreads();
        if (tid < 16) { const int t = tid >> 1, which = tid & 1; float* x = X + t * NIN + (which ? OFF_DCKV : OFF_DCQ); const int n = which ? 128 : 192;
            const float* g = which ? p.in[19] + layer * 128 : p.in[17] + layer * 192; float ss = 0.f;
            for (int i = 0; i < n; ++i) ss += x[i] * x[i];
            const float r = rsqrtf(ss / n + EPS); for (int i = 0; i < n; ++i) x[i] = x[i] * r * g[i]; }
        __syncthreads();
        if (tid < 384) { float acc[8];
#pragma unroll
            for (int t = 0; t < 8; ++t) acc[t] = 0.f;
            const bf16_t* w = Wuq + (size_t)tid * 192;
            for (int k = 0; k < 192; k += 8) { const u32x4 wv = *(const u32x4*)(w + k); const float w0 = bflo(wv.x), w1 = bfhi(wv.x), w2 = bflo(wv.y), w3 = bfhi(wv.y), w4 = bflo(wv.z), w5 = bfhi(wv.z), w6 = bflo(wv.w), w7 = bfhi(wv.w);
#pragma unroll
                for (int t = 0; t < 8; ++t) { const float* x = X + t * NIN + OFF_DCQ + k; acc[t] += x[0] * w0 + x[1] * w1 + x[2] * w2 + x[3] * w3 + x[4] * w4 + x[5] * w5 + x[6] * w6 + x[7] * w7; } }
#pragma unroll
            for (int t = 0; t < 8; ++t) QM[t * 384 + tid] = acc[t]; }
        { float acc[8];
#pragma unroll
            for (int t = 0; t < 8; ++t) acc[t] = 0.f;
            const bf16_t* w = Wukv + (size_t)tid * 128;
            for (int k = 0; k < 128; k += 8) { const u32x4 wv = *(const u32x4*)(w + k); const float w0 = bflo(wv.x), w1 = bfhi(wv.x), w2 = bflo(wv.y), w3 = bfhi(wv.y), w4 = bflo(wv.z), w5 = bfhi(wv.z), w6 = bflo(wv.w), w7 = bfhi(wv.w);
#pragma unroll
                for (int t = 0; t < 8; ++t) { const float* x = X + t * NIN + OFF_DCKV + k; acc[t] += x[0] * w0 + x[1] * w1 + x[2] * w2 + x[3] * w3 + x[4] * w4 + x[5] * w5 + x[6] * w6 + x[7] * w7; } }
#pragma unroll
            for (int t = 0; t < 8; ++t) KV[t * 512 + tid] = acc[t]; }
        __syncthreads();
        if (tid < 224) {
            const int t = tid / 28, j = tid % 28, m = m0 + t; const bool lat = m < TL;
            const int b = lat ? m / SEQ : (m - TL) / CTX, s = lat ? m % SEQ : (m - TL) % CTX, key = lat ? CTX + s : s;
            const int prow = s / 64, pcol = s % 64;
            float* src; const float* gn; int n = 64; bf16_t* dst; int ropemode = 0;
            const float qs = (j < 4 || (j >= 6 && j < 10) || (j >= 12 && j < 16)) ? 0.125f * 1.4426950408889634f : (j >= 20 && j < 24) ? 0.10206207261596575f * 1.4426950408889634f : 1.f;
            if (j < 4)       { src = X + t * NIN + OFF_AQ + 64 * j; gn = p.in[9] + layer * 64; ropemode = 1; dst = lat ? qb.QA + ((size_t)(b * 4 + j) * SEQ + s) * 64 : qb.QAc + ((size_t)(b * 4 + j) * CTX + s) * 64; }
            else if (j < 6)  { const int h = j - 4; src = X + t * NIN + OFF_AK + 64 * h; gn = p.in[10] + layer * 64; ropemode = 1; dst = qb.KA + ((size_t)(b * 2 + h) * KEYS + key) * 64; }
            else if (j < 10) { const int h = j - 6; src = X + t * NIN + OFF_BQ + 64 * h; gn = p.in[12] + layer * 64; ropemode = 1; dst = lat ? qb.QB + ((size_t)(b * 4 + h) * SEQ + s) * 64 : qb.QBc + ((size_t)(b * 4 + h) * CTX + s) * 64; }
            else if (j < 12) { const int h = j - 10; src = X + t * NIN + OFF_BK + 64 * h; gn = p.in[13] + layer * 64; ropemode = 1; dst = qb.KB + ((size_t)(b * 2 + h) * KEYS + key) * 64; }
            else if (j < 16) { const int h = j - 12; src = X + t * NIN + OFF_CQ + 64 * h; gn = p.in[14] + layer * 64; dst = lat ? qb.QC + ((size_t)(b * 4 + h) * SEQ + s) * 64 : qb.QCc + ((size_t)(b * 4 + h) * CTX + s) * 64; }
            else if (j < 20) { const int h = j - 16; src = X + t * NIN + OFF_CK + 64 * h; gn = p.in[15] + layer * 64; dst = qb.KC + ((size_t)(b * 4 + h) * KEYS + key) * 64; }
            else if (j < 24) { const int h = j - 20; src = QM + t * 384 + 96 * h; gn = p.in[21] + layer * 96; n = 96; ropemode = 2; dst = lat ? qb.QD + ((size_t)(b * 4 + h) * SEQ + s) * 96 : qb.QDc + ((size_t)(b * 4 + h) * CTX + s) * 96; }
            else { const int h = j - 24; float* kd = KDN + (t * 4 + h) * 96; const float* kn = KV + t * 512 + 128 * h; const float* kr = X + t * NIN + OFF_DKR;
                for (int i = 0; i < 64; ++i) kd[i] = kn[i];
                for (int i = 0; i < 32; ++i) kd[64 + i] = kr[i];
                src = kd; gn = p.in[22] + layer * 96; n = 96; ropemode = 2; dst = qb.KD + ((size_t)(b * 4 + h) * KEYS + key) * 96; }
            float ss = 0.f; for (int i = 0; i < n; ++i) ss += src[i] * src[i];
            const float r = rsqrtf(ss / n + EPS);
            for (int i = 0; i < n; ++i) src[i] = src[i] * (r * qs) * gn[i];
            if (lat && ropemode == 1) {
                for (int i = 0; i < 16; ++i) { const float2 cr = rope[RT_R64 + prow * 16 + i], cc = rope[RT_C64 + pcol * 16 + i];
                    const float a = src[i], bq = src[16 + i]; src[i] = a * cr.x - bq * cr.y; src[16 + i] = bq * cr.x + a * cr.y;
                    const float c1 = src[32 + i], c2 = src[48 + i]; src[32 + i] = c1 * cc.x - c2 * cc.y; src[48 + i] = c2 * cc.x + c1 * cc.y; }
            } else if (lat && ropemode == 2) {
                for (int i = 0; i < 8; ++i) { const float2 cr = rope[RT_R32 + prow * 8 + i], cc = rope[RT_C32 + pcol * 8 + i];
                    const float a = src[64 + i], bq = src[72 + i]; src[64 + i] = a * cr.x - bq * cr.y; src[72 + i] = bq * cr.x + a * cr.y;
                    const float c1 = src[80 + i], c2 = src[88 + i]; src[80 + i] = c1 * cc.x - c2 * cc.y; src[88 + i] = c2 * cc.x + c1 * cc.y; }
            }
            store_row_bf16(dst, src, n);
        } else if (tid >= 256 && tid < 256 + 96) {
            const int u = tid - 256, t = u / 12, j = u % 12, m = m0 + t; const bool lat = m < TL;
            const int b = lat ? m / SEQ : (m - TL) / CTX, s = lat ? m % SEQ : (m - TL) % CTX, key = lat ? CTX + s : s;
            const float* src; bf16_t* dst;
            if (j < 2) { src = X + t * NIN + OFF_AV + 64 * j; dst = qb.VA + ((size_t)(b * 2 + j) * KEYS + key) * 64; }
            else if (j < 4) { src = X + t * NIN + OFF_BV + 64 * (j - 2); dst = qb.VB + ((size_t)(b * 2 + j - 2) * KEYS + key) * 64; }
            else if (j < 8) { src = X + t * NIN + OFF_CV + 64 * (j - 4); dst = qb.VC + ((size_t)(b * 4 + j - 4) * KEYS + key) * 64; }
            else { src = KV + t * 512 + 128 * (j - 8) + 64; dst = qb.VD + ((size_t)(b * 4 + j - 8) * KEYS + key) * 64; }
            store_row_bf16(dst, src, 64);
        }
    }
    __syncthreads();
}


namespace fa {
typedef short bf16x8 __attribute__((ext_vector_type(8)));
typedef short s16x4 __attribute__((ext_vector_type(4)));
typedef float f32x16 __attribute__((ext_vector_type(16)));
typedef __attribute__((address_space(3))) const char* lds_cptr;
typedef short v4i16_t __attribute__((ext_vector_type(4)));
constexpr int KSTG = 12288, VSTG = 8192, STG = KSTG + VSTG;
constexpr int LDS_WS = 2 * STG, LDS_OST = LDS_WS + 8 * 256, LDS_RPB = LDS_OST + 8 * 4096, LDS_TOTAL = LDS_RPB + 2048;
constexpr float LOG2E = 1.4426950408889634f;
constexpr float THR = 6.0f;
__device__ __forceinline__ int crow(int r, int hi) { return (r & 3) + 8 * (r >> 2) + 4 * hi; }
__device__ __forceinline__ void glds16(const void* gsrc, unsigned lds_dst) { unsigned keep;
    asm volatile("s_mov_b32 %0, m0\n\ts_mov_b32 m0, %2\n\ts_nop 0\n\tglobal_load_lds_dwordx4 %1, off\n\ts_mov_b32 m0, %0" : "=&s"(keep) : "v"(gsrc), "s"(lds_dst) : "memory"); }
__device__ __forceinline__ s16x4 vtr(lds_cptr p) { return __builtin_bit_cast(s16x4, __builtin_amdgcn_ds_read_tr16_b64_v4i16((__attribute__((address_space(3))) v4i16_t*)p)); }
typedef float f32x2_t __attribute__((ext_vector_type(2))); typedef __bf16 bf16x2_t __attribute__((ext_vector_type(2)));
__device__ __forceinline__ unsigned cvtpk(float lo, float hi) { f32x2_t v = {lo, hi}; bf16x2_t b = __builtin_convertvector(v, bf16x2_t); return __builtin_bit_cast(unsigned, b); }
__device__ __forceinline__ float xhalf_max(float m) { auto rr = __builtin_amdgcn_permlane32_swap(__float_as_uint(m), __float_as_uint(m), false, false); return fmaxf(__uint_as_float(rr[0]), __uint_as_float(rr[1])); }
__device__ __forceinline__ float xhalf_sum(float m) { auto rr = __builtin_amdgcn_permlane32_swap(__float_as_uint(m), __float_as_uint(m), false, false); return __uint_as_float(rr[0]) + __uint_as_float(rr[1]); }
#define FA_WAIT_BAR() asm volatile("s_waitcnt vmcnt(0) lgkmcnt(0)\n\ts_barrier" ::: "memory")

template <int DQK, int MODE>
__device__ __forceinline__ void attn_unit(const bf16_t* Qg, const bf16_t* Kg, const bf16_t* Vg, bf16_t* Og, int q0, float sink2, const float* rpb, char* shm) {
    const int tid = opq((int)threadIdx.x), lane = tid & 63, r32 = lane & 31, hi = lane >> 5; const int wid = __builtin_amdgcn_readfirstlane(tid >> 6);
    const unsigned lds0 = (unsigned)(uintptr_t)shm;
    float* wsf = (float*)(shm + LDS_WS) + wid * 64;
    constexpr int NCH = DQK / 8, ND0 = DQK / 16;
    int NT, wbase = 0;
    if (MODE == 0) NT = KEYS / 64; else if (MODE == 3) NT = 4;
    else if (MODE == 1) { wbase = max(0, q0 - 128); const int we = min(SEQ, q0 + 256 + 128); NT = 4 + (we - wbase) / 64; }
    else { const int r0 = q0 >> 6; wbase = min(max(r0 - 4, 0), 120); const int kre = min(max(r0 - 1, 0), 120) + 8; NT = 4 + (kre - wbase); }
#define FA_KEY0(t) ((MODE == 0 || MODE == 3 || (t) < 4) ? 64 * (t) : (MODE == 1 ? CTX + wbase + 64 * ((t) - 4) : CTX + (wbase + (t) - 4) * 64))
    const bf16_t* ksrc = Kg + (size_t)lane * DQK; const bf16_t* vsrc = Vg + (size_t)(16 * (wid & 3) + (lane >> 2)) * 64 + (wid >> 2) * 32 + (lane & 3) * 8;
#define FA_DMA(t, s) do { const int k0_ = FA_KEY0(t); \
        _Pragma("unroll") for (int c_ = 0; c_ < 2; ++c_) { const int ch_ = wid + 8 * c_; if (ch_ < NCH) glds16(ksrc + (size_t)k0_ * DQK + ch_ * 8, (unsigned)__builtin_amdgcn_readfirstlane(lds0 + (s) * STG + ch_ * 1024)); } \
        glds16(vsrc + (size_t)k0_ * 64, (unsigned)__builtin_amdgcn_readfirstlane(lds0 + (s) * STG + KSTG + wid * 1024)); } while (0)
    FA_DMA(0, 0);
    if (MODE == 2) { float* rp = (float*)(shm + LDS_RPB); for (int i = tid; i < 15 * 31; i += 512) rp[i] = rpb[i] * LOG2E; }
    bf16x8 qr[ND0];
#pragma unroll
    for (int d0 = 0; d0 < ND0; ++d0) qr[d0] = *reinterpret_cast<const bf16x8*>(Qg + (size_t)(wid * 32 + r32) * DQK + d0 * 16 + hi * 8);
    float mhat = -1e30f, l_reg = 0.f; f32x16 o[2];
#pragma unroll
    for (int r = 0; r < 16; ++r) { o[0][r] = 0.f; o[1][r] = 0.f; }
    const int qpos = q0 + wid * 32 + r32;
    const int rq = (q0 >> 6) + (wid >> 1), jq = 32 * (wid & 1) + r32;
    const int rs = min(max(rq - 4, 0), 120), cs = min(max(jq - 8, 0), 48);
    const lds_cptr shm3 = (lds_cptr)shm;
    FA_WAIT_BAR();
    for (int t = 0; t < NT; ++t) {
        const int s = t & 1;
        if (t + 1 < NT) FA_DMA(t + 1, s ^ 1);
        bool active = true;
        if (MODE == 1 && t >= 4) { const int kp0 = wbase + 64 * (t - 4), qw0 = q0 + wid * 32; active = (kp0 + 63 >= qw0 - 128) && (kp0 <= qw0 + 31 + 128); }
        if (MODE == 2 && t >= 4) { const int kr = wbase + t - 4; active = (kr >= rs) && (kr < rs + 8); }
        if (active) {
            const lds_cptr kb = shm3 + s * STG + hi * 1024 + r32 * 16;
            f32x16 p0, p1;
#pragma unroll
            for (int r = 0; r < 16; ++r) { p0[r] = 0.f; p1[r] = 0.f; }
#pragma unroll
            for (int d0 = 0; d0 < ND0; ++d0) {
                const bf16x8 b0 = *(const __attribute__((address_space(3))) bf16x8*)(kb + d0 * 2048);
                const bf16x8 b1 = *(const __attribute__((address_space(3))) bf16x8*)(kb + d0 * 2048 + 512);
                p0 = __builtin_amdgcn_mfma_f32_32x32x16_bf16(b0, qr[d0], p0, 0, 0, 0);
                p1 = __builtin_amdgcn_mfma_f32_32x32x16_bf16(b1, qr[d0], p1, 0, 0, 0);
            }
            if (MODE == 1 && t >= 4) { const int kp0 = wbase + 64 * (t - 4) - qpos;
#pragma unroll
                for (int r = 0; r < 16; ++r) { const int d0_ = kp0 + crow(r, hi), d1_ = d0_ + 32; if (d0_ < -128 || d0_ > 128) p0[r] = -INFINITY; if (d1_ < -128 || d1_ > 128) p1[r] = -INFINITY; } }
            if (MODE == 2 && t >= 4) { const int kr = wbase + t - 4; const float* rp = (const float*)(shm + LDS_RPB) + (kr - rq + 7) * 31 + 15 - jq;
#pragma unroll
                for (int r = 0; r < 16; ++r) { const int kc0 = crow(r, hi), kc1 = kc0 + 32;
                    const bool v0 = (kc0 >= cs) && (kc0 < cs + 16), v1 = (kc1 >= cs) && (kc1 < cs + 16);
                    p0[r] = v0 ? p0[r] + rp[v0 ? kc0 : jq] : -INFINITY; p1[r] = v1 ? p1[r] + rp[v1 ? kc1 : jq] : -INFINITY; } }
            float rm = fmaxf(p0[0], p1[0]);
#pragma unroll
            for (int r = 1; r < 16; ++r) rm = fmaxf(rm, fmaxf(p0[r], p1[r]));
            rm = xhalf_max(rm);
            if (__any(rm - mhat > THR)) {
                const float mn = fmaxf(mhat, rm), f = __builtin_amdgcn_exp2f(mhat - mn); mhat = mn; l_reg *= f;
                if (hi == 0) wsf[r32] = f;
#pragma unroll
                for (int r = 0; r < 16; ++r) { const float fr = wsf[crow(r, hi)]; o[0][r] *= fr; o[1][r] *= fr; }
            }
            float sacc = 0.f;
#pragma unroll
            for (int r = 0; r < 16; ++r) { p0[r] = __builtin_amdgcn_exp2f(p0[r] - mhat); p1[r] = __builtin_amdgcn_exp2f(p1[r] - mhat); sacc += p0[r] + p1[r]; }
            l_reg += sacc;
            u32x4 pw0, pw1, pw2, pw3;
            pw0 = (u32x4){cvtpk(p0[0], p0[1]), cvtpk(p0[2], p0[3]), cvtpk(p0[4], p0[5]), cvtpk(p0[6], p0[7])};
            pw1 = (u32x4){cvtpk(p0[8], p0[9]), cvtpk(p0[10], p0[11]), cvtpk(p0[12], p0[13]), cvtpk(p0[14], p0[15])};
            pw2 = (u32x4){cvtpk(p1[0], p1[1]), cvtpk(p1[2], p1[3]), cvtpk(p1[4], p1[5]), cvtpk(p1[6], p1[7])};
            pw3 = (u32x4){cvtpk(p1[8], p1[9]), cvtpk(p1[10], p1[11]), cvtpk(p1[12], p1[13]), cvtpk(p1[14], p1[15])};
            const lds_cptr vp = shm3 + s * STG + KSTG + ((lane >> 4) & 1) * 32 + (lane & 3) * 8 + (4 * hi + ((lane & 15) >> 2)) * 64;
#pragma unroll
            for (int dh = 0; dh < 2; ++dh) {
                s16x4 vlo[4], vhi[4];
#pragma unroll
                for (int ks = 0; ks < 4; ++ks) { vlo[ks] = vtr(vp + dh * 4096 + ks * 1024); vhi[ks] = vtr(vp + dh * 4096 + ks * 1024 + 512); }
#define FA_VFR(k) (bf16x8){vlo[k][0], vlo[k][1], vlo[k][2], vlo[k][3], vhi[k][0], vhi[k][1], vhi[k][2], vhi[k][3]}
                o[dh] = __builtin_amdgcn_mfma_f32_32x32x16_bf16(__builtin_bit_cast(bf16x8, pw0), FA_VFR(0), o[dh], 0, 0, 0);
                o[dh] = __builtin_amdgcn_mfma_f32_32x32x16_bf16(__builtin_bit_cast(bf16x8, pw1), FA_VFR(1), o[dh], 0, 0, 0);
                o[dh] = __builtin_amdgcn_mfma_f32_32x32x16_bf16(__builtin_bit_cast(bf16x8, pw2), FA_VFR(2), o[dh], 0, 0, 0);
                o[dh] = __builtin_amdgcn_mfma_f32_32x32x16_bf16(__builtin_bit_cast(bf16x8, pw3), FA_VFR(3), o[dh], 0, 0, 0);
#undef FA_VFR
            }
        }
        FA_WAIT_BAR();
    }
    l_reg = xhalf_sum(l_reg);
    if (MODE == 1 || MODE == 3) l_reg += __builtin_amdgcn_exp2f(sink2 - mhat);
    if (hi == 0) wsf[32 + r32] = 1.0f / l_reg;
    float rli[16];
#pragma unroll
    for (int r = 0; r < 16; ++r) rli[r] = wsf[32 + crow(r, hi)];
    bf16_t* stg = (bf16_t*)(shm + LDS_OST) + wid * 2048;
#pragma unroll
    for (int r = 0; r < 16; ++r) { const int orow = crow(r, hi);
#pragma unroll
        for (int dh = 0; dh < 2; ++dh) stg[orow * 64 + dh * 32 + r32] = (bf16_t)f2bf(o[dh][r] * rli[r]); }
#pragma unroll
    for (int i = 0; i < 4; ++i) { const int row = i * 8 + (lane >> 3), ch = lane & 7; const u32x4 v = *(const u32x4*)(stg + row * 64 + ch * 8); *(u32x4*)(Og + (size_t)(wid * 32 + row) * D + ch * 8) = v; }
    asm volatile("s_waitcnt lgkmcnt(0)\n\ts_barrier" ::: "memory");
#undef FA_DMA
#undef FA_KEY0
}
#undef FA_WAIT_BAR
}

constexpr float SCALE_MLA = 0.10206207261596575f;
__device__ __forceinline__ void ph_attn(const Params& p, int layer, bool with_ctx, char* shm) {
    const QKVB qb = make_qkv(p.ws);
    bf16_t* O = (bf16_t*)(p.ws + WS_P);
    const int G = gridDim.x;
    const float NEG = -INFINITY;
    for (int u = blockIdx.x; u < 256; u += G) { const int bh = u & 7, b = bh >> 2, h = bh & 3, qbk = u >> 3;
        fa::attn_unit<96, 0>(qb.QD + ((size_t)bh * SEQ + qbk * 256) * 96, qb.KD + (size_t)bh * KEYS * 96, qb.VD + (size_t)bh * KEYS * 64, O + (size_t)(b * SEQ + qbk * 256) * D + 768 + h * 64, qbk * 256, NEG, nullptr, shm); }
    for (int u = blockIdx.x; u < 256; u += G) { const int bh = u & 7, b = bh >> 2, h = bh & 3, qbk = u >> 3;
        fa::attn_unit<64, 0>(qb.QB + ((size_t)bh * SEQ + qbk * 256) * 64, qb.KB + (size_t)(b * 2 + (h >> 1)) * KEYS * 64, qb.VB + (size_t)(b * 2 + (h >> 1)) * KEYS * 64, O + (size_t)(b * SEQ + qbk * 256) * D + 256 + h * 64, qbk * 256, NEG, nullptr, shm); }
    for (int u = blockIdx.x; u < 256; u += G) { const int bh = u & 7, b = bh >> 2, h = bh & 3, qbk = u >> 3;
        fa::attn_unit<64, 1>(qb.QA + ((size_t)bh * SEQ + qbk * 256) * 64, qb.KA + (size_t)(b * 2 + (h >> 1)) * KEYS * 64, qb.VA + (size_t)(b * 2 + (h >> 1)) * KEYS * 64, O + (size_t)(b * SEQ + qbk * 256) * D + 0 + h * 64, qbk * 256, p.in[11][layer * 4 + h] * fa::LOG2E, nullptr, shm); }
    for (int u = blockIdx.x; u < 256; u += G) { const int bh = u & 7, b = bh >> 2, h = bh & 3, qbk = u >> 3;
        fa::attn_unit<64, 2>(qb.QC + ((size_t)bh * SEQ + qbk * 256) * 64, qb.KC + (size_t)bh * KEYS * 64, qb.VC + (size_t)bh * KEYS * 64, O + (size_t)(b * SEQ + qbk * 256) * D + 512 + h * 64, qbk * 256, NEG, p.in[16] + ((size_t)layer * 4 + h) * 15 * 31, shm); }
    if (with_ctx) for (int u = blockIdx.x; u < 32; u += G) { const int ty = u >> 3, bh = u & 7, b = bh >> 2, h = bh & 3;
        bf16_t* Oc = O + (size_t)(TL + b * CTX) * D + ty * 256 + h * 64;
        if (ty == 0) fa::attn_unit<64, 3>(qb.QAc + (size_t)bh * CTX * 64, qb.KA + (size_t)(b * 2 + (h >> 1)) * KEYS * 64, qb.VA + (size_t)(b * 2 + (h >> 1)) * KEYS * 64, Oc, 0, p.in[11][layer * 4 + h] * fa::LOG2E, nullptr, shm);
        else if (ty == 1) fa::attn_unit<64, 3>(qb.QBc + (size_t)bh * CTX * 64, qb.KB + (size_t)(b * 2 + (h >> 1)) * KEYS * 64, qb.VB + (size_t)(b * 2 + (h >> 1)) * KEYS * 64, Oc, 0, NEG, nullptr, shm);
        else if (ty == 2) fa::attn_unit<64, 3>(qb.QCc + (size_t)bh * CTX * 64, qb.KC + (size_t)bh * KEYS * 64, qb.VC + (size_t)bh * KEYS * 64, Oc, 0, NEG, nullptr, shm);
        else fa::attn_unit<96, 3>(qb.QDc + (size_t)bh * CTX * 96, qb.KD + (size_t)bh * KEYS * 96, qb.VD + (size_t)bh * KEYS * 64, Oc, 0, NEG, nullptr, shm); }
}

__device__ __forceinline__ void ph_gnorm(const Params& p, int layer, int nrows) {
    const int tx = opq((int)threadIdx.x), lane = tx & 63, gw = (blockIdx.x * 512 + tx) >> 6, ngw = (gridDim.x * 512) >> 6;
    const bf16_t* O = (const bf16_t*)(p.ws + WS_P); bf16_t* Y = (bf16_t*)(p.ws + WS_ACT1); const float* g = p.in[23] + layer * D;
    for (int m = gw; m < nrows; m += ngw) {
#pragma unroll
        for (int grp = 0; grp < 4; ++grp) { const int c = grp * 256 + 4 * lane; const u32x2 w = *(const u32x2*)(O + (size_t)m * D + c);
            const float a0 = bflo(w.x), a1 = bfhi(w.x), a2 = bflo(w.y), a3 = bfhi(w.y);
            const float r = rsqrtf(wave_sum(a0 * a0 + a1 * a1 + a2 * a2 + a3 * a3) * (1.f / 256.f) + EPS);
            const f32x4 gv = *(const f32x4*)(g + c); u32x2 o; o.x = pk2(a0 * r * gv.x, a1 * r * gv.y); o.y = pk2(a2 * r * gv.z, a3 * r * gv.w);
            *(u32x2*)(Y + (size_t)m * D + c) = o; }
    }
}

__device__ __forceinline__ void moe_bases(const unsigned* cnt, int (&base)[9]) {
    int acc = 0;
#pragma unroll
    for (int e = 0; e < 8; ++e) { base[e] = acc; acc += ((int)cnt[e] + 255) / 256 * 256; }
    base[8] = acc;
}
__device__ __forceinline__ void ph_moe_gather(const Params& p) {
    const int tx = opq((int)threadIdx.x), lane = tx & 63, gw = (blockIdx.x * 512 + tx) >> 6, ngw = (gridDim.x * 512) >> 6;
    const unsigned* cnt = (const unsigned*)(p.ws + WS_CTL); int base[9]; moe_bases(cnt, base);
    if (blockIdx.x == 0 && tx < 136) { const int r = tx * 256; int e = -1;
#pragma unroll
        for (int i = 0; i < 8; ++i) if (r >= base[i] && r < base[i + 1]) e = i;
        ((int*)(p.ws + WS_TEXP))[tx] = e < 0 ? 0 : e; }
    const bf16_t* F = (const bf16_t*)(p.ws + WS_ACT1); bf16_t* A = (bf16_t*)(p.ws + WS_ASORT);
    for (int m = gw; m < TL; m += ngw) {
        const int2 e = ((const int2*)(p.ws + WS_TOKE))[m]; const int2 ps = ((const int2*)(p.ws + WS_TOKP))[m];
        int b0 = 0, b1 = 0;
#pragma unroll
        for (int i = 0; i < 8; ++i) { if (e.x == i) b0 = base[i]; if (e.y == i) b1 = base[i]; }
        const int s0 = b0 + ps.x, s1 = b1 + ps.y;
        const u32x4 v0 = *(const u32x4*)(F + (size_t)m * D + lane * 16), v1 = *(const u32x4*)(F + (size_t)m * D + lane * 16 + 8);
        *(u32x4*)(A + (size_t)s0 * D + lane * 16) = v0; *(u32x4*)(A + (size_t)s0 * D + lane * 16 + 8) = v1;
        *(u32x4*)(A + (size_t)s1 * D + lane * 16) = v0; *(u32x4*)(A + (size_t)s1 * D + lane * 16 + 8) = v1;
        if (lane == 0) ((int2*)(p.ws + WS_TOKS))[m] = make_int2(s0, s1);
    }
}
__device__ __forceinline__ void ph_moe_combine(const Params& p, int layer) {
    const size_t nthr = (size_t)gridDim.x * 512;
    for (size_t idx = (size_t)blockIdx.x * 512 + opq((int)threadIdx.x); idx < (size_t)TL * 256; idx += nthr) {
        const int m = (int)(idx >> 8), c = (int)(idx & 255) * 4;
        const int2 sl = ((const int2*)(p.ws + WS_TOKS))[m]; const float2 g = ((const float2*)(p.ws + WS_TOKG))[m];
        const bf16_t* Y = (const bf16_t*)(p.ws + WS_ASORT);
        const u32x2 a = *(const u32x2*)(Y + (size_t)sl.x * D + c), b = *(const u32x2*)(Y + (size_t)sl.y * D + c);
        const f32x4 ya = {bflo(a.x), bfhi(a.x), bflo(a.y), bfhi(a.y)}, yb = {bflo(b.x), bfhi(b.x), bflo(b.y), bfhi(b.y)};
        const float* mod = (const float*)(p.ws + WS_MOD) + (size_t)layer * 3 * 6144 + (m / SEQ) * 6144 + 5 * D;
        f32x4* o = (f32x4*)(p.out + (size_t)m * D + c);
        *o = *o + *(const f32x4*)(mod + c) * (ya * g.x + yb * g.y);
    }
}

struct Args { Params p; int ph_lo, ph_hi; };
__global__ void __launch_bounds__(NWAVES * 64, 2) mega_fwd(Args args) {
    extern __shared__ __attribute__((aligned(16))) unsigned char lds[];
    LAS unsigned char* ldsl = (LAS unsigned char*)lds;
    for (int u = threadIdx.x; u < (LDS_BYTES - LDSCTL_OFF) / 4; u += NWAVES * 64) ((LAS unsigned*)(ldsl + LDSCTL_OFF))[u] = 0u;
    __syncthreads();
    XcdBarrier bar = xcd_barrier_post((unsigned*)(args.p.ws + WS_CTL) + CW_BAR, (volatile LAS unsigned*)(ldsl + MISC_OFF) + 8);
    const int lo = args.ph_lo, hi = args.ph_hi; int ph = 0;
#define PHASE(body) do { if (lo <= ph && ph < hi) { Params q = args.p; q.ws = opqp(args.p.ws); q.out = opqp(args.p.out); LAS unsigned char* ldq = (LAS unsigned char*)lds; (void)ldq; body; if (ph + 1 < hi) xcd_barrier(bar); } ++ph; } while (0)
#define QMOD(l) ((const float*)(q.ws + WS_MOD) + (size_t)(l) * 3 * 6144)
    PHASE(ph_prologue(q, (float*)lds));
#pragma unroll 1
    for (int l = 0; l < 2; ++l) {
        const bool last = (l == 1);
        const int nrows = last ? TL : MALL;
        PHASE((ph_norm<1, false>(q, l, MALL)));
        PHASE(run_gemm(ldq, (const bf16_t*)(q.ws + WS_ACT1), (const bf16_t*)(q.ws + WS_WIN) + (size_t)l * NINP * D, D, MALL / 256, NINP / 256, nullptr, 0, EpiBf16Perm{(bf16_t*)(q.ws + WS_P), NINP, 0}));
        PHASE(ph_postproj(q, l, (float*)lds));
        PHASE(ph_attn(q, l, !last, (char*)lds));
        PHASE(ph_gnorm(q, l, nrows));
        PHASE(run_gemm(ldq, (const bf16_t*)(q.ws + WS_ACT1), (const bf16_t*)(q.ws + WS_WOUT) + (size_t)l * D * D, D, nrows / 256, D / 256, nullptr, 0,
                       EpiResid{(l == 0) ? q.in[0] : q.out, (l == 0) ? q.in[2] : (const float*)(q.ws + WS_HCTX), q.out, (float*)(q.ws + WS_HCTX), QMOD(l), 2 * D, 0}));
        if (!last) {
            PHASE((ph_norm<2, false>(q, l, MALL)));
            PHASE(run_gemm(ldq, (const bf16_t*)(q.ws + WS_ACT1), (const bf16_t*)(q.ws + WS_WFGU), D, MALL / 256, 2 * DFF / 256, nullptr, 0, EpiSwiglu{(bf16_t*)(q.ws + WS_HIDF), DFF, 0}));
            PHASE(run_gemm(ldq, (const bf16_t*)(q.ws + WS_HIDF), (const bf16_t*)(q.ws + WS_WFDN), DFF, MALL / 256, D / 256, nullptr, 0,
                           EpiResid{q.out, (const float*)(q.ws + WS_HCTX), q.out, (float*)(q.ws + WS_HCTX), QMOD(l), 5 * D, 0}));
        } else {
            PHASE((ph_norm<2, true>(q, l, TL)));
            PHASE(ph_moe_gather(q));
            PHASE({ int base[9]; moe_bases((const unsigned*)(q.ws + WS_CTL), base); run_gemm(ldq, (const bf16_t*)(q.ws + WS_ASORT), (const bf16_t*)(q.ws + WS_WMGU), D, base[8] / 256, 2 * DFFE / 256, (const int*)(q.ws + WS_TEXP), (size_t)2 * DFFE * D * 2, EpiSwiglu{(bf16_t*)(q.ws + WS_HIDM), DFFE, 0}); });
            PHASE({ int base[9]; moe_bases((const unsigned*)(q.ws + WS_CTL), base); run_gemm(ldq, (const bf16_t*)(q.ws + WS_HIDM), (const bf16_t*)(q.ws + WS_WMDN), DFFE, base[8] / 256, D / 256, (const int*)(q.ws + WS_TEXP), (size_t)D * DFFE * 2, EpiBf16Perm{(bf16_t*)(q.ws + WS_ASORT), D, 0}); });
            PHASE(ph_moe_combine(q, l));
        }
    }
#undef QMOD
#undef PHASE
}

#ifndef MK_CUTS
#define MK_CUTS 0
#endif
extern "C" void kernel_launch(void* const* d_in, const int* in_sizes, int n_in, void* d_out, int out_size, void* d_ws, size_t ws_size, hipStream_t stream) {
    static int grid = 0;
    if (grid == 0) {
        if (n_in != 32 || ws_size < WS_END) { fprintf(stderr, "kernel_launch: need 32 inputs and %zu bytes of workspace (got %d, %zu)\n", (size_t)WS_END, n_in, ws_size); grid = -1; return; }
        int dev = 0, cus = 0, per_cu = 0;
        if (hipGetDevice(&dev) != hipSuccess || hipDeviceGetAttribute(&cus, hipDeviceAttributeMultiprocessorCount, dev) != hipSuccess) { grid = -1; return; }
        if (hipFuncSetAttribute((const void*)mega_fwd, hipFuncAttributeMaxDynamicSharedMemorySize, LDS_BYTES) != hipSuccess) { fprintf(stderr, "kernel_launch: hipFuncSetAttribute failed\n"); grid = -1; return; }
        if (hipOccupancyMaxActiveBlocksPerMultiprocessor(&per_cu, (const void*)mega_fwd, NWAVES * 64, LDS_BYTES) != hipSuccess || per_cu < 1) fprintf(stderr, "kernel_launch: occupancy query says %d blocks per CU\n", per_cu);
        (void)hipGetLastError();
        grid = cus;
    }
    if (grid < 0) return;
    (void)hipMemsetAsync((char*)d_ws + WS_CTL, 0, CTL_ZERO_BYTES, stream);
    Args a{}; for (int i = 0; i < 32; ++i) a.p.in[i] = (const float*)d_in[i]; a.p.out = (float*)d_out; a.p.ws = (unsigned char*)d_ws;
#if MK_CUTS
    for (int ph = 0; ph < 24; ++ph) { a.ph_lo = ph; a.ph_hi = ph + 1; hipLaunchKernelGGL(mega_fwd, dim3(grid), dim3(NWAVES * 64), LDS_BYTES, stream, a); }
#else
    a.ph_lo = 0; a.ph_hi = 21;
    hipLaunchKernelGGL(mega_fwd, dim3(grid), dim3(NWAVES * 64), LDS_BYTES, stream, a);
#endif
}
```

```cpp
#include <hip/hip_runtime.h>
#include <stdint.h>
#include <cstdio>

typedef unsigned short bf16_t;
typedef float f32x4 __attribute__((ext_vector_type(4)));
typedef unsigned u32x4 __attribute__((ext_vector_type(4)));
typedef unsigned u32x2 __attribute__((ext_vector_type(2)));

constexpr int D = 1024, NB = 2, SEQ = 8192, CTX = 256, TL = NB * SEQ, TC = NB * CTX, MALL = TL + TC;
constexpr int NIN = 2144, NINP = 2304, DFF = 2816, NE = 8, DFFE = 3584, KEYS = CTX + SEQ;
constexpr int OFF_AQ = 0, OFF_AK = 256, OFF_AV = 384, OFF_BQ = 512, OFF_BK = 768, OFF_BV = 896, OFF_CQ = 1024, OFF_CK = 1280,
              OFF_CV = 1536, OFF_DCQ = 1792, OFF_DCKV = 1984, OFF_DKR = 2112;
constexpr int MOE_ROWS = 34816;
constexpr float EPS = 1e-6f;

constexpr size_t MiB = 1u << 20;
constexpr size_t WS_CTL = 0;
constexpr size_t WS_MOD = 1 * MiB;
constexpr size_t WS_ROPE = WS_MOD + 256 * 1024;
constexpr size_t WS_TOKE = WS_ROPE + 64 * 1024;
constexpr size_t WS_TOKP = WS_TOKE + TL * 8;
constexpr size_t WS_TOKG = WS_TOKP + TL * 8;
constexpr size_t WS_TEXP = WS_TOKG + TL * 8;
constexpr size_t WS_TOKS = WS_TEXP + 1024;
constexpr size_t WS_HCTX = 2 * MiB;
constexpr size_t WS_WMGU = 6 * MiB;
constexpr size_t WS_WMDN = WS_WMGU + 112 * MiB;
constexpr size_t WS_WDEAD = WS_WMDN + 56 * MiB;
constexpr size_t WS_WIN = WS_WDEAD;
constexpr size_t WS_WOUT = WS_WIN + 9 * MiB;
constexpr size_t WS_WUQ = WS_WOUT + 4 * MiB;
constexpr size_t WS_WUKV = WS_WUQ + 512 * 1024;
constexpr size_t WS_WFGU = WS_WUKV + 512 * 1024;
constexpr size_t WS_WFDN = WS_WFGU + 11 * MiB;
constexpr size_t WS_ACT = 205 * MiB;
static_assert(WS_WFDN + (size_t)1024 * 2816 * 2 <= WS_ACT, "weights fit");
constexpr size_t WS_ACT1 = WS_ACT;
constexpr size_t WS_P = WS_ACT + 33 * MiB;
constexpr size_t WS_QKV = WS_ACT + 108 * MiB;
constexpr size_t WS_HIDF = WS_P;
constexpr size_t WS_HIDM = WS_WDEAD;
constexpr size_t WS_ASORT = WS_HIDM + 238 * MiB;
constexpr size_t WS_END = WS_ASORT + 68 * MiB;
static_assert(WS_QKV + 91 * MiB <= WS_END, "qkv fits");

struct Params { const float* in[32]; float* out; unsigned char* ws; };

struct QKVB { bf16_t *QA, *KA, *VA, *QB, *KB, *VB, *QC, *KC, *VC, *QD, *KD, *VD, *QAc, *QBc, *QCc, *QDc; };
__host__ __device__ inline QKVB make_qkv(unsigned char* ws) {
    QKVB q; bf16_t* p = (bf16_t*)(ws + WS_QKV);
    q.QA = p; p += (size_t)NB * 4 * SEQ * 64; q.KA = p; p += (size_t)NB * 2 * KEYS * 64; q.VA = p; p += (size_t)NB * 2 * KEYS * 64;
    q.QB = p; p += (size_t)NB * 4 * SEQ * 64; q.KB = p; p += (size_t)NB * 2 * KEYS * 64; q.VB = p; p += (size_t)NB * 2 * KEYS * 64;
    q.QC = p; p += (size_t)NB * 4 * SEQ * 64; q.KC = p; p += (size_t)NB * 4 * KEYS * 64; q.VC = p; p += (size_t)NB * 4 * KEYS * 64;
    q.QD = p; p += (size_t)NB * 4 * SEQ * 96; q.KD = p; p += (size_t)NB * 4 * KEYS * 96; q.VD = p; p += (size_t)NB * 4 * KEYS * 64;
    q.QAc = p; p += (size_t)NB * 4 * CTX * 64; q.QBc = p; p += (size_t)NB * 4 * CTX * 64; q.QCc = p; p += (size_t)NB * 4 * CTX * 64;
    q.QDc = p; p += (size_t)NB * 4 * CTX * 96;
    return q;
}

__device__ __forceinline__ float bf2f(unsigned v) { return __uint_as_float(v << 16); }
__device__ __forceinline__ float bflo(unsigned w) { return __uint_as_float(w << 16); }
__device__ __forceinline__ float bfhi(unsigned w) { return __uint_as_float(w & 0xffff0000u); }
__device__ __forceinline__ unsigned f2bf(float f) { unsigned u = __float_as_uint(f); return (u + 0x7fffu + ((u >> 16) & 1u)) >> 16; }
__device__ __forceinline__ unsigned pk2(float lo, float hi) { return f2bf(lo) | (f2bf(hi) << 16); }
template <int X> __device__ __forceinline__ float swz_xor(float v) { return __int_as_float(__builtin_amdgcn_ds_swizzle(__float_as_int(v), 0x1f | (X << 10))); }
__device__ __forceinline__ float half_sum(float v) { auto rr = __builtin_amdgcn_permlane32_swap(__float_as_uint(v), __float_as_uint(v), false, false); return __uint_as_float(rr[0]) + __uint_as_float(rr[1]); }
__device__ __forceinline__ float half_other(float v, int lane) { auto rr = __builtin_amdgcn_permlane32_swap(__float_as_uint(v), __float_as_uint(v), false, false); return __uint_as_float((lane & 32) ? rr[0] : rr[1]); }
__device__ __forceinline__ float wave_sum(float v) { v += swz_xor<1>(v); v += swz_xor<2>(v); v += swz_xor<4>(v); v += swz_xor<8>(v); v += swz_xor<16>(v); return half_sum(v); }
__device__ __forceinline__ int opq(int v) { asm volatile("" : "+v"(v)); return v; }
template <class T> __device__ __forceinline__ T* opqp(T* p) { asm volatile("" : "+s"(p)); return p; }
__device__ __forceinline__ float silu_f(float x) { return x / (1.f + expf(-x)); }

__device__ __forceinline__ void sincos_d(double a, double& s, double& c) {
    const double k = rint(a * 0.63661977236758134308);
    double r = a - k * 1.57079632679489655800e+00; r -= k * 6.12323399573676603587e-17;
    const double r2 = r * r;
    double sp = 1.0 / 121645100408832000.0;
    sp = sp * r2 - 1.0 / 355687428096000.0; sp = sp * r2 + 1.0 / 1307674368000.0; sp = sp * r2 - 1.0 / 6227020800.0; sp = sp * r2 + 1.0 / 39916800.0;
    sp = sp * r2 - 1.0 / 362880.0; sp = sp * r2 + 1.0 / 5040.0; sp = sp * r2 - 1.0 / 120.0; sp = sp * r2 + 1.0 / 6.0; sp = -sp * r2 + 1.0;
    const double sr = r * sp;
    double cp = 1.0 / 6402373705728000.0;
    cp = cp * r2 - 1.0 / 20922789888000.0; cp = cp * r2 + 1.0 / 87178291200.0; cp = cp * r2 - 1.0 / 479001600.0; cp = cp * r2 + 1.0 / 3628800.0;
    cp = cp * r2 - 1.0 / 40320.0; cp = cp * r2 + 1.0 / 720.0; cp = cp * r2 - 1.0 / 24.0; cp = cp * r2 + 0.5; const double cr = 1.0 - cp * r2;
    const int q = ((int)k) & 3;
    s = (q == 0) ? sr : (q == 1) ? cr : (q == 2) ? -sr : -cr;
    c = (q == 0) ? cr : (q == 1) ? -sr : (q == 2) ? -cr : sr;
}
constexpr int RT_R64 = 0, RT_C64 = 2048, RT_R32 = 3072, RT_C32 = 4096, RT_N = 4608;

namespace pg8 {
#define PG8_LAS __attribute__((address_space(3)))
typedef unsigned short bf16_t;
typedef short bf16x8 __attribute__((ext_vector_type(8)));
typedef float f32x4 __attribute__((ext_vector_type(4)));
typedef unsigned u32x4 __attribute__((ext_vector_type(4)));
constexpr int BM = 256, BK = 64, HALF = 128, HTB = HALF * BK * 2  , STAGE_BYTES = 8 * HTB, NXCD = 8, WGM = 8;

__host__ __device__ __forceinline__ int lds_byte(int r, int c) { const int st = (r >> 4) * 2 + (c >> 5), rr = r & 15, cc = c & 31, ob = rr * 64 + cc * 2; return st * 1024 + (ob ^ (((ob >> 9) & 1) << 5)); }
__host__ __device__ __forceinline__ void stage_rc(int b, int& R, int& C) { const int st = b / 1024, sb = b % 1024, swz = sb ^ (((sb >> 9) & 1) << 5); R = (st >> 1) * 16 + swz / 64; C = (st & 1) * 32 + (swz % 64) / 2; }
__host__ __device__ __forceinline__ int perm32(int rho) { const int n = rho >> 4, i = rho & 15; return 8 * (i >> 2) + 4 * n + (i & 3); }

struct Unit { int pm, pn, e; };
struct Gemm { const bf16_t* A; const bf16_t* Bt; int K; size_t estride; };

struct StaticOrder {
    int nM, nN, nwg, G, c; const int* texp;
    __host__ __device__ void init(int nM_, int nN_, int G_, int c_, const int* texp_) { nM = nM_; nN = nN_; nwg = nM * nN; G = G_; c = c_; texp = texp_; }
    __host__ __device__ bool next(int i, Unit& u) const {
        const long L = (long)i * G + c; if (L >= nwg) return false;
        int wgid = (int)L; { const int q = nwg / NXCD, r = nwg % NXCD, xcd = wgid % NXCD, off = wgid / NXCD; wgid = (xcd < r ? xcd * (q + 1) : r * (q + 1) + (xcd - r) * q) + off; }
        const int nig = WGM * nN, gid = wgid / nig, fm = gid * WGM, gsz = (nM - fm) < WGM ? (nM - fm) : WGM;
        u.pm = fm + ((wgid % nig) % gsz); u.pn = (wgid % nig) / gsz; u.e = texp ? texp[u.pm] : 0; return true;
    }
    __device__ __forceinline__ void a_ready(const Unit&) const {}
    __device__ __forceinline__ void done(const Unit&) const {}
};

template <class Epi, class Sched, bool ALIGN_EPI = false, bool SP2 = false>
__device__ __forceinline__ void gemm_phase(PG8_LAS unsigned char* lds, const Gemm g, const Sched& S, const Epi& E) {
    const int tid = opq((int)threadIdx.x), wid = __builtin_amdgcn_readfirstlane(tid >> 6), lane = tid & 63, wr = wid >> 2, wc = wid & 3, fr = lane & 15, fq = lane >> 4;
    const int K = g.K, nt = K / BK;
    unsigned voffA[2], voffB[2];
#pragma unroll
    for (int i = 0; i < 2; ++i) { int R, C; stage_rc(tid * 16 + i * 8192, R, C); const int Rb = Epi::PERM ? ((R & ~31) + perm32(R & 31)) : R;
        voffA[i] = (unsigned)(R * K + C) * 2u; voffB[i] = (unsigned)(Rb * K + C) * 2u; }
    const size_t kstep = (size_t)(BK * 2);
    const size_t hstep = (size_t)HALF * K * 2;
    const size_t tstep = 2 * hstep;
    const unsigned ldsw = (unsigned)wid * 1024u;
    const int aoff = lds_byte(wr * 64 + fr, fq * 8), boff = lds_byte(wc * 32 + fr, fq * 8);
#define PG8_SA(b, h) (((b) * 2 + (h)) * HTB)
#define PG8_SB(b, h) ((4 + (b) * 2 + (h)) * HTB)
#define PG8_STAGE(bufoff, gbase, voff) do { _Pragma("unroll") for (int _i = 0; _i < 2; ++_i) \
        __builtin_amdgcn_global_load_lds((const unsigned*)((const char*)(gbase) + (voff)[_i]), (PG8_LAS unsigned*)(lds + (bufoff) + ldsw + _i * 8192), 16, 0, 0); } while (0)
#define PG8_LDA(dst, b, h) do { _Pragma("unroll") for (int m = 0; m < 4; ++m) _Pragma("unroll") for (int k = 0; k < 2; ++k) dst[m][k] = *(const PG8_LAS bf16x8*)(lds + PG8_SA(b, h) + aoff + m * 2048 + k * 1024); } while (0)
#define PG8_LDB(dst, b, h) do { _Pragma("unroll") for (int n = 0; n < 2; ++n) _Pragma("unroll") for (int k = 0; k < 2; ++k) dst[n][k] = *(const PG8_LAS bf16x8*)(lds + PG8_SB(b, h) + boff + n * 2048 + k * 1024); } while (0)
#define PG8_MMA(ai, bj, At, Bt) do { __builtin_amdgcn_s_setprio(1); _Pragma("unroll") for (int m = 0; m < 4; ++m) _Pragma("unroll") for (int n = 0; n < 2; ++n) _Pragma("unroll") for (int k = 0; k < 2; ++k) \
        acc[ai][bj][m][n] = __builtin_amdgcn_mfma_f32_16x16x32_bf16(Bt[n][k], At[m][k], acc[ai][bj][m][n], 0, 0, 0); __builtin_amdgcn_s_setprio(0); } while (0)
#define PG8_WAIT_V(n) asm volatile("s_waitcnt vmcnt(" #n ")" ::: "memory")
#define PG8_WAIT_L(n) asm volatile("s_waitcnt lgkmcnt(" #n ")" ::: "memory")
#define PG8_BAR __builtin_amdgcn_s_barrier()
#define PG8_SCHED __builtin_amdgcn_sched_barrier(0)
    Unit cur, nxt; int ui = 0;
    if (!S.next(0, cur)) return;
    f32x4 acc[2][2][4][2];
#pragma unroll
    for (int a = 0; a < 2; ++a)
#pragma unroll
        for (int b = 0; b < 2; ++b)
#pragma unroll
            for (int m = 0; m < 4; ++m)
#pragma unroll
                for (int n = 0; n < 2; ++n) acc[a][b][m][n] = (f32x4){0.f, 0.f, 0.f, 0.f};
    bf16x8 At[4][2], B0[2][2], B1[2][2];
    const char* cA = (const char*)g.A + (size_t)cur.pm * tstep; const char* cB = (const char*)g.Bt + (size_t)cur.e * g.estride + (size_t)cur.pn * tstep;
    S.a_ready(cur);
    if constexpr (SP2) {
        PG8_STAGE(PG8_SB(0, 0), cB, voffB); PG8_STAGE(PG8_SB(0, 1), cB + hstep, voffB); PG8_STAGE(PG8_SA(0, 0), cA, voffA); PG8_STAGE(PG8_SA(0, 1), cA + hstep, voffA);
        if (wr == 1) PG8_BAR;
        PG8_WAIT_V(2); PG8_BAR;
        PG8_STAGE(PG8_SB(1, 0), cB + kstep, voffB); PG8_STAGE(PG8_SA(1, 0), cA + kstep, voffA); PG8_STAGE(PG8_SB(1, 1), cB + hstep + kstep, voffB);
        PG8_WAIT_V(6); PG8_BAR;
    } else {
        PG8_STAGE(PG8_SB(0, 0), cB, voffB); PG8_STAGE(PG8_SA(0, 0), cA, voffA); PG8_STAGE(PG8_SB(0, 1), cB + hstep, voffB); PG8_STAGE(PG8_SA(0, 1), cA + hstep, voffA);
        if (wr == 1) PG8_BAR;
        PG8_WAIT_V(4); PG8_BAR;
        PG8_STAGE(PG8_SB(1, 0), cB + kstep, voffB); PG8_STAGE(PG8_SA(1, 0), cA + kstep, voffA); PG8_STAGE(PG8_SB(1, 1), cB + hstep + kstep, voffB);
        PG8_WAIT_V(6); PG8_BAR;
    }
    for (;;) {
        const bool has_next = S.next(ui + 1, nxt);
        const char* nA = has_next ? (const char*)g.A + (size_t)nxt.pm * tstep : cA; const char* nB = has_next ? (const char*)g.Bt + (size_t)nxt.e * g.estride + (size_t)nxt.pn * tstep : cB;
        for (int t = 0; t < nt; t += 2) {
            const bool last = (t == nt - 2);
            const char* a1 = cA + (size_t)(t + 1) * kstep;
            const char* a2 = last ? nA : cA + (size_t)(t + 2) * kstep; const char* b2 = last ? nB : cB + (size_t)(t + 2) * kstep;
            const char* a3 = a2 + kstep; const char* b3 = b2 + kstep;
            if (last && has_next) S.a_ready(nxt);
            if constexpr (SP2) {
            PG8_LDB(B0, 0, 0); PG8_LDB(B1, 0, 1); PG8_SCHED; PG8_LDA(At, 0, 0); PG8_STAGE(PG8_SA(1, 1), a1 + hstep, voffA);
            PG8_WAIT_V(8); PG8_WAIT_L(0); PG8_BAR; PG8_MMA(0, 0, At, B0); PG8_MMA(0, 1, At, B1); PG8_BAR; PG8_SCHED;
            PG8_LDA(At, 0, 1); PG8_STAGE(PG8_SB(0, 0), b2, voffB); PG8_STAGE(PG8_SB(0, 1), b2 + hstep, voffB); PG8_STAGE(PG8_SA(0, 0), a2, voffA);
            PG8_WAIT_V(8); PG8_WAIT_L(0); PG8_BAR; PG8_MMA(1, 0, At, B0); PG8_MMA(1, 1, At, B1); PG8_BAR; PG8_SCHED;
            PG8_LDB(B0, 1, 0); PG8_LDB(B1, 1, 1); PG8_SCHED; PG8_LDA(At, 1, 0); PG8_STAGE(PG8_SA(0, 1), a2 + hstep, voffA);
            PG8_WAIT_V(8); PG8_WAIT_L(0); PG8_BAR; PG8_MMA(0, 0, At, B0); PG8_MMA(0, 1, At, B1); PG8_BAR; PG8_SCHED;
            PG8_LDA(At, 1, 1); PG8_STAGE(PG8_SB(1, 0), b3, voffB); PG8_STAGE(PG8_SB(1, 1), b3 + hstep, voffB); PG8_STAGE(PG8_SA(1, 0), a3, voffA);
            PG8_WAIT_V(8); PG8_WAIT_L(0); PG8_BAR; PG8_MMA(1, 0, At, B0); PG8_MMA(1, 1, At, B1); PG8_BAR; PG8_SCHED;
            } else {
            PG8_LDB(B0, 0, 0); PG8_SCHED; PG8_LDA(At, 0, 0); PG8_STAGE(PG8_SA(1, 1), a1 + hstep, voffA);
            PG8_WAIT_L(8); PG8_BAR; PG8_WAIT_L(0); PG8_MMA(0, 0, At, B0); PG8_BAR; PG8_SCHED;
            PG8_LDB(B1, 0, 1); PG8_STAGE(PG8_SB(0, 0), b2, voffB);
            PG8_BAR; PG8_WAIT_L(0); PG8_MMA(0, 1, At, B1); PG8_BAR;
            PG8_LDA(At, 0, 1); PG8_STAGE(PG8_SA(0, 0), a2, voffA);
            PG8_BAR; PG8_WAIT_L(0); PG8_MMA(1, 0, At, B0); PG8_BAR; PG8_SCHED;
            PG8_STAGE(PG8_SB(0, 1), b2 + hstep, voffB);
            PG8_WAIT_V(6); PG8_BAR; PG8_MMA(1, 1, At, B1); PG8_BAR;
            PG8_LDB(B0, 1, 0); PG8_SCHED; PG8_LDA(At, 1, 0); PG8_STAGE(PG8_SA(0, 1), a2 + hstep, voffA);
            PG8_WAIT_L(8); PG8_BAR; PG8_WAIT_L(0); PG8_MMA(0, 0, At, B0); PG8_BAR; PG8_SCHED;
            PG8_LDB(B1, 1, 1); PG8_STAGE(PG8_SB(1, 0), b3, voffB);
            PG8_BAR; PG8_WAIT_L(0); PG8_MMA(0, 1, At, B1); PG8_BAR;
            PG8_LDA(At, 1, 1); PG8_STAGE(PG8_SA(1, 0), a3, voffA);
            PG8_BAR; PG8_WAIT_L(0); PG8_MMA(1, 0, At, B0); PG8_BAR; PG8_SCHED;
            PG8_STAGE(PG8_SB(1, 1), b3 + hstep, voffB);
            PG8_WAIT_V(6); PG8_BAR; PG8_MMA(1, 1, At, B1); PG8_BAR;
            }
        }
        if constexpr (ALIGN_EPI) { if (wr == 0) PG8_BAR; }
        if constexpr (!Epi::AFTER_DRAIN) { E(acc, cur, wr, wc, fr, fq); S.done(cur); }
        if (!has_next) break;
#pragma unroll
        for (int a = 0; a < 2; ++a)
#pragma unroll
            for (int b = 0; b < 2; ++b)
#pragma unroll
                for (int m = 0; m < 4; ++m)
#pragma unroll
                    for (int n = 0; n < 2; ++n) acc[a][b][m][n] = (f32x4){0.f, 0.f, 0.f, 0.f};
        cur = nxt; cA = nA; cB = nB; ++ui;
        if constexpr (ALIGN_EPI) { if (wr == 1) PG8_BAR; }
    }
    PG8_WAIT_V(0);
    if constexpr (!ALIGN_EPI) { if (wr == 0) PG8_BAR; }
    PG8_BAR;
    if constexpr (Epi::AFTER_DRAIN) { E.fused(acc, cur, wr, wc, fr, fq, lds, wid, lane); S.done(cur); }
#undef PG8_SA
#undef PG8_SB
#undef PG8_STAGE
#undef PG8_LDA
#undef PG8_LDB
#undef PG8_MMA
#undef PG8_WAIT_V
#undef PG8_WAIT_L
#undef PG8_BAR
#undef PG8_SCHED
}
}

#define GAS __attribute__((address_space(1)))
#define LAS __attribute__((address_space(3)))
typedef GAS unsigned gu32;
#define RLX_AGENT __ATOMIC_RELAXED, __HIP_MEMORY_SCOPE_AGENT
constexpr int NWAVES = 8;
constexpr int CW_BAR = 4096;
constexpr int RING_BYTES = 131072, LDSCTL_OFF = RING_BYTES, MISC_OFF = LDSCTL_OFF + 320, LDS_BYTES = 147456;
constexpr size_t CTL_ZERO_BYTES = 65536;

#define XB_TMO      128
#define XB_XCNT(j)  (256  + 64 * (j))
#define XB_XSUB(j)  (1280 + 64 * (j))
#define XB_XGEN(j)  (2304 + 64 * (j))
#define XB_TOP      3328
#define XB_TOPGEN   3392
#define XCD_BAR_WORDS 3456
#define XB_SPIN_CAP (1u << 18)

__device__ __forceinline__ unsigned xb_ld(unsigned* p)              { return __hip_atomic_load(p, __ATOMIC_RELAXED, __HIP_MEMORY_SCOPE_AGENT); }
__device__ __forceinline__ unsigned xb_add(unsigned* p, unsigned v) { return __hip_atomic_fetch_add(p, v, __ATOMIC_RELAXED, __HIP_MEMORY_SCOPE_AGENT); }
__device__ __forceinline__ unsigned xb_xcc_id() { return (unsigned)__builtin_amdgcn_s_getreg((3 << 11) | 20) & 0xFu; }
#define XB_SPIN(cond, bar) do { unsigned _sp = 0; while (cond) { __builtin_amdgcn_s_sleep(1); \
    if ((++_sp & 255u) == 0u) { if (xb_ld(&(bar)[XB_TMO])) break; if (_sp > XB_SPIN_CAP) { atomicAdd(&(bar)[XB_TMO], 1u); break; } } } } while (0)

struct XcdBarrier {
    unsigned* bar; unsigned x;
    volatile LAS unsigned* st;
};

__device__ __forceinline__ XcdBarrier xcd_barrier_post(unsigned* bar, volatile LAS unsigned* st) {
    XcdBarrier b; b.bar = bar; b.x = xb_xcc_id(); b.st = st;
    if (threadIdx.x == 0) (void)xb_add(&bar[XB_XCNT(b.x)], 1u);
    return b;
}
__device__ __forceinline__ void xcd_barrier_complete(unsigned* bar, unsigned x, unsigned& nloc, unsigned& nx) {
    const unsigned G = gridDim.x * gridDim.y * gridDim.z;
    unsigned sum, cnt, mine, sp = 0u;
    for (;;) {
        sum = 0u; cnt = 0u; mine = 0u;
#pragma unroll
        for (unsigned j = 0; j < 16; ++j) { const unsigned c = xb_ld(&bar[XB_XCNT(j)]); sum += c; cnt += (c > 0u) ? 1u : 0u; mine = (j == x) ? c : mine; }
        if (sum == G) break;
        __builtin_amdgcn_s_sleep(1);
        if ((++sp & 255u) == 0u) { if (xb_ld(&bar[XB_TMO])) break; if (sp > XB_SPIN_CAP) { atomicAdd(&bar[XB_TMO], 1u); break; } }
    }
    nloc = mine > 0u ? mine : 1u; nx = cnt > 0u ? cnt : 1u;
}

__device__ __forceinline__ void xcd_barrier(const XcdBarrier& b) {
    asm volatile("s_waitcnt vmcnt(0)" ::: "memory");
    __syncthreads();
    if (threadIdx.x == 0) {
        unsigned* bar = b.bar;
        __builtin_amdgcn_s_waitcnt(0);
        unsigned nloc = b.st[0], nx = b.st[1];
        if (nloc == 0u) { xcd_barrier_complete(bar, b.x, nloc, nx); b.st[0] = nloc; b.st[1] = nx; }
        const unsigned old = xb_add(&bar[XB_XSUB(b.x)], 1u);
        const unsigned gen = old / nloc;
        if (old + 1u == (gen + 1u) * nloc) {
            __builtin_amdgcn_fence(__ATOMIC_RELEASE, "agent");
            asm volatile("s_waitcnt vmcnt(0)" ::: "memory");
            const unsigned og = xb_add(&bar[XB_TOP], 1u);
            const unsigned tg = og / nx;
            if (og + 1u == (tg + 1u) * nx) xb_add(&bar[XB_TOPGEN], 1u);
            else XB_SPIN(xb_ld(&bar[XB_TOPGEN]) == tg, bar);
            __builtin_amdgcn_fence(__ATOMIC_ACQUIRE, "agent");
            xb_add(&bar[XB_XGEN(b.x)], 1u);
            asm volatile("s_waitcnt vmcnt(0)" ::: "memory");
        } else {
            XB_SPIN(xb_ld(&bar[XB_XGEN(b.x)]) == gen, bar);
            __builtin_amdgcn_fence(__ATOMIC_ACQUIRE, "agent");
            asm volatile("s_waitcnt vmcnt(0)" ::: "memory");
        }
    }
    __syncthreads();
}


template <class F> struct EpiAdapt {
    static constexpr bool PERM = false, AFTER_DRAIN = false; F f;
    __device__ __forceinline__ void operator()(const pg8::f32x4 (&acc)[2][2][4][2], const pg8::Unit& u, int wr, int wc, int fr, int fq) const {
#pragma unroll
        for (int ai = 0; ai < 2; ++ai)
#pragma unroll
            for (int m = 0; m < 4; ++m) { const int row = u.pm * 256 + ai * 128 + wr * 64 + m * 16 + fr;
#pragma unroll
                for (int bj = 0; bj < 2; ++bj) f(row, u.pn * 8 + bj * 4 + wc, fq, acc[ai][bj][m][0], acc[ai][bj][m][1]);
                asm volatile("" ::: "memory"); }
    }
};
struct EpiBf16Perm { bf16_t* O; int ldo; int pad;
    __device__ __forceinline__ void operator()(int row, int g, int fq, f32x4 v0, f32x4 v1) const {
        u32x4 w; w.x = pk2(v0.x, v0.y); w.y = pk2(v0.z, v0.w); w.z = pk2(v1.x, v1.y); w.w = pk2(v1.z, v1.w);
        *(u32x4*)(O + (size_t)row * ldo + 32 * g + 8 * fq) = w; } };
struct EpiResid { const float* hl_in; const float* hc_in; float* hl_out; float* hc_out; const float* mod; int goff; int pad;
    __device__ __forceinline__ void operator()(int row, int g, int fq, f32x4 v0, f32x4 v1) const {
        const int c0 = 32 * g + 4 * fq; const float* hin; float* hout; const float* gv;
        if (row < TL) { hin = hl_in + (size_t)row * D; hout = hl_out + (size_t)row * D; gv = mod + (row / SEQ) * 6144 + goff; }
        else { hin = hc_in + (size_t)(row - TL) * D; hout = hc_out + (size_t)(row - TL) * D; gv = mod + 2 * 6144 + goff; }
        *(f32x4*)(hout + c0) = *(const f32x4*)(hin + c0) + *(const f32x4*)(gv + c0) * v0;
        *(f32x4*)(hout + c0 + 16) = *(const f32x4*)(hin + c0 + 16) + *(const f32x4*)(gv + c0 + 16) * v1; } };
struct EpiSwiglu { bf16_t* H; int ldh; int pad;
    __device__ __forceinline__ void operator()(int row, int g, int fq, f32x4 v0, f32x4 v1) const {
        u32x2 w; w.x = pk2(silu_f(v0.x) * v1.x, silu_f(v0.y) * v1.y); w.y = pk2(silu_f(v0.z) * v1.z, silu_f(v0.w) * v1.w);
        *(u32x2*)(H + (size_t)row * ldh + 16 * g + 4 * fq) = w; } };

template <class F> __device__ __forceinline__ void run_gemm(LAS unsigned char* lds, const bf16_t* A, const bf16_t* Bt, int K, int nM, int nN, const int* texp, size_t estride_bytes, const F& f) {
    pg8::Gemm g{A, Bt, K, estride_bytes}; pg8::StaticOrder S; S.init(nM, nN, (int)gridDim.x, (int)blockIdx.x, texp);
    EpiAdapt<F> E{f};
    pg8::gemm_phase<EpiAdapt<F>, pg8::StaticOrder, true, true>(lds, g, S, E);
}

__device__ __forceinline__ float conv_src(const Params& p, int mode, const float* W0, const float* W1, int N, int nvalid, int k, int nb) {
    if (mode == 0) return W0[(size_t)k * N + nb];
    if (mode == 1) { const int col = (nb & ~31) + 8 * ((nb >> 2) & 3) + 4 * ((nb >> 4) & 1) + (nb & 3); return col < nvalid ? W0[(size_t)k * N + col] : 0.f; }
    const int col = 16 * (nb >> 5) + (nb & 15); return ((nb >> 4) & 1) ? W1[(size_t)k * N + col] : W0[(size_t)k * N + col];
}
constexpr int CT_WIN = 0, CT_WOUT = 1152, CT_WUQ = 1664, CT_WUKV = 1700, CT_WFGU = 1732, CT_WFDN = 3140, CT_WMGU = 3844, CT_WMDN = 18180, CT_END = 25348;
constexpr int IT_MODS = 192, IT_ROPE = 9, IT_TOTAL = IT_MODS + IT_ROPE + CT_END;
__device__ __forceinline__ void ph_prologue(const Params& p, float* lds) {
    const int tid = opq((int)threadIdx.x);
    for (int it = blockIdx.x; it < IT_TOTAL; it += gridDim.x) {
        if (it < IT_MODS) {
            const int l = it / 96, n0 = (it % 96) * 64, nn = tid & 63, kc = tid >> 6;
            float* sv = lds; float* red = lds + 3 * 1024;
            __syncthreads();
            for (int i = tid; i < 3 * 1024; i += 512) { const int v = i >> 10, k = i & 1023; const float x = (v < 2) ? p.in[1][v * D + k] : p.in[3][k]; sv[i] = silu_f(x); }
            __syncthreads();
            const float* w = p.in[4] + ((size_t)l * D + kc * 128) * 6144 + n0 + nn;
            float a0 = 0.f, a1 = 0.f, a2 = 0.f;
#pragma unroll 8
            for (int k = 0; k < 128; ++k) { const float wv = w[(size_t)k * 6144]; a0 += sv[kc * 128 + k] * wv; a1 += sv[1024 + kc * 128 + k] * wv; a2 += sv[2048 + kc * 128 + k] * wv; }
            red[(kc * 3 + 0) * 64 + nn] = a0; red[(kc * 3 + 1) * 64 + nn] = a1; red[(kc * 3 + 2) * 64 + nn] = a2;
            __syncthreads();
            if (tid < 192) { const int v = tid >> 6; float s = p.in[5][l * 6144 + n0 + nn];
#pragma unroll
                for (int q = 0; q < 8; ++q) s += red[(q * 3 + v) * 64 + nn];
                ((float*)(p.ws + WS_MOD))[((size_t)l * 3 + v) * 6144 + n0 + nn] = s; }
        } else if (it < IT_MODS + IT_ROPE) {
            const int idx = (it - IT_MODS) * 512 + tid;
            if (idx < RT_N) {
                int pos, i, nf;
                if (idx < RT_C64) { pos = idx / 16; i = idx % 16; nf = 16; }
                else if (idx < RT_R32) { pos = (idx - RT_C64) / 16; i = idx % 16; nf = 16; }
                else if (idx < RT_C32) { pos = (idx - RT_R32) / 8; i = idx % 8; nf = 8; }
                else { pos = (idx - RT_C32) / 8; i = idx % 8; nf = 8; }
                const float inv = powf(10000.0f, -(float)i / (float)nf);
                const float ang = (float)pos * inv;
                double s, c; sincos_d((double)ang, s, c);
                ((float2*)(p.ws + WS_ROPE))[idx] = make_float2((float)c, (float)s);
            }
        } else {
            int t = it - IT_MODS - IT_ROPE;
            bf16_t* dst; const float* W0; const float* W1 = nullptr; int K, N, nvalid = 0, mode, ktl;
            if (t < CT_WOUT) { const int l = t / 576; t %= 576; dst = (bf16_t*)(p.ws + WS_WIN) + (size_t)l * NINP * D; W0 = p.in[8] + (size_t)l * D * NIN; K = D; N = NIN; nvalid = NIN; mode = 1; }
            else if (t < CT_WUQ) { t -= CT_WOUT; const int l = t / 256; t %= 256; dst = (bf16_t*)(p.ws + WS_WOUT) + (size_t)l * D * D; W0 = p.in[24] + (size_t)l * D * D; K = D; N = D; mode = 0; }
            else if (t < CT_WUKV) { t -= CT_WUQ; const int l = t / 18; t %= 18; dst = (bf16_t*)(p.ws + WS_WUQ) + (size_t)l * 384 * 192; W0 = p.in[18] + (size_t)l * 192 * 384; K = 192; N = 384; mode = 0; }
            else if (t < CT_WFGU) { t -= CT_WUKV; const int l = t / 16; t %= 16; dst = (bf16_t*)(p.ws + WS_WUKV) + (size_t)l * 512 * 128; W0 = p.in[20] + (size_t)l * 128 * 512; K = 128; N = 512; mode = 0; }
            else if (t < CT_WFDN) { t -= CT_WFGU; dst = (bf16_t*)(p.ws + WS_WFGU); W0 = p.in[25]; W1 = p.in[26]; K = D; N = DFF; mode = 2; }
            else if (t < CT_WMGU) { t -= CT_WFDN; dst = (bf16_t*)(p.ws + WS_WFDN); W0 = p.in[27]; K = DFF; N = D; mode = 0; }
            else if (t < CT_WMDN) { t -= CT_WMGU; const int e = t / 1792; t %= 1792; dst = (bf16_t*)(p.ws + WS_WMGU) + (size_t)e * 2 * DFFE * D; W0 = p.in[29] + (size_t)e * D * DFFE; W1 = p.in[30] + (size_t)e * D * DFFE; K = D; N = DFFE; mode = 2; }
            else { t -= CT_WMDN; const int e = t / 896; t %= 896; dst = (bf16_t*)(p.ws + WS_WMDN) + (size_t)e * D * DFFE; W0 = p.in[31] + (size_t)e * DFFE * D; K = DFFE; N = D; nvalid = D; mode = 1; }
            ktl = K / 64; const int n0 = (t / ktl) * 64, k0 = (t % ktl) * 64;
            __syncthreads();
#pragma unroll
            for (int r = 0; r < 8; ++r) { const int i = (tid >> 6) + 8 * r, j = tid & 63; lds[i * 65 + j] = conv_src(p, mode, W0, W1, N, nvalid, k0 + i, n0 + j); }
            __syncthreads();
            const int n = tid >> 3, kc = (tid & 7) * 8;
            u32x4 o; o.x = pk2(lds[(kc + 0) * 65 + n], lds[(kc + 1) * 65 + n]); o.y = pk2(lds[(kc + 2) * 65 + n], lds[(kc + 3) * 65 + n]);
            o.z = pk2(lds[(kc + 4) * 65 + n], lds[(kc + 5) * 65 + n]); o.w = pk2(lds[(kc + 6) * 65 + n], lds[(kc + 7) * 65 + n]);
            *(u32x4*)(dst + (size_t)(n0 + n) * K + k0 + kc) = o;
        }
    }
    __syncthreads();
}

template <int WHICH, bool ROUTER> __device__ __forceinline__ void ph_norm(const Params& p, int layer, int nrows) {
    const int tx = opq((int)threadIdx.x), lane = tx & 63, gw = (blockIdx.x * 512 + tx) >> 6, ngw = (gridDim.x * 512) >> 6;
    const float* hl = (layer == 0 && WHICH == 1) ? p.in[0] : p.out;
    const float* hc = (layer == 0 && WHICH == 1) ? p.in[2] : (const float*)(p.ws + WS_HCTX);
    const float* gain = p.in[WHICH == 1 ? 6 : 7] + layer * D;
    const float* mod = (const float*)(p.ws + WS_MOD) + (size_t)layer * 3 * 6144;
    bf16_t* dst = (bf16_t*)(p.ws + WS_ACT1);
    for (int m = gw; m < nrows; m += ngw) {
        const float* src = (m < TL) ? hl + (size_t)m * D : hc + (size_t)(m - TL) * D;
        const float* mv = mod + (m < TL ? m / SEQ : 2) * 6144;
        const float* shp = mv + (WHICH == 1 ? 0 : 3) * D; const float* scp = mv + (WHICH == 1 ? 1 : 4) * D;
        f32x4 v[4]; float ss = 0.f;
#pragma unroll
        for (int j = 0; j < 4; ++j) { v[j] = *(const f32x4*)(src + 256 * j + 4 * lane); ss += v[j].x * v[j].x + v[j].y * v[j].y + v[j].z * v[j].z + v[j].w * v[j].w; }
        const float rstd = rsqrtf(wave_sum(ss) * (1.f / D) + EPS);
        float lg[8];
#pragma unroll
        for (int e = 0; e < 8; ++e) lg[e] = 0.f;
#pragma unroll
        for (int j = 0; j < 4; ++j) {
            const int c = 256 * j + 4 * lane;
            const f32x4 g = *(const f32x4*)(gain + c), sh = *(const f32x4*)(shp + c), sc = *(const f32x4*)(scp + c);
            f32x4 f = v[j] * rstd * g * (sc + 1.f) + sh;
            u32x2 w; w.x = pk2(f.x, f.y); w.y = pk2(f.z, f.w);
            *(u32x2*)(dst + (size_t)m * D + c) = w;
            if (ROUTER) {
                const float* rt = p.in[28] + (size_t)c * 8;
#pragma unroll
                for (int i = 0; i < 4; ++i) { const f32x4 r0 = *(const f32x4*)(rt + 8 * i), r1 = *(const f32x4*)(rt + 8 * i + 4); const float fv = f[i];
                    lg[0] += fv * r0.x; lg[1] += fv * r0.y; lg[2] += fv * r0.z; lg[3] += fv * r0.w; lg[4] += fv * r1.x; lg[5] += fv * r1.y; lg[6] += fv * r1.z; lg[7] += fv * r1.w; }
            }
        }
        if (ROUTER) {
#pragma unroll
            for (int e = 0; e < 8; ++e) lg[e] = wave_sum(lg[e]);
            if (lane == 0) {
                int e0 = 0; float v0 = lg[0];
#pragma unroll
                for (int e = 1; e < 8; ++e) if (lg[e] > v0) { v0 = lg[e]; e0 = e; }
                int e1 = -1; float v1 = -INFINITY;
#pragma unroll
                for (int e = 0; e < 8; ++e) if (e != e0 && lg[e] > v1) { v1 = lg[e]; e1 = e; }
                const float t = expf(v1 - v0), g0 = 1.f / (1.f + t), g1 = t / (1.f + t);
                unsigned* cnt = (unsigned*)(p.ws + WS_CTL);
                const int p0 = (int)atomicAdd(cnt + e0, 1u), p1 = (int)atomicAdd(cnt + e1, 1u);
                ((int2*)(p.ws + WS_TOKE))[m] = make_int2(e0, e1); ((int2*)(p.ws + WS_TOKP))[m] = make_int2(p0, p1); ((float2*)(p.ws + WS_TOKG))[m] = make_float2(g0, g1);
            }
        }
    }
}


typedef short pp_bf16x8 __attribute__((ext_vector_type(8)));
__device__ __forceinline__ float quad_sum(float v) { v += swz_xor<1>(v); v += swz_xor<2>(v); return v; }
__device__ __forceinline__ float kg_sum(float v) { v += swz_xor<16>(v); return half_sum(v); }
constexpr float QS64 = 0.125f * 1.4426950408889634f, QS96 = 0.10206207261596575f * 1.4426950408889634f;

template <int HS> __device__ __forceinline__ void pp_head(const Params& p, const QKVB& qb, int layer, const bf16_t* prow, bool lat, int b, int s, int key, int sub,
                                                          const float2 (&rr)[4], const float2 (&rc)[4]) {
    constexpr bool ISV = HS >= 20;
    constexpr int col = HS < 4 ? OFF_AQ + 64 * HS : HS < 6 ? OFF_AK + 64 * (HS - 4) : HS < 10 ? OFF_BQ + 64 * (HS - 6) : HS < 12 ? OFF_BK + 64 * (HS - 10) : HS < 16 ? OFF_CQ + 64 * (HS - 12) :
                        HS < 20 ? OFF_CK + 64 * (HS - 16) : HS < 22 ? OFF_AV + 64 * (HS - 20) : HS < 24 ? OFF_BV + 64 * (HS - 22) : OFF_CV + 64 * (HS - 24);
    constexpr bool ISQ = HS < 4 || (HS >= 6 && HS < 10) || (HS >= 12 && HS < 16);
    constexpr bool ROPE = HS < 12;
    constexpr int GIN = HS < 4 ? 9 : HS < 6 ? 10 : HS < 10 ? 12 : HS < 12 ? 13 : HS < 16 ? 14 : 15;
    bf16_t* dst;
    if (HS < 4) dst = lat ? qb.QA + ((size_t)(b * 4 + HS) * SEQ + s) * 64 : qb.QAc + ((size_t)(b * 4 + HS) * CTX + s) * 64;
    else if (HS < 6) dst = qb.KA + ((size_t)(b * 2 + HS - 4) * KEYS + key) * 64;
    else if (HS < 10) dst = lat ? qb.QB + ((size_t)(b * 4 + HS - 6) * SEQ + s) * 64 : qb.QBc + ((size_t)(b * 4 + HS - 6) * CTX + s) * 64;
    else if (HS < 12) dst = qb.KB + ((size_t)(b * 2 + HS - 10) * KEYS + key) * 64;
    else if (HS < 16) dst = lat ? qb.QC + ((size_t)(b * 4 + HS - 12) * SEQ + s) * 64 : qb.QCc + ((size_t)(b * 4 + HS - 12) * CTX + s) * 64;
    else if (HS < 20) dst = qb.KC + ((size_t)(b * 4 + HS - 16) * KEYS + key) * 64;
    else if (HS < 22) dst = qb.VA + ((size_t)(b * 2 + HS - 20) * KEYS + key) * 64;
    else if (HS < 24) dst = qb.VB + ((size_t)(b * 2 + HS - 22) * KEYS + key) * 64;
    else dst = qb.VC + ((size_t)(b * 4 + HS - 24) * KEYS + key) * 64;
    u32x2 w[4];
#pragma unroll
    for (int c = 0; c < 4; ++c) w[c] = *(const u32x2*)(prow + col + 16 * c + 4 * sub);
    if (!ISV) {
        f32x4 x[4]; float ss = 0.f;
#pragma unroll
        for (int c = 0; c < 4; ++c) { x[c] = (f32x4){bflo(w[c].x), bfhi(w[c].x), bflo(w[c].y), bfhi(w[c].y)}; ss += x[c].x * x[c].x + x[c].y * x[c].y + x[c].z * x[c].z + x[c].w * x[c].w; }
        const float r = rsqrtf(quad_sum(ss) * (1.f / 64.f) + EPS) * (ISQ ? QS64 : 1.f);
        const float* g = p.in[GIN] + layer * 64 + 4 * sub;
#pragma unroll
        for (int c = 0; c < 4; ++c) x[c] = x[c] * r * *(const f32x4*)(g + 16 * c);
        if (ROPE && lat) {
#pragma unroll
            for (int i = 0; i < 4; ++i) { const float a = x[0][i], bq = x[1][i]; x[0][i] = a * rr[i].x - bq * rr[i].y; x[1][i] = bq * rr[i].x + a * rr[i].y;
                const float c1 = x[2][i], c2 = x[3][i]; x[2][i] = c1 * rc[i].x - c2 * rc[i].y; x[3][i] = c2 * rc[i].x + c1 * rc[i].y; }
        }
#pragma unroll
        for (int c = 0; c < 4; ++c) { w[c].x = pk2(x[c].x, x[c].y); w[c].y = pk2(x[c].z, x[c].w); }
    }
#pragma unroll
    for (int c = 0; c < 4; ++c) *(u32x2*)(dst + 16 * c + 4 * sub) = w[c];
}
template <int HS> struct PPHeads { static __device__ __forceinline__ void run(const Params& p, const QKVB& qb, int layer, const bf16_t* prow, bool lat, int b, int s, int key, int sub, const float2 (&rr)[4], const float2 (&rc)[4]) {
    pp_head<HS>(p, qb, layer, prow, lat, b, s, key, sub, rr, rc); PPHeads<HS + 1>::run(p, qb, layer, prow, lat, b, s, key, sub, rr, rc); } };
template <> struct PPHeads<28> { static __device__ __forceinline__ void run(const Params&, const QKVB&, int, const bf16_t*, bool, int, int, int, int, const float2 (&)[4], const float2 (&)[4]) {} };

__device__ __forceinline__ void f8_from_bf(const u32x4 v, float (&x)[8]) { x[0] = bflo(v.x); x[1] = bfhi(v.x); x[2] = bflo(v.y); x[3] = bfhi(v.y); x[4] = bflo(v.z); x[5] = bfhi(v.z); x[6] = bflo(v.w); x[7] = bfhi(v.w); }

__device__ __forceinline__ void ph_postproj2(const Params& p, int layer) {
    const int tx = opq((int)threadIdx.x), lane = tx & 63, gw = (tx >> 6) * gridDim.x + blockIdx.x, ngw = gridDim.x * 8;
    const bf16_t* P = (const bf16_t*)(p.ws + WS_P);
    const QKVB qb = make_qkv(p.ws);
    const bf16_t* Wuq = (const bf16_t*)(p.ws + WS_WUQ) + (size_t)layer * 384 * 192;
    const bf16_t* Wukv = (const bf16_t*)(p.ws + WS_WUKV) + (size_t)layer * 512 * 128;
    const float2* rope = (const float2*)(p.ws + WS_ROPE);
    for (int u = gw; u < MALL / 16; u += ngw) {
        const int m0 = u * 16; const bool lat = m0 < TL;
        {
            const int t = lane >> 2, sub = lane & 3, m = m0 + t;
            const int b = lat ? m / SEQ : (m - TL) / CTX, s = lat ? m % SEQ : (m - TL) % CTX, key = lat ? CTX + s : s;
            float2 rr[4], rc[4];
#pragma unroll
            for (int i = 0; i < 4; ++i) { rr[i] = lat ? rope[RT_R64 + (s >> 6) * 16 + 4 * sub + i] : make_float2(1.f, 0.f); rc[i] = lat ? rope[RT_C64 + (s & 63) * 16 + 4 * sub + i] : make_float2(1.f, 0.f); }
            PPHeads<0>::run(p, qb, layer, P + (size_t)m * NINP, lat, b, s, key, sub, rr, rc);
        }
        {
            const int tk = lane & 15, kg = lane >> 4, m = m0 + tk;
            const int b = lat ? m / SEQ : (m - TL) / CTX, s = lat ? m % SEQ : (m - TL) % CTX, key = lat ? CTX + s : s;
            const bf16_t* prow = P + (size_t)m * NINP;
            pp_bf16x8 aq[6];
            { float x[6][8]; float ss = 0.f;
#pragma unroll
                for (int ks = 0; ks < 6; ++ks) { f8_from_bf(*(const u32x4*)(prow + OFF_DCQ + 32 * ks + 8 * kg), x[ks]);
#pragma unroll
                    for (int j = 0; j < 8; ++j) ss += x[ks][j] * x[ks][j]; }
                const float r = rsqrtf(kg_sum(ss) * (1.f / 192.f) + EPS);
                const float* g = p.in[17] + layer * 192 + 8 * kg;
#pragma unroll
                for (int ks = 0; ks < 6; ++ks) { const f32x4 g0 = *(const f32x4*)(g + 32 * ks), g1 = *(const f32x4*)(g + 32 * ks + 4);
                    u32x4 w; w.x = pk2(x[ks][0] * r * g0.x, x[ks][1] * r * g0.y); w.y = pk2(x[ks][2] * r * g0.z, x[ks][3] * r * g0.w); w.z = pk2(x[ks][4] * r * g1.x, x[ks][5] * r * g1.y); w.w = pk2(x[ks][6] * r * g1.z, x[ks][7] * r * g1.w);
                    aq[ks] = __builtin_bit_cast(pp_bf16x8, w); } }
            float2 qr_[4], qc_[4];
#pragma unroll
            for (int reg = 0; reg < 4; ++reg) { const int i = (4 * kg + reg) & 7; qr_[reg] = lat ? rope[RT_R32 + (s >> 6) * 8 + i] : make_float2(1.f, 0.f); qc_[reg] = lat ? rope[RT_C32 + (s & 63) * 8 + i] : make_float2(1.f, 0.f); }
#pragma unroll 1
            for (int h = 0; h < 4; ++h) {
                f32x4 acc[6];
#pragma unroll
                for (int nb = 0; nb < 6; ++nb) { acc[nb] = (f32x4){0.f, 0.f, 0.f, 0.f};
                    const bf16_t* wp = Wuq + (size_t)(96 * h + 16 * nb + tk) * 192 + 8 * kg;
#pragma unroll
                    for (int ks = 0; ks < 6; ++ks) acc[nb] = __builtin_amdgcn_mfma_f32_16x16x32_bf16(*(const pp_bf16x8*)(wp + 32 * ks), aq[ks], acc[nb], 0, 0, 0); }
                float ss = 0.f;
#pragma unroll
                for (int nb = 0; nb < 6; ++nb) ss += acc[nb].x * acc[nb].x + acc[nb].y * acc[nb].y + acc[nb].z * acc[nb].z + acc[nb].w * acc[nb].w;
                const float r = rsqrtf(kg_sum(ss) * (1.f / 96.f) + EPS) * QS96;
                const float* g = p.in[21] + layer * 96 + 4 * kg;
                bf16_t* dst = (lat ? qb.QD + ((size_t)(b * 4 + h) * SEQ + s) * 96 : qb.QDc + ((size_t)(b * 4 + h) * CTX + s) * 96) + 4 * kg;
#pragma unroll
                for (int nb = 0; nb < 6; ++nb) { f32x4 y = acc[nb] * r * *(const f32x4*)(g + 16 * nb);
                    if (nb >= 4 && lat) {
#pragma unroll
                        for (int reg = 0; reg < 4; ++reg) { const float other = half_other(y[reg], lane); const float2 cs = nb == 4 ? qr_[reg] : qc_[reg];
                            y[reg] = (kg < 2) ? y[reg] * cs.x - other * cs.y : y[reg] * cs.x + other * cs.y; } }
                    u32x2 w; w.x = pk2(y.x, y.y); w.y = pk2(y.z, y.w); *(u32x2*)(dst + 16 * nb) = w; }
            }
            pp_bf16x8 akv[4];
            { float x[4][8]; float ss = 0.f;
#pragma unroll
                for (int ks = 0; ks < 4; ++ks) { f8_from_bf(*(const u32x4*)(prow + OFF_DCKV + 32 * ks + 8 * kg), x[ks]);
#pragma unroll
                    for (int j = 0; j < 8; ++j) ss += x[ks][j] * x[ks][j]; }
                const float r = rsqrtf(kg_sum(ss) * (1.f / 128.f) + EPS);
                const float* g = p.in[19] + layer * 128 + 8 * kg;
#pragma unroll
                for (int ks = 0; ks < 4; ++ks) { const f32x4 g0 = *(const f32x4*)(g + 32 * ks), g1 = *(const f32x4*)(g + 32 * ks + 4);
                    u32x4 w; w.x = pk2(x[ks][0] * r * g0.x, x[ks][1] * r * g0.y); w.y = pk2(x[ks][2] * r * g0.z, x[ks][3] * r * g0.w); w.z = pk2(x[ks][4] * r * g1.x, x[ks][5] * r * g1.y); w.w = pk2(x[ks][6] * r * g1.z, x[ks][7] * r * g1.w);
                    akv[ks] = __builtin_bit_cast(pp_bf16x8, w); } }
            float kr[8]; f8_from_bf(*(const u32x4*)(prow + OFF_DKR + 8 * kg), kr);
            float krss = 0.f;
#pragma unroll
            for (int j = 0; j < 8; ++j) krss += kr[j] * kr[j];
            float2 kcs[8];
#pragma unroll
            for (int j = 0; j < 8; ++j) kcs[j] = !lat ? make_float2(1.f, 0.f) : (kg < 2 ? rope[RT_R32 + (s >> 6) * 8 + j] : rope[RT_C32 + (s & 63) * 8 + j]);
#pragma unroll 1
            for (int h = 0; h < 4; ++h) {
                f32x4 acc[8];
#pragma unroll
                for (int nb = 0; nb < 8; ++nb) { acc[nb] = (f32x4){0.f, 0.f, 0.f, 0.f};
                    const bf16_t* wp = Wukv + (size_t)(128 * h + 16 * nb + tk) * 128 + 8 * kg;
#pragma unroll
                    for (int ks = 0; ks < 4; ++ks) acc[nb] = __builtin_amdgcn_mfma_f32_16x16x32_bf16(*(const pp_bf16x8*)(wp + 32 * ks), akv[ks], acc[nb], 0, 0, 0); }
                float ss = krss;
#pragma unroll
                for (int nb = 0; nb < 4; ++nb) ss += acc[nb].x * acc[nb].x + acc[nb].y * acc[nb].y + acc[nb].z * acc[nb].z + acc[nb].w * acc[nb].w;
                const float r = rsqrtf(kg_sum(ss) * (1.f / 96.f) + EPS);
                const float* g = p.in[22] + layer * 96;
                bf16_t* kd = qb.KD + ((size_t)(b * 4 + h) * KEYS + key) * 96; bf16_t* vd = qb.VD + ((size_t)(b * 4 + h) * KEYS + key) * 64;
#pragma unroll
                for (int nb = 0; nb < 4; ++nb) { const f32x4 y = acc[nb] * r * *(const f32x4*)(g + 16 * nb + 4 * kg); u32x2 w; w.x = pk2(y.x, y.y); w.y = pk2(y.z, y.w); *(u32x2*)(kd + 16 * nb + 4 * kg) = w; }
                { float y[8];
#pragma unroll
                    for (int j = 0; j < 8; ++j) y[j] = kr[j] * r * g[64 + 8 * kg + j];
#pragma unroll
                    for (int j = 0; j < 8; ++j) { const float other = swz_xor<16>(y[j]); y[j] = (kg & 1) == 0 ? y[j] * kcs[j].x - other * kcs[j].y : y[j] * kcs[j].x + other * kcs[j].y; }
                    u32x4 w; w.x = pk2(y[0], y[1]); w.y = pk2(y[2], y[3]); w.z = pk2(y[4], y[5]); w.w = pk2(y[6], y[7]); *(u32x4*)(kd + 64 + 8 * kg) = w; }
#pragma unroll
                for (int nb = 4; nb < 8; ++nb) { const f32x4 y = acc[nb]; u32x2 w; w.x = pk2(y.x, y.y); w.y = pk2(y.z, y.w); *(u32x2*)(vd + 16 * (nb - 4) + 4 * kg) = w; }
            }
        }
    }
}

namespace fa {
typedef short bf16x8 __attribute__((ext_vector_type(8)));
typedef short s16x4 __attribute__((ext_vector_type(4)));
typedef float f32x16 __attribute__((ext_vector_type(16)));
typedef __attribute__((address_space(3))) const char* lds_cptr;
typedef short v4i16_t __attribute__((ext_vector_type(4)));
constexpr int KSTG = 12288, VSTG = 8192, STG = KSTG + VSTG;
constexpr int LDS_WS = 2 * STG, LDS_OST = LDS_WS + 8 * 256, LDS_RPB = LDS_OST + 8 * 4096, LDS_TOTAL = LDS_RPB + 2048;
constexpr float LOG2E = 1.4426950408889634f;
constexpr float THR = 6.0f;
__device__ __forceinline__ int crow(int r, int hi) { return (r & 3) + 8 * (r >> 2) + 4 * hi; }
__device__ __forceinline__ void glds16(const void* gsrc, unsigned lds_dst) { unsigned keep;
    asm volatile("s_mov_b32 %0, m0\n\ts_mov_b32 m0, %2\n\ts_nop 0\n\tglobal_load_lds_dwordx4 %1, off\n\ts_mov_b32 m0, %0" : "=&s"(keep) : "v"(gsrc), "s"(lds_dst) : "memory"); }
__device__ __forceinline__ s16x4 vtr(lds_cptr p) { return __builtin_bit_cast(s16x4, __builtin_amdgcn_ds_read_tr16_b64_v4i16((__attribute__((address_space(3))) v4i16_t*)p)); }
typedef float f32x2_t __attribute__((ext_vector_type(2))); typedef __bf16 bf16x2_t __attribute__((ext_vector_type(2)));
__device__ __forceinline__ unsigned cvtpk(float lo, float hi) { f32x2_t v = {lo, hi}; bf16x2_t b = __builtin_convertvector(v, bf16x2_t); return __builtin_bit_cast(unsigned, b); }
__device__ __forceinline__ float xhalf_max(float m) { auto rr = __builtin_amdgcn_permlane32_swap(__float_as_uint(m), __float_as_uint(m), false, false); return fmaxf(__uint_as_float(rr[0]), __uint_as_float(rr[1])); }
__device__ __forceinline__ float xhalf_sum(float m) { auto rr = __builtin_amdgcn_permlane32_swap(__float_as_uint(m), __float_as_uint(m), false, false); return __uint_as_float(rr[0]) + __uint_as_float(rr[1]); }
#define FA_WAIT_BAR() asm volatile("s_waitcnt vmcnt(0) lgkmcnt(0)\n\ts_barrier" ::: "memory")

template <int DQK, int MODE>
__device__ __forceinline__ void attn_unit(const bf16_t* Qg, const bf16_t* Kg, const bf16_t* Vg, bf16_t* Og, int q0, float sink2, const float* rpb, char* shm) {
    const int tid = opq((int)threadIdx.x), lane = tid & 63, r32 = lane & 31, hi = lane >> 5; const int wid = __builtin_amdgcn_readfirstlane(tid >> 6);
    const unsigned lds0 = (unsigned)(uintptr_t)shm;
    float* wsf = (float*)(shm + LDS_WS) + wid * 64;
    constexpr int NCH = DQK / 8, ND0 = DQK / 16;
    int NT, wbase = 0;
    if (MODE == 0) NT = KEYS / 64; else if (MODE == 3) NT = 4;
    else if (MODE == 1) { wbase = max(0, q0 - 128); const int we = min(SEQ, q0 + 256 + 128); NT = 4 + (we - wbase) / 64; }
    else { const int r0 = q0 >> 6; wbase = min(max(r0 - 4, 0), 120); const int kre = min(max(r0 - 1, 0), 120) + 8; NT = 4 + (kre - wbase); }
#define FA_KEY0(t) ((MODE == 0 || MODE == 3 || (t) < 4) ? 64 * (t) : (MODE == 1 ? CTX + wbase + 64 * ((t) - 4) : CTX + (wbase + (t) - 4) * 64))
    const bf16_t* ksrc = Kg + (size_t)lane * DQK; const bf16_t* vsrc = Vg + (size_t)(16 * (wid & 3) + (lane >> 2)) * 64 + (wid >> 2) * 32 + (lane & 3) * 8;
#define FA_DMA(t, s) do { const int k0_ = FA_KEY0(t); \
        _Pragma("unroll") for (int c_ = 0; c_ < 2; ++c_) { const int ch_ = wid + 8 * c_; if (ch_ < NCH) glds16(ksrc + (size_t)k0_ * DQK + ch_ * 8, (unsigned)__builtin_amdgcn_readfirstlane(lds0 + (s) * STG + ch_ * 1024)); } \
        glds16(vsrc + (size_t)k0_ * 64, (unsigned)__builtin_amdgcn_readfirstlane(lds0 + (s) * STG + KSTG + wid * 1024)); } while (0)
    FA_DMA(0, 0);
    if (MODE == 2) { float* rp = (float*)(shm + LDS_RPB); for (int i = tid; i < 15 * 31; i += 512) rp[i] = rpb[i] * LOG2E; }
    bf16x8 qr[ND0];
#pragma unroll
    for (int d0 = 0; d0 < ND0; ++d0) qr[d0] = *reinterpret_cast<const bf16x8*>(Qg + (size_t)(wid * 32 + r32) * DQK + d0 * 16 + hi * 8);
    float mhat = -1e30f, l_reg = 0.f; f32x16 o[2];
#pragma unroll
    for (int r = 0; r < 16; ++r) { o[0][r] = 0.f; o[1][r] = 0.f; }
    const int qpos = q0 + wid * 32 + r32;
    const int rq = (q0 >> 6) + (wid >> 1), jq = 32 * (wid & 1) + r32;
    const int rs = min(max(rq - 4, 0), 120), cs = min(max(jq - 8, 0), 48);
    const lds_cptr shm3 = (lds_cptr)shm;
    FA_WAIT_BAR();
    for (int t = 0; t < NT; ++t) {
        const int s = t & 1;
        if (t + 1 < NT) FA_DMA(t + 1, s ^ 1);
        bool active = true;
        if (MODE == 1 && t >= 4) { const int kp0 = wbase + 64 * (t - 4), qw0 = q0 + wid * 32; active = (kp0 + 63 >= qw0 - 128) && (kp0 <= qw0 + 31 + 128); }
        if (MODE == 2 && t >= 4) { const int kr = wbase + t - 4; active = (kr >= rs) && (kr < rs + 8); }
        if (active) {
            const lds_cptr kb = shm3 + s * STG + hi * 1024 + r32 * 16;
            f32x16 p0, p1;
#pragma unroll
            for (int r = 0; r < 16; ++r) { p0[r] = 0.f; p1[r] = 0.f; }
#pragma unroll
            for (int d0 = 0; d0 < ND0; ++d0) {
                const bf16x8 b0 = *(const __attribute__((address_space(3))) bf16x8*)(kb + d0 * 2048);
                const bf16x8 b1 = *(const __attribute__((address_space(3))) bf16x8*)(kb + d0 * 2048 + 512);
                p0 = __builtin_amdgcn_mfma_f32_32x32x16_bf16(b0, qr[d0], p0, 0, 0, 0);
                p1 = __builtin_amdgcn_mfma_f32_32x32x16_bf16(b1, qr[d0], p1, 0, 0, 0);
            }
            if (MODE == 1 && t >= 4) { const int kp0 = wbase + 64 * (t - 4) - qpos;
#pragma unroll
                for (int r = 0; r < 16; ++r) { const int d0_ = kp0 + crow(r, hi), d1_ = d0_ + 32; if (d0_ < -128 || d0_ > 128) p0[r] = -INFINITY; if (d1_ < -128 || d1_ > 128) p1[r] = -INFINITY; } }
            if (MODE == 2 && t >= 4) { const int kr = wbase + t - 4; const float* rp = (const float*)(shm + LDS_RPB) + (kr - rq + 7) * 31 + 15 - jq;
#pragma unroll
                for (int r = 0; r < 16; ++r) { const int kc0 = crow(r, hi), kc1 = kc0 + 32;
                    const bool v0 = (kc0 >= cs) && (kc0 < cs + 16), v1 = (kc1 >= cs) && (kc1 < cs + 16);
                    p0[r] = v0 ? p0[r] + rp[v0 ? kc0 : jq] : -INFINITY; p1[r] = v1 ? p1[r] + rp[v1 ? kc1 : jq] : -INFINITY; } }
            float rm = fmaxf(p0[0], p1[0]);
#pragma unroll
            for (int r = 1; r < 16; ++r) rm = fmaxf(rm, fmaxf(p0[r], p1[r]));
            rm = xhalf_max(rm);
            if (__any(rm - mhat > THR)) {
                const float mn = fmaxf(mhat, rm), f = __builtin_amdgcn_exp2f(mhat - mn); mhat = mn; l_reg *= f;
                if (hi == 0) wsf[r32] = f;
#pragma unroll
                for (int r = 0; r < 16; ++r) { const float fr = wsf[crow(r, hi)]; o[0][r] *= fr; o[1][r] *= fr; }
            }
            float sacc = 0.f;
#pragma unroll
            for (int r = 0; r < 16; ++r) { p0[r] = __builtin_amdgcn_exp2f(p0[r] - mhat); p1[r] = __builtin_amdgcn_exp2f(p1[r] - mhat); sacc += p0[r] + p1[r]; }
            l_reg += sacc;
            u32x4 pw0, pw1, pw2, pw3;
            pw0 = (u32x4){cvtpk(p0[0], p0[1]), cvtpk(p0[2], p0[3]), cvtpk(p0[4], p0[5]), cvtpk(p0[6], p0[7])};
            pw1 = (u32x4){cvtpk(p0[8], p0[9]), cvtpk(p0[10], p0[11]), cvtpk(p0[12], p0[13]), cvtpk(p0[14], p0[15])};
            pw2 = (u32x4){cvtpk(p1[0], p1[1]), cvtpk(p1[2], p1[3]), cvtpk(p1[4], p1[5]), cvtpk(p1[6], p1[7])};
            pw3 = (u32x4){cvtpk(p1[8], p1[9]), cvtpk(p1[10], p1[11]), cvtpk(p1[12], p1[13]), cvtpk(p1[14], p1[15])};
            const lds_cptr vp = shm3 + s * STG + KSTG + ((lane >> 4) & 1) * 32 + (lane & 3) * 8 + (4 * hi + ((lane & 15) >> 2)) * 64;
#pragma unroll
            for (int dh = 0; dh < 2; ++dh) {
                s16x4 vlo[4], vhi[4];
#pragma unroll
                for (int ks = 0; ks < 4; ++ks) { vlo[ks] = vtr(vp + dh * 4096 + ks * 1024); vhi[ks] = vtr(vp + dh * 4096 + ks * 1024 + 512); }
#define FA_VFR(k) (bf16x8){vlo[k][0], vlo[k][1], vlo[k][2], vlo[k][3], vhi[k][0], vhi[k][1], vhi[k][2], vhi[k][3]}
                o[dh] = __builtin_amdgcn_mfma_f32_32x32x16_bf16(__builtin_bit_cast(bf16x8, pw0), FA_VFR(0), o[dh], 0, 0, 0);
                o[dh] = __builtin_amdgcn_mfma_f32_32x32x16_bf16(__builtin_bit_cast(bf16x8, pw1), FA_VFR(1), o[dh], 0, 0, 0);
                o[dh] = __builtin_amdgcn_mfma_f32_32x32x16_bf16(__builtin_bit_cast(bf16x8, pw2), FA_VFR(2), o[dh], 0, 0, 0);
                o[dh] = __builtin_amdgcn_mfma_f32_32x32x16_bf16(__builtin_bit_cast(bf16x8, pw3), FA_VFR(3), o[dh], 0, 0, 0);
#undef FA_VFR
            }
        }
        FA_WAIT_BAR();
    }
    l_reg = xhalf_sum(l_reg);
    if (MODE == 1 || MODE == 3) l_reg += __builtin_amdgcn_exp2f(sink2 - mhat);
    if (hi == 0) wsf[32 + r32] = 1.0f / l_reg;
    float rli[16];
#pragma unroll
    for (int r = 0; r < 16; ++r) rli[r] = wsf[32 + crow(r, hi)];
    bf16_t* stg = (bf16_t*)(shm + LDS_OST) + wid * 2048;
#pragma unroll
    for (int r = 0; r < 16; ++r) { const int orow = crow(r, hi);
#pragma unroll
        for (int dh = 0; dh < 2; ++dh) stg[orow * 64 + dh * 32 + r32] = (bf16_t)f2bf(o[dh][r] * rli[r]); }
#pragma unroll
    for (int i = 0; i < 4; ++i) { const int row = i * 8 + (lane >> 3), ch = lane & 7; const u32x4 v = *(const u32x4*)(stg + row * 64 + ch * 8); *(u32x4*)(Og + (size_t)(wid * 32 + row) * D + ch * 8) = v; }
    asm volatile("s_waitcnt lgkmcnt(0)\n\ts_barrier" ::: "memory");
#undef FA_DMA
#undef FA_KEY0
}
#undef FA_WAIT_BAR
}

constexpr float SCALE_MLA = 0.10206207261596575f;
__device__ __forceinline__ void ph_attn(const Params& p, int layer, bool with_ctx, char* shm) {
    const QKVB qb = make_qkv(p.ws);
    bf16_t* O = (bf16_t*)(p.ws + WS_P);
    const int G = gridDim.x;
    const float NEG = -INFINITY;
    for (int u = blockIdx.x; u < 256; u += G) { const int bh = u & 7, b = bh >> 2, h = bh & 3, qbk = u >> 3;
        fa::attn_unit<96, 0>(qb.QD + ((size_t)bh * SEQ + qbk * 256) * 96, qb.KD + (size_t)bh * KEYS * 96, qb.VD + (size_t)bh * KEYS * 64, O + (size_t)(b * SEQ + qbk * 256) * D + 768 + h * 64, qbk * 256, NEG, nullptr, shm); }
    for (int u = blockIdx.x; u < 256; u += G) { const int bh = u & 7, b = bh >> 2, h = bh & 3, qbk = u >> 3;
        fa::attn_unit<64, 0>(qb.QB + ((size_t)bh * SEQ + qbk * 256) * 64, qb.KB + (size_t)(b * 2 + (h >> 1)) * KEYS * 64, qb.VB + (size_t)(b * 2 + (h >> 1)) * KEYS * 64, O + (size_t)(b * SEQ + qbk * 256) * D + 256 + h * 64, qbk * 256, NEG, nullptr, shm); }
    for (int u = blockIdx.x; u < 256; u += G) { const int bh = u & 7, b = bh >> 2, h = bh & 3, qbk = u >> 3;
        fa::attn_unit<64, 1>(qb.QA + ((size_t)bh * SEQ + qbk * 256) * 64, qb.KA + (size_t)(b * 2 + (h >> 1)) * KEYS * 64, qb.VA + (size_t)(b * 2 + (h >> 1)) * KEYS * 64, O + (size_t)(b * SEQ + qbk * 256) * D + 0 + h * 64, qbk * 256, p.in[11][layer * 4 + h] * fa::LOG2E, nullptr, shm); }
    for (int u = blockIdx.x; u < 256; u += G) { const int bh = u & 7, b = bh >> 2, h = bh & 3, qbk = u >> 3;
        fa::attn_unit<64, 2>(qb.QC + ((size_t)bh * SEQ + qbk * 256) * 64, qb.KC + (size_t)bh * KEYS * 64, qb.VC + (size_t)bh * KEYS * 64, O + (size_t)(b * SEQ + qbk * 256) * D + 512 + h * 64, qbk * 256, NEG, p.in[16] + ((size_t)layer * 4 + h) * 15 * 31, shm); }
    if (with_ctx) for (int u = blockIdx.x; u < 32; u += G) { const int ty = u >> 3, bh = u & 7, b = bh >> 2, h = bh & 3;
        bf16_t* Oc = O + (size_t)(TL + b * CTX) * D + ty * 256 + h * 64;
        if (ty == 0) fa::attn_unit<64, 3>(qb.QAc + (size_t)bh * CTX * 64, qb.KA + (size_t)(b * 2 + (h >> 1)) * KEYS * 64, qb.VA + (size_t)(b * 2 + (h >> 1)) * KEYS * 64, Oc, 0, p.in[11][layer * 4 + h] * fa::LOG2E, nullptr, shm);
        else if (ty == 1) fa::attn_unit<64, 3>(qb.QBc + (size_t)bh * CTX * 64, qb.KB + (size_t)(b * 2 + (h >> 1)) * KEYS * 64, qb.VB + (size_t)(b * 2 + (h >> 1)) * KEYS * 64, Oc, 0, NEG, nullptr, shm);
        else if (ty == 2) fa::attn_unit<64, 3>(qb.QCc + (size_t)bh * CTX * 64, qb.KC + (size_t)bh * KEYS * 64, qb.VC + (size_t)bh * KEYS * 64, Oc, 0, NEG, nullptr, shm);
        else fa::attn_unit<96, 3>(qb.QDc + (size_t)bh * CTX * 96, qb.KD + (size_t)bh * KEYS * 96, qb.VD + (size_t)bh * KEYS * 64, Oc, 0, NEG, nullptr, shm); }
}

__device__ __forceinline__ void ph_gnorm(const Params& p, int layer, int nrows) {
    const int tx = opq((int)threadIdx.x), lane = tx & 63, gw = (blockIdx.x * 512 + tx) >> 6, ngw = (gridDim.x * 512) >> 6;
    const bf16_t* O = (const bf16_t*)(p.ws + WS_P); bf16_t* Y = (bf16_t*)(p.ws + WS_ACT1); const float* g = p.in[23] + layer * D;
    for (int m = gw; m < nrows; m += ngw) {
#pragma unroll
        for (int grp = 0; grp < 4; ++grp) { const int c = grp * 256 + 4 * lane; const u32x2 w = *(const u32x2*)(O + (size_t)m * D + c);
            const float a0 = bflo(w.x), a1 = bfhi(w.x), a2 = bflo(w.y), a3 = bfhi(w.y);
            const float r = rsqrtf(wave_sum(a0 * a0 + a1 * a1 + a2 * a2 + a3 * a3) * (1.f / 256.f) + EPS);
            const f32x4 gv = *(const f32x4*)(g + c); u32x2 o; o.x = pk2(a0 * r * gv.x, a1 * r * gv.y); o.y = pk2(a2 * r * gv.z, a3 * r * gv.w);
            *(u32x2*)(Y + (size_t)m * D + c) = o; }
    }
}

__device__ __forceinline__ void moe_bases(const unsigned* cnt, int (&base)[9]) {
    int acc = 0;
#pragma unroll
    for (int e = 0; e < 8; ++e) { base[e] = acc; acc += ((int)cnt[e] + 255) / 256 * 256; }
    base[8] = acc;
}
__device__ __forceinline__ void ph_moe_gather(const Params& p) {
    const int tx = opq((int)threadIdx.x), lane = tx & 63, gw = (blockIdx.x * 512 + tx) >> 6, ngw = (gridDim.x * 512) >> 6;
    const unsigned* cnt = (const unsigned*)(p.ws + WS_CTL); int base[9]; moe_bases(cnt, base);
    if (blockIdx.x == 0 && tx < 136) { const int r = tx * 256; int e = -1;
#pragma unroll
        for (int i = 0; i < 8; ++i) if (r >= base[i] && r < base[i + 1]) e = i;
        ((int*)(p.ws + WS_TEXP))[tx] = e < 0 ? 0 : e; }
    const bf16_t* F = (const bf16_t*)(p.ws + WS_ACT1); bf16_t* A = (bf16_t*)(p.ws + WS_ASORT);
    for (int m = gw; m < TL; m += ngw) {
        const int2 e = ((const int2*)(p.ws + WS_TOKE))[m]; const int2 ps = ((const int2*)(p.ws + WS_TOKP))[m];
        int b0 = 0, b1 = 0;
#pragma unroll
        for (int i = 0; i < 8; ++i) { if (e.x == i) b0 = base[i]; if (e.y == i) b1 = base[i]; }
        const int s0 = b0 + ps.x, s1 = b1 + ps.y;
        const u32x4 v0 = *(const u32x4*)(F + (size_t)m * D + lane * 16), v1 = *(const u32x4*)(F + (size_t)m * D + lane * 16 + 8);
        *(u32x4*)(A + (size_t)s0 * D + lane * 16) = v0; *(u32x4*)(A + (size_t)s0 * D + lane * 16 + 8) = v1;
        *(u32x4*)(A + (size_t)s1 * D + lane * 16) = v0; *(u32x4*)(A + (size_t)s1 * D + lane * 16 + 8) = v1;
        if (lane == 0) ((int2*)(p.ws + WS_TOKS))[m] = make_int2(s0, s1);
    }
}
__device__ __forceinline__ void ph_moe_combine(const Params& p, int layer) {
    const size_t nthr = (size_t)gridDim.x * 512;
    for (size_t idx = (size_t)blockIdx.x * 512 + opq((int)threadIdx.x); idx < (size_t)TL * 256; idx += nthr) {
        const int m = (int)(idx >> 8), c = (int)(idx & 255) * 4;
        const int2 sl = ((const int2*)(p.ws + WS_TOKS))[m]; const float2 g = ((const float2*)(p.ws + WS_TOKG))[m];
        const bf16_t* Y = (const bf16_t*)(p.ws + WS_ASORT);
        const u32x2 a = *(const u32x2*)(Y + (size_t)sl.x * D + c), b = *(const u32x2*)(Y + (size_t)sl.y * D + c);
        const f32x4 ya = {bflo(a.x), bfhi(a.x), bflo(a.y), bfhi(a.y)}, yb = {bflo(b.x), bfhi(b.x), bflo(b.y), bfhi(b.y)};
        const float* mod = (const float*)(p.ws + WS_MOD) + (size_t)layer * 3 * 6144 + (m / SEQ) * 6144 + 5 * D;
        f32x4* o = (f32x4*)(p.out + (size_t)m * D + c);
        *o = *o + *(const f32x4*)(mod + c) * (ya * g.x + yb * g.y);
    }
}

#ifndef DBL_PHASE
#define DBL_PHASE (-1)
#endif
struct Args { Params p; int ph_lo, ph_hi; };
__global__ void __launch_bounds__(NWAVES * 64, 2) mega_fwd(Args args) {
    extern __shared__ __attribute__((aligned(16))) unsigned char lds[];
    LAS unsigned char* ldsl = (LAS unsigned char*)lds;
    for (int u = threadIdx.x; u < (LDS_BYTES - LDSCTL_OFF) / 4; u += NWAVES * 64) ((LAS unsigned*)(ldsl + LDSCTL_OFF))[u] = 0u;
    __syncthreads();
    XcdBarrier bar = xcd_barrier_post((unsigned*)(args.p.ws + WS_CTL) + CW_BAR, (volatile LAS unsigned*)(ldsl + MISC_OFF) + 8);
    const int lo = args.ph_lo, hi = args.ph_hi; int ph = 0;
#define PHASE(body) do { if (lo <= ph && ph < hi) { Params q = args.p; q.ws = opqp(args.p.ws); q.out = opqp(args.p.out); LAS unsigned char* ldq = (LAS unsigned char*)lds; (void)ldq; for (int rep_ = 0; rep_ < ((ph == DBL_PHASE) ? 2 : 1); ++rep_) { if (rep_) xcd_barrier(bar); body; } if (ph + 1 < hi) xcd_barrier(bar); } ++ph; } while (0)
#define QMOD(l) ((const float*)(q.ws + WS_MOD) + (size_t)(l) * 3 * 6144)
    PHASE(ph_prologue(q, (float*)lds));
#pragma unroll 1
    for (int l = 0; l < 2; ++l) {
        const bool last = (l == 1);
        const int nrows = last ? TL : MALL;
        PHASE((ph_norm<1, false>(q, l, MALL)));
        PHASE(run_gemm(ldq, (const bf16_t*)(q.ws + WS_ACT1), (const bf16_t*)(q.ws + WS_WIN) + (size_t)l * NINP * D, D, MALL / 256, NINP / 256, nullptr, 0, EpiBf16Perm{(bf16_t*)(q.ws + WS_P), NINP, 0}));
        PHASE(ph_postproj2(q, l));
        PHASE(ph_attn(q, l, !last, (char*)lds));
        PHASE(ph_gnorm(q, l, nrows));
        PHASE(run_gemm(ldq, (const bf16_t*)(q.ws + WS_ACT1), (const bf16_t*)(q.ws + WS_WOUT) + (size_t)l * D * D, D, nrows / 256, D / 256, nullptr, 0,
                       EpiResid{(l == 0) ? q.in[0] : q.out, (l == 0) ? q.in[2] : (const float*)(q.ws + WS_HCTX), q.out, (float*)(q.ws + WS_HCTX), QMOD(l), 2 * D, 0}));
        if (!last) {
            PHASE((ph_norm<2, false>(q, l, MALL)));
            PHASE(run_gemm(ldq, (const bf16_t*)(q.ws + WS_ACT1), (const bf16_t*)(q.ws + WS_WFGU), D, MALL / 256, 2 * DFF / 256, nullptr, 0, EpiSwiglu{(bf16_t*)(q.ws + WS_HIDF), DFF, 0}));
            PHASE(run_gemm(ldq, (const bf16_t*)(q.ws + WS_HIDF), (const bf16_t*)(q.ws + WS_WFDN), DFF, MALL / 256, D / 256, nullptr, 0,
                           EpiResid{q.out, (const float*)(q.ws + WS_HCTX), q.out, (float*)(q.ws + WS_HCTX), QMOD(l), 5 * D, 0}));
        } else {
            PHASE((ph_norm<2, true>(q, l, TL)));
            PHASE(ph_moe_gather(q));
            PHASE({ int base[9]; moe_bases((const unsigned*)(q.ws + WS_CTL), base); run_gemm(ldq, (const bf16_t*)(q.ws + WS_ASORT), (const bf16_t*)(q.ws + WS_WMGU), D, base[8] / 256, 2 * DFFE / 256, (const int*)(q.ws + WS_TEXP), (size_t)2 * DFFE * D * 2, EpiSwiglu{(bf16_t*)(q.ws + WS_HIDM), DFFE, 0}); });
            PHASE({ int base[9]; moe_bases((const unsigned*)(q.ws + WS_CTL), base); run_gemm(ldq, (const bf16_t*)(q.ws + WS_HIDM), (const bf16_t*)(q.ws + WS_WMDN), DFFE, base[8] / 256, D / 256, (const int*)(q.ws + WS_TEXP), (size_t)D * DFFE * 2, EpiBf16Perm{(bf16_t*)(q.ws + WS_ASORT), D, 0}); });
            PHASE(ph_moe_combine(q, l));
        }
    }
#undef QMOD
#undef PHASE
}

#ifndef MK_CUTS
#define MK_CUTS 0
#endif
extern "C" void kernel_launch(void* const* d_in, const int* in_sizes, int n_in, void* d_out, int out_size, void* d_ws, size_t ws_size, hipStream_t stream) {
    static int grid = 0;
    if (grid == 0) {
        if (n_in != 32 || ws_size < WS_END) { fprintf(stderr, "kernel_launch: need 32 inputs and %zu bytes of workspace (got %d, %zu)\n", (size_t)WS_END, n_in, ws_size); grid = -1; return; }
        int dev = 0, cus = 0, per_cu = 0;
        if (hipGetDevice(&dev) != hipSuccess || hipDeviceGetAttribute(&cus, hipDeviceAttributeMultiprocessorCount, dev) != hipSuccess) { grid = -1; return; }
        if (hipFuncSetAttribute((const void*)mega_fwd, hipFuncAttributeMaxDynamicSharedMemorySize, LDS_BYTES) != hipSuccess) { fprintf(stderr, "kernel_launch: hipFuncSetAttribute failed\n"); grid = -1; return; }
        if (hipOccupancyMaxActiveBlocksPerMultiprocessor(&per_cu, (const void*)mega_fwd, NWAVES * 64, LDS_BYTES) != hipSuccess || per_cu < 1) fprintf(stderr, "kernel_launch: occupancy query says %d blocks per CU\n", per_cu);
        (void)hipGetLastError();
        grid = cus;
    }
    if (grid < 0) return;
    (void)hipMemsetAsync((char*)d_ws + WS_CTL, 0, CTL_ZERO_BYTES, stream);
    Args a{}; for (int i = 0; i < 32; ++i) a.p.in[i] = (const float*)d_in[i]; a.p.out = (float*)d_out; a.p.ws = (unsigned char*)d_ws;
#if MK_CUTS
    for (int ph = 0; ph < 24; ++ph) { a.ph_lo = ph; a.ph_hi = ph + 1; hipLaunchKernelGGL(mega_fwd, dim3(grid), dim3(NWAVES * 64), LDS_BYTES, stream, a); }
#else
    a.ph_lo = 0; a.ph_hi = 21;
    hipLaunchKernelGGL(mega_fwd, dim3(grid), dim3(NWAVES * 64), LDS_BYTES, stream, a);
#endif
}
```

```cpp
#include <hip/hip_runtime.h>
#include <stdint.h>
#include <cstdio>

typedef unsigned short bf16_t;
typedef float f32x4 __attribute__((ext_vector_type(4)));
typedef unsigned u32x4 __attribute__((ext_vector_type(4)));
typedef unsigned u32x2 __attribute__((ext_vector_type(2)));

constexpr int D = 1024, NB = 2, SEQ = 8192, CTX = 256, TL = NB * SEQ, TC = NB * CTX, MALL = TL + TC;
constexpr int NIN = 2144, NINP = 2304, DFF = 2816, NE = 8, DFFE = 3584, KEYS = CTX + SEQ;
constexpr int OFF_AQ = 0, OFF_AK = 256, OFF_AV = 384, OFF_BQ = 512, OFF_BK = 768, OFF_BV = 896, OFF_CQ = 1024, OFF_CK = 1280,
              OFF_CV = 1536, OFF_DCQ = 1792, OFF_DCKV = 1984, OFF_DKR = 2112;
constexpr int MOE_ROWS = 34816;
constexpr float EPS = 1e-6f;

constexpr size_t MiB = 1u << 20;
constexpr size_t WS_CTL = 0;
constexpr size_t WS_MOD = 1 * MiB;
constexpr size_t WS_ROPE = WS_MOD + 256 * 1024;
constexpr size_t WS_TOKE = WS_ROPE + 64 * 1024;
constexpr size_t WS_TOKP = WS_TOKE + TL * 8;
constexpr size_t WS_TOKG = WS_TOKP + TL * 8;
constexpr size_t WS_TEXP = WS_TOKG + TL * 8;
constexpr size_t WS_TOKS = WS_TEXP + 1024;
constexpr size_t WS_HCTX = 2 * MiB;
constexpr size_t WS_WMGU = 6 * MiB;
constexpr size_t WS_WMDN = WS_WMGU + 112 * MiB;
constexpr size_t WS_WDEAD = WS_WMDN + 56 * MiB;
constexpr size_t WS_WIN = WS_WDEAD;
constexpr size_t WS_WOUT = WS_WIN + 9 * MiB;
constexpr size_t WS_WUQ = WS_WOUT + 4 * MiB;
constexpr size_t WS_WUKV = WS_WUQ + 512 * 1024;
constexpr size_t WS_WFGU = WS_WUKV + 512 * 1024;
constexpr size_t WS_WFDN = WS_WFGU + 11 * MiB;
constexpr size_t WS_ACT = 205 * MiB;
static_assert(WS_WFDN + (size_t)1024 * 2816 * 2 <= WS_ACT, "weights fit");
constexpr size_t WS_ACT1 = WS_ACT;
constexpr size_t WS_P = WS_ACT + 33 * MiB;
constexpr size_t WS_QKV = WS_ACT + 108 * MiB;
constexpr size_t WS_HIDF = WS_P;
constexpr size_t WS_HIDM = WS_WDEAD;
constexpr size_t WS_ASORT = WS_HIDM + 238 * MiB;
constexpr size_t WS_END = WS_ASORT + 68 * MiB;
static_assert(WS_QKV + 91 * MiB <= WS_END, "qkv fits");

struct Params { const float* in[32]; float* out; unsigned char* ws; };

struct QKVB { bf16_t *QA, *KA, *VA, *QB, *KB, *VB, *QC, *KC, *VC, *QD, *KD, *VD, *QAc, *QBc, *QCc, *QDc; };
__host__ __device__ inline QKVB make_qkv(unsigned char* ws) {
    QKVB q; bf16_t* p = (bf16_t*)(ws + WS_QKV);
    q.QA = p; p += (size_t)NB * 4 * SEQ * 64; q.KA = p; p += (size_t)NB * 2 * KEYS * 64; q.VA = p; p += (size_t)NB * 2 * KEYS * 64;
    q.QB = p; p += (size_t)NB * 4 * SEQ * 64; q.KB = p; p += (size_t)NB * 2 * KEYS * 64; q.VB = p; p += (size_t)NB * 2 * KEYS * 64;
    q.QC = p; p += (size_t)NB * 4 * SEQ * 64; q.KC = p; p += (size_t)NB * 4 * KEYS * 64; q.VC = p; p += (size_t)NB * 4 * KEYS * 64;
    q.QD = p; p += (size_t)NB * 4 * SEQ * 96; q.KD = p; p += (size_t)NB * 4 * KEYS * 96; q.VD = p; p += (size_t)NB * 4 * KEYS * 64;
    q.QAc = p; p += (size_t)NB * 4 * CTX * 64; q.QBc = p; p += (size_t)NB * 4 * CTX * 64; q.QCc = p; p += (size_t)NB * 4 * CTX * 64;
    q.QDc = p; p += (size_t)NB * 4 * CTX * 96;
    return q;
}

__device__ __forceinline__ float bf2f(unsigned v) { return __uint_as_float(v << 16); }
__device__ __forceinline__ float bflo(unsigned w) { return __uint_as_float(w << 16); }
__device__ __forceinline__ float bfhi(unsigned w) { return __uint_as_float(w & 0xffff0000u); }
__device__ __forceinline__ unsigned f2bf(float f) { unsigned u = __float_as_uint(f); return (u + 0x7fffu + ((u >> 16) & 1u)) >> 16; }
__device__ __forceinline__ unsigned pk2(float lo, float hi) { return f2bf(lo) | (f2bf(hi) << 16); }
template <int X> __device__ __forceinline__ float swz_xor(float v) { return __int_as_float(__builtin_amdgcn_ds_swizzle(__float_as_int(v), 0x1f | (X << 10))); }
__device__ __forceinline__ float half_sum(float v) { auto rr = __builtin_amdgcn_permlane32_swap(__float_as_uint(v), __float_as_uint(v), false, false); return __uint_as_float(rr[0]) + __uint_as_float(rr[1]); }
__device__ __forceinline__ float half_other(float v, int lane) { auto rr = __builtin_amdgcn_permlane32_swap(__float_as_uint(v), __float_as_uint(v), false, false); return __uint_as_float((lane & 32) ? rr[0] : rr[1]); }
__device__ __forceinline__ float wave_sum(float v) { v += swz_xor<1>(v); v += swz_xor<2>(v); v += swz_xor<4>(v); v += swz_xor<8>(v); v += swz_xor<16>(v); return half_sum(v); }
__device__ __forceinline__ int opq(int v) { asm volatile("" : "+v"(v)); return v; }
template <class T> __device__ __forceinline__ T* opqp(T* p) { asm volatile("" : "+s"(p)); return p; }
__device__ __forceinline__ float silu_f(float x) { return x / (1.f + expf(-x)); }

__device__ __forceinline__ void sincos_d(double a, double& s, double& c) {
    const double k = rint(a * 0.63661977236758134308);
    double r = a - k * 1.57079632679489655800e+00; r -= k * 6.12323399573676603587e-17;
    const double r2 = r * r;
    double sp = 1.0 / 121645100408832000.0;
    sp = sp * r2 - 1.0 / 355687428096000.0; sp = sp * r2 + 1.0 / 1307674368000.0; sp = sp * r2 - 1.0 / 6227020800.0; sp = sp * r2 + 1.0 / 39916800.0;
    sp = sp * r2 - 1.0 / 362880.0; sp = sp * r2 + 1.0 / 5040.0; sp = sp * r2 - 1.0 / 120.0; sp = sp * r2 + 1.0 / 6.0; sp = -sp * r2 + 1.0;
    const double sr = r * sp;
    double cp = 1.0 / 6402373705728000.0;
    cp = cp * r2 - 1.0 / 20922789888000.0; cp = cp * r2 + 1.0 / 87178291200.0; cp = cp * r2 - 1.0 / 479001600.0; cp = cp * r2 + 1.0 / 3628800.0;
    cp = cp * r2 - 1.0 / 40320.0; cp = cp * r2 + 1.0 / 720.0; cp = cp * r2 - 1.0 / 24.0; cp = cp * r2 + 0.5; const double cr = 1.0 - cp * r2;
    const int q = ((int)k) & 3;
    s = (q == 0) ? sr : (q == 1) ? cr : (q == 2) ? -sr : -cr;
    c = (q == 0) ? cr : (q == 1) ? -sr : (q == 2) ? -cr : sr;
}
constexpr int RT_R64 = 0, RT_C64 = 2048, RT_R32 = 3072, RT_C32 = 4096, RT_N = 4608;

namespace pg8 {
#define PG8_LAS __attribute__((address_space(3)))
typedef unsigned short bf16_t;
typedef short bf16x8 __attribute__((ext_vector_type(8)));
typedef float f32x4 __attribute__((ext_vector_type(4)));
typedef unsigned u32x4 __attribute__((ext_vector_type(4)));
constexpr int BM = 256, BK = 64, HALF = 128, HTB = HALF * BK * 2  , STAGE_BYTES = 8 * HTB, NXCD = 8, WGM = 8;

__host__ __device__ __forceinline__ int lds_byte(int r, int c) { const int st = (r >> 4) * 2 + (c >> 5), rr = r & 15, cc = c & 31, ob = rr * 64 + cc * 2; return st * 1024 + (ob ^ (((ob >> 9) & 1) << 5)); }
__host__ __device__ __forceinline__ void stage_rc(int b, int& R, int& C) { const int st = b / 1024, sb = b % 1024, swz = sb ^ (((sb >> 9) & 1) << 5); R = (st >> 1) * 16 + swz / 64; C = (st & 1) * 32 + (swz % 64) / 2; }
__host__ __device__ __forceinline__ int perm32(int rho) { const int n = rho >> 4, i = rho & 15; return 8 * (i >> 2) + 4 * n + (i & 3); }

struct Unit { int pm, pn, e; };
struct Gemm { const bf16_t* A; const bf16_t* Bt; int K; size_t estride; };

struct StaticOrder {
    int nM, nN, nwg, G, c; const int* texp;
    __host__ __device__ void init(int nM_, int nN_, int G_, int c_, const int* texp_) { nM = nM_; nN = nN_; nwg = nM * nN; G = G_; c = c_; texp = texp_; }
    __host__ __device__ bool next(int i, Unit& u) const {
        const long L = (long)i * G + c; if (L >= nwg) return false;
        int wgid = (int)L; { const int q = nwg / NXCD, r = nwg % NXCD, xcd = wgid % NXCD, off = wgid / NXCD; wgid = (xcd < r ? xcd * (q + 1) : r * (q + 1) + (xcd - r) * q) + off; }
        const int nig = WGM * nN, gid = wgid / nig, fm = gid * WGM, gsz = (nM - fm) < WGM ? (nM - fm) : WGM;
        u.pm = fm + ((wgid % nig) % gsz); u.pn = (wgid % nig) / gsz; u.e = texp ? texp[u.pm] : 0; return true;
    }
    __device__ __forceinline__ void a_ready(const Unit&) const {}
    __device__ __forceinline__ void done(const Unit&) const {}
};

template <class Epi, class Sched, bool ALIGN_EPI = false, bool SP2 = false>
__device__ __forceinline__ void gemm_phase(PG8_LAS unsigned char* lds, const Gemm g, const Sched& S, const Epi& E) {
    const int tid = opq((int)threadIdx.x), wid = __builtin_amdgcn_readfirstlane(tid >> 6), lane = tid & 63, wr = wid >> 2, wc = wid & 3, fr = lane & 15, fq = lane >> 4;
    const int K = g.K, nt = K / BK;
    unsigned voffA[2], voffB[2];
#pragma unroll
    for (int i = 0; i < 2; ++i) { int R, C; stage_rc(tid * 16 + i * 8192, R, C); const int Rb = Epi::PERM ? ((R & ~31) + perm32(R & 31)) : R;
        voffA[i] = (unsigned)(R * K + C) * 2u; voffB[i] = (unsigned)(Rb * K + C) * 2u; }
    const size_t kstep = (size_t)(BK * 2);
    const size_t hstep = (size_t)HALF * K * 2;
    const size_t tstep = 2 * hstep;
    const unsigned ldsw = (unsigned)wid * 1024u;
    const int aoff = lds_byte(wr * 64 + fr, fq * 8), boff = lds_byte(wc * 32 + fr, fq * 8);
#define PG8_SA(b, h) (((b) * 2 + (h)) * HTB)
#define PG8_SB(b, h) ((4 + (b) * 2 + (h)) * HTB)
#define PG8_STAGE(bufoff, gbase, voff) do { _Pragma("unroll") for (int _i = 0; _i < 2; ++_i) \
        __builtin_amdgcn_global_load_lds((const unsigned*)((const char*)(gbase) + (voff)[_i]), (PG8_LAS unsigned*)(lds + (bufoff) + ldsw + _i * 8192), 16, 0, 0); } while (0)
#define PG8_LDA(dst, b, h) do { _Pragma("unroll") for (int m = 0; m < 4; ++m) _Pragma("unroll") for (int k = 0; k < 2; ++k) dst[m][k] = *(const PG8_LAS bf16x8*)(lds + PG8_SA(b, h) + aoff + m * 2048 + k * 1024); } while (0)
#define PG8_LDB(dst, b, h) do { _Pragma("unroll") for (int n = 0; n < 2; ++n) _Pragma("unroll") for (int k = 0; k < 2; ++k) dst[n][k] = *(const PG8_LAS bf16x8*)(lds + PG8_SB(b, h) + boff + n * 2048 + k * 1024); } while (0)
#define PG8_MMA(ai, bj, At, Bt) do { __builtin_amdgcn_s_setprio(1); _Pragma("unroll") for (int m = 0; m < 4; ++m) _Pragma("unroll") for (int n = 0; n < 2; ++n) _Pragma("unroll") for (int k = 0; k < 2; ++k) \
        acc[ai][bj][m][n] = __builtin_amdgcn_mfma_f32_16x16x32_bf16(Bt[n][k], At[m][k], acc[ai][bj][m][n], 0, 0, 0); __builtin_amdgcn_s_setprio(0); } while (0)
#define PG8_WAIT_V(n) asm volatile("s_waitcnt vmcnt(" #n ")" ::: "memory")
#define PG8_WAIT_L(n) asm volatile("s_waitcnt lgkmcnt(" #n ")" ::: "memory")
#define PG8_BAR __builtin_amdgcn_s_barrier()
#define PG8_SCHED __builtin_amdgcn_sched_barrier(0)
    Unit cur, nxt; int ui = 0;
    if (!S.next(0, cur)) return;
    f32x4 acc[2][2][4][2];
#pragma unroll
    for (int a = 0; a < 2; ++a)
#pragma unroll
        for (int b = 0; b < 2; ++b)
#pragma unroll
            for (int m = 0; m < 4; ++m)
#pragma unroll
                for (int n = 0; n < 2; ++n) acc[a][b][m][n] = (f32x4){0.f, 0.f, 0.f, 0.f};
    bf16x8 At[4][2], B0[2][2], B1[2][2];
    const char* cA = (const char*)g.A + (size_t)cur.pm * tstep; const char* cB = (const char*)g.Bt + (size_t)cur.e * g.estride + (size_t)cur.pn * tstep;
    S.a_ready(cur);
    if constexpr (SP2) {
        PG8_STAGE(PG8_SB(0, 0), cB, voffB); PG8_STAGE(PG8_SB(0, 1), cB + hstep, voffB); PG8_STAGE(PG8_SA(0, 0), cA, voffA); PG8_STAGE(PG8_SA(0, 1), cA + hstep, voffA);
        if (wr == 1) PG8_BAR;
        PG8_WAIT_V(2); PG8_BAR;
        PG8_STAGE(PG8_SB(1, 0), cB + kstep, voffB); PG8_STAGE(PG8_SA(1, 0), cA + kstep, voffA); PG8_STAGE(PG8_SB(1, 1), cB + hstep + kstep, voffB);
        PG8_WAIT_V(6); PG8_BAR;
    } else {
        PG8_STAGE(PG8_SB(0, 0), cB, voffB); PG8_STAGE(PG8_SA(0, 0), cA, voffA); PG8_STAGE(PG8_SB(0, 1), cB + hstep, voffB); PG8_STAGE(PG8_SA(0, 1), cA + hstep, voffA);
        if (wr == 1) PG8_BAR;
        PG8_WAIT_V(4); PG8_BAR;
        PG8_STAGE(PG8_SB(1, 0), cB + kstep, voffB); PG8_STAGE(PG8_SA(1, 0), cA + kstep, voffA); PG8_STAGE(PG8_SB(1, 1), cB + hstep + kstep, voffB);
        PG8_WAIT_V(6); PG8_BAR;
    }
    for (;;) {
        const bool has_next = S.next(ui + 1, nxt);
        const char* nA = has_next ? (const char*)g.A + (size_t)nxt.pm * tstep : cA; const char* nB = has_next ? (const char*)g.Bt + (size_t)nxt.e * g.estride + (size_t)nxt.pn * tstep : cB;
        for (int t = 0; t < nt; t += 2) {
            const bool last = (t == nt - 2);
            const char* a1 = cA + (size_t)(t + 1) * kstep;
            const char* a2 = last ? nA : cA + (size_t)(t + 2) * kstep; const char* b2 = last ? nB : cB + (size_t)(t + 2) * kstep;
            const char* a3 = a2 + kstep; const char* b3 = b2 + kstep;
            if (last && has_next) S.a_ready(nxt);
            if constexpr (SP2) {
            PG8_LDB(B0, 0, 0); PG8_LDB(B1, 0, 1); PG8_SCHED; PG8_LDA(At, 0, 0); PG8_STAGE(PG8_SA(1, 1), a1 + hstep, voffA);
            PG8_WAIT_V(8); PG8_WAIT_L(0); PG8_BAR; PG8_MMA(0, 0, At, B0); PG8_MMA(0, 1, At, B1); PG8_BAR; PG8_SCHED;
            PG8_LDA(At, 0, 1); PG8_STAGE(PG8_SB(0, 0), b2, voffB); PG8_STAGE(PG8_SB(0, 1), b2 + hstep, voffB); PG8_STAGE(PG8_SA(0, 0), a2, voffA);
            PG8_WAIT_V(8); PG8_WAIT_L(0); PG8_BAR; PG8_MMA(1, 0, At, B0); PG8_MMA(1, 1, At, B1); PG8_BAR; PG8_SCHED;
            PG8_LDB(B0, 1, 0); PG8_LDB(B1, 1, 1); PG8_SCHED; PG8_LDA(At, 1, 0); PG8_STAGE(PG8_SA(0, 1), a2 + hstep, voffA);
            PG8_WAIT_V(8); PG8_WAIT_L(0); PG8_BAR; PG8_MMA(0, 0, At, B0); PG8_MMA(0, 1, At, B1); PG8_BAR; PG8_SCHED;
            PG8_LDA(At, 1, 1); PG8_STAGE(PG8_SB(1, 0), b3, voffB); PG8_STAGE(PG8_SB(1, 1), b3 + hstep, voffB); PG8_STAGE(PG8_SA(1, 0), a3, voffA);
            PG8_WAIT_V(8); PG8_WAIT_L(0); PG8_BAR; PG8_MMA(1, 0, At, B0); PG8_MMA(1, 1, At, B1); PG8_BAR; PG8_SCHED;
            } else {
            PG8_LDB(B0, 0, 0); PG8_SCHED; PG8_LDA(At, 0, 0); PG8_STAGE(PG8_SA(1, 1), a1 + hstep, voffA);
            PG8_WAIT_L(8); PG8_BAR; PG8_WAIT_L(0); PG8_MMA(0, 0, At, B0); PG8_BAR; PG8_SCHED;
            PG8_LDB(B1, 0, 1); PG8_STAGE(PG8_SB(0, 0), b2, voffB);
            PG8_BAR; PG8_WAIT_L(0); PG8_MMA(0, 1, At, B1); PG8_BAR;
            PG8_LDA(At, 0, 1); PG8_STAGE(PG8_SA(0, 0), a2, voffA);
            PG8_BAR; PG8_WAIT_L(0); PG8_MMA(1, 0, At, B0); PG8_BAR; PG8_SCHED;
            PG8_STAGE(PG8_SB(0, 1), b2 + hstep, voffB);
            PG8_WAIT_V(6); PG8_BAR; PG8_MMA(1, 1, At, B1); PG8_BAR;
            PG8_LDB(B0, 1, 0); PG8_SCHED; PG8_LDA(At, 1, 0); PG8_STAGE(PG8_SA(0, 1), a2 + hstep, voffA);
            PG8_WAIT_L(8); PG8_BAR; PG8_WAIT_L(0); PG8_MMA(0, 0, At, B0); PG8_BAR; PG8_SCHED;
            PG8_LDB(B1, 1, 1); PG8_STAGE(PG8_SB(1, 0), b3, voffB);
            PG8_BAR; PG8_WAIT_L(0); PG8_MMA(0, 1, At, B1); PG8_BAR;
            PG8_LDA(At, 1, 1); PG8_STAGE(PG8_SA(1, 0), a3, voffA);
            PG8_BAR; PG8_WAIT_L(0); PG8_MMA(1, 0, At, B0); PG8_BAR; PG8_SCHED;
            PG8_STAGE(PG8_SB(1, 1), b3 + hstep, voffB);
            PG8_WAIT_V(6); PG8_BAR; PG8_MMA(1, 1, At, B1); PG8_BAR;
            }
        }
        if constexpr (ALIGN_EPI) { if (wr == 0) PG8_BAR; }
        if constexpr (!Epi::AFTER_DRAIN) { E(acc, cur, wr, wc, fr, fq); S.done(cur); }
        if (!has_next) break;
#pragma unroll
        for (int a = 0; a < 2; ++a)
#pragma unroll
            for (int b = 0; b < 2; ++b)
#pragma unroll
                for (int m = 0; m < 4; ++m)
#pragma unroll
                    for (int n = 0; n < 2; ++n) acc[a][b][m][n] = (f32x4){0.f, 0.f, 0.f, 0.f};
        cur = nxt; cA = nA; cB = nB; ++ui;
        if constexpr (ALIGN_EPI) { if (wr == 1) PG8_BAR; }
    }
    PG8_WAIT_V(0);
    if constexpr (!ALIGN_EPI) { if (wr == 0) PG8_BAR; }
    PG8_BAR;
    if constexpr (Epi::AFTER_DRAIN) { E.fused(acc, cur, wr, wc, fr, fq, lds, wid, lane); S.done(cur); }
#undef PG8_SA
#undef PG8_SB
#undef PG8_STAGE
#undef PG8_LDA
#undef PG8_LDB
#undef PG8_MMA
#undef PG8_WAIT_V
#undef PG8_WAIT_L
#undef PG8_BAR
#undef PG8_SCHED
}
}

#define GAS __attribute__((address_space(1)))
#define LAS __attribute__((address_space(3)))
typedef GAS unsigned gu32;
#define RLX_AGENT __ATOMIC_RELAXED, __HIP_MEMORY_SCOPE_AGENT
constexpr int NWAVES = 8;
constexpr int CW_BAR = 4096;
constexpr int RING_BYTES = 131072, LDSCTL_OFF = RING_BYTES, MISC_OFF = LDSCTL_OFF + 320, LDS_BYTES = 147456;
constexpr size_t CTL_ZERO_BYTES = 65536;

#define XB_TMO      128
#define XB_XCNT(j)  (256  + 64 * (j))
#define XB_XSUB(j)  (1280 + 64 * (j))
#define XB_XGEN(j)  (2304 + 64 * (j))
#define XB_TOP      3328
#define XB_TOPGEN   3392
#define XCD_BAR_WORDS 3456
#define XB_SPIN_CAP (1u << 18)

__device__ __forceinline__ unsigned xb_ld(unsigned* p)              { return __hip_atomic_load(p, __ATOMIC_RELAXED, __HIP_MEMORY_SCOPE_AGENT); }
__device__ __forceinline__ unsigned xb_add(unsigned* p, unsigned v) { return __hip_atomic_fetch_add(p, v, __ATOMIC_RELAXED, __HIP_MEMORY_SCOPE_AGENT); }
__device__ __forceinline__ unsigned xb_xcc_id() { return (unsigned)__builtin_amdgcn_s_getreg((3 << 11) | 20) & 0xFu; }
#define XB_SPIN(cond, bar) do { unsigned _sp = 0; while (cond) { __builtin_amdgcn_s_sleep(1); \
    if ((++_sp & 255u) == 0u) { if (xb_ld(&(bar)[XB_TMO])) break; if (_sp > XB_SPIN_CAP) { atomicAdd(&(bar)[XB_TMO], 1u); break; } } } } while (0)

struct XcdBarrier {
    unsigned* bar; unsigned x;
    volatile LAS unsigned* st;
};

__device__ __forceinline__ XcdBarrier xcd_barrier_post(unsigned* bar, volatile LAS unsigned* st) {
    XcdBarrier b; b.bar = bar; b.x = xb_xcc_id(); b.st = st;
    if (threadIdx.x == 0) (void)xb_add(&bar[XB_XCNT(b.x)], 1u);
    return b;
}
__device__ __forceinline__ void xcd_barrier_complete(unsigned* bar, unsigned x, unsigned& nloc, unsigned& nx) {
    const unsigned G = gridDim.x * gridDim.y * gridDim.z;
    unsigned sum, cnt, mine, sp = 0u;
    for (;;) {
        sum = 0u; cnt = 0u; mine = 0u;
#pragma unroll
        for (unsigned j = 0; j < 16; ++j) { const unsigned c = xb_ld(&bar[XB_XCNT(j)]); sum += c; cnt += (c > 0u) ? 1u : 0u; mine = (j == x) ? c : mine; }
        if (sum == G) break;
        __builtin_amdgcn_s_sleep(1);
        if ((++sp & 255u) == 0u) { if (xb_ld(&bar[XB_TMO])) break; if (sp > XB_SPIN_CAP) { atomicAdd(&bar[XB_TMO], 1u); break; } }
    }
    nloc = mine > 0u ? mine : 1u; nx = cnt > 0u ? cnt : 1u;
}

__device__ __forceinline__ void xcd_barrier(const XcdBarrier& b) {
    asm volatile("s_waitcnt vmcnt(0)" ::: "memory");
    __syncthreads();
    if (threadIdx.x == 0) {
        unsigned* bar = b.bar;
        __builtin_amdgcn_s_waitcnt(0);
        unsigned nloc = b.st[0], nx = b.st[1];
        if (nloc == 0u) { xcd_barrier_complete(bar, b.x, nloc, nx); b.st[0] = nloc; b.st[1] = nx; }
        const unsigned old = xb_add(&bar[XB_XSUB(b.x)], 1u);
        const unsigned gen = old / nloc;
        if (old + 1u == (gen + 1u) * nloc) {
            __builtin_amdgcn_fence(__ATOMIC_RELEASE, "agent");
            asm volatile("s_waitcnt vmcnt(0)" ::: "memory");
            const unsigned og = xb_add(&bar[XB_TOP], 1u);
            const unsigned tg = og / nx;
            if (og + 1u == (tg + 1u) * nx) xb_add(&bar[XB_TOPGEN], 1u);
            else XB_SPIN(xb_ld(&bar[XB_TOPGEN]) == tg, bar);
            __builtin_amdgcn_fence(__ATOMIC_ACQUIRE, "agent");
            xb_add(&bar[XB_XGEN(b.x)], 1u);
            asm volatile("s_waitcnt vmcnt(0)" ::: "memory");
        } else {
            XB_SPIN(xb_ld(&bar[XB_XGEN(b.x)]) == gen, bar);
            __builtin_amdgcn_fence(__ATOMIC_ACQUIRE, "agent");
            asm volatile("s_waitcnt vmcnt(0)" ::: "memory");
        }
    }
    __syncthreads();
}


template <class F> struct EpiAdapt {
    static constexpr bool PERM = false, AFTER_DRAIN = false; F f;
    __device__ __forceinline__ void operator()(const pg8::f32x4 (&acc)[2][2][4][2], const pg8::Unit& u, int wr, int wc, int fr, int fq) const {
#pragma unroll
        for (int ai = 0; ai < 2; ++ai)
#pragma unroll
            for (int m = 0; m < 4; ++m) { const int row = u.pm * 256 + ai * 128 + wr * 64 + m * 16 + fr;
#pragma unroll
                for (int bj = 0; bj < 2; ++bj) f(row, u.pn * 8 + bj * 4 + wc, fq, acc[ai][bj][m][0], acc[ai][bj][m][1]);
                asm volatile("" ::: "memory"); }
    }
};
struct EpiBf16Perm { bf16_t* O; int ldo; int pad;
    __device__ __forceinline__ void operator()(int row, int g, int fq, f32x4 v0, f32x4 v1) const {
        u32x4 w; w.x = pk2(v0.x, v0.y); w.y = pk2(v0.z, v0.w); w.z = pk2(v1.x, v1.y); w.w = pk2(v1.z, v1.w);
        *(u32x4*)(O + (size_t)row * ldo + 32 * g + 8 * fq) = w; } };
struct EpiResid { const float* hl_in; const float* hc_in; float* hl_out; float* hc_out; const float* mod; int goff; int pad;
    __device__ __forceinline__ void operator()(int row, int g, int fq, f32x4 v0, f32x4 v1) const {
        const int c0 = 32 * g + 4 * fq; const float* hin; float* hout; const float* gv;
        if (row < TL) { hin = hl_in + (size_t)row * D; hout = hl_out + (size_t)row * D; gv = mod + (row / SEQ) * 6144 + goff; }
        else { hin = hc_in + (size_t)(row - TL) * D; hout = hc_out + (size_t)(row - TL) * D; gv = mod + 2 * 6144 + goff; }
        *(f32x4*)(hout + c0) = *(const f32x4*)(hin + c0) + *(const f32x4*)(gv + c0) * v0;
        *(f32x4*)(hout + c0 + 16) = *(const f32x4*)(hin + c0 + 16) + *(const f32x4*)(gv + c0 + 16) * v1; } };
struct EpiSwiglu { bf16_t* H; int ldh; int pad;
    __device__ __forceinline__ void operator()(int row, int g, int fq, f32x4 v0, f32x4 v1) const {
        u32x2 w; w.x = pk2(silu_f(v0.x) * v1.x, silu_f(v0.y) * v1.y); w.y = pk2(silu_f(v0.z) * v1.z, silu_f(v0.w) * v1.w);
        *(u32x2*)(H + (size_t)row * ldh + 16 * g + 4 * fq) = w; } };

template <class F> __device__ __forceinline__ void run_gemm(LAS unsigned char* lds, const bf16_t* A, const bf16_t* Bt, int K, int nM, int nN, const int* texp, size_t estride_bytes, const F& f) {
    pg8::Gemm g{A, Bt, K, estride_bytes}; pg8::StaticOrder S; S.init(nM, nN, (int)gridDim.x, (int)blockIdx.x, texp);
    EpiAdapt<F> E{f};
    pg8::gemm_phase<EpiAdapt<F>, pg8::StaticOrder, true, true>(lds, g, S, E);
}

__device__ __forceinline__ float conv_src(const Params& p, int mode, const float* W0, const float* W1, int N, int nvalid, int k, int nb) {
    if (mode == 0) return W0[(size_t)k * N + nb];
    if (mode == 1) { const int col = (nb & ~31) + 8 * ((nb >> 2) & 3) + 4 * ((nb >> 4) & 1) + (nb & 3); return col < nvalid ? W0[(size_t)k * N + col] : 0.f; }
    const int col = 16 * (nb >> 5) + (nb & 15); return ((nb >> 4) & 1) ? W1[(size_t)k * N + col] : W0[(size_t)k * N + col];
}
constexpr int CT_WIN = 0, CT_WOUT = 2304, CT_WUQ = 3328, CT_WUKV = 3400, CT_WFGU = 3464, CT_WFDN = 6280, CT_WMGU = 7688, CT_WMDN = 36360, CT_END = 50696;
constexpr int IT_MODS = 192, IT_ROPE = 9;
__device__ __forceinline__ void ph_prologue(const Params& p, float* lds) {
    const int tid = opq((int)threadIdx.x), lane = tid & 63, wv = tid >> 6;
    for (int it = blockIdx.x; it < IT_MODS + IT_ROPE; it += gridDim.x) {
        if (it < IT_MODS) {
            const int l = it / 96, n0 = (it % 96) * 64, nn = tid & 63, kc = tid >> 6;
            float* sv = lds; float* red = lds + 3 * 1024;
            __syncthreads();
            for (int i = tid; i < 3 * 1024; i += 512) { const int v = i >> 10, k = i & 1023; const float x = (v < 2) ? p.in[1][v * D + k] : p.in[3][k]; sv[i] = silu_f(x); }
            __syncthreads();
            const float* w = p.in[4] + ((size_t)l * D + kc * 128) * 6144 + n0 + nn;
            float a0 = 0.f, a1 = 0.f, a2 = 0.f;
#pragma unroll 8
            for (int k = 0; k < 128; ++k) { const float wv_ = w[(size_t)k * 6144]; a0 += sv[kc * 128 + k] * wv_; a1 += sv[1024 + kc * 128 + k] * wv_; a2 += sv[2048 + kc * 128 + k] * wv_; }
            red[(kc * 3 + 0) * 64 + nn] = a0; red[(kc * 3 + 1) * 64 + nn] = a1; red[(kc * 3 + 2) * 64 + nn] = a2;
            __syncthreads();
            if (tid < 192) { const int v = tid >> 6; float s = p.in[5][l * 6144 + n0 + nn];
#pragma unroll
                for (int q = 0; q < 8; ++q) s += red[(q * 3 + v) * 64 + nn];
                ((float*)(p.ws + WS_MOD))[((size_t)l * 3 + v) * 6144 + n0 + nn] = s; }
        } else {
            const int idx = (it - IT_MODS) * 512 + tid;
            if (idx < RT_N) {
                int pos, i, nf;
                if (idx < RT_C64) { pos = idx / 16; i = idx % 16; nf = 16; }
                else if (idx < RT_R32) { pos = (idx - RT_C64) / 16; i = idx % 16; nf = 16; }
                else if (idx < RT_C32) { pos = (idx - RT_R32) / 8; i = idx % 8; nf = 8; }
                else { pos = (idx - RT_C32) / 8; i = idx % 8; nf = 8; }
                const float inv = powf(10000.0f, -(float)i / (float)nf);
                const float ang = (float)pos * inv;
                double s, c; sincos_d((double)ang, s, c);
                ((float2*)(p.ws + WS_ROPE))[idx] = make_float2((float)c, (float)s);
            }
        }
    }
    __syncthreads();
    float* scr = lds + wv * (64 * 33);
    for (int it = wv * gridDim.x + blockIdx.x; it < CT_END; it += 8 * gridDim.x) {
        int t = it;
        bf16_t* dst; const float* W0; const float* W1 = nullptr; int K, N, nvalid = 0, mode;
        if (t < CT_WOUT) { const int l = t / 1152; t %= 1152; dst = (bf16_t*)(p.ws + WS_WIN) + (size_t)l * NINP * D; W0 = p.in[8] + (size_t)l * D * NIN; K = D; N = NIN; nvalid = NIN; mode = 1; }
        else if (t < CT_WUQ) { t -= CT_WOUT; const int l = t / 512; t %= 512; dst = (bf16_t*)(p.ws + WS_WOUT) + (size_t)l * D * D; W0 = p.in[24] + (size_t)l * D * D; K = D; N = D; mode = 0; }
        else if (t < CT_WUKV) { t -= CT_WUQ; const int l = t / 36; t %= 36; dst = (bf16_t*)(p.ws + WS_WUQ) + (size_t)l * 384 * 192; W0 = p.in[18] + (size_t)l * 192 * 384; K = 192; N = 384; mode = 0; }
        else if (t < CT_WFGU) { t -= CT_WUKV; const int l = t / 32; t %= 32; dst = (bf16_t*)(p.ws + WS_WUKV) + (size_t)l * 512 * 128; W0 = p.in[20] + (size_t)l * 128 * 512; K = 128; N = 512; mode = 0; }
        else if (t < CT_WFDN) { t -= CT_WFGU; dst = (bf16_t*)(p.ws + WS_WFGU); W0 = p.in[25]; W1 = p.in[26]; K = D; N = DFF; mode = 2; }
        else if (t < CT_WMGU) { t -= CT_WFDN; dst = (bf16_t*)(p.ws + WS_WFDN); W0 = p.in[27]; K = DFF; N = D; mode = 0; }
        else if (t < CT_WMDN) { t -= CT_WMGU; const int e = t / 3584; t %= 3584; dst = (bf16_t*)(p.ws + WS_WMGU) + (size_t)e * 2 * DFFE * D; W0 = p.in[29] + (size_t)e * D * DFFE; W1 = p.in[30] + (size_t)e * D * DFFE; K = D; N = DFFE; mode = 2; }
        else { t -= CT_WMDN; const int e = t / 1792; t %= 1792; dst = (bf16_t*)(p.ws + WS_WMDN) + (size_t)e * D * DFFE; W0 = p.in[31] + (size_t)e * DFFE * D; K = DFFE; N = D; nvalid = D; mode = 1; }
        const int ktl = K / 64, n0 = (t / ktl) * 32, k0 = (t % ktl) * 64;
        const int nb = n0 + (lane & 31); const float* src; bool valid = true;
        if (mode == 0) src = W0 + nb;
        else if (mode == 1) { const int col = (nb & ~31) + 8 * ((nb >> 2) & 3) + 4 * ((nb >> 4) & 1) + (nb & 3); valid = col < nvalid; src = W0 + (valid ? col : 0); }
        else { const int col = 16 * (nb >> 5) + (nb & 15); src = (((nb >> 4) & 1) ? W1 : W0) + col; }
        src += (size_t)(k0 + (lane >> 5)) * N;
#pragma unroll 8
        for (int i = 0; i < 32; ++i) { const float v = valid ? src[(size_t)(2 * i) * N] : 0.f; scr[(2 * i + (lane >> 5)) * 33 + (lane & 31)] = v; }
        const int c = lane & 7;
#pragma unroll
        for (int j = 0; j < 4; ++j) { const int n = (lane >> 3) + 8 * j; const float* sp = scr + (8 * c) * 33 + n;
            u32x4 o; o.x = pk2(sp[0 * 33], sp[1 * 33]); o.y = pk2(sp[2 * 33], sp[3 * 33]); o.z = pk2(sp[4 * 33], sp[5 * 33]); o.w = pk2(sp[6 * 33], sp[7 * 33]);
            *(u32x4*)(dst + (size_t)(n0 + n) * K + k0 + 8 * c) = o; }
    }
    __syncthreads();
}

template <int WHICH, bool ROUTER> __device__ __forceinline__ void ph_norm(const Params& p, int layer, int nrows, unsigned* lcnt) {
    const int tx = opq((int)threadIdx.x), lane = tx & 63, gw = (blockIdx.x * 512 + tx) >> 6, ngw = (gridDim.x * 512) >> 6;
    if (ROUTER) { if (tx < 16) lcnt[tx] = 0u; __syncthreads(); }
    const float* hl = (layer == 0 && WHICH == 1) ? p.in[0] : p.out;
    const float* hc = (layer == 0 && WHICH == 1) ? p.in[2] : (const float*)(p.ws + WS_HCTX);
    const float* gain = p.in[WHICH == 1 ? 6 : 7] + layer * D;
    const float* mod = (const float*)(p.ws + WS_MOD) + (size_t)layer * 3 * 6144;
    bf16_t* dst = (bf16_t*)(p.ws + WS_ACT1);
    for (int m = gw; m < nrows; m += ngw) {
        const float* src = (m < TL) ? hl + (size_t)m * D : hc + (size_t)(m - TL) * D;
        const float* mv = mod + (m < TL ? m / SEQ : 2) * 6144;
        const float* shp = mv + (WHICH == 1 ? 0 : 3) * D; const float* scp = mv + (WHICH == 1 ? 1 : 4) * D;
        f32x4 v[4]; float ss = 0.f;
#pragma unroll
        for (int j = 0; j < 4; ++j) { v[j] = *(const f32x4*)(src + 256 * j + 4 * lane); ss += v[j].x * v[j].x + v[j].y * v[j].y + v[j].z * v[j].z + v[j].w * v[j].w; }
        const float rstd = rsqrtf(wave_sum(ss) * (1.f / D) + EPS);
        float lg[8];
#pragma unroll
        for (int e = 0; e < 8; ++e) lg[e] = 0.f;
#pragma unroll
        for (int j = 0; j < 4; ++j) {
            const int c = 256 * j + 4 * lane;
            const f32x4 g = *(const f32x4*)(gain + c), sh = *(const f32x4*)(shp + c), sc = *(const f32x4*)(scp + c);
            f32x4 f = v[j] * rstd * g * (sc + 1.f) + sh;
            u32x2 w; w.x = pk2(f.x, f.y); w.y = pk2(f.z, f.w);
            *(u32x2*)(dst + (size_t)m * D + c) = w;
            if (ROUTER) {
                const float* rt = p.in[28] + (size_t)c * 8;
#pragma unroll
                for (int i = 0; i < 4; ++i) { const f32x4 r0 = *(const f32x4*)(rt + 8 * i), r1 = *(const f32x4*)(rt + 8 * i + 4); const float fv = f[i];
                    lg[0] += fv * r0.x; lg[1] += fv * r0.y; lg[2] += fv * r0.z; lg[3] += fv * r0.w; lg[4] += fv * r1.x; lg[5] += fv * r1.y; lg[6] += fv * r1.z; lg[7] += fv * r1.w; }
            }
        }
        if (ROUTER) {
#pragma unroll
            for (int e = 0; e < 8; ++e) lg[e] = wave_sum(lg[e]);
            if (lane == 0) {
                int e0 = 0; float v0 = lg[0];
#pragma unroll
                for (int e = 1; e < 8; ++e) if (lg[e] > v0) { v0 = lg[e]; e0 = e; }
                int e1 = -1; float v1 = -INFINITY;
#pragma unroll
                for (int e = 0; e < 8; ++e) if (e != e0 && lg[e] > v1) { v1 = lg[e]; e1 = e; }
                const float t = expf(v1 - v0), g0 = 1.f / (1.f + t), g1 = t / (1.f + t);
                const int p0 = (int)atomicAdd(&lcnt[e0], 1u), p1 = (int)atomicAdd(&lcnt[e1], 1u);
                ((int2*)(p.ws + WS_TOKE))[m] = make_int2(e0, e1); ((int2*)(p.ws + WS_TOKP))[m] = make_int2(p0, p1); ((float2*)(p.ws + WS_TOKG))[m] = make_float2(g0, g1);
            }
        }
    }
    if (ROUTER) {
        __syncthreads();
        if (tx < 8) lcnt[8 + tx] = atomicAdd((unsigned*)(p.ws + WS_CTL) + 64 * tx, lcnt[tx]);
        __syncthreads();
        if (lane == 0) for (int m = gw; m < nrows; m += ngw) {
            const int2 e = ((const int2*)(p.ws + WS_TOKE))[m]; int2 ps = ((const int2*)(p.ws + WS_TOKP))[m];
            ps.x += (int)lcnt[8 + e.x]; ps.y += (int)lcnt[8 + e.y]; ((int2*)(p.ws + WS_TOKP))[m] = ps; }
        __syncthreads();
    }
}


typedef short pp_bf16x8 __attribute__((ext_vector_type(8)));
__device__ __forceinline__ float quad_sum(float v) { v += swz_xor<1>(v); v += swz_xor<2>(v); return v; }
__device__ __forceinline__ float kg_sum(float v) { v += swz_xor<16>(v); return half_sum(v); }
constexpr float QS64 = 0.125f * 1.4426950408889634f, QS96 = 0.10206207261596575f * 1.4426950408889634f;

template <int HS> __device__ __forceinline__ void pp_head(const Params& p, const QKVB& qb, int layer, const bf16_t* prow, bool lat, int b, int s, int key, int sub,
                                                          const float2 (&rr)[4], const float2 (&rc)[4]) {
    constexpr bool ISV = HS >= 20;
    constexpr int col = HS < 4 ? OFF_AQ + 64 * HS : HS < 6 ? OFF_AK + 64 * (HS - 4) : HS < 10 ? OFF_BQ + 64 * (HS - 6) : HS < 12 ? OFF_BK + 64 * (HS - 10) : HS < 16 ? OFF_CQ + 64 * (HS - 12) :
                        HS < 20 ? OFF_CK + 64 * (HS - 16) : HS < 22 ? OFF_AV + 64 * (HS - 20) : HS < 24 ? OFF_BV + 64 * (HS - 22) : OFF_CV + 64 * (HS - 24);
    constexpr bool ISQ = HS < 4 || (HS >= 6 && HS < 10) || (HS >= 12 && HS < 16);
    constexpr bool ROPE = HS < 12;
    constexpr int GIN = HS < 4 ? 9 : HS < 6 ? 10 : HS < 10 ? 12 : HS < 12 ? 13 : HS < 16 ? 14 : 15;
    bf16_t* dst;
    if (HS < 4) dst = lat ? qb.QA + ((size_t)(b * 4 + HS) * SEQ + s) * 64 : qb.QAc + ((size_t)(b * 4 + HS) * CTX + s) * 64;
    else if (HS < 6) dst = qb.KA + ((size_t)(b * 2 + HS - 4) * KEYS + key) * 64;
    else if (HS < 10) dst = lat ? qb.QB + ((size_t)(b * 4 + HS - 6) * SEQ + s) * 64 : qb.QBc + ((size_t)(b * 4 + HS - 6) * CTX + s) * 64;
    else if (HS < 12) dst = qb.KB + ((size_t)(b * 2 + HS - 10) * KEYS + key) * 64;
    else if (HS < 16) dst = lat ? qb.QC + ((size_t)(b * 4 + HS - 12) * SEQ + s) * 64 : qb.QCc + ((size_t)(b * 4 + HS - 12) * CTX + s) * 64;
    else if (HS < 20) dst = qb.KC + ((size_t)(b * 4 + HS - 16) * KEYS + key) * 64;
    else if (HS < 22) dst = qb.VA + ((size_t)(b * 2 + HS - 20) * KEYS + key) * 64;
    else if (HS < 24) dst = qb.VB + ((size_t)(b * 2 + HS - 22) * KEYS + key) * 64;
    else dst = qb.VC + ((size_t)(b * 4 + HS - 24) * KEYS + key) * 64;
    u32x2 w[4];
#pragma unroll
    for (int c = 0; c < 4; ++c) w[c] = *(const u32x2*)(prow + col + 16 * c + 4 * sub);
    if (!ISV) {
        f32x4 x[4]; float ss = 0.f;
#pragma unroll
        for (int c = 0; c < 4; ++c) { x[c] = (f32x4){bflo(w[c].x), bfhi(w[c].x), bflo(w[c].y), bfhi(w[c].y)}; ss += x[c].x * x[c].x + x[c].y * x[c].y + x[c].z * x[c].z + x[c].w * x[c].w; }
        const float r = rsqrtf(quad_sum(ss) * (1.f / 64.f) + EPS) * (ISQ ? QS64 : 1.f);
        const float* g = p.in[GIN] + layer * 64 + 4 * sub;
#pragma unroll
        for (int c = 0; c < 4; ++c) x[c] = x[c] * r * *(const f32x4*)(g + 16 * c);
        if (ROPE && lat) {
#pragma unroll
            for (int i = 0; i < 4; ++i) { const float a = x[0][i], bq = x[1][i]; x[0][i] = a * rr[i].x - bq * rr[i].y; x[1][i] = bq * rr[i].x + a * rr[i].y;
                const float c1 = x[2][i], c2 = x[3][i]; x[2][i] = c1 * rc[i].x - c2 * rc[i].y; x[3][i] = c2 * rc[i].x + c1 * rc[i].y; }
        }
#pragma unroll
        for (int c = 0; c < 4; ++c) { w[c].x = pk2(x[c].x, x[c].y); w[c].y = pk2(x[c].z, x[c].w); }
    }
#pragma unroll
    for (int c = 0; c < 4; ++c) *(u32x2*)(dst + 16 * c + 4 * sub) = w[c];
}
template <int HS> struct PPHeads { static __device__ __forceinline__ void run(const Params& p, const QKVB& qb, int layer, const bf16_t* prow, bool lat, int b, int s, int key, int sub, const float2 (&rr)[4], const float2 (&rc)[4]) {
    pp_head<HS>(p, qb, layer, prow, lat, b, s, key, sub, rr, rc); PPHeads<HS + 1>::run(p, qb, layer, prow, lat, b, s, key, sub, rr, rc); } };
template <> struct PPHeads<28> { static __device__ __forceinline__ void run(const Params&, const QKVB&, int, const bf16_t*, bool, int, int, int, int, const float2 (&)[4], const float2 (&)[4]) {} };

__device__ __forceinline__ void f8_from_bf(const u32x4 v, float (&x)[8]) { x[0] = bflo(v.x); x[1] = bfhi(v.x); x[2] = bflo(v.y); x[3] = bfhi(v.y); x[4] = bflo(v.z); x[5] = bfhi(v.z); x[6] = bflo(v.w); x[7] = bfhi(v.w); }

__device__ __forceinline__ void ph_postproj2(const Params& p, int layer) {
    const int tx = opq((int)threadIdx.x), lane = tx & 63, gw = (tx >> 6) * gridDim.x + blockIdx.x, ngw = gridDim.x * 8;
    const bf16_t* P = (const bf16_t*)(p.ws + WS_P);
    const QKVB qb = make_qkv(p.ws);
    const bf16_t* Wuq = (const bf16_t*)(p.ws + WS_WUQ) + (size_t)layer * 384 * 192;
    const bf16_t* Wukv = (const bf16_t*)(p.ws + WS_WUKV) + (size_t)layer * 512 * 128;
    const float2* rope = (const float2*)(p.ws + WS_ROPE);
    for (int u = gw; u < MALL / 16; u += ngw) {
        const int m0 = u * 16; const bool lat = m0 < TL;
        {
            const int t = lane >> 2, sub = lane & 3, m = m0 + t;
            const int b = lat ? m / SEQ : (m - TL) / CTX, s = lat ? m % SEQ : (m - TL) % CTX, key = lat ? CTX + s : s;
            float2 rr[4], rc[4];
#pragma unroll
            for (int i = 0; i < 4; ++i) { rr[i] = lat ? rope[RT_R64 + (s >> 6) * 16 + 4 * sub + i] : make_float2(1.f, 0.f); rc[i] = lat ? rope[RT_C64 + (s & 63) * 16 + 4 * sub + i] : make_float2(1.f, 0.f); }
            PPHeads<0>::run(p, qb, layer, P + (size_t)m * NINP, lat, b, s, key, sub, rr, rc);
        }
        {
            const int tk = lane & 15, kg = lane >> 4, m = m0 + tk;
            const int b = lat ? m / SEQ : (m - TL) / CTX, s = lat ? m % SEQ : (m - TL) % CTX, key = lat ? CTX + s : s;
            const bf16_t* prow = P + (size_t)m * NINP;
            pp_bf16x8 aq[6];
            { float x[6][8]; float ss = 0.f;
#pragma unroll
                for (int ks = 0; ks < 6; ++ks) { f8_from_bf(*(const u32x4*)(prow + OFF_DCQ + 32 * ks + 8 * kg), x[ks]);
#pragma unroll
                    for (int j = 0; j < 8; ++j) ss += x[ks][j] * x[ks][j]; }
                const float r = rsqrtf(kg_sum(ss) * (1.f / 192.f) + EPS);
                const float* g = p.in[17] + layer * 192 + 8 * kg;
#pragma unroll
                for (int ks = 0; ks < 6; ++ks) { const f32x4 g0 = *(const f32x4*)(g + 32 * ks), g1 = *(const f32x4*)(g + 32 * ks + 4);
                    u32x4 w; w.x = pk2(x[ks][0] * r * g0.x, x[ks][1] * r * g0.y); w.y = pk2(x[ks][2] * r * g0.z, x[ks][3] * r * g0.w); w.z = pk2(x[ks][4] * r * g1.x, x[ks][5] * r * g1.y); w.w = pk2(x[ks][6] * r * g1.z, x[ks][7] * r * g1.w);
                    aq[ks] = __builtin_bit_cast(pp_bf16x8, w); } }
            float2 qr_[4], qc_[4];
#pragma unroll
            for (int reg = 0; reg < 4; ++reg) { const int i = (4 * kg + reg) & 7; qr_[reg] = lat ? rope[RT_R32 + (s >> 6) * 8 + i] : make_float2(1.f, 0.f); qc_[reg] = lat ? rope[RT_C32 + (s & 63) * 8 + i] : make_float2(1.f, 0.f); }
#pragma unroll 1
            for (int h = 0; h < 4; ++h) {
                f32x4 acc[6];
#pragma unroll
                for (int nb = 0; nb < 6; ++nb) { acc[nb] = (f32x4){0.f, 0.f, 0.f, 0.f};
                    const bf16_t* wp = Wuq + (size_t)(96 * h + 16 * nb + tk) * 192 + 8 * kg;
#pragma unroll
                    for (int ks = 0; ks < 6; ++ks) acc[nb] = __builtin_amdgcn_mfma_f32_16x16x32_bf16(*(const pp_bf16x8*)(wp + 32 * ks), aq[ks], acc[nb], 0, 0, 0); }
                float ss = 0.f;
#pragma unroll
                for (int nb = 0; nb < 6; ++nb) ss += acc[nb].x * acc[nb].x + acc[nb].y * acc[nb].y + acc[nb].z * acc[nb].z + acc[nb].w * acc[nb].w;
                const float r = rsqrtf(kg_sum(ss) * (1.f / 96.f) + EPS) * QS96;
                const float* g = p.in[21] + layer * 96 + 4 * kg;
                bf16_t* dst = (lat ? qb.QD + ((size_t)(b * 4 + h) * SEQ + s) * 96 : qb.QDc + ((size_t)(b * 4 + h) * CTX + s) * 96) + 4 * kg;
#pragma unroll
                for (int nb = 0; nb < 6; ++nb) { f32x4 y = acc[nb] * r * *(const f32x4*)(g + 16 * nb);
                    if (nb >= 4 && lat) {
#pragma unroll
                        for (int reg = 0; reg < 4; ++reg) { const float other = half_other(y[reg], lane); const float2 cs = nb == 4 ? qr_[reg] : qc_[reg];
                            y[reg] = (kg < 2) ? y[reg] * cs.x - other * cs.y : y[reg] * cs.x + other * cs.y; } }
                    u32x2 w; w.x = pk2(y.x, y.y); w.y = pk2(y.z, y.w); *(u32x2*)(dst + 16 * nb) = w; }
            }
            pp_bf16x8 akv[4];
            { float x[4][8]; float ss = 0.f;
#pragma unroll
                for (int ks = 0; ks < 4; ++ks) { f8_from_bf(*(const u32x4*)(prow + OFF_DCKV + 32 * ks + 8 * kg), x[ks]);
#pragma unroll
                    for (int j = 0; j < 8; ++j) ss += x[ks][j] * x[ks][j]; }
                const float r = rsqrtf(kg_sum(ss) * (1.f / 128.f) + EPS);
                const float* g = p.in[19] + layer * 128 + 8 * kg;
#pragma unroll
                for (int ks = 0; ks < 4; ++ks) { const f32x4 g0 = *(const f32x4*)(g + 32 * ks), g1 = *(const f32x4*)(g + 32 * ks + 4);
                    u32x4 w; w.x = pk2(x[ks][0] * r * g0.x, x[ks][1] * r * g0.y); w.y = pk2(x[ks][2] * r * g0.z, x[ks][3] * r * g0.w); w.z = pk2(x[ks][4] * r * g1.x, x[ks][5] * r * g1.y); w.w = pk2(x[ks][6] * r * g1.z, x[ks][7] * r * g1.w);
                    akv[ks] = __builtin_bit_cast(pp_bf16x8, w); } }
            float kr[8]; f8_from_bf(*(const u32x4*)(prow + OFF_DKR + 8 * kg), kr);
            float krss = 0.f;
#pragma unroll
            for (int j = 0; j < 8; ++j) krss += kr[j] * kr[j];
            float2 kcs[8];
#pragma unroll
            for (int j = 0; j < 8; ++j) kcs[j] = !lat ? make_float2(1.f, 0.f) : (kg < 2 ? rope[RT_R32 + (s >> 6) * 8 + j] : rope[RT_C32 + (s & 63) * 8 + j]);
#pragma unroll 1
            for (int h = 0; h < 4; ++h) {
                f32x4 acc[8];
#pragma unroll
                for (int nb = 0; nb < 8; ++nb) { acc[nb] = (f32x4){0.f, 0.f, 0.f, 0.f};
                    const bf16_t* wp = Wukv + (size_t)(128 * h + 16 * nb + tk) * 128 + 8 * kg;
#pragma unroll
                    for (int ks = 0; ks < 4; ++ks) acc[nb] = __builtin_amdgcn_mfma_f32_16x16x32_bf16(*(const pp_bf16x8*)(wp + 32 * ks), akv[ks], acc[nb], 0, 0, 0); }
                float ss = krss;
#pragma unroll
                for (int nb = 0; nb < 4; ++nb) ss += acc[nb].x * acc[nb].x + acc[nb].y * acc[nb].y + acc[nb].z * acc[nb].z + acc[nb].w * acc[nb].w;
                const float r = rsqrtf(kg_sum(ss) * (1.f / 96.f) + EPS);
                const float* g = p.in[22] + layer * 96;
                bf16_t* kd = qb.KD + ((size_t)(b * 4 + h) * KEYS + key) * 96; bf16_t* vd = qb.VD + ((size_t)(b * 4 + h) * KEYS + key) * 64;
#pragma unroll
                for (int nb = 0; nb < 4; ++nb) { const f32x4 y = acc[nb] * r * *(const f32x4*)(g + 16 * nb + 4 * kg); u32x2 w; w.x = pk2(y.x, y.y); w.y = pk2(y.z, y.w); *(u32x2*)(kd + 16 * nb + 4 * kg) = w; }
                { float y[8];
#pragma unroll
                    for (int j = 0; j < 8; ++j) y[j] = kr[j] * r * g[64 + 8 * kg + j];
#pragma unroll
                    for (int j = 0; j < 8; ++j) { const float other = swz_xor<16>(y[j]); y[j] = (kg & 1) == 0 ? y[j] * kcs[j].x - other * kcs[j].y : y[j] * kcs[j].x + other * kcs[j].y; }
                    u32x4 w; w.x = pk2(y[0], y[1]); w.y = pk2(y[2], y[3]); w.z = pk2(y[4], y[5]); w.w = pk2(y[6], y[7]); *(u32x4*)(kd + 64 + 8 * kg) = w; }
#pragma unroll
                for (int nb = 4; nb < 8; ++nb) { const f32x4 y = acc[nb]; u32x2 w; w.x = pk2(y.x, y.y); w.y = pk2(y.z, y.w); *(u32x2*)(vd + 16 * (nb - 4) + 4 * kg) = w; }
            }
        }
    }
}

namespace fa {
typedef short bf16x8 __attribute__((ext_vector_type(8)));
typedef short s16x4 __attribute__((ext_vector_type(4)));
typedef float f32x16 __attribute__((ext_vector_type(16)));
typedef __attribute__((address_space(3))) const char* lds_cptr;
typedef short v4i16_t __attribute__((ext_vector_type(4)));
constexpr int KSTG = 12288, VSTG = 8192, STG = KSTG + VSTG;
constexpr int LDS_WS = 2 * STG, LDS_OST = LDS_WS + 8 * 256, LDS_RPB = LDS_OST + 8 * 4096, LDS_TOTAL = LDS_RPB + 2048;
constexpr float LOG2E = 1.4426950408889634f;
constexpr float THR = 6.0f;
__device__ __forceinline__ int crow(int r, int hi) { return (r & 3) + 8 * (r >> 2) + 4 * hi; }
__device__ __forceinline__ void glds16(const void* gsrc, unsigned lds_dst) { unsigned keep;
    asm volatile("s_mov_b32 %0, m0\n\ts_mov_b32 m0, %2\n\ts_nop 0\n\tglobal_load_lds_dwordx4 %1, off\n\ts_mov_b32 m0, %0" : "=&s"(keep) : "v"(gsrc), "s"(lds_dst) : "memory"); }
__device__ __forceinline__ s16x4 vtr(lds_cptr p) { return __builtin_bit_cast(s16x4, __builtin_amdgcn_ds_read_tr16_b64_v4i16((__attribute__((address_space(3))) v4i16_t*)p)); }
typedef float f32x2_t __attribute__((ext_vector_type(2))); typedef __bf16 bf16x2_t __attribute__((ext_vector_type(2)));
__device__ __forceinline__ unsigned cvtpk(float lo, float hi) { f32x2_t v = {lo, hi}; bf16x2_t b = __builtin_convertvector(v, bf16x2_t); return __builtin_bit_cast(unsigned, b); }
__device__ __forceinline__ float xhalf_max(float m) { auto rr = __builtin_amdgcn_permlane32_swap(__float_as_uint(m), __float_as_uint(m), false, false); return fmaxf(__uint_as_float(rr[0]), __uint_as_float(rr[1])); }
__device__ __forceinline__ float xhalf_sum(float m) { auto rr = __builtin_amdgcn_permlane32_swap(__float_as_uint(m), __float_as_uint(m), false, false); return __uint_as_float(rr[0]) + __uint_as_float(rr[1]); }
#define FA_WAIT_BAR() asm volatile("s_waitcnt vmcnt(0) lgkmcnt(0)\n\ts_barrier" ::: "memory")

template <int DQK, int MODE>
__device__ __forceinline__ void attn_unit(const bf16_t* Qg, const bf16_t* Kg, const bf16_t* Vg, bf16_t* Og, int q0, float sink2, const float* rpb, char* shm) {
    const int tid = opq((int)threadIdx.x), lane = tid & 63, r32 = lane & 31, hi = lane >> 5; const int wid = __builtin_amdgcn_readfirstlane(tid >> 6);
    const unsigned lds0 = (unsigned)(uintptr_t)shm;
    float* wsf = (float*)(shm + LDS_WS) + wid * 64;
    constexpr int NCH = DQK / 8, ND0 = DQK / 16;
    int NT, wbase = 0;
    if (MODE == 0) NT = KEYS / 64; else if (MODE == 3) NT = 4;
    else if (MODE == 1) { wbase = max(0, q0 - 128); const int we = min(SEQ, q0 + 256 + 128); NT = 4 + (we - wbase) / 64; }
    else { const int r0 = q0 >> 6; wbase = min(max(r0 - 4, 0), 120); const int kre = min(max(r0 - 1, 0), 120) + 8; NT = 4 + (kre - wbase); }
#define FA_KEY0(t) ((MODE == 0 || MODE == 3 || (t) < 4) ? 64 * (t) : (MODE == 1 ? CTX + wbase + 64 * ((t) - 4) : CTX + (wbase + (t) - 4) * 64))
    const bf16_t* ksrc = Kg + (size_t)lane * DQK; const bf16_t* vsrc = Vg + (size_t)(16 * (wid & 3) + (lane >> 2)) * 64 + (wid >> 2) * 32 + (lane & 3) * 8;
#define FA_DMA(t, s) do { const int k0_ = FA_KEY0(t); \
        _Pragma("unroll") for (int c_ = 0; c_ < 2; ++c_) { const int ch_ = wid + 8 * c_; if (ch_ < NCH) glds16(ksrc + (size_t)k0_ * DQK + ch_ * 8, (unsigned)__builtin_amdgcn_readfirstlane(lds0 + (s) * STG + ch_ * 1024)); } \
        glds16(vsrc + (size_t)k0_ * 64, (unsigned)__builtin_amdgcn_readfirstlane(lds0 + (s) * STG + KSTG + wid * 1024)); } while (0)
    FA_DMA(0, 0);
    if (MODE == 2) { float* rp = (float*)(shm + LDS_RPB); for (int i = tid; i < 15 * 31; i += 512) rp[i] = rpb[i] * LOG2E; }
    bf16x8 qr[ND0];
#pragma unroll
    for (int d0 = 0; d0 < ND0; ++d0) qr[d0] = *reinterpret_cast<const bf16x8*>(Qg + (size_t)(wid * 32 + r32) * DQK + d0 * 16 + hi * 8);
    float mhat = -1e30f, l_reg = 0.f; f32x16 o[2];
#pragma unroll
    for (int r = 0; r < 16; ++r) { o[0][r] = 0.f; o[1][r] = 0.f; }
    const int qpos = q0 + wid * 32 + r32;
    const int rq = (q0 >> 6) + (wid >> 1), jq = 32 * (wid & 1) + r32;
    const int rs = min(max(rq - 4, 0), 120), cs = min(max(jq - 8, 0), 48);
    const lds_cptr shm3 = (lds_cptr)shm;
    FA_WAIT_BAR();
    for (int t = 0; t < NT; ++t) {
        const int s = t & 1;
        if (t + 1 < NT) FA_DMA(t + 1, s ^ 1);
        bool active = true;
        if (MODE == 1 && t >= 4) { const int kp0 = wbase + 64 * (t - 4), qw0 = q0 + wid * 32; active = (kp0 + 63 >= qw0 - 128) && (kp0 <= qw0 + 31 + 128); }
        if (MODE == 2 && t >= 4) { const int kr = wbase + t - 4; active = (kr >= rs) && (kr < rs + 8); }
        if (active) {
            const lds_cptr kb = shm3 + s * STG + hi * 1024 + r32 * 16;
            f32x16 p0, p1;
#pragma unroll
            for (int r = 0; r < 16; ++r) { p0[r] = 0.f; p1[r] = 0.f; }
#pragma unroll
            for (int d0 = 0; d0 < ND0; ++d0) {
                const bf16x8 b0 = *(const __attribute__((address_space(3))) bf16x8*)(kb + d0 * 2048);
                const bf16x8 b1 = *(const __attribute__((address_space(3))) bf16x8*)(kb + d0 * 2048 + 512);
                p0 = __builtin_amdgcn_mfma_f32_32x32x16_bf16(b0, qr[d0], p0, 0, 0, 0);
                p1 = __builtin_amdgcn_mfma_f32_32x32x16_bf16(b1, qr[d0], p1, 0, 0, 0);
            }
            if (MODE == 1 && t >= 4) { const int kp0 = wbase + 64 * (t - 4) - qpos;
#pragma unroll
                for (int r = 0; r < 16; ++r) { const int d0_ = kp0 + crow(r, hi), d1_ = d0_ + 32; if (d0_ < -128 || d0_ > 128) p0[r] = -INFINITY; if (d1_ < -128 || d1_ > 128) p1[r] = -INFINITY; } }
            if (MODE == 2 && t >= 4) { const int kr = wbase + t - 4; const float* rp = (const float*)(shm + LDS_RPB) + (kr - rq + 7) * 31 + 15 - jq;
#pragma unroll
                for (int r = 0; r < 16; ++r) { const int kc0 = crow(r, hi), kc1 = kc0 + 32;
                    const bool v0 = (kc0 >= cs) && (kc0 < cs + 16), v1 = (kc1 >= cs) && (kc1 < cs + 16);
                    p0[r] = v0 ? p0[r] + rp[v0 ? kc0 : jq] : -INFINITY; p1[r] = v1 ? p1[r] + rp[v1 ? kc1 : jq] : -INFINITY; } }
            float rm = fmaxf(p0[0], p1[0]);
#pragma unroll
            for (int r = 1; r < 16; ++r) rm = fmaxf(rm, fmaxf(p0[r], p1[r]));
            rm = xhalf_max(rm);
            if (__any(rm - mhat > THR)) {
                const float mn = fmaxf(mhat, rm), f = __builtin_amdgcn_exp2f(mhat - mn); mhat = mn; l_reg *= f;
                if (hi == 0) wsf[r32] = f;
#pragma unroll
                for (int r = 0; r < 16; ++r) { const float fr = wsf[crow(r, hi)]; o[0][r] *= fr; o[1][r] *= fr; }
            }
            float sacc = 0.f;
#pragma unroll
            for (int r = 0; r < 16; ++r) { p0[r] = __builtin_amdgcn_exp2f(p0[r] - mhat); p1[r] = __builtin_amdgcn_exp2f(p1[r] - mhat); sacc += p0[r] + p1[r]; }
            l_reg += sacc;
            u32x4 pw0, pw1, pw2, pw3;
            pw0 = (u32x4){cvtpk(p0[0], p0[1]), cvtpk(p0[2], p0[3]), cvtpk(p0[4], p0[5]), cvtpk(p0[6], p0[7])};
            pw1 = (u32x4){cvtpk(p0[8], p0[9]), cvtpk(p0[10], p0[11]), cvtpk(p0[12], p0[13]), cvtpk(p0[14], p0[15])};
            pw2 = (u32x4){cvtpk(p1[0], p1[1]), cvtpk(p1[2], p1[3]), cvtpk(p1[4], p1[5]), cvtpk(p1[6], p1[7])};
            pw3 = (u32x4){cvtpk(p1[8], p1[9]), cvtpk(p1[10], p1[11]), cvtpk(p1[12], p1[13]), cvtpk(p1[14], p1[15])};
            const lds_cptr vp = shm3 + s * STG + KSTG + ((lane >> 4) & 1) * 32 + (lane & 3) * 8 + (4 * hi + ((lane & 15) >> 2)) * 64;
#pragma unroll
            for (int dh = 0; dh < 2; ++dh) {
                s16x4 vlo[4], vhi[4];
#pragma unroll
                for (int ks = 0; ks < 4; ++ks) { vlo[ks] = vtr(vp + dh * 4096 + ks * 1024); vhi[ks] = vtr(vp + dh * 4096 + ks * 1024 + 512); }
#define FA_VFR(k) (bf16x8){vlo[k][0], vlo[k][1], vlo[k][2], vlo[k][3], vhi[k][0], vhi[k][1], vhi[k][2], vhi[k][3]}
                o[dh] = __builtin_amdgcn_mfma_f32_32x32x16_bf16(__builtin_bit_cast(bf16x8, pw0), FA_VFR(0), o[dh], 0, 0, 0);
                o[dh] = __builtin_amdgcn_mfma_f32_32x32x16_bf16(__builtin_bit_cast(bf16x8, pw1), FA_VFR(1), o[dh], 0, 0, 0);
                o[dh] = __builtin_amdgcn_mfma_f32_32x32x16_bf16(__builtin_bit_cast(bf16x8, pw2), FA_VFR(2), o[dh], 0, 0, 0);
                o[dh] = __builtin_amdgcn_mfma_f32_32x32x16_bf16(__builtin_bit_cast(bf16x8, pw3), FA_VFR(3), o[dh], 0, 0, 0);
#undef FA_VFR
            }
        }
        FA_WAIT_BAR();
    }
    l_reg = xhalf_sum(l_reg);
    if (MODE == 1 || MODE == 3) l_reg += __builtin_amdgcn_exp2f(sink2 - mhat);
    if (hi == 0) wsf[32 + r32] = 1.0f / l_reg;
    float rli[16];
#pragma unroll
    for (int r = 0; r < 16; ++r) rli[r] = wsf[32 + crow(r, hi)];
    bf16_t* stg = (bf16_t*)(shm + LDS_OST) + wid * 2048;
#pragma unroll
    for (int r = 0; r < 16; ++r) { const int orow = crow(r, hi);
#pragma unroll
        for (int dh = 0; dh < 2; ++dh) stg[orow * 64 + dh * 32 + r32] = (bf16_t)f2bf(o[dh][r] * rli[r]); }
#pragma unroll
    for (int i = 0; i < 4; ++i) { const int row = i * 8 + (lane >> 3), ch = lane & 7; const u32x4 v = *(const u32x4*)(stg + row * 64 + ch * 8); *(u32x4*)(Og + (size_t)(wid * 32 + row) * D + ch * 8) = v; }
    asm volatile("s_waitcnt lgkmcnt(0)\n\ts_barrier" ::: "memory");
#undef FA_DMA
#undef FA_KEY0
}
#undef FA_WAIT_BAR
}

constexpr float SCALE_MLA = 0.10206207261596575f;
__device__ __forceinline__ void ph_attn(const Params& p, int layer, bool with_ctx, char* shm) {
    const QKVB qb = make_qkv(p.ws);
    bf16_t* O = (bf16_t*)(p.ws + WS_P);
    const int G = gridDim.x;
    const float NEG = -INFINITY;
    for (int u = blockIdx.x; u < 256; u += G) { const int bh = u & 7, b = bh >> 2, h = bh & 3, qbk = u >> 3;
        fa::attn_unit<96, 0>(qb.QD + ((size_t)bh * SEQ + qbk * 256) * 96, qb.KD + (size_t)bh * KEYS * 96, qb.VD + (size_t)bh * KEYS * 64, O + (size_t)(b * SEQ + qbk * 256) * D + 768 + h * 64, qbk * 256, NEG, nullptr, shm); }
    for (int u = blockIdx.x; u < 256; u += G) { const int bh = u & 7, b = bh >> 2, h = bh & 3, qbk = u >> 3;
        fa::attn_unit<64, 0>(qb.QB + ((size_t)bh * SEQ + qbk * 256) * 64, qb.KB + (size_t)(b * 2 + (h >> 1)) * KEYS * 64, qb.VB + (size_t)(b * 2 + (h >> 1)) * KEYS * 64, O + (size_t)(b * SEQ + qbk * 256) * D + 256 + h * 64, qbk * 256, NEG, nullptr, shm); }
    for (int u = blockIdx.x; u < 256; u += G) { const int bh = u & 7, b = bh >> 2, h = bh & 3, qbk = u >> 3;
        fa::attn_unit<64, 1>(qb.QA + ((size_t)bh * SEQ + qbk * 256) * 64, qb.KA + (size_t)(b * 2 + (h >> 1)) * KEYS * 64, qb.VA + (size_t)(b * 2 + (h >> 1)) * KEYS * 64, O + (size_t)(b * SEQ + qbk * 256) * D + 0 + h * 64, qbk * 256, p.in[11][layer * 4 + h] * fa::LOG2E, nullptr, shm); }
    for (int u = blockIdx.x; u < 256; u += G) { const int bh = u & 7, b = bh >> 2, h = bh & 3, qbk = u >> 3;
        fa::attn_unit<64, 2>(qb.QC + ((size_t)bh * SEQ + qbk * 256) * 64, qb.KC + (size_t)bh * KEYS * 64, qb.VC + (size_t)bh * KEYS * 64, O + (size_t)(b * SEQ + qbk * 256) * D + 512 + h * 64, qbk * 256, NEG, p.in[16] + ((size_t)layer * 4 + h) * 15 * 31, shm); }
    if (with_ctx) for (int u = blockIdx.x; u < 32; u += G) { const int ty = u >> 3, bh = u & 7, b = bh >> 2, h = bh & 3;
        bf16_t* Oc = O + (size_t)(TL + b * CTX) * D + ty * 256 + h * 64;
        if (ty == 0) fa::attn_unit<64, 3>(qb.QAc + (size_t)bh * CTX * 64, qb.KA + (size_t)(b * 2 + (h >> 1)) * KEYS * 64, qb.VA + (size_t)(b * 2 + (h >> 1)) * KEYS * 64, Oc, 0, p.in[11][layer * 4 + h] * fa::LOG2E, nullptr, shm);
        else if (ty == 1) fa::attn_unit<64, 3>(qb.QBc + (size_t)bh * CTX * 64, qb.KB + (size_t)(b * 2 + (h >> 1)) * KEYS * 64, qb.VB + (size_t)(b * 2 + (h >> 1)) * KEYS * 64, Oc, 0, NEG, nullptr, shm);
        else if (ty == 2) fa::attn_unit<64, 3>(qb.QCc + (size_t)bh * CTX * 64, qb.KC + (size_t)bh * KEYS * 64, qb.VC + (size_t)bh * KEYS * 64, Oc, 0, NEG, nullptr, shm);
        else fa::attn_unit<96, 3>(qb.QDc + (size_t)bh * CTX * 96, qb.KD + (size_t)bh * KEYS * 96, qb.VD + (size_t)bh * KEYS * 64, Oc, 0, NEG, nullptr, shm); }
}

__device__ __forceinline__ void ph_gnorm(const Params& p, int layer, int nrows) {
    const int tx = opq((int)threadIdx.x), lane = tx & 63, gw = (blockIdx.x * 512 + tx) >> 6, ngw = (gridDim.x * 512) >> 6;
    const bf16_t* O = (const bf16_t*)(p.ws + WS_P); bf16_t* Y = (bf16_t*)(p.ws + WS_ACT1); const float* g = p.in[23] + layer * D;
    for (int m = gw; m < nrows; m += ngw) {
#pragma unroll
        for (int grp = 0; grp < 4; ++grp) { const int c = grp * 256 + 4 * lane; const u32x2 w = *(const u32x2*)(O + (size_t)m * D + c);
            const float a0 = bflo(w.x), a1 = bfhi(w.x), a2 = bflo(w.y), a3 = bfhi(w.y);
            const float r = rsqrtf(wave_sum(a0 * a0 + a1 * a1 + a2 * a2 + a3 * a3) * (1.f / 256.f) + EPS);
            const f32x4 gv = *(const f32x4*)(g + c); u32x2 o; o.x = pk2(a0 * r * gv.x, a1 * r * gv.y); o.y = pk2(a2 * r * gv.z, a3 * r * gv.w);
            *(u32x2*)(Y + (size_t)m * D + c) = o; }
    }
}

__device__ __forceinline__ void moe_bases(const unsigned* cnt, int (&base)[9]) {
    int acc = 0;
#pragma unroll
    for (int e = 0; e < 8; ++e) { base[e] = acc; acc += ((int)cnt[64 * e] + 255) / 256 * 256; }
    base[8] = acc;
}
__device__ __forceinline__ void ph_moe_gather(const Params& p) {
    const int tx = opq((int)threadIdx.x), lane = tx & 63, gw = (blockIdx.x * 512 + tx) >> 6, ngw = (gridDim.x * 512) >> 6;
    const unsigned* cnt = (const unsigned*)(p.ws + WS_CTL); int base[9]; moe_bases(cnt, base);
    if (blockIdx.x == 0 && tx < 136) { const int r = tx * 256; int e = -1;
#pragma unroll
        for (int i = 0; i < 8; ++i) if (r >= base[i] && r < base[i + 1]) e = i;
        ((int*)(p.ws + WS_TEXP))[tx] = e < 0 ? 0 : e; }
    const bf16_t* F = (const bf16_t*)(p.ws + WS_ACT1); bf16_t* A = (bf16_t*)(p.ws + WS_ASORT);
    for (int m = gw; m < TL; m += ngw) {
        const int2 e = ((const int2*)(p.ws + WS_TOKE))[m]; const int2 ps = ((const int2*)(p.ws + WS_TOKP))[m];
        int b0 = 0, b1 = 0;
#pragma unroll
        for (int i = 0; i < 8; ++i) { if (e.x == i) b0 = base[i]; if (e.y == i) b1 = base[i]; }
        const int s0 = b0 + ps.x, s1 = b1 + ps.y;
        const u32x4 v0 = *(const u32x4*)(F + (size_t)m * D + lane * 16), v1 = *(const u32x4*)(F + (size_t)m * D + lane * 16 + 8);
        *(u32x4*)(A + (size_t)s0 * D + lane * 16) = v0; *(u32x4*)(A + (size_t)s0 * D + lane * 16 + 8) = v1;
        *(u32x4*)(A + (size_t)s1 * D + lane * 16) = v0; *(u32x4*)(A + (size_t)s1 * D + lane * 16 + 8) = v1;
        if (lane == 0) ((int2*)(p.ws + WS_TOKS))[m] = make_int2(s0, s1);
    }
}
__device__ __forceinline__ void ph_moe_combine(const Params& p, int layer) {
    const size_t nthr = (size_t)gridDim.x * 512;
    for (size_t idx = (size_t)blockIdx.x * 512 + opq((int)threadIdx.x); idx < (size_t)TL * 256; idx += nthr) {
        const int m = (int)(idx >> 8), c = (int)(idx & 255) * 4;
        const int2 sl = ((const int2*)(p.ws + WS_TOKS))[m]; const float2 g = ((const float2*)(p.ws + WS_TOKG))[m];
        const bf16_t* Y = (const bf16_t*)(p.ws + WS_ASORT);
        const u32x2 a = *(const u32x2*)(Y + (size_t)sl.x * D + c), b = *(const u32x2*)(Y + (size_t)sl.y * D + c);
        const f32x4 ya = {bflo(a.x), bfhi(a.x), bflo(a.y), bfhi(a.y)}, yb = {bflo(b.x), bfhi(b.x), bflo(b.y), bfhi(b.y)};
        const float* mod = (const float*)(p.ws + WS_MOD) + (size_t)layer * 3 * 6144 + (m / SEQ) * 6144 + 5 * D;
        f32x4* o = (f32x4*)(p.out + (size_t)m * D + c);
        *o = *o + *(const f32x4*)(mod + c) * (ya * g.x + yb * g.y);
    }
}

#ifndef DBL_PHASE
#define DBL_PHASE (-1)
#endif
struct Args { Params p; int ph_lo, ph_hi; };
__global__ void __launch_bounds__(NWAVES * 64, 2) mega_fwd(Args args) {
    extern __shared__ __attribute__((aligned(16))) unsigned char lds[];
    LAS unsigned char* ldsl = (LAS unsigned char*)lds;
    for (int u = threadIdx.x; u < (LDS_BYTES - LDSCTL_OFF) / 4; u += NWAVES * 64) ((LAS unsigned*)(ldsl + LDSCTL_OFF))[u] = 0u;
    __syncthreads();
    XcdBarrier bar = xcd_barrier_post((unsigned*)(args.p.ws + WS_CTL) + CW_BAR, (volatile LAS unsigned*)(ldsl + MISC_OFF) + 8);
    const int lo = args.ph_lo, hi = args.ph_hi; int ph = 0;
#define PHASE(body) do { if (lo <= ph && ph < hi) { Params q = args.p; q.ws = opqp(args.p.ws); q.out = opqp(args.p.out); LAS unsigned char* ldq = (LAS unsigned char*)lds; (void)ldq; for (int rep_ = 0; rep_ < ((ph == DBL_PHASE) ? 2 : 1); ++rep_) { if (rep_) xcd_barrier(bar); body; } if (ph + 1 < hi) xcd_barrier(bar); } ++ph; } while (0)
#define QMOD(l) ((const float*)(q.ws + WS_MOD) + (size_t)(l) * 3 * 6144)
    PHASE(ph_prologue(q, (float*)lds));
#pragma unroll 1
    for (int l = 0; l < 2; ++l) {
        const bool last = (l == 1);
        const int nrows = last ? TL : MALL;
        PHASE((ph_norm<1, false>(q, l, MALL, (unsigned*)lds)));
        PHASE(run_gemm(ldq, (const bf16_t*)(q.ws + WS_ACT1), (const bf16_t*)(q.ws + WS_WIN) + (size_t)l * NINP * D, D, MALL / 256, NINP / 256, nullptr, 0, EpiBf16Perm{(bf16_t*)(q.ws + WS_P), NINP, 0}));
        PHASE(ph_postproj2(q, l));
        PHASE(ph_attn(q, l, !last, (char*)lds));
        PHASE(ph_gnorm(q, l, nrows));
        PHASE(run_gemm(ldq, (const bf16_t*)(q.ws + WS_ACT1), (const bf16_t*)(q.ws + WS_WOUT) + (size_t)l * D * D, D, nrows / 256, D / 256, nullptr, 0,
                       EpiResid{(l == 0) ? q.in[0] : q.out, (l == 0) ? q.in[2] : (const float*)(q.ws + WS_HCTX), q.out, (float*)(q.ws + WS_HCTX), QMOD(l), 2 * D, 0}));
        if (!last) {
            PHASE((ph_norm<2, false>(q, l, MALL, (unsigned*)lds)));
            PHASE(run_gemm(ldq, (const bf16_t*)(q.ws + WS_ACT1), (const bf16_t*)(q.ws + WS_WFGU), D, MALL / 256, 2 * DFF / 256, nullptr, 0, EpiSwiglu{(bf16_t*)(q.ws + WS_HIDF), DFF, 0}));
            PHASE(run_gemm(ldq, (const bf16_t*)(q.ws + WS_HIDF), (const bf16_t*)(q.ws + WS_WFDN), DFF, MALL / 256, D / 256, nullptr, 0,
                           EpiResid{q.out, (const float*)(q.ws + WS_HCTX), q.out, (float*)(q.ws + WS_HCTX), QMOD(l), 5 * D, 0}));
        } else {
            PHASE((ph_norm<2, true>(q, l, TL, (unsigned*)lds)));
            PHASE(ph_moe_gather(q));
            PHASE({ int base[9]; moe_bases((const unsigned*)(q.ws + WS_CTL), base); run_gemm(ldq, (const bf16_t*)(q.ws + WS_ASORT), (const bf16_t*)(q.ws + WS_WMGU), D, base[8] / 256, 2 * DFFE / 256, (const int*)(q.ws + WS_TEXP), (size_t)2 * DFFE * D * 2, EpiSwiglu{(bf16_t*)(q.ws + WS_HIDM), DFFE, 0}); });
            PHASE({ int base[9]; moe_bases((const unsigned*)(q.ws + WS_CTL), base); run_gemm(ldq, (const bf16_t*)(q.ws + WS_HIDM), (const bf16_t*)(q.ws + WS_WMDN), DFFE, base[8] / 256, D / 256, (const int*)(q.ws + WS_TEXP), (size_t)D * DFFE * 2, EpiBf16Perm{(bf16_t*)(q.ws + WS_ASORT), D, 0}); });
            PHASE(ph_moe_combine(q, l));
        }
    }
#undef QMOD
#undef PHASE
}

#ifndef MK_CUTS
#define MK_CUTS 0
#endif
extern "C" void kernel_launch(void* const* d_in, const int* in_sizes, int n_in, void* d_out, int out_size, void* d_ws, size_t ws_size, hipStream_t stream) {
    static int grid = 0;
    if (grid == 0) {
        if (n_in != 32 || ws_size < WS_END) { fprintf(stderr, "kernel_launch: need 32 inputs and %zu bytes of workspace (got %d, %zu)\n", (size_t)WS_END, n_in, ws_size); grid = -1; return; }
        int dev = 0, cus = 0, per_cu = 0;
        if (hipGetDevice(&dev) != hipSuccess || hipDeviceGetAttribute(&cus, hipDeviceAttributeMultiprocessorCount, dev) != hipSuccess) { grid = -1; return; }
        if (hipFuncSetAttribute((const void*)mega_fwd, hipFuncAttributeMaxDynamicSharedMemorySize, LDS_BYTES) != hipSuccess) { fprintf(stderr, "kernel_launch: hipFuncSetAttribute failed\n"); grid = -1; return; }
        if (hipOccupancyMaxActiveBlocksPerMultiprocessor(&per_cu, (const void*)mega_fwd, NWAVES * 64, LDS_BYTES) != hipSuccess || per_cu < 1) fprintf(stderr, "kernel_launch: occupancy query says %d blocks per CU\n", per_cu);
        (void)hipGetLastError();
        grid = cus;
    }
    if (grid < 0) return;
    (void)hipMemsetAsync((char*)d_ws + WS_CTL, 0, CTL_ZERO_BYTES, stream);
    Args a{}; for (int i = 0; i < 32; ++i) a.p.in[i] = (const float*)d_in[i]; a.p.out = (float*)d_out; a.p.ws = (unsigned char*)d_ws;
#if MK_CUTS
    for (int ph = 0; ph < 24; ++ph) { a.ph_lo = ph; a.ph_hi = ph + 1; hipLaunchKernelGGL(mega_fwd, dim3(grid), dim3(NWAVES * 64), LDS_BYTES, stream, a); }
#else
    a.ph_lo = 0; a.ph_hi = 21;
    hipLaunchKernelGGL(mega_fwd, dim3(grid), dim3(NWAVES * 64), LDS_BYTES, stream, a);
#endif
}
```

```cpp
#include <hip/hip_runtime.h>
#include <stdint.h>
#include <cstdio>

typedef unsigned short bf16_t;
typedef float f32x4 __attribute__((ext_vector_type(4)));
typedef unsigned u32x4 __attribute__((ext_vector_type(4)));
typedef unsigned u32x2 __attribute__((ext_vector_type(2)));

constexpr int D = 1024, NB = 2, SEQ = 8192, CTX = 256, TL = NB * SEQ, TC = NB * CTX, MALL = TL + TC;
constexpr int NIN = 2144, NINP = 2304, DFF = 2816, NE = 8, DFFE = 3584, KEYS = CTX + SEQ;
constexpr int OFF_AQ = 0, OFF_AK = 256, OFF_AV = 384, OFF_BQ = 512, OFF_BK = 768, OFF_BV = 896, OFF_CQ = 1024, OFF_CK = 1280,
              OFF_CV = 1536, OFF_DCQ = 1792, OFF_DCKV = 1984, OFF_DKR = 2112;
constexpr int MOE_ROWS = 34816;
constexpr float EPS = 1e-6f;

constexpr size_t MiB = 1u << 20;
constexpr size_t WS_CTL = 0;
constexpr size_t WS_MOD = 1 * MiB;
constexpr size_t WS_ROPE = WS_MOD + 256 * 1024;
constexpr size_t WS_TOKE = WS_ROPE + 64 * 1024;
constexpr size_t WS_TOKP = WS_TOKE + TL * 8;
constexpr size_t WS_TOKG = WS_TOKP + TL * 8;
constexpr size_t WS_TEXP = WS_TOKG + TL * 8;
constexpr size_t WS_TOKS = WS_TEXP + 1024;
constexpr size_t WS_HCTX = 2 * MiB;
constexpr size_t WS_WMGU = 6 * MiB;
constexpr size_t WS_WMDN = WS_WMGU + 112 * MiB;
constexpr size_t WS_WDEAD = WS_WMDN + 56 * MiB;
constexpr size_t WS_WIN = WS_WDEAD;
constexpr size_t WS_WOUT = WS_WIN + 9 * MiB;
constexpr size_t WS_WUQ = WS_WOUT + 4 * MiB;
constexpr size_t WS_WUKV = WS_WUQ + 512 * 1024;
constexpr size_t WS_WFGU = WS_WUKV + 512 * 1024;
constexpr size_t WS_WFDN = WS_WFGU + 11 * MiB;
constexpr size_t WS_ACT = 205 * MiB;
static_assert(WS_WFDN + (size_t)1024 * 2816 * 2 <= WS_ACT, "weights fit");
constexpr size_t WS_ACT1 = WS_ACT;
constexpr size_t WS_P = WS_ACT + 33 * MiB;
constexpr size_t WS_QKV = WS_ACT + 108 * MiB;
constexpr size_t WS_HIDF = WS_P;
constexpr size_t WS_HIDM = WS_WDEAD;
constexpr size_t WS_ASORT = WS_HIDM + 238 * MiB;
constexpr size_t WS_END = WS_ASORT + 68 * MiB;
static_assert(WS_QKV + 91 * MiB <= WS_END, "qkv fits");

struct Params { const float* in[32]; float* out; unsigned char* ws; };

struct QKVB { bf16_t *QA, *KA, *VA, *QB, *KB, *VB, *QC, *KC, *VC, *QD, *KD, *VD, *QAc, *QBc, *QCc, *QDc; };
__host__ __device__ inline QKVB make_qkv(unsigned char* ws) {
    QKVB q; bf16_t* p = (bf16_t*)(ws + WS_QKV);
    q.QA = p; p += (size_t)NB * 4 * SEQ * 64; q.KA = p; p += (size_t)NB * 2 * KEYS * 64; q.VA = p; p += (size_t)NB * 2 * KEYS * 64;
    q.QB = p; p += (size_t)NB * 4 * SEQ * 64; q.KB = p; p += (size_t)NB * 2 * KEYS * 64; q.VB = p; p += (size_t)NB * 2 * KEYS * 64;
    q.QC = p; p += (size_t)NB * 4 * SEQ * 64; q.KC = p; p += (size_t)NB * 4 * KEYS * 64; q.VC = p; p += (size_t)NB * 4 * KEYS * 64;
    q.QD = p; p += (size_t)NB * 4 * SEQ * 96; q.KD = p; p += (size_t)NB * 4 * KEYS * 96; q.VD = p; p += (size_t)NB * 4 * KEYS * 64;
    q.QAc = p; p += (size_t)NB * 4 * CTX * 64; q.QBc = p; p += (size_t)NB * 4 * CTX * 64; q.QCc = p; p += (size_t)NB * 4 * CTX * 64;
    q.QDc = p; p += (size_t)NB * 4 * CTX * 96;
    return q;
}

__device__ __forceinline__ float bf2f(unsigned v) { return __uint_as_float(v << 16); }
__device__ __forceinline__ float bflo(unsigned w) { return __uint_as_float(w << 16); }
__device__ __forceinline__ float bfhi(unsigned w) { return __uint_as_float(w & 0xffff0000u); }
__device__ __forceinline__ unsigned f2bf(float f) { unsigned u = __float_as_uint(f); return (u + 0x7fffu + ((u >> 16) & 1u)) >> 16; }
__device__ __forceinline__ unsigned pk2(float lo, float hi) { return f2bf(lo) | (f2bf(hi) << 16); }
template <int X> __device__ __forceinline__ float swz_xor(float v) { return __int_as_float(__builtin_amdgcn_ds_swizzle(__float_as_int(v), 0x1f | (X << 10))); }
__device__ __forceinline__ float half_sum(float v) { auto rr = __builtin_amdgcn_permlane32_swap(__float_as_uint(v), __float_as_uint(v), false, false); return __uint_as_float(rr[0]) + __uint_as_float(rr[1]); }
__device__ __forceinline__ float half_other(float v, int lane) { auto rr = __builtin_amdgcn_permlane32_swap(__float_as_uint(v), __float_as_uint(v), false, false); return __uint_as_float((lane & 32) ? rr[0] : rr[1]); }
__device__ __forceinline__ float wave_sum(float v) { v += swz_xor<1>(v); v += swz_xor<2>(v); v += swz_xor<4>(v); v += swz_xor<8>(v); v += swz_xor<16>(v); return half_sum(v); }
__device__ __forceinline__ int opq(int v) { asm volatile("" : "+v"(v)); return v; }
template <class T> __device__ __forceinline__ T* opqp(T* p) { asm volatile("" : "+s"(p)); return p; }
__device__ __forceinline__ float silu_f(float x) { return x / (1.f + expf(-x)); }

__device__ __forceinline__ void sincos_d(double a, double& s, double& c) {
    const double k = rint(a * 0.63661977236758134308);
    double r = a - k * 1.57079632679489655800e+00; r -= k * 6.12323399573676603587e-17;
    const double r2 = r * r;
    double sp = 1.0 / 121645100408832000.0;
    sp = sp * r2 - 1.0 / 355687428096000.0; sp = sp * r2 + 1.0 / 1307674368000.0; sp = sp * r2 - 1.0 / 6227020800.0; sp = sp * r2 + 1.0 / 39916800.0;
    sp = sp * r2 - 1.0 / 362880.0; sp = sp * r2 + 1.0 / 5040.0; sp = sp * r2 - 1.0 / 120.0; sp = sp * r2 + 1.0 / 6.0; sp = -sp * r2 + 1.0;
    const double sr = r * sp;
    double cp = 1.0 / 6402373705728000.0;
    cp = cp * r2 - 1.0 / 20922789888000.0; cp = cp * r2 + 1.0 / 87178291200.0; cp = cp * r2 - 1.0 / 479001600.0; cp = cp * r2 + 1.0 / 3628800.0;
    cp = cp * r2 - 1.0 / 40320.0; cp = cp * r2 + 1.0 / 720.0; cp = cp * r2 - 1.0 / 24.0; cp = cp * r2 + 0.5; const double cr = 1.0 - cp * r2;
    const int q = ((int)k) & 3;
    s = (q == 0) ? sr : (q == 1) ? cr : (q == 2) ? -sr : -cr;
    c = (q == 0) ? cr : (q == 1) ? -sr : (q == 2) ? -cr : sr;
}
constexpr int RT_R64 = 0, RT_C64 = 2048, RT_R32 = 3072, RT_C32 = 4096, RT_N = 4608;

namespace pg8 {
#define PG8_LAS __attribute__((address_space(3)))
typedef unsigned short bf16_t;
typedef short bf16x8 __attribute__((ext_vector_type(8)));
typedef float f32x4 __attribute__((ext_vector_type(4)));
typedef unsigned u32x4 __attribute__((ext_vector_type(4)));
constexpr int BM = 256, BK = 64, HALF = 128, HTB = HALF * BK * 2  , STAGE_BYTES = 8 * HTB, NXCD = 8, WGM = 8;

__host__ __device__ __forceinline__ int lds_byte(int r, int c) { const int st = (r >> 4) * 2 + (c >> 5), rr = r & 15, cc = c & 31, ob = rr * 64 + cc * 2; return st * 1024 + (ob ^ (((ob >> 9) & 1) << 5)); }
__host__ __device__ __forceinline__ void stage_rc(int b, int& R, int& C) { const int st = b / 1024, sb = b % 1024, swz = sb ^ (((sb >> 9) & 1) << 5); R = (st >> 1) * 16 + swz / 64; C = (st & 1) * 32 + (swz % 64) / 2; }
__host__ __device__ __forceinline__ int perm32(int rho) { const int n = rho >> 4, i = rho & 15; return 8 * (i >> 2) + 4 * n + (i & 3); }

struct Unit { int pm, pn, e; };
struct Gemm { const bf16_t* A; const bf16_t* Bt; int K; size_t estride; };

struct StaticOrder {
    int nM, nN, nwg, G, c; const int* texp;
    __host__ __device__ void init(int nM_, int nN_, int G_, int c_, const int* texp_) { nM = nM_; nN = nN_; nwg = nM * nN; G = G_; c = c_; texp = texp_; }
    __host__ __device__ bool next(int i, Unit& u) const {
        const long L = (long)i * G + c; if (L >= nwg) return false;
        int wgid = (int)L; { const int q = nwg / NXCD, r = nwg % NXCD, xcd = wgid % NXCD, off = wgid / NXCD; wgid = (xcd < r ? xcd * (q + 1) : r * (q + 1) + (xcd - r) * q) + off; }
        const int nig = WGM * nN, gid = wgid / nig, fm = gid * WGM, gsz = (nM - fm) < WGM ? (nM - fm) : WGM;
        u.pm = fm + ((wgid % nig) % gsz); u.pn = (wgid % nig) / gsz; u.e = texp ? texp[u.pm] : 0; return true;
    }
    __device__ __forceinline__ void a_ready(const Unit&) const {}
    __device__ __forceinline__ void done(const Unit&) const {}
};

template <class Epi, class Sched, bool ALIGN_EPI = false, bool SP2 = false>
__device__ __forceinline__ void gemm_phase(PG8_LAS unsigned char* lds, const Gemm g, const Sched& S, const Epi& E) {
    const int tid = opq((int)threadIdx.x), wid = __builtin_amdgcn_readfirstlane(tid >> 6), lane = tid & 63, wr = wid >> 2, wc = wid & 3, fr = lane & 15, fq = lane >> 4;
    const int K = g.K, nt = K / BK;
    unsigned voffA[2], voffB[2];
#pragma unroll
    for (int i = 0; i < 2; ++i) { int R, C; stage_rc(tid * 16 + i * 8192, R, C); const int Rb = Epi::PERM ? ((R & ~31) + perm32(R & 31)) : R;
        voffA[i] = (unsigned)(R * K + C) * 2u; voffB[i] = (unsigned)(Rb * K + C) * 2u; }
    const size_t kstep = (size_t)(BK * 2);
    const size_t hstep = (size_t)HALF * K * 2;
    const size_t tstep = 2 * hstep;
    const unsigned ldsw = (unsigned)wid * 1024u;
    const int aoff = lds_byte(wr * 64 + fr, fq * 8), boff = lds_byte(wc * 32 + fr, fq * 8);
#define PG8_SA(b, h) (((b) * 2 + (h)) * HTB)
#define PG8_SB(b, h) ((4 + (b) * 2 + (h)) * HTB)
#define PG8_STAGE(bufoff, gbase, voff) do { _Pragma("unroll") for (int _i = 0; _i < 2; ++_i) \
        __builtin_amdgcn_global_load_lds((const unsigned*)((const char*)(gbase) + (voff)[_i]), (PG8_LAS unsigned*)(lds + (bufoff) + ldsw + _i * 8192), 16, 0, 0); } while (0)
#define PG8_LDA(dst, b, h) do { _Pragma("unroll") for (int m = 0; m < 4; ++m) _Pragma("unroll") for (int k = 0; k < 2; ++k) dst[m][k] = *(const PG8_LAS bf16x8*)(lds + PG8_SA(b, h) + aoff + m * 2048 + k * 1024); } while (0)
#define PG8_LDB(dst, b, h) do { _Pragma("unroll") for (int n = 0; n < 2; ++n) _Pragma("unroll") for (int k = 0; k < 2; ++k) dst[n][k] = *(const PG8_LAS bf16x8*)(lds + PG8_SB(b, h) + boff + n * 2048 + k * 1024); } while (0)
#define PG8_MMA(ai, bj, At, Bt) do { __builtin_amdgcn_s_setprio(1); _Pragma("unroll") for (int m = 0; m < 4; ++m) _Pragma("unroll") for (int n = 0; n < 2; ++n) _Pragma("unroll") for (int k = 0; k < 2; ++k) \
        acc[ai][bj][m][n] = __builtin_amdgcn_mfma_f32_16x16x32_bf16(Bt[n][k], At[m][k], acc[ai][bj][m][n], 0, 0, 0); __builtin_amdgcn_s_setprio(0); } while (0)
#define PG8_WAIT_V(n) asm volatile("s_waitcnt vmcnt(" #n ")" ::: "memory")
#define PG8_WAIT_L(n) asm volatile("s_waitcnt lgkmcnt(" #n ")" ::: "memory")
#define PG8_BAR __builtin_amdgcn_s_barrier()
#define PG8_SCHED __builtin_amdgcn_sched_barrier(0)
    Unit cur, nxt; int ui = 0;
    if (!S.next(0, cur)) return;
    f32x4 acc[2][2][4][2];
#pragma unroll
    for (int a = 0; a < 2; ++a)
#pragma unroll
        for (int b = 0; b < 2; ++b)
#pragma unroll
            for (int m = 0; m < 4; ++m)
#pragma unroll
                for (int n = 0; n < 2; ++n) acc[a][b][m][n] = (f32x4){0.f, 0.f, 0.f, 0.f};
    bf16x8 At[4][2], B0[2][2], B1[2][2];
    const char* cA = (const char*)g.A + (size_t)cur.pm * tstep; const char* cB = (const char*)g.Bt + (size_t)cur.e * g.estride + (size_t)cur.pn * tstep;
    S.a_ready(cur);
    if constexpr (SP2) {
        PG8_STAGE(PG8_SB(0, 0), cB, voffB); PG8_STAGE(PG8_SB(0, 1), cB + hstep, voffB); PG8_STAGE(PG8_SA(0, 0), cA, voffA); PG8_STAGE(PG8_SA(0, 1), cA + hstep, voffA);
        if (wr == 1) PG8_BAR;
        PG8_WAIT_V(2); PG8_BAR;
        PG8_STAGE(PG8_SB(1, 0), cB + kstep, voffB); PG8_STAGE(PG8_SA(1, 0), cA + kstep, voffA); PG8_STAGE(PG8_SB(1, 1), cB + hstep + kstep, voffB);
        PG8_WAIT_V(6); PG8_BAR;
    } else {
        PG8_STAGE(PG8_SB(0, 0), cB, voffB); PG8_STAGE(PG8_SA(0, 0), cA, voffA); PG8_STAGE(PG8_SB(0, 1), cB + hstep, voffB); PG8_STAGE(PG8_SA(0, 1), cA + hstep, voffA);
        if (wr == 1) PG8_BAR;
        PG8_WAIT_V(4); PG8_BAR;
        PG8_STAGE(PG8_SB(1, 0), cB + kstep, voffB); PG8_STAGE(PG8_SA(1, 0), cA + kstep, voffA); PG8_STAGE(PG8_SB(1, 1), cB + hstep + kstep, voffB);
        PG8_WAIT_V(6); PG8_BAR;
    }
    for (;;) {
        const bool has_next = S.next(ui + 1, nxt);
        const char* nA = has_next ? (const char*)g.A + (size_t)nxt.pm * tstep : cA; const char* nB = has_next ? (const char*)g.Bt + (size_t)nxt.e * g.estride + (size_t)nxt.pn * tstep : cB;
        for (int t = 0; t < nt; t += 2) {
            const bool last = (t == nt - 2);
            const char* a1 = cA + (size_t)(t + 1) * kstep;
            const char* a2 = last ? nA : cA + (size_t)(t + 2) * kstep; const char* b2 = last ? nB : cB + (size_t)(t + 2) * kstep;
            const char* a3 = a2 + kstep; const char* b3 = b2 + kstep;
            if (last && has_next) S.a_ready(nxt);
            if constexpr (SP2) {
            PG8_LDB(B0, 0, 0); PG8_LDB(B1, 0, 1); PG8_SCHED; PG8_LDA(At, 0, 0); PG8_STAGE(PG8_SA(1, 1), a1 + hstep, voffA);
            PG8_WAIT_V(8); PG8_WAIT_L(0); PG8_BAR; PG8_MMA(0, 0, At, B0); PG8_MMA(0, 1, At, B1); PG8_BAR; PG8_SCHED;
            PG8_LDA(At, 0, 1); PG8_STAGE(PG8_SB(0, 0), b2, voffB); PG8_STAGE(PG8_SB(0, 1), b2 + hstep, voffB); PG8_STAGE(PG8_SA(0, 0), a2, voffA);
            PG8_WAIT_V(8); PG8_WAIT_L(0); PG8_BAR; PG8_MMA(1, 0, At, B0); PG8_MMA(1, 1, At, B1); PG8_BAR; PG8_SCHED;
            PG8_LDB(B0, 1, 0); PG8_LDB(B1, 1, 1); PG8_SCHED; PG8_LDA(At, 1, 0); PG8_STAGE(PG8_SA(0, 1), a2 + hstep, voffA);
            PG8_WAIT_V(8); PG8_WAIT_L(0); PG8_BAR; PG8_MMA(0, 0, At, B0); PG8_MMA(0, 1, At, B1); PG8_BAR; PG8_SCHED;
            PG8_LDA(At, 1, 1); PG8_STAGE(PG8_SB(1, 0), b3, voffB); PG8_STAGE(PG8_SB(1, 1), b3 + hstep, voffB); PG8_STAGE(PG8_SA(1, 0), a3, voffA);
            PG8_WAIT_V(8); PG8_WAIT_L(0); PG8_BAR; PG8_MMA(1, 0, At, B0); PG8_MMA(1, 1, At, B1); PG8_BAR; PG8_SCHED;
            } else {
            PG8_LDB(B0, 0, 0); PG8_SCHED; PG8_LDA(At, 0, 0); PG8_STAGE(PG8_SA(1, 1), a1 + hstep, voffA);
            PG8_WAIT_L(8); PG8_BAR; PG8_WAIT_L(0); PG8_MMA(0, 0, At, B0); PG8_BAR; PG8_SCHED;
            PG8_LDB(B1, 0, 1); PG8_STAGE(PG8_SB(0, 0), b2, voffB);
            PG8_BAR; PG8_WAIT_L(0); PG8_MMA(0, 1, At, B1); PG8_BAR;
            PG8_LDA(At, 0, 1); PG8_STAGE(PG8_SA(0, 0), a2, voffA);
            PG8_BAR; PG8_WAIT_L(0); PG8_MMA(1, 0, At, B0); PG8_BAR; PG8_SCHED;
            PG8_STAGE(PG8_SB(0, 1), b2 + hstep, voffB);
            PG8_WAIT_V(6); PG8_BAR; PG8_MMA(1, 1, At, B1); PG8_BAR;
            PG8_LDB(B0, 1, 0); PG8_SCHED; PG8_LDA(At, 1, 0); PG8_STAGE(PG8_SA(0, 1), a2 + hstep, voffA);
            PG8_WAIT_L(8); PG8_BAR; PG8_WAIT_L(0); PG8_MMA(0, 0, At, B0); PG8_BAR; PG8_SCHED;
            PG8_LDB(B1, 1, 1); PG8_STAGE(PG8_SB(1, 0), b3, voffB);
            PG8_BAR; PG8_WAIT_L(0); PG8_MMA(0, 1, At, B1); PG8_BAR;
            PG8_LDA(At, 1, 1); PG8_STAGE(PG8_SA(1, 0), a3, voffA);
            PG8_BAR; PG8_WAIT_L(0); PG8_MMA(1, 0, At, B0); PG8_BAR; PG8_SCHED;
            PG8_STAGE(PG8_SB(1, 1), b3 + hstep, voffB);
            PG8_WAIT_V(6); PG8_BAR; PG8_MMA(1, 1, At, B1); PG8_BAR;
            }
        }
        if constexpr (ALIGN_EPI) { if (wr == 0) PG8_BAR; }
        if constexpr (!Epi::AFTER_DRAIN) { E(acc, cur, wr, wc, fr, fq); S.done(cur); }
        if (!has_next) break;
#pragma unroll
        for (int a = 0; a < 2; ++a)
#pragma unroll
            for (int b = 0; b < 2; ++b)
#pragma unroll
                for (int m = 0; m < 4; ++m)
#pragma unroll
                    for (int n = 0; n < 2; ++n) acc[a][b][m][n] = (f32x4){0.f, 0.f, 0.f, 0.f};
        cur = nxt; cA = nA; cB = nB; ++ui;
        if constexpr (ALIGN_EPI) { if (wr == 1) PG8_BAR; }
    }
    PG8_WAIT_V(0);
    if constexpr (!ALIGN_EPI) { if (wr == 0) PG8_BAR; }
    PG8_BAR;
    if constexpr (Epi::AFTER_DRAIN) { E.fused(acc, cur, wr, wc, fr, fq, lds, wid, lane); S.done(cur); }
#undef PG8_SA
#undef PG8_SB
#undef PG8_STAGE
#undef PG8_LDA
#undef PG8_LDB
#undef PG8_MMA
#undef PG8_WAIT_V
#undef PG8_WAIT_L
#undef PG8_BAR
#undef PG8_SCHED
}
}

#define GAS __attribute__((address_space(1)))
#define LAS __attribute__((address_space(3)))
typedef GAS unsigned gu32;
#define RLX_AGENT __ATOMIC_RELAXED, __HIP_MEMORY_SCOPE_AGENT
constexpr int NWAVES = 8;
constexpr int CW_BAR = 4096;
constexpr int RING_BYTES = 131072, LDSCTL_OFF = RING_BYTES, MISC_OFF = LDSCTL_OFF + 320, LDS_BYTES = 147456;
constexpr size_t CTL_ZERO_BYTES = 65536;

#define XB_TMO      128
#define XB_XCNT(j)  (256  + 64 * (j))
#define XB_XSUB(j)  (1280 + 64 * (j))
#define XB_XGEN(j)  (2304 + 64 * (j))
#define XB_TOP      3328
#define XB_TOPGEN   3392
#define XCD_BAR_WORDS 3456
#define XB_SPIN_CAP (1u << 18)

__device__ __forceinline__ unsigned xb_ld(unsigned* p)              { return __hip_atomic_load(p, __ATOMIC_RELAXED, __HIP_MEMORY_SCOPE_AGENT); }
__device__ __forceinline__ unsigned xb_add(unsigned* p, unsigned v) { return __hip_atomic_fetch_add(p, v, __ATOMIC_RELAXED, __HIP_MEMORY_SCOPE_AGENT); }
__device__ __forceinline__ unsigned xb_xcc_id() { return (unsigned)__builtin_amdgcn_s_getreg((3 << 11) | 20) & 0xFu; }
#define XB_SPIN(cond, bar) do { unsigned _sp = 0; while (cond) { __builtin_amdgcn_s_sleep(1); \
    if ((++_sp & 255u) == 0u) { if (xb_ld(&(bar)[XB_TMO])) break; if (_sp > XB_SPIN_CAP) { atomicAdd(&(bar)[XB_TMO], 1u); break; } } } } while (0)

struct XcdBarrier {
    unsigned* bar; unsigned x;
    volatile LAS unsigned* st;
};

__device__ __forceinline__ XcdBarrier xcd_barrier_post(unsigned* bar, volatile LAS unsigned* st) {
    XcdBarrier b; b.bar = bar; b.x = xb_xcc_id(); b.st = st;
    if (threadIdx.x == 0) (void)xb_add(&bar[XB_XCNT(b.x)], 1u);
    return b;
}
__device__ __forceinline__ void xcd_barrier_complete(unsigned* bar, unsigned x, unsigned& nloc, unsigned& nx) {
    const unsigned G = gridDim.x * gridDim.y * gridDim.z;
    unsigned sum, cnt, mine, sp = 0u;
    for (;;) {
        sum = 0u; cnt = 0u; mine = 0u;
#pragma unroll
        for (unsigned j = 0; j < 16; ++j) { const unsigned c = xb_ld(&bar[XB_XCNT(j)]); sum += c; cnt += (c > 0u) ? 1u : 0u; mine = (j == x) ? c : mine; }
        if (sum == G) break;
        __builtin_amdgcn_s_sleep(1);
        if ((++sp & 255u) == 0u) { if (xb_ld(&bar[XB_TMO])) break; if (sp > XB_SPIN_CAP) { atomicAdd(&bar[XB_TMO], 1u); break; } }
    }
    nloc = mine > 0u ? mine : 1u; nx = cnt > 0u ? cnt : 1u;
}

__device__ __forceinline__ void xcd_barrier(const XcdBarrier& b) {
    asm volatile("s_waitcnt vmcnt(0)" ::: "memory");
    __syncthreads();
    if (threadIdx.x == 0) {
        unsigned* bar = b.bar;
        __builtin_amdgcn_s_waitcnt(0);
        unsigned nloc = b.st[0], nx = b.st[1];
        if (nloc == 0u) { xcd_barrier_complete(bar, b.x, nloc, nx); b.st[0] = nloc; b.st[1] = nx; }
        const unsigned old = xb_add(&bar[XB_XSUB(b.x)], 1u);
        const unsigned gen = old / nloc;
        if (old + 1u == (gen + 1u) * nloc) {
            __builtin_amdgcn_fence(__ATOMIC_RELEASE, "agent");
            asm volatile("s_waitcnt vmcnt(0)" ::: "memory");
            const unsigned og = xb_add(&bar[XB_TOP], 1u);
            const unsigned tg = og / nx;
            if (og + 1u == (tg + 1u) * nx) xb_add(&bar[XB_TOPGEN], 1u);
            else XB_SPIN(xb_ld(&bar[XB_TOPGEN]) == tg, bar);
            __builtin_amdgcn_fence(__ATOMIC_ACQUIRE, "agent");
            xb_add(&bar[XB_XGEN(b.x)], 1u);
            asm volatile("s_waitcnt vmcnt(0)" ::: "memory");
        } else {
            XB_SPIN(xb_ld(&bar[XB_XGEN(b.x)]) == gen, bar);
            __builtin_amdgcn_fence(__ATOMIC_ACQUIRE, "agent");
            asm volatile("s_waitcnt vmcnt(0)" ::: "memory");
        }
    }
    __syncthreads();
}


template <class F> struct EpiAdapt {
    static constexpr bool PERM = false, AFTER_DRAIN = false; F f;
    __device__ __forceinline__ void operator()(const pg8::f32x4 (&acc)[2][2][4][2], const pg8::Unit& u, int wr, int wc, int fr, int fq) const {
#pragma unroll
        for (int ai = 0; ai < 2; ++ai)
#pragma unroll
            for (int m = 0; m < 4; ++m) { const int row = u.pm * 256 + ai * 128 + wr * 64 + m * 16 + fr;
#pragma unroll
                for (int bj = 0; bj < 2; ++bj) f(row, u.pn * 8 + bj * 4 + wc, fq, acc[ai][bj][m][0], acc[ai][bj][m][1]);
                asm volatile("" ::: "memory"); }
    }
};
struct EpiBf16Perm { bf16_t* O; int ldo; int pad;
    __device__ __forceinline__ void operator()(int row, int g, int fq, f32x4 v0, f32x4 v1) const {
        u32x4 w; w.x = pk2(v0.x, v0.y); w.y = pk2(v0.z, v0.w); w.z = pk2(v1.x, v1.y); w.w = pk2(v1.z, v1.w);
        *(u32x4*)(O + (size_t)row * ldo + 32 * g + 8 * fq) = w; } };
struct EpiResid { const float* hl_in; const float* hc_in; float* hl_out; float* hc_out; const float* mod; int goff; int pad;
    __device__ __forceinline__ void operator()(int row, int g, int fq, f32x4 v0, f32x4 v1) const {
        const int c0 = 32 * g + 4 * fq; const float* hin; float* hout; const float* gv;
        if (row < TL) { hin = hl_in + (size_t)row * D; hout = hl_out + (size_t)row * D; gv = mod + (row / SEQ) * 6144 + goff; }
        else { hin = hc_in + (size_t)(row - TL) * D; hout = hc_out + (size_t)(row - TL) * D; gv = mod + 2 * 6144 + goff; }
        *(f32x4*)(hout + c0) = *(const f32x4*)(hin + c0) + *(const f32x4*)(gv + c0) * v0;
        *(f32x4*)(hout + c0 + 16) = *(const f32x4*)(hin + c0 + 16) + *(const f32x4*)(gv + c0 + 16) * v1; } };
struct EpiSwiglu { bf16_t* H; int ldh; int pad;
    __device__ __forceinline__ void operator()(int row, int g, int fq, f32x4 v0, f32x4 v1) const {
        u32x2 w; w.x = pk2(silu_f(v0.x) * v1.x, silu_f(v0.y) * v1.y); w.y = pk2(silu_f(v0.z) * v1.z, silu_f(v0.w) * v1.w);
        *(u32x2*)(H + (size_t)row * ldh + 16 * g + 4 * fq) = w; } };

template <class F> __device__ __forceinline__ void run_gemm(LAS unsigned char* lds, const bf16_t* A, const bf16_t* Bt, int K, int nM, int nN, const int* texp, size_t estride_bytes, const F& f) {
    pg8::Gemm g{A, Bt, K, estride_bytes}; pg8::StaticOrder S; S.init(nM, nN, (int)gridDim.x, (int)blockIdx.x, texp);
    EpiAdapt<F> E{f};
    pg8::gemm_phase<EpiAdapt<F>, pg8::StaticOrder, true, true>(lds, g, S, E);
}

__device__ __forceinline__ float conv_src(const Params& p, int mode, const float* W0, const float* W1, int N, int nvalid, int k, int nb) {
    if (mode == 0) return W0[(size_t)k * N + nb];
    if (mode == 1) { const int col = (nb & ~31) + 8 * ((nb >> 2) & 3) + 4 * ((nb >> 4) & 1) + (nb & 3); return col < nvalid ? W0[(size_t)k * N + col] : 0.f; }
    const int col = 16 * (nb >> 5) + (nb & 15); return ((nb >> 4) & 1) ? W1[(size_t)k * N + col] : W0[(size_t)k * N + col];
}
constexpr int CT_WIN = 0, CT_WOUT = 2304, CT_WUQ = 3328, CT_WUKV = 3400, CT_WFGU = 3464, CT_WFDN = 6280, CT_WMGU = 7688, CT_WMDN = 36360, CT_END = 50696;
constexpr int IT_MODS = 192, IT_ROPE = 9;
__device__ __forceinline__ void ph_prologue(const Params& p, float* lds) {
    const int tid = opq((int)threadIdx.x), lane = tid & 63, wv = tid >> 6;
    for (int it = blockIdx.x; it < IT_MODS + IT_ROPE; it += gridDim.x) {
        if (it < IT_MODS) {
            const int l = it / 96, n0 = (it % 96) * 64, nn = tid & 63, kc = tid >> 6;
            float* sv = lds; float* red = lds + 3 * 1024;
            __syncthreads();
            for (int i = tid; i < 3 * 1024; i += 512) { const int v = i >> 10, k = i & 1023; const float x = (v < 2) ? p.in[1][v * D + k] : p.in[3][k]; sv[i] = silu_f(x); }
            __syncthreads();
            const float* w = p.in[4] + ((size_t)l * D + kc * 128) * 6144 + n0 + nn;
            float a0 = 0.f, a1 = 0.f, a2 = 0.f;
#pragma unroll 8
            for (int k = 0; k < 128; ++k) { const float wv_ = w[(size_t)k * 6144]; a0 += sv[kc * 128 + k] * wv_; a1 += sv[1024 + kc * 128 + k] * wv_; a2 += sv[2048 + kc * 128 + k] * wv_; }
            red[(kc * 3 + 0) * 64 + nn] = a0; red[(kc * 3 + 1) * 64 + nn] = a1; red[(kc * 3 + 2) * 64 + nn] = a2;
            __syncthreads();
            if (tid < 192) { const int v = tid >> 6; float s = p.in[5][l * 6144 + n0 + nn];
#pragma unroll
                for (int q = 0; q < 8; ++q) s += red[(q * 3 + v) * 64 + nn];
                ((float*)(p.ws + WS_MOD))[((size_t)l * 3 + v) * 6144 + n0 + nn] = s; }
        } else {
            const int idx = (it - IT_MODS) * 512 + tid;
            if (idx < RT_N) {
                int pos, i, nf;
                if (idx < RT_C64) { pos = idx / 16; i = idx % 16; nf = 16; }
                else if (idx < RT_R32) { pos = (idx - RT_C64) / 16; i = idx % 16; nf = 16; }
                else if (idx < RT_C32) { pos = (idx - RT_R32) / 8; i = idx % 8; nf = 8; }
                else { pos = (idx - RT_C32) / 8; i = idx % 8; nf = 8; }
                const float inv = powf(10000.0f, -(float)i / (float)nf);
                const float ang = (float)pos * inv;
                double s, c; sincos_d((double)ang, s, c);
                ((float2*)(p.ws + WS_ROPE))[idx] = make_float2((float)c, (float)s);
            }
        }
    }
    __syncthreads();
    float* scr = lds + wv * (64 * 36);
    for (int it = wv * gridDim.x + blockIdx.x; it < CT_END; it += 8 * gridDim.x) {
        int t = it;
        bf16_t* dst; const float* W0; const float* W1 = nullptr; int K, N, nvalid = 0, mode;
        if (t < CT_WOUT) { const int l = t / 1152; t %= 1152; dst = (bf16_t*)(p.ws + WS_WIN) + (size_t)l * NINP * D; W0 = p.in[8] + (size_t)l * D * NIN; K = D; N = NIN; nvalid = NIN; mode = 1; }
        else if (t < CT_WUQ) { t -= CT_WOUT; const int l = t / 512; t %= 512; dst = (bf16_t*)(p.ws + WS_WOUT) + (size_t)l * D * D; W0 = p.in[24] + (size_t)l * D * D; K = D; N = D; mode = 0; }
        else if (t < CT_WUKV) { t -= CT_WUQ; const int l = t / 36; t %= 36; dst = (bf16_t*)(p.ws + WS_WUQ) + (size_t)l * 384 * 192; W0 = p.in[18] + (size_t)l * 192 * 384; K = 192; N = 384; mode = 0; }
        else if (t < CT_WFGU) { t -= CT_WUKV; const int l = t / 32; t %= 32; dst = (bf16_t*)(p.ws + WS_WUKV) + (size_t)l * 512 * 128; W0 = p.in[20] + (size_t)l * 128 * 512; K = 128; N = 512; mode = 0; }
        else if (t < CT_WFDN) { t -= CT_WFGU; dst = (bf16_t*)(p.ws + WS_WFGU); W0 = p.in[25]; W1 = p.in[26]; K = D; N = DFF; mode = 2; }
        else if (t < CT_WMGU) { t -= CT_WFDN; dst = (bf16_t*)(p.ws + WS_WFDN); W0 = p.in[27]; K = DFF; N = D; mode = 0; }
        else if (t < CT_WMDN) { t -= CT_WMGU; const int e = t / 3584; t %= 3584; dst = (bf16_t*)(p.ws + WS_WMGU) + (size_t)e * 2 * DFFE * D; W0 = p.in[29] + (size_t)e * D * DFFE; W1 = p.in[30] + (size_t)e * D * DFFE; K = D; N = DFFE; mode = 2; }
        else { t -= CT_WMDN; const int e = t / 1792; t %= 1792; dst = (bf16_t*)(p.ws + WS_WMDN) + (size_t)e * D * DFFE; W0 = p.in[31] + (size_t)e * DFFE * D; K = DFFE; N = D; nvalid = D; mode = 1; }
        const int ktl = K / 64, n0 = (t / ktl) * 32, k0 = (t % ktl) * 64;
        const int n4 = lane & 7; const float* src; bool valid = true; int ln;
        if (mode == 0) { src = W0 + n0 + 4 * n4; ln = 4 * n4; }
        else if (mode == 1) { const int col = n0 + 4 * n4; valid = col < nvalid; src = W0 + (valid ? col : 0); ln = 16 * (n4 & 1) + 4 * (n4 >> 1); }
        else { src = ((n4 >> 2) ? W1 : W0) + 16 * (n0 >> 5) + 4 * (n4 & 3); ln = 16 * (n4 >> 2) + 4 * (n4 & 3); }
        src += (size_t)(k0 + (lane >> 3)) * N;
        f32x4 v[8];
#pragma unroll
        for (int i = 0; i < 8; ++i) v[i] = valid ? *(const f32x4*)(src + (size_t)(8 * i) * N) : (f32x4){0.f, 0.f, 0.f, 0.f};
#pragma unroll
        for (int i = 0; i < 8; ++i) *(f32x4*)(scr + ((lane >> 3) + 8 * i) * 36 + ln) = v[i];
        const int c = lane & 7;
#pragma unroll
        for (int j = 0; j < 4; ++j) { const int n = (lane >> 3) + 8 * j; const float* sp = scr + (8 * c) * 36 + n;
            u32x4 o; o.x = pk2(sp[0 * 36], sp[1 * 36]); o.y = pk2(sp[2 * 36], sp[3 * 36]); o.z = pk2(sp[4 * 36], sp[5 * 36]); o.w = pk2(sp[6 * 36], sp[7 * 36]);
            *(u32x4*)(dst + (size_t)(n0 + n) * K + k0 + 8 * c) = o; }
    }
    __syncthreads();
}

template <int WHICH, bool ROUTER> __device__ __forceinline__ void ph_norm(const Params& p, int layer, int nrows, unsigned* lcnt) {
    const int tx = opq((int)threadIdx.x), lane = tx & 63, gw = (blockIdx.x * 512 + tx) >> 6, ngw = (gridDim.x * 512) >> 6;
    if (ROUTER) { if (tx < 16) lcnt[tx] = 0u; __syncthreads(); }
    const float* hl = (layer == 0 && WHICH == 1) ? p.in[0] : p.out;
    const float* hc = (layer == 0 && WHICH == 1) ? p.in[2] : (const float*)(p.ws + WS_HCTX);
    const float* gain = p.in[WHICH == 1 ? 6 : 7] + layer * D;
    const float* mod = (const float*)(p.ws + WS_MOD) + (size_t)layer * 3 * 6144;
    bf16_t* dst = (bf16_t*)(p.ws + WS_ACT1);
    for (int m = gw; m < nrows; m += ngw) {
        const float* src = (m < TL) ? hl + (size_t)m * D : hc + (size_t)(m - TL) * D;
        const float* mv = mod + (m < TL ? m / SEQ : 2) * 6144;
        const float* shp = mv + (WHICH == 1 ? 0 : 3) * D; const float* scp = mv + (WHICH == 1 ? 1 : 4) * D;
        f32x4 v[4]; float ss = 0.f;
#pragma unroll
        for (int j = 0; j < 4; ++j) { v[j] = *(const f32x4*)(src + 256 * j + 4 * lane); ss += v[j].x * v[j].x + v[j].y * v[j].y + v[j].z * v[j].z + v[j].w * v[j].w; }
        const float rstd = rsqrtf(wave_sum(ss) * (1.f / D) + EPS);
        float lg[8];
#pragma unroll
        for (int e = 0; e < 8; ++e) lg[e] = 0.f;
#pragma unroll
        for (int j = 0; j < 4; ++j) {
            const int c = 256 * j + 4 * lane;
            const f32x4 g = *(const f32x4*)(gain + c), sh = *(const f32x4*)(shp + c), sc = *(const f32x4*)(scp + c);
            f32x4 f = v[j] * rstd * g * (sc + 1.f) + sh;
            u32x2 w; w.x = pk2(f.x, f.y); w.y = pk2(f.z, f.w);
            *(u32x2*)(dst + (size_t)m * D + c) = w;
            if (ROUTER) {
                const float* rt = p.in[28] + (size_t)c * 8;
#pragma unroll
                for (int i = 0; i < 4; ++i) { const f32x4 r0 = *(const f32x4*)(rt + 8 * i), r1 = *(const f32x4*)(rt + 8 * i + 4); const float fv = f[i];
                    lg[0] += fv * r0.x; lg[1] += fv * r0.y; lg[2] += fv * r0.z; lg[3] += fv * r0.w; lg[4] += fv * r1.x; lg[5] += fv * r1.y; lg[6] += fv * r1.z; lg[7] += fv * r1.w; }
            }
        }
        if (ROUTER) {
#pragma unroll
            for (int e = 0; e < 8; ++e) lg[e] = wave_sum(lg[e]);
            if (lane == 0) {
                int e0 = 0; float v0 = lg[0];
#pragma unroll
                for (int e = 1; e < 8; ++e) if (lg[e] > v0) { v0 = lg[e]; e0 = e; }
                int e1 = -1; float v1 = -INFINITY;
#pragma unroll
                for (int e = 0; e < 8; ++e) if (e != e0 && lg[e] > v1) { v1 = lg[e]; e1 = e; }
                const float t = expf(v1 - v0), g0 = 1.f / (1.f + t), g1 = t / (1.f + t);
                const int p0 = (int)atomicAdd(&lcnt[e0], 1u), p1 = (int)atomicAdd(&lcnt[e1], 1u);
                ((int2*)(p.ws + WS_TOKE))[m] = make_int2(e0, e1); ((int2*)(p.ws + WS_TOKP))[m] = make_int2(p0, p1); ((float2*)(p.ws + WS_TOKG))[m] = make_float2(g0, g1);
            }
        }
    }
    if (ROUTER) {
        __syncthreads();
        if (tx < 8) lcnt[8 + tx] = atomicAdd((unsigned*)(p.ws + WS_CTL) + 64 * tx, lcnt[tx]);
        __syncthreads();
        if (lane == 0) for (int m = gw; m < nrows; m += ngw) {
            const int2 e = ((const int2*)(p.ws + WS_TOKE))[m]; int2 ps = ((const int2*)(p.ws + WS_TOKP))[m];
            ps.x += (int)lcnt[8 + e.x]; ps.y += (int)lcnt[8 + e.y]; ((int2*)(p.ws + WS_TOKP))[m] = ps; }
        __syncthreads();
    }
}


typedef short pp_bf16x8 __attribute__((ext_vector_type(8)));
__device__ __forceinline__ float quad_sum(float v) { v += swz_xor<1>(v); v += swz_xor<2>(v); return v; }
__device__ __forceinline__ float kg_sum(float v) { v += swz_xor<16>(v); return half_sum(v); }
constexpr float QS64 = 0.125f * 1.4426950408889634f, QS96 = 0.10206207261596575f * 1.4426950408889634f;

template <int HS> __device__ __forceinline__ void pp_head(const Params& p, const QKVB& qb, int layer, const bf16_t* prow, bool lat, int b, int s, int key, int sub,
                                                          const float2 (&rr)[4], const float2 (&rc)[4]) {
    constexpr bool ISV = HS >= 20;
    constexpr int col = HS < 4 ? OFF_AQ + 64 * HS : HS < 6 ? OFF_AK + 64 * (HS - 4) : HS < 10 ? OFF_BQ + 64 * (HS - 6) : HS < 12 ? OFF_BK + 64 * (HS - 10) : HS < 16 ? OFF_CQ + 64 * (HS - 12) :
                        HS < 20 ? OFF_CK + 64 * (HS - 16) : HS < 22 ? OFF_AV + 64 * (HS - 20) : HS < 24 ? OFF_BV + 64 * (HS - 22) : OFF_CV + 64 * (HS - 24);
    constexpr bool ISQ = HS < 4 || (HS >= 6 && HS < 10) || (HS >= 12 && HS < 16);
    constexpr bool ROPE = HS < 12;
    constexpr int GIN = HS < 4 ? 9 : HS < 6 ? 10 : HS < 10 ? 12 : HS < 12 ? 13 : HS < 16 ? 14 : 15;
    bf16_t* dst;
    if (HS < 4) dst = lat ? qb.QA + ((size_t)(b * 4 + HS) * SEQ + s) * 64 : qb.QAc + ((size_t)(b * 4 + HS) * CTX + s) * 64;
    else if (HS < 6) dst = qb.KA + ((size_t)(b * 2 + HS - 4) * KEYS + key) * 64;
    else if (HS < 10) dst = lat ? qb.QB + ((size_t)(b * 4 + HS - 6) * SEQ + s) * 64 : qb.QBc + ((size_t)(b * 4 + HS - 6) * CTX + s) * 64;
    else if (HS < 12) dst = qb.KB + ((size_t)(b * 2 + HS - 10) * KEYS + key) * 64;
    else if (HS < 16) dst = lat ? qb.QC + ((size_t)(b * 4 + HS - 12) * SEQ + s) * 64 : qb.QCc + ((size_t)(b * 4 + HS - 12) * CTX + s) * 64;
    else if (HS < 20) dst = qb.KC + ((size_t)(b * 4 + HS - 16) * KEYS + key) * 64;
    else if (HS < 22) dst = qb.VA + ((size_t)(b * 2 + HS - 20) * KEYS + key) * 64;
    else if (HS < 24) dst = qb.VB + ((size_t)(b * 2 + HS - 22) * KEYS + key) * 64;
    else dst = qb.VC + ((size_t)(b * 4 + HS - 24) * KEYS + key) * 64;
    u32x2 w[4];
#pragma unroll
    for (int c = 0; c < 4; ++c) w[c] = *(const u32x2*)(prow + col + 16 * c + 4 * sub);
    if (!ISV) {
        f32x4 x[4]; float ss = 0.f;
#pragma unroll
        for (int c = 0; c < 4; ++c) { x[c] = (f32x4){bflo(w[c].x), bfhi(w[c].x), bflo(w[c].y), bfhi(w[c].y)}; ss += x[c].x * x[c].x + x[c].y * x[c].y + x[c].z * x[c].z + x[c].w * x[c].w; }
        const float r = rsqrtf(quad_sum(ss) * (1.f / 64.f) + EPS) * (ISQ ? QS64 : 1.f);
        const float* g = p.in[GIN] + layer * 64 + 4 * sub;
#pragma unroll
        for (int c = 0; c < 4; ++c) x[c] = x[c] * r * *(const f32x4*)(g + 16 * c);
        if (ROPE && lat) {
#pragma unroll
            for (int i = 0; i < 4; ++i) { const float a = x[0][i], bq = x[1][i]; x[0][i] = a * rr[i].x - bq * rr[i].y; x[1][i] = bq * rr[i].x + a * rr[i].y;
                const float c1 = x[2][i], c2 = x[3][i]; x[2][i] = c1 * rc[i].x - c2 * rc[i].y; x[3][i] = c2 * rc[i].x + c1 * rc[i].y; }
        }
#pragma unroll
        for (int c = 0; c < 4; ++c) { w[c].x = pk2(x[c].x, x[c].y); w[c].y = pk2(x[c].z, x[c].w); }
    }
#pragma unroll
    for (int c = 0; c < 4; ++c) *(u32x2*)(dst + 16 * c + 4 * sub) = w[c];
}
template <int HS> struct PPHeads { static __device__ __forceinline__ void run(const Params& p, const QKVB& qb, int layer, const bf16_t* prow, bool lat, int b, int s, int key, int sub, const float2 (&rr)[4], const float2 (&rc)[4]) {
    pp_head<HS>(p, qb, layer, prow, lat, b, s, key, sub, rr, rc); PPHeads<HS + 1>::run(p, qb, layer, prow, lat, b, s, key, sub, rr, rc); } };
template <> struct PPHeads<28> { static __device__ __forceinline__ void run(const Params&, const QKVB&, int, const bf16_t*, bool, int, int, int, int, const float2 (&)[4], const float2 (&)[4]) {} };

__device__ __forceinline__ void f8_from_bf(const u32x4 v, float (&x)[8]) { x[0] = bflo(v.x); x[1] = bfhi(v.x); x[2] = bflo(v.y); x[3] = bfhi(v.y); x[4] = bflo(v.z); x[5] = bfhi(v.z); x[6] = bflo(v.w); x[7] = bfhi(v.w); }

__device__ __forceinline__ void ph_postproj2(const Params& p, int layer) {
    const int tx = opq((int)threadIdx.x), lane = tx & 63, gw = (tx >> 6) * gridDim.x + blockIdx.x, ngw = gridDim.x * 8;
    const bf16_t* P = (const bf16_t*)(p.ws + WS_P);
    const QKVB qb = make_qkv(p.ws);
    const bf16_t* Wuq = (const bf16_t*)(p.ws + WS_WUQ) + (size_t)layer * 384 * 192;
    const bf16_t* Wukv = (const bf16_t*)(p.ws + WS_WUKV) + (size_t)layer * 512 * 128;
    const float2* rope = (const float2*)(p.ws + WS_ROPE);
    for (int u = gw; u < MALL / 16; u += ngw) {
        const int m0 = u * 16; const bool lat = m0 < TL;
        {
            const int t = lane >> 2, sub = lane & 3, m = m0 + t;
            const int b = lat ? m / SEQ : (m - TL) / CTX, s = lat ? m % SEQ : (m - TL) % CTX, key = lat ? CTX + s : s;
            float2 rr[4], rc[4];
#pragma unroll
            for (int i = 0; i < 4; ++i) { rr[i] = lat ? rope[RT_R64 + (s >> 6) * 16 + 4 * sub + i] : make_float2(1.f, 0.f); rc[i] = lat ? rope[RT_C64 + (s & 63) * 16 + 4 * sub + i] : make_float2(1.f, 0.f); }
            PPHeads<0>::run(p, qb, layer, P + (size_t)m * NINP, lat, b, s, key, sub, rr, rc);
        }
        {
            const int tk = lane & 15, kg = lane >> 4, m = m0 + tk;
            const int b = lat ? m / SEQ : (m - TL) / CTX, s = lat ? m % SEQ : (m - TL) % CTX, key = lat ? CTX + s : s;
            const bf16_t* prow = P + (size_t)m * NINP;
            pp_bf16x8 aq[6];
            { float x[6][8]; float ss = 0.f;
#pragma unroll
                for (int ks = 0; ks < 6; ++ks) { f8_from_bf(*(const u32x4*)(prow + OFF_DCQ + 32 * ks + 8 * kg), x[ks]);
#pragma unroll
                    for (int j = 0; j < 8; ++j) ss += x[ks][j] * x[ks][j]; }
                const float r = rsqrtf(kg_sum(ss) * (1.f / 192.f) + EPS);
                const float* g = p.in[17] + layer * 192 + 8 * kg;
#pragma unroll
                for (int ks = 0; ks < 6; ++ks) { const f32x4 g0 = *(const f32x4*)(g + 32 * ks), g1 = *(const f32x4*)(g + 32 * ks + 4);
                    u32x4 w; w.x = pk2(x[ks][0] * r * g0.x, x[ks][1] * r * g0.y); w.y = pk2(x[ks][2] * r * g0.z, x[ks][3] * r * g0.w); w.z = pk2(x[ks][4] * r * g1.x, x[ks][5] * r * g1.y); w.w = pk2(x[ks][6] * r * g1.z, x[ks][7] * r * g1.w);
                    aq[ks] = __builtin_bit_cast(pp_bf16x8, w); } }
            float2 qr_[4], qc_[4];
#pragma unroll
            for (int reg = 0; reg < 4; ++reg) { const int i = (4 * kg + reg) & 7; qr_[reg] = lat ? rope[RT_R32 + (s >> 6) * 8 + i] : make_float2(1.f, 0.f); qc_[reg] = lat ? rope[RT_C32 + (s & 63) * 8 + i] : make_float2(1.f, 0.f); }
#pragma unroll 1
            for (int h = 0; h < 4; ++h) {
                f32x4 acc[6];
#pragma unroll
                for (int nb = 0; nb < 6; ++nb) { acc[nb] = (f32x4){0.f, 0.f, 0.f, 0.f};
                    const bf16_t* wp = Wuq + (size_t)(96 * h + 16 * nb + tk) * 192 + 8 * kg;
#pragma unroll
                    for (int ks = 0; ks < 6; ++ks) acc[nb] = __builtin_amdgcn_mfma_f32_16x16x32_bf16(*(const pp_bf16x8*)(wp + 32 * ks), aq[ks], acc[nb], 0, 0, 0); }
                float ss = 0.f;
#pragma unroll
                for (int nb = 0; nb < 6; ++nb) ss += acc[nb].x * acc[nb].x + acc[nb].y * acc[nb].y + acc[nb].z * acc[nb].z + acc[nb].w * acc[nb].w;
                const float r = rsqrtf(kg_sum(ss) * (1.f / 96.f) + EPS) * QS96;
                const float* g = p.in[21] + layer * 96 + 4 * kg;
                bf16_t* dst = (lat ? qb.QD + ((size_t)(b * 4 + h) * SEQ + s) * 96 : qb.QDc + ((size_t)(b * 4 + h) * CTX + s) * 96) + 4 * kg;
#pragma unroll
                for (int nb = 0; nb < 6; ++nb) { f32x4 y = acc[nb] * r * *(const f32x4*)(g + 16 * nb);
                    if (nb >= 4 && lat) {
#pragma unroll
                        for (int reg = 0; reg < 4; ++reg) { const float other = half_other(y[reg], lane); const float2 cs = nb == 4 ? qr_[reg] : qc_[reg];
                            y[reg] = (kg < 2) ? y[reg] * cs.x - other * cs.y : y[reg] * cs.x + other * cs.y; } }
                    u32x2 w; w.x = pk2(y.x, y.y); w.y = pk2(y.z, y.w); *(u32x2*)(dst + 16 * nb) = w; }
            }
            pp_bf16x8 akv[4];
            { float x[4][8]; float ss = 0.f;
#pragma unroll
                for (int ks = 0; ks < 4; ++ks) { f8_from_bf(*(const u32x4*)(prow + OFF_DCKV + 32 * ks + 8 * kg), x[ks]);
#pragma unroll
                    for (int j = 0; j < 8; ++j) ss += x[ks][j] * x[ks][j]; }
                const float r = rsqrtf(kg_sum(ss) * (1.f / 128.f) + EPS);
                const float* g = p.in[19] + layer * 128 + 8 * kg;
#pragma unroll
                for (int ks = 0; ks < 4; ++ks) { const f32x4 g0 = *(const f32x4*)(g + 32 * ks), g1 = *(const f32x4*)(g + 32 * ks + 4);
                    u32x4 w; w.x = pk2(x[ks][0] * r * g0.x, x[ks][1] * r * g0.y); w.y = pk2(x[ks][2] * r * g0.z, x[ks][3] * r * g0.w); w.z = pk2(x[ks][4] * r * g1.x, x[ks][5] * r * g1.y); w.w = pk2(x[ks][6] * r * g1.z, x[ks][7] * r * g1.w);
                    akv[ks] = __builtin_bit_cast(pp_bf16x8, w); } }
            float kr[8]; f8_from_bf(*(const u32x4*)(prow + OFF_DKR + 8 * kg), kr);
            float krss = 0.f;
#pragma unroll
            for (int j = 0; j < 8; ++j) krss += kr[j] * kr[j];
            float2 kcs[8];
#pragma unroll
            for (int j = 0; j < 8; ++j) kcs[j] = !lat ? make_float2(1.f, 0.f) : (kg < 2 ? rope[RT_R32 + (s >> 6) * 8 + j] : rope[RT_C32 + (s & 63) * 8 + j]);
#pragma unroll 1
            for (int h = 0; h < 4; ++h) {
                f32x4 acc[8];
#pragma unroll
                for (int nb = 0; nb < 8; ++nb) { acc[nb] = (f32x4){0.f, 0.f, 0.f, 0.f};
                    const bf16_t* wp = Wukv + (size_t)(128 * h + 16 * nb + tk) * 128 + 8 * kg;
#pragma unroll
                    for (int ks = 0; ks < 4; ++ks) acc[nb] = __builtin_amdgcn_mfma_f32_16x16x32_bf16(*(const pp_bf16x8*)(wp + 32 * ks), akv[ks], acc[nb], 0, 0, 0); }
                float ss = krss;
#pragma unroll
                for (int nb = 0; nb < 4; ++nb) ss += acc[nb].x * acc[nb].x + acc[nb].y * acc[nb].y + acc[nb].z * acc[nb].z + acc[nb].w * acc[nb].w;
                const float r = rsqrtf(kg_sum(ss) * (1.f / 96.f) + EPS);
                const float* g = p.in[22] + layer * 96;
                bf16_t* kd = qb.KD + ((size_t)(b * 4 + h) * KEYS + key) * 96; bf16_t* vd = qb.VD + ((size_t)(b * 4 + h) * KEYS + key) * 64;
#pragma unroll
                for (int nb = 0; nb < 4; ++nb) { const f32x4 y = acc[nb] * r * *(const f32x4*)(g + 16 * nb + 4 * kg); u32x2 w; w.x = pk2(y.x, y.y); w.y = pk2(y.z, y.w); *(u32x2*)(kd + 16 * nb + 4 * kg) = w; }
                { float y[8];
#pragma unroll
                    for (int j = 0; j < 8; ++j) y[j] = kr[j] * r * g[64 + 8 * kg + j];
#pragma unroll
                    for (int j = 0; j < 8; ++j) { const float other = swz_xor<16>(y[j]); y[j] = (kg & 1) == 0 ? y[j] * kcs[j].x - other * kcs[j].y : y[j] * kcs[j].x + other * kcs[j].y; }
                    u32x4 w; w.x = pk2(y[0], y[1]); w.y = pk2(y[2], y[3]); w.z = pk2(y[4], y[5]); w.w = pk2(y[6], y[7]); *(u32x4*)(kd + 64 + 8 * kg) = w; }
#pragma unroll
                for (int nb = 4; nb < 8; ++nb) { const f32x4 y = acc[nb]; u32x2 w; w.x = pk2(y.x, y.y); w.y = pk2(y.z, y.w); *(u32x2*)(vd + 16 * (nb - 4) + 4 * kg) = w; }
            }
        }
    }
}

namespace fa {
typedef short bf16x8 __attribute__((ext_vector_type(8)));
typedef short s16x4 __attribute__((ext_vector_type(4)));
typedef float f32x16 __attribute__((ext_vector_type(16)));
typedef __attribute__((address_space(3))) const char* lds_cptr;
typedef short v4i16_t __attribute__((ext_vector_type(4)));
constexpr int KSTG = 12288, VSTG = 8192, STG = KSTG + VSTG;
constexpr int LDS_WS = 2 * STG, LDS_OST = LDS_WS + 8 * 256, LDS_RPB = LDS_OST + 8 * 4096, LDS_TOTAL = LDS_RPB + 2048;
constexpr float LOG2E = 1.4426950408889634f;
constexpr float THR = 6.0f;
__device__ __forceinline__ int crow(int r, int hi) { return (r & 3) + 8 * (r >> 2) + 4 * hi; }
__device__ __forceinline__ void glds16(const void* gsrc, unsigned lds_dst) { unsigned keep;
    asm volatile("s_mov_b32 %0, m0\n\ts_mov_b32 m0, %2\n\ts_nop 0\n\tglobal_load_lds_dwordx4 %1, off\n\ts_mov_b32 m0, %0" : "=&s"(keep) : "v"(gsrc), "s"(lds_dst) : "memory"); }
__device__ __forceinline__ s16x4 vtr(lds_cptr p) { return __builtin_bit_cast(s16x4, __builtin_amdgcn_ds_read_tr16_b64_v4i16((__attribute__((address_space(3))) v4i16_t*)p)); }
typedef float f32x2_t __attribute__((ext_vector_type(2))); typedef __bf16 bf16x2_t __attribute__((ext_vector_type(2)));
__device__ __forceinline__ unsigned cvtpk(float lo, float hi) { f32x2_t v = {lo, hi}; bf16x2_t b = __builtin_convertvector(v, bf16x2_t); return __builtin_bit_cast(unsigned, b); }
__device__ __forceinline__ float xhalf_max(float m) { auto rr = __builtin_amdgcn_permlane32_swap(__float_as_uint(m), __float_as_uint(m), false, false); return fmaxf(__uint_as_float(rr[0]), __uint_as_float(rr[1])); }
__device__ __forceinline__ float xhalf_sum(float m) { auto rr = __builtin_amdgcn_permlane32_swap(__float_as_uint(m), __float_as_uint(m), false, false); return __uint_as_float(rr[0]) + __uint_as_float(rr[1]); }
#define FA_WAIT_BAR() asm volatile("s_waitcnt vmcnt(0) lgkmcnt(0)\n\ts_barrier" ::: "memory")

template <int DQK, int MODE>
__device__ __forceinline__ void attn_unit(const bf16_t* Qg, const bf16_t* Kg, const bf16_t* Vg, bf16_t* Og, int q0, float sink2, const float* rpb, char* shm) {
    const int tid = opq((int)threadIdx.x), lane = tid & 63, r32 = lane & 31, hi = lane >> 5; const int wid = __builtin_amdgcn_readfirstlane(tid >> 6);
    const unsigned lds0 = (unsigned)(uintptr_t)shm;
    float* wsf = (float*)(shm + LDS_WS) + wid * 64;
    constexpr int NCH = DQK / 8, ND0 = DQK / 16;
    int NT, wbase = 0;
    if (MODE == 0) NT = KEYS / 64; else if (MODE == 3) NT = 4;
    else if (MODE == 1) { wbase = max(0, q0 - 128); const int we = min(SEQ, q0 + 256 + 128); NT = 4 + (we - wbase) / 64; }
    else { const int r0 = q0 >> 6; wbase = min(max(r0 - 4, 0), 120); const int kre = min(max(r0 - 1, 0), 120) + 8; NT = 4 + (kre - wbase); }
#define FA_KEY0(t) ((MODE == 0 || MODE == 3 || (t) < 4) ? 64 * (t) : (MODE == 1 ? CTX + wbase + 64 * ((t) - 4) : CTX + (wbase + (t) - 4) * 64))
    const bf16_t* ksrc = Kg + (size_t)lane * DQK; const bf16_t* vsrc = Vg + (size_t)(16 * (wid & 3) + (lane >> 2)) * 64 + (wid >> 2) * 32 + (lane & 3) * 8;
#define FA_DMA(t, s) do { const int k0_ = FA_KEY0(t); \
        _Pragma("unroll") for (int c_ = 0; c_ < 2; ++c_) { const int ch_ = wid + 8 * c_; if (ch_ < NCH) glds16(ksrc + (size_t)k0_ * DQK + ch_ * 8, (unsigned)__builtin_amdgcn_readfirstlane(lds0 + (s) * STG + ch_ * 1024)); } \
        glds16(vsrc + (size_t)k0_ * 64, (unsigned)__builtin_amdgcn_readfirstlane(lds0 + (s) * STG + KSTG + wid * 1024)); } while (0)
    FA_DMA(0, 0);
    if (MODE == 2) { float* rp = (float*)(shm + LDS_RPB); for (int i = tid; i < 15 * 31; i += 512) rp[i] = rpb[i] * LOG2E; }
    bf16x8 qr[ND0];
#pragma unroll
    for (int d0 = 0; d0 < ND0; ++d0) qr[d0] = *reinterpret_cast<const bf16x8*>(Qg + (size_t)(wid * 32 + r32) * DQK + d0 * 16 + hi * 8);
    float mhat = -1e30f, l_reg = 0.f; f32x16 o[2];
#pragma unroll
    for (int r = 0; r < 16; ++r) { o[0][r] = 0.f; o[1][r] = 0.f; }
    const int qpos = q0 + wid * 32 + r32;
    const int rq = (q0 >> 6) + (wid >> 1), jq = 32 * (wid & 1) + r32;
    const int rs = min(max(rq - 4, 0), 120), cs = min(max(jq - 8, 0), 48);
    const lds_cptr shm3 = (lds_cptr)shm;
    FA_WAIT_BAR();
    for (int t = 0; t < NT; ++t) {
        const int s = t & 1;
        if (t + 1 < NT) FA_DMA(t + 1, s ^ 1);
        bool active = true;
        if (MODE == 1 && t >= 4) { const int kp0 = wbase + 64 * (t - 4), qw0 = q0 + wid * 32; active = (kp0 + 63 >= qw0 - 128) && (kp0 <= qw0 + 31 + 128); }
        if (MODE == 2 && t >= 4) { const int kr = wbase + t - 4; active = (kr >= rs) && (kr < rs + 8); }
        if (active) {
            const lds_cptr kb = shm3 + s * STG + hi * 1024 + r32 * 16;
            f32x16 p0, p1;
#pragma unroll
            for (int r = 0; r < 16; ++r) { p0[r] = 0.f; p1[r] = 0.f; }
#pragma unroll
            for (int d0 = 0; d0 < ND0; ++d0) {
                const bf16x8 b0 = *(const __attribute__((address_space(3))) bf16x8*)(kb + d0 * 2048);
                const bf16x8 b1 = *(const __attribute__((address_space(3))) bf16x8*)(kb + d0 * 2048 + 512);
                p0 = __builtin_amdgcn_mfma_f32_32x32x16_bf16(b0, qr[d0], p0, 0, 0, 0);
                p1 = __builtin_amdgcn_mfma_f32_32x32x16_bf16(b1, qr[d0], p1, 0, 0, 0);
            }
            if (MODE == 1 && t >= 4) { const int kp0 = wbase + 64 * (t - 4) - qpos;
#pragma unroll
                for (int r = 0; r < 16; ++r) { const int d0_ = kp0 + crow(r, hi), d1_ = d0_ + 32; if (d0_ < -128 || d0_ > 128) p0[r] = -INFINITY; if (d1_ < -128 || d1_ > 128) p1[r] = -INFINITY; } }
            if (MODE == 2 && t >= 4) { const int kr = wbase + t - 4; const float* rp = (const float*)(shm + LDS_RPB) + (kr - rq + 7) * 31 + 15 - jq;
#pragma unroll
                for (int r = 0; r < 16; ++r) { const int kc0 = crow(r, hi), kc1 = kc0 + 32;
                    const bool v0 = (kc0 >= cs) && (kc0 < cs + 16), v1 = (kc1 >= cs) && (kc1 < cs + 16);
                    p0[r] = v0 ? p0[r] + rp[v0 ? kc0 : jq] : -INFINITY; p1[r] = v1 ? p1[r] + rp[v1 ? kc1 : jq] : -INFINITY; } }
            float rm = fmaxf(p0[0], p1[0]);
#pragma unroll
            for (int r = 1; r < 16; ++r) rm = fmaxf(rm, fmaxf(p0[r], p1[r]));
            rm = xhalf_max(rm);
            if (__any(rm - mhat > THR)) {
                const float mn = fmaxf(mhat, rm), f = __builtin_amdgcn_exp2f(mhat - mn); mhat = mn; l_reg *= f;
                if (hi == 0) wsf[r32] = f;
#pragma unroll
                for (int r = 0; r < 16; ++r) { const float fr = wsf[crow(r, hi)]; o[0][r] *= fr; o[1][r] *= fr; }
            }
            float sacc = 0.f;
#pragma unroll
            for (int r = 0; r < 16; ++r) { p0[r] = __builtin_amdgcn_exp2f(p0[r] - mhat); p1[r] = __builtin_amdgcn_exp2f(p1[r] - mhat); sacc += p0[r] + p1[r]; }
            l_reg += sacc;
            u32x4 pw0, pw1, pw2, pw3;
            pw0 = (u32x4){cvtpk(p0[0], p0[1]), cvtpk(p0[2], p0[3]), cvtpk(p0[4], p0[5]), cvtpk(p0[6], p0[7])};
            pw1 = (u32x4){cvtpk(p0[8], p0[9]), cvtpk(p0[10], p0[11]), cvtpk(p0[12], p0[13]), cvtpk(p0[14], p0[15])};
            pw2 = (u32x4){cvtpk(p1[0], p1[1]), cvtpk(p1[2], p1[3]), cvtpk(p1[4], p1[5]), cvtpk(p1[6], p1[7])};
            pw3 = (u32x4){cvtpk(p1[8], p1[9]), cvtpk(p1[10], p1[11]), cvtpk(p1[12], p1[13]), cvtpk(p1[14], p1[15])};
            const lds_cptr vp = shm3 + s * STG + KSTG + ((lane >> 4) & 1) * 32 + (lane & 3) * 8 + (4 * hi + ((lane & 15) >> 2)) * 64;
#pragma unroll
            for (int dh = 0; dh < 2; ++dh) {
                s16x4 vlo[4], vhi[4];
#pragma unroll
                for (int ks = 0; ks < 4; ++ks) { vlo[ks] = vtr(vp + dh * 4096 + ks * 1024); vhi[ks] = vtr(vp + dh * 4096 + ks * 1024 + 512); }
#define FA_VFR(k) (bf16x8){vlo[k][0], vlo[k][1], vlo[k][2], vlo[k][3], vhi[k][0], vhi[k][1], vhi[k][2], vhi[k][3]}
                o[dh] = __builtin_amdgcn_mfma_f32_32x32x16_bf16(__builtin_bit_cast(bf16x8, pw0), FA_VFR(0), o[dh], 0, 0, 0);
                o[dh] = __builtin_amdgcn_mfma_f32_32x32x16_bf16(__builtin_bit_cast(bf16x8, pw1), FA_VFR(1), o[dh], 0, 0, 0);
                o[dh] = __builtin_amdgcn_mfma_f32_32x32x16_bf16(__builtin_bit_cast(bf16x8, pw2), FA_VFR(2), o[dh], 0, 0, 0);
                o[dh] = __builtin_amdgcn_mfma_f32_32x32x16_bf16(__builtin_bit_cast(bf16x8, pw3), FA_VFR(3), o[dh], 0, 0, 0);
#undef FA_VFR
            }
        }
        FA_WAIT_BAR();
    }
    l_reg = xhalf_sum(l_reg);
    if (MODE == 1 || MODE == 3) l_reg += __builtin_amdgcn_exp2f(sink2 - mhat);
    if (hi == 0) wsf[32 + r32] = 1.0f / l_reg;
    float rli[16];
#pragma unroll
    for (int r = 0; r < 16; ++r) rli[r] = wsf[32 + crow(r, hi)];
    bf16_t* stg = (bf16_t*)(shm + LDS_OST) + wid * 2048;
#pragma unroll
    for (int r = 0; r < 16; ++r) { const int orow = crow(r, hi);
#pragma unroll
        for (int dh = 0; dh < 2; ++dh) stg[orow * 64 + dh * 32 + r32] = (bf16_t)f2bf(o[dh][r] * rli[r]); }
#pragma unroll
    for (int i = 0; i < 4; ++i) { const int row = i * 8 + (lane >> 3), ch = lane & 7; const u32x4 v = *(const u32x4*)(stg + row * 64 + ch * 8); *(u32x4*)(Og + (size_t)(wid * 32 + row) * D + ch * 8) = v; }
    asm volatile("s_waitcnt lgkmcnt(0)\n\ts_barrier" ::: "memory");
#undef FA_DMA
#undef FA_KEY0
}
#undef FA_WAIT_BAR
}

constexpr float SCALE_MLA = 0.10206207261596575f;
__device__ __forceinline__ void ph_attn(const Params& p, int layer, bool with_ctx, char* shm) {
    const QKVB qb = make_qkv(p.ws);
    bf16_t* O = (bf16_t*)(p.ws + WS_P);
    const int G = gridDim.x;
    const float NEG = -INFINITY;
    for (int u = blockIdx.x; u < 256; u += G) { const int bh = u & 7, b = bh >> 2, h = bh & 3, qbk = u >> 3;
        fa::attn_unit<96, 0>(qb.QD + ((size_t)bh * SEQ + qbk * 256) * 96, qb.KD + (size_t)bh * KEYS * 96, qb.VD + (size_t)bh * KEYS * 64, O + (size_t)(b * SEQ + qbk * 256) * D + 768 + h * 64, qbk * 256, NEG, nullptr, shm); }
    for (int u = blockIdx.x; u < 256; u += G) { const int bh = u & 7, b = bh >> 2, h = bh & 3, qbk = u >> 3;
        fa::attn_unit<64, 0>(qb.QB + ((size_t)bh * SEQ + qbk * 256) * 64, qb.KB + (size_t)(b * 2 + (h >> 1)) * KEYS * 64, qb.VB + (size_t)(b * 2 + (h >> 1)) * KEYS * 64, O + (size_t)(b * SEQ + qbk * 256) * D + 256 + h * 64, qbk * 256, NEG, nullptr, shm); }
    for (int u = blockIdx.x; u < 256; u += G) { const int bh = u & 7, b = bh >> 2, h = bh & 3, qbk = u >> 3;
        fa::attn_unit<64, 1>(qb.QA + ((size_t)bh * SEQ + qbk * 256) * 64, qb.KA + (size_t)(b * 2 + (h >> 1)) * KEYS * 64, qb.VA + (size_t)(b * 2 + (h >> 1)) * KEYS * 64, O + (size_t)(b * SEQ + qbk * 256) * D + 0 + h * 64, qbk * 256, p.in[11][layer * 4 + h] * fa::LOG2E, nullptr, shm); }
    for (int u = blockIdx.x; u < 256; u += G) { const int bh = u & 7, b = bh >> 2, h = bh & 3, qbk = u >> 3;
        fa::attn_unit<64, 2>(qb.QC + ((size_t)bh * SEQ + qbk * 256) * 64, qb.KC + (size_t)bh * KEYS * 64, qb.VC + (size_t)bh * KEYS * 64, O + (size_t)(b * SEQ + qbk * 256) * D + 512 + h * 64, qbk * 256, NEG, p.in[16] + ((size_t)layer * 4 + h) * 15 * 31, shm); }
    if (with_ctx) for (int u = blockIdx.x; u < 32; u += G) { const int ty = u >> 3, bh = u & 7, b = bh >> 2, h = bh & 3;
        bf16_t* Oc = O + (size_t)(TL + b * CTX) * D + ty * 256 + h * 64;
        if (ty == 0) fa::attn_unit<64, 3>(qb.QAc + (size_t)bh * CTX * 64, qb.KA + (size_t)(b * 2 + (h >> 1)) * KEYS * 64, qb.VA + (size_t)(b * 2 + (h >> 1)) * KEYS * 64, Oc, 0, p.in[11][layer * 4 + h] * fa::LOG2E, nullptr, shm);
        else if (ty == 1) fa::attn_unit<64, 3>(qb.QBc + (size_t)bh * CTX * 64, qb.KB + (size_t)(b * 2 + (h >> 1)) * KEYS * 64, qb.VB + (size_t)(b * 2 + (h >> 1)) * KEYS * 64, Oc, 0, NEG, nullptr, shm);
        else if (ty == 2) fa::attn_unit<64, 3>(qb.QCc + (size_t)bh * CTX * 64, qb.KC + (size_t)bh * KEYS * 64, qb.VC + (size_t)bh * KEYS * 64, Oc, 0, NEG, nullptr, shm);
        else fa::attn_unit<96, 3>(qb.QDc + (size_t)bh * CTX * 96, qb.KD + (size_t)bh * KEYS * 96, qb.VD + (size_t)bh * KEYS * 64, Oc, 0, NEG, nullptr, shm); }
}

__device__ __forceinline__ void ph_gnorm(const Params& p, int layer, int nrows) {
    const int tx = opq((int)threadIdx.x), lane = tx & 63, gw = (blockIdx.x * 512 + tx) >> 6, ngw = (gridDim.x * 512) >> 6;
    const bf16_t* O = (const bf16_t*)(p.ws + WS_P); bf16_t* Y = (bf16_t*)(p.ws + WS_ACT1); const float* g = p.in[23] + layer * D;
    for (int m = gw; m < nrows; m += ngw) {
#pragma unroll
        for (int grp = 0; grp < 4; ++grp) { const int c = grp * 256 + 4 * lane; const u32x2 w = *(const u32x2*)(O + (size_t)m * D + c);
            const float a0 = bflo(w.x), a1 = bfhi(w.x), a2 = bflo(w.y), a3 = bfhi(w.y);
            const float r = rsqrtf(wave_sum(a0 * a0 + a1 * a1 + a2 * a2 + a3 * a3) * (1.f / 256.f) + EPS);
            const f32x4 gv = *(const f32x4*)(g + c); u32x2 o; o.x = pk2(a0 * r * gv.x, a1 * r * gv.y); o.y = pk2(a2 * r * gv.z, a3 * r * gv.w);
            *(u32x2*)(Y + (size_t)m * D + c) = o; }
    }
}

__device__ __forceinline__ void moe_bases(const unsigned* cnt, int (&base)[9]) {
    int acc = 0;
#pragma unroll
    for (int e = 0; e < 8; ++e) { base[e] = acc; acc += ((int)cnt[64 * e] + 255) / 256 * 256; }
    base[8] = acc;
}
__device__ __forceinline__ void ph_moe_gather(const Params& p) {
    const int tx = opq((int)threadIdx.x), lane = tx & 63, gw = (blockIdx.x * 512 + tx) >> 6, ngw = (gridDim.x * 512) >> 6;
    const unsigned* cnt = (const unsigned*)(p.ws + WS_CTL); int base[9]; moe_bases(cnt, base);
    if (blockIdx.x == 0 && tx < 136) { const int r = tx * 256; int e = -1;
#pragma unroll
        for (int i = 0; i < 8; ++i) if (r >= base[i] && r < base[i + 1]) e = i;
        ((int*)(p.ws + WS_TEXP))[tx] = e < 0 ? 0 : e; }
    const bf16_t* F = (const bf16_t*)(p.ws + WS_ACT1); bf16_t* A = (bf16_t*)(p.ws + WS_ASORT);
    for (int m = gw; m < TL; m += ngw) {
        const int2 e = ((const int2*)(p.ws + WS_TOKE))[m]; const int2 ps = ((const int2*)(p.ws + WS_TOKP))[m];
        int b0 = 0, b1 = 0;
#pragma unroll
        for (int i = 0; i < 8; ++i) { if (e.x == i) b0 = base[i]; if (e.y == i) b1 = base[i]; }
        const int s0 = b0 + ps.x, s1 = b1 + ps.y;
        const u32x4 v0 = *(const u32x4*)(F + (size_t)m * D + lane * 16), v1 = *(const u32x4*)(F + (size_t)m * D + lane * 16 + 8);
        *(u32x4*)(A + (size_t)s0 * D + lane * 16) = v0; *(u32x4*)(A + (size_t)s0 * D + lane * 16 + 8) = v1;
        *(u32x4*)(A + (size_t)s1 * D + lane * 16) = v0; *(u32x4*)(A + (size_t)s1 * D + lane * 16 + 8) = v1;
        if (lane == 0) ((int2*)(p.ws + WS_TOKS))[m] = make_int2(s0, s1);
    }
}
__device__ __forceinline__ void ph_moe_combine(const Params& p, int layer) {
    const size_t nthr = (size_t)gridDim.x * 512;
    for (size_t idx = (size_t)blockIdx.x * 512 + opq((int)threadIdx.x); idx < (size_t)TL * 256; idx += nthr) {
        const int m = (int)(idx >> 8), c = (int)(idx & 255) * 4;
        const int2 sl = ((const int2*)(p.ws + WS_TOKS))[m]; const float2 g = ((const float2*)(p.ws + WS_TOKG))[m];
        const bf16_t* Y = (const bf16_t*)(p.ws + WS_ASORT);
        const u32x2 a = *(const u32x2*)(Y + (size_t)sl.x * D + c), b = *(const u32x2*)(Y + (size_t)sl.y * D + c);
        const f32x4 ya = {bflo(a.x), bfhi(a.x), bflo(a.y), bfhi(a.y)}, yb = {bflo(b.x), bfhi(b.x), bflo(b.y), bfhi(b.y)};
        const float* mod = (const float*)(p.ws + WS_MOD) + (size_t)layer * 3 * 6144 + (m / SEQ) * 6144 + 5 * D;
        f32x4* o = (f32x4*)(p.out + (size_t)m * D + c);
        *o = *o + *(const f32x4*)(mod + c) * (ya * g.x + yb * g.y);
    }
}

#ifndef DBL_PHASE
#define DBL_PHASE (-1)
#endif
struct Args { Params p; int ph_lo, ph_hi; };
__global__ void __launch_bounds__(NWAVES * 64, 2) mega_fwd(Args args) {
    extern __shared__ __attribute__((aligned(16))) unsigned char lds[];
    LAS unsigned char* ldsl = (LAS unsigned char*)lds;
    for (int u = threadIdx.x; u < (LDS_BYTES - LDSCTL_OFF) / 4; u += NWAVES * 64) ((LAS unsigned*)(ldsl + LDSCTL_OFF))[u] = 0u;
    __syncthreads();
    XcdBarrier bar = xcd_barrier_post((unsigned*)(args.p.ws + WS_CTL) + CW_BAR, (volatile LAS unsigned*)(ldsl + MISC_OFF) + 8);
    const int lo = args.ph_lo, hi = args.ph_hi; int ph = 0;
#define PHASE(body) do { if (lo <= ph && ph < hi) { Params q = args.p; q.ws = opqp(args.p.ws); q.out = opqp(args.p.out); LAS unsigned char* ldq = (LAS unsigned char*)lds; (void)ldq; for (int rep_ = 0; rep_ < ((ph == DBL_PHASE) ? 2 : 1); ++rep_) { if (rep_) xcd_barrier(bar); body; } if (ph + 1 < hi) xcd_barrier(bar); } ++ph; } while (0)
#define QMOD(l) ((const float*)(q.ws + WS_MOD) + (size_t)(l) * 3 * 6144)
    PHASE(ph_prologue(q, (float*)lds));
#pragma unroll 1
    for (int l = 0; l < 2; ++l) {
        const bool last = (l == 1);
        const int nrows = last ? TL : MALL;
        PHASE((ph_norm<1, false>(q, l, MALL, (unsigned*)lds)));
        PHASE(run_gemm(ldq, (const bf16_t*)(q.ws + WS_ACT1), (const bf16_t*)(q.ws + WS_WIN) + (size_t)l * NINP * D, D, MALL / 256, NINP / 256, nullptr, 0, EpiBf16Perm{(bf16_t*)(q.ws + WS_P), NINP, 0}));
        PHASE(ph_postproj2(q, l));
        PHASE(ph_attn(q, l, !last, (char*)lds));
        PHASE(ph_gnorm(q, l, nrows));
        PHASE(run_gemm(ldq, (const bf16_t*)(q.ws + WS_ACT1), (const bf16_t*)(q.ws + WS_WOUT) + (size_t)l * D * D, D, nrows / 256, D / 256, nullptr, 0,
                       EpiResid{(l == 0) ? q.in[0] : q.out, (l == 0) ? q.in[2] : (const float*)(q.ws + WS_HCTX), q.out, (float*)(q.ws + WS_HCTX), QMOD(l), 2 * D, 0}));
        if (!last) {
            PHASE((ph_norm<2, false>(q, l, MALL, (unsigned*)lds)));
            PHASE(run_gemm(ldq, (const bf16_t*)(q.ws + WS_ACT1), (const bf16_t*)(q.ws + WS_WFGU), D, MALL / 256, 2 * DFF / 256, nullptr, 0, EpiSwiglu{(bf16_t*)(q.ws + WS_HIDF), DFF, 0}));
            PHASE(run_gemm(ldq, (const bf16_t*)(q.ws + WS_HIDF), (const bf16_t*)(q.ws + WS_WFDN), DFF, MALL / 256, D / 256, nullptr, 0,
                           EpiResid{q.out, (const float*)(q.ws + WS_HCTX), q.out, (float*)(q.ws + WS_HCTX), QMOD(l), 5 * D, 0}));
        } else {
            PHASE((ph_norm<2, true>(q, l, TL, (unsigned*)lds)));
            PHASE(ph_moe_gather(q));
            PHASE({ int base[9]; moe_bases((const unsigned*)(q.ws + WS_CTL), base); run_gemm(ldq, (const bf16_t*)(q.ws + WS_ASORT), (const bf16_t*)(q.ws + WS_WMGU), D, base[8] / 256, 2 * DFFE / 256, (const int*)(q.ws + WS_TEXP), (size_t)2 * DFFE * D * 2, EpiSwiglu{(bf16_t*)(q.ws + WS_HIDM), DFFE, 0}); });
            PHASE({ int base[9]; moe_bases((const unsigned*)(q.ws + WS_CTL), base); run_gemm(ldq, (const bf16_t*)(q.ws + WS_HIDM), (const bf16_t*)(q.ws + WS_WMDN), DFFE, base[8] / 256, D / 256, (const int*)(q.ws + WS_TEXP), (size_t)D * DFFE * 2, EpiBf16Perm{(bf16_t*)(q.ws + WS_ASORT), D, 0}); });
            PHASE(ph_moe_combine(q, l));
        }
    }
#undef QMOD
#undef PHASE
}

#ifndef MK_CUTS
#define MK_CUTS 0
#endif
extern "C" void kernel_launch(void* const* d_in, const int* in_sizes, int n_in, void* d_out, int out_size, void* d_ws, size_t ws_size, hipStream_t stream) {
    static int grid = 0;
    if (grid == 0) {
        if (n_in != 32 || ws_size < WS_END) { fprintf(stderr, "kernel_launch: need 32 inputs and %zu bytes of workspace (got %d, %zu)\n", (size_t)WS_END, n_in, ws_size); grid = -1; return; }
        int dev = 0, cus = 0, per_cu = 0;
        if (hipGetDevice(&dev) != hipSuccess || hipDeviceGetAttribute(&cus, hipDeviceAttributeMultiprocessorCount, dev) != hipSuccess) { grid = -1; return; }
        if (hipFuncSetAttribute((const void*)mega_fwd, hipFuncAttributeMaxDynamicSharedMemorySize, LDS_BYTES) != hipSuccess) { fprintf(stderr, "kernel_launch: hipFuncSetAttribute failed\n"); grid = -1; return; }
        if (hipOccupancyMaxActiveBlocksPerMultiprocessor(&per_cu, (const void*)mega_fwd, NWAVES * 64, LDS_BYTES) != hipSuccess || per_cu < 1) fprintf(stderr, "kernel_launch: occupancy query says %d blocks per CU\n", per_cu);
        (void)hipGetLastError();
        grid = cus;
    }
    if (grid < 0) return;
    (void)hipMemsetAsync((char*)d_ws + WS_CTL, 0, CTL_ZERO_BYTES, stream);
    Args a{}; for (int i = 0; i < 32; ++i) a.p.in[i] = (const float*)d_in[i]; a.p.out = (float*)d_out; a.p.ws = (unsigned char*)d_ws;
#if MK_CUTS
    for (int ph = 0; ph < 24; ++ph) { a.ph_lo = ph; a.ph_hi = ph + 1; hipLaunchKernelGGL(mega_fwd, dim3(grid), dim3(NWAVES * 64), LDS_BYTES, stream, a); }
#else
    a.ph_lo = 0; a.ph_hi = 21;
    hipLaunchKernelGGL(mega_fwd, dim3(grid), dim3(NWAVES * 64), LDS_BYTES, stream, a);
#endif
}
```

```cpp
#include <hip/hip_runtime.h>
#include <stdint.h>
#include <cstdio>

typedef unsigned short bf16_t;
typedef float f32x4 __attribute__((ext_vector_type(4)));
typedef unsigned u32x4 __attribute__((ext_vector_type(4)));
typedef unsigned u32x2 __attribute__((ext_vector_type(2)));

constexpr int D = 1024, NB = 2, SEQ = 8192, CTX = 256, TL = NB * SEQ, TC = NB * CTX, MALL = TL + TC;
constexpr int NIN = 2144, NINP = 2304, DFF = 2816, NE = 8, DFFE = 3584, KEYS = CTX + SEQ;
constexpr int OFF_AQ = 0, OFF_AK = 256, OFF_AV = 384, OFF_BQ = 512, OFF_BK = 768, OFF_BV = 896, OFF_CQ = 1024, OFF_CK = 1280,
              OFF_CV = 1536, OFF_DCQ = 1792, OFF_DCKV = 1984, OFF_DKR = 2112;
constexpr int MOE_ROWS = 34816;
constexpr float EPS = 1e-6f;

constexpr size_t MiB = 1u << 20;
constexpr size_t WS_CTL = 0;
constexpr size_t WS_MOD = 1 * MiB;
constexpr size_t WS_ROPE = WS_MOD + 256 * 1024;
constexpr size_t WS_TOKE = WS_ROPE + 64 * 1024;
constexpr size_t WS_TOKP = WS_TOKE + TL * 8;
constexpr size_t WS_TOKG = WS_TOKP + TL * 8;
constexpr size_t WS_TEXP = WS_TOKG + TL * 8;
constexpr size_t WS_TOKS = WS_TEXP + 1024;
constexpr size_t WS_HCTX = 2 * MiB;
constexpr size_t WS_WMGU = 6 * MiB;
constexpr size_t WS_WMDN = WS_WMGU + 112 * MiB;
constexpr size_t WS_WDEAD = WS_WMDN + 56 * MiB;
constexpr size_t WS_WIN = WS_WDEAD;
constexpr size_t WS_WOUT = WS_WIN + 9 * MiB;
constexpr size_t WS_WUQ = WS_WOUT + 4 * MiB;
constexpr size_t WS_WUKV = WS_WUQ + 512 * 1024;
constexpr size_t WS_WFGU = WS_WUKV + 512 * 1024;
constexpr size_t WS_WFDN = WS_WFGU + 11 * MiB;
constexpr size_t WS_ACT = 205 * MiB;
static_assert(WS_WFDN + (size_t)1024 * 2816 * 2 <= WS_ACT, "weights fit");
constexpr size_t WS_ACT1 = WS_ACT;
constexpr size_t WS_P = WS_ACT + 33 * MiB;
constexpr size_t WS_QKV = WS_ACT + 108 * MiB;
constexpr size_t WS_HIDF = WS_P;
constexpr size_t WS_HIDM = WS_WDEAD;
constexpr size_t WS_ASORT = WS_HIDM + 238 * MiB;
constexpr size_t WS_END = WS_ASORT + 68 * MiB;
static_assert(WS_QKV + 91 * MiB <= WS_END, "qkv fits");

struct Params { const float* in[32]; float* out; unsigned char* ws; };

struct QKVB { bf16_t *QA, *KA, *VA, *QB, *KB, *VB, *QC, *KC, *VC, *QD, *KD, *VD, *QAc, *QBc, *QCc, *QDc; };
__host__ __device__ inline QKVB make_qkv(unsigned char* ws) {
    QKVB q; bf16_t* p = (bf16_t*)(ws + WS_QKV);
    q.QA = p; p += (size_t)NB * 4 * SEQ * 64; q.KA = p; p += (size_t)NB * 2 * KEYS * 64; q.VA = p; p += (size_t)NB * 2 * KEYS * 64;
    q.QB = p; p += (size_t)NB * 4 * SEQ * 64; q.KB = p; p += (size_t)NB * 2 * KEYS * 64; q.VB = p; p += (size_t)NB * 2 * KEYS * 64;
    q.QC = p; p += (size_t)NB * 4 * SEQ * 64; q.KC = p; p += (size_t)NB * 4 * KEYS * 64; q.VC = p; p += (size_t)NB * 4 * KEYS * 64;
    q.QD = p; p += (size_t)NB * 4 * SEQ * 96; q.KD = p; p += (size_t)NB * 4 * KEYS * 96; q.VD = p; p += (size_t)NB * 4 * KEYS * 64;
    q.QAc = p; p += (size_t)NB * 4 * CTX * 64; q.QBc = p; p += (size_t)NB * 4 * CTX * 64; q.QCc = p; p += (size_t)NB * 4 * CTX * 64;
    q.QDc = p; p += (size_t)NB * 4 * CTX * 96;
    return q;
}

__device__ __forceinline__ float bf2f(unsigned v) { return __uint_as_float(v << 16); }
__device__ __forceinline__ float bflo(unsigned w) { return __uint_as_float(w << 16); }
__device__ __forceinline__ float bfhi(unsigned w) { return __uint_as_float(w & 0xffff0000u); }
__device__ __forceinline__ unsigned f2bf(float f) { unsigned u = __float_as_uint(f); return (u + 0x7fffu + ((u >> 16) & 1u)) >> 16; }
__device__ __forceinline__ unsigned pk2(float lo, float hi) { return f2bf(lo) | (f2bf(hi) << 16); }
template <int X> __device__ __forceinline__ float swz_xor(float v) { return __int_as_float(__builtin_amdgcn_ds_swizzle(__float_as_int(v), 0x1f | (X << 10))); }
__device__ __forceinline__ float half_sum(float v) { auto rr = __builtin_amdgcn_permlane32_swap(__float_as_uint(v), __float_as_uint(v), false, false); return __uint_as_float(rr[0]) + __uint_as_float(rr[1]); }
__device__ __forceinline__ float half_other(float v, int lane) { auto rr = __builtin_amdgcn_permlane32_swap(__float_as_uint(v), __float_as_uint(v), false, false); return __uint_as_float((lane & 32) ? rr[0] : rr[1]); }
__device__ __forceinline__ float wave_sum(float v) { v += swz_xor<1>(v); v += swz_xor<2>(v); v += swz_xor<4>(v); v += swz_xor<8>(v); v += swz_xor<16>(v); return half_sum(v); }
__device__ __forceinline__ int opq(int v) { asm volatile("" : "+v"(v)); return v; }
template <class T> __device__ __forceinline__ T* opqp(T* p) { asm volatile("" : "+s"(p)); return p; }
__device__ __forceinline__ float silu_f(float x) { return x / (1.f + expf(-x)); }

__device__ __forceinline__ void sincos_d(double a, double& s, double& c) {
    const double k = rint(a * 0.63661977236758134308);
    double r = a - k * 1.57079632679489655800e+00; r -= k * 6.12323399573676603587e-17;
    const double r2 = r * r;
    double sp = 1.0 / 121645100408832000.0;
    sp = sp * r2 - 1.0 / 355687428096000.0; sp = sp * r2 + 1.0 / 1307674368000.0; sp = sp * r2 - 1.0 / 6227020800.0; sp = sp * r2 + 1.0 / 39916800.0;
    sp = sp * r2 - 1.0 / 362880.0; sp = sp * r2 + 1.0 / 5040.0; sp = sp * r2 - 1.0 / 120.0; sp = sp * r2 + 1.0 / 6.0; sp = -sp * r2 + 1.0;
    const double sr = r * sp;
    double cp = 1.0 / 6402373705728000.0;
    cp = cp * r2 - 1.0 / 20922789888000.0; cp = cp * r2 + 1.0 / 87178291200.0; cp = cp * r2 - 1.0 / 479001600.0; cp = cp * r2 + 1.0 / 3628800.0;
    cp = cp * r2 - 1.0 / 40320.0; cp = cp * r2 + 1.0 / 720.0; cp = cp * r2 - 1.0 / 24.0; cp = cp * r2 + 0.5; const double cr = 1.0 - cp * r2;
    const int q = ((int)k) & 3;
    s = (q == 0) ? sr : (q == 1) ? cr : (q == 2) ? -sr : -cr;
    c = (q == 0) ? cr : (q == 1) ? -sr : (q == 2) ? -cr : sr;
}
constexpr int RT_R64 = 0, RT_C64 = 2048, RT_R32 = 3072, RT_C32 = 4096, RT_N = 4608;

namespace pg8 {
#define PG8_LAS __attribute__((address_space(3)))
typedef unsigned short bf16_t;
typedef short bf16x8 __attribute__((ext_vector_type(8)));
typedef float f32x4 __attribute__((ext_vector_type(4)));
typedef unsigned u32x4 __attribute__((ext_vector_type(4)));
constexpr int BM = 256, BK = 64, HALF = 128, HTB = HALF * BK * 2  , STAGE_BYTES = 8 * HTB, NXCD = 8, WGM = 8;

__host__ __device__ __forceinline__ int lds_byte(int r, int c) { const int st = (r >> 4) * 2 + (c >> 5), rr = r & 15, cc = c & 31, ob = rr * 64 + cc * 2; return st * 1024 + (ob ^ (((ob >> 9) & 1) << 5)); }
__host__ __device__ __forceinline__ void stage_rc(int b, int& R, int& C) { const int st = b / 1024, sb = b % 1024, swz = sb ^ (((sb >> 9) & 1) << 5); R = (st >> 1) * 16 + swz / 64; C = (st & 1) * 32 + (swz % 64) / 2; }
__host__ __device__ __forceinline__ int perm32(int rho) { const int n = rho >> 4, i = rho & 15; return 8 * (i >> 2) + 4 * n + (i & 3); }

struct Unit { int pm, pn, e; };
struct Gemm { const bf16_t* A; const bf16_t* Bt; int K; size_t estride; };

struct StaticOrder {
    int nM, nN, nwg, G, c; const int* texp;
    __host__ __device__ void init(int nM_, int nN_, int G_, int c_, const int* texp_) { nM = nM_; nN = nN_; nwg = nM * nN; G = G_; c = c_; texp = texp_; }
    __host__ __device__ bool next(int i, Unit& u) const {
        const long L = (long)i * G + c; if (L >= nwg) return false;
        int wgid = (int)L; { const int q = nwg / NXCD, r = nwg % NXCD, xcd = wgid % NXCD, off = wgid / NXCD; wgid = (xcd < r ? xcd * (q + 1) : r * (q + 1) + (xcd - r) * q) + off; }
        const int nig = WGM * nN, gid = wgid / nig, fm = gid * WGM, gsz = (nM - fm) < WGM ? (nM - fm) : WGM;
        u.pm = fm + ((wgid % nig) % gsz); u.pn = (wgid % nig) / gsz; u.e = texp ? texp[u.pm] : 0; return true;
    }
    __device__ __forceinline__ void a_ready(const Unit&) const {}
    __device__ __forceinline__ void done(const Unit&) const {}
};

template <class Epi, class Sched, bool ALIGN_EPI = false, bool SP2 = false>
__device__ __forceinline__ void gemm_phase(PG8_LAS unsigned char* lds, const Gemm g, const Sched& S, const Epi& E) {
    const int tid = opq((int)threadIdx.x), wid = __builtin_amdgcn_readfirstlane(tid >> 6), lane = tid & 63, wr = wid >> 2, wc = wid & 3, fr = lane & 15, fq = lane >> 4;
    const int K = g.K, nt = K / BK;
    unsigned voffA[2], voffB[2];
#pragma unroll
    for (int i = 0; i < 2; ++i) { int R, C; stage_rc(tid * 16 + i * 8192, R, C); const int Rb = Epi::PERM ? ((R & ~31) + perm32(R & 31)) : R;
        voffA[i] = (unsigned)(R * K + C) * 2u; voffB[i] = (unsigned)(Rb * K + C) * 2u; }
    const size_t kstep = (size_t)(BK * 2);
    const size_t hstep = (size_t)HALF * K * 2;
    const size_t tstep = 2 * hstep;
    const unsigned ldsw = (unsigned)wid * 1024u;
    const int aoff = lds_byte(wr * 64 + fr, fq * 8), boff = lds_byte(wc * 32 + fr, fq * 8);
#define PG8_SA(b, h) (((b) * 2 + (h)) * HTB)
#define PG8_SB(b, h) ((4 + (b) * 2 + (h)) * HTB)
#define PG8_STAGE(bufoff, gbase, voff) do { _Pragma("unroll") for (int _i = 0; _i < 2; ++_i) \
        __builtin_amdgcn_global_load_lds((const unsigned*)((const char*)(gbase) + (voff)[_i]), (PG8_LAS unsigned*)(lds + (bufoff) + ldsw + _i * 8192), 16, 0, 0); } while (0)
#define PG8_LDA(dst, b, h) do { _Pragma("unroll") for (int m = 0; m < 4; ++m) _Pragma("unroll") for (int k = 0; k < 2; ++k) dst[m][k] = *(const PG8_LAS bf16x8*)(lds + PG8_SA(b, h) + aoff + m * 2048 + k * 1024); } while (0)
#define PG8_LDB(dst, b, h) do { _Pragma("unroll") for (int n = 0; n < 2; ++n) _Pragma("unroll") for (int k = 0; k < 2; ++k) dst[n][k] = *(const PG8_LAS bf16x8*)(lds + PG8_SB(b, h) + boff + n * 2048 + k * 1024); } while (0)
#define PG8_MMA(ai, bj, At, Bt) do { __builtin_amdgcn_s_setprio(1); _Pragma("unroll") for (int m = 0; m < 4; ++m) _Pragma("unroll") for (int n = 0; n < 2; ++n) _Pragma("unroll") for (int k = 0; k < 2; ++k) \
        acc[ai][bj][m][n] = __builtin_amdgcn_mfma_f32_16x16x32_bf16(Bt[n][k], At[m][k], acc[ai][bj][m][n], 0, 0, 0); __builtin_amdgcn_s_setprio(0); } while (0)
#define PG8_WAIT_V(n) asm volatile("s_waitcnt vmcnt(" #n ")" ::: "memory")
#define PG8_WAIT_L(n) asm volatile("s_waitcnt lgkmcnt(" #n ")" ::: "memory")
#define PG8_BAR __builtin_amdgcn_s_barrier()
#define PG8_SCHED __builtin_amdgcn_sched_barrier(0)
    Unit cur, nxt; int ui = 0;
    if (!S.next(0, cur)) return;
    f32x4 acc[2][2][4][2];
#pragma unroll
    for (int a = 0; a < 2; ++a)
#pragma unroll
        for (int b = 0; b < 2; ++b)
#pragma unroll
            for (int m = 0; m < 4; ++m)
#pragma unroll
                for (int n = 0; n < 2; ++n) acc[a][b][m][n] = (f32x4){0.f, 0.f, 0.f, 0.f};
    bf16x8 At[4][2], B0[2][2], B1[2][2];
    const char* cA = (const char*)g.A + (size_t)cur.pm * tstep; const char* cB = (const char*)g.Bt + (size_t)cur.e * g.estride + (size_t)cur.pn * tstep;
    S.a_ready(cur);
    if constexpr (SP2) {
        PG8_STAGE(PG8_SB(0, 0), cB, voffB); PG8_STAGE(PG8_SB(0, 1), cB + hstep, voffB); PG8_STAGE(PG8_SA(0, 0), cA, voffA); PG8_STAGE(PG8_SA(0, 1), cA + hstep, voffA);
        if (wr == 1) PG8_BAR;
        PG8_WAIT_V(2); PG8_BAR;
        PG8_STAGE(PG8_SB(1, 0), cB + kstep, voffB); PG8_STAGE(PG8_SA(1, 0), cA + kstep, voffA); PG8_STAGE(PG8_SB(1, 1), cB + hstep + kstep, voffB);
        PG8_WAIT_V(6); PG8_BAR;
    } else {
        PG8_STAGE(PG8_SB(0, 0), cB, voffB); PG8_STAGE(PG8_SA(0, 0), cA, voffA); PG8_STAGE(PG8_SB(0, 1), cB + hstep, voffB); PG8_STAGE(PG8_SA(0, 1), cA + hstep, voffA);
        if (wr == 1) PG8_BAR;
        PG8_WAIT_V(4); PG8_BAR;
        PG8_STAGE(PG8_SB(1, 0), cB + kstep, voffB); PG8_STAGE(PG8_SA(1, 0), cA + kstep, voffA); PG8_STAGE(PG8_SB(1, 1), cB + hstep + kstep, voffB);
        PG8_WAIT_V(6); PG8_BAR;
    }
    for (;;) {
        const bool has_next = S.next(ui + 1, nxt);
        const char* nA = has_next ? (const char*)g.A + (size_t)nxt.pm * tstep : cA; const char* nB = has_next ? (const char*)g.Bt + (size_t)nxt.e * g.estride + (size_t)nxt.pn * tstep : cB;
        for (int t = 0; t < nt; t += 2) {
            const bool last = (t == nt - 2);
            const char* a1 = cA + (size_t)(t + 1) * kstep;
            const char* a2 = last ? nA : cA + (size_t)(t + 2) * kstep; const char* b2 = last ? nB : cB + (size_t)(t + 2) * kstep;
            const char* a3 = a2 + kstep; const char* b3 = b2 + kstep;
            if (last && has_next) S.a_ready(nxt);
            if constexpr (SP2) {
            PG8_LDB(B0, 0, 0); PG8_LDB(B1, 0, 1); PG8_SCHED; PG8_LDA(At, 0, 0); PG8_STAGE(PG8_SA(1, 1), a1 + hstep, voffA);
            PG8_WAIT_V(8); PG8_WAIT_L(0); PG8_BAR; PG8_MMA(0, 0, At, B0); PG8_MMA(0, 1, At, B1); PG8_BAR; PG8_SCHED;
            PG8_LDA(At, 0, 1); PG8_STAGE(PG8_SB(0, 0), b2, voffB); PG8_STAGE(PG8_SB(0, 1), b2 + hstep, voffB); PG8_STAGE(PG8_SA(0, 0), a2, voffA);
            PG8_WAIT_V(8); PG8_WAIT_L(0); PG8_BAR; PG8_MMA(1, 0, At, B0); PG8_MMA(1, 1, At, B1); PG8_BAR; PG8_SCHED;
            PG8_LDB(B0, 1, 0); PG8_LDB(B1, 1, 1); PG8_SCHED; PG8_LDA(At, 1, 0); PG8_STAGE(PG8_SA(0, 1), a2 + hstep, voffA);
            PG8_WAIT_V(8); PG8_WAIT_L(0); PG8_BAR; PG8_MMA(0, 0, At, B0); PG8_MMA(0, 1, At, B1); PG8_BAR; PG8_SCHED;
            PG8_LDA(At, 1, 1); PG8_STAGE(PG8_SB(1, 0), b3, voffB); PG8_STAGE(PG8_SB(1, 1), b3 + hstep, voffB); PG8_STAGE(PG8_SA(1, 0), a3, voffA);
            PG8_WAIT_V(8); PG8_WAIT_L(0); PG8_BAR; PG8_MMA(1, 0, At, B0); PG8_MMA(1, 1, At, B1); PG8_BAR; PG8_SCHED;
            } else {
            PG8_LDB(B0, 0, 0); PG8_SCHED; PG8_LDA(At, 0, 0); PG8_STAGE(PG8_SA(1, 1), a1 + hstep, voffA);
            PG8_WAIT_L(8); PG8_BAR; PG8_WAIT_L(0); PG8_MMA(0, 0, At, B0); PG8_BAR; PG8_SCHED;
            PG8_LDB(B1, 0, 1); PG8_STAGE(PG8_SB(0, 0), b2, voffB);
            PG8_BAR; PG8_WAIT_L(0); PG8_MMA(0, 1, At, B1); PG8_BAR;
            PG8_LDA(At, 0, 1); PG8_STAGE(PG8_SA(0, 0), a2, voffA);
            PG8_BAR; PG8_WAIT_L(0); PG8_MMA(1, 0, At, B0); PG8_BAR; PG8_SCHED;
            PG8_STAGE(PG8_SB(0, 1), b2 + hstep, voffB);
            PG8_WAIT_V(6); PG8_BAR; PG8_MMA(1, 1, At, B1); PG8_BAR;
            PG8_LDB(B0, 1, 0); PG8_SCHED; PG8_LDA(At, 1, 0); PG8_STAGE(PG8_SA(0, 1), a2 + hstep, voffA);
            PG8_WAIT_L(8); PG8_BAR; PG8_WAIT_L(0); PG8_MMA(0, 0, At, B0); PG8_BAR; PG8_SCHED;
            PG8_LDB(B1, 1, 1); PG8_STAGE(PG8_SB(1, 0), b3, voffB);
            PG8_BAR; PG8_WAIT_L(0); PG8_MMA(0, 1, At, B1); PG8_BAR;
            PG8_LDA(At, 1, 1); PG8_STAGE(PG8_SA(1, 0), a3, voffA);
            PG8_BAR; PG8_WAIT_L(0); PG8_MMA(1, 0, At, B0); PG8_BAR; PG8_SCHED;
            PG8_STAGE(PG8_SB(1, 1), b3 + hstep, voffB);
            PG8_WAIT_V(6); PG8_BAR; PG8_MMA(1, 1, At, B1); PG8_BAR;
            }
        }
        if constexpr (ALIGN_EPI) { if (wr == 0) PG8_BAR; }
        if constexpr (!Epi::AFTER_DRAIN) { E(acc, cur, wr, wc, fr, fq); S.done(cur); }
        if (!has_next) break;
#pragma unroll
        for (int a = 0; a < 2; ++a)
#pragma unroll
            for (int b = 0; b < 2; ++b)
#pragma unroll
                for (int m = 0; m < 4; ++m)
#pragma unroll
                    for (int n = 0; n < 2; ++n) acc[a][b][m][n] = (f32x4){0.f, 0.f, 0.f, 0.f};
        cur = nxt; cA = nA; cB = nB; ++ui;
        if constexpr (ALIGN_EPI) { if (wr == 1) PG8_BAR; }
    }
    PG8_WAIT_V(0);
    if constexpr (!ALIGN_EPI) { if (wr == 0) PG8_BAR; }
    PG8_BAR;
    if constexpr (Epi::AFTER_DRAIN) { E.fused(acc, cur, wr, wc, fr, fq, lds, wid, lane); S.done(cur); }
#undef PG8_SA
#undef PG8_SB
#undef PG8_STAGE
#undef PG8_LDA
#undef PG8_LDB
#undef PG8_MMA
#undef PG8_WAIT_V
#undef PG8_WAIT_L
#undef PG8_BAR
#undef PG8_SCHED
}
}

#define GAS __attribute__((address_space(1)))
#define LAS __attribute__((address_space(3)))
typedef GAS unsigned gu32;
#define RLX_AGENT __ATOMIC_RELAXED, __HIP_MEMORY_SCOPE_AGENT
constexpr int NWAVES = 8;
constexpr int CW_BAR = 4096;
constexpr int RING_BYTES = 131072, LDSCTL_OFF = RING_BYTES, MISC_OFF = LDSCTL_OFF + 320, LDS_BYTES = 147456;
constexpr size_t CTL_ZERO_BYTES = 65536;

#define XB_TMO      128
#define XB_XCNT(j)  (256  + 64 * (j))
#define XB_XSUB(j)  (1280 + 64 * (j))
#define XB_XGEN(j)  (2304 + 64 * (j))
#define XB_TOP      3328
#define XB_TOPGEN   3392
#define XCD_BAR_WORDS 3456
#define XB_SPIN_CAP (1u << 18)

__device__ __forceinline__ unsigned xb_ld(unsigned* p)              { return __hip_atomic_load(p, __ATOMIC_RELAXED, __HIP_MEMORY_SCOPE_AGENT); }
__device__ __forceinline__ unsigned xb_add(unsigned* p, unsigned v) { return __hip_atomic_fetch_add(p, v, __ATOMIC_RELAXED, __HIP_MEMORY_SCOPE_AGENT); }
__device__ __forceinline__ unsigned xb_xcc_id() { return (unsigned)__builtin_amdgcn_s_getreg((3 << 11) | 20) & 0xFu; }
#define XB_SPIN(cond, bar) do { unsigned _sp = 0; while (cond) { __builtin_amdgcn_s_sleep(1); \
    if ((++_sp & 255u) == 0u) { if (xb_ld(&(bar)[XB_TMO])) break; if (_sp > XB_SPIN_CAP) { atomicAdd(&(bar)[XB_TMO], 1u); break; } } } } while (0)

struct XcdBarrier {
    unsigned* bar; unsigned x;
    volatile LAS unsigned* st;
};

__device__ __forceinline__ XcdBarrier xcd_barrier_post(unsigned* bar, volatile LAS unsigned* st) {
    XcdBarrier b; b.bar = bar; b.x = xb_xcc_id(); b.st = st;
    if (threadIdx.x == 0) (void)xb_add(&bar[XB_XCNT(b.x)], 1u);
    return b;
}
__device__ __forceinline__ void xcd_barrier_complete(unsigned* bar, unsigned x, unsigned& nloc, unsigned& nx) {
    const unsigned G = gridDim.x * gridDim.y * gridDim.z;
    unsigned sum, cnt, mine, sp = 0u;
    for (;;) {
        sum = 0u; cnt = 0u; mine = 0u;
#pragma unroll
        for (unsigned j = 0; j < 16; ++j) { const unsigned c = xb_ld(&bar[XB_XCNT(j)]); sum += c; cnt += (c > 0u) ? 1u : 0u; mine = (j == x) ? c : mine; }
        if (sum == G) break;
        __builtin_amdgcn_s_sleep(1);
        if ((++sp & 255u) == 0u) { if (xb_ld(&bar[XB_TMO])) break; if (sp > XB_SPIN_CAP) { atomicAdd(&bar[XB_TMO], 1u); break; } }
    }
    nloc = mine > 0u ? mine : 1u; nx = cnt > 0u ? cnt : 1u;
}

__device__ __forceinline__ void xcd_barrier(const XcdBarrier& b) {
    asm volatile("s_waitcnt vmcnt(0)" ::: "memory");
    __syncthreads();
    if (threadIdx.x == 0) {
        unsigned* bar = b.bar;
        __builtin_amdgcn_s_waitcnt(0);
        unsigned nloc = b.st[0], nx = b.st[1];
        if (nloc == 0u) { xcd_barrier_complete(bar, b.x, nloc, nx); b.st[0] = nloc; b.st[1] = nx; }
        const unsigned old = xb_add(&bar[XB_XSUB(b.x)], 1u);
        const unsigned gen = old / nloc;
        if (old + 1u == (gen + 1u) * nloc) {
            __builtin_amdgcn_fence(__ATOMIC_RELEASE, "agent");
            asm volatile("s_waitcnt vmcnt(0)" ::: "memory");
            const unsigned og = xb_add(&bar[XB_TOP], 1u);
            const unsigned tg = og / nx;
            if (og + 1u == (tg + 1u) * nx) xb_add(&bar[XB_TOPGEN], 1u);
            else XB_SPIN(xb_ld(&bar[XB_TOPGEN]) == tg, bar);
            __builtin_amdgcn_fence(__ATOMIC_ACQUIRE, "agent");
            xb_add(&bar[XB_XGEN(b.x)], 1u);
            asm volatile("s_waitcnt vmcnt(0)" ::: "memory");
        } else {
            XB_SPIN(xb_ld(&bar[XB_XGEN(b.x)]) == gen, bar);
            __builtin_amdgcn_fence(__ATOMIC_ACQUIRE, "agent");
            asm volatile("s_waitcnt vmcnt(0)" ::: "memory");
        }
    }
    __syncthreads();
}


template <class F> struct EpiAdapt {
    static constexpr bool PERM = false, AFTER_DRAIN = false; F f;
    __device__ __forceinline__ void operator()(const pg8::f32x4 (&acc)[2][2][4][2], const pg8::Unit& u, int wr, int wc, int fr, int fq) const {
#pragma unroll
        for (int ai = 0; ai < 2; ++ai)
#pragma unroll
            for (int m = 0; m < 4; ++m) { const int row = u.pm * 256 + ai * 128 + wr * 64 + m * 16 + fr;
#pragma unroll
                for (int bj = 0; bj < 2; ++bj) f(row, u.pn * 8 + bj * 4 + wc, fq, acc[ai][bj][m][0], acc[ai][bj][m][1]);
                asm volatile("" ::: "memory"); }
    }
};
struct EpiBf16Perm { bf16_t* O; int ldo; int pad;
    __device__ __forceinline__ void operator()(int row, int g, int fq, f32x4 v0, f32x4 v1) const {
        u32x4 w; w.x = pk2(v0.x, v0.y); w.y = pk2(v0.z, v0.w); w.z = pk2(v1.x, v1.y); w.w = pk2(v1.z, v1.w);
        *(u32x4*)(O + (size_t)row * ldo + 32 * g + 8 * fq) = w; } };
struct EpiResid { const float* hl_in; const float* hc_in; float* hl_out; float* hc_out; const float* mod; int goff; int pad;
    __device__ __forceinline__ void operator()(int row, int g, int fq, f32x4 v0, f32x4 v1) const {
        const int c0 = 32 * g + 4 * fq; const float* hin; float* hout; const float* gv;
        if (row < TL) { hin = hl_in + (size_t)row * D; hout = hl_out + (size_t)row * D; gv = mod + (row / SEQ) * 6144 + goff; }
        else { hin = hc_in + (size_t)(row - TL) * D; hout = hc_out + (size_t)(row - TL) * D; gv = mod + 2 * 6144 + goff; }
        *(f32x4*)(hout + c0) = *(const f32x4*)(hin + c0) + *(const f32x4*)(gv + c0) * v0;
        *(f32x4*)(hout + c0 + 16) = *(const f32x4*)(hin + c0 + 16) + *(const f32x4*)(gv + c0 + 16) * v1; } };
struct EpiSwiglu { bf16_t* H; int ldh; int pad;
    __device__ __forceinline__ void operator()(int row, int g, int fq, f32x4 v0, f32x4 v1) const {
        u32x2 w; w.x = pk2(silu_f(v0.x) * v1.x, silu_f(v0.y) * v1.y); w.y = pk2(silu_f(v0.z) * v1.z, silu_f(v0.w) * v1.w);
        *(u32x2*)(H + (size_t)row * ldh + 16 * g + 4 * fq) = w; } };

template <class F> __device__ __forceinline__ void run_gemm(LAS unsigned char* lds, const bf16_t* A, const bf16_t* Bt, int K, int nM, int nN, const int* texp, size_t estride_bytes, const F& f) {
    pg8::Gemm g{A, Bt, K, estride_bytes}; pg8::StaticOrder S; S.init(nM, nN, (int)gridDim.x, (int)blockIdx.x, texp);
    EpiAdapt<F> E{f};
    pg8::gemm_phase<EpiAdapt<F>, pg8::StaticOrder, true, true>(lds, g, S, E);
}

__device__ __forceinline__ float conv_src(const Params& p, int mode, const float* W0, const float* W1, int N, int nvalid, int k, int nb) {
    if (mode == 0) return W0[(size_t)k * N + nb];
    if (mode == 1) { const int col = (nb & ~31) + 8 * ((nb >> 2) & 3) + 4 * ((nb >> 4) & 1) + (nb & 3); return col < nvalid ? W0[(size_t)k * N + col] : 0.f; }
    const int col = 16 * (nb >> 5) + (nb & 15); return ((nb >> 4) & 1) ? W1[(size_t)k * N + col] : W0[(size_t)k * N + col];
}
constexpr int CT_WIN = 0, CT_WOUT = 2304, CT_WUQ = 3328, CT_WUKV = 3400, CT_WFGU = 3464, CT_WFDN = 6280, CT_WMGU = 7688, CT_WMDN = 36360, CT_END = 50696;
constexpr int IT_MODS = 192, IT_ROPE = 9;
__device__ __forceinline__ void ph_prologue(const Params& p, float* lds) {
    const int tid = opq((int)threadIdx.x), lane = tid & 63, wv = tid >> 6;
    for (int it = blockIdx.x; it < IT_MODS + IT_ROPE; it += gridDim.x) {
        if (it < IT_MODS) {
            const int l = it / 96, n0 = (it % 96) * 64, nn = tid & 63, kc = tid >> 6;
            float* sv = lds; float* red = lds + 3 * 1024;
            __syncthreads();
            for (int i = tid; i < 3 * 1024; i += 512) { const int v = i >> 10, k = i & 1023; const float x = (v < 2) ? p.in[1][v * D + k] : p.in[3][k]; sv[i] = silu_f(x); }
            __syncthreads();
            const float* w = p.in[4] + ((size_t)l * D + kc * 128) * 6144 + n0 + nn;
            float a0 = 0.f, a1 = 0.f, a2 = 0.f;
#pragma unroll 8
            for (int k = 0; k < 128; ++k) { const float wv_ = w[(size_t)k * 6144]; a0 += sv[kc * 128 + k] * wv_; a1 += sv[1024 + kc * 128 + k] * wv_; a2 += sv[2048 + kc * 128 + k] * wv_; }
            red[(kc * 3 + 0) * 64 + nn] = a0; red[(kc * 3 + 1) * 64 + nn] = a1; red[(kc * 3 + 2) * 64 + nn] = a2;
            __syncthreads();
            if (tid < 192) { const int v = tid >> 6; float s = p.in[5][l * 6144 + n0 + nn];
#pragma unroll
                for (int q = 0; q < 8; ++q) s += red[(q * 3 + v) * 64 + nn];
                ((float*)(p.ws + WS_MOD))[((size_t)l * 3 + v) * 6144 + n0 + nn] = s; }
        } else {
            const int idx = (it - IT_MODS) * 512 + tid;
            if (idx < RT_N) {
                int pos, i, nf;
                if (idx < RT_C64) { pos = idx / 16; i = idx % 16; nf = 16; }
                else if (idx < RT_R32) { pos = (idx - RT_C64) / 16; i = idx % 16; nf = 16; }
                else if (idx < RT_C32) { pos = (idx - RT_R32) / 8; i = idx % 8; nf = 8; }
                else { pos = (idx - RT_C32) / 8; i = idx % 8; nf = 8; }
                const float inv = powf(10000.0f, -(float)i / (float)nf);
                const float ang = (float)pos * inv;
                double s, c; sincos_d((double)ang, s, c);
                ((float2*)(p.ws + WS_ROPE))[idx] = make_float2((float)c, (float)s);
            }
        }
    }
    __syncthreads();
    float* scr = lds + wv * (64 * 36);
    for (int it = wv * gridDim.x + blockIdx.x; it < CT_END; it += 8 * gridDim.x) {
        int t = it;
        bf16_t* dst; const float* W0; const float* W1 = nullptr; int K, N, nvalid = 0, mode;
        if (t < CT_WOUT) { const int l = t / 1152; t %= 1152; dst = (bf16_t*)(p.ws + WS_WIN) + (size_t)l * NINP * D; W0 = p.in[8] + (size_t)l * D * NIN; K = D; N = NIN; nvalid = NIN; mode = 1; }
        else if (t < CT_WUQ) { t -= CT_WOUT; const int l = t / 512; t %= 512; dst = (bf16_t*)(p.ws + WS_WOUT) + (size_t)l * D * D; W0 = p.in[24] + (size_t)l * D * D; K = D; N = D; mode = 0; }
        else if (t < CT_WUKV) { t -= CT_WUQ; const int l = t / 36; t %= 36; dst = (bf16_t*)(p.ws + WS_WUQ) + (size_t)l * 384 * 192; W0 = p.in[18] + (size_t)l * 192 * 384; K = 192; N = 384; mode = 0; }
        else if (t < CT_WFGU) { t -= CT_WUKV; const int l = t / 32; t %= 32; dst = (bf16_t*)(p.ws + WS_WUKV) + (size_t)l * 512 * 128; W0 = p.in[20] + (size_t)l * 128 * 512; K = 128; N = 512; mode = 0; }
        else if (t < CT_WFDN) { t -= CT_WFGU; dst = (bf16_t*)(p.ws + WS_WFGU); W0 = p.in[25]; W1 = p.in[26]; K = D; N = DFF; mode = 2; }
        else if (t < CT_WMGU) { t -= CT_WFDN; dst = (bf16_t*)(p.ws + WS_WFDN); W0 = p.in[27]; K = DFF; N = D; mode = 0; }
        else if (t < CT_WMDN) { t -= CT_WMGU; const int e = t / 3584; t %= 3584; dst = (bf16_t*)(p.ws + WS_WMGU) + (size_t)e * 2 * DFFE * D; W0 = p.in[29] + (size_t)e * D * DFFE; W1 = p.in[30] + (size_t)e * D * DFFE; K = D; N = DFFE; mode = 2; }
        else { t -= CT_WMDN; const int e = t / 1792; t %= 1792; dst = (bf16_t*)(p.ws + WS_WMDN) + (size_t)e * D * DFFE; W0 = p.in[31] + (size_t)e * DFFE * D; K = DFFE; N = D; nvalid = D; mode = 1; }
        const int ktl = K / 64, n0 = (t / ktl) * 32, k0 = (t % ktl) * 64;
        const int n4 = lane & 7; const float* src; bool valid = true; int ln;
        if (mode == 0) { src = W0 + n0 + 4 * n4; ln = 4 * n4; }
        else if (mode == 1) { const int col = n0 + 4 * n4; valid = col < nvalid; src = W0 + (valid ? col : 0); ln = 16 * (n4 & 1) + 4 * (n4 >> 1); }
        else { src = ((n4 >> 2) ? W1 : W0) + 16 * (n0 >> 5) + 4 * (n4 & 3); ln = 16 * (n4 >> 2) + 4 * (n4 & 3); }
        src += (size_t)(k0 + (lane >> 3)) * N;
        f32x4 v[8];
#pragma unroll
        for (int i = 0; i < 8; ++i) v[i] = valid ? *(const f32x4*)(src + (size_t)(8 * i) * N) : (f32x4){0.f, 0.f, 0.f, 0.f};
#pragma unroll
        for (int i = 0; i < 8; ++i) *(f32x4*)(scr + ((lane >> 3) + 8 * i) * 36 + ln) = v[i];
        const int c = lane & 7;
#pragma unroll
        for (int j = 0; j < 4; ++j) { const int n = (lane >> 3) + 8 * j; const float* sp = scr + (8 * c) * 36 + n;
            u32x4 o; o.x = pk2(sp[0 * 36], sp[1 * 36]); o.y = pk2(sp[2 * 36], sp[3 * 36]); o.z = pk2(sp[4 * 36], sp[5 * 36]); o.w = pk2(sp[6 * 36], sp[7 * 36]);
            *(u32x4*)(dst + (size_t)(n0 + n) * K + k0 + 8 * c) = o; }
    }
    __syncthreads();
}

template <int WHICH, bool ROUTER> __device__ __forceinline__ void ph_norm(const Params& p, int layer, int nrows, unsigned* lcnt) {
    const int tx = opq((int)threadIdx.x), lane = tx & 63, gw = (blockIdx.x * 512 + tx) >> 6, ngw = (gridDim.x * 512) >> 6;
    if (ROUTER) { if (tx < 16) lcnt[tx] = 0u; __syncthreads(); }
    const float* hl = (layer == 0 && WHICH == 1) ? p.in[0] : p.out;
    const float* hc = (layer == 0 && WHICH == 1) ? p.in[2] : (const float*)(p.ws + WS_HCTX);
    const float* gain = p.in[WHICH == 1 ? 6 : 7] + layer * D;
    const float* mod = (const float*)(p.ws + WS_MOD) + (size_t)layer * 3 * 6144;
    bf16_t* dst = (bf16_t*)(p.ws + WS_ACT1);
    for (int m = gw; m < nrows; m += ngw) {
        const float* src = (m < TL) ? hl + (size_t)m * D : hc + (size_t)(m - TL) * D;
        const float* mv = mod + (m < TL ? m / SEQ : 2) * 6144;
        const float* shp = mv + (WHICH == 1 ? 0 : 3) * D; const float* scp = mv + (WHICH == 1 ? 1 : 4) * D;
        f32x4 v[4]; float ss = 0.f;
#pragma unroll
        for (int j = 0; j < 4; ++j) { v[j] = *(const f32x4*)(src + 256 * j + 4 * lane); ss += v[j].x * v[j].x + v[j].y * v[j].y + v[j].z * v[j].z + v[j].w * v[j].w; }
        const float rstd = rsqrtf(wave_sum(ss) * (1.f / D) + EPS);
        float lg[8];
#pragma unroll
        for (int e = 0; e < 8; ++e) lg[e] = 0.f;
#pragma unroll
        for (int j = 0; j < 4; ++j) {
            const int c = 256 * j + 4 * lane;
            const f32x4 g = *(const f32x4*)(gain + c), sh = *(const f32x4*)(shp + c), sc = *(const f32x4*)(scp + c);
            f32x4 f = v[j] * rstd * g * (sc + 1.f) + sh;
            u32x2 w; w.x = pk2(f.x, f.y); w.y = pk2(f.z, f.w);
            *(u32x2*)(dst + (size_t)m * D + c) = w;
            if (ROUTER) {
                const float* rt = p.in[28] + (size_t)c * 8;
#pragma unroll
                for (int i = 0; i < 4; ++i) { const f32x4 r0 = *(const f32x4*)(rt + 8 * i), r1 = *(const f32x4*)(rt + 8 * i + 4); const float fv = f[i];
                    lg[0] += fv * r0.x; lg[1] += fv * r0.y; lg[2] += fv * r0.z; lg[3] += fv * r0.w; lg[4] += fv * r1.x; lg[5] += fv * r1.y; lg[6] += fv * r1.z; lg[7] += fv * r1.w; }
            }
        }
        if (ROUTER) {
#pragma unroll
            for (int e = 0; e < 8; ++e) lg[e] = wave_sum(lg[e]);
            if (lane == 0) {
                int e0 = 0; float v0 = lg[0];
#pragma unroll
                for (int e = 1; e < 8; ++e) if (lg[e] > v0) { v0 = lg[e]; e0 = e; }
                int e1 = -1; float v1 = -INFINITY;
#pragma unroll
                for (int e = 0; e < 8; ++e) if (e != e0 && lg[e] > v1) { v1 = lg[e]; e1 = e; }
                const float t = expf(v1 - v0), g0 = 1.f / (1.f + t), g1 = t / (1.f + t);
                const int p0 = (int)atomicAdd(&lcnt[e0], 1u), p1 = (int)atomicAdd(&lcnt[e1], 1u);
                ((int2*)(p.ws + WS_TOKE))[m] = make_int2(e0, e1); ((int2*)(p.ws + WS_TOKP))[m] = make_int2(p0, p1); ((float2*)(p.ws + WS_TOKG))[m] = make_float2(g0, g1);
            }
        }
    }
    if (ROUTER) {
        __syncthreads();
        if (tx < 8) lcnt[8 + tx] = atomicAdd((unsigned*)(p.ws + WS_CTL) + 64 * tx, lcnt[tx]);
        __syncthreads();
        if (lane == 0) for (int m = gw; m < nrows; m += ngw) {
            const int2 e = ((const int2*)(p.ws + WS_TOKE))[m]; int2 ps = ((const int2*)(p.ws + WS_TOKP))[m];
            ps.x += (int)lcnt[8 + e.x]; ps.y += (int)lcnt[8 + e.y]; ((int2*)(p.ws + WS_TOKP))[m] = ps; }
        __syncthreads();
    }
}


typedef short pp_bf16x8 __attribute__((ext_vector_type(8)));
__device__ __forceinline__ float quad_sum(float v) { v += swz_xor<1>(v); v += swz_xor<2>(v); return v; }
__device__ __forceinline__ float kg_sum(float v) { v += swz_xor<16>(v); return half_sum(v); }
constexpr float QS64 = 0.125f * 1.4426950408889634f, QS96 = 0.10206207261596575f * 1.4426950408889634f;

template <int HS> __device__ __forceinline__ void pp_head(const Params& p, const QKVB& qb, int layer, const bf16_t* prow, bool lat, int b, int s, int key, int sub,
                                                          const float2 (&rr)[4], const float2 (&rc)[4]) {
    constexpr bool ISV = HS >= 20;
    constexpr int col = HS < 4 ? OFF_AQ + 64 * HS : HS < 6 ? OFF_AK + 64 * (HS - 4) : HS < 10 ? OFF_BQ + 64 * (HS - 6) : HS < 12 ? OFF_BK + 64 * (HS - 10) : HS < 16 ? OFF_CQ + 64 * (HS - 12) :
                        HS < 20 ? OFF_CK + 64 * (HS - 16) : HS < 22 ? OFF_AV + 64 * (HS - 20) : HS < 24 ? OFF_BV + 64 * (HS - 22) : OFF_CV + 64 * (HS - 24);
    constexpr bool ISQ = HS < 4 || (HS >= 6 && HS < 10) || (HS >= 12 && HS < 16);
    constexpr bool ROPE = HS < 12;
    constexpr int GIN = HS < 4 ? 9 : HS < 6 ? 10 : HS < 10 ? 12 : HS < 12 ? 13 : HS < 16 ? 14 : 15;
    bf16_t* dst;
    if (HS < 4) dst = lat ? qb.QA + ((size_t)(b * 4 + HS) * SEQ + s) * 64 : qb.QAc + ((size_t)(b * 4 + HS) * CTX + s) * 64;
    else if (HS < 6) dst = qb.KA + ((size_t)(b * 2 + HS - 4) * KEYS + key) * 64;
    else if (HS < 10) dst = lat ? qb.QB + ((size_t)(b * 4 + HS - 6) * SEQ + s) * 64 : qb.QBc + ((size_t)(b * 4 + HS - 6) * CTX + s) * 64;
    else if (HS < 12) dst = qb.KB + ((size_t)(b * 2 + HS - 10) * KEYS + key) * 64;
    else if (HS < 16) dst = lat ? qb.QC + ((size_t)(b * 4 + HS - 12) * SEQ + s) * 64 : qb.QCc + ((size_t)(b * 4 + HS - 12) * CTX + s) * 64;
    else if (HS < 20) dst = qb.KC + ((size_t)(b * 4 + HS - 16) * KEYS + key) * 64;
    else if (HS < 22) dst = qb.VA + ((size_t)(b * 2 + HS - 20) * KEYS + key) * 64;
    else if (HS < 24) dst = qb.VB + ((size_t)(b * 2 + HS - 22) * KEYS + key) * 64;
    else dst = qb.VC + ((size_t)(b * 4 + HS - 24) * KEYS + key) * 64;
    u32x2 w[4];
#pragma unroll
    for (int c = 0; c < 4; ++c) w[c] = *(const u32x2*)(prow + col + 16 * c + 4 * sub);
    if (!ISV) {
        f32x4 x[4]; float ss = 0.f;
#pragma unroll
        for (int c = 0; c < 4; ++c) { x[c] = (f32x4){bflo(w[c].x), bfhi(w[c].x), bflo(w[c].y), bfhi(w[c].y)}; ss += x[c].x * x[c].x + x[c].y * x[c].y + x[c].z * x[c].z + x[c].w * x[c].w; }
        const float r = rsqrtf(quad_sum(ss) * (1.f / 64.f) + EPS) * (ISQ ? QS64 : 1.f);
        const float* g = p.in[GIN] + layer * 64 + 4 * sub;
#pragma unroll
        for (int c = 0; c < 4; ++c) x[c] = x[c] * r * *(const f32x4*)(g + 16 * c);
        if (ROPE && lat) {
#pragma unroll
            for (int i = 0; i < 4; ++i) { const float a = x[0][i], bq = x[1][i]; x[0][i] = a * rr[i].x - bq * rr[i].y; x[1][i] = bq * rr[i].x + a * rr[i].y;
                const float c1 = x[2][i], c2 = x[3][i]; x[2][i] = c1 * rc[i].x - c2 * rc[i].y; x[3][i] = c2 * rc[i].x + c1 * rc[i].y; }
        }
#pragma unroll
        for (int c = 0; c < 4; ++c) { w[c].x = pk2(x[c].x, x[c].y); w[c].y = pk2(x[c].z, x[c].w); }
    }
#pragma unroll
    for (int c = 0; c < 4; ++c) *(u32x2*)(dst + 16 * c + 4 * sub) = w[c];
}
template <int HS> struct PPHeads { static __device__ __forceinline__ void run(const Params& p, const QKVB& qb, int layer, const bf16_t* prow, bool lat, int b, int s, int key, int sub, const float2 (&rr)[4], const float2 (&rc)[4]) {
    pp_head<HS>(p, qb, layer, prow, lat, b, s, key, sub, rr, rc); PPHeads<HS + 1>::run(p, qb, layer, prow, lat, b, s, key, sub, rr, rc); } };
template <> struct PPHeads<28> { static __device__ __forceinline__ void run(const Params&, const QKVB&, int, const bf16_t*, bool, int, int, int, int, const float2 (&)[4], const float2 (&)[4]) {} };

__device__ __forceinline__ void f8_from_bf(const u32x4 v, float (&x)[8]) { x[0] = bflo(v.x); x[1] = bfhi(v.x); x[2] = bflo(v.y); x[3] = bfhi(v.y); x[4] = bflo(v.z); x[5] = bfhi(v.z); x[6] = bflo(v.w); x[7] = bfhi(v.w); }

__device__ __forceinline__ void ph_postproj2(const Params& p, int layer) {
    const int tx = opq((int)threadIdx.x), lane = tx & 63, gw = (tx >> 6) * gridDim.x + blockIdx.x, ngw = gridDim.x * 8;
    const bf16_t* P = (const bf16_t*)(p.ws + WS_P);
    const QKVB qb = make_qkv(p.ws);
    const bf16_t* Wuq = (const bf16_t*)(p.ws + WS_WUQ) + (size_t)layer * 384 * 192;
    const bf16_t* Wukv = (const bf16_t*)(p.ws + WS_WUKV) + (size_t)layer * 512 * 128;
    const float2* rope = (const float2*)(p.ws + WS_ROPE);
    for (int u = gw; u < MALL / 16; u += ngw) {
        const int m0 = u * 16; const bool lat = m0 < TL;
        {
            const int t = lane >> 2, sub = lane & 3, m = m0 + t;
            const int b = lat ? m / SEQ : (m - TL) / CTX, s = lat ? m % SEQ : (m - TL) % CTX, key = lat ? CTX + s : s;
            float2 rr[4], rc[4];
#pragma unroll
            for (int i = 0; i < 4; ++i) { rr[i] = lat ? rope[RT_R64 + (s >> 6) * 16 + 4 * sub + i] : make_float2(1.f, 0.f); rc[i] = lat ? rope[RT_C64 + (s & 63) * 16 + 4 * sub + i] : make_float2(1.f, 0.f); }
            PPHeads<0>::run(p, qb, layer, P + (size_t)m * NINP, lat, b, s, key, sub, rr, rc);
        }
        {
            const int tk = lane & 15, kg = lane >> 4, m = m0 + tk;
            const int b = lat ? m / SEQ : (m - TL) / CTX, s = lat ? m % SEQ : (m - TL) % CTX, key = lat ? CTX + s : s;
            const bf16_t* prow = P + (size_t)m * NINP;
            pp_bf16x8 aq[6];
            { float x[6][8]; float ss = 0.f;
#pragma unroll
                for (int ks = 0; ks < 6; ++ks) { f8_from_bf(*(const u32x4*)(prow + OFF_DCQ + 32 * ks + 8 * kg), x[ks]);
#pragma unroll
                    for (int j = 0; j < 8; ++j) ss += x[ks][j] * x[ks][j]; }
                const float r = rsqrtf(kg_sum(ss) * (1.f / 192.f) + EPS);
                const float* g = p.in[17] + layer * 192 + 8 * kg;
#pragma unroll
                for (int ks = 0; ks < 6; ++ks) { const f32x4 g0 = *(const f32x4*)(g + 32 * ks), g1 = *(const f32x4*)(g + 32 * ks + 4);
                    u32x4 w; w.x = pk2(x[ks][0] * r * g0.x, x[ks][1] * r * g0.y); w.y = pk2(x[ks][2] * r * g0.z, x[ks][3] * r * g0.w); w.z = pk2(x[ks][4] * r * g1.x, x[ks][5] * r * g1.y); w.w = pk2(x[ks][6] * r * g1.z, x[ks][7] * r * g1.w);
                    aq[ks] = __builtin_bit_cast(pp_bf16x8, w); } }
            float2 qr_[4], qc_[4];
#pragma unroll
            for (int reg = 0; reg < 4; ++reg) { const int i = (4 * kg + reg) & 7; qr_[reg] = lat ? rope[RT_R32 + (s >> 6) * 8 + i] : make_float2(1.f, 0.f); qc_[reg] = lat ? rope[RT_C32 + (s & 63) * 8 + i] : make_float2(1.f, 0.f); }
#pragma unroll 1
            for (int h = 0; h < 4; ++h) {
                f32x4 acc[6];
#pragma unroll
                for (int nb = 0; nb < 6; ++nb) { acc[nb] = (f32x4){0.f, 0.f, 0.f, 0.f};
                    const bf16_t* wp = Wuq + (size_t)(96 * h + 16 * nb + tk) * 192 + 8 * kg;
#pragma unroll
                    for (int ks = 0; ks < 6; ++ks) acc[nb] = __builtin_amdgcn_mfma_f32_16x16x32_bf16(*(const pp_bf16x8*)(wp + 32 * ks), aq[ks], acc[nb], 0, 0, 0); }
                float ss = 0.f;
#pragma unroll
                for (int nb = 0; nb < 6; ++nb) ss += acc[nb].x * acc[nb].x + acc[nb].y * acc[nb].y + acc[nb].z * acc[nb].z + acc[nb].w * acc[nb].w;
                const float r = rsqrtf(kg_sum(ss) * (1.f / 96.f) + EPS) * QS96;
                const float* g = p.in[21] + layer * 96 + 4 * kg;
                bf16_t* dst = (lat ? qb.QD + ((size_t)(b * 4 + h) * SEQ + s) * 96 : qb.QDc + ((size_t)(b * 4 + h) * CTX + s) * 96) + 4 * kg;
#pragma unroll
                for (int nb = 0; nb < 6; ++nb) { f32x4 y = acc[nb] * r * *(const f32x4*)(g + 16 * nb);
                    if (nb >= 4 && lat) {
#pragma unroll
                        for (int reg = 0; reg < 4; ++reg) { const float other = half_other(y[reg], lane); const float2 cs = nb == 4 ? qr_[reg] : qc_[reg];
                            y[reg] = (kg < 2) ? y[reg] * cs.x - other * cs.y : y[reg] * cs.x + other * cs.y; } }
                    u32x2 w; w.x = pk2(y.x, y.y); w.y = pk2(y.z, y.w); *(u32x2*)(dst + 16 * nb) = w; }
            }
            pp_bf16x8 akv[4];
            { float x[4][8]; float ss = 0.f;
#pragma unroll
                for (int ks = 0; ks < 4; ++ks) { f8_from_bf(*(const u32x4*)(prow + OFF_DCKV + 32 * ks + 8 * kg), x[ks]);
#pragma unroll
                    for (int j = 0; j < 8; ++j) ss += x[ks][j] * x[ks][j]; }
                const float r = rsqrtf(kg_sum(ss) * (1.f / 128.f) + EPS);
                const float* g = p.in[19] + layer * 128 + 8 * kg;
#pragma unroll
                for (int ks = 0; ks < 4; ++ks) { const f32x4 g0 = *(const f32x4*)(g + 32 * ks), g1 = *(const f32x4*)(g + 32 * ks + 4);
                    u32x4 w; w.x = pk2(x[ks][0] * r * g0.x, x[ks][1] * r * g0.y); w.y = pk2(x[ks][2] * r * g0.z, x[ks][3] * r * g0.w); w.z = pk2(x[ks][4] * r * g1.x, x[ks][5] * r * g1.y); w.w = pk2(x[ks][6] * r * g1.z, x[ks][7] * r * g1.w);
                    akv[ks] = __builtin_bit_cast(pp_bf16x8, w); } }
            float kr[8]; f8_from_bf(*(const u32x4*)(prow + OFF_DKR + 8 * kg), kr);
            float krss = 0.f;
#pragma unroll
            for (int j = 0; j < 8; ++j) krss += kr[j] * kr[j];
            float2 kcs[8];
#pragma unroll
            for (int j = 0; j < 8; ++j) kcs[j] = !lat ? make_float2(1.f, 0.f) : (kg < 2 ? rope[RT_R32 + (s >> 6) * 8 + j] : rope[RT_C32 + (s & 63) * 8 + j]);
#pragma unroll 1
            for (int h = 0; h < 4; ++h) {
                f32x4 acc[8];
#pragma unroll
                for (int nb = 0; nb < 8; ++nb) { acc[nb] = (f32x4){0.f, 0.f, 0.f, 0.f};
                    const bf16_t* wp = Wukv + (size_t)(128 * h + 16 * nb + tk) * 128 + 8 * kg;
#pragma unroll
                    for (int ks = 0; ks < 4; ++ks) acc[nb] = __builtin_amdgcn_mfma_f32_16x16x32_bf16(*(const pp_bf16x8*)(wp + 32 * ks), akv[ks], acc[nb], 0, 0, 0); }
                float ss = krss;
#pragma unroll
                for (int nb = 0; nb < 4; ++nb) ss += acc[nb].x * acc[nb].x + acc[nb].y * acc[nb].y + acc[nb].z * acc[nb].z + acc[nb].w * acc[nb].w;
                const float r = rsqrtf(kg_sum(ss) * (1.f / 96.f) + EPS);
                const float* g = p.in[22] + layer * 96;
                bf16_t* kd = qb.KD + ((size_t)(b * 4 + h) * KEYS + key) * 96; bf16_t* vd = qb.VD + ((size_t)(b * 4 + h) * KEYS + key) * 64;
#pragma unroll
                for (int nb = 0; nb < 4; ++nb) { const f32x4 y = acc[nb] * r * *(const f32x4*)(g + 16 * nb + 4 * kg); u32x2 w; w.x = pk2(y.x, y.y); w.y = pk2(y.z, y.w); *(u32x2*)(kd + 16 * nb + 4 * kg) = w; }
                { float y[8];
#pragma unroll
                    for (int j = 0; j < 8; ++j) y[j] = kr[j] * r * g[64 + 8 * kg + j];
#pragma unroll
                    for (int j = 0; j < 8; ++j) { const float other = swz_xor<16>(y[j]); y[j] = (kg & 1) == 0 ? y[j] * kcs[j].x - other * kcs[j].y : y[j] * kcs[j].x + other * kcs[j].y; }
                    u32x4 w; w.x = pk2(y[0], y[1]); w.y = pk2(y[2], y[3]); w.z = pk2(y[4], y[5]); w.w = pk2(y[6], y[7]); *(u32x4*)(kd + 64 + 8 * kg) = w; }
#pragma unroll
                for (int nb = 4; nb < 8; ++nb) { const f32x4 y = acc[nb]; u32x2 w; w.x = pk2(y.x, y.y); w.y = pk2(y.z, y.w); *(u32x2*)(vd + 16 * (nb - 4) + 4 * kg) = w; }
            }
        }
    }
}

namespace fa {
typedef short bf16x8 __attribute__((ext_vector_type(8)));
typedef short s16x4 __attribute__((ext_vector_type(4)));
typedef float f32x16 __attribute__((ext_vector_type(16)));
typedef __attribute__((address_space(3))) const char* lds_cptr;
typedef short v4i16_t __attribute__((ext_vector_type(4)));
constexpr int KSTG = 12288, VSTG = 8192, STG = KSTG + VSTG;
constexpr int LDS_WS = 2 * STG, LDS_OST = LDS_WS + 8 * 256, LDS_RPB = LDS_OST + 8 * 4096, LDS_TOTAL = LDS_RPB + 2048;
constexpr float LOG2E = 1.4426950408889634f;
constexpr float THR = 6.0f;
__device__ __forceinline__ int crow(int r, int hi) { return (r & 3) + 8 * (r >> 2) + 4 * hi; }
__device__ __forceinline__ void glds16(const void* gsrc, unsigned lds_dst) { unsigned keep;
    asm volatile("s_mov_b32 %0, m0\n\ts_mov_b32 m0, %2\n\ts_nop 0\n\tglobal_load_lds_dwordx4 %1, off\n\ts_mov_b32 m0, %0" : "=&s"(keep) : "v"(gsrc), "s"(lds_dst) : "memory"); }
__device__ __forceinline__ s16x4 vtr(lds_cptr p) { return __builtin_bit_cast(s16x4, __builtin_amdgcn_ds_read_tr16_b64_v4i16((__attribute__((address_space(3))) v4i16_t*)p)); }
typedef float f32x2_t __attribute__((ext_vector_type(2))); typedef __bf16 bf16x2_t __attribute__((ext_vector_type(2)));
__device__ __forceinline__ unsigned cvtpk(float lo, float hi) { f32x2_t v = {lo, hi}; bf16x2_t b = __builtin_convertvector(v, bf16x2_t); return __builtin_bit_cast(unsigned, b); }
__device__ __forceinline__ float xhalf_max(float m) { auto rr = __builtin_amdgcn_permlane32_swap(__float_as_uint(m), __float_as_uint(m), false, false); return fmaxf(__uint_as_float(rr[0]), __uint_as_float(rr[1])); }
__device__ __forceinline__ float xhalf_sum(float m) { auto rr = __builtin_amdgcn_permlane32_swap(__float_as_uint(m), __float_as_uint(m), false, false); return __uint_as_float(rr[0]) + __uint_as_float(rr[1]); }
#define FA_WAIT_BAR() asm volatile("s_waitcnt vmcnt(0) lgkmcnt(0)\n\ts_barrier" ::: "memory")

template <int DQK, int MODE>
__device__ __forceinline__ void attn_unit(const bf16_t* Qg, const bf16_t* Kg, const bf16_t* Vg, bf16_t* Og, int q0, float sink2, const float* rpb, char* shm) {
    const int tid = opq((int)threadIdx.x), lane = tid & 63, r32 = lane & 31, hi = lane >> 5; const int wid = __builtin_amdgcn_readfirstlane(tid >> 6);
    const unsigned lds0 = (unsigned)(uintptr_t)shm;
    float* wsf = (float*)(shm + LDS_WS) + wid * 64;
    constexpr int NCH = DQK / 8, ND0 = DQK / 16;
    int NT, wbase = 0;
    if (MODE == 0) NT = KEYS / 64; else if (MODE == 3) NT = 4;
    else if (MODE == 1) { wbase = max(0, q0 - 128); const int we = min(SEQ, q0 + 256 + 128); NT = 4 + (we - wbase) / 64; }
    else { const int r0 = q0 >> 6; wbase = min(max(r0 - 4, 0), 120); const int kre = min(max(r0 - 1, 0), 120) + 8; NT = 4 + (kre - wbase); }
#define FA_KEY0(t) ((MODE == 0 || MODE == 3 || (t) < 4) ? 64 * (t) : (MODE == 1 ? CTX + wbase + 64 * ((t) - 4) : CTX + (wbase + (t) - 4) * 64))
    const bf16_t* ksrc = Kg + (size_t)lane * DQK; const bf16_t* vsrc = Vg + (size_t)(16 * (wid & 3) + (lane >> 2)) * 64 + (wid >> 2) * 32 + (lane & 3) * 8;
#define FA_DMA(t, s) do { const int k0_ = FA_KEY0(t); \
        _Pragma("unroll") for (int c_ = 0; c_ < 2; ++c_) { const int ch_ = wid + 8 * c_; if (ch_ < NCH) glds16(ksrc + (size_t)k0_ * DQK + ch_ * 8, (unsigned)__builtin_amdgcn_readfirstlane(lds0 + (s) * STG + ch_ * 1024)); } \
        glds16(vsrc + (size_t)k0_ * 64, (unsigned)__builtin_amdgcn_readfirstlane(lds0 + (s) * STG + KSTG + wid * 1024)); } while (0)
    FA_DMA(0, 0);
    if (MODE == 2) { float* rp = (float*)(shm + LDS_RPB); for (int i = tid; i < 15 * 31; i += 512) rp[i] = rpb[i] * LOG2E; }
    bf16x8 qr[ND0];
#pragma unroll
    for (int d0 = 0; d0 < ND0; ++d0) qr[d0] = *reinterpret_cast<const bf16x8*>(Qg + (size_t)(wid * 32 + r32) * DQK + d0 * 16 + hi * 8);
    float mhat = -1e30f, l_reg = 0.f; f32x16 o[2];
#pragma unroll
    for (int r = 0; r < 16; ++r) { o[0][r] = 0.f; o[1][r] = 0.f; }
    const int qpos = q0 + wid * 32 + r32;
    const int rq = (q0 >> 6) + (wid >> 1), jq = 32 * (wid & 1) + r32;
    const int rs = min(max(rq - 4, 0), 120), cs = min(max(jq - 8, 0), 48);
    const lds_cptr shm3 = (lds_cptr)shm;
    FA_WAIT_BAR();
    for (int t = 0; t < NT; ++t) {
        const int s = t & 1;
        if (t + 1 < NT) FA_DMA(t + 1, s ^ 1);
        bool active = true;
        if (MODE == 1 && t >= 4) { const int kp0 = wbase + 64 * (t - 4), qw0 = q0 + wid * 32; active = (kp0 + 63 >= qw0 - 128) && (kp0 <= qw0 + 31 + 128); }
        if (MODE == 2 && t >= 4) { const int kr = wbase + t - 4; active = (kr >= rs) && (kr < rs + 8); }
        if (active) {
            const lds_cptr kb = shm3 + s * STG + hi * 1024 + r32 * 16;
            f32x16 p0, p1;
#pragma unroll
            for (int r = 0; r < 16; ++r) { p0[r] = 0.f; p1[r] = 0.f; }
#pragma unroll
            for (int d0 = 0; d0 < ND0; ++d0) {
                const bf16x8 b0 = *(const __attribute__((address_space(3))) bf16x8*)(kb + d0 * 2048);
                const bf16x8 b1 = *(const __attribute__((address_space(3))) bf16x8*)(kb + d0 * 2048 + 512);
                p0 = __builtin_amdgcn_mfma_f32_32x32x16_bf16(b0, qr[d0], p0, 0, 0, 0);
                p1 = __builtin_amdgcn_mfma_f32_32x32x16_bf16(b1, qr[d0], p1, 0, 0, 0);
            }
            if (MODE == 1 && t >= 4) { const int kp0 = wbase + 64 * (t - 4) - qpos;
#pragma unroll
                for (int r = 0; r < 16; ++r) { const int d0_ = kp0 + crow(r, hi), d1_ = d0_ + 32; if (d0_ < -128 || d0_ > 128) p0[r] = -INFINITY; if (d1_ < -128 || d1_ > 128) p1[r] = -INFINITY; } }
            if (MODE == 2 && t >= 4) { const int kr = wbase + t - 4; const float* rp = (const float*)(shm + LDS_RPB) + (kr - rq + 7) * 31 + 15 - jq;
#pragma unroll
                for (int r = 0; r < 16; ++r) { const int kc0 = crow(r, hi), kc1 = kc0 + 32;
                    const bool v0 = (kc0 >= cs) && (kc0 < cs + 16), v1 = (kc1 >= cs) && (kc1 < cs + 16);
                    p0[r] = v0 ? p0[r] + rp[v0 ? kc0 : jq] : -INFINITY; p1[r] = v1 ? p1[r] + rp[v1 ? kc1 : jq] : -INFINITY; } }
            float rm = fmaxf(p0[0], p1[0]);
#pragma unroll
            for (int r = 1; r < 16; ++r) rm = fmaxf(rm, fmaxf(p0[r], p1[r]));
            rm = xhalf_max(rm);
            if (__any(rm - mhat > THR)) {
                const float mn = fmaxf(mhat, rm), f = __builtin_amdgcn_exp2f(mhat - mn); mhat = mn; l_reg *= f;
                if (hi == 0) wsf[r32] = f;
#pragma unroll
                for (int r = 0; r < 16; ++r) { const float fr = wsf[crow(r, hi)]; o[0][r] *= fr; o[1][r] *= fr; }
            }
            float sacc = 0.f;
#pragma unroll
            for (int r = 0; r < 16; ++r) { p0[r] = __builtin_amdgcn_exp2f(p0[r] - mhat); p1[r] = __builtin_amdgcn_exp2f(p1[r] - mhat); sacc += p0[r] + p1[r]; }
            l_reg += sacc;
            u32x4 pw0, pw1, pw2, pw3;
            pw0 = (u32x4){cvtpk(p0[0], p0[1]), cvtpk(p0[2], p0[3]), cvtpk(p0[4], p0[5]), cvtpk(p0[6], p0[7])};
            pw1 = (u32x4){cvtpk(p0[8], p0[9]), cvtpk(p0[10], p0[11]), cvtpk(p0[12], p0[13]), cvtpk(p0[14], p0[15])};
            pw2 = (u32x4){cvtpk(p1[0], p1[1]), cvtpk(p1[2], p1[3]), cvtpk(p1[4], p1[5]), cvtpk(p1[6], p1[7])};
            pw3 = (u32x4){cvtpk(p1[8], p1[9]), cvtpk(p1[10], p1[11]), cvtpk(p1[12], p1[13]), cvtpk(p1[14], p1[15])};
            const lds_cptr vp = shm3 + s * STG + KSTG + ((lane >> 4) & 1) * 32 + (lane & 3) * 8 + (4 * hi + ((lane & 15) >> 2)) * 64;
#pragma unroll
            for (int dh = 0; dh < 2; ++dh) {
                s16x4 vlo[4], vhi[4];
#pragma unroll
                for (int ks = 0; ks < 4; ++ks) { vlo[ks] = vtr(vp + dh * 4096 + ks * 1024); vhi[ks] = vtr(vp + dh * 4096 + ks * 1024 + 512); }
#define FA_VFR(k) (bf16x8){vlo[k][0], vlo[k][1], vlo[k][2], vlo[k][3], vhi[k][0], vhi[k][1], vhi[k][2], vhi[k][3]}
                o[dh] = __builtin_amdgcn_mfma_f32_32x32x16_bf16(__builtin_bit_cast(bf16x8, pw0), FA_VFR(0), o[dh], 0, 0, 0);
                o[dh] = __builtin_amdgcn_mfma_f32_32x32x16_bf16(__builtin_bit_cast(bf16x8, pw1), FA_VFR(1), o[dh], 0, 0, 0);
                o[dh] = __builtin_amdgcn_mfma_f32_32x32x16_bf16(__builtin_bit_cast(bf16x8, pw2), FA_VFR(2), o[dh], 0, 0, 0);
                o[dh] = __builtin_amdgcn_mfma_f32_32x32x16_bf16(__builtin_bit_cast(bf16x8, pw3), FA_VFR(3), o[dh], 0, 0, 0);
#undef FA_VFR
            }
        }
        FA_WAIT_BAR();
    }
    l_reg = xhalf_sum(l_reg);
    if (MODE == 1 || MODE == 3) l_reg += __builtin_amdgcn_exp2f(sink2 - mhat);
    if (hi == 0) wsf[32 + r32] = 1.0f / l_reg;
    float rli[16];
#pragma unroll
    for (int r = 0; r < 16; ++r) rli[r] = wsf[32 + crow(r, hi)];
    bf16_t* stg = (bf16_t*)(shm + LDS_OST) + wid * 2048;
#pragma unroll
    for (int r = 0; r < 16; ++r) { const int orow = crow(r, hi);
#pragma unroll
        for (int dh = 0; dh < 2; ++dh) stg[orow * 64 + dh * 32 + r32] = (bf16_t)f2bf(o[dh][r] * rli[r]); }
#pragma unroll
    for (int i = 0; i < 4; ++i) { const int row = i * 8 + (lane >> 3), ch = lane & 7; const u32x4 v = *(const u32x4*)(stg + row * 64 + ch * 8); *(u32x4*)(Og + (size_t)(wid * 32 + row) * D + ch * 8) = v; }
    asm volatile("s_waitcnt lgkmcnt(0)\n\ts_barrier" ::: "memory");
#undef FA_DMA
#undef FA_KEY0
}
#undef FA_WAIT_BAR
}


namespace fa2 {
using fa::bf16x8; using fa::s16x4; using fa::f32x16; using fa::lds_cptr; using fa::crow; using fa::glds16; using fa::vtr; using fa::cvtpk; using fa::LOG2E;
constexpr int KSL = 12288, VSL = 8192, VBASE = 4 * KSL, LDS_WS = VBASE + 3 * VSL, LDS_OST = LDS_WS + 8 * 256, LDS_RPB = LDS_OST + 8 * 4096, LDS_TOTAL = LDS_RPB + 2048;
static_assert(LDS_TOTAL <= 131072, "attention LDS");
#define SBAR() __builtin_amdgcn_sched_barrier(0)
#define PIN(x) asm volatile("" : "+v"(x))
template <int DQK, int MODE, int THRL>
__device__ __forceinline__ void attn_unit(const bf16_t* Qg, const bf16_t* Kg, const bf16_t* Vg, bf16_t* Og, int q0, float sink2, const float* rpb, char* shm) {
    const int tid = opq((int)threadIdx.x), lane = tid & 63, r32 = lane & 31, hi = lane >> 5; const int wid = __builtin_amdgcn_readfirstlane(tid >> 6);
    const unsigned lds0 = (unsigned)(uintptr_t)shm;
    float* wsf = (float*)(shm + LDS_WS) + wid * 64;
    constexpr int NCH = DQK / 8, ND0 = DQK / 16;
    int NT, wbase = 0;
    if (MODE == 0) NT = KEYS / 64; else if (MODE == 3) NT = 4;
    else if (MODE == 1) { wbase = max(0, q0 - 128); const int we = min(SEQ, q0 + 256 + 128); NT = 4 + (we - wbase) / 64; }
    else { const int r0 = q0 >> 6; wbase = min(max(r0 - 4, 0), 120); const int kre = min(max(r0 - 1, 0), 120) + 8; NT = 4 + (kre - wbase); }
#define FA_KEY0(t) ((MODE == 0 || MODE == 3 || (t) < 4) ? 64 * (t) : (MODE == 1 ? CTX + wbase + 64 * ((t) - 4) : CTX + (wbase + (t) - 4) * 64))
    const bf16_t* ksrc = Kg + (size_t)lane * DQK; const bf16_t* vsrc = Vg + (size_t)(16 * (wid & 3) + (lane >> 2)) * 64 + (wid >> 2) * 32 + (lane & 3) * 8;
#define DMA_K(t, slotoff) do { const int tt_ = (t) < NT ? (t) : NT - 1; const int k0_ = FA_KEY0(tt_); \
        glds16(ksrc + (size_t)k0_ * DQK + wid * 8, (unsigned)__builtin_amdgcn_readfirstlane(lds0 + (slotoff) + wid * 1024)); \
        if (NCH > 8) { if (wid < NCH - 8) glds16(ksrc + (size_t)k0_ * DQK + (wid + 8) * 8, (unsigned)__builtin_amdgcn_readfirstlane(lds0 + (slotoff) + (wid + 8) * 1024)); } } while (0)
#define DMA_V(t, slotoff) do { const int tt_ = (t) < NT ? (t) : NT - 1; const int k0_ = FA_KEY0(tt_); \
        glds16(vsrc + (size_t)k0_ * 64, (unsigned)__builtin_amdgcn_readfirstlane(lds0 + VBASE + (slotoff) + wid * 1024)); } while (0)
#define WAIT_STEP() do { if (NCH > 8 && wid < NCH - 8) asm volatile("s_waitcnt vmcnt(3) lgkmcnt(0)\n\ts_barrier" ::: "memory"); else asm volatile("s_waitcnt vmcnt(2) lgkmcnt(0)\n\ts_barrier" ::: "memory"); } while (0)
    DMA_K(0, 0); DMA_V(0, 0); DMA_K(1, KSL); DMA_K(2, 2 * KSL);
    if (MODE == 2) { float* rp = (float*)(shm + LDS_RPB); for (int i = tid; i < 15 * 31; i += 512) rp[i] = rpb[i] * LOG2E; }
    bf16x8 qr[ND0];
#pragma unroll
    for (int d0 = 0; d0 < ND0; ++d0) qr[d0] = *reinterpret_cast<const bf16x8*>(Qg + (size_t)(wid * 32 + r32) * DQK + d0 * 16 + hi * 8);
    float mhat = 0.f, l_reg = 0.f; f32x16 o[2]; f32x16 negm;
#pragma unroll
    for (int r = 0; r < 16; ++r) { o[0][r] = 0.f; o[1][r] = 0.f; negm[r] = 0.f; }
    PIN(negm);
    const int qpos = q0 + wid * 32 + r32;
    const int rq = (q0 >> 6) + (wid >> 1), jq = 32 * (wid & 1) + r32;
    const int rs = min(max(rq - 4, 0), 120), cs = min(max(jq - 8, 0), 48);
    const lds_cptr shm3 = (lds_cptr)shm;
    const lds_cptr kp0 = shm3 + hi * 1024 + r32 * 16;
    const lds_cptr vp0 = shm3 + VBASE + ((lane >> 4) & 1) * 32 + (lane & 3) * 8 + (4 * hi + ((lane & 15) >> 2)) * 64;
#define MASK(C0, C1, t) do { \
        if (MODE == 1 && (t) >= 4) { const int kp0_ = wbase + 64 * ((t) - 4) - qpos; \
            _Pragma("unroll") for (int r = 0; r < 16; ++r) { const int d0_ = kp0_ + crow(r, hi), d1_ = d0_ + 32; if (d0_ < -128 || d0_ > 128) C0[r] = -INFINITY; if (d1_ < -128 || d1_ > 128) C1[r] = -INFINITY; } } \
        if (MODE == 2 && (t) >= 4) { const int kr_ = wbase + (t) - 4; const bool rowok_ = (kr_ >= rs) && (kr_ < rs + 8); const int ro_ = min(max(kr_ - rq + 7, 0), 14); \
            const float* rp_ = (const float*)(shm + LDS_RPB) + ro_ * 31 + 15 - jq; \
            _Pragma("unroll") for (int r = 0; r < 16; ++r) { const int kc0 = crow(r, hi), kc1 = kc0 + 32; \
                const bool v0 = rowok_ && (kc0 >= cs) && (kc0 < cs + 16), v1 = rowok_ && (kc1 >= cs) && (kc1 < cs + 16); \
                C0[r] = v0 ? C0[r] + rp_[v0 ? kc0 : jq] : -INFINITY; C1[r] = v1 ? C1[r] + rp_[v1 ? kc1 : jq] : -INFINITY; } } } while (0)
#define ROWMAX(C0, C1, rm) do { float a_ = fmaxf(fmaxf(C0[0], C0[1]), C1[0]), b_ = fmaxf(fmaxf(C0[2], C0[3]), C1[1]); a_ = fmaxf(fmaxf(a_, C1[2]), C1[3]); \
        _Pragma("unroll") for (int r = 4; r < 16; r += 4) { a_ = fmaxf(fmaxf(a_, C0[r]), C0[r + 1]); b_ = fmaxf(fmaxf(b_, C0[r + 2]), C0[r + 3]); a_ = fmaxf(fmaxf(a_, C1[r]), C1[r + 1]); b_ = fmaxf(fmaxf(b_, C1[r + 2]), C1[r + 3]); } \
        rm = fa::xhalf_max(fmaxf(a_, b_)); } while (0)
    bf16x8 kf[8]; bf16x8 kf2[4];
#define KLOAD(j, slotoff) do { kf[2 * (j)] = *(const __attribute__((address_space(3))) bf16x8*)(kp0 + (slotoff) + (j) * 2048); kf[2 * (j) + 1] = *(const __attribute__((address_space(3))) bf16x8*)(kp0 + (slotoff) + (j) * 2048 + 512); } while (0)
#define KLOAD2(slotoff) do { if (ND0 > 4) { kf2[0] = *(const __attribute__((address_space(3))) bf16x8*)(kp0 + (slotoff) + 4 * 2048); kf2[1] = *(const __attribute__((address_space(3))) bf16x8*)(kp0 + (slotoff) + 4 * 2048 + 512); \
        kf2[2] = *(const __attribute__((address_space(3))) bf16x8*)(kp0 + (slotoff) + 5 * 2048); kf2[3] = *(const __attribute__((address_space(3))) bf16x8*)(kp0 + (slotoff) + 5 * 2048 + 512); } } while (0)
    asm volatile("s_waitcnt vmcnt(0) lgkmcnt(0)\n\ts_barrier" ::: "memory");
    f32x16 pA0, pA1, pB0, pB1;
    int ks_cur = 0, ks_next = KSL, ks_nn = 2 * KSL, ks_tgt = 3 * KSL;
    int vs_prev = 2 * VSL, vs_cur = 0, vs_next = VSL;
#define ROT() do { const int k_ = ks_cur; ks_cur = ks_next; ks_next = ks_nn; ks_nn = ks_tgt; ks_tgt = k_; const int v_ = vs_prev; vs_prev = vs_cur; vs_cur = vs_next; vs_next = v_; } while (0)
    bool resc = false;
#define RESC() do { if (resc) { _Pragma("unroll") for (int r = 0; r < 16; ++r) { const float fr_ = wsf[crow(r, hi)]; o[0][r] *= fr_; o[1][r] *= fr_; } } } while (0)
    KLOAD(0, 0); KLOAD(1, 0); KLOAD(2, 0); KLOAD(3, 0); KLOAD2(0);
    {
#pragma unroll
        for (int d0 = 0; d0 < 4; ++d0) { pA0 = __builtin_amdgcn_mfma_f32_32x32x16_bf16(kf[2 * d0], qr[d0], d0 == 0 ? negm : pA0, 0, 0, 0); pA1 = __builtin_amdgcn_mfma_f32_32x32x16_bf16(kf[2 * d0 + 1], qr[d0], d0 == 0 ? negm : pA1, 0, 0, 0); }
        if (ND0 > 4) { pA0 = __builtin_amdgcn_mfma_f32_32x32x16_bf16(kf2[0], qr[ND0 > 4 ? 4 : 0], pA0, 0, 0, 0); pA1 = __builtin_amdgcn_mfma_f32_32x32x16_bf16(kf2[1], qr[ND0 > 4 ? 4 : 0], pA1, 0, 0, 0);
                       pA0 = __builtin_amdgcn_mfma_f32_32x32x16_bf16(kf2[2], qr[ND0 > 4 ? 5 : 0], pA0, 0, 0, 0); pA1 = __builtin_amdgcn_mfma_f32_32x32x16_bf16(kf2[3], qr[ND0 > 4 ? 5 : 0], pA1, 0, 0, 0); }
        DMA_K(3, 3 * KSL); DMA_V(1, VSL);
        float rm; ROWMAX(pA0, pA1, rm);
        mhat = rm;
#pragma unroll
        for (int r = 0; r < 16; ++r) { pA0[r] = __builtin_amdgcn_exp2f(pA0[r] - rm); pA1[r] = __builtin_amdgcn_exp2f(pA1[r] - rm); negm[r] = -mhat; }
        PIN(negm);
        KLOAD(0, KSL); KLOAD(1, KSL); KLOAD(2, KSL); KLOAD(3, KSL);
        WAIT_STEP();
    }
    s16x4 vlo[8], vhi[8]; u32x4 pw0, pw1, pw2, pw3;
#define VRD(i) do { vlo[i] = vtr(vp_ + (((i) >> 2) * 4096 + ((i) & 3) * 1024)); vhi[i] = vtr(vp_ + (((i) >> 2) * 4096 + ((i) & 3) * 1024 + 512)); } while (0)
#define VFR(i) (bf16x8){vlo[i][0], vlo[i][1], vlo[i][2], vlo[i][3], vhi[i][0], vhi[i][1], vhi[i][2], vhi[i][3]}
#define PAF(k) __builtin_bit_cast(bf16x8, pw##k)
#define GAPA(MF, A0, A1, A2, A3, W0, W1, PW) do { MF; sacc += A0; sacc += A1; sacc += A2; sacc += A3; PIN(sacc); W0; W1; PIN(PW); SBAR(); } while (0)
#define EX(v) __builtin_amdgcn_exp2f(v)
#define GAPB(MF, X, B) do { MF; X[B] = EX(X[B]); X[B + 1] = EX(X[B + 1]); X[B + 2] = EX(X[B + 2]); X[B + 3] = EX(X[B + 3]); PIN(X); SBAR(); } while (0)
#define KRD(j) do { KLOAD(j, ks_nn_); SBAR(); } while (0)
#define STEP(C0, C1, P0, P1, t) do { SBAR(); \
        const lds_cptr vp_ = vp0 + vs_prev; const int ks_cur_ = ks_cur; (void)ks_cur_; \
        KLOAD2(ks_cur_); \
        VRD(0); SBAR(); float sacc = (P0[0] + P0[1]); \
        GAPA(C0 = __builtin_amdgcn_mfma_f32_32x32x16_bf16(kf[0], qr[0], negm, 0, 0, 0), P0[2], P0[3], P0[4], P0[5], pw0[0] = cvtpk(P0[0], P0[1]), pw0[1] = cvtpk(P0[2], P0[3]), pw0); \
        VRD(4); SBAR(); GAPA(C1 = __builtin_amdgcn_mfma_f32_32x32x16_bf16(kf[1], qr[0], negm, 0, 0, 0), P0[6], P0[7], P0[8], P0[9], pw0[2] = cvtpk(P0[4], P0[5]), pw0[3] = cvtpk(P0[6], P0[7]), pw0); \
        VRD(1); SBAR(); GAPA(C0 = __builtin_amdgcn_mfma_f32_32x32x16_bf16(kf[2], qr[1], C0, 0, 0, 0), P0[10], P0[11], P0[12], P0[13], pw1[0] = cvtpk(P0[8], P0[9]), pw1[1] = cvtpk(P0[10], P0[11]), pw1); \
        VRD(5); SBAR(); GAPA(C1 = __builtin_amdgcn_mfma_f32_32x32x16_bf16(kf[3], qr[1], C1, 0, 0, 0), P0[14], P0[15], P1[0], P1[1], pw1[2] = cvtpk(P0[12], P0[13]), pw1[3] = cvtpk(P0[14], P0[15]), pw1); \
        VRD(2); SBAR(); GAPA(C0 = __builtin_amdgcn_mfma_f32_32x32x16_bf16(kf[4], qr[2], C0, 0, 0, 0), P1[2], P1[3], P1[4], P1[5], pw2[0] = cvtpk(P1[0], P1[1]), pw2[1] = cvtpk(P1[2], P1[3]), pw2); \
        VRD(6); SBAR(); GAPA(C1 = __builtin_amdgcn_mfma_f32_32x32x16_bf16(kf[5], qr[2], C1, 0, 0, 0), P1[6], P1[7], P1[8], P1[9], pw2[2] = cvtpk(P1[4], P1[5]), pw2[3] = cvtpk(P1[6], P1[7]), pw2); \
        VRD(3); SBAR(); GAPA(C0 = __builtin_amdgcn_mfma_f32_32x32x16_bf16(kf[6], qr[3], C0, 0, 0, 0), P1[10], P1[11], P1[12], P1[13], pw3[0] = cvtpk(P1[8], P1[9]), pw3[1] = cvtpk(P1[10], P1[11]), pw3); \
        VRD(7); SBAR(); GAPA(C1 = __builtin_amdgcn_mfma_f32_32x32x16_bf16(kf[7], qr[3], C1, 0, 0, 0), P1[14], P1[15], 0.f, 0.f, pw3[2] = cvtpk(P1[12], P1[13]), pw3[3] = cvtpk(P1[14], P1[15]), pw3); \
        if (ND0 > 4) { C0 = __builtin_amdgcn_mfma_f32_32x32x16_bf16(kf2[0], qr[ND0 > 4 ? 4 : 0], C0, 0, 0, 0); C1 = __builtin_amdgcn_mfma_f32_32x32x16_bf16(kf2[1], qr[ND0 > 4 ? 4 : 0], C1, 0, 0, 0); \
                       C0 = __builtin_amdgcn_mfma_f32_32x32x16_bf16(kf2[2], qr[ND0 > 4 ? 5 : 0], C0, 0, 0, 0); C1 = __builtin_amdgcn_mfma_f32_32x32x16_bf16(kf2[3], qr[ND0 > 4 ? 5 : 0], C1, 0, 0, 0); SBAR(); } \
        l_reg += sacc; \
        DMA_K((t) + 3, ks_tgt); DMA_V((t) + 1, vs_next); \
        MASK(C0, C1, t); \
        { float rm; ROWMAX(C0, C1, rm); resc = false; \
          if (__builtin_expect(__any(rm > (float)THRL), 0)) { const float dl = fmaxf(rm, 0.f); mhat += dl; \
              _Pragma("unroll") for (int r = 0; r < 16; ++r) { C0[r] -= dl; C1[r] -= dl; } \
              _Pragma("unroll") for (int r = 0; r < 16; ++r) negm[r] = -mhat; PIN(negm); \
              const float f = __builtin_amdgcn_exp2f(-dl); l_reg *= f; if (hi == 0) wsf[r32] = f; resc = true; } } \
        SBAR(); \
        const int ks_nn_ = ks_next; \
        GAPB(o[0] = __builtin_amdgcn_mfma_f32_32x32x16_bf16(PAF(0), VFR(0), o[0], 0, 0, 0), C0, 0); \
        GAPB(o[1] = __builtin_amdgcn_mfma_f32_32x32x16_bf16(PAF(0), VFR(4), o[1], 0, 0, 0), C0, 4); \
        KRD(0); GAPB(o[0] = __builtin_amdgcn_mfma_f32_32x32x16_bf16(PAF(1), VFR(1), o[0], 0, 0, 0), C0, 8); \
        KRD(1); GAPB(o[1] = __builtin_amdgcn_mfma_f32_32x32x16_bf16(PAF(1), VFR(5), o[1], 0, 0, 0), C0, 12); \
        KRD(2); GAPB(o[0] = __builtin_amdgcn_mfma_f32_32x32x16_bf16(PAF(2), VFR(2), o[0], 0, 0, 0), C1, 0); \
        KRD(3); GAPB(o[1] = __builtin_amdgcn_mfma_f32_32x32x16_bf16(PAF(2), VFR(6), o[1], 0, 0, 0), C1, 4); \
        GAPB(o[0] = __builtin_amdgcn_mfma_f32_32x32x16_bf16(PAF(3), VFR(3), o[0], 0, 0, 0), C1, 8); \
        GAPB(o[1] = __builtin_amdgcn_mfma_f32_32x32x16_bf16(PAF(3), VFR(7), o[1], 0, 0, 0), C1, 12); \
    } while (0)
    ROT();
    int t = 1;
    for (; t + 1 < NT; t += 2) {
        STEP(pB0, pB1, pA0, pA1, t);     WAIT_STEP(); RESC(); ROT();
        STEP(pA0, pA1, pB0, pB1, t + 1); WAIT_STEP(); RESC(); ROT();
    }
    if (t < NT) {
        STEP(pB0, pB1, pA0, pA1, t);     WAIT_STEP(); RESC(); ROT();
        pA0 = pB0; pA1 = pB1;
    }
    {
        float sacc = 0.f;
#pragma unroll
        for (int r = 0; r < 16; ++r) sacc += pA0[r] + pA1[r];
        l_reg += sacc;
        pw0 = (u32x4){cvtpk(pA0[0], pA0[1]), cvtpk(pA0[2], pA0[3]), cvtpk(pA0[4], pA0[5]), cvtpk(pA0[6], pA0[7])};
        pw1 = (u32x4){cvtpk(pA0[8], pA0[9]), cvtpk(pA0[10], pA0[11]), cvtpk(pA0[12], pA0[13]), cvtpk(pA0[14], pA0[15])};
        pw2 = (u32x4){cvtpk(pA1[0], pA1[1]), cvtpk(pA1[2], pA1[3]), cvtpk(pA1[4], pA1[5]), cvtpk(pA1[6], pA1[7])};
        pw3 = (u32x4){cvtpk(pA1[8], pA1[9]), cvtpk(pA1[10], pA1[11]), cvtpk(pA1[12], pA1[13]), cvtpk(pA1[14], pA1[15])};
        const lds_cptr vp_ = vp0 + vs_prev;
#pragma unroll
        for (int i = 0; i < 8; ++i) VRD(i);
        o[0] = __builtin_amdgcn_mfma_f32_32x32x16_bf16(PAF(0), VFR(0), o[0], 0, 0, 0); o[1] = __builtin_amdgcn_mfma_f32_32x32x16_bf16(PAF(0), VFR(4), o[1], 0, 0, 0);
        o[0] = __builtin_amdgcn_mfma_f32_32x32x16_bf16(PAF(1), VFR(1), o[0], 0, 0, 0); o[1] = __builtin_amdgcn_mfma_f32_32x32x16_bf16(PAF(1), VFR(5), o[1], 0, 0, 0);
        o[0] = __builtin_amdgcn_mfma_f32_32x32x16_bf16(PAF(2), VFR(2), o[0], 0, 0, 0); o[1] = __builtin_amdgcn_mfma_f32_32x32x16_bf16(PAF(2), VFR(6), o[1], 0, 0, 0);
        o[0] = __builtin_amdgcn_mfma_f32_32x32x16_bf16(PAF(3), VFR(3), o[0], 0, 0, 0); o[1] = __builtin_amdgcn_mfma_f32_32x32x16_bf16(PAF(3), VFR(7), o[1], 0, 0, 0);
    }
    l_reg = fa::xhalf_sum(l_reg);
    if (MODE == 1 || MODE == 3) l_reg += __builtin_amdgcn_exp2f(sink2 - mhat);
    if (hi == 0) wsf[32 + r32] = 1.0f / l_reg;
    float rli[16];
#pragma unroll
    for (int r = 0; r < 16; ++r) rli[r] = wsf[32 + crow(r, hi)];
    bf16_t* stg = (bf16_t*)(shm + LDS_OST) + wid * 2048;
#pragma unroll
    for (int r = 0; r < 16; ++r) { const int orow = crow(r, hi);
#pragma unroll
        for (int dh = 0; dh < 2; ++dh) stg[orow * 64 + dh * 32 + r32] = (bf16_t)f2bf(o[dh][r] * rli[r]); }
#pragma unroll
    for (int i = 0; i < 4; ++i) { const int row = i * 8 + (lane >> 3), ch = lane & 7; const u32x4 v = *(const u32x4*)(stg + row * 64 + ch * 8); *(u32x4*)(Og + (size_t)(wid * 32 + row) * D + ch * 8) = v; }
    asm volatile("s_waitcnt vmcnt(0) lgkmcnt(0)\n\ts_barrier" ::: "memory");
#undef FA_KEY0
#undef DMA_K
#undef DMA_V
#undef WAIT_STEP
#undef MASK
#undef ROWMAX
#undef KLOAD
#undef KLOAD2
#undef ROT
#undef RESC
#undef VRD
#undef VFR
#undef PAF
#undef GAPA
#undef EX
#undef GAPB
#undef KRD
#undef STEP
}
#undef SBAR
#undef PIN
}

constexpr float SCALE_MLA = 0.10206207261596575f;
__device__ __forceinline__ void ph_attn(const Params& p, int layer, bool with_ctx, char* shm) {
    const QKVB qb = make_qkv(p.ws);
    bf16_t* O = (bf16_t*)(p.ws + WS_P);
    const int G = gridDim.x;
    const float NEG = -INFINITY;
    for (int u = blockIdx.x; u < 256; u += G) { const int bh = u & 7, b = bh >> 2, h = bh & 3, qbk = u >> 3;
        fa2::attn_unit<96, 0, 6>(qb.QD + ((size_t)bh * SEQ + qbk * 256) * 96, qb.KD + (size_t)bh * KEYS * 96, qb.VD + (size_t)bh * KEYS * 64, O + (size_t)(b * SEQ + qbk * 256) * D + 768 + h * 64, qbk * 256, NEG, nullptr, shm); }
    for (int u = blockIdx.x; u < 256; u += G) { const int bh = u & 7, b = bh >> 2, h = bh & 3, qbk = u >> 3;
        fa2::attn_unit<64, 0, 6>(qb.QB + ((size_t)bh * SEQ + qbk * 256) * 64, qb.KB + (size_t)(b * 2 + (h >> 1)) * KEYS * 64, qb.VB + (size_t)(b * 2 + (h >> 1)) * KEYS * 64, O + (size_t)(b * SEQ + qbk * 256) * D + 256 + h * 64, qbk * 256, NEG, nullptr, shm); }
    for (int u = blockIdx.x; u < 256; u += G) { const int bh = u & 7, b = bh >> 2, h = bh & 3, qbk = u >> 3;
        fa2::attn_unit<64, 1, 6>(qb.QA + ((size_t)bh * SEQ + qbk * 256) * 64, qb.KA + (size_t)(b * 2 + (h >> 1)) * KEYS * 64, qb.VA + (size_t)(b * 2 + (h >> 1)) * KEYS * 64, O + (size_t)(b * SEQ + qbk * 256) * D + 0 + h * 64, qbk * 256, p.in[11][layer * 4 + h] * fa::LOG2E, nullptr, shm); }
    for (int u = blockIdx.x; u < 256; u += G) { const int bh = u & 7, b = bh >> 2, h = bh & 3, qbk = u >> 3;
        fa2::attn_unit<64, 2, 6>(qb.QC + ((size_t)bh * SEQ + qbk * 256) * 64, qb.KC + (size_t)bh * KEYS * 64, qb.VC + (size_t)bh * KEYS * 64, O + (size_t)(b * SEQ + qbk * 256) * D + 512 + h * 64, qbk * 256, NEG, p.in[16] + ((size_t)layer * 4 + h) * 15 * 31, shm); }
    if (with_ctx) for (int u = blockIdx.x; u < 32; u += G) { const int ty = u >> 3, bh = u & 7, b = bh >> 2, h = bh & 3;
        bf16_t* Oc = O + (size_t)(TL + b * CTX) * D + ty * 256 + h * 64;
        if (ty == 0) fa2::attn_unit<64, 3, 6>(qb.QAc + (size_t)bh * CTX * 64, qb.KA + (size_t)(b * 2 + (h >> 1)) * KEYS * 64, qb.VA + (size_t)(b * 2 + (h >> 1)) * KEYS * 64, Oc, 0, p.in[11][layer * 4 + h] * fa::LOG2E, nullptr, shm);
        else if (ty == 1) fa2::attn_unit<64, 3, 6>(qb.QBc + (size_t)bh * CTX * 64, qb.KB + (size_t)(b * 2 + (h >> 1)) * KEYS * 64, qb.VB + (size_t)(b * 2 + (h >> 1)) * KEYS * 64, Oc, 0, NEG, nullptr, shm);
        else if (ty == 2) fa2::attn_unit<64, 3, 6>(qb.QCc + (size_t)bh * CTX * 64, qb.KC + (size_t)bh * KEYS * 64, qb.VC + (size_t)bh * KEYS * 64, Oc, 0, NEG, nullptr, shm);
        else fa2::attn_unit<96, 3, 6>(qb.QDc + (size_t)bh * CTX * 96, qb.KD + (size_t)bh * KEYS * 96, qb.VD + (size_t)bh * KEYS * 64, Oc, 0, NEG, nullptr, shm); }
}

__device__ __forceinline__ void ph_gnorm(const Params& p, int layer, int nrows) {
    const int tx = opq((int)threadIdx.x), lane = tx & 63, gw = (blockIdx.x * 512 + tx) >> 6, ngw = (gridDim.x * 512) >> 6;
    const bf16_t* O = (const bf16_t*)(p.ws + WS_P); bf16_t* Y = (bf16_t*)(p.ws + WS_ACT1); const float* g = p.in[23] + layer * D;
    for (int m = gw; m < nrows; m += ngw) {
#pragma unroll
        for (int grp = 0; grp < 4; ++grp) { const int c = grp * 256 + 4 * lane; const u32x2 w = *(const u32x2*)(O + (size_t)m * D + c);
            const float a0 = bflo(w.x), a1 = bfhi(w.x), a2 = bflo(w.y), a3 = bfhi(w.y);
            const float r = rsqrtf(wave_sum(a0 * a0 + a1 * a1 + a2 * a2 + a3 * a3) * (1.f / 256.f) + EPS);
            const f32x4 gv = *(const f32x4*)(g + c); u32x2 o; o.x = pk2(a0 * r * gv.x, a1 * r * gv.y); o.y = pk2(a2 * r * gv.z, a3 * r * gv.w);
            *(u32x2*)(Y + (size_t)m * D + c) = o; }
    }
}

__device__ __forceinline__ void moe_bases(const unsigned* cnt, int (&base)[9]) {
    int acc = 0;
#pragma unroll
    for (int e = 0; e < 8; ++e) { base[e] = acc; acc += ((int)cnt[64 * e] + 255) / 256 * 256; }
    base[8] = acc;
}
__device__ __forceinline__ void ph_moe_gather(const Params& p) {
    const int tx = opq((int)threadIdx.x), lane = tx & 63, gw = (blockIdx.x * 512 + tx) >> 6, ngw = (gridDim.x * 512) >> 6;
    const unsigned* cnt = (const unsigned*)(p.ws + WS_CTL); int base[9]; moe_bases(cnt, base);
    if (blockIdx.x == 0 && tx < 136) { const int r = tx * 256; int e = -1;
#pragma unroll
        for (int i = 0; i < 8; ++i) if (r >= base[i] && r < base[i + 1]) e = i;
        ((int*)(p.ws + WS_TEXP))[tx] = e < 0 ? 0 : e; }
    const bf16_t* F = (const bf16_t*)(p.ws + WS_ACT1); bf16_t* A = (bf16_t*)(p.ws + WS_ASORT);
    for (int m = gw; m < TL; m += ngw) {
        const int2 e = ((const int2*)(p.ws + WS_TOKE))[m]; const int2 ps = ((const int2*)(p.ws + WS_TOKP))[m];
        int b0 = 0, b1 = 0;
#pragma unroll
        for (int i = 0; i < 8; ++i) { if (e.x == i) b0 = base[i]; if (e.y == i) b1 = base[i]; }
        const int s0 = b0 + ps.x, s1 = b1 + ps.y;
        const u32x4 v0 = *(const u32x4*)(F + (size_t)m * D + lane * 16), v1 = *(const u32x4*)(F + (size_t)m * D + lane * 16 + 8);
        *(u32x4*)(A + (size_t)s0 * D + lane * 16) = v0; *(u32x4*)(A + (size_t)s0 * D + lane * 16 + 8) = v1;
        *(u32x4*)(A + (size_t)s1 * D + lane * 16) = v0; *(u32x4*)(A + (size_t)s1 * D + lane * 16 + 8) = v1;
        if (lane == 0) ((int2*)(p.ws + WS_TOKS))[m] = make_int2(s0, s1);
    }
}
__device__ __forceinline__ void ph_moe_combine(const Params& p, int layer) {
    const size_t nthr = (size_t)gridDim.x * 512;
    for (size_t idx = (size_t)blockIdx.x * 512 + opq((int)threadIdx.x); idx < (size_t)TL * 256; idx += nthr) {
        const int m = (int)(idx >> 8), c = (int)(idx & 255) * 4;
        const int2 sl = ((const int2*)(p.ws + WS_TOKS))[m]; const float2 g = ((const float2*)(p.ws + WS_TOKG))[m];
        const bf16_t* Y = (const bf16_t*)(p.ws + WS_ASORT);
        const u32x2 a = *(const u32x2*)(Y + (size_t)sl.x * D + c), b = *(const u32x2*)(Y + (size_t)sl.y * D + c);
        const f32x4 ya = {bflo(a.x), bfhi(a.x), bflo(a.y), bfhi(a.y)}, yb = {bflo(b.x), bfhi(b.x), bflo(b.y), bfhi(b.y)};
        const float* mod = (const float*)(p.ws + WS_MOD) + (size_t)layer * 3 * 6144 + (m / SEQ) * 6144 + 5 * D;
        f32x4* o = (f32x4*)(p.out + (size_t)m * D + c);
        *o = *o + *(const f32x4*)(mod + c) * (ya * g.x + yb * g.y);
    }
}

#ifndef DBL_PHASE
#define DBL_PHASE (-1)
#endif
struct Args { Params p; int ph_lo, ph_hi; };
__global__ void __launch_bounds__(NWAVES * 64, 2) mega_fwd(Args args) {
    extern __shared__ __attribute__((aligned(16))) unsigned char lds[];
    LAS unsigned char* ldsl = (LAS unsigned char*)lds;
    for (int u = threadIdx.x; u < (LDS_BYTES - LDSCTL_OFF) / 4; u += NWAVES * 64) ((LAS unsigned*)(ldsl + LDSCTL_OFF))[u] = 0u;
    __syncthreads();
    XcdBarrier bar = xcd_barrier_post((unsigned*)(args.p.ws + WS_CTL) + CW_BAR, (volatile LAS unsigned*)(ldsl + MISC_OFF) + 8);
    const int lo = args.ph_lo, hi = args.ph_hi; int ph = 0;
#define PHASE(body) do { if (lo <= ph && ph < hi) { Params q = args.p; q.ws = opqp(args.p.ws); q.out = opqp(args.p.out); LAS unsigned char* ldq = (LAS unsigned char*)lds; (void)ldq; for (int rep_ = 0; rep_ < ((ph == DBL_PHASE) ? 2 : 1); ++rep_) { if (rep_) xcd_barrier(bar); body; } if (ph + 1 < hi) xcd_barrier(bar); } ++ph; } while (0)
#define QMOD(l) ((const float*)(q.ws + WS_MOD) + (size_t)(l) * 3 * 6144)
    PHASE(ph_prologue(q, (float*)lds));
#pragma unroll 1
    for (int l = 0; l < 2; ++l) {
        const bool last = (l == 1);
        const int nrows = last ? TL : MALL;
        PHASE((ph_norm<1, false>(q, l, MALL, (unsigned*)lds)));
        PHASE(run_gemm(ldq, (const bf16_t*)(q.ws + WS_ACT1), (const bf16_t*)(q.ws + WS_WIN) + (size_t)l * NINP * D, D, MALL / 256, NINP / 256, nullptr, 0, EpiBf16Perm{(bf16_t*)(q.ws + WS_P), NINP, 0}));
        PHASE(ph_postproj2(q, l));
        PHASE(ph_attn(q, l, !last, (char*)lds));
        PHASE(ph_gnorm(q, l, nrows));
        PHASE(run_gemm(ldq, (const bf16_t*)(q.ws + WS_ACT1), (const bf16_t*)(q.ws + WS_WOUT) + (size_t)l * D * D, D, nrows / 256, D / 256, nullptr, 0,
                       EpiResid{(l == 0) ? q.in[0] : q.out, (l == 0) ? q.in[2] : (const float*)(q.ws + WS_HCTX), q.out, (float*)(q.ws + WS_HCTX), QMOD(l), 2 * D, 0}));
        if (!last) {
            PHASE((ph_norm<2, false>(q, l, MALL, (unsigned*)lds)));
            PHASE(run_gemm(ldq, (const bf16_t*)(q.ws + WS_ACT1), (const bf16_t*)(q.ws + WS_WFGU), D, MALL / 256, 2 * DFF / 256, nullptr, 0, EpiSwiglu{(bf16_t*)(q.ws + WS_HIDF), DFF, 0}));
            PHASE(run_gemm(ldq, (const bf16_t*)(q.ws + WS_HIDF), (const bf16_t*)(q.ws + WS_WFDN), DFF, MALL / 256, D / 256, nullptr, 0,
                           EpiResid{q.out, (const float*)(q.ws + WS_HCTX), q.out, (float*)(q.ws + WS_HCTX), QMOD(l), 5 * D, 0}));
        } else {
            PHASE((ph_norm<2, true>(q, l, TL, (unsigned*)lds)));
            PHASE(ph_moe_gather(q));
            PHASE({ int base[9]; moe_bases((const unsigned*)(q.ws + WS_CTL), base); run_gemm(ldq, (const bf16_t*)(q.ws + WS_ASORT), (const bf16_t*)(q.ws + WS_WMGU), D, base[8] / 256, 2 * DFFE / 256, (const int*)(q.ws + WS_TEXP), (size_t)2 * DFFE * D * 2, EpiSwiglu{(bf16_t*)(q.ws + WS_HIDM), DFFE, 0}); });
            PHASE({ int base[9]; moe_bases((const unsigned*)(q.ws + WS_CTL), base); run_gemm(ldq, (const bf16_t*)(q.ws + WS_HIDM), (const bf16_t*)(q.ws + WS_WMDN), DFFE, base[8] / 256, D / 256, (const int*)(q.ws + WS_TEXP), (size_t)D * DFFE * 2, EpiBf16Perm{(bf16_t*)(q.ws + WS_ASORT), D, 0}); });
            PHASE(ph_moe_combine(q, l));
        }
    }
#undef QMOD
#undef PHASE
}

#ifndef MK_CUTS
#define MK_CUTS 0
#endif
extern "C" void kernel_launch(void* const* d_in, const int* in_sizes, int n_in, void* d_out, int out_size, void* d_ws, size_t ws_size, hipStream_t stream) {
    static int grid = 0;
    if (grid == 0) {
        if (n_in != 32 || ws_size < WS_END) { fprintf(stderr, "kernel_launch: need 32 inputs and %zu bytes of workspace (got %d, %zu)\n", (size_t)WS_END, n_in, ws_size); grid = -1; return; }
        int dev = 0, cus = 0, per_cu = 0;
        if (hipGetDevice(&dev) != hipSuccess || hipDeviceGetAttribute(&cus, hipDeviceAttributeMultiprocessorCount, dev) != hipSuccess) { grid = -1; return; }
        if (hipFuncSetAttribute((const void*)mega_fwd, hipFuncAttributeMaxDynamicSharedMemorySize, LDS_BYTES) != hipSuccess) { fprintf(stderr, "kernel_launch: hipFuncSetAttribute failed\n"); grid = -1; return; }
        if (hipOccupancyMaxActiveBlocksPerMultiprocessor(&per_cu, (const void*)mega_fwd, NWAVES * 64, LDS_BYTES) != hipSuccess || per_cu < 1) fprintf(stderr, "kernel_launch: occupancy query says %d blocks per CU\n", per_cu);
        (void)hipGetLastError();
        grid = cus;
    }
    if (grid < 0) return;
    (void)hipMemsetAsync((char*)d_ws + WS_CTL, 0, CTL_ZERO_BYTES, stream);
    Args a{}; for (int i = 0; i < 32; ++i) a.p.in[i] = (const float*)d_in[i]; a.p.out = (float*)d_out; a.p.ws = (unsigned char*)d_ws;
#if MK_CUTS
    for (int ph = 0; ph < 24; ++ph) { a.ph_lo = ph; a.ph_hi = ph + 1; hipLaunchKernelGGL(mega_fwd, dim3(grid), dim3(NWAVES * 64), LDS_BYTES, stream, a); }
#else
    a.ph_lo = 0; a.ph_hi = 21;
    hipLaunchKernelGGL(mega_fwd, dim3(grid), dim3(NWAVES * 64), LDS_BYTES, stream, a);
#endif
}
```

```cpp
#include <hip/hip_runtime.h>
#include <stdint.h>
#include <cstdio>

typedef unsigned short bf16_t;
typedef float f32x4 __attribute__((ext_vector_type(4)));
typedef unsigned u32x4 __attribute__((ext_vector_type(4)));
typedef unsigned u32x2 __attribute__((ext_vector_type(2)));

constexpr int D = 1024, NB = 2, SEQ = 8192, CTX = 256, TL = NB * SEQ, TC = NB * CTX, MALL = TL + TC;
constexpr int NIN = 2144, NINP = 2304, DFF = 2816, NE = 8, DFFE = 3584, KEYS = CTX + SEQ;
constexpr int OFF_AQ = 0, OFF_AK = 256, OFF_AV = 384, OFF_BQ = 512, OFF_BK = 768, OFF_BV = 896, OFF_CQ = 1024, OFF_CK = 1280,
              OFF_CV = 1536, OFF_DCQ = 1792, OFF_DCKV = 1984, OFF_DKR = 2112;
constexpr int MOE_ROWS = 34816;
constexpr float EPS = 1e-6f;

constexpr size_t MiB = 1u << 20;
constexpr size_t WS_CTL = 0;
constexpr size_t WS_MOD = 1 * MiB;
constexpr size_t WS_ROPE = WS_MOD + 256 * 1024;
constexpr size_t WS_TOKE = WS_ROPE + 64 * 1024;
constexpr size_t WS_TOKP = WS_TOKE + TL * 8;
constexpr size_t WS_TOKG = WS_TOKP + TL * 8;
constexpr size_t WS_TEXP = WS_TOKG + TL * 8;
constexpr size_t WS_TOKS = WS_TEXP + 1024;
constexpr size_t WS_HCTX = 2 * MiB;
constexpr size_t WS_WMGU = 6 * MiB;
constexpr size_t WS_WMDN = WS_WMGU + 112 * MiB;
constexpr size_t WS_WDEAD = WS_WMDN + 56 * MiB;
constexpr size_t WS_WIN = WS_WDEAD;
constexpr size_t WS_WOUT = WS_WIN + 9 * MiB;
constexpr size_t WS_WUQ = WS_WOUT + 4 * MiB;
constexpr size_t WS_WUKV = WS_WUQ + 512 * 1024;
constexpr size_t WS_WFGU = WS_WUKV + 512 * 1024;
constexpr size_t WS_WFDN = WS_WFGU + 11 * MiB;
constexpr size_t WS_ACT = 205 * MiB;
static_assert(WS_WFDN + (size_t)1024 * 2816 * 2 <= WS_ACT, "weights fit");
constexpr size_t WS_ACT1 = WS_ACT;
constexpr size_t WS_P = WS_ACT + 33 * MiB;
constexpr size_t WS_QKV = WS_ACT + 108 * MiB;
constexpr size_t WS_HIDF = WS_P;
constexpr size_t WS_HIDM = WS_WDEAD;
constexpr size_t WS_ASORT = WS_HIDM + 238 * MiB;
constexpr size_t WS_END = WS_ASORT + 68 * MiB;
static_assert(WS_QKV + 91 * MiB <= WS_END, "qkv fits");

struct Params { const float* in[32]; float* out; unsigned char* ws; };

struct QKVB { bf16_t *QA, *KA, *VA, *QB, *KB, *VB, *QC, *KC, *VC, *QD, *KD, *VD, *QAc, *QBc, *QCc, *QDc; };
__host__ __device__ inline QKVB make_qkv(unsigned char* ws) {
    QKVB q; bf16_t* p = (bf16_t*)(ws + WS_QKV);
    q.QA = p; p += (size_t)NB * 4 * SEQ * 64; q.KA = p; p += (size_t)NB * 2 * KEYS * 64; q.VA = p; p += (size_t)NB * 2 * KEYS * 64;
    q.QB = p; p += (size_t)NB * 4 * SEQ * 64; q.KB = p; p += (size_t)NB * 2 * KEYS * 64; q.VB = p; p += (size_t)NB * 2 * KEYS * 64;
    q.QC = p; p += (size_t)NB * 4 * SEQ * 64; q.KC = p; p += (size_t)NB * 4 * KEYS * 64; q.VC = p; p += (size_t)NB * 4 * KEYS * 64;
    q.QD = p; p += (size_t)NB * 4 * SEQ * 96; q.KD = p; p += (size_t)NB * 4 * KEYS * 96; q.VD = p; p += (size_t)NB * 4 * KEYS * 64;
    q.QAc = p; p += (size_t)NB * 4 * CTX * 64; q.QBc = p; p += (size_t)NB * 4 * CTX * 64; q.QCc = p; p += (size_t)NB * 4 * CTX * 64;
    q.QDc = p; p += (size_t)NB * 4 * CTX * 96;
    return q;
}

__device__ __forceinline__ float bf2f(unsigned v) { return __uint_as_float(v << 16); }
__device__ __forceinline__ float bflo(unsigned w) { return __uint_as_float(w << 16); }
__device__ __forceinline__ float bfhi(unsigned w) { return __uint_as_float(w & 0xffff0000u); }
__device__ __forceinline__ unsigned f2bf(float f) { unsigned u = __float_as_uint(f); return (u + 0x7fffu + ((u >> 16) & 1u)) >> 16; }
__device__ __forceinline__ unsigned pk2(float lo, float hi) { return f2bf(lo) | (f2bf(hi) << 16); }
template <int X> __device__ __forceinline__ float swz_xor(float v) { return __int_as_float(__builtin_amdgcn_ds_swizzle(__float_as_int(v), 0x1f | (X << 10))); }
__device__ __forceinline__ float half_sum(float v) { auto rr = __builtin_amdgcn_permlane32_swap(__float_as_uint(v), __float_as_uint(v), false, false); return __uint_as_float(rr[0]) + __uint_as_float(rr[1]); }
__device__ __forceinline__ float half_other(float v, int lane) { auto rr = __builtin_amdgcn_permlane32_swap(__float_as_uint(v), __float_as_uint(v), false, false); return __uint_as_float((lane & 32) ? rr[0] : rr[1]); }
__device__ __forceinline__ float wave_sum(float v) { v += swz_xor<1>(v); v += swz_xor<2>(v); v += swz_xor<4>(v); v += swz_xor<8>(v); v += swz_xor<16>(v); return half_sum(v); }
__device__ __forceinline__ int opq(int v) { asm volatile("" : "+v"(v)); return v; }
template <class T> __device__ __forceinline__ T* opqp(T* p) { asm volatile("" : "+s"(p)); return p; }
__device__ __forceinline__ int opqs(int v) { asm volatile("" : "+s"(v)); return v; }
__device__ __forceinline__ float silu_f(float x) { return x / (1.f + expf(-x)); }

constexpr int RT_R64 = 0, RT_C64 = 2048, RT_R32 = 3072, RT_C32 = 4096, RT_N = 4608;

namespace pg8 {
#define PG8_LAS __attribute__((address_space(3)))
typedef unsigned short bf16_t;
typedef short bf16x8 __attribute__((ext_vector_type(8)));
typedef float f32x4 __attribute__((ext_vector_type(4)));
typedef unsigned u32x4 __attribute__((ext_vector_type(4)));
constexpr int BM = 256, BK = 64, HALF = 128, HTB = HALF * BK * 2  , STAGE_BYTES = 8 * HTB, NXCD = 8, WGM = 8;

__host__ __device__ __forceinline__ int lds_byte(int r, int c) { const int st = (r >> 4) * 2 + (c >> 5), rr = r & 15, cc = c & 31, ob = rr * 64 + cc * 2; return st * 1024 + (ob ^ (((ob >> 9) & 1) << 5)); }
__host__ __device__ __forceinline__ void stage_rc(int b, int& R, int& C) { const int st = b / 1024, sb = b % 1024, swz = sb ^ (((sb >> 9) & 1) << 5); R = (st >> 1) * 16 + swz / 64; C = (st & 1) * 32 + (swz % 64) / 2; }
__host__ __device__ __forceinline__ int perm32(int rho) { const int n = rho >> 4, i = rho & 15; return 8 * (i >> 2) + 4 * n + (i & 3); }

struct Unit { int pm, pn, e; };
struct Gemm { const bf16_t* A; const bf16_t* Bt; int K; size_t estride; };

struct StaticOrder {
    int nM, nN, nwg, G, c; const int* texp;
    __host__ __device__ void init(int nM_, int nN_, int G_, int c_, const int* texp_) { nM = nM_; nN = nN_; nwg = nM * nN; G = G_; c = c_; texp = texp_; }
    __host__ __device__ bool next(int i, Unit& u) const {
        const long L = (long)i * G + c; if (L >= nwg) return false;
        int wgid = (int)L; { const int q = nwg / NXCD, r = nwg % NXCD, xcd = wgid % NXCD, off = wgid / NXCD; wgid = (xcd < r ? xcd * (q + 1) : r * (q + 1) + (xcd - r) * q) + off; }
        const int nig = WGM * nN, gid = wgid / nig, fm = gid * WGM, gsz = (nM - fm) < WGM ? (nM - fm) : WGM;
        u.pm = fm + ((wgid % nig) % gsz); u.pn = (wgid % nig) / gsz; u.e = texp ? texp[u.pm] : 0; return true;
    }
    __device__ __forceinline__ void a_ready(const Unit&) const {}
    __device__ __forceinline__ void done(const Unit&) const {}
};

template <class Epi, class Sched, bool ALIGN_EPI = false, bool SP2 = false>
__device__ __forceinline__ void gemm_phase(PG8_LAS unsigned char* lds, const Gemm g, const Sched& S, const Epi& E) {
    const int tid = opq((int)threadIdx.x), wid = __builtin_amdgcn_readfirstlane(tid >> 6), lane = tid & 63, wr = wid >> 2, wc = wid & 3, fr = lane & 15, fq = lane >> 4;
    const int K = g.K, nt = K / BK;
    unsigned voffA[2], voffB[2];
#pragma unroll
    for (int i = 0; i < 2; ++i) { int R, C; stage_rc(tid * 16 + i * 8192, R, C); const int Rb = Epi::PERM ? ((R & ~31) + perm32(R & 31)) : R;
        voffA[i] = (unsigned)(R * K + C) * 2u; voffB[i] = (unsigned)(Rb * K + C) * 2u; }
    const size_t kstep = (size_t)(BK * 2);
    const size_t hstep = (size_t)HALF * K * 2;
    const size_t tstep = 2 * hstep;
    const unsigned ldsw = (unsigned)wid * 1024u;
    const int aoff = lds_byte(wr * 64 + fr, fq * 8), boff = lds_byte(wc * 32 + fr, fq * 8);
#define PG8_SA(b, h) (((b) * 2 + (h)) * HTB)
#define PG8_SB(b, h) ((4 + (b) * 2 + (h)) * HTB)
#define PG8_STAGE(bufoff, gbase, voff) do { _Pragma("unroll") for (int _i = 0; _i < 2; ++_i) \
        __builtin_amdgcn_global_load_lds((const unsigned*)((const char*)(gbase) + (voff)[_i]), (PG8_LAS unsigned*)(lds + (bufoff) + ldsw + _i * 8192), 16, 0, 0); } while (0)
#define PG8_LDA(dst, b, h) do { _Pragma("unroll") for (int m = 0; m < 4; ++m) _Pragma("unroll") for (int k = 0; k < 2; ++k) dst[m][k] = *(const PG8_LAS bf16x8*)(lds + PG8_SA(b, h) + aoff + m * 2048 + k * 1024); } while (0)
#define PG8_LDB(dst, b, h) do { _Pragma("unroll") for (int n = 0; n < 2; ++n) _Pragma("unroll") for (int k = 0; k < 2; ++k) dst[n][k] = *(const PG8_LAS bf16x8*)(lds + PG8_SB(b, h) + boff + n * 2048 + k * 1024); } while (0)
#define PG8_MMA(ai, bj, At, Bt) do { __builtin_amdgcn_s_setprio(1); _Pragma("unroll") for (int m = 0; m < 4; ++m) _Pragma("unroll") for (int n = 0; n < 2; ++n) _Pragma("unroll") for (int k = 0; k < 2; ++k) \
        acc[ai][bj][m][n] = __builtin_amdgcn_mfma_f32_16x16x32_bf16(Bt[n][k], At[m][k], acc[ai][bj][m][n], 0, 0, 0); __builtin_amdgcn_s_setprio(0); } while (0)
#define PG8_WAIT_V(n) asm volatile("s_waitcnt vmcnt(" #n ")" ::: "memory")
#define PG8_WAIT_L(n) asm volatile("s_waitcnt lgkmcnt(" #n ")" ::: "memory")
#define PG8_BAR __builtin_amdgcn_s_barrier()
#define PG8_SCHED __builtin_amdgcn_sched_barrier(0)
    Unit cur, nxt; int ui = 0;
    if (!S.next(0, cur)) return;
    f32x4 acc[2][2][4][2];
#pragma unroll
    for (int a = 0; a < 2; ++a)
#pragma unroll
        for (int b = 0; b < 2; ++b)
#pragma unroll
            for (int m = 0; m < 4; ++m)
#pragma unroll
                for (int n = 0; n < 2; ++n) acc[a][b][m][n] = (f32x4){0.f, 0.f, 0.f, 0.f};
    bf16x8 At[4][2], B0[2][2], B1[2][2];
    const char* cA = (const char*)g.A + (size_t)cur.pm * tstep; const char* cB = (const char*)g.Bt + (size_t)cur.e * g.estride + (size_t)cur.pn * tstep;
    S.a_ready(cur);
    if constexpr (SP2) {
        PG8_STAGE(PG8_SB(0, 0), cB, voffB); PG8_STAGE(PG8_SB(0, 1), cB + hstep, voffB); PG8_STAGE(PG8_SA(0, 0), cA, voffA); PG8_STAGE(PG8_SA(0, 1), cA + hstep, voffA);
        if (wr == 1) PG8_BAR;
        PG8_WAIT_V(2); PG8_BAR;
        PG8_STAGE(PG8_SB(1, 0), cB + kstep, voffB); PG8_STAGE(PG8_SA(1, 0), cA + kstep, voffA); PG8_STAGE(PG8_SB(1, 1), cB + hstep + kstep, voffB);
        PG8_WAIT_V(6); PG8_BAR;
    } else {
        PG8_STAGE(PG8_SB(0, 0), cB, voffB); PG8_STAGE(PG8_SA(0, 0), cA, voffA); PG8_STAGE(PG8_SB(0, 1), cB + hstep, voffB); PG8_STAGE(PG8_SA(0, 1), cA + hstep, voffA);
        if (wr == 1) PG8_BAR;
        PG8_WAIT_V(4); PG8_BAR;
        PG8_STAGE(PG8_SB(1, 0), cB + kstep, voffB); PG8_STAGE(PG8_SA(1, 0), cA + kstep, voffA); PG8_STAGE(PG8_SB(1, 1), cB + hstep + kstep, voffB);
        PG8_WAIT_V(6); PG8_BAR;
    }
    for (;;) {
        const bool has_next = S.next(ui + 1, nxt);
        const char* nA = has_next ? (const char*)g.A + (size_t)nxt.pm * tstep : cA; const char* nB = has_next ? (const char*)g.Bt + (size_t)nxt.e * g.estride + (size_t)nxt.pn * tstep : cB;
        for (int t = 0; t < nt; t += 2) {
            const bool last = (t == nt - 2);
            const char* a1 = cA + (size_t)(t + 1) * kstep;
            const char* a2 = last ? nA : cA + (size_t)(t + 2) * kstep; const char* b2 = last ? nB : cB + (size_t)(t + 2) * kstep;
            const char* a3 = a2 + kstep; const char* b3 = b2 + kstep;
            if (last && has_next) S.a_ready(nxt);
            if constexpr (SP2) {
            PG8_LDB(B0, 0, 0); PG8_LDB(B1, 0, 1); PG8_SCHED; PG8_LDA(At, 0, 0); PG8_STAGE(PG8_SA(1, 1), a1 + hstep, voffA);
            PG8_WAIT_V(8); PG8_WAIT_L(0); PG8_BAR; PG8_MMA(0, 0, At, B0); PG8_MMA(0, 1, At, B1); PG8_BAR; PG8_SCHED;
            PG8_LDA(At, 0, 1); PG8_STAGE(PG8_SB(0, 0), b2, voffB); PG8_STAGE(PG8_SB(0, 1), b2 + hstep, voffB); PG8_STAGE(PG8_SA(0, 0), a2, voffA);
            PG8_WAIT_V(8); PG8_WAIT_L(0); PG8_BAR; PG8_MMA(1, 0, At, B0); PG8_MMA(1, 1, At, B1); PG8_BAR; PG8_SCHED;
            PG8_LDB(B0, 1, 0); PG8_LDB(B1, 1, 1); PG8_SCHED; PG8_LDA(At, 1, 0); PG8_STAGE(PG8_SA(0, 1), a2 + hstep, voffA);
            PG8_WAIT_V(8); PG8_WAIT_L(0); PG8_BAR; PG8_MMA(0, 0, At, B0); PG8_MMA(0, 1, At, B1); PG8_BAR; PG8_SCHED;
            PG8_LDA(At, 1, 1); PG8_STAGE(PG8_SB(1, 0), b3, voffB); PG8_STAGE(PG8_SB(1, 1), b3 + hstep, voffB); PG8_STAGE(PG8_SA(1, 0), a3, voffA);
            PG8_WAIT_V(8); PG8_WAIT_L(0); PG8_BAR; PG8_MMA(1, 0, At, B0); PG8_MMA(1, 1, At, B1); PG8_BAR; PG8_SCHED;
            } else {
            PG8_LDB(B0, 0, 0); PG8_SCHED; PG8_LDA(At, 0, 0); PG8_STAGE(PG8_SA(1, 1), a1 + hstep, voffA);
            PG8_WAIT_L(8); PG8_BAR; PG8_WAIT_L(0); PG8_MMA(0, 0, At, B0); PG8_BAR; PG8_SCHED;
            PG8_LDB(B1, 0, 1); PG8_STAGE(PG8_SB(0, 0), b2, voffB);
            PG8_BAR; PG8_WAIT_L(0); PG8_MMA(0, 1, At, B1); PG8_BAR;
            PG8_LDA(At, 0, 1); PG8_STAGE(PG8_SA(0, 0), a2, voffA);
            PG8_BAR; PG8_WAIT_L(0); PG8_MMA(1, 0, At, B0); PG8_BAR; PG8_SCHED;
            PG8_STAGE(PG8_SB(0, 1), b2 + hstep, voffB);
            PG8_WAIT_V(6); PG8_BAR; PG8_MMA(1, 1, At, B1); PG8_BAR;
            PG8_LDB(B0, 1, 0); PG8_SCHED; PG8_LDA(At, 1, 0); PG8_STAGE(PG8_SA(0, 1), a2 + hstep, voffA);
            PG8_WAIT_L(8); PG8_BAR; PG8_WAIT_L(0); PG8_MMA(0, 0, At, B0); PG8_BAR; PG8_SCHED;
            PG8_LDB(B1, 1, 1); PG8_STAGE(PG8_SB(1, 0), b3, voffB);
            PG8_BAR; PG8_WAIT_L(0); PG8_MMA(0, 1, At, B1); PG8_BAR;
            PG8_LDA(At, 1, 1); PG8_STAGE(PG8_SA(1, 0), a3, voffA);
            PG8_BAR; PG8_WAIT_L(0); PG8_MMA(1, 0, At, B0); PG8_BAR; PG8_SCHED;
            PG8_STAGE(PG8_SB(1, 1), b3 + hstep, voffB);
            PG8_WAIT_V(6); PG8_BAR; PG8_MMA(1, 1, At, B1); PG8_BAR;
            }
        }
        if constexpr (ALIGN_EPI) { if (wr == 0) PG8_BAR; }
        if constexpr (!Epi::AFTER_DRAIN) { E(acc, cur, wr, wc, fr, fq); S.done(cur); }
        if (!has_next) break;
#pragma unroll
        for (int a = 0; a < 2; ++a)
#pragma unroll
            for (int b = 0; b < 2; ++b)
#pragma unroll
                for (int m = 0; m < 4; ++m)
#pragma unroll
                    for (int n = 0; n < 2; ++n) acc[a][b][m][n] = (f32x4){0.f, 0.f, 0.f, 0.f};
        cur = nxt; cA = nA; cB = nB; ++ui;
        if constexpr (ALIGN_EPI) { if (wr == 1) PG8_BAR; }
    }
    PG8_WAIT_V(0);
    if constexpr (!ALIGN_EPI) { if (wr == 0) PG8_BAR; }
    PG8_BAR;
    if constexpr (Epi::AFTER_DRAIN) { E.fused(acc, cur, wr, wc, fr, fq, lds, wid, lane); S.done(cur); }
#undef PG8_SA
#undef PG8_SB
#undef PG8_STAGE
#undef PG8_LDA
#undef PG8_LDB
#undef PG8_MMA
#undef PG8_WAIT_V
#undef PG8_WAIT_L
#undef PG8_BAR
#undef PG8_SCHED
}
}

#define GAS __attribute__((address_space(1)))
#define LAS __attribute__((address_space(3)))
typedef GAS unsigned gu32;
#define RLX_AGENT __ATOMIC_RELAXED, __HIP_MEMORY_SCOPE_AGENT
constexpr int NWAVES = 8;
constexpr int CW_BAR = 4096;
constexpr int RING_BYTES = 131072, LDSCTL_OFF = RING_BYTES, MISC_OFF = LDSCTL_OFF + 320, LDS_BYTES = 147456;
constexpr size_t CTL_ZERO_BYTES = 65536;

#define XB_TMO      128
#define XB_XCNT(j)  (256  + 64 * (j))
#define XB_XSUB(j)  (1280 + 64 * (j))
#define XB_XGEN(j)  (2304 + 64 * (j))
#define XB_TOP      3328
#define XB_TOPGEN   3392
#define XCD_BAR_WORDS 3456
#define XB_SPIN_CAP (1u << 18)

__device__ __forceinline__ unsigned xb_ld(unsigned* p)              { return __hip_atomic_load(p, __ATOMIC_RELAXED, __HIP_MEMORY_SCOPE_AGENT); }
__device__ __forceinline__ unsigned xb_add(unsigned* p, unsigned v) { return __hip_atomic_fetch_add(p, v, __ATOMIC_RELAXED, __HIP_MEMORY_SCOPE_AGENT); }
__device__ __forceinline__ unsigned xb_xcc_id() { return (unsigned)__builtin_amdgcn_s_getreg((3 << 11) | 20) & 0xFu; }
#define XB_SPIN(cond, bar) do { unsigned _sp = 0; while (cond) { __builtin_amdgcn_s_sleep(1); \
    if ((++_sp & 255u) == 0u) { if (xb_ld(&(bar)[XB_TMO])) break; if (_sp > XB_SPIN_CAP) { atomicAdd(&(bar)[XB_TMO], 1u); break; } } } } while (0)

struct XcdBarrier {
    unsigned* bar; unsigned x;
    volatile LAS unsigned* st;
};

__device__ __forceinline__ XcdBarrier xcd_barrier_post(unsigned* bar, volatile LAS unsigned* st) {
    XcdBarrier b; b.bar = bar; b.x = xb_xcc_id(); b.st = st;
    if (threadIdx.x == 0) (void)xb_add(&bar[XB_XCNT(b.x)], 1u);
    return b;
}
__device__ __forceinline__ void xcd_barrier_complete(unsigned* bar, unsigned x, unsigned& nloc, unsigned& nx) {
    const unsigned G = gridDim.x * gridDim.y * gridDim.z;
    unsigned sum, cnt, mine, sp = 0u;
    for (;;) {
        sum = 0u; cnt = 0u; mine = 0u;
#pragma unroll
        for (unsigned j = 0; j < 16; ++j) { const unsigned c = xb_ld(&bar[XB_XCNT(j)]); sum += c; cnt += (c > 0u) ? 1u : 0u; mine = (j == x) ? c : mine; }
        if (sum == G) break;
        __builtin_amdgcn_s_sleep(1);
        if ((++sp & 255u) == 0u) { if (xb_ld(&bar[XB_TMO])) break; if (sp > XB_SPIN_CAP) { atomicAdd(&bar[XB_TMO], 1u); break; } }
    }
    nloc = mine > 0u ? mine : 1u; nx = cnt > 0u ? cnt : 1u;
}

__device__ __forceinline__ void xcd_barrier(const XcdBarrier& b) {
    asm volatile("s_waitcnt vmcnt(0)" ::: "memory");
    __syncthreads();
    if (threadIdx.x == 0) {
        unsigned* bar = b.bar;
        __builtin_amdgcn_s_waitcnt(0);
        unsigned nloc = b.st[0], nx = b.st[1];
        if (nloc == 0u) { xcd_barrier_complete(bar, b.x, nloc, nx); b.st[0] = nloc; b.st[1] = nx; }
        const unsigned old = xb_add(&bar[XB_XSUB(b.x)], 1u);
        const unsigned gen = old / nloc;
        if (old + 1u == (gen + 1u) * nloc) {
            __builtin_amdgcn_fence(__ATOMIC_RELEASE, "agent");
            asm volatile("s_waitcnt vmcnt(0)" ::: "memory");
            const unsigned og = xb_add(&bar[XB_TOP], 1u);
            const unsigned tg = og / nx;
            if (og + 1u == (tg + 1u) * nx) xb_add(&bar[XB_TOPGEN], 1u);
            else XB_SPIN(xb_ld(&bar[XB_TOPGEN]) == tg, bar);
            __builtin_amdgcn_fence(__ATOMIC_ACQUIRE, "agent");
            xb_add(&bar[XB_XGEN(b.x)], 1u);
            asm volatile("s_waitcnt vmcnt(0)" ::: "memory");
        } else {
            XB_SPIN(xb_ld(&bar[XB_XGEN(b.x)]) == gen, bar);
            __builtin_amdgcn_fence(__ATOMIC_ACQUIRE, "agent");
            asm volatile("s_waitcnt vmcnt(0)" ::: "memory");
        }
    }
    __syncthreads();
}


template <class F> struct EpiAdapt {
    static constexpr bool PERM = false, AFTER_DRAIN = false; F f;
    __device__ __forceinline__ void operator()(const pg8::f32x4 (&acc)[2][2][4][2], const pg8::Unit& u, int wr, int wc, int fr, int fq) const {
#pragma unroll
        for (int ai = 0; ai < 2; ++ai)
#pragma unroll
            for (int m = 0; m < 4; ++m) { const int row = u.pm * 256 + ai * 128 + wr * 64 + m * 16 + fr;
#pragma unroll
                for (int bj = 0; bj < 2; ++bj) f(row, u.pn * 8 + bj * 4 + wc, fq, acc[ai][bj][m][0], acc[ai][bj][m][1]);
                asm volatile("" ::: "memory"); }
    }
};
struct EpiBf16Perm { bf16_t* O; int ldo; int pad;
    __device__ __forceinline__ void operator()(int row, int g, int fq, f32x4 v0, f32x4 v1) const {
        u32x4 w; w.x = pk2(v0.x, v0.y); w.y = pk2(v0.z, v0.w); w.z = pk2(v1.x, v1.y); w.w = pk2(v1.z, v1.w);
        *(u32x4*)(O + (size_t)row * ldo + 32 * g + 8 * fq) = w; } };
struct EpiResid { const float* hl_in; const float* hc_in; float* hl_out; float* hc_out; const float* mod; int goff; int pad;
    __device__ __forceinline__ void operator()(int row, int g, int fq, f32x4 v0, f32x4 v1) const {
        const int c0 = 32 * g + 4 * fq; const float* hin; float* hout; const float* gv;
        if (row < TL) { hin = hl_in + (size_t)row * D; hout = hl_out + (size_t)row * D; gv = mod + (row / SEQ) * 6144 + goff; }
        else { hin = hc_in + (size_t)(row - TL) * D; hout = hc_out + (size_t)(row - TL) * D; gv = mod + 2 * 6144 + goff; }
        *(f32x4*)(hout + c0) = *(const f32x4*)(hin + c0) + *(const f32x4*)(gv + c0) * v0;
        *(f32x4*)(hout + c0 + 16) = *(const f32x4*)(hin + c0 + 16) + *(const f32x4*)(gv + c0 + 16) * v1; } };
struct EpiSwiglu { bf16_t* H; int ldh; int pad;
    __device__ __forceinline__ void operator()(int row, int g, int fq, f32x4 v0, f32x4 v1) const {
        u32x2 w; w.x = pk2(silu_f(v0.x) * v1.x, silu_f(v0.y) * v1.y); w.y = pk2(silu_f(v0.z) * v1.z, silu_f(v0.w) * v1.w);
        *(u32x2*)(H + (size_t)row * ldh + 16 * g + 4 * fq) = w; } };

template <class F> __device__ __forceinline__ void run_gemm(LAS unsigned char* lds, const bf16_t* A, const bf16_t* Bt, int K, int nM, int nN, const int* texp, size_t estride_bytes, const F& f) {
    pg8::Gemm g{A, Bt, K, estride_bytes}; pg8::StaticOrder S; S.init(nM, nN, opqs((int)gridDim.x), opqs((int)blockIdx.x), texp);
    EpiAdapt<F> E{f};
    pg8::gemm_phase<EpiAdapt<F>, pg8::StaticOrder, true, true>(lds, g, S, E);
}
__device__ __forceinline__ bool gemm_tail_idle(int nwg) { const int G = opqs((int)gridDim.x), r = nwg % G; return r != 0 && opqs((int)blockIdx.x) >= r; }

__device__ __forceinline__ float conv_src(const Params& p, int mode, const float* W0, const float* W1, int N, int nvalid, int k, int nb) {
    if (mode == 0) return W0[(size_t)k * N + nb];
    if (mode == 1) { const int col = (nb & ~31) + 8 * ((nb >> 2) & 3) + 4 * ((nb >> 4) & 1) + (nb & 3); return col < nvalid ? W0[(size_t)k * N + col] : 0.f; }
    const int col = 16 * (nb >> 5) + (nb & 15); return ((nb >> 4) & 1) ? W1[(size_t)k * N + col] : W0[(size_t)k * N + col];
}
constexpr int CT_WIN = 0, CT_WOUT = 2304, CT_WUQ = 3328, CT_WUKV = 3400, CT_WFGU = 3464, CT_WFDN = 6280, CT_WMGU = 7688, CT_WMDN = 36360, CT_END = 50696;
constexpr int IT_MODS = 192, IT_ROPE = 9;
__device__ __forceinline__ void conv_item(const Params& p, int it, float* scr, int lane) {
    int t = it;
    bf16_t* dst; const float* W0; const float* W1 = nullptr; int K, N, nvalid = 0, mode;
    if (t < CT_WOUT) { const int l = t / 1152; t %= 1152; dst = (bf16_t*)(p.ws + WS_WIN) + (size_t)l * NINP * D; W0 = p.in[8] + (size_t)l * D * NIN; K = D; N = NIN; nvalid = NIN; mode = 1; }
    else if (t < CT_WUQ) { t -= CT_WOUT; const int l = t / 512; t %= 512; dst = (bf16_t*)(p.ws + WS_WOUT) + (size_t)l * D * D; W0 = p.in[24] + (size_t)l * D * D; K = D; N = D; mode = 0; }
    else if (t < CT_WUKV) { t -= CT_WUQ; const int l = t / 36; t %= 36; dst = (bf16_t*)(p.ws + WS_WUQ) + (size_t)l * 384 * 192; W0 = p.in[18] + (size_t)l * 192 * 384; K = 192; N = 384; mode = 0; }
    else if (t < CT_WFGU) { t -= CT_WUKV; const int l = t / 32; t %= 32; dst = (bf16_t*)(p.ws + WS_WUKV) + (size_t)l * 512 * 128; W0 = p.in[20] + (size_t)l * 128 * 512; K = 128; N = 512; mode = 0; }
    else if (t < CT_WFDN) { t -= CT_WFGU; dst = (bf16_t*)(p.ws + WS_WFGU); W0 = p.in[25]; W1 = p.in[26]; K = D; N = DFF; mode = 2; }
    else if (t < CT_WMGU) { t -= CT_WFDN; dst = (bf16_t*)(p.ws + WS_WFDN); W0 = p.in[27]; K = DFF; N = D; mode = 0; }
    else if (t < CT_WMDN) { t -= CT_WMGU; const int e = t / 3584; t %= 3584; dst = (bf16_t*)(p.ws + WS_WMGU) + (size_t)e * 2 * DFFE * D; W0 = p.in[29] + (size_t)e * D * DFFE; W1 = p.in[30] + (size_t)e * D * DFFE; K = D; N = DFFE; mode = 2; }
    else { t -= CT_WMDN; const int e = t / 1792; t %= 1792; dst = (bf16_t*)(p.ws + WS_WMDN) + (size_t)e * D * DFFE; W0 = p.in[31] + (size_t)e * DFFE * D; K = DFFE; N = D; nvalid = D; mode = 1; }
    const int ktl = K / 64, n0 = (t / ktl) * 32, k0 = (t % ktl) * 64;
    const int n4 = lane & 7; const float* src; bool valid = true; int ln;
    if (mode == 0) { src = W0 + n0 + 4 * n4; ln = 4 * n4; }
    else if (mode == 1) { const int col = n0 + 4 * n4; valid = col < nvalid; src = W0 + (valid ? col : 0); ln = 16 * (n4 & 1) + 4 * (n4 >> 1); }
    else { src = ((n4 >> 2) ? W1 : W0) + 16 * (n0 >> 5) + 4 * (n4 & 3); ln = 16 * (n4 >> 2) + 4 * (n4 & 3); }
    src += (size_t)(k0 + (lane >> 3)) * N;
    f32x4 v[8];
#pragma unroll
    for (int i = 0; i < 8; ++i) v[i] = valid ? *(const f32x4*)(src + (size_t)(8 * i) * N) : (f32x4){0.f, 0.f, 0.f, 0.f};
#pragma unroll
    for (int i = 0; i < 8; ++i) *(f32x4*)(scr + ((lane >> 3) + 8 * i) * 36 + ln) = v[i];
    const int c = lane & 7;
#pragma unroll
    for (int j = 0; j < 4; ++j) { const int n = (lane >> 3) + 8 * j; const float* sp = scr + (8 * c) * 36 + n;
        u32x4 o; o.x = pk2(sp[0 * 36], sp[1 * 36]); o.y = pk2(sp[2 * 36], sp[3 * 36]); o.z = pk2(sp[4 * 36], sp[5 * 36]); o.w = pk2(sp[6 * 36], sp[7 * 36]);
        *(u32x4*)(dst + (size_t)(n0 + n) * K + k0 + 8 * c) = o; }
}
constexpr int CW_FILL = 1024;
__device__ __forceinline__ void fill_moe(const Params& p, float* lds, int quota) {
    const int tid = opq((int)threadIdx.x), lane = tid & 63, wv = tid >> 6;
    float* scr = lds + wv * (64 * 36); volatile int* slot = (volatile int*)(lds + 8 * 64 * 36);
    constexpr int NIT = CT_END - CT_WMGU;
    for (;;) {
        const int claim = quota > 64 ? 4 : quota;
        __syncthreads();
        if (tid == 0) *slot = (int)atomicAdd((unsigned*)(p.ws + WS_CTL) + CW_FILL, 8u * (unsigned)claim);
        __syncthreads();
        const int idx = *slot;
        if (idx >= NIT) break;
        const int end = min(idx + 8 * claim, NIT);
        for (int it = idx + wv; it < end; it += 8) conv_item(p, CT_WMGU + it, scr, lane);
        if (quota <= 64) break;
    }
    __syncthreads();
}
__device__ __forceinline__ void ph_prologue(const Params& p, float* lds) {
    const int tid = opq((int)threadIdx.x), lane = tid & 63, wv = tid >> 6;
    for (int it = blockIdx.x; it < IT_MODS + IT_ROPE; it += gridDim.x) {
        if (it < IT_MODS) {
            const int l = it / 96, n0 = (it % 96) * 64, nn = tid & 63, kc = tid >> 6;
            float* sv = lds; float* red = lds + 3 * 1024;
            __syncthreads();
            for (int i = tid; i < 3 * 1024; i += 512) { const int v = i >> 10, k = i & 1023; const float x = (v < 2) ? p.in[1][v * D + k] : p.in[3][k]; sv[i] = silu_f(x); }
            __syncthreads();
            const float* w = p.in[4] + ((size_t)l * D + kc * 128) * 6144 + n0 + nn;
            float a0 = 0.f, a1 = 0.f, a2 = 0.f;
#pragma unroll 8
            for (int k = 0; k < 128; ++k) { const float wv_ = w[(size_t)k * 6144]; a0 += sv[kc * 128 + k] * wv_; a1 += sv[1024 + kc * 128 + k] * wv_; a2 += sv[2048 + kc * 128 + k] * wv_; }
            red[(kc * 3 + 0) * 64 + nn] = a0; red[(kc * 3 + 1) * 64 + nn] = a1; red[(kc * 3 + 2) * 64 + nn] = a2;
            __syncthreads();
            if (tid < 192) { const int v = tid >> 6; float s = p.in[5][l * 6144 + n0 + nn];
#pragma unroll
                for (int q = 0; q < 8; ++q) s += red[(q * 3 + v) * 64 + nn];
                ((float*)(p.ws + WS_MOD))[((size_t)l * 3 + v) * 6144 + n0 + nn] = s; }
        } else {
            const int idx = (it - IT_MODS) * 512 + tid;
            if (idx < RT_N) {
                int pos, i, nf;
                if (idx < RT_C64) { pos = idx / 16; i = idx % 16; nf = 16; }
                else if (idx < RT_R32) { pos = (idx - RT_C64) / 16; i = idx % 16; nf = 16; }
                else if (idx < RT_C32) { pos = (idx - RT_R32) / 8; i = idx % 8; nf = 8; }
                else { pos = (idx - RT_C32) / 8; i = idx % 8; nf = 8; }
                const float inv = powf(10000.0f, -(float)i / (float)nf);
                const float ang = (float)pos * inv;
                const float rev = ang * 0.15915494309189535f;
                ((float2*)(p.ws + WS_ROPE))[idx] = make_float2(__builtin_amdgcn_cosf(rev), __builtin_amdgcn_sinf(rev));
            }
        }
    }
    __syncthreads();
    float* scr = lds + wv * (64 * 36);
    for (int it = wv * gridDim.x + blockIdx.x; it < CT_WMGU; it += 8 * gridDim.x) conv_item(p, it, scr, lane);
    __syncthreads();
}

template <int WHICH, bool ROUTER> __device__ __forceinline__ void ph_norm(const Params& p, int layer, int nrows, unsigned* lcnt) {
    const int tx = opq((int)threadIdx.x), lane = tx & 63, gw = (blockIdx.x * 512 + tx) >> 6, ngw = (gridDim.x * 512) >> 6;
    if (ROUTER) { if (tx < 16) lcnt[tx] = 0u; __syncthreads(); }
    const float* hl = (layer == 0 && WHICH == 1) ? p.in[0] : p.out;
    const float* hc = (layer == 0 && WHICH == 1) ? p.in[2] : (const float*)(p.ws + WS_HCTX);
    const float* gain = p.in[WHICH == 1 ? 6 : 7] + layer * D;
    const float* mod = (const float*)(p.ws + WS_MOD) + (size_t)layer * 3 * 6144;
    bf16_t* dst = (bf16_t*)(p.ws + WS_ACT1);
    for (int m = gw; m < nrows; m += ngw) {
        const float* src = (m < TL) ? hl + (size_t)m * D : hc + (size_t)(m - TL) * D;
        const float* mv = mod + (m < TL ? m / SEQ : 2) * 6144;
        const float* shp = mv + (WHICH == 1 ? 0 : 3) * D; const float* scp = mv + (WHICH == 1 ? 1 : 4) * D;
        f32x4 v[4]; float ss = 0.f;
#pragma unroll
        for (int j = 0; j < 4; ++j) { v[j] = *(const f32x4*)(src + 256 * j + 4 * lane); ss += v[j].x * v[j].x + v[j].y * v[j].y + v[j].z * v[j].z + v[j].w * v[j].w; }
        const float rstd = rsqrtf(wave_sum(ss) * (1.f / D) + EPS);
        float lg[8];
#pragma unroll
        for (int e = 0; e < 8; ++e) lg[e] = 0.f;
#pragma unroll
        for (int j = 0; j < 4; ++j) {
            const int c = 256 * j + 4 * lane;
            const f32x4 g = *(const f32x4*)(gain + c), sh = *(const f32x4*)(shp + c), sc = *(const f32x4*)(scp + c);
            f32x4 f = v[j] * rstd * g * (sc + 1.f) + sh;
            u32x2 w; w.x = pk2(f.x, f.y); w.y = pk2(f.z, f.w);
            *(u32x2*)(dst + (size_t)m * D + c) = w;
            if (ROUTER) {
                const float* rt = p.in[28] + (size_t)c * 8;
#pragma unroll
                for (int i = 0; i < 4; ++i) { const f32x4 r0 = *(const f32x4*)(rt + 8 * i), r1 = *(const f32x4*)(rt + 8 * i + 4); const float fv = f[i];
                    lg[0] += fv * r0.x; lg[1] += fv * r0.y; lg[2] += fv * r0.z; lg[3] += fv * r0.w; lg[4] += fv * r1.x; lg[5] += fv * r1.y; lg[6] += fv * r1.z; lg[7] += fv * r1.w; }
            }
        }
        if (ROUTER) {
#pragma unroll
            for (int e = 0; e < 8; ++e) lg[e] = wave_sum(lg[e]);
            if (lane == 0) {
                int e0 = 0; float v0 = lg[0];
#pragma unroll
                for (int e = 1; e < 8; ++e) if (lg[e] > v0) { v0 = lg[e]; e0 = e; }
                int e1 = -1; float v1 = -INFINITY;
#pragma unroll
                for (int e = 0; e < 8; ++e) if (e != e0 && lg[e] > v1) { v1 = lg[e]; e1 = e; }
                const float t = expf(v1 - v0), g0 = 1.f / (1.f + t), g1 = t / (1.f + t);
                const int p0 = (int)atomicAdd(&lcnt[e0], 1u), p1 = (int)atomicAdd(&lcnt[e1], 1u);
                ((int2*)(p.ws + WS_TOKE))[m] = make_int2(e0, e1); ((int2*)(p.ws + WS_TOKP))[m] = make_int2(p0, p1); ((float2*)(p.ws + WS_TOKG))[m] = make_float2(g0, g1);
            }
        }
    }
    if (ROUTER) {
        __syncthreads();
        if (tx < 8) lcnt[8 + tx] = atomicAdd((unsigned*)(p.ws + WS_CTL) + 64 * tx, lcnt[tx]);
        __syncthreads();
        if (lane == 0) for (int m = gw; m < nrows; m += ngw) {
            const int2 e = ((const int2*)(p.ws + WS_TOKE))[m]; int2 ps = ((const int2*)(p.ws + WS_TOKP))[m];
            ps.x += (int)lcnt[8 + e.x]; ps.y += (int)lcnt[8 + e.y]; ((int2*)(p.ws + WS_TOKP))[m] = ps; }
        __syncthreads();
    }
}


typedef short pp_bf16x8 __attribute__((ext_vector_type(8)));
__device__ __forceinline__ float quad_sum(float v) { v += swz_xor<1>(v); v += swz_xor<2>(v); return v; }
__device__ __forceinline__ float kg_sum(float v) { v += swz_xor<16>(v); return half_sum(v); }
constexpr float QS64 = 0.125f * 1.4426950408889634f, QS96 = 0.10206207261596575f * 1.4426950408889634f;

template <int HS> __device__ __forceinline__ void pp_head(const Params& p, const QKVB& qb, int layer, const bf16_t* prow, bool lat, int b, int s, int key, int sub,
                                                          const float2 (&rr)[4], const float2 (&rc)[4]) {
    constexpr bool ISV = HS >= 20;
    constexpr int col = HS < 4 ? OFF_AQ + 64 * HS : HS < 6 ? OFF_AK + 64 * (HS - 4) : HS < 10 ? OFF_BQ + 64 * (HS - 6) : HS < 12 ? OFF_BK + 64 * (HS - 10) : HS < 16 ? OFF_CQ + 64 * (HS - 12) :
                        HS < 20 ? OFF_CK + 64 * (HS - 16) : HS < 22 ? OFF_AV + 64 * (HS - 20) : HS < 24 ? OFF_BV + 64 * (HS - 22) : OFF_CV + 64 * (HS - 24);
    constexpr bool ISQ = HS < 4 || (HS >= 6 && HS < 10) || (HS >= 12 && HS < 16);
    constexpr bool ROPE = HS < 12;
    constexpr int GIN = HS < 4 ? 9 : HS < 6 ? 10 : HS < 10 ? 12 : HS < 12 ? 13 : HS < 16 ? 14 : 15;
    bf16_t* dst;
    if (HS < 4) dst = lat ? qb.QA + ((size_t)(b * 4 + HS) * SEQ + s) * 64 : qb.QAc + ((size_t)(b * 4 + HS) * CTX + s) * 64;
    else if (HS < 6) dst = qb.KA + ((size_t)(b * 2 + HS - 4) * KEYS + key) * 64;
    else if (HS < 10) dst = lat ? qb.QB + ((size_t)(b * 4 + HS - 6) * SEQ + s) * 64 : qb.QBc + ((size_t)(b * 4 + HS - 6) * CTX + s) * 64;
    else if (HS < 12) dst = qb.KB + ((size_t)(b * 2 + HS - 10) * KEYS + key) * 64;
    else if (HS < 16) dst = lat ? qb.QC + ((size_t)(b * 4 + HS - 12) * SEQ + s) * 64 : qb.QCc + ((size_t)(b * 4 + HS - 12) * CTX + s) * 64;
    else if (HS < 20) dst = qb.KC + ((size_t)(b * 4 + HS - 16) * KEYS + key) * 64;
    else if (HS < 22) dst = qb.VA + ((size_t)(b * 2 + HS - 20) * KEYS + key) * 64;
    else if (HS < 24) dst = qb.VB + ((size_t)(b * 2 + HS - 22) * KEYS + key) * 64;
    else dst = qb.VC + ((size_t)(b * 4 + HS - 24) * KEYS + key) * 64;
    u32x2 w[4];
#pragma unroll
    for (int c = 0; c < 4; ++c) w[c] = *(const u32x2*)(prow + col + 16 * c + 4 * sub);
    if (!ISV) {
        f32x4 x[4]; float ss = 0.f;
#pragma unroll
        for (int c = 0; c < 4; ++c) { x[c] = (f32x4){bflo(w[c].x), bfhi(w[c].x), bflo(w[c].y), bfhi(w[c].y)}; ss += x[c].x * x[c].x + x[c].y * x[c].y + x[c].z * x[c].z + x[c].w * x[c].w; }
        const float r = rsqrtf(quad_sum(ss) * (1.f / 64.f) + EPS) * (ISQ ? QS64 : 1.f);
        const float* g = p.in[GIN] + layer * 64 + 4 * sub;
#pragma unroll
        for (int c = 0; c < 4; ++c) x[c] = x[c] * r * *(const f32x4*)(g + 16 * c);
        if (ROPE && lat) {
#pragma unroll
            for (int i = 0; i < 4; ++i) { const float a = x[0][i], bq = x[1][i]; x[0][i] = a * rr[i].x - bq * rr[i].y; x[1][i] = bq * rr[i].x + a * rr[i].y;
                const float c1 = x[2][i], c2 = x[3][i]; x[2][i] = c1 * rc[i].x - c2 * rc[i].y; x[3][i] = c2 * rc[i].x + c1 * rc[i].y; }
        }
#pragma unroll
        for (int c = 0; c < 4; ++c) { w[c].x = pk2(x[c].x, x[c].y); w[c].y = pk2(x[c].z, x[c].w); }
    }
#pragma unroll
    for (int c = 0; c < 4; ++c) *(u32x2*)(dst + 16 * c + 4 * sub) = w[c];
}
template <int HS> struct PPHeads { static __device__ __forceinline__ void run(const Params& p, const QKVB& qb, int layer, const bf16_t* prow, bool lat, int b, int s, int key, int sub, const float2 (&rr)[4], const float2 (&rc)[4]) {
    pp_head<HS>(p, qb, layer, prow, lat, b, s, key, sub, rr, rc); PPHeads<HS + 1>::run(p, qb, layer, prow, lat, b, s, key, sub, rr, rc); } };
template <> struct PPHeads<28> { static __device__ __forceinline__ void run(const Params&, const QKVB&, int, const bf16_t*, bool, int, int, int, int, const float2 (&)[4], const float2 (&)[4]) {} };

__device__ __forceinline__ void f8_from_bf(const u32x4 v, float (&x)[8]) { x[0] = bflo(v.x); x[1] = bfhi(v.x); x[2] = bflo(v.y); x[3] = bfhi(v.y); x[4] = bflo(v.z); x[5] = bfhi(v.z); x[6] = bflo(v.w); x[7] = bfhi(v.w); }

__device__ __forceinline__ void ph_postproj2(const Params& p, int layer) {
    const int tx = opq((int)threadIdx.x), lane = tx & 63, gw = (tx >> 6) * gridDim.x + blockIdx.x, ngw = gridDim.x * 8;
    const bf16_t* P = (const bf16_t*)(p.ws + WS_P);
    const QKVB qb = make_qkv(p.ws);
    const bf16_t* Wuq = (const bf16_t*)(p.ws + WS_WUQ) + (size_t)layer * 384 * 192;
    const bf16_t* Wukv = (const bf16_t*)(p.ws + WS_WUKV) + (size_t)layer * 512 * 128;
    const float2* rope = (const float2*)(p.ws + WS_ROPE);
    for (int u = gw; u < MALL / 16; u += ngw) {
        const int m0 = u * 16; const bool lat = m0 < TL;
        {
            const int t = lane >> 2, sub = lane & 3, m = m0 + t;
            const int b = lat ? m / SEQ : (m - TL) / CTX, s = lat ? m % SEQ : (m - TL) % CTX, key = lat ? CTX + s : s;
            float2 rr[4], rc[4];
#pragma unroll
            for (int i = 0; i < 4; ++i) { rr[i] = lat ? rope[RT_R64 + (s >> 6) * 16 + 4 * sub + i] : make_float2(1.f, 0.f); rc[i] = lat ? rope[RT_C64 + (s & 63) * 16 + 4 * sub + i] : make_float2(1.f, 0.f); }
            PPHeads<0>::run(p, qb, layer, P + (size_t)m * NINP, lat, b, s, key, sub, rr, rc);
        }
        {
            const int tk = lane & 15, kg = lane >> 4, m = m0 + tk;
            const int b = lat ? m / SEQ : (m - TL) / CTX, s = lat ? m % SEQ : (m - TL) % CTX, key = lat ? CTX + s : s;
            const bf16_t* prow = P + (size_t)m * NINP;
            pp_bf16x8 aq[6];
            { float x[6][8]; float ss = 0.f;
#pragma unroll
                for (int ks = 0; ks < 6; ++ks) { f8_from_bf(*(const u32x4*)(prow + OFF_DCQ + 32 * ks + 8 * kg), x[ks]);
#pragma unroll
                    for (int j = 0; j < 8; ++j) ss += x[ks][j] * x[ks][j]; }
                const float r = rsqrtf(kg_sum(ss) * (1.f / 192.f) + EPS);
                const float* g = p.in[17] + layer * 192 + 8 * kg;
#pragma unroll
                for (int ks = 0; ks < 6; ++ks) { const f32x4 g0 = *(const f32x4*)(g + 32 * ks), g1 = *(const f32x4*)(g + 32 * ks + 4);
                    u32x4 w; w.x = pk2(x[ks][0] * r * g0.x, x[ks][1] * r * g0.y); w.y = pk2(x[ks][2] * r * g0.z, x[ks][3] * r * g0.w); w.z = pk2(x[ks][4] * r * g1.x, x[ks][5] * r * g1.y); w.w = pk2(x[ks][6] * r * g1.z, x[ks][7] * r * g1.w);
                    aq[ks] = __builtin_bit_cast(pp_bf16x8, w); } }
            float2 qr_[4], qc_[4];
#pragma unroll
            for (int reg = 0; reg < 4; ++reg) { const int i = (4 * kg + reg) & 7; qr_[reg] = lat ? rope[RT_R32 + (s >> 6) * 8 + i] : make_float2(1.f, 0.f); qc_[reg] = lat ? rope[RT_C32 + (s & 63) * 8 + i] : make_float2(1.f, 0.f); }
#pragma unroll 1
            for (int h = 0; h < 4; ++h) {
                f32x4 acc[6];
#pragma unroll
                for (int nb = 0; nb < 6; ++nb) { acc[nb] = (f32x4){0.f, 0.f, 0.f, 0.f};
                    const bf16_t* wp = Wuq + (size_t)(96 * h + 16 * nb + tk) * 192 + 8 * kg;
#pragma unroll
                    for (int ks = 0; ks < 6; ++ks) acc[nb] = __builtin_amdgcn_mfma_f32_16x16x32_bf16(*(const pp_bf16x8*)(wp + 32 * ks), aq[ks], acc[nb], 0, 0, 0); }
                float ss = 0.f;
#pragma unroll
                for (int nb = 0; nb < 6; ++nb) ss += acc[nb].x * acc[nb].x + acc[nb].y * acc[nb].y + acc[nb].z * acc[nb].z + acc[nb].w * acc[nb].w;
                const float r = rsqrtf(kg_sum(ss) * (1.f / 96.f) + EPS) * QS96;
                const float* g = p.in[21] + layer * 96 + 4 * kg;
                bf16_t* dst = (lat ? qb.QD + ((size_t)(b * 4 + h) * SEQ + s) * 96 : qb.QDc + ((size_t)(b * 4 + h) * CTX + s) * 96) + 4 * kg;
#pragma unroll
                for (int nb = 0; nb < 6; ++nb) { f32x4 y = acc[nb] * r * *(const f32x4*)(g + 16 * nb);
                    if (nb >= 4 && lat) {
#pragma unroll
                        for (int reg = 0; reg < 4; ++reg) { const float other = half_other(y[reg], lane); const float2 cs = nb == 4 ? qr_[reg] : qc_[reg];
                            y[reg] = (kg < 2) ? y[reg] * cs.x - other * cs.y : y[reg] * cs.x + other * cs.y; } }
                    u32x2 w; w.x = pk2(y.x, y.y); w.y = pk2(y.z, y.w); *(u32x2*)(dst + 16 * nb) = w; }
            }
            pp_bf16x8 akv[4];
            { float x[4][8]; float ss = 0.f;
#pragma unroll
                for (int ks = 0; ks < 4; ++ks) { f8_from_bf(*(const u32x4*)(prow + OFF_DCKV + 32 * ks + 8 * kg), x[ks]);
#pragma unroll
                    for (int j = 0; j < 8; ++j) ss += x[ks][j] * x[ks][j]; }
                const float r = rsqrtf(kg_sum(ss) * (1.f / 128.f) + EPS);
                const float* g = p.in[19] + layer * 128 + 8 * kg;
#pragma unroll
                for (int ks = 0; ks < 4; ++ks) { const f32x4 g0 = *(const f32x4*)(g + 32 * ks), g1 = *(const f32x4*)(g + 32 * ks + 4);
                    u32x4 w; w.x = pk2(x[ks][0] * r * g0.x, x[ks][1] * r * g0.y); w.y = pk2(x[ks][2] * r * g0.z, x[ks][3] * r * g0.w); w.z = pk2(x[ks][4] * r * g1.x, x[ks][5] * r * g1.y); w.w = pk2(x[ks][6] * r * g1.z, x[ks][7] * r * g1.w);
                    akv[ks] = __builtin_bit_cast(pp_bf16x8, w); } }
            float kr[8]; f8_from_bf(*(const u32x4*)(prow + OFF_DKR + 8 * kg), kr);
            float krss = 0.f;
#pragma unroll
            for (int j = 0; j < 8; ++j) krss += kr[j] * kr[j];
            float2 kcs[8];
#pragma unroll
            for (int j = 0; j < 8; ++j) kcs[j] = !lat ? make_float2(1.f, 0.f) : (kg < 2 ? rope[RT_R32 + (s >> 6) * 8 + j] : rope[RT_C32 + (s & 63) * 8 + j]);
#pragma unroll 1
            for (int h = 0; h < 4; ++h) {
                f32x4 acc[8];
#pragma unroll
                for (int nb = 0; nb < 8; ++nb) { acc[nb] = (f32x4){0.f, 0.f, 0.f, 0.f};
                    const bf16_t* wp = Wukv + (size_t)(128 * h + 16 * nb + tk) * 128 + 8 * kg;
#pragma unroll
                    for (int ks = 0; ks < 4; ++ks) acc[nb] = __builtin_amdgcn_mfma_f32_16x16x32_bf16(*(const pp_bf16x8*)(wp + 32 * ks), akv[ks], acc[nb], 0, 0, 0); }
                float ss = krss;
#pragma unroll
                for (int nb = 0; nb < 4; ++nb) ss += acc[nb].x * acc[nb].x + acc[nb].y * acc[nb].y + acc[nb].z * acc[nb].z + acc[nb].w * acc[nb].w;
                const float r = rsqrtf(kg_sum(ss) * (1.f / 96.f) + EPS);
                const float* g = p.in[22] + layer * 96;
                bf16_t* kd = qb.KD + ((size_t)(b * 4 + h) * KEYS + key) * 96; bf16_t* vd = qb.VD + ((size_t)(b * 4 + h) * KEYS + key) * 64;
#pragma unroll
                for (int nb = 0; nb < 4; ++nb) { const f32x4 y = acc[nb] * r * *(const f32x4*)(g + 16 * nb + 4 * kg); u32x2 w; w.x = pk2(y.x, y.y); w.y = pk2(y.z, y.w); *(u32x2*)(kd + 16 * nb + 4 * kg) = w; }
                { float y[8];
#pragma unroll
                    for (int j = 0; j < 8; ++j) y[j] = kr[j] * r * g[64 + 8 * kg + j];
#pragma unroll
                    for (int j = 0; j < 8; ++j) { const float other = swz_xor<16>(y[j]); y[j] = (kg & 1) == 0 ? y[j] * kcs[j].x - other * kcs[j].y : y[j] * kcs[j].x + other * kcs[j].y; }
                    u32x4 w; w.x = pk2(y[0], y[1]); w.y = pk2(y[2], y[3]); w.z = pk2(y[4], y[5]); w.w = pk2(y[6], y[7]); *(u32x4*)(kd + 64 + 8 * kg) = w; }
#pragma unroll
                for (int nb = 4; nb < 8; ++nb) { const f32x4 y = acc[nb]; u32x2 w; w.x = pk2(y.x, y.y); w.y = pk2(y.z, y.w); *(u32x2*)(vd + 16 * (nb - 4) + 4 * kg) = w; }
            }
        }
    }
}

namespace fa {
typedef short bf16x8 __attribute__((ext_vector_type(8)));
typedef short s16x4 __attribute__((ext_vector_type(4)));
typedef float f32x16 __attribute__((ext_vector_type(16)));
typedef __attribute__((address_space(3))) const char* lds_cptr;
typedef short v4i16_t __attribute__((ext_vector_type(4)));
constexpr int KSTG = 12288, VSTG = 8192, STG = KSTG + VSTG;
constexpr int LDS_WS = 2 * STG, LDS_OST = LDS_WS + 8 * 256, LDS_RPB = LDS_OST + 8 * 4096, LDS_TOTAL = LDS_RPB + 2048;
constexpr float LOG2E = 1.4426950408889634f;
constexpr float THR = 6.0f;
__device__ __forceinline__ int crow(int r, int hi) { return (r & 3) + 8 * (r >> 2) + 4 * hi; }
__device__ __forceinline__ void glds16(const void* gsrc, unsigned lds_dst) { unsigned keep;
    asm volatile("s_mov_b32 %0, m0\n\ts_mov_b32 m0, %2\n\ts_nop 0\n\tglobal_load_lds_dwordx4 %1, off\n\ts_mov_b32 m0, %0" : "=&s"(keep) : "v"(gsrc), "s"(lds_dst) : "memory"); }
__device__ __forceinline__ s16x4 vtr(lds_cptr p) { return __builtin_bit_cast(s16x4, __builtin_amdgcn_ds_read_tr16_b64_v4i16((__attribute__((address_space(3))) v4i16_t*)p)); }
typedef float f32x2_t __attribute__((ext_vector_type(2))); typedef __bf16 bf16x2_t __attribute__((ext_vector_type(2)));
__device__ __forceinline__ unsigned cvtpk(float lo, float hi) { f32x2_t v = {lo, hi}; bf16x2_t b = __builtin_convertvector(v, bf16x2_t); return __builtin_bit_cast(unsigned, b); }
__device__ __forceinline__ float xhalf_max(float m) { auto rr = __builtin_amdgcn_permlane32_swap(__float_as_uint(m), __float_as_uint(m), false, false); return fmaxf(__uint_as_float(rr[0]), __uint_as_float(rr[1])); }
__device__ __forceinline__ float xhalf_sum(float m) { auto rr = __builtin_amdgcn_permlane32_swap(__float_as_uint(m), __float_as_uint(m), false, false); return __uint_as_float(rr[0]) + __uint_as_float(rr[1]); }
#define FA_WAIT_BAR() asm volatile("s_waitcnt vmcnt(0) lgkmcnt(0)\n\ts_barrier" ::: "memory")

template <int DQK, int MODE>
__device__ __forceinline__ void attn_unit(const bf16_t* Qg, const bf16_t* Kg, const bf16_t* Vg, bf16_t* Og, int q0, float sink2, const float* rpb, char* shm) {
    const int tid = opq((int)threadIdx.x), lane = tid & 63, r32 = lane & 31, hi = lane >> 5; const int wid = __builtin_amdgcn_readfirstlane(tid >> 6);
    const unsigned lds0 = (unsigned)(uintptr_t)shm;
    float* wsf = (float*)(shm + LDS_WS) + wid * 64;
    constexpr int NCH = DQK / 8, ND0 = DQK / 16;
    int NT, wbase = 0;
    if (MODE == 0) NT = KEYS / 64; else if (MODE == 3) NT = 4;
    else if (MODE == 1) { wbase = max(0, q0 - 128); const int we = min(SEQ, q0 + 256 + 128); NT = 4 + (we - wbase) / 64; }
    else { const int r0 = q0 >> 6; wbase = min(max(r0 - 4, 0), 120); const int kre = min(max(r0 - 1, 0), 120) + 8; NT = 4 + (kre - wbase); }
#define FA_KEY0(t) ((MODE == 0 || MODE == 3 || (t) < 4) ? 64 * (t) : (MODE == 1 ? CTX + wbase + 64 * ((t) - 4) : CTX + (wbase + (t) - 4) * 64))
    const bf16_t* ksrc = Kg + (size_t)lane * DQK; const bf16_t* vsrc = Vg + (size_t)(16 * (wid & 3) + (lane >> 2)) * 64 + (wid >> 2) * 32 + (lane & 3) * 8;
#define FA_DMA(t, s) do { const int k0_ = FA_KEY0(t); \
        _Pragma("unroll") for (int c_ = 0; c_ < 2; ++c_) { const int ch_ = wid + 8 * c_; if (ch_ < NCH) glds16(ksrc + (size_t)k0_ * DQK + ch_ * 8, (unsigned)__builtin_amdgcn_readfirstlane(lds0 + (s) * STG + ch_ * 1024)); } \
        glds16(vsrc + (size_t)k0_ * 64, (unsigned)__builtin_amdgcn_readfirstlane(lds0 + (s) * STG + KSTG + wid * 1024)); } while (0)
    FA_DMA(0, 0);
    if (MODE == 2) { float* rp = (float*)(shm + LDS_RPB); for (int i = tid; i < 15 * 31; i += 512) rp[i] = rpb[i] * LOG2E; }
    bf16x8 qr[ND0];
#pragma unroll
    for (int d0 = 0; d0 < ND0; ++d0) qr[d0] = *reinterpret_cast<const bf16x8*>(Qg + (size_t)(wid * 32 + r32) * DQK + d0 * 16 + hi * 8);
    float mhat = -1e30f, l_reg = 0.f; f32x16 o[2];
#pragma unroll
    for (int r = 0; r < 16; ++r) { o[0][r] = 0.f; o[1][r] = 0.f; }
    const int qpos = q0 + wid * 32 + r32;
    const int rq = (q0 >> 6) + (wid >> 1), jq = 32 * (wid & 1) + r32;
    const int rs = min(max(rq - 4, 0), 120), cs = min(max(jq - 8, 0), 48);
    const lds_cptr shm3 = (lds_cptr)shm;
    FA_WAIT_BAR();
    for (int t = 0; t < NT; ++t) {
        const int s = t & 1;
        if (t + 1 < NT) FA_DMA(t + 1, s ^ 1);
        bool active = true;
        if (MODE == 1 && t >= 4) { const int kp0 = wbase + 64 * (t - 4), qw0 = q0 + wid * 32; active = (kp0 + 63 >= qw0 - 128) && (kp0 <= qw0 + 31 + 128); }
        if (MODE == 2 && t >= 4) { const int kr = wbase + t - 4; active = (kr >= rs) && (kr < rs + 8); }
        if (active) {
            const lds_cptr kb = shm3 + s * STG + hi * 1024 + r32 * 16;
            f32x16 p0, p1;
#pragma unroll
            for (int r = 0; r < 16; ++r) { p0[r] = 0.f; p1[r] = 0.f; }
#pragma unroll
            for (int d0 = 0; d0 < ND0; ++d0) {
                const bf16x8 b0 = *(const __attribute__((address_space(3))) bf16x8*)(kb + d0 * 2048);
                const bf16x8 b1 = *(const __attribute__((address_space(3))) bf16x8*)(kb + d0 * 2048 + 512);
                p0 = __builtin_amdgcn_mfma_f32_32x32x16_bf16(b0, qr[d0], p0, 0, 0, 0);
                p1 = __builtin_amdgcn_mfma_f32_32x32x16_bf16(b1, qr[d0], p1, 0, 0, 0);
            }
            if (MODE == 1 && t >= 4) { const int kp0 = wbase + 64 * (t - 4) - qpos;
#pragma unroll
                for (int r = 0; r < 16; ++r) { const int d0_ = kp0 + crow(r, hi), d1_ = d0_ + 32; if (d0_ < -128 || d0_ > 128) p0[r] = -INFINITY; if (d1_ < -128 || d1_ > 128) p1[r] = -INFINITY; } }
            if (MODE == 2 && t >= 4) { const int kr = wbase + t - 4; const float* rp = (const float*)(shm + LDS_RPB) + (kr - rq + 7) * 31 + 15 - jq;
#pragma unroll
                for (int r = 0; r < 16; ++r) { const int kc0 = crow(r, hi), kc1 = kc0 + 32;
                    const bool v0 = (kc0 >= cs) && (kc0 < cs + 16), v1 = (kc1 >= cs) && (kc1 < cs + 16);
                    p0[r] = v0 ? p0[r] + rp[v0 ? kc0 : jq] : -INFINITY; p1[r] = v1 ? p1[r] + rp[v1 ? kc1 : jq] : -INFINITY; } }
            float rm = fmaxf(p0[0], p1[0]);
#pragma unroll
            for (int r = 1; r < 16; ++r) rm = fmaxf(rm, fmaxf(p0[r], p1[r]));
            rm = xhalf_max(rm);
            if (__any(rm - mhat > THR)) {
                const float mn = fmaxf(mhat, rm), f = __builtin_amdgcn_exp2f(mhat - mn); mhat = mn; l_reg *= f;
                if (hi == 0) wsf[r32] = f;
#pragma unroll
                for (int r = 0; r < 16; ++r) { const float fr = wsf[crow(r, hi)]; o[0][r] *= fr; o[1][r] *= fr; }
            }
            float sacc = 0.f;
#pragma unroll
            for (int r = 0; r < 16; ++r) { p0[r] = __builtin_amdgcn_exp2f(p0[r] - mhat); p1[r] = __builtin_amdgcn_exp2f(p1[r] - mhat); sacc += p0[r] + p1[r]; }
            l_reg += sacc;
            u32x4 pw0, pw1, pw2, pw3;
            pw0 = (u32x4){cvtpk(p0[0], p0[1]), cvtpk(p0[2], p0[3]), cvtpk(p0[4], p0[5]), cvtpk(p0[6], p0[7])};
            pw1 = (u32x4){cvtpk(p0[8], p0[9]), cvtpk(p0[10], p0[11]), cvtpk(p0[12], p0[13]), cvtpk(p0[14], p0[15])};
            pw2 = (u32x4){cvtpk(p1[0], p1[1]), cvtpk(p1[2], p1[3]), cvtpk(p1[4], p1[5]), cvtpk(p1[6], p1[7])};
            pw3 = (u32x4){cvtpk(p1[8], p1[9]), cvtpk(p1[10], p1[11]), cvtpk(p1[12], p1[13]), cvtpk(p1[14], p1[15])};
            const lds_cptr vp = shm3 + s * STG + KSTG + ((lane >> 4) & 1) * 32 + (lane & 3) * 8 + (4 * hi + ((lane & 15) >> 2)) * 64;
#pragma unroll
            for (int dh = 0; dh < 2; ++dh) {
                s16x4 vlo[4], vhi[4];
#pragma unroll
                for (int ks = 0; ks < 4; ++ks) { vlo[ks] = vtr(vp + dh * 4096 + ks * 1024); vhi[ks] = vtr(vp + dh * 4096 + ks * 1024 + 512); }
#define FA_VFR(k) (bf16x8){vlo[k][0], vlo[k][1], vlo[k][2], vlo[k][3], vhi[k][0], vhi[k][1], vhi[k][2], vhi[k][3]}
                o[dh] = __builtin_amdgcn_mfma_f32_32x32x16_bf16(__builtin_bit_cast(bf16x8, pw0), FA_VFR(0), o[dh], 0, 0, 0);
                o[dh] = __builtin_amdgcn_mfma_f32_32x32x16_bf16(__builtin_bit_cast(bf16x8, pw1), FA_VFR(1), o[dh], 0, 0, 0);
                o[dh] = __builtin_amdgcn_mfma_f32_32x32x16_bf16(__builtin_bit_cast(bf16x8, pw2), FA_VFR(2), o[dh], 0, 0, 0);
                o[dh] = __builtin_amdgcn_mfma_f32_32x32x16_bf16(__builtin_bit_cast(bf16x8, pw3), FA_VFR(3), o[dh], 0, 0, 0);
#undef FA_VFR
            }
        }
        FA_WAIT_BAR();
    }
    l_reg = xhalf_sum(l_reg);
    if (MODE == 1 || MODE == 3) l_reg += __builtin_amdgcn_exp2f(sink2 - mhat);
    if (hi == 0) wsf[32 + r32] = 1.0f / l_reg;
    float rli[16];
#pragma unroll
    for (int r = 0; r < 16; ++r) rli[r] = wsf[32 + crow(r, hi)];
    bf16_t* stg = (bf16_t*)(shm + LDS_OST) + wid * 2048;
#pragma unroll
    for (int r = 0; r < 16; ++r) { const int orow = crow(r, hi);
#pragma unroll
        for (int dh = 0; dh < 2; ++dh) stg[orow * 64 + dh * 32 + r32] = (bf16_t)f2bf(o[dh][r] * rli[r]); }
#pragma unroll
    for (int i = 0; i < 4; ++i) { const int row = i * 8 + (lane >> 3), ch = lane & 7; const u32x4 v = *(const u32x4*)(stg + row * 64 + ch * 8); *(u32x4*)(Og + (size_t)(wid * 32 + row) * D + ch * 8) = v; }
    asm volatile("s_waitcnt lgkmcnt(0)\n\ts_barrier" ::: "memory");
#undef FA_DMA
#undef FA_KEY0
}
#undef FA_WAIT_BAR
}


namespace fa2 {
using fa::bf16x8; using fa::s16x4; using fa::f32x16; using fa::lds_cptr; using fa::crow; using fa::glds16; using fa::vtr; using fa::cvtpk; using fa::LOG2E;
constexpr int KSL = 12288, VSL = 8192, VBASE = 4 * KSL, LDS_WS = VBASE + 3 * VSL, LDS_OST = LDS_WS + 8 * 256, LDS_RPB = LDS_OST + 8 * 4096, LDS_TOTAL = LDS_RPB + 2048;
static_assert(LDS_TOTAL <= 131072, "attention LDS");
#define SBAR() __builtin_amdgcn_sched_barrier(0)
#define PIN(x) asm volatile("" : "+v"(x))
template <int DQK, int MODE, int THRL>
__device__ __forceinline__ void attn_unit(const bf16_t* Qg, const bf16_t* Kg, const bf16_t* Vg, bf16_t* Og, int q0, float sink2, const float* rpb, char* shm) {
    const int tid = opq((int)threadIdx.x), lane = tid & 63, r32 = lane & 31, hi = lane >> 5; const int wid = __builtin_amdgcn_readfirstlane(tid >> 6);
    const unsigned lds0 = (unsigned)(uintptr_t)shm;
    float* wsf = (float*)(shm + LDS_WS) + wid * 64;
    constexpr int NCH = DQK / 8, ND0 = DQK / 16;
    int NT, wbase = 0;
    if (MODE == 0) NT = KEYS / 64; else if (MODE == 3) NT = 4;
    else if (MODE == 1) { wbase = max(0, q0 - 128); const int we = min(SEQ, q0 + 256 + 128); NT = 4 + (we - wbase) / 64; }
    else { const int r0 = q0 >> 6; wbase = min(max(r0 - 4, 0), 120); const int kre = min(max(r0 - 1, 0), 120) + 8; NT = 4 + (kre - wbase); }
#define FA_KEY0(t) ((MODE == 0 || MODE == 3 || (t) < 4) ? 64 * (t) : (MODE == 1 ? CTX + wbase + 64 * ((t) - 4) : CTX + (wbase + (t) - 4) * 64))
    const bf16_t* ksrc = Kg + (size_t)lane * DQK; const bf16_t* vsrc = Vg + (size_t)(16 * (wid & 3) + (lane >> 2)) * 64 + (wid >> 2) * 32 + (lane & 3) * 8;
#define DMA_K(t, slotoff) do { const int tt_ = (t) < NT ? (t) : NT - 1; const int k0_ = FA_KEY0(tt_); \
        glds16(ksrc + (size_t)k0_ * DQK + wid * 8, (unsigned)__builtin_amdgcn_readfirstlane(lds0 + (slotoff) + wid * 1024)); \
        if (NCH > 8) { if (wid < NCH - 8) glds16(ksrc + (size_t)k0_ * DQK + (wid + 8) * 8, (unsigned)__builtin_amdgcn_readfirstlane(lds0 + (slotoff) + (wid + 8) * 1024)); } } while (0)
#define DMA_V(t, slotoff) do { const int tt_ = (t) < NT ? (t) : NT - 1; const int k0_ = FA_KEY0(tt_); \
        glds16(vsrc + (size_t)k0_ * 64, (unsigned)__builtin_amdgcn_readfirstlane(lds0 + VBASE + (slotoff) + wid * 1024)); } while (0)
#define WAIT_STEP() do { if (NCH > 8 && wid < NCH - 8) asm volatile("s_waitcnt vmcnt(3) lgkmcnt(0)\n\ts_barrier" ::: "memory"); else asm volatile("s_waitcnt vmcnt(2) lgkmcnt(0)\n\ts_barrier" ::: "memory"); } while (0)
    DMA_K(0, 0); DMA_V(0, 0); DMA_K(1, KSL); DMA_K(2, 2 * KSL);
    if (MODE == 2) { float* rp = (float*)(shm + LDS_RPB); for (int i = tid; i < 15 * 31; i += 512) rp[i] = rpb[i] * LOG2E; }
    bf16x8 qr[ND0];
#pragma unroll
    for (int d0 = 0; d0 < ND0; ++d0) qr[d0] = *reinterpret_cast<const bf16x8*>(Qg + (size_t)(wid * 32 + r32) * DQK + d0 * 16 + hi * 8);
    float mhat = 0.f, l_reg = 0.f; f32x16 o[2]; f32x16 negm;
#pragma unroll
    for (int r = 0; r < 16; ++r) { o[0][r] = 0.f; o[1][r] = 0.f; negm[r] = 0.f; }
    PIN(negm);
    const int qpos = q0 + wid * 32 + r32;
    const int rq = (q0 >> 6) + (wid >> 1), jq = 32 * (wid & 1) + r32;
    const int rs = min(max(rq - 4, 0), 120), cs = min(max(jq - 8, 0), 48);
    const lds_cptr shm3 = (lds_cptr)shm;
    const lds_cptr kp0 = shm3 + hi * 1024 + r32 * 16;
    const lds_cptr vp0 = shm3 + VBASE + ((lane >> 4) & 1) * 32 + (lane & 3) * 8 + (4 * hi + ((lane & 15) >> 2)) * 64;
#define MASK(C0, C1, t) do { \
        if (MODE == 1 && (t) >= 4) { const int kp0_ = wbase + 64 * ((t) - 4) - qpos; \
            _Pragma("unroll") for (int r = 0; r < 16; ++r) { const int d0_ = kp0_ + crow(r, hi), d1_ = d0_ + 32; if (d0_ < -128 || d0_ > 128) C0[r] = -INFINITY; if (d1_ < -128 || d1_ > 128) C1[r] = -INFINITY; } } \
        if (MODE == 2 && (t) >= 4) { const int kr_ = wbase + (t) - 4; const bool rowok_ = (kr_ >= rs) && (kr_ < rs + 8); const int ro_ = min(max(kr_ - rq + 7, 0), 14); \
            const float* rp_ = (const float*)(shm + LDS_RPB) + ro_ * 31 + 15 - jq; \
            _Pragma("unroll") for (int r = 0; r < 16; ++r) { const int kc0 = crow(r, hi), kc1 = kc0 + 32; \
                const bool v0 = rowok_ && (kc0 >= cs) && (kc0 < cs + 16), v1 = rowok_ && (kc1 >= cs) && (kc1 < cs + 16); \
                C0[r] = v0 ? C0[r] + rp_[v0 ? kc0 : jq] : -INFINITY; C1[r] = v1 ? C1[r] + rp_[v1 ? kc1 : jq] : -INFINITY; } } } while (0)
#define ROWMAX(C0, C1, rm) do { float a_ = fmaxf(fmaxf(C0[0], C0[1]), C1[0]), b_ = fmaxf(fmaxf(C0[2], C0[3]), C1[1]); a_ = fmaxf(fmaxf(a_, C1[2]), C1[3]); \
        _Pragma("unroll") for (int r = 4; r < 16; r += 4) { a_ = fmaxf(fmaxf(a_, C0[r]), C0[r + 1]); b_ = fmaxf(fmaxf(b_, C0[r + 2]), C0[r + 3]); a_ = fmaxf(fmaxf(a_, C1[r]), C1[r + 1]); b_ = fmaxf(fmaxf(b_, C1[r + 2]), C1[r + 3]); } \
        rm = fa::xhalf_max(fmaxf(a_, b_)); } while (0)
    bf16x8 kf[8]; bf16x8 kf2[4];
#define KLOAD(j, slotoff) do { kf[2 * (j)] = *(const __attribute__((address_space(3))) bf16x8*)(kp0 + (slotoff) + (j) * 2048); kf[2 * (j) + 1] = *(const __attribute__((address_space(3))) bf16x8*)(kp0 + (slotoff) + (j) * 2048 + 512); } while (0)
#define KLOAD2(slotoff) do { if (ND0 > 4) { kf2[0] = *(const __attribute__((address_space(3))) bf16x8*)(kp0 + (slotoff) + 4 * 2048); kf2[1] = *(const __attribute__((address_space(3))) bf16x8*)(kp0 + (slotoff) + 4 * 2048 + 512); \
        kf2[2] = *(const __attribute__((address_space(3))) bf16x8*)(kp0 + (slotoff) + 5 * 2048); kf2[3] = *(const __attribute__((address_space(3))) bf16x8*)(kp0 + (slotoff) + 5 * 2048 + 512); } } while (0)
    asm volatile("s_waitcnt vmcnt(0) lgkmcnt(0)\n\ts_barrier" ::: "memory");
    f32x16 pA0, pA1, pB0, pB1;
    int ks_cur = 0, ks_next = KSL, ks_nn = 2 * KSL, ks_tgt = 3 * KSL;
    int vs_prev = 2 * VSL, vs_cur = 0, vs_next = VSL;
#define ROT() do { const int k_ = ks_cur; ks_cur = ks_next; ks_next = ks_nn; ks_nn = ks_tgt; ks_tgt = k_; const int v_ = vs_prev; vs_prev = vs_cur; vs_cur = vs_next; vs_next = v_; } while (0)
    bool resc = false;
#define RESC() do { if (resc) { _Pragma("unroll") for (int r = 0; r < 16; ++r) { const float fr_ = wsf[crow(r, hi)]; o[0][r] *= fr_; o[1][r] *= fr_; } } } while (0)
    KLOAD(0, 0); KLOAD(1, 0); KLOAD(2, 0); KLOAD(3, 0); KLOAD2(0);
    {
#pragma unroll
        for (int d0 = 0; d0 < 4; ++d0) { pA0 = __builtin_amdgcn_mfma_f32_32x32x16_bf16(kf[2 * d0], qr[d0], d0 == 0 ? negm : pA0, 0, 0, 0); pA1 = __builtin_amdgcn_mfma_f32_32x32x16_bf16(kf[2 * d0 + 1], qr[d0], d0 == 0 ? negm : pA1, 0, 0, 0); }
        if (ND0 > 4) { pA0 = __builtin_amdgcn_mfma_f32_32x32x16_bf16(kf2[0], qr[ND0 > 4 ? 4 : 0], pA0, 0, 0, 0); pA1 = __builtin_amdgcn_mfma_f32_32x32x16_bf16(kf2[1], qr[ND0 > 4 ? 4 : 0], pA1, 0, 0, 0);
                       pA0 = __builtin_amdgcn_mfma_f32_32x32x16_bf16(kf2[2], qr[ND0 > 4 ? 5 : 0], pA0, 0, 0, 0); pA1 = __builtin_amdgcn_mfma_f32_32x32x16_bf16(kf2[3], qr[ND0 > 4 ? 5 : 0], pA1, 0, 0, 0); }
        DMA_K(3, 3 * KSL); DMA_V(1, VSL);
        float rm; ROWMAX(pA0, pA1, rm);
        mhat = rm;
#pragma unroll
        for (int r = 0; r < 16; ++r) { pA0[r] = __builtin_amdgcn_exp2f(pA0[r] - rm); pA1[r] = __builtin_amdgcn_exp2f(pA1[r] - rm); negm[r] = -mhat; }
        PIN(negm);
        KLOAD(0, KSL); KLOAD(1, KSL); KLOAD(2, KSL); KLOAD(3, KSL);
        WAIT_STEP();
    }
    s16x4 vlo[8], vhi[8]; u32x4 pw0, pw1, pw2, pw3;
#define VRD(i) do { vlo[i] = vtr(vp_ + (((i) >> 2) * 4096 + ((i) & 3) * 1024)); vhi[i] = vtr(vp_ + (((i) >> 2) * 4096 + ((i) & 3) * 1024 + 512)); } while (0)
#define VFR(i) (bf16x8){vlo[i][0], vlo[i][1], vlo[i][2], vlo[i][3], vhi[i][0], vhi[i][1], vhi[i][2], vhi[i][3]}
#define PAF(k) __builtin_bit_cast(bf16x8, pw##k)
#define GAPA(MF, A0, A1, A2, A3, W0, W1, PW) do { MF; sacc += A0; sacc += A1; sacc += A2; sacc += A3; PIN(sacc); W0; W1; PIN(PW); SBAR(); } while (0)
#define EX(v) __builtin_amdgcn_exp2f(v)
#define GAPB(MF, X, B) do { MF; X[B] = EX(X[B]); X[B + 1] = EX(X[B + 1]); X[B + 2] = EX(X[B + 2]); X[B + 3] = EX(X[B + 3]); PIN(X); SBAR(); } while (0)
#define KRD(j) do { KLOAD(j, ks_nn_); SBAR(); } while (0)
#define STEP(C0, C1, P0, P1, t) do { SBAR(); \
        const lds_cptr vp_ = vp0 + vs_prev; const int ks_cur_ = ks_cur; (void)ks_cur_; \
        KLOAD2(ks_cur_); \
        VRD(0); SBAR(); float sacc = (P0[0] + P0[1]); \
        GAPA(C0 = __builtin_amdgcn_mfma_f32_32x32x16_bf16(kf[0], qr[0], negm, 0, 0, 0), P0[2], P0[3], P0[4], P0[5], pw0[0] = cvtpk(P0[0], P0[1]), pw0[1] = cvtpk(P0[2], P0[3]), pw0); \
        VRD(4); SBAR(); GAPA(C1 = __builtin_amdgcn_mfma_f32_32x32x16_bf16(kf[1], qr[0], negm, 0, 0, 0), P0[6], P0[7], P0[8], P0[9], pw0[2] = cvtpk(P0[4], P0[5]), pw0[3] = cvtpk(P0[6], P0[7]), pw0); \
        VRD(1); SBAR(); GAPA(C0 = __builtin_amdgcn_mfma_f32_32x32x16_bf16(kf[2], qr[1], C0, 0, 0, 0), P0[10], P0[11], P0[12], P0[13], pw1[0] = cvtpk(P0[8], P0[9]), pw1[1] = cvtpk(P0[10], P0[11]), pw1); \
        VRD(5); SBAR(); GAPA(C1 = __builtin_amdgcn_mfma_f32_32x32x16_bf16(kf[3], qr[1], C1, 0, 0, 0), P0[14], P0[15], P1[0], P1[1], pw1[2] = cvtpk(P0[12], P0[13]), pw1[3] = cvtpk(P0[14], P0[15]), pw1); \
        VRD(2); SBAR(); GAPA(C0 = __builtin_amdgcn_mfma_f32_32x32x16_bf16(kf[4], qr[2], C0, 0, 0, 0), P1[2], P1[3], P1[4], P1[5], pw2[0] = cvtpk(P1[0], P1[1]), pw2[1] = cvtpk(P1[2], P1[3]), pw2); \
        VRD(6); SBAR(); GAPA(C1 = __builtin_amdgcn_mfma_f32_32x32x16_bf16(kf[5], qr[2], C1, 0, 0, 0), P1[6], P1[7], P1[8], P1[9], pw2[2] = cvtpk(P1[4], P1[5]), pw2[3] = cvtpk(P1[6], P1[7]), pw2); \
        VRD(3); SBAR(); GAPA(C0 = __builtin_amdgcn_mfma_f32_32x32x16_bf16(kf[6], qr[3], C0, 0, 0, 0), P1[10], P1[11], P1[12], P1[13], pw3[0] = cvtpk(P1[8], P1[9]), pw3[1] = cvtpk(P1[10], P1[11]), pw3); \
        VRD(7); SBAR(); GAPA(C1 = __builtin_amdgcn_mfma_f32_32x32x16_bf16(kf[7], qr[3], C1, 0, 0, 0), P1[14], P1[15], 0.f, 0.f, pw3[2] = cvtpk(P1[12], P1[13]), pw3[3] = cvtpk(P1[14], P1[15]), pw3); \
        if (ND0 > 4) { C0 = __builtin_amdgcn_mfma_f32_32x32x16_bf16(kf2[0], qr[ND0 > 4 ? 4 : 0], C0, 0, 0, 0); C1 = __builtin_amdgcn_mfma_f32_32x32x16_bf16(kf2[1], qr[ND0 > 4 ? 4 : 0], C1, 0, 0, 0); \
                       C0 = __builtin_amdgcn_mfma_f32_32x32x16_bf16(kf2[2], qr[ND0 > 4 ? 5 : 0], C0, 0, 0, 0); C1 = __builtin_amdgcn_mfma_f32_32x32x16_bf16(kf2[3], qr[ND0 > 4 ? 5 : 0], C1, 0, 0, 0); SBAR(); } \
        l_reg += sacc; \
        DMA_K((t) + 3, ks_tgt); DMA_V((t) + 1, vs_next); \
        MASK(C0, C1, t); \
        { float rm; ROWMAX(C0, C1, rm); resc = false; \
          if (__builtin_expect(__any(rm > (float)THRL), 0)) { const float dl = fmaxf(rm, 0.f); mhat += dl; \
              _Pragma("unroll") for (int r = 0; r < 16; ++r) { C0[r] -= dl; C1[r] -= dl; } \
              _Pragma("unroll") for (int r = 0; r < 16; ++r) negm[r] = -mhat; PIN(negm); \
              const float f = __builtin_amdgcn_exp2f(-dl); l_reg *= f; if (hi == 0) wsf[r32] = f; resc = true; } } \
        SBAR(); \
        const int ks_nn_ = ks_next; \
        GAPB(o[0] = __builtin_amdgcn_mfma_f32_32x32x16_bf16(PAF(0), VFR(0), o[0], 0, 0, 0), C0, 0); \
        GAPB(o[1] = __builtin_amdgcn_mfma_f32_32x32x16_bf16(PAF(0), VFR(4), o[1], 0, 0, 0), C0, 4); \
        KRD(0); GAPB(o[0] = __builtin_amdgcn_mfma_f32_32x32x16_bf16(PAF(1), VFR(1), o[0], 0, 0, 0), C0, 8); \
        KRD(1); GAPB(o[1] = __builtin_amdgcn_mfma_f32_32x32x16_bf16(PAF(1), VFR(5), o[1], 0, 0, 0), C0, 12); \
        KRD(2); GAPB(o[0] = __builtin_amdgcn_mfma_f32_32x32x16_bf16(PAF(2), VFR(2), o[0], 0, 0, 0), C1, 0); \
        KRD(3); GAPB(o[1] = __builtin_amdgcn_mfma_f32_32x32x16_bf16(PAF(2), VFR(6), o[1], 0, 0, 0), C1, 4); \
        GAPB(o[0] = __builtin_amdgcn_mfma_f32_32x32x16_bf16(PAF(3), VFR(3), o[0], 0, 0, 0), C1, 8); \
        GAPB(o[1] = __builtin_amdgcn_mfma_f32_32x32x16_bf16(PAF(3), VFR(7), o[1], 0, 0, 0), C1, 12); \
    } while (0)
    ROT();
    int t = 1;
    for (; t + 1 < NT; t += 2) {
        STEP(pB0, pB1, pA0, pA1, t);     WAIT_STEP(); RESC(); ROT();
        STEP(pA0, pA1, pB0, pB1, t + 1); WAIT_STEP(); RESC(); ROT();
    }
    if (t < NT) {
        STEP(pB0, pB1, pA0, pA1, t);     WAIT_STEP(); RESC(); ROT();
        pA0 = pB0; pA1 = pB1;
    }
    {
        float sacc = 0.f;
#pragma unroll
        for (int r = 0; r < 16; ++r) sacc += pA0[r] + pA1[r];
        l_reg += sacc;
        pw0 = (u32x4){cvtpk(pA0[0], pA0[1]), cvtpk(pA0[2], pA0[3]), cvtpk(pA0[4], pA0[5]), cvtpk(pA0[6], pA0[7])};
        pw1 = (u32x4){cvtpk(pA0[8], pA0[9]), cvtpk(pA0[10], pA0[11]), cvtpk(pA0[12], pA0[13]), cvtpk(pA0[14], pA0[15])};
        pw2 = (u32x4){cvtpk(pA1[0], pA1[1]), cvtpk(pA1[2], pA1[3]), cvtpk(pA1[4], pA1[5]), cvtpk(pA1[6], pA1[7])};
        pw3 = (u32x4){cvtpk(pA1[8], pA1[9]), cvtpk(pA1[10], pA1[11]), cvtpk(pA1[12], pA1[13]), cvtpk(pA1[14], pA1[15])};
        const lds_cptr vp_ = vp0 + vs_prev;
#pragma unroll
        for (int i = 0; i < 8; ++i) VRD(i);
        o[0] = __builtin_amdgcn_mfma_f32_32x32x16_bf16(PAF(0), VFR(0), o[0], 0, 0, 0); o[1] = __builtin_amdgcn_mfma_f32_32x32x16_bf16(PAF(0), VFR(4), o[1], 0, 0, 0);
        o[0] = __builtin_amdgcn_mfma_f32_32x32x16_bf16(PAF(1), VFR(1), o[0], 0, 0, 0); o[1] = __builtin_amdgcn_mfma_f32_32x32x16_bf16(PAF(1), VFR(5), o[1], 0, 0, 0);
        o[0] = __builtin_amdgcn_mfma_f32_32x32x16_bf16(PAF(2), VFR(2), o[0], 0, 0, 0); o[1] = __builtin_amdgcn_mfma_f32_32x32x16_bf16(PAF(2), VFR(6), o[1], 0, 0, 0);
        o[0] = __builtin_amdgcn_mfma_f32_32x32x16_bf16(PAF(3), VFR(3), o[0], 0, 0, 0); o[1] = __builtin_amdgcn_mfma_f32_32x32x16_bf16(PAF(3), VFR(7), o[1], 0, 0, 0);
    }
    l_reg = fa::xhalf_sum(l_reg);
    if (MODE == 1 || MODE == 3) l_reg += __builtin_amdgcn_exp2f(sink2 - mhat);
    if (hi == 0) wsf[32 + r32] = 1.0f / l_reg;
    float rli[16];
#pragma unroll
    for (int r = 0; r < 16; ++r) rli[r] = wsf[32 + crow(r, hi)];
    bf16_t* stg = (bf16_t*)(shm + LDS_OST) + wid * 2048;
#pragma unroll
    for (int r = 0; r < 16; ++r) { const int orow = crow(r, hi);
#pragma unroll
        for (int dh = 0; dh < 2; ++dh) stg[orow * 64 + dh * 32 + r32] = (bf16_t)f2bf(o[dh][r] * rli[r]); }
#pragma unroll
    for (int i = 0; i < 4; ++i) { const int row = i * 8 + (lane >> 3), ch = lane & 7; const u32x4 v = *(const u32x4*)(stg + row * 64 + ch * 8); *(u32x4*)(Og + (size_t)(wid * 32 + row) * D + ch * 8) = v; }
    asm volatile("s_waitcnt vmcnt(0) lgkmcnt(0)\n\ts_barrier" ::: "memory");
#undef FA_KEY0
#undef DMA_K
#undef DMA_V
#undef WAIT_STEP
#undef MASK
#undef ROWMAX
#undef KLOAD
#undef KLOAD2
#undef ROT
#undef RESC
#undef VRD
#undef VFR
#undef PAF
#undef GAPA
#undef EX
#undef GAPB
#undef KRD
#undef STEP
}
#undef SBAR
#undef PIN
}

constexpr float SCALE_MLA = 0.10206207261596575f;
__device__ __forceinline__ void ph_attn(const Params& p, int layer, bool with_ctx, char* shm) {
    const QKVB qb = make_qkv(p.ws);
    bf16_t* O = (bf16_t*)(p.ws + WS_P);
    const int G = gridDim.x;
    const float NEG = -INFINITY;
    for (int u = blockIdx.x; u < 256; u += G) { const int bh = u & 7, b = bh >> 2, h = bh & 3, qbk = u >> 3;
        fa2::attn_unit<96, 0, 6>(qb.QD + ((size_t)bh * SEQ + qbk * 256) * 96, qb.KD + (size_t)bh * KEYS * 96, qb.VD + (size_t)bh * KEYS * 64, O + (size_t)(b * SEQ + qbk * 256) * D + 768 + h * 64, qbk * 256, NEG, nullptr, shm); }
    for (int u = blockIdx.x; u < 256; u += G) { const int bh = u & 7, b = bh >> 2, h = bh & 3, qbk = u >> 3;
        fa2::attn_unit<64, 0, 6>(qb.QB + ((size_t)bh * SEQ + qbk * 256) * 64, qb.KB + (size_t)(b * 2 + (h >> 1)) * KEYS * 64, qb.VB + (size_t)(b * 2 + (h >> 1)) * KEYS * 64, O + (size_t)(b * SEQ + qbk * 256) * D + 256 + h * 64, qbk * 256, NEG, nullptr, shm); }
    for (int u = blockIdx.x; u < 256; u += G) { const int bh = u & 7, b = bh >> 2, h = bh & 3, qbk = u >> 3;
        fa2::attn_unit<64, 1, 6>(qb.QA + ((size_t)bh * SEQ + qbk * 256) * 64, qb.KA + (size_t)(b * 2 + (h >> 1)) * KEYS * 64, qb.VA + (size_t)(b * 2 + (h >> 1)) * KEYS * 64, O + (size_t)(b * SEQ + qbk * 256) * D + 0 + h * 64, qbk * 256, p.in[11][layer * 4 + h] * fa::LOG2E, nullptr, shm); }
    for (int u = blockIdx.x; u < 256; u += G) { const int bh = u & 7, b = bh >> 2, h = bh & 3, qbk = u >> 3;
        fa2::attn_unit<64, 2, 6>(qb.QC + ((size_t)bh * SEQ + qbk * 256) * 64, qb.KC + (size_t)bh * KEYS * 64, qb.VC + (size_t)bh * KEYS * 64, O + (size_t)(b * SEQ + qbk * 256) * D + 512 + h * 64, qbk * 256, NEG, p.in[16] + ((size_t)layer * 4 + h) * 15 * 31, shm); }
    if (with_ctx) for (int u = blockIdx.x; u < 32; u += G) { const int ty = u >> 3, bh = u & 7, b = bh >> 2, h = bh & 3;
        bf16_t* Oc = O + (size_t)(TL + b * CTX) * D + ty * 256 + h * 64;
        if (ty == 0) fa2::attn_unit<64, 3, 6>(qb.QAc + (size_t)bh * CTX * 64, qb.KA + (size_t)(b * 2 + (h >> 1)) * KEYS * 64, qb.VA + (size_t)(b * 2 + (h >> 1)) * KEYS * 64, Oc, 0, p.in[11][layer * 4 + h] * fa::LOG2E, nullptr, shm);
        else if (ty == 1) fa2::attn_unit<64, 3, 6>(qb.QBc + (size_t)bh * CTX * 64, qb.KB + (size_t)(b * 2 + (h >> 1)) * KEYS * 64, qb.VB + (size_t)(b * 2 + (h >> 1)) * KEYS * 64, Oc, 0, NEG, nullptr, shm);
        else if (ty == 2) fa2::attn_unit<64, 3, 6>(qb.QCc + (size_t)bh * CTX * 64, qb.KC + (size_t)bh * KEYS * 64, qb.VC + (size_t)bh * KEYS * 64, Oc, 0, NEG, nullptr, shm);
        else fa2::attn_unit<96, 3, 6>(qb.QDc + (size_t)bh * CTX * 96, qb.KD + (size_t)bh * KEYS * 96, qb.VD + (size_t)bh * KEYS * 64, Oc, 0, NEG, nullptr, shm); }
}

__device__ __forceinline__ void ph_gnorm(const Params& p, int layer, int nrows) {
    const int tx = opq((int)threadIdx.x), lane = tx & 63, gw = (blockIdx.x * 512 + tx) >> 6, ngw = (gridDim.x * 512) >> 6;
    const bf16_t* O = (const bf16_t*)(p.ws + WS_P); bf16_t* Y = (bf16_t*)(p.ws + WS_ACT1); const float* g = p.in[23] + layer * D;
    for (int m = gw; m < nrows; m += ngw) {
#pragma unroll
        for (int grp = 0; grp < 4; ++grp) { const int c = grp * 256 + 4 * lane; const u32x2 w = *(const u32x2*)(O + (size_t)m * D + c);
            const float a0 = bflo(w.x), a1 = bfhi(w.x), a2 = bflo(w.y), a3 = bfhi(w.y);
            const float r = rsqrtf(wave_sum(a0 * a0 + a1 * a1 + a2 * a2 + a3 * a3) * (1.f / 256.f) + EPS);
            const f32x4 gv = *(const f32x4*)(g + c); u32x2 o; o.x = pk2(a0 * r * gv.x, a1 * r * gv.y); o.y = pk2(a2 * r * gv.z, a3 * r * gv.w);
            *(u32x2*)(Y + (size_t)m * D + c) = o; }
    }
}

__device__ __forceinline__ void moe_bases(const unsigned* cnt, int (&base)[9]) {
    int acc = 0;
#pragma unroll
    for (int e = 0; e < 8; ++e) { base[e] = acc; acc += ((int)cnt[64 * e] + 255) / 256 * 256; }
    base[8] = acc;
}
__device__ __forceinline__ void ph_moe_gather(const Params& p) {
    const int tx = opq((int)threadIdx.x), lane = tx & 63, gw = (blockIdx.x * 512 + tx) >> 6, ngw = (gridDim.x * 512) >> 6;
    const unsigned* cnt = (const unsigned*)(p.ws + WS_CTL); int base[9]; moe_bases(cnt, base);
    if (blockIdx.x == 0 && tx < 136) { const int r = tx * 256; int e = -1;
#pragma unroll
        for (int i = 0; i < 8; ++i) if (r >= base[i] && r < base[i + 1]) e = i;
        ((int*)(p.ws + WS_TEXP))[tx] = e < 0 ? 0 : e; }
    const bf16_t* F = (const bf16_t*)(p.ws + WS_ACT1); bf16_t* A = (bf16_t*)(p.ws + WS_ASORT);
    for (int m = gw; m < TL; m += ngw) {
        const int2 e = ((const int2*)(p.ws + WS_TOKE))[m]; const int2 ps = ((const int2*)(p.ws + WS_TOKP))[m];
        int b0 = 0, b1 = 0;
#pragma unroll
        for (int i = 0; i < 8; ++i) { if (e.x == i) b0 = base[i]; if (e.y == i) b1 = base[i]; }
        const int s0 = b0 + ps.x, s1 = b1 + ps.y;
        const u32x4 v0 = *(const u32x4*)(F + (size_t)m * D + lane * 16), v1 = *(const u32x4*)(F + (size_t)m * D + lane * 16 + 8);
        *(u32x4*)(A + (size_t)s0 * D + lane * 16) = v0; *(u32x4*)(A + (size_t)s0 * D + lane * 16 + 8) = v1;
        *(u32x4*)(A + (size_t)s1 * D + lane * 16) = v0; *(u32x4*)(A + (size_t)s1 * D + lane * 16 + 8) = v1;
        if (lane == 0) ((int2*)(p.ws + WS_TOKS))[m] = make_int2(s0, s1);
    }
}
__device__ __forceinline__ void ph_moe_combine(const Params& p, int layer) {
    const size_t nthr = (size_t)gridDim.x * 512;
    for (size_t idx = (size_t)blockIdx.x * 512 + opq((int)threadIdx.x); idx < (size_t)TL * 256; idx += nthr) {
        const int m = (int)(idx >> 8), c = (int)(idx & 255) * 4;
        const int2 sl = ((const int2*)(p.ws + WS_TOKS))[m]; const float2 g = ((const float2*)(p.ws + WS_TOKG))[m];
        const bf16_t* Y = (const bf16_t*)(p.ws + WS_ASORT);
        const u32x2 a = *(const u32x2*)(Y + (size_t)sl.x * D + c), b = *(const u32x2*)(Y + (size_t)sl.y * D + c);
        const f32x4 ya = {bflo(a.x), bfhi(a.x), bflo(a.y), bfhi(a.y)}, yb = {bflo(b.x), bfhi(b.x), bflo(b.y), bfhi(b.y)};
        const float* mod = (const float*)(p.ws + WS_MOD) + (size_t)layer * 3 * 6144 + (m / SEQ) * 6144 + 5 * D;
        f32x4* o = (f32x4*)(p.out + (size_t)m * D + c);
        *o = *o + *(const f32x4*)(mod + c) * (ya * g.x + yb * g.y);
    }
}

#ifndef DBL_PHASE
#define DBL_PHASE (-1)
#endif
#ifndef FILL_Q_IN
#define FILL_Q_IN 0
#define FILL_Q_OUT 0
#define FILL_Q_UP 0
#define FILL_Q_DN 0
#endif
struct Args { Params p; int ph_lo, ph_hi; };
__global__ void __launch_bounds__(NWAVES * 64, 2) mega_fwd(Args args) {
    extern __shared__ __attribute__((aligned(16))) unsigned char lds[];
    LAS unsigned char* ldsl = (LAS unsigned char*)lds;
    for (int u = threadIdx.x; u < (LDS_BYTES - LDSCTL_OFF) / 4; u += NWAVES * 64) ((LAS unsigned*)(ldsl + LDSCTL_OFF))[u] = 0u;
    __syncthreads();
    XcdBarrier bar = xcd_barrier_post((unsigned*)(args.p.ws + WS_CTL) + CW_BAR, (volatile LAS unsigned*)(ldsl + MISC_OFF) + 8);
    const int lo = args.ph_lo, hi = args.ph_hi;
#pragma unroll 1
    for (int ph = lo; ph < hi; ++ph) {
      const int nrep = (ph == DBL_PHASE) ? 2 : 1;
#pragma unroll 1
      for (int rep_ = 0; rep_ < nrep; ++rep_) {
        if (rep_) xcd_barrier(bar);
        Params q = args.p; q.ws = opqp(args.p.ws); q.out = opqp(args.p.out);
        LAS unsigned char* ldq = (LAS unsigned char*)lds;
        const int l = ph >= 10 ? 1 : 0, st = ph == 0 ? -1 : (l ? ph - 10 : ph - 1);
        const bool last = (l == 1); const int nrows = last ? TL : MALL;
        const float* qmod = (const float*)(q.ws + WS_MOD) + (size_t)l * 3 * 6144;
        int fillq = 0, fill_nwg = 1;
        if (st == -1) ph_prologue(q, (float*)lds);
        else if (st == 0) ph_norm<1, false>(q, l, MALL, (unsigned*)lds);
        else if (st == 1) { run_gemm(ldq, (const bf16_t*)(q.ws + WS_ACT1), (const bf16_t*)(q.ws + WS_WIN) + (size_t)l * NINP * D, D, MALL / 256, NINP / 256, nullptr, 0, EpiBf16Perm{(bf16_t*)(q.ws + WS_P), NINP, 0});
                            fillq = FILL_Q_IN; fill_nwg = (MALL / 256) * (NINP / 256); }
        else if (st == 2) ph_postproj2(q, l);
        else if (st == 3) ph_attn(q, l, !last, (char*)lds);
        else if (st == 4) ph_gnorm(q, l, nrows);
        else if (st == 5) { run_gemm(ldq, (const bf16_t*)(q.ws + WS_ACT1), (const bf16_t*)(q.ws + WS_WOUT) + (size_t)l * D * D, D, nrows / 256, D / 256, nullptr, 0,
                                     EpiResid{(l == 0) ? q.in[0] : q.out, (l == 0) ? q.in[2] : (const float*)(q.ws + WS_HCTX), q.out, (float*)(q.ws + WS_HCTX), qmod, 2 * D, 0});
                            fillq = FILL_Q_OUT; fill_nwg = (nrows / 256) * (D / 256); }
        else if (!last) {
            if (st == 6) ph_norm<2, false>(q, l, MALL, (unsigned*)lds);
            else if (st == 7) { run_gemm(ldq, (const bf16_t*)(q.ws + WS_ACT1), (const bf16_t*)(q.ws + WS_WFGU), D, MALL / 256, 2 * DFF / 256, nullptr, 0, EpiSwiglu{(bf16_t*)(q.ws + WS_HIDF), DFF, 0});
                                fillq = FILL_Q_UP; fill_nwg = (MALL / 256) * (2 * DFF / 256); }
            else { run_gemm(ldq, (const bf16_t*)(q.ws + WS_HIDF), (const bf16_t*)(q.ws + WS_WFDN), DFF, MALL / 256, D / 256, nullptr, 0,
                            EpiResid{q.out, (const float*)(q.ws + WS_HCTX), q.out, (float*)(q.ws + WS_HCTX), qmod, 5 * D, 0});
                   fillq = FILL_Q_DN; fill_nwg = (MALL / 256) * (D / 256); }
        } else {
            if (st == 6) ph_norm<2, true>(q, l, TL, (unsigned*)lds);
            else if (st == 7) { ph_moe_gather(q); fillq = 1 << 30; fill_nwg = 0; }
            else if (st == 8) { int base[9]; moe_bases((const unsigned*)(q.ws + WS_CTL), base); run_gemm(ldq, (const bf16_t*)(q.ws + WS_ASORT), (const bf16_t*)(q.ws + WS_WMGU), D, __builtin_amdgcn_readfirstlane(base[8] / 256), 2 * DFFE / 256, (const int*)(q.ws + WS_TEXP), (size_t)2 * DFFE * D * 2, EpiSwiglu{(bf16_t*)(q.ws + WS_HIDM), DFFE, 0}); }
            else if (st == 9) { int base[9]; moe_bases((const unsigned*)(q.ws + WS_CTL), base); run_gemm(ldq, (const bf16_t*)(q.ws + WS_HIDM), (const bf16_t*)(q.ws + WS_WMDN), DFFE, __builtin_amdgcn_readfirstlane(base[8] / 256), D / 256, (const int*)(q.ws + WS_TEXP), (size_t)D * DFFE * 2, EpiBf16Perm{(bf16_t*)(q.ws + WS_ASORT), D, 0}); }
            else ph_moe_combine(q, l);
        }
        if (fillq > 0 && (fill_nwg == 0 || gemm_tail_idle(fill_nwg))) fill_moe(q, (float*)lds, fillq);
      }
      if (ph + 1 < hi) xcd_barrier(bar);
    }
}

#ifndef MK_CUTS
#define MK_CUTS 0
#endif
extern "C" void kernel_launch(void* const* d_in, const int* in_sizes, int n_in, void* d_out, int out_size, void* d_ws, size_t ws_size, hipStream_t stream) {
    static int grid = 0;
    if (grid == 0) {
        if (n_in != 32 || ws_size < WS_END) { fprintf(stderr, "kernel_launch: need 32 inputs and %zu bytes of workspace (got %d, %zu)\n", (size_t)WS_END, n_in, ws_size); grid = -1; return; }
        int dev = 0, cus = 0, per_cu = 0;
        if (hipGetDevice(&dev) != hipSuccess || hipDeviceGetAttribute(&cus, hipDeviceAttributeMultiprocessorCount, dev) != hipSuccess) { grid = -1; return; }
        if (hipFuncSetAttribute((const void*)mega_fwd, hipFuncAttributeMaxDynamicSharedMemorySize, LDS_BYTES) != hipSuccess) { fprintf(stderr, "kernel_launch: hipFuncSetAttribute failed\n"); grid = -1; return; }
        if (hipOccupancyMaxActiveBlocksPerMultiprocessor(&per_cu, (const void*)mega_fwd, NWAVES * 64, LDS_BYTES) != hipSuccess || per_cu < 1) fprintf(stderr, "kernel_launch: occupancy query says %d blocks per CU\n", per_cu);
        (void)hipGetLastError();
        grid = cus;
    }
    if (grid < 0) return;
    (void)hipMemsetAsync((char*)d_ws + WS_CTL, 0, CTL_ZERO_BYTES, stream);
    Args a{}; for (int i = 0; i < 32; ++i) a.p.in[i] = (const float*)d_in[i]; a.p.out = (float*)d_out; a.p.ws = (unsigned char*)d_ws;
#if MK_CUTS
    for (int ph = 0; ph < 24; ++ph) { a.ph_lo = ph; a.ph_hi = ph + 1; hipLaunchKernelGGL(mega_fwd, dim3(grid), dim3(NWAVES * 64), LDS_BYTES, stream, a); }
#else
    a.ph_lo = 0; a.ph_hi = 21;
    hipLaunchKernelGGL(mega_fwd, dim3(grid), dim3(NWAVES * 64), LDS_BYTES, stream, a);
#endif
}
```

```cpp
#include <hip/hip_runtime.h>
#include <stdint.h>
#include <cstdio>

typedef unsigned short bf16_t;
typedef float f32x4 __attribute__((ext_vector_type(4)));
typedef unsigned u32x4 __attribute__((ext_vector_type(4)));
typedef unsigned u32x2 __attribute__((ext_vector_type(2)));

constexpr int D = 1024, NB = 2, SEQ = 8192, CTX = 256, TL = NB * SEQ, TC = NB * CTX, MALL = TL + TC;
constexpr int NIN = 2144, NINP = 2304, DFF = 2816, NE = 8, DFFE = 3584, KEYS = CTX + SEQ;
constexpr int OFF_AQ = 0, OFF_AK = 256, OFF_AV = 384, OFF_BQ = 512, OFF_BK = 768, OFF_BV = 896, OFF_CQ = 1024, OFF_CK = 1280,
              OFF_CV = 1536, OFF_DCQ = 1792, OFF_DCKV = 1984, OFF_DKR = 2112;
constexpr int MOE_ROWS = 34816;
constexpr float EPS = 1e-6f;

constexpr size_t MiB = 1u << 20;
constexpr size_t WS_CTL = 0;
constexpr size_t WS_MOD = 1 * MiB;
constexpr size_t WS_ROPE = WS_MOD + 256 * 1024;
constexpr size_t WS_TOKE = WS_ROPE + 64 * 1024;
constexpr size_t WS_TOKP = WS_TOKE + TL * 8;
constexpr size_t WS_TOKG = WS_TOKP + TL * 8;
constexpr size_t WS_TEXP = WS_TOKG + TL * 8;
constexpr size_t WS_TOKS = WS_TEXP + 1024;
constexpr size_t WS_HCTX = 2 * MiB;
constexpr size_t WS_WMGU = 6 * MiB;
constexpr size_t WS_WMDN = WS_WMGU + 112 * MiB;
constexpr size_t WS_WDEAD = WS_WMDN + 56 * MiB;
constexpr size_t WS_WIN = WS_WDEAD;
constexpr size_t WS_WOUT = WS_WIN + 9 * MiB;
constexpr size_t WS_WUQ = WS_WOUT + 4 * MiB;
constexpr size_t WS_WUKV = WS_WUQ + 512 * 1024;
constexpr size_t WS_WFGU = WS_WUKV + 512 * 1024;
constexpr size_t WS_WFDN = WS_WFGU + 11 * MiB;
constexpr size_t WS_ACT = 205 * MiB;
static_assert(WS_WFDN + (size_t)1024 * 2816 * 2 <= WS_ACT, "weights fit");
constexpr size_t WS_ACT1 = WS_ACT;
constexpr size_t WS_P = WS_ACT + 33 * MiB;
constexpr size_t WS_QKV = WS_ACT + 108 * MiB;
constexpr size_t WS_PART = WS_ACT + 128 * MiB;
constexpr size_t WS_HIDF = WS_P;
constexpr size_t WS_HIDM = WS_WDEAD;
constexpr size_t WS_ASORT = WS_HIDM + 238 * MiB;
constexpr size_t WS_END = WS_ASORT + 68 * MiB;
static_assert(WS_QKV + 91 * MiB <= WS_END, "qkv fits");

struct Params { const float* in[32]; float* out; unsigned char* ws; };

struct QKVB { bf16_t *QA, *KA, *VA, *QB, *KB, *VB, *QC, *KC, *VC, *QD, *KD, *VD, *QAc, *QBc, *QCc, *QDc; };
__host__ __device__ inline QKVB make_qkv(unsigned char* ws) {
    QKVB q; bf16_t* p = (bf16_t*)(ws + WS_QKV);
    q.QA = p; p += (size_t)NB * 4 * SEQ * 64; q.KA = p; p += (size_t)NB * 2 * KEYS * 64; q.VA = p; p += (size_t)NB * 2 * KEYS * 64;
    q.QB = p; p += (size_t)NB * 4 * SEQ * 64; q.KB = p; p += (size_t)NB * 2 * KEYS * 64; q.VB = p; p += (size_t)NB * 2 * KEYS * 64;
    q.QC = p; p += (size_t)NB * 4 * SEQ * 64; q.KC = p; p += (size_t)NB * 4 * KEYS * 64; q.VC = p; p += (size_t)NB * 4 * KEYS * 64;
    q.QD = p; p += (size_t)NB * 4 * SEQ * 96; q.KD = p; p += (size_t)NB * 4 * KEYS * 96; q.VD = p; p += (size_t)NB * 4 * KEYS * 64;
    q.QAc = p; p += (size_t)NB * 4 * CTX * 64; q.QBc = p; p += (size_t)NB * 4 * CTX * 64; q.QCc = p; p += (size_t)NB * 4 * CTX * 64;
    q.QDc = p; p += (size_t)NB * 4 * CTX * 96;
    return q;
}

__device__ __forceinline__ float bf2f(unsigned v) { return __uint_as_float(v << 16); }
__device__ __forceinline__ float bflo(unsigned w) { return __uint_as_float(w << 16); }
__device__ __forceinline__ float bfhi(unsigned w) { return __uint_as_float(w & 0xffff0000u); }
__device__ __forceinline__ unsigned f2bf(float f) { unsigned u = __float_as_uint(f); return (u + 0x7fffu + ((u >> 16) & 1u)) >> 16; }
__device__ __forceinline__ unsigned pk2(float lo, float hi) { return f2bf(lo) | (f2bf(hi) << 16); }
template <int X> __device__ __forceinline__ float swz_xor(float v) { return __int_as_float(__builtin_amdgcn_ds_swizzle(__float_as_int(v), 0x1f | (X << 10))); }
__device__ __forceinline__ float half_sum(float v) { auto rr = __builtin_amdgcn_permlane32_swap(__float_as_uint(v), __float_as_uint(v), false, false); return __uint_as_float(rr[0]) + __uint_as_float(rr[1]); }
__device__ __forceinline__ float half_other(float v, int lane) { auto rr = __builtin_amdgcn_permlane32_swap(__float_as_uint(v), __float_as_uint(v), false, false); return __uint_as_float((lane & 32) ? rr[0] : rr[1]); }
__device__ __forceinline__ float wave_sum(float v) { v += swz_xor<1>(v); v += swz_xor<2>(v); v += swz_xor<4>(v); v += swz_xor<8>(v); v += swz_xor<16>(v); return half_sum(v); }
__device__ __forceinline__ int opq(int v) { asm volatile("" : "+v"(v)); return v; }
template <class T> __device__ __forceinline__ T* opqp(T* p) { asm volatile("" : "+s"(p)); return p; }
__device__ __forceinline__ int opqs(int v) { asm volatile("" : "+s"(v)); return v; }
__device__ __forceinline__ float silu_f(float x) { return x / (1.f + expf(-x)); }

constexpr int RT_R64 = 0, RT_C64 = 2048, RT_R32 = 3072, RT_C32 = 4096, RT_N = 4608;

namespace pg8 {
#define PG8_LAS __attribute__((address_space(3)))
typedef unsigned short bf16_t;
typedef short bf16x8 __attribute__((ext_vector_type(8)));
typedef float f32x4 __attribute__((ext_vector_type(4)));
typedef unsigned u32x4 __attribute__((ext_vector_type(4)));
constexpr int BM = 256, BK = 64, HALF = 128, HTB = HALF * BK * 2  , STAGE_BYTES = 8 * HTB, NXCD = 8, WGM = 8;

__host__ __device__ __forceinline__ int lds_byte(int r, int c) { const int st = (r >> 4) * 2 + (c >> 5), rr = r & 15, cc = c & 31, ob = rr * 64 + cc * 2; return st * 1024 + (ob ^ (((ob >> 9) & 1) << 5)); }
__host__ __device__ __forceinline__ void stage_rc(int b, int& R, int& C) { const int st = b / 1024, sb = b % 1024, swz = sb ^ (((sb >> 9) & 1) << 5); R = (st >> 1) * 16 + swz / 64; C = (st & 1) * 32 + (swz % 64) / 2; }
__host__ __device__ __forceinline__ int perm32(int rho) { const int n = rho >> 4, i = rho & 15; return 8 * (i >> 2) + 4 * n + (i & 3); }

struct Unit { int pm, pn, e, ks; };
struct Gemm { const bf16_t* A; const bf16_t* Bt; int K; size_t estride; int Kloop; };

struct StaticOrder {
    int nM, nN, nwg, G, c, S, pm0; const int* texp;
    __host__ __device__ void init(int nM_, int nN_, int G_, int c_, const int* texp_, int S_ = 1, int pm0_ = 0) { nM = nM_; nN = nN_; nwg = nM * nN; G = G_; c = c_; texp = texp_; S = S_; pm0 = pm0_; }
    __host__ __device__ bool next(int i, Unit& u) const {
        const long L = (long)i * G + c; if (L >= (long)nwg * S) return false;
        u.ks = (int)(L % S); int wgid = (int)(L / S); { const int q = nwg / NXCD, r = nwg % NXCD, xcd = wgid % NXCD, off = wgid / NXCD; wgid = (xcd < r ? xcd * (q + 1) : r * (q + 1) + (xcd - r) * q) + off; }
        const int nig = WGM * nN, gid = wgid / nig, fm = gid * WGM, gsz = (nM - fm) < WGM ? (nM - fm) : WGM;
        u.pm = fm + ((wgid % nig) % gsz); u.pn = (wgid % nig) / gsz; u.e = texp ? texp[u.pm] : 0; u.pm += pm0; return true;
    }
    __device__ __forceinline__ void a_ready(const Unit&) const {}
    __device__ __forceinline__ void done(const Unit&) const {}
};

template <class Epi, class Sched, bool ALIGN_EPI = false, bool SP2 = false>
__device__ __forceinline__ void gemm_phase(PG8_LAS unsigned char* lds, const Gemm g, const Sched& S, const Epi& E) {
    const int tid = opq((int)threadIdx.x), wid = __builtin_amdgcn_readfirstlane(tid >> 6), lane = tid & 63, wr = wid >> 2, wc = wid & 3, fr = lane & 15, fq = lane >> 4;
    const int K = g.K, nt = g.Kloop / BK;
    unsigned voffA[2], voffB[2];
#pragma unroll
    for (int i = 0; i < 2; ++i) { int R, C; stage_rc(tid * 16 + i * 8192, R, C); const int Rb = Epi::PERM ? ((R & ~31) + perm32(R & 31)) : R;
        voffA[i] = (unsigned)(R * K + C) * 2u; voffB[i] = (unsigned)(Rb * K + C) * 2u; }
    const size_t kstep = (size_t)(BK * 2);
    const size_t hstep = (size_t)HALF * K * 2;
    const size_t tstep = 2 * hstep;
    const unsigned ldsw = (unsigned)wid * 1024u;
    const int aoff = lds_byte(wr * 64 + fr, fq * 8), boff = lds_byte(wc * 32 + fr, fq * 8);
#define PG8_SA(b, h) (((b) * 2 + (h)) * HTB)
#define PG8_SB(b, h) ((4 + (b) * 2 + (h)) * HTB)
#define PG8_STAGE(bufoff, gbase, voff) do { _Pragma("unroll") for (int _i = 0; _i < 2; ++_i) \
        __builtin_amdgcn_global_load_lds((const unsigned*)((const char*)(gbase) + (voff)[_i]), (PG8_LAS unsigned*)(lds + (bufoff) + ldsw + _i * 8192), 16, 0, 0); } while (0)
#define PG8_LDA(dst, b, h) do { _Pragma("unroll") for (int m = 0; m < 4; ++m) _Pragma("unroll") for (int k = 0; k < 2; ++k) dst[m][k] = *(const PG8_LAS bf16x8*)(lds + PG8_SA(b, h) + aoff + m * 2048 + k * 1024); } while (0)
#define PG8_LDB(dst, b, h) do { _Pragma("unroll") for (int n = 0; n < 2; ++n) _Pragma("unroll") for (int k = 0; k < 2; ++k) dst[n][k] = *(const PG8_LAS bf16x8*)(lds + PG8_SB(b, h) + boff + n * 2048 + k * 1024); } while (0)
#define PG8_MMA(ai, bj, At, Bt) do { __builtin_amdgcn_s_setprio(1); _Pragma("unroll") for (int m = 0; m < 4; ++m) _Pragma("unroll") for (int n = 0; n < 2; ++n) _Pragma("unroll") for (int k = 0; k < 2; ++k) \
        acc[ai][bj][m][n] = __builtin_amdgcn_mfma_f32_16x16x32_bf16(Bt[n][k], At[m][k], acc[ai][bj][m][n], 0, 0, 0); __builtin_amdgcn_s_setprio(0); } while (0)
#define PG8_WAIT_V(n) asm volatile("s_waitcnt vmcnt(" #n ")" ::: "memory")
#define PG8_WAIT_L(n) asm volatile("s_waitcnt lgkmcnt(" #n ")" ::: "memory")
#define PG8_BAR __builtin_amdgcn_s_barrier()
#define PG8_SCHED __builtin_amdgcn_sched_barrier(0)
    Unit cur, nxt; int ui = 0;
    if (!S.next(0, cur)) return;
    f32x4 acc[2][2][4][2];
#pragma unroll
    for (int a = 0; a < 2; ++a)
#pragma unroll
        for (int b = 0; b < 2; ++b)
#pragma unroll
            for (int m = 0; m < 4; ++m)
#pragma unroll
                for (int n = 0; n < 2; ++n) acc[a][b][m][n] = (f32x4){0.f, 0.f, 0.f, 0.f};
    bf16x8 At[4][2], B0[2][2], B1[2][2];
    const char* cA = (const char*)g.A + (size_t)cur.pm * tstep + (size_t)cur.ks * g.Kloop * 2; const char* cB = (const char*)g.Bt + (size_t)cur.e * g.estride + (size_t)cur.pn * tstep + (size_t)cur.ks * g.Kloop * 2;
    S.a_ready(cur);
    if constexpr (SP2) {
        PG8_STAGE(PG8_SB(0, 0), cB, voffB); PG8_STAGE(PG8_SB(0, 1), cB + hstep, voffB); PG8_STAGE(PG8_SA(0, 0), cA, voffA); PG8_STAGE(PG8_SA(0, 1), cA + hstep, voffA);
        if (wr == 1) PG8_BAR;
        PG8_WAIT_V(2); PG8_BAR;
        PG8_STAGE(PG8_SB(1, 0), cB + kstep, voffB); PG8_STAGE(PG8_SA(1, 0), cA + kstep, voffA); PG8_STAGE(PG8_SB(1, 1), cB + hstep + kstep, voffB);
        PG8_WAIT_V(6); PG8_BAR;
    } else {
        PG8_STAGE(PG8_SB(0, 0), cB, voffB); PG8_STAGE(PG8_SA(0, 0), cA, voffA); PG8_STAGE(PG8_SB(0, 1), cB + hstep, voffB); PG8_STAGE(PG8_SA(0, 1), cA + hstep, voffA);
        if (wr == 1) PG8_BAR;
        PG8_WAIT_V(4); PG8_BAR;
        PG8_STAGE(PG8_SB(1, 0), cB + kstep, voffB); PG8_STAGE(PG8_SA(1, 0), cA + kstep, voffA); PG8_STAGE(PG8_SB(1, 1), cB + hstep + kstep, voffB);
        PG8_WAIT_V(6); PG8_BAR;
    }
    for (;;) {
        const bool has_next = S.next(ui + 1, nxt);
        const char* nA = has_next ? (const char*)g.A + (size_t)nxt.pm * tstep + (size_t)nxt.ks * g.Kloop * 2 : cA; const char* nB = has_next ? (const char*)g.Bt + (size_t)nxt.e * g.estride + (size_t)nxt.pn * tstep + (size_t)nxt.ks * g.Kloop * 2 : cB;
        for (int t = 0; t < nt; t += 2) {
            const bool last = (t == nt - 2);
            const char* a1 = cA + (size_t)(t + 1) * kstep;
            const char* a2 = last ? nA : cA + (size_t)(t + 2) * kstep; const char* b2 = last ? nB : cB + (size_t)(t + 2) * kstep;
            const char* a3 = a2 + kstep; const char* b3 = b2 + kstep;
            if (last && has_next) S.a_ready(nxt);
            if constexpr (SP2) {
            PG8_LDB(B0, 0, 0); PG8_LDB(B1, 0, 1); PG8_SCHED; PG8_LDA(At, 0, 0); PG8_STAGE(PG8_SA(1, 1), a1 + hstep, voffA);
            PG8_WAIT_V(8); PG8_WAIT_L(0); PG8_BAR; PG8_MMA(0, 0, At, B0); PG8_MMA(0, 1, At, B1); PG8_BAR; PG8_SCHED;
            PG8_LDA(At, 0, 1); PG8_STAGE(PG8_SB(0, 0), b2, voffB); PG8_STAGE(PG8_SB(0, 1), b2 + hstep, voffB); PG8_STAGE(PG8_SA(0, 0), a2, voffA);
            PG8_WAIT_V(8); PG8_WAIT_L(0); PG8_BAR; PG8_MMA(1, 0, At, B0); PG8_MMA(1, 1, At, B1); PG8_BAR; PG8_SCHED;
            PG8_LDB(B0, 1, 0); PG8_LDB(B1, 1, 1); PG8_SCHED; PG8_LDA(At, 1, 0); PG8_STAGE(PG8_SA(0, 1), a2 + hstep, voffA);
            PG8_WAIT_V(8); PG8_WAIT_L(0); PG8_BAR; PG8_MMA(0, 0, At, B0); PG8_MMA(0, 1, At, B1); PG8_BAR; PG8_SCHED;
            PG8_LDA(At, 1, 1); PG8_STAGE(PG8_SB(1, 0), b3, voffB); PG8_STAGE(PG8_SB(1, 1), b3 + hstep, voffB); PG8_STAGE(PG8_SA(1, 0), a3, voffA);
            PG8_WAIT_V(8); PG8_WAIT_L(0); PG8_BAR; PG8_MMA(1, 0, At, B0); PG8_MMA(1, 1, At, B1); PG8_BAR; PG8_SCHED;
            } else {
            PG8_LDB(B0, 0, 0); PG8_SCHED; PG8_LDA(At, 0, 0); PG8_STAGE(PG8_SA(1, 1), a1 + hstep, voffA);
            PG8_WAIT_L(8); PG8_BAR; PG8_WAIT_L(0); PG8_MMA(0, 0, At, B0); PG8_BAR; PG8_SCHED;
            PG8_LDB(B1, 0, 1); PG8_STAGE(PG8_SB(0, 0), b2, voffB);
            PG8_BAR; PG8_WAIT_L(0); PG8_MMA(0, 1, At, B1); PG8_BAR;
            PG8_LDA(At, 0, 1); PG8_STAGE(PG8_SA(0, 0), a2, voffA);
            PG8_BAR; PG8_WAIT_L(0); PG8_MMA(1, 0, At, B0); PG8_BAR; PG8_SCHED;
            PG8_STAGE(PG8_SB(0, 1), b2 + hstep, voffB);
            PG8_WAIT_V(6); PG8_BAR; PG8_MMA(1, 1, At, B1); PG8_BAR;
            PG8_LDB(B0, 1, 0); PG8_SCHED; PG8_LDA(At, 1, 0); PG8_STAGE(PG8_SA(0, 1), a2 + hstep, voffA);
            PG8_WAIT_L(8); PG8_BAR; PG8_WAIT_L(0); PG8_MMA(0, 0, At, B0); PG8_BAR; PG8_SCHED;
            PG8_LDB(B1, 1, 1); PG8_STAGE(PG8_SB(1, 0), b3, voffB);
            PG8_BAR; PG8_WAIT_L(0); PG8_MMA(0, 1, At, B1); PG8_BAR;
            PG8_LDA(At, 1, 1); PG8_STAGE(PG8_SA(1, 0), a3, voffA);
            PG8_BAR; PG8_WAIT_L(0); PG8_MMA(1, 0, At, B0); PG8_BAR; PG8_SCHED;
            PG8_STAGE(PG8_SB(1, 1), b3 + hstep, voffB);
            PG8_WAIT_V(6); PG8_BAR; PG8_MMA(1, 1, At, B1); PG8_BAR;
            }
        }
        if constexpr (ALIGN_EPI) { if (wr == 0) PG8_BAR; }
        if constexpr (!Epi::AFTER_DRAIN) { E(acc, cur, wr, wc, fr, fq); S.done(cur); }
        if (!has_next) break;
#pragma unroll
        for (int a = 0; a < 2; ++a)
#pragma unroll
            for (int b = 0; b < 2; ++b)
#pragma unroll
                for (int m = 0; m < 4; ++m)
#pragma unroll
                    for (int n = 0; n < 2; ++n) acc[a][b][m][n] = (f32x4){0.f, 0.f, 0.f, 0.f};
        cur = nxt; cA = nA; cB = nB; ++ui;
        if constexpr (ALIGN_EPI) { if (wr == 1) PG8_BAR; }
    }
    PG8_WAIT_V(0);
    if constexpr (!ALIGN_EPI) { if (wr == 0) PG8_BAR; }
    PG8_BAR;
    if constexpr (Epi::AFTER_DRAIN) { E.fused(acc, cur, wr, wc, fr, fq, lds, wid, lane); S.done(cur); }
#undef PG8_SA
#undef PG8_SB
#undef PG8_STAGE
#undef PG8_LDA
#undef PG8_LDB
#undef PG8_MMA
#undef PG8_WAIT_V
#undef PG8_WAIT_L
#undef PG8_BAR
#undef PG8_SCHED
}
}

#define GAS __attribute__((address_space(1)))
#define LAS __attribute__((address_space(3)))
typedef GAS unsigned gu32;
#define RLX_AGENT __ATOMIC_RELAXED, __HIP_MEMORY_SCOPE_AGENT
constexpr int NWAVES = 8;
constexpr int CW_BAR = 4096;
constexpr int RING_BYTES = 131072, LDSCTL_OFF = RING_BYTES, MISC_OFF = LDSCTL_OFF + 320, LDS_BYTES = 147456;
constexpr size_t CTL_ZERO_BYTES = 65536;

#define XB_TMO      128
#define XB_XCNT(j)  (256  + 64 * (j))
#define XB_XSUB(j)  (1280 + 64 * (j))
#define XB_XGEN(j)  (2304 + 64 * (j))
#define XB_TOP      3328
#define XB_TOPGEN   3392
#define XCD_BAR_WORDS 3456
#define XB_SPIN_CAP (1u << 18)

__device__ __forceinline__ unsigned xb_ld(unsigned* p)              { return __hip_atomic_load(p, __ATOMIC_RELAXED, __HIP_MEMORY_SCOPE_AGENT); }
__device__ __forceinline__ unsigned xb_add(unsigned* p, unsigned v) { return __hip_atomic_fetch_add(p, v, __ATOMIC_RELAXED, __HIP_MEMORY_SCOPE_AGENT); }
__device__ __forceinline__ unsigned xb_xcc_id() { return (unsigned)__builtin_amdgcn_s_getreg((3 << 11) | 20) & 0xFu; }
#define XB_SPIN(cond, bar) do { unsigned _sp = 0; while (cond) { __builtin_amdgcn_s_sleep(1); \
    if ((++_sp & 255u) == 0u) { if (xb_ld(&(bar)[XB_TMO])) break; if (_sp > XB_SPIN_CAP) { atomicAdd(&(bar)[XB_TMO], 1u); break; } } } } while (0)

struct XcdBarrier {
    unsigned* bar; unsigned x;
    volatile LAS unsigned* st;
};

__device__ __forceinline__ XcdBarrier xcd_barrier_post(unsigned* bar, volatile LAS unsigned* st) {
    XcdBarrier b; b.bar = bar; b.x = xb_xcc_id(); b.st = st;
    if (threadIdx.x == 0) (void)xb_add(&bar[XB_XCNT(b.x)], 1u);
    return b;
}
__device__ __forceinline__ void xcd_barrier_complete(unsigned* bar, unsigned x, unsigned& nloc, unsigned& nx) {
    const unsigned G = gridDim.x * gridDim.y * gridDim.z;
    unsigned sum, cnt, mine, sp = 0u;
    for (;;) {
        sum = 0u; cnt = 0u; mine = 0u;
#pragma unroll
        for (unsigned j = 0; j < 16; ++j) { const unsigned c = xb_ld(&bar[XB_XCNT(j)]); sum += c; cnt += (c > 0u) ? 1u : 0u; mine = (j == x) ? c : mine; }
        if (sum == G) break;
        __builtin_amdgcn_s_sleep(1);
        if ((++sp & 255u) == 0u) { if (xb_ld(&bar[XB_TMO])) break; if (sp > XB_SPIN_CAP) { atomicAdd(&bar[XB_TMO], 1u); break; } }
    }
    nloc = mine > 0u ? mine : 1u; nx = cnt > 0u ? cnt : 1u;
}

__device__ __forceinline__ void xcd_barrier(const XcdBarrier& b) {
    asm volatile("s_waitcnt vmcnt(0)" ::: "memory");
    __syncthreads();
    if (threadIdx.x == 0) {
        unsigned* bar = b.bar;
        __builtin_amdgcn_s_waitcnt(0);
        unsigned nloc = b.st[0], nx = b.st[1];
        if (nloc == 0u) { xcd_barrier_complete(bar, b.x, nloc, nx); b.st[0] = nloc; b.st[1] = nx; }
        const unsigned old = xb_add(&bar[XB_XSUB(b.x)], 1u);
        const unsigned gen = old / nloc;
        if (old + 1u == (gen + 1u) * nloc) {
            __builtin_amdgcn_fence(__ATOMIC_RELEASE, "agent");
            asm volatile("s_waitcnt vmcnt(0)" ::: "memory");
            const unsigned og = xb_add(&bar[XB_TOP], 1u);
            const unsigned tg = og / nx;
            if (og + 1u == (tg + 1u) * nx) xb_add(&bar[XB_TOPGEN], 1u);
            else XB_SPIN(xb_ld(&bar[XB_TOPGEN]) == tg, bar);
            __builtin_amdgcn_fence(__ATOMIC_ACQUIRE, "agent");
            xb_add(&bar[XB_XGEN(b.x)], 1u);
            asm volatile("s_waitcnt vmcnt(0)" ::: "memory");
        } else {
            XB_SPIN(xb_ld(&bar[XB_XGEN(b.x)]) == gen, bar);
            __builtin_amdgcn_fence(__ATOMIC_ACQUIRE, "agent");
            asm volatile("s_waitcnt vmcnt(0)" ::: "memory");
        }
    }
    __syncthreads();
}


template <class F> struct EpiAdapt {
    static constexpr bool PERM = false, AFTER_DRAIN = false; F f;
    __device__ __forceinline__ void operator()(const pg8::f32x4 (&acc)[2][2][4][2], const pg8::Unit& u, int wr, int wc, int fr, int fq) const {
#pragma unroll
        for (int ai = 0; ai < 2; ++ai)
#pragma unroll
            for (int m = 0; m < 4; ++m) { const int row = u.pm * 256 + ai * 128 + wr * 64 + m * 16 + fr;
#pragma unroll
                for (int bj = 0; bj < 2; ++bj) f(row, u.pn * 8 + bj * 4 + wc, fq, acc[ai][bj][m][0], acc[ai][bj][m][1], u.ks);
                asm volatile("" ::: "memory"); }
    }
};
struct EpiBf16Perm { bf16_t* O; int ldo; int pad;
    __device__ __forceinline__ void operator()(int row, int g, int fq, f32x4 v0, f32x4 v1, int) const {
        u32x4 w; w.x = pk2(v0.x, v0.y); w.y = pk2(v0.z, v0.w); w.z = pk2(v1.x, v1.y); w.w = pk2(v1.z, v1.w);
        *(u32x4*)(O + (size_t)row * ldo + 32 * g + 8 * fq) = w; } };
struct EpiResid { const float* hl_in; const float* hc_in; float* hl_out; float* hc_out; const float* mod; int goff; int split;
    __device__ __forceinline__ void operator()(int row, int g, int fq, f32x4 v0, f32x4 v1, int ks) const {
        const int c0 = 32 * g + 4 * fq; const float* hin; float* hout; const float* gv;
        if (row < TL) { hin = hl_in + (size_t)row * D; hout = hl_out + (size_t)row * D; gv = mod + (row / SEQ) * 6144 + goff; }
        else { hin = hc_in + (size_t)(row - TL) * D; hout = hc_out + (size_t)(row - TL) * D; gv = mod + 2 * 6144 + goff; }
        if (split) { float* po = hout + (size_t)ks * TC * D; *(f32x4*)(po + c0) = *(const f32x4*)(gv + c0) * v0; *(f32x4*)(po + c0 + 16) = *(const f32x4*)(gv + c0 + 16) * v1; return; }
        *(f32x4*)(hout + c0) = *(const f32x4*)(hin + c0) + *(const f32x4*)(gv + c0) * v0;
        *(f32x4*)(hout + c0 + 16) = *(const f32x4*)(hin + c0 + 16) + *(const f32x4*)(gv + c0 + 16) * v1; } };
struct EpiSwiglu { bf16_t* H; int ldh; int pad;
    __device__ __forceinline__ void operator()(int row, int g, int fq, f32x4 v0, f32x4 v1, int) const {
        u32x2 w; w.x = pk2(silu_f(v0.x) * v1.x, silu_f(v0.y) * v1.y); w.y = pk2(silu_f(v0.z) * v1.z, silu_f(v0.w) * v1.w);
        *(u32x2*)(H + (size_t)row * ldh + 16 * g + 4 * fq) = w; } };

template <class F> __device__ __forceinline__ void run_gemm(LAS unsigned char* lds, const bf16_t* A, const bf16_t* Bt, int K, int nM, int nN, const int* texp, size_t estride_bytes, const F& f, int slices = 1, int pm0 = 0) {
    pg8::Gemm g{A, Bt, K, estride_bytes, K / slices}; pg8::StaticOrder S; S.init(nM, nN, opqs((int)gridDim.x), opqs((int)blockIdx.x), texp, slices, pm0);
    EpiAdapt<F> E{f};
    pg8::gemm_phase<EpiAdapt<F>, pg8::StaticOrder, true, true>(lds, g, S, E);
}
__device__ __forceinline__ bool gemm_tail_idle(int nwg) { const int G = opqs((int)gridDim.x), r = nwg % G; return r != 0 && opqs((int)blockIdx.x) >= r; }

__device__ __forceinline__ float conv_src(const Params& p, int mode, const float* W0, const float* W1, int N, int nvalid, int k, int nb) {
    if (mode == 0) return W0[(size_t)k * N + nb];
    if (mode == 1) { const int col = (nb & ~31) + 8 * ((nb >> 2) & 3) + 4 * ((nb >> 4) & 1) + (nb & 3); return col < nvalid ? W0[(size_t)k * N + col] : 0.f; }
    const int col = 16 * (nb >> 5) + (nb & 15); return ((nb >> 4) & 1) ? W1[(size_t)k * N + col] : W0[(size_t)k * N + col];
}
constexpr int CT_WIN = 0, CT_WOUT = 2304, CT_WUQ = 3328, CT_WUKV = 3400, CT_WFGU = 3464, CT_WFDN = 6280, CT_WMGU = 7688, CT_WMDN = 36360, CT_END = 50696;
constexpr int IT_MODS = 192, IT_ROPE = 9;
__device__ __forceinline__ void conv_item(const Params& p, int it, float* scr, int lane) {
    int t = it;
    bf16_t* dst; const float* W0; const float* W1 = nullptr; int K, N, nvalid = 0, mode;
    if (t < CT_WOUT) { const int l = t / 1152; t %= 1152; dst = (bf16_t*)(p.ws + WS_WIN) + (size_t)l * NINP * D; W0 = p.in[8] + (size_t)l * D * NIN; K = D; N = NIN; nvalid = NIN; mode = 1; }
    else if (t < CT_WUQ) { t -= CT_WOUT; const int l = t / 512; t %= 512; dst = (bf16_t*)(p.ws + WS_WOUT) + (size_t)l * D * D; W0 = p.in[24] + (size_t)l * D * D; K = D; N = D; mode = 0; }
    else if (t < CT_WUKV) { t -= CT_WUQ; const int l = t / 36; t %= 36; dst = (bf16_t*)(p.ws + WS_WUQ) + (size_t)l * 384 * 192; W0 = p.in[18] + (size_t)l * 192 * 384; K = 192; N = 384; mode = 0; }
    else if (t < CT_WFGU) { t -= CT_WUKV; const int l = t / 32; t %= 32; dst = (bf16_t*)(p.ws + WS_WUKV) + (size_t)l * 512 * 128; W0 = p.in[20] + (size_t)l * 128 * 512; K = 128; N = 512; mode = 0; }
    else if (t < CT_WFDN) { t -= CT_WFGU; dst = (bf16_t*)(p.ws + WS_WFGU); W0 = p.in[25]; W1 = p.in[26]; K = D; N = DFF; mode = 2; }
    else if (t < CT_WMGU) { t -= CT_WFDN; dst = (bf16_t*)(p.ws + WS_WFDN); W0 = p.in[27]; K = DFF; N = D; mode = 0; }
    else if (t < CT_WMDN) { t -= CT_WMGU; const int e = t / 3584; t %= 3584; dst = (bf16_t*)(p.ws + WS_WMGU) + (size_t)e * 2 * DFFE * D; W0 = p.in[29] + (size_t)e * D * DFFE; W1 = p.in[30] + (size_t)e * D * DFFE; K = D; N = DFFE; mode = 2; }
    else { t -= CT_WMDN; const int e = t / 1792; t %= 1792; dst = (bf16_t*)(p.ws + WS_WMDN) + (size_t)e * D * DFFE; W0 = p.in[31] + (size_t)e * DFFE * D; K = DFFE; N = D; nvalid = D; mode = 1; }
    const int ktl = K / 64, n0 = (t / ktl) * 32, k0 = (t % ktl) * 64;
    const int n4 = lane & 7; const float* src; bool valid = true; int ln;
    if (mode == 0) { src = W0 + n0 + 4 * n4; ln = 4 * n4; }
    else if (mode == 1) { const int col = n0 + 4 * n4; valid = col < nvalid; src = W0 + (valid ? col : 0); ln = 16 * (n4 & 1) + 4 * (n4 >> 1); }
    else { src = ((n4 >> 2) ? W1 : W0) + 16 * (n0 >> 5) + 4 * (n4 & 3); ln = 16 * (n4 >> 2) + 4 * (n4 & 3); }
    src += (size_t)(k0 + (lane >> 3)) * N;
    f32x4 v[8];
#pragma unroll
    for (int i = 0; i < 8; ++i) v[i] = valid ? *(const f32x4*)(src + (size_t)(8 * i) * N) : (f32x4){0.f, 0.f, 0.f, 0.f};
#pragma unroll
    for (int i = 0; i < 8; ++i) *(f32x4*)(scr + ((lane >> 3) + 8 * i) * 36 + ln) = v[i];
    const int c = lane & 7;
#pragma unroll
    for (int j = 0; j < 4; ++j) { const int n = (lane >> 3) + 8 * j; const float* sp = scr + (8 * c) * 36 + n;
        u32x4 o; o.x = pk2(sp[0 * 36], sp[1 * 36]); o.y = pk2(sp[2 * 36], sp[3 * 36]); o.z = pk2(sp[4 * 36], sp[5 * 36]); o.w = pk2(sp[6 * 36], sp[7 * 36]);
        *(u32x4*)(dst + (size_t)(n0 + n) * K + k0 + 8 * c) = o; }
}
constexpr int CW_FILL = 1024;
__device__ __forceinline__ void fill_moe(const Params& p, float* lds, int quota) {
    const int tid = opq((int)threadIdx.x), lane = tid & 63, wv = tid >> 6;
    float* scr = lds + wv * (64 * 36); volatile int* slot = (volatile int*)(lds + 8 * 64 * 36);
    constexpr int NIT = CT_END - CT_WMGU;
    for (;;) {
        const int claim = quota > 64 ? 4 : quota;
        __syncthreads();
        if (tid == 0) *slot = (int)atomicAdd((unsigned*)(p.ws + WS_CTL) + CW_FILL, 8u * (unsigned)claim);
        __syncthreads();
        const int idx = *slot;
        if (idx >= NIT) break;
        const int end = min(idx + 8 * claim, NIT);
        for (int it = idx + wv; it < end; it += 8) conv_item(p, CT_WMGU + it, scr, lane);
        if (quota <= 64) break;
    }
    __syncthreads();
}
__device__ __forceinline__ void ph_prologue(const Params& p, float* lds) {
    const int tid = opq((int)threadIdx.x), lane = tid & 63, wv = tid >> 6;
    for (int it = blockIdx.x; it < IT_MODS + IT_ROPE; it += gridDim.x) {
        if (it < IT_MODS) {
            const int l = it / 96, n0 = (it % 96) * 64, nn = tid & 63, kc = tid >> 6;
            float* sv = lds; float* red = lds + 3 * 1024;
            __syncthreads();
            for (int i = tid; i < 3 * 1024; i += 512) { const int v = i >> 10, k = i & 1023; const float x = (v < 2) ? p.in[1][v * D + k] : p.in[3][k]; sv[i] = silu_f(x); }
            __syncthreads();
            const float* w = p.in[4] + ((size_t)l * D + kc * 128) * 6144 + n0 + nn;
            float a0 = 0.f, a1 = 0.f, a2 = 0.f;
#pragma unroll 8
            for (int k = 0; k < 128; ++k) { const float wv_ = w[(size_t)k * 6144]; a0 += sv[kc * 128 + k] * wv_; a1 += sv[1024 + kc * 128 + k] * wv_; a2 += sv[2048 + kc * 128 + k] * wv_; }
            red[(kc * 3 + 0) * 64 + nn] = a0; red[(kc * 3 + 1) * 64 + nn] = a1; red[(kc * 3 + 2) * 64 + nn] = a2;
            __syncthreads();
            if (tid < 192) { const int v = tid >> 6; float s = p.in[5][l * 6144 + n0 + nn];
#pragma unroll
                for (int q = 0; q < 8; ++q) s += red[(q * 3 + v) * 64 + nn];
                ((float*)(p.ws + WS_MOD))[((size_t)l * 3 + v) * 6144 + n0 + nn] = s; }
        } else {
            const int idx = (it - IT_MODS) * 512 + tid;
            if (idx < RT_N) {
                int pos, i, nf;
                if (idx < RT_C64) { pos = idx / 16; i = idx % 16; nf = 16; }
                else if (idx < RT_R32) { pos = (idx - RT_C64) / 16; i = idx % 16; nf = 16; }
                else if (idx < RT_C32) { pos = (idx - RT_R32) / 8; i = idx % 8; nf = 8; }
                else { pos = (idx - RT_C32) / 8; i = idx % 8; nf = 8; }
                const float inv = powf(10000.0f, -(float)i / (float)nf);
                const float ang = (float)pos * inv;
                const float rev = ang * 0.15915494309189535f;
                ((float2*)(p.ws + WS_ROPE))[idx] = make_float2(__builtin_amdgcn_cosf(rev), __builtin_amdgcn_sinf(rev));
            }
        }
    }
    __syncthreads();
    for (int i = blockIdx.x * 512 + tid; i < TC * D / 4; i += gridDim.x * 512) ((f32x4*)(p.ws + WS_HCTX))[i] = ((const f32x4*)p.in[2])[i];
    float* scr = lds + wv * (64 * 36);
    for (int it = wv * gridDim.x + blockIdx.x; it < CT_WMGU; it += 8 * gridDim.x) conv_item(p, it, scr, lane);
    __syncthreads();
}

template <int WHICH, bool ROUTER> __device__ __forceinline__ void ph_norm(const Params& p, int layer, int nrows, unsigned* lcnt, int nslab) {
    const int tx = opq((int)threadIdx.x), lane = tx & 63, gw = (blockIdx.x * 512 + tx) >> 6, ngw = (gridDim.x * 512) >> 6;
    if (ROUTER) { if (tx < 16) lcnt[tx] = 0u; __syncthreads(); }
    const float* hl = (layer == 0 && WHICH == 1) ? p.in[0] : p.out;
    const float* hc = (layer == 0 && WHICH == 1) ? p.in[2] : (const float*)(p.ws + WS_HCTX);
    const float* gain = p.in[WHICH == 1 ? 6 : 7] + layer * D;
    const float* mod = (const float*)(p.ws + WS_MOD) + (size_t)layer * 3 * 6144;
    bf16_t* dst = (bf16_t*)(p.ws + WS_ACT1);
    for (int m = gw; m < nrows; m += ngw) {
        const float* src = (m < TL) ? hl + (size_t)m * D : hc + (size_t)(m - TL) * D;
        const float* mv = mod + (m < TL ? m / SEQ : 2) * 6144;
        const float* shp = mv + (WHICH == 1 ? 0 : 3) * D; const float* scp = mv + (WHICH == 1 ? 1 : 4) * D;
        f32x4 v[4]; float ss = 0.f;
#pragma unroll
        for (int j = 0; j < 4; ++j) v[j] = *(const f32x4*)(src + 256 * j + 4 * lane);
        if (!ROUTER && m >= TL && nslab > 0) {
            const float* pp = (const float*)(p.ws + WS_PART) + (size_t)(m - TL) * D + 4 * lane;
            for (int sl = 0; sl < nslab; ++sl) {
#pragma unroll
                for (int j = 0; j < 4; ++j) v[j] = v[j] + *(const f32x4*)(pp + (size_t)sl * TC * D + 256 * j); }
#pragma unroll
            for (int j = 0; j < 4; ++j) *(f32x4*)((float*)(p.ws + WS_HCTX) + (size_t)(m - TL) * D + 256 * j + 4 * lane) = v[j];
        }
#pragma unroll
        for (int j = 0; j < 4; ++j) ss += v[j].x * v[j].x + v[j].y * v[j].y + v[j].z * v[j].z + v[j].w * v[j].w;
        const float rstd = rsqrtf(wave_sum(ss) * (1.f / D) + EPS);
        float lg[8];
#pragma unroll
        for (int e = 0; e < 8; ++e) lg[e] = 0.f;
#pragma unroll
        for (int j = 0; j < 4; ++j) {
            const int c = 256 * j + 4 * lane;
            const f32x4 g = *(const f32x4*)(gain + c), sh = *(const f32x4*)(shp + c), sc = *(const f32x4*)(scp + c);
            f32x4 f = v[j] * rstd * g * (sc + 1.f) + sh;
            u32x2 w; w.x = pk2(f.x, f.y); w.y = pk2(f.z, f.w);
            *(u32x2*)(dst + (size_t)m * D + c) = w;
            if (ROUTER) {
                const float* rt = p.in[28] + (size_t)c * 8;
#pragma unroll
                for (int i = 0; i < 4; ++i) { const f32x4 r0 = *(const f32x4*)(rt + 8 * i), r1 = *(const f32x4*)(rt + 8 * i + 4); const float fv = f[i];
                    lg[0] += fv * r0.x; lg[1] += fv * r0.y; lg[2] += fv * r0.z; lg[3] += fv * r0.w; lg[4] += fv * r1.x; lg[5] += fv * r1.y; lg[6] += fv * r1.z; lg[7] += fv * r1.w; }
            }
        }
        if (ROUTER) {
#pragma unroll
            for (int e = 0; e < 8; ++e) lg[e] = wave_sum(lg[e]);
            if (lane == 0) {
                int e0 = 0; float v0 = lg[0];
#pragma unroll
                for (int e = 1; e < 8; ++e) if (lg[e] > v0) { v0 = lg[e]; e0 = e; }
                int e1 = -1; float v1 = -INFINITY;
#pragma unroll
                for (int e = 0; e < 8; ++e) if (e != e0 && lg[e] > v1) { v1 = lg[e]; e1 = e; }
                const float t = expf(v1 - v0), g0 = 1.f / (1.f + t), g1 = t / (1.f + t);
                const int p0 = (int)atomicAdd(&lcnt[e0], 1u), p1 = (int)atomicAdd(&lcnt[e1], 1u);
                ((int2*)(p.ws + WS_TOKE))[m] = make_int2(e0, e1); ((int2*)(p.ws + WS_TOKP))[m] = make_int2(p0, p1); ((float2*)(p.ws + WS_TOKG))[m] = make_float2(g0, g1);
            }
        }
    }
    if (ROUTER) {
        __syncthreads();
        if (tx < 8) lcnt[8 + tx] = atomicAdd((unsigned*)(p.ws + WS_CTL) + 64 * tx, lcnt[tx]);
        __syncthreads();
        if (lane == 0) for (int m = gw; m < nrows; m += ngw) {
            const int2 e = ((const int2*)(p.ws + WS_TOKE))[m]; int2 ps = ((const int2*)(p.ws + WS_TOKP))[m];
            ps.x += (int)lcnt[8 + e.x]; ps.y += (int)lcnt[8 + e.y]; ((int2*)(p.ws + WS_TOKP))[m] = ps; }
        __syncthreads();
    }
}


typedef short pp_bf16x8 __attribute__((ext_vector_type(8)));
__device__ __forceinline__ float quad_sum(float v) { v += swz_xor<1>(v); v += swz_xor<2>(v); return v; }
__device__ __forceinline__ float kg_sum(float v) { v += swz_xor<16>(v); return half_sum(v); }
constexpr float QS64 = 0.125f * 1.4426950408889634f, QS96 = 0.10206207261596575f * 1.4426950408889634f;

template <int HS> __device__ __forceinline__ void pp_head(const Params& p, const QKVB& qb, int layer, const bf16_t* prow, bool lat, int b, int s, int key, int sub,
                                                          const float2 (&rr)[4], const float2 (&rc)[4]) {
    constexpr bool ISV = HS >= 20;
    constexpr int col = HS < 4 ? OFF_AQ + 64 * HS : HS < 6 ? OFF_AK + 64 * (HS - 4) : HS < 10 ? OFF_BQ + 64 * (HS - 6) : HS < 12 ? OFF_BK + 64 * (HS - 10) : HS < 16 ? OFF_CQ + 64 * (HS - 12) :
                        HS < 20 ? OFF_CK + 64 * (HS - 16) : HS < 22 ? OFF_AV + 64 * (HS - 20) : HS < 24 ? OFF_BV + 64 * (HS - 22) : OFF_CV + 64 * (HS - 24);
    constexpr bool ISQ = HS < 4 || (HS >= 6 && HS < 10) || (HS >= 12 && HS < 16);
    constexpr bool ROPE = HS < 12;
    constexpr int GIN = HS < 4 ? 9 : HS < 6 ? 10 : HS < 10 ? 12 : HS < 12 ? 13 : HS < 16 ? 14 : 15;
    bf16_t* dst;
    if (HS < 4) dst = lat ? qb.QA + ((size_t)(b * 4 + HS) * SEQ + s) * 64 : qb.QAc + ((size_t)(b * 4 + HS) * CTX + s) * 64;
    else if (HS < 6) dst = qb.KA + ((size_t)(b * 2 + HS - 4) * KEYS + key) * 64;
    else if (HS < 10) dst = lat ? qb.QB + ((size_t)(b * 4 + HS - 6) * SEQ + s) * 64 : qb.QBc + ((size_t)(b * 4 + HS - 6) * CTX + s) * 64;
    else if (HS < 12) dst = qb.KB + ((size_t)(b * 2 + HS - 10) * KEYS + key) * 64;
    else if (HS < 16) dst = lat ? qb.QC + ((size_t)(b * 4 + HS - 12) * SEQ + s) * 64 : qb.QCc + ((size_t)(b * 4 + HS - 12) * CTX + s) * 64;
    else if (HS < 20) dst = qb.KC + ((size_t)(b * 4 + HS - 16) * KEYS + key) * 64;
    else if (HS < 22) dst = qb.VA + ((size_t)(b * 2 + HS - 20) * KEYS + key) * 64;
    else if (HS < 24) dst = qb.VB + ((size_t)(b * 2 + HS - 22) * KEYS + key) * 64;
    else dst = qb.VC + ((size_t)(b * 4 + HS - 24) * KEYS + key) * 64;
    u32x2 w[4];
#pragma unroll
    for (int c = 0; c < 4; ++c) w[c] = *(const u32x2*)(prow + col + 16 * c + 4 * sub);
    if (!ISV) {
        f32x4 x[4]; float ss = 0.f;
#pragma unroll
        for (int c = 0; c < 4; ++c) { x[c] = (f32x4){bflo(w[c].x), bfhi(w[c].x), bflo(w[c].y), bfhi(w[c].y)}; ss += x[c].x * x[c].x + x[c].y * x[c].y + x[c].z * x[c].z + x[c].w * x[c].w; }
        const float r = rsqrtf(quad_sum(ss) * (1.f / 64.f) + EPS) * (ISQ ? QS64 : 1.f);
        const float* g = p.in[GIN] + layer * 64 + 4 * sub;
#pragma unroll
        for (int c = 0; c < 4; ++c) x[c] = x[c] * r * *(const f32x4*)(g + 16 * c);
        if (ROPE && lat) {
#pragma unroll
            for (int i = 0; i < 4; ++i) { const float a = x[0][i], bq = x[1][i]; x[0][i] = a * rr[i].x - bq * rr[i].y; x[1][i] = bq * rr[i].x + a * rr[i].y;
                const float c1 = x[2][i], c2 = x[3][i]; x[2][i] = c1 * rc[i].x - c2 * rc[i].y; x[3][i] = c2 * rc[i].x + c1 * rc[i].y; }
        }
#pragma unroll
        for (int c = 0; c < 4; ++c) { w[c].x = pk2(x[c].x, x[c].y); w[c].y = pk2(x[c].z, x[c].w); }
    }
#pragma unroll
    for (int c = 0; c < 4; ++c) *(u32x2*)(dst + 16 * c + 4 * sub) = w[c];
}
template <int HS> struct PPHeads { static __device__ __forceinline__ void run(const Params& p, const QKVB& qb, int layer, const bf16_t* prow, bool lat, int b, int s, int key, int sub, const float2 (&rr)[4], const float2 (&rc)[4]) {
    pp_head<HS>(p, qb, layer, prow, lat, b, s, key, sub, rr, rc); PPHeads<HS + 1>::run(p, qb, layer, prow, lat, b, s, key, sub, rr, rc); } };
template <> struct PPHeads<28> { static __device__ __forceinline__ void run(const Params&, const QKVB&, int, const bf16_t*, bool, int, int, int, int, const float2 (&)[4], const float2 (&)[4]) {} };

__device__ __forceinline__ void f8_from_bf(const u32x4 v, float (&x)[8]) { x[0] = bflo(v.x); x[1] = bfhi(v.x); x[2] = bflo(v.y); x[3] = bfhi(v.y); x[4] = bflo(v.z); x[5] = bfhi(v.z); x[6] = bflo(v.w); x[7] = bfhi(v.w); }

__device__ __forceinline__ void ph_postproj2(const Params& p, int layer) {
    const int tx = opq((int)threadIdx.x), lane = tx & 63, gw = (tx >> 6) * gridDim.x + blockIdx.x, ngw = gridDim.x * 8;
    const bf16_t* P = (const bf16_t*)(p.ws + WS_P);
    const QKVB qb = make_qkv(p.ws);
    const bf16_t* Wuq = (const bf16_t*)(p.ws + WS_WUQ) + (size_t)layer * 384 * 192;
    const bf16_t* Wukv = (const bf16_t*)(p.ws + WS_WUKV) + (size_t)layer * 512 * 128;
    const float2* rope = (const float2*)(p.ws + WS_ROPE);
    for (int u = gw; u < MALL / 16; u += ngw) {
        const int m0 = u * 16; const bool lat = m0 < TL;
        {
            const int t = lane >> 2, sub = lane & 3, m = m0 + t;
            const int b = lat ? m / SEQ : (m - TL) / CTX, s = lat ? m % SEQ : (m - TL) % CTX, key = lat ? CTX + s : s;
            float2 rr[4], rc[4];
#pragma unroll
            for (int i = 0; i < 4; ++i) { rr[i] = lat ? rope[RT_R64 + (s >> 6) * 16 + 4 * sub + i] : make_float2(1.f, 0.f); rc[i] = lat ? rope[RT_C64 + (s & 63) * 16 + 4 * sub + i] : make_float2(1.f, 0.f); }
            PPHeads<0>::run(p, qb, layer, P + (size_t)m * NINP, lat, b, s, key, sub, rr, rc);
        }
        {
            const int tk = lane & 15, kg = lane >> 4, m = m0 + tk;
            const int b = lat ? m / SEQ : (m - TL) / CTX, s = lat ? m % SEQ : (m - TL) % CTX, key = lat ? CTX + s : s;
            const bf16_t* prow = P + (size_t)m * NINP;
            pp_bf16x8 aq[6];
            { float x[6][8]; float ss = 0.f;
#pragma unroll
                for (int ks = 0; ks < 6; ++ks) { f8_from_bf(*(const u32x4*)(prow + OFF_DCQ + 32 * ks + 8 * kg), x[ks]);
#pragma unroll
                    for (int j = 0; j < 8; ++j) ss += x[ks][j] * x[ks][j]; }
                const float r = rsqrtf(kg_sum(ss) * (1.f / 192.f) + EPS);
                const float* g = p.in[17] + layer * 192 + 8 * kg;
#pragma unroll
                for (int ks = 0; ks < 6; ++ks) { const f32x4 g0 = *(const f32x4*)(g + 32 * ks), g1 = *(const f32x4*)(g + 32 * ks + 4);
                    u32x4 w; w.x = pk2(x[ks][0] * r * g0.x, x[ks][1] * r * g0.y); w.y = pk2(x[ks][2] * r * g0.z, x[ks][3] * r * g0.w); w.z = pk2(x[ks][4] * r * g1.x, x[ks][5] * r * g1.y); w.w = pk2(x[ks][6] * r * g1.z, x[ks][7] * r * g1.w);
                    aq[ks] = __builtin_bit_cast(pp_bf16x8, w); } }
            float2 qr_[4], qc_[4];
#pragma unroll
            for (int reg = 0; reg < 4; ++reg) { const int i = (4 * kg + reg) & 7; qr_[reg] = lat ? rope[RT_R32 + (s >> 6) * 8 + i] : make_float2(1.f, 0.f); qc_[reg] = lat ? rope[RT_C32 + (s & 63) * 8 + i] : make_float2(1.f, 0.f); }
#pragma unroll 1
            for (int h = 0; h < 4; ++h) {
                f32x4 acc[6];
#pragma unroll
                for (int nb = 0; nb < 6; ++nb) { acc[nb] = (f32x4){0.f, 0.f, 0.f, 0.f};
                    const bf16_t* wp = Wuq + (size_t)(96 * h + 16 * nb + tk) * 192 + 8 * kg;
#pragma unroll
                    for (int ks = 0; ks < 6; ++ks) acc[nb] = __builtin_amdgcn_mfma_f32_16x16x32_bf16(*(const pp_bf16x8*)(wp + 32 * ks), aq[ks], acc[nb], 0, 0, 0); }
                float ss = 0.f;
#pragma unroll
                for (int nb = 0; nb < 6; ++nb) ss += acc[nb].x * acc[nb].x + acc[nb].y * acc[nb].y + acc[nb].z * acc[nb].z + acc[nb].w * acc[nb].w;
                const float r = rsqrtf(kg_sum(ss) * (1.f / 96.f) + EPS) * QS96;
                const float* g = p.in[21] + layer * 96 + 4 * kg;
                bf16_t* dst = (lat ? qb.QD + ((size_t)(b * 4 + h) * SEQ + s) * 96 : qb.QDc + ((size_t)(b * 4 + h) * CTX + s) * 96) + 4 * kg;
#pragma unroll
                for (int nb = 0; nb < 6; ++nb) { f32x4 y = acc[nb] * r * *(const f32x4*)(g + 16 * nb);
                    if (nb >= 4 && lat) {
#pragma unroll
                        for (int reg = 0; reg < 4; ++reg) { const float other = half_other(y[reg], lane); const float2 cs = nb == 4 ? qr_[reg] : qc_[reg];
                            y[reg] = (kg < 2) ? y[reg] * cs.x - other * cs.y : y[reg] * cs.x + other * cs.y; } }
                    u32x2 w; w.x = pk2(y.x, y.y); w.y = pk2(y.z, y.w); *(u32x2*)(dst + 16 * nb) = w; }
            }
            pp_bf16x8 akv[4];
            { float x[4][8]; float ss = 0.f;
#pragma unroll
                for (int ks = 0; ks < 4; ++ks) { f8_from_bf(*(const u32x4*)(prow + OFF_DCKV + 32 * ks + 8 * kg), x[ks]);
#pragma unroll
                    for (int j = 0; j < 8; ++j) ss += x[ks][j] * x[ks][j]; }
                const float r = rsqrtf(kg_sum(ss) * (1.f / 128.f) + EPS);
                const float* g = p.in[19] + layer * 128 + 8 * kg;
#pragma unroll
                for (int ks = 0; ks < 4; ++ks) { const f32x4 g0 = *(const f32x4*)(g + 32 * ks), g1 = *(const f32x4*)(g + 32 * ks + 4);
                    u32x4 w; w.x = pk2(x[ks][0] * r * g0.x, x[ks][1] * r * g0.y); w.y = pk2(x[ks][2] * r * g0.z, x[ks][3] * r * g0.w); w.z = pk2(x[ks][4] * r * g1.x, x[ks][5] * r * g1.y); w.w = pk2(x[ks][6] * r * g1.z, x[ks][7] * r * g1.w);
                    akv[ks] = __builtin_bit_cast(pp_bf16x8, w); } }
            float kr[8]; f8_from_bf(*(const u32x4*)(prow + OFF_DKR + 8 * kg), kr);
            float krss = 0.f;
#pragma unroll
            for (int j = 0; j < 8; ++j) krss += kr[j] * kr[j];
            float2 kcs[8];
#pragma unroll
            for (int j = 0; j < 8; ++j) kcs[j] = !lat ? make_float2(1.f, 0.f) : (kg < 2 ? rope[RT_R32 + (s >> 6) * 8 + j] : rope[RT_C32 + (s & 63) * 8 + j]);
#pragma unroll 1
            for (int h = 0; h < 4; ++h) {
                f32x4 acc[8];
#pragma unroll
                for (int nb = 0; nb < 8; ++nb) { acc[nb] = (f32x4){0.f, 0.f, 0.f, 0.f};
                    const bf16_t* wp = Wukv + (size_t)(128 * h + 16 * nb + tk) * 128 + 8 * kg;
#pragma unroll
                    for (int ks = 0; ks < 4; ++ks) acc[nb] = __builtin_amdgcn_mfma_f32_16x16x32_bf16(*(const pp_bf16x8*)(wp + 32 * ks), akv[ks], acc[nb], 0, 0, 0); }
                float ss = krss;
#pragma unroll
                for (int nb = 0; nb < 4; ++nb) ss += acc[nb].x * acc[nb].x + acc[nb].y * acc[nb].y + acc[nb].z * acc[nb].z + acc[nb].w * acc[nb].w;
                const float r = rsqrtf(kg_sum(ss) * (1.f / 96.f) + EPS);
                const float* g = p.in[22] + layer * 96;
                bf16_t* kd = qb.KD + ((size_t)(b * 4 + h) * KEYS + key) * 96; bf16_t* vd = qb.VD + ((size_t)(b * 4 + h) * KEYS + key) * 64;
#pragma unroll
                for (int nb = 0; nb < 4; ++nb) { const f32x4 y = acc[nb] * r * *(const f32x4*)(g + 16 * nb + 4 * kg); u32x2 w; w.x = pk2(y.x, y.y); w.y = pk2(y.z, y.w); *(u32x2*)(kd + 16 * nb + 4 * kg) = w; }
                { float y[8];
#pragma unroll
                    for (int j = 0; j < 8; ++j) y[j] = kr[j] * r * g[64 + 8 * kg + j];
#pragma unroll
                    for (int j = 0; j < 8; ++j) { const float other = swz_xor<16>(y[j]); y[j] = (kg & 1) == 0 ? y[j] * kcs[j].x - other * kcs[j].y : y[j] * kcs[j].x + other * kcs[j].y; }
                    u32x4 w; w.x = pk2(y[0], y[1]); w.y = pk2(y[2], y[3]); w.z = pk2(y[4], y[5]); w.w = pk2(y[6], y[7]); *(u32x4*)(kd + 64 + 8 * kg) = w; }
#pragma unroll
                for (int nb = 4; nb < 8; ++nb) { const f32x4 y = acc[nb]; u32x2 w; w.x = pk2(y.x, y.y); w.y = pk2(y.z, y.w); *(u32x2*)(vd + 16 * (nb - 4) + 4 * kg) = w; }
            }
        }
    }
}

namespace fa {
typedef short bf16x8 __attribute__((ext_vector_type(8)));
typedef short s16x4 __attribute__((ext_vector_type(4)));
typedef float f32x16 __attribute__((ext_vector_type(16)));
typedef __attribute__((address_space(3))) const char* lds_cptr;
typedef short v4i16_t __attribute__((ext_vector_type(4)));
constexpr int KSTG = 12288, VSTG = 8192, STG = KSTG + VSTG;
constexpr int LDS_WS = 2 * STG, LDS_OST = LDS_WS + 8 * 256, LDS_RPB = LDS_OST + 8 * 4096, LDS_TOTAL = LDS_RPB + 2048;
constexpr float LOG2E = 1.4426950408889634f;
constexpr float THR = 6.0f;
__device__ __forceinline__ int crow(int r, int hi) { return (r & 3) + 8 * (r >> 2) + 4 * hi; }
__device__ __forceinline__ void glds16(const void* gsrc, unsigned lds_dst) { unsigned keep;
    asm volatile("s_mov_b32 %0, m0\n\ts_mov_b32 m0, %2\n\ts_nop 0\n\tglobal_load_lds_dwordx4 %1, off\n\ts_mov_b32 m0, %0" : "=&s"(keep) : "v"(gsrc), "s"(lds_dst) : "memory"); }
__device__ __forceinline__ s16x4 vtr(lds_cptr p) { return __builtin_bit_cast(s16x4, __builtin_amdgcn_ds_read_tr16_b64_v4i16((__attribute__((address_space(3))) v4i16_t*)p)); }
typedef float f32x2_t __attribute__((ext_vector_type(2))); typedef __bf16 bf16x2_t __attribute__((ext_vector_type(2)));
__device__ __forceinline__ unsigned cvtpk(float lo, float hi) { f32x2_t v = {lo, hi}; bf16x2_t b = __builtin_convertvector(v, bf16x2_t); return __builtin_bit_cast(unsigned, b); }
__device__ __forceinline__ float xhalf_max(float m) { auto rr = __builtin_amdgcn_permlane32_swap(__float_as_uint(m), __float_as_uint(m), false, false); return fmaxf(__uint_as_float(rr[0]), __uint_as_float(rr[1])); }
__device__ __forceinline__ float xhalf_sum(float m) { auto rr = __builtin_amdgcn_permlane32_swap(__float_as_uint(m), __float_as_uint(m), false, false); return __uint_as_float(rr[0]) + __uint_as_float(rr[1]); }
#define FA_WAIT_BAR() asm volatile("s_waitcnt vmcnt(0) lgkmcnt(0)\n\ts_barrier" ::: "memory")

template <int DQK, int MODE>
__device__ __forceinline__ void attn_unit(const bf16_t* Qg, const bf16_t* Kg, const bf16_t* Vg, bf16_t* Og, int q0, float sink2, const float* rpb, char* shm) {
    const int tid = opq((int)threadIdx.x), lane = tid & 63, r32 = lane & 31, hi = lane >> 5; const int wid = __builtin_amdgcn_readfirstlane(tid >> 6);
    const unsigned lds0 = (unsigned)(uintptr_t)shm;
    float* wsf = (float*)(shm + LDS_WS) + wid * 64;
    constexpr int NCH = DQK / 8, ND0 = DQK / 16;
    int NT, wbase = 0;
    if (MODE == 0) NT = KEYS / 64; else if (MODE == 3) NT = 4;
    else if (MODE == 1) { wbase = max(0, q0 - 128); const int we = min(SEQ, q0 + 256 + 128); NT = 4 + (we - wbase) / 64; }
    else { const int r0 = q0 >> 6; wbase = min(max(r0 - 4, 0), 120); const int kre = min(max(r0 - 1, 0), 120) + 8; NT = 4 + (kre - wbase); }
#define FA_KEY0(t) ((MODE == 0 || MODE == 3 || (t) < 4) ? 64 * (t) : (MODE == 1 ? CTX + wbase + 64 * ((t) - 4) : CTX + (wbase + (t) - 4) * 64))
    const bf16_t* ksrc = Kg + (size_t)lane * DQK; const bf16_t* vsrc = Vg + (size_t)(16 * (wid & 3) + (lane >> 2)) * 64 + (wid >> 2) * 32 + (lane & 3) * 8;
#define FA_DMA(t, s) do { const int k0_ = FA_KEY0(t); \
        _Pragma("unroll") for (int c_ = 0; c_ < 2; ++c_) { const int ch_ = wid + 8 * c_; if (ch_ < NCH) glds16(ksrc + (size_t)k0_ * DQK + ch_ * 8, (unsigned)__builtin_amdgcn_readfirstlane(lds0 + (s) * STG + ch_ * 1024)); } \
        glds16(vsrc + (size_t)k0_ * 64, (unsigned)__builtin_amdgcn_readfirstlane(lds0 + (s) * STG + KSTG + wid * 1024)); } while (0)
    FA_DMA(0, 0);
    if (MODE == 2) { float* rp = (float*)(shm + LDS_RPB); for (int i = tid; i < 15 * 31; i += 512) rp[i] = rpb[i] * LOG2E; }
    bf16x8 qr[ND0];
#pragma unroll
    for (int d0 = 0; d0 < ND0; ++d0) qr[d0] = *reinterpret_cast<const bf16x8*>(Qg + (size_t)(wid * 32 + r32) * DQK + d0 * 16 + hi * 8);
    float mhat = -1e30f, l_reg = 0.f; f32x16 o[2];
#pragma unroll
    for (int r = 0; r < 16; ++r) { o[0][r] = 0.f; o[1][r] = 0.f; }
    const int qpos = q0 + wid * 32 + r32;
    const int rq = (q0 >> 6) + (wid >> 1), jq = 32 * (wid & 1) + r32;
    const int rs = min(max(rq - 4, 0), 120), cs = min(max(jq - 8, 0), 48);
    const lds_cptr shm3 = (lds_cptr)shm;
    FA_WAIT_BAR();
    for (int t = 0; t < NT; ++t) {
        const int s = t & 1;
        if (t + 1 < NT) FA_DMA(t + 1, s ^ 1);
        bool active = true;
        if (MODE == 1 && t >= 4) { const int kp0 = wbase + 64 * (t - 4), qw0 = q0 + wid * 32; active = (kp0 + 63 >= qw0 - 128) && (kp0 <= qw0 + 31 + 128); }
        if (MODE == 2 && t >= 4) { const int kr = wbase + t - 4; active = (kr >= rs) && (kr < rs + 8); }
        if (active) {
            const lds_cptr kb = shm3 + s * STG + hi * 1024 + r32 * 16;
            f32x16 p0, p1;
#pragma unroll
            for (int r = 0; r < 16; ++r) { p0[r] = 0.f; p1[r] = 0.f; }
#pragma unroll
            for (int d0 = 0; d0 < ND0; ++d0) {
                const bf16x8 b0 = *(const __attribute__((address_space(3))) bf16x8*)(kb + d0 * 2048);
                const bf16x8 b1 = *(const __attribute__((address_space(3))) bf16x8*)(kb + d0 * 2048 + 512);
                p0 = __builtin_amdgcn_mfma_f32_32x32x16_bf16(b0, qr[d0], p0, 0, 0, 0);
                p1 = __builtin_amdgcn_mfma_f32_32x32x16_bf16(b1, qr[d0], p1, 0, 0, 0);
            }
            if (MODE == 1 && t >= 4) { const int kp0 = wbase + 64 * (t - 4) - qpos;
#pragma unroll
                for (int r = 0; r < 16; ++r) { const int d0_ = kp0 + crow(r, hi), d1_ = d0_ + 32; if (d0_ < -128 || d0_ > 128) p0[r] = -INFINITY; if (d1_ < -128 || d1_ > 128) p1[r] = -INFINITY; } }
            if (MODE == 2 && t >= 4) { const int kr = wbase + t - 4; const float* rp = (const float*)(shm + LDS_RPB) + (kr - rq + 7) * 31 + 15 - jq;
#pragma unroll
                for (int r = 0; r < 16; ++r) { const int kc0 = crow(r, hi), kc1 = kc0 + 32;
                    const bool v0 = (kc0 >= cs) && (kc0 < cs + 16), v1 = (kc1 >= cs) && (kc1 < cs + 16);
                    p0[r] = v0 ? p0[r] + rp[v0 ? kc0 : jq] : -INFINITY; p1[r] = v1 ? p1[r] + rp[v1 ? kc1 : jq] : -INFINITY; } }
            float rm = fmaxf(p0[0], p1[0]);
#pragma unroll
            for (int r = 1; r < 16; ++r) rm = fmaxf(rm, fmaxf(p0[r], p1[r]));
            rm = xhalf_max(rm);
            if (__any(rm - mhat > THR)) {
                const float mn = fmaxf(mhat, rm), f = __builtin_amdgcn_exp2f(mhat - mn); mhat = mn; l_reg *= f;
                if (hi == 0) wsf[r32] = f;
#pragma unroll
                for (int r = 0; r < 16; ++r) { const float fr = wsf[crow(r, hi)]; o[0][r] *= fr; o[1][r] *= fr; }
            }
            float sacc = 0.f;
#pragma unroll
            for (int r = 0; r < 16; ++r) { p0[r] = __builtin_amdgcn_exp2f(p0[r] - mhat); p1[r] = __builtin_amdgcn_exp2f(p1[r] - mhat); sacc += p0[r] + p1[r]; }
            l_reg += sacc;
            u32x4 pw0, pw1, pw2, pw3;
            pw0 = (u32x4){cvtpk(p0[0], p0[1]), cvtpk(p0[2], p0[3]), cvtpk(p0[4], p0[5]), cvtpk(p0[6], p0[7])};
            pw1 = (u32x4){cvtpk(p0[8], p0[9]), cvtpk(p0[10], p0[11]), cvtpk(p0[12], p0[13]), cvtpk(p0[14], p0[15])};
            pw2 = (u32x4){cvtpk(p1[0], p1[1]), cvtpk(p1[2], p1[3]), cvtpk(p1[4], p1[5]), cvtpk(p1[6], p1[7])};
            pw3 = (u32x4){cvtpk(p1[8], p1[9]), cvtpk(p1[10], p1[11]), cvtpk(p1[12], p1[13]), cvtpk(p1[14], p1[15])};
            const lds_cptr vp = shm3 + s * STG + KSTG + ((lane >> 4) & 1) * 32 + (lane & 3) * 8 + (4 * hi + ((lane & 15) >> 2)) * 64;
#pragma unroll
            for (int dh = 0; dh < 2; ++dh) {
                s16x4 vlo[4], vhi[4];
#pragma unroll
                for (int ks = 0; ks < 4; ++ks) { vlo[ks] = vtr(vp + dh * 4096 + ks * 1024); vhi[ks] = vtr(vp + dh * 4096 + ks * 1024 + 512); }
#define FA_VFR(k) (bf16x8){vlo[k][0], vlo[k][1], vlo[k][2], vlo[k][3], vhi[k][0], vhi[k][1], vhi[k][2], vhi[k][3]}
                o[dh] = __builtin_amdgcn_mfma_f32_32x32x16_bf16(__builtin_bit_cast(bf16x8, pw0), FA_VFR(0), o[dh], 0, 0, 0);
                o[dh] = __builtin_amdgcn_mfma_f32_32x32x16_bf16(__builtin_bit_cast(bf16x8, pw1), FA_VFR(1), o[dh], 0, 0, 0);
                o[dh] = __builtin_amdgcn_mfma_f32_32x32x16_bf16(__builtin_bit_cast(bf16x8, pw2), FA_VFR(2), o[dh], 0, 0, 0);
                o[dh] = __builtin_amdgcn_mfma_f32_32x32x16_bf16(__builtin_bit_cast(bf16x8, pw3), FA_VFR(3), o[dh], 0, 0, 0);
#undef FA_VFR
            }
        }
        FA_WAIT_BAR();
    }
    l_reg = xhalf_sum(l_reg);
    if (MODE == 1 || MODE == 3) l_reg += __builtin_amdgcn_exp2f(sink2 - mhat);
    if (hi == 0) wsf[32 + r32] = 1.0f / l_reg;
    float rli[16];
#pragma unroll
    for (int r = 0; r < 16; ++r) rli[r] = wsf[32 + crow(r, hi)];
    bf16_t* stg = (bf16_t*)(shm + LDS_OST) + wid * 2048;
#pragma unroll
    for (int r = 0; r < 16; ++r) { const int orow = crow(r, hi);
#pragma unroll
        for (int dh = 0; dh < 2; ++dh) stg[orow * 64 + dh * 32 + r32] = (bf16_t)f2bf(o[dh][r] * rli[r]); }
#pragma unroll
    for (int i = 0; i < 4; ++i) { const int row = i * 8 + (lane >> 3), ch = lane & 7; const u32x4 v = *(const u32x4*)(stg + row * 64 + ch * 8); *(u32x4*)(Og + (size_t)(wid * 32 + row) * D + ch * 8) = v; }
    asm volatile("s_waitcnt lgkmcnt(0)\n\ts_barrier" ::: "memory");
#undef FA_DMA
#undef FA_KEY0
}
#undef FA_WAIT_BAR
}


namespace fa2 {
using fa::bf16x8; using fa::s16x4; using fa::f32x16; using fa::lds_cptr; using fa::crow; using fa::glds16; using fa::vtr; using fa::cvtpk; using fa::LOG2E;
constexpr int KSL = 12288, VSL = 8192, VBASE = 4 * KSL, LDS_WS = VBASE + 3 * VSL, LDS_OST = LDS_WS + 8 * 256, LDS_RPB = LDS_OST + 8 * 4096, LDS_TOTAL = LDS_RPB + 2048;
static_assert(LDS_TOTAL <= 131072, "attention LDS");
#define SBAR() __builtin_amdgcn_sched_barrier(0)
#define PIN(x) asm volatile("" : "+v"(x))
template <int DQK, int MODE, int THRL>
__device__ __forceinline__ void attn_unit(const bf16_t* Qg, const bf16_t* Kg, const bf16_t* Vg, bf16_t* Og, int q0, float sink2, const float* rpb, char* shm) {
    const int tid = opq((int)threadIdx.x), lane = tid & 63, r32 = lane & 31, hi = lane >> 5; const int wid = __builtin_amdgcn_readfirstlane(tid >> 6);
    const unsigned lds0 = (unsigned)(uintptr_t)shm;
    float* wsf = (float*)(shm + LDS_WS) + wid * 64;
    constexpr int NCH = DQK / 8, ND0 = DQK / 16;
    int NT, wbase = 0;
    if (MODE == 0) NT = KEYS / 64; else if (MODE == 3) NT = 4;
    else if (MODE == 1) { wbase = max(0, q0 - 128); const int we = min(SEQ, q0 + 256 + 128); NT = 4 + (we - wbase) / 64; }
    else { const int r0 = q0 >> 6; wbase = min(max(r0 - 4, 0), 120); const int kre = min(max(r0 - 1, 0), 120) + 8; NT = 4 + (kre - wbase); }
#define FA_KEY0(t) ((MODE == 0 || MODE == 3 || (t) < 4) ? 64 * (t) : (MODE == 1 ? CTX + wbase + 64 * ((t) - 4) : CTX + (wbase + (t) - 4) * 64))
    const bf16_t* ksrc = Kg + (size_t)lane * DQK; const bf16_t* vsrc = Vg + (size_t)(16 * (wid & 3) + (lane >> 2)) * 64 + (wid >> 2) * 32 + (lane & 3) * 8;
#define DMA_K(t, slotoff) do { const int tt_ = (t) < NT ? (t) : NT - 1; const int k0_ = FA_KEY0(tt_); \
        glds16(ksrc + (size_t)k0_ * DQK + wid * 8, (unsigned)__builtin_amdgcn_readfirstlane(lds0 + (slotoff) + wid * 1024)); \
        if (NCH > 8) { if (wid < NCH - 8) glds16(ksrc + (size_t)k0_ * DQK + (wid + 8) * 8, (unsigned)__builtin_amdgcn_readfirstlane(lds0 + (slotoff) + (wid + 8) * 1024)); } } while (0)
#define DMA_V(t, slotoff) do { const int tt_ = (t) < NT ? (t) : NT - 1; const int k0_ = FA_KEY0(tt_); \
        glds16(vsrc + (size_t)k0_ * 64, (unsigned)__builtin_amdgcn_readfirstlane(lds0 + VBASE + (slotoff) + wid * 1024)); } while (0)
#define WAIT_STEP() do { if (NCH > 8 && wid < NCH - 8) asm volatile("s_waitcnt vmcnt(3) lgkmcnt(0)\n\ts_barrier" ::: "memory"); else asm volatile("s_waitcnt vmcnt(2) lgkmcnt(0)\n\ts_barrier" ::: "memory"); } while (0)
    DMA_K(0, 0); DMA_V(0, 0); DMA_K(1, KSL); DMA_K(2, 2 * KSL);
    if (MODE == 2) { float* rp = (float*)(shm + LDS_RPB); for (int i = tid; i < 15 * 31; i += 512) rp[i] = rpb[i] * LOG2E; }
    bf16x8 qr[ND0];
#pragma unroll
    for (int d0 = 0; d0 < ND0; ++d0) qr[d0] = *reinterpret_cast<const bf16x8*>(Qg + (size_t)(wid * 32 + r32) * DQK + d0 * 16 + hi * 8);
    float mhat = 0.f, l_reg = 0.f; f32x16 o[2]; f32x16 negm;
#pragma unroll
    for (int r = 0; r < 16; ++r) { o[0][r] = 0.f; o[1][r] = 0.f; negm[r] = 0.f; }
    PIN(negm);
    const int qpos = q0 + wid * 32 + r32;
    const int rq = (q0 >> 6) + (wid >> 1), jq = 32 * (wid & 1) + r32;
    const int rs = min(max(rq - 4, 0), 120), cs = min(max(jq - 8, 0), 48);
    const lds_cptr shm3 = (lds_cptr)shm;
    const lds_cptr kp0 = shm3 + hi * 1024 + r32 * 16;
    const lds_cptr vp0 = shm3 + VBASE + ((lane >> 4) & 1) * 32 + (lane & 3) * 8 + (4 * hi + ((lane & 15) >> 2)) * 64;
#define MASK(C0, C1, t) do { \
        if (MODE == 1 && (t) >= 4) { const int kp0_ = wbase + 64 * ((t) - 4) - qpos; \
            _Pragma("unroll") for (int r = 0; r < 16; ++r) { const int d0_ = kp0_ + crow(r, hi), d1_ = d0_ + 32; if (d0_ < -128 || d0_ > 128) C0[r] = -INFINITY; if (d1_ < -128 || d1_ > 128) C1[r] = -INFINITY; } } \
        if (MODE == 2 && (t) >= 4) { const int kr_ = wbase + (t) - 4; const bool rowok_ = (kr_ >= rs) && (kr_ < rs + 8); const int ro_ = min(max(kr_ - rq + 7, 0), 14); \
            const float* rp_ = (const float*)(shm + LDS_RPB) + ro_ * 31 + 15 - jq; \
            _Pragma("unroll") for (int r = 0; r < 16; ++r) { const int kc0 = crow(r, hi), kc1 = kc0 + 32; \
                const bool v0 = rowok_ && (kc0 >= cs) && (kc0 < cs + 16), v1 = rowok_ && (kc1 >= cs) && (kc1 < cs + 16); \
                C0[r] = v0 ? C0[r] + rp_[v0 ? kc0 : jq] : -INFINITY; C1[r] = v1 ? C1[r] + rp_[v1 ? kc1 : jq] : -INFINITY; } } } while (0)
#define ROWMAX(C0, C1, rm) do { float a_ = fmaxf(fmaxf(C0[0], C0[1]), C1[0]), b_ = fmaxf(fmaxf(C0[2], C0[3]), C1[1]); a_ = fmaxf(fmaxf(a_, C1[2]), C1[3]); \
        _Pragma("unroll") for (int r = 4; r < 16; r += 4) { a_ = fmaxf(fmaxf(a_, C0[r]), C0[r + 1]); b_ = fmaxf(fmaxf(b_, C0[r + 2]), C0[r + 3]); a_ = fmaxf(fmaxf(a_, C1[r]), C1[r + 1]); b_ = fmaxf(fmaxf(b_, C1[r + 2]), C1[r + 3]); } \
        rm = fa::xhalf_max(fmaxf(a_, b_)); } while (0)
    bf16x8 kf[8]; bf16x8 kf2[4];
#define KLOAD(j, slotoff) do { kf[2 * (j)] = *(const __attribute__((address_space(3))) bf16x8*)(kp0 + (slotoff) + (j) * 2048); kf[2 * (j) + 1] = *(const __attribute__((address_space(3))) bf16x8*)(kp0 + (slotoff) + (j) * 2048 + 512); } while (0)
#define KLOAD2(slotoff) do { if (ND0 > 4) { kf2[0] = *(const __attribute__((address_space(3))) bf16x8*)(kp0 + (slotoff) + 4 * 2048); kf2[1] = *(const __attribute__((address_space(3))) bf16x8*)(kp0 + (slotoff) + 4 * 2048 + 512); \
        kf2[2] = *(const __attribute__((address_space(3))) bf16x8*)(kp0 + (slotoff) + 5 * 2048); kf2[3] = *(const __attribute__((address_space(3))) bf16x8*)(kp0 + (slotoff) + 5 * 2048 + 512); } } while (0)
    asm volatile("s_waitcnt vmcnt(0) lgkmcnt(0)\n\ts_barrier" ::: "memory");
    f32x16 pA0, pA1, pB0, pB1;
    int ks_cur = 0, ks_next = KSL, ks_nn = 2 * KSL, ks_tgt = 3 * KSL;
    int vs_prev = 2 * VSL, vs_cur = 0, vs_next = VSL;
#define ROT() do { const int k_ = ks_cur; ks_cur = ks_next; ks_next = ks_nn; ks_nn = ks_tgt; ks_tgt = k_; const int v_ = vs_prev; vs_prev = vs_cur; vs_cur = vs_next; vs_next = v_; } while (0)
    bool resc = false;
#define RESC() do { if (resc) { _Pragma("unroll") for (int r = 0; r < 16; ++r) { const float fr_ = wsf[crow(r, hi)]; o[0][r] *= fr_; o[1][r] *= fr_; } } } while (0)
    KLOAD(0, 0); KLOAD(1, 0); KLOAD(2, 0); KLOAD(3, 0); KLOAD2(0);
    {
#pragma unroll
        for (int d0 = 0; d0 < 4; ++d0) { pA0 = __builtin_amdgcn_mfma_f32_32x32x16_bf16(kf[2 * d0], qr[d0], d0 == 0 ? negm : pA0, 0, 0, 0); pA1 = __builtin_amdgcn_mfma_f32_32x32x16_bf16(kf[2 * d0 + 1], qr[d0], d0 == 0 ? negm : pA1, 0, 0, 0); }
        if (ND0 > 4) { pA0 = __builtin_amdgcn_mfma_f32_32x32x16_bf16(kf2[0], qr[ND0 > 4 ? 4 : 0], pA0, 0, 0, 0); pA1 = __builtin_amdgcn_mfma_f32_32x32x16_bf16(kf2[1], qr[ND0 > 4 ? 4 : 0], pA1, 0, 0, 0);
                       pA0 = __builtin_amdgcn_mfma_f32_32x32x16_bf16(kf2[2], qr[ND0 > 4 ? 5 : 0], pA0, 0, 0, 0); pA1 = __builtin_amdgcn_mfma_f32_32x32x16_bf16(kf2[3], qr[ND0 > 4 ? 5 : 0], pA1, 0, 0, 0); }
        DMA_K(3, 3 * KSL); DMA_V(1, VSL);
        float rm; ROWMAX(pA0, pA1, rm);
        mhat = rm;
#pragma unroll
        for (int r = 0; r < 16; ++r) { pA0[r] = __builtin_amdgcn_exp2f(pA0[r] - rm); pA1[r] = __builtin_amdgcn_exp2f(pA1[r] - rm); negm[r] = -mhat; }
        PIN(negm);
        KLOAD(0, KSL); KLOAD(1, KSL); KLOAD(2, KSL); KLOAD(3, KSL);
        WAIT_STEP();
    }
    s16x4 vlo[8], vhi[8]; u32x4 pw0, pw1, pw2, pw3;
#define VRD(i) do { vlo[i] = vtr(vp_ + (((i) >> 2) * 4096 + ((i) & 3) * 1024)); vhi[i] = vtr(vp_ + (((i) >> 2) * 4096 + ((i) & 3) * 1024 + 512)); } while (0)
#define VFR(i) (bf16x8){vlo[i][0], vlo[i][1], vlo[i][2], vlo[i][3], vhi[i][0], vhi[i][1], vhi[i][2], vhi[i][3]}
#define PAF(k) __builtin_bit_cast(bf16x8, pw##k)
#define GAPA(MF, A0, A1, A2, A3, W0, W1, PW) do { MF; sacc += A0; sacc += A1; sacc += A2; sacc += A3; PIN(sacc); W0; W1; PIN(PW); SBAR(); } while (0)
#define EX(v) __builtin_amdgcn_exp2f(v)
#define GAPB(MF, X, B) do { MF; X[B] = EX(X[B]); X[B + 1] = EX(X[B + 1]); X[B + 2] = EX(X[B + 2]); X[B + 3] = EX(X[B + 3]); PIN(X); SBAR(); } while (0)
#define KRD(j) do { KLOAD(j, ks_nn_); SBAR(); } while (0)
#define STEP(C0, C1, P0, P1, t) do { SBAR(); \
        const lds_cptr vp_ = vp0 + vs_prev; const int ks_cur_ = ks_cur; (void)ks_cur_; \
        KLOAD2(ks_cur_); \
        VRD(0); SBAR(); float sacc = (P0[0] + P0[1]); \
        GAPA(C0 = __builtin_amdgcn_mfma_f32_32x32x16_bf16(kf[0], qr[0], negm, 0, 0, 0), P0[2], P0[3], P0[4], P0[5], pw0[0] = cvtpk(P0[0], P0[1]), pw0[1] = cvtpk(P0[2], P0[3]), pw0); \
        VRD(4); SBAR(); GAPA(C1 = __builtin_amdgcn_mfma_f32_32x32x16_bf16(kf[1], qr[0], negm, 0, 0, 0), P0[6], P0[7], P0[8], P0[9], pw0[2] = cvtpk(P0[4], P0[5]), pw0[3] = cvtpk(P0[6], P0[7]), pw0); \
        VRD(1); SBAR(); GAPA(C0 = __builtin_amdgcn_mfma_f32_32x32x16_bf16(kf[2], qr[1], C0, 0, 0, 0), P0[10], P0[11], P0[12], P0[13], pw1[0] = cvtpk(P0[8], P0[9]), pw1[1] = cvtpk(P0[10], P0[11]), pw1); \
        VRD(5); SBAR(); GAPA(C1 = __builtin_amdgcn_mfma_f32_32x32x16_bf16(kf[3], qr[1], C1, 0, 0, 0), P0[14], P0[15], P1[0], P1[1], pw1[2] = cvtpk(P0[12], P0[13]), pw1[3] = cvtpk(P0[14], P0[15]), pw1); \
        VRD(2); SBAR(); GAPA(C0 = __builtin_amdgcn_mfma_f32_32x32x16_bf16(kf[4], qr[2], C0, 0, 0, 0), P1[2], P1[3], P1[4], P1[5], pw2[0] = cvtpk(P1[0], P1[1]), pw2[1] = cvtpk(P1[2], P1[3]), pw2); \
        VRD(6); SBAR(); GAPA(C1 = __builtin_amdgcn_mfma_f32_32x32x16_bf16(kf[5], qr[2], C1, 0, 0, 0), P1[6], P1[7], P1[8], P1[9], pw2[2] = cvtpk(P1[4], P1[5]), pw2[3] = cvtpk(P1[6], P1[7]), pw2); \
        VRD(3); SBAR(); GAPA(C0 = __builtin_amdgcn_mfma_f32_32x32x16_bf16(kf[6], qr[3], C0, 0, 0, 0), P1[10], P1[11], P1[12], P1[13], pw3[0] = cvtpk(P1[8], P1[9]), pw3[1] = cvtpk(P1[10], P1[11]), pw3); \
        VRD(7); SBAR(); GAPA(C1 = __builtin_amdgcn_mfma_f32_32x32x16_bf16(kf[7], qr[3], C1, 0, 0, 0), P1[14], P1[15], 0.f, 0.f, pw3[2] = cvtpk(P1[12], P1[13]), pw3[3] = cvtpk(P1[14], P1[15]), pw3); \
        if (ND0 > 4) { C0 = __builtin_amdgcn_mfma_f32_32x32x16_bf16(kf2[0], qr[ND0 > 4 ? 4 : 0], C0, 0, 0, 0); C1 = __builtin_amdgcn_mfma_f32_32x32x16_bf16(kf2[1], qr[ND0 > 4 ? 4 : 0], C1, 0, 0, 0); \
                       C0 = __builtin_amdgcn_mfma_f32_32x32x16_bf16(kf2[2], qr[ND0 > 4 ? 5 : 0], C0, 0, 0, 0); C1 = __builtin_amdgcn_mfma_f32_32x32x16_bf16(kf2[3], qr[ND0 > 4 ? 5 : 0], C1, 0, 0, 0); SBAR(); } \
        l_reg += sacc; \
        DMA_K((t) + 3, ks_tgt); DMA_V((t) + 1, vs_next); \
        MASK(C0, C1, t); \
        { float rm; ROWMAX(C0, C1, rm); resc = false; \
          if (__builtin_expect(__any(rm > (float)THRL), 0)) { const float dl = fmaxf(rm, 0.f); mhat += dl; \
              _Pragma("unroll") for (int r = 0; r < 16; ++r) { C0[r] -= dl; C1[r] -= dl; } \
              _Pragma("unroll") for (int r = 0; r < 16; ++r) negm[r] = -mhat; PIN(negm); \
              const float f = __builtin_amdgcn_exp2f(-dl); l_reg *= f; if (hi == 0) wsf[r32] = f; resc = true; } } \
        SBAR(); \
        const int ks_nn_ = ks_next; \
        GAPB(o[0] = __builtin_amdgcn_mfma_f32_32x32x16_bf16(PAF(0), VFR(0), o[0], 0, 0, 0), C0, 0); \
        GAPB(o[1] = __builtin_amdgcn_mfma_f32_32x32x16_bf16(PAF(0), VFR(4), o[1], 0, 0, 0), C0, 4); \
        KRD(0); GAPB(o[0] = __builtin_amdgcn_mfma_f32_32x32x16_bf16(PAF(1), VFR(1), o[0], 0, 0, 0), C0, 8); \
        KRD(1); GAPB(o[1] = __builtin_amdgcn_mfma_f32_32x32x16_bf16(PAF(1), VFR(5), o[1], 0, 0, 0), C0, 12); \
        KRD(2); GAPB(o[0] = __builtin_amdgcn_mfma_f32_32x32x16_bf16(PAF(2), VFR(2), o[0], 0, 0, 0), C1, 0); \
        KRD(3); GAPB(o[1] = __builtin_amdgcn_mfma_f32_32x32x16_bf16(PAF(2), VFR(6), o[1], 0, 0, 0), C1, 4); \
        GAPB(o[0] = __builtin_amdgcn_mfma_f32_32x32x16_bf16(PAF(3), VFR(3), o[0], 0, 0, 0), C1, 8); \
        GAPB(o[1] = __builtin_amdgcn_mfma_f32_32x32x16_bf16(PAF(3), VFR(7), o[1], 0, 0, 0), C1, 12); \
    } while (0)
    ROT();
    int t = 1;
    for (; t + 1 < NT; t += 2) {
        STEP(pB0, pB1, pA0, pA1, t);     WAIT_STEP(); RESC(); ROT();
        STEP(pA0, pA1, pB0, pB1, t + 1); WAIT_STEP(); RESC(); ROT();
    }
    if (t < NT) {
        STEP(pB0, pB1, pA0, pA1, t);     WAIT_STEP(); RESC(); ROT();
        pA0 = pB0; pA1 = pB1;
    }
    {
        float sacc = 0.f;
#pragma unroll
        for (int r = 0; r < 16; ++r) sacc += pA0[r] + pA1[r];
        l_reg += sacc;
        pw0 = (u32x4){cvtpk(pA0[0], pA0[1]), cvtpk(pA0[2], pA0[3]), cvtpk(pA0[4], pA0[5]), cvtpk(pA0[6], pA0[7])};
        pw1 = (u32x4){cvtpk(pA0[8], pA0[9]), cvtpk(pA0[10], pA0[11]), cvtpk(pA0[12], pA0[13]), cvtpk(pA0[14], pA0[15])};
        pw2 = (u32x4){cvtpk(pA1[0], pA1[1]), cvtpk(pA1[2], pA1[3]), cvtpk(pA1[4], pA1[5]), cvtpk(pA1[6], pA1[7])};
        pw3 = (u32x4){cvtpk(pA1[8], pA1[9]), cvtpk(pA1[10], pA1[11]), cvtpk(pA1[12], pA1[13]), cvtpk(pA1[14], pA1[15])};
        const lds_cptr vp_ = vp0 + vs_prev;
#pragma unroll
        for (int i = 0; i < 8; ++i) VRD(i);
        o[0] = __builtin_amdgcn_mfma_f32_32x32x16_bf16(PAF(0), VFR(0), o[0], 0, 0, 0); o[1] = __builtin_amdgcn_mfma_f32_32x32x16_bf16(PAF(0), VFR(4), o[1], 0, 0, 0);
        o[0] = __builtin_amdgcn_mfma_f32_32x32x16_bf16(PAF(1), VFR(1), o[0], 0, 0, 0); o[1] = __builtin_amdgcn_mfma_f32_32x32x16_bf16(PAF(1), VFR(5), o[1], 0, 0, 0);
        o[0] = __builtin_amdgcn_mfma_f32_32x32x16_bf16(PAF(2), VFR(2), o[0], 0, 0, 0); o[1] = __builtin_amdgcn_mfma_f32_32x32x16_bf16(PAF(2), VFR(6), o[1], 0, 0, 0);
        o[0] = __builtin_amdgcn_mfma_f32_32x32x16_bf16(PAF(3), VFR(3), o[0], 0, 0, 0); o[1] = __builtin_amdgcn_mfma_f32_32x32x16_bf16(PAF(3), VFR(7), o[1], 0, 0, 0);
    }
    l_reg = fa::xhalf_sum(l_reg);
    if (MODE == 1 || MODE == 3) l_reg += __builtin_amdgcn_exp2f(sink2 - mhat);
    if (hi == 0) wsf[32 + r32] = 1.0f / l_reg;
    float rli[16];
#pragma unroll
    for (int r = 0; r < 16; ++r) rli[r] = wsf[32 + crow(r, hi)];
    bf16_t* stg = (bf16_t*)(shm + LDS_OST) + wid * 2048;
#pragma unroll
    for (int r = 0; r < 16; ++r) { const int orow = crow(r, hi);
#pragma unroll
        for (int dh = 0; dh < 2; ++dh) stg[orow * 64 + dh * 32 + r32] = (bf16_t)f2bf(o[dh][r] * rli[r]); }
#pragma unroll
    for (int i = 0; i < 4; ++i) { const int row = i * 8 + (lane >> 3), ch = lane & 7; const u32x4 v = *(const u32x4*)(stg + row * 64 + ch * 8); *(u32x4*)(Og + (size_t)(wid * 32 + row) * D + ch * 8) = v; }
    asm volatile("s_waitcnt vmcnt(0) lgkmcnt(0)\n\ts_barrier" ::: "memory");
#undef FA_KEY0
#undef DMA_K
#undef DMA_V
#undef WAIT_STEP
#undef MASK
#undef ROWMAX
#undef KLOAD
#undef KLOAD2
#undef ROT
#undef RESC
#undef VRD
#undef VFR
#undef PAF
#undef GAPA
#undef EX
#undef GAPB
#undef KRD
#undef STEP
}
#undef SBAR
#undef PIN
}

constexpr float SCALE_MLA = 0.10206207261596575f;
__device__ __forceinline__ void ph_attn(const Params& p, int layer, bool with_ctx, char* shm) {
    const QKVB qb = make_qkv(p.ws);
    bf16_t* O = (bf16_t*)(p.ws + WS_P);
    const int G = gridDim.x;
    const float NEG = -INFINITY;
    for (int u = blockIdx.x; u < 256; u += G) { const int bh = u & 7, b = bh >> 2, h = bh & 3, qbk = u >> 3;
        fa2::attn_unit<96, 0, 6>(qb.QD + ((size_t)bh * SEQ + qbk * 256) * 96, qb.KD + (size_t)bh * KEYS * 96, qb.VD + (size_t)bh * KEYS * 64, O + (size_t)(b * SEQ + qbk * 256) * D + 768 + h * 64, qbk * 256, NEG, nullptr, shm); }
    for (int u = blockIdx.x; u < 256; u += G) { const int bh = u & 7, b = bh >> 2, h = bh & 3, qbk = u >> 3;
        fa2::attn_unit<64, 0, 6>(qb.QB + ((size_t)bh * SEQ + qbk * 256) * 64, qb.KB + (size_t)(b * 2 + (h >> 1)) * KEYS * 64, qb.VB + (size_t)(b * 2 + (h >> 1)) * KEYS * 64, O + (size_t)(b * SEQ + qbk * 256) * D + 256 + h * 64, qbk * 256, NEG, nullptr, shm); }
    for (int u = blockIdx.x; u < 256; u += G) { const int bh = u & 7, b = bh >> 2, h = bh & 3, qbk = u >> 3;
        fa2::attn_unit<64, 1, 6>(qb.QA + ((size_t)bh * SEQ + qbk * 256) * 64, qb.KA + (size_t)(b * 2 + (h >> 1)) * KEYS * 64, qb.VA + (size_t)(b * 2 + (h >> 1)) * KEYS * 64, O + (size_t)(b * SEQ + qbk * 256) * D + 0 + h * 64, qbk * 256, p.in[11][layer * 4 + h] * fa::LOG2E, nullptr, shm); }
    for (int u = blockIdx.x; u < 256; u += G) { const int bh = u & 7, b = bh >> 2, h = bh & 3, qbk = u >> 3;
        fa2::attn_unit<64, 2, 6>(qb.QC + ((size_t)bh * SEQ + qbk * 256) * 64, qb.KC + (size_t)bh * KEYS * 64, qb.VC + (size_t)bh * KEYS * 64, O + (size_t)(b * SEQ + qbk * 256) * D + 512 + h * 64, qbk * 256, NEG, p.in[16] + ((size_t)layer * 4 + h) * 15 * 31, shm); }
    if (with_ctx) for (int u = blockIdx.x; u < 32; u += G) { const int ty = u >> 3, bh = u & 7, b = bh >> 2, h = bh & 3;
        bf16_t* Oc = O + (size_t)(TL + b * CTX) * D + ty * 256 + h * 64;
        if (ty == 0) fa2::attn_unit<64, 3, 6>(qb.QAc + (size_t)bh * CTX * 64, qb.KA + (size_t)(b * 2 + (h >> 1)) * KEYS * 64, qb.VA + (size_t)(b * 2 + (h >> 1)) * KEYS * 64, Oc, 0, p.in[11][layer * 4 + h] * fa::LOG2E, nullptr, shm);
        else if (ty == 1) fa2::attn_unit<64, 3, 6>(qb.QBc + (size_t)bh * CTX * 64, qb.KB + (size_t)(b * 2 + (h >> 1)) * KEYS * 64, qb.VB + (size_t)(b * 2 + (h >> 1)) * KEYS * 64, Oc, 0, NEG, nullptr, shm);
        else if (ty == 2) fa2::attn_unit<64, 3, 6>(qb.QCc + (size_t)bh * CTX * 64, qb.KC + (size_t)bh * KEYS * 64, qb.VC + (size_t)bh * KEYS * 64, Oc, 0, NEG, nullptr, shm);
        else fa2::attn_unit<96, 3, 6>(qb.QDc + (size_t)bh * CTX * 96, qb.KD + (size_t)bh * KEYS * 96, qb.VD + (size_t)bh * KEYS * 64, Oc, 0, NEG, nullptr, shm); }
}

__device__ __forceinline__ void ph_gnorm(const Params& p, int layer, int nrows) {
    const int tx = opq((int)threadIdx.x), lane = tx & 63, gw = (blockIdx.x * 512 + tx) >> 6, ngw = (gridDim.x * 512) >> 6;
    const bf16_t* O = (const bf16_t*)(p.ws + WS_P); bf16_t* Y = (bf16_t*)(p.ws + WS_ACT1); const float* g = p.in[23] + layer * D;
    for (int m = gw; m < nrows; m += ngw) {
#pragma unroll
        for (int grp = 0; grp < 4; ++grp) { const int c = grp * 256 + 4 * lane; const u32x2 w = *(const u32x2*)(O + (size_t)m * D + c);
            const float a0 = bflo(w.x), a1 = bfhi(w.x), a2 = bflo(w.y), a3 = bfhi(w.y);
            const float r = rsqrtf(wave_sum(a0 * a0 + a1 * a1 + a2 * a2 + a3 * a3) * (1.f / 256.f) + EPS);
            const f32x4 gv = *(const f32x4*)(g + c); u32x2 o; o.x = pk2(a0 * r * gv.x, a1 * r * gv.y); o.y = pk2(a2 * r * gv.z, a3 * r * gv.w);
            *(u32x2*)(Y + (size_t)m * D + c) = o; }
    }
}

__device__ __forceinline__ void moe_bases(const unsigned* cnt, int (&base)[9]) {
    int acc = 0;
#pragma unroll
    for (int e = 0; e < 8; ++e) { base[e] = acc; acc += ((int)cnt[64 * e] + 255) / 256 * 256; }
    base[8] = acc;
}
__device__ __forceinline__ void ph_moe_gather(const Params& p) {
    const int tx = opq((int)threadIdx.x), lane = tx & 63, gw = (blockIdx.x * 512 + tx) >> 6, ngw = (gridDim.x * 512) >> 6;
    const unsigned* cnt = (const unsigned*)(p.ws + WS_CTL); int base[9]; moe_bases(cnt, base);
    if (blockIdx.x == 0 && tx < 136) { const int r = tx * 256; int e = -1;
#pragma unroll
        for (int i = 0; i < 8; ++i) if (r >= base[i] && r < base[i + 1]) e = i;
        ((int*)(p.ws + WS_TEXP))[tx] = e < 0 ? 0 : e; }
    const bf16_t* F = (const bf16_t*)(p.ws + WS_ACT1); bf16_t* A = (bf16_t*)(p.ws + WS_ASORT);
    for (int m = gw; m < TL; m += ngw) {
        const int2 e = ((const int2*)(p.ws + WS_TOKE))[m]; const int2 ps = ((const int2*)(p.ws + WS_TOKP))[m];
        int b0 = 0, b1 = 0;
#pragma unroll
        for (int i = 0; i < 8; ++i) { if (e.x == i) b0 = base[i]; if (e.y == i) b1 = base[i]; }
        const int s0 = b0 + ps.x, s1 = b1 + ps.y;
        const u32x4 v0 = *(const u32x4*)(F + (size_t)m * D + lane * 16), v1 = *(const u32x4*)(F + (size_t)m * D + lane * 16 + 8);
        *(u32x4*)(A + (size_t)s0 * D + lane * 16) = v0; *(u32x4*)(A + (size_t)s0 * D + lane * 16 + 8) = v1;
        *(u32x4*)(A + (size_t)s1 * D + lane * 16) = v0; *(u32x4*)(A + (size_t)s1 * D + lane * 16 + 8) = v1;
        if (lane == 0) ((int2*)(p.ws + WS_TOKS))[m] = make_int2(s0, s1);
    }
}
__device__ __forceinline__ void ph_moe_combine(const Params& p, int layer) {
    const size_t nthr = (size_t)gridDim.x * 512;
    for (size_t idx = (size_t)blockIdx.x * 512 + opq((int)threadIdx.x); idx < (size_t)TL * 256; idx += nthr) {
        const int m = (int)(idx >> 8), c = (int)(idx & 255) * 4;
        const int2 sl = ((const int2*)(p.ws + WS_TOKS))[m]; const float2 g = ((const float2*)(p.ws + WS_TOKG))[m];
        const bf16_t* Y = (const bf16_t*)(p.ws + WS_ASORT);
        const u32x2 a = *(const u32x2*)(Y + (size_t)sl.x * D + c), b = *(const u32x2*)(Y + (size_t)sl.y * D + c);
        const f32x4 ya = {bflo(a.x), bfhi(a.x), bflo(a.y), bfhi(a.y)}, yb = {bflo(b.x), bfhi(b.x), bflo(b.y), bfhi(b.y)};
        const float* mod = (const float*)(p.ws + WS_MOD) + (size_t)layer * 3 * 6144 + (m / SEQ) * 6144 + 5 * D;
        f32x4* o = (f32x4*)(p.out + (size_t)m * D + c);
        *o = *o + *(const f32x4*)(mod + c) * (ya * g.x + yb * g.y);
    }
}

#ifndef DBL_PHASE
#define DBL_PHASE (-1)
#endif
#ifndef FILL_Q_IN
#define FILL_Q_IN 0
#define FILL_Q_OUT 0
#define FILL_Q_UP 0
#define FILL_Q_DN 0
#endif
struct Args { Params p; int ph_lo, ph_hi; };
__global__ void __launch_bounds__(NWAVES * 64, 2) mega_fwd(Args args) {
    extern __shared__ __attribute__((aligned(16))) unsigned char lds[];
    LAS unsigned char* ldsl = (LAS unsigned char*)lds;
    for (int u = threadIdx.x; u < (LDS_BYTES - LDSCTL_OFF) / 4; u += NWAVES * 64) ((LAS unsigned*)(ldsl + LDSCTL_OFF))[u] = 0u;
    __syncthreads();
    XcdBarrier bar = xcd_barrier_post((unsigned*)(args.p.ws + WS_CTL) + CW_BAR, (volatile LAS unsigned*)(ldsl + MISC_OFF) + 8);
    const int lo = args.ph_lo, hi = args.ph_hi;
#pragma unroll 1
    for (int ph = lo; ph < hi; ++ph) {
      const int nrep = (ph == DBL_PHASE) ? 2 : 1;
#pragma unroll 1
      for (int rep_ = 0; rep_ < nrep; ++rep_) {
        if (rep_) xcd_barrier(bar);
        Params q = args.p; q.ws = opqp(args.p.ws); q.out = opqp(args.p.out);
        LAS unsigned char* ldq = (LAS unsigned char*)lds;
        const int l = ph >= 10 ? 1 : 0, st = ph == 0 ? -1 : (l ? ph - 10 : ph - 1);
        const bool last = (l == 1); const int nrows = last ? TL : MALL;
        const float* qmod = (const float*)(q.ws + WS_MOD) + (size_t)l * 3 * 6144;
        int fillq = 0, fill_nwg = 1;
        if (st == -1) ph_prologue(q, (float*)lds);
        else if (st == 0) ph_norm<1, false>(q, l, MALL, (unsigned*)lds, l ? 11 : 0);
        else if (st == 1) { run_gemm(ldq, (const bf16_t*)(q.ws + WS_ACT1), (const bf16_t*)(q.ws + WS_WIN) + (size_t)l * NINP * D, D, MALL / 256, NINP / 256, nullptr, 0, EpiBf16Perm{(bf16_t*)(q.ws + WS_P), NINP, 0});
                            fillq = FILL_Q_IN; fill_nwg = (MALL / 256) * (NINP / 256); }
        else if (st == 2) ph_postproj2(q, l);
        else if (st == 3) ph_attn(q, l, !last, (char*)lds);
        else if (st == 4) ph_gnorm(q, l, nrows);
        else if (st == 5 || (st == 8 && !last)) {
            const bool op = (st == 5);
            const bf16_t* A_ = (const bf16_t*)(q.ws + (op ? WS_ACT1 : WS_HIDF)); const bf16_t* B_ = op ? (const bf16_t*)(q.ws + WS_WOUT) + (size_t)l * D * D : (const bf16_t*)(q.ws + WS_WFDN);
            const int K_ = op ? D : DFF, goff_ = op ? 2 * D : 5 * D;
            const float* hl_in_ = (op && l == 0) ? q.in[0] : q.out;
#pragma unroll 1
            for (int pass = 0; pass < (last ? 1 : 2); ++pass)
                run_gemm(ldq, A_, B_, K_, pass ? 2 : 64, D / 256, nullptr, 0, EpiResid{hl_in_, (const float*)(q.ws + WS_HCTX), q.out, pass ? (float*)(q.ws + WS_PART) : (float*)(q.ws + WS_HCTX), qmod, goff_, pass}, pass ? (op ? 8 : 11) : 1, pass ? 64 : 0);
        }
        else if (!last) {
            if (st == 6) ph_norm<2, false>(q, l, MALL, (unsigned*)lds, 8);
            else if (st == 7) { run_gemm(ldq, (const bf16_t*)(q.ws + WS_ACT1), (const bf16_t*)(q.ws + WS_WFGU), D, MALL / 256, 2 * DFF / 256, nullptr, 0, EpiSwiglu{(bf16_t*)(q.ws + WS_HIDF), DFF, 0});
                                fillq = FILL_Q_UP; fill_nwg = (MALL / 256) * (2 * DFF / 256); }
            else {}
        } else {
            if (st == 6) ph_norm<2, true>(q, l, TL, (unsigned*)lds, 0);
            else if (st == 7) { ph_moe_gather(q); fillq = 1 << 30; fill_nwg = 0; }
            else if (st == 8) { int base[9]; moe_bases((const unsigned*)(q.ws + WS_CTL), base); run_gemm(ldq, (const bf16_t*)(q.ws + WS_ASORT), (const bf16_t*)(q.ws + WS_WMGU), D, __builtin_amdgcn_readfirstlane(base[8] / 256), 2 * DFFE / 256, (const int*)(q.ws + WS_TEXP), (size_t)2 * DFFE * D * 2, EpiSwiglu{(bf16_t*)(q.ws + WS_HIDM), DFFE, 0}); }
            else if (st == 9) { int base[9]; moe_bases((const unsigned*)(q.ws + WS_CTL), base); run_gemm(ldq, (const bf16_t*)(q.ws + WS_HIDM), (const bf16_t*)(q.ws + WS_WMDN), DFFE, __builtin_amdgcn_readfirstlane(base[8] / 256), D / 256, (const int*)(q.ws + WS_TEXP), (size_t)D * DFFE * 2, EpiBf16Perm{(bf16_t*)(q.ws + WS_ASORT), D, 0}); }
            else ph_moe_combine(q, l);
        }
        if (fillq > 0 && (fill_nwg == 0 || gemm_tail_idle(fill_nwg))) fill_moe(q, (float*)lds, fillq);
      }
      if (ph + 1 < hi) xcd_barrier(bar);
    }
}

#ifndef MK_CUTS
#define MK_CUTS 0
#endif
extern "C" void kernel_launch(void* const* d_in, const int* in_sizes, int n_in, void* d_out, int out_size, void* d_ws, size_t ws_size, hipStream_t stream) {
    static int grid = 0;
    if (grid == 0) {
        if (n_in != 32 || ws_size < WS_END) { fprintf(stderr, "kernel_launch: need 32 inputs and %zu bytes of workspace (got %d, %zu)\n", (size_t)WS_END, n_in, ws_size); grid = -1; return; }
        int dev = 0, cus = 0, per_cu = 0;
        if (hipGetDevice(&dev) != hipSuccess || hipDeviceGetAttribute(&cus, hipDeviceAttributeMultiprocessorCount, dev) != hipSuccess) { grid = -1; return; }
        if (hipFuncSetAttribute((const void*)mega_fwd, hipFuncAttributeMaxDynamicSharedMemorySize, LDS_BYTES) != hipSuccess) { fprintf(stderr, "kernel_launch: hipFuncSetAttribute failed\n"); grid = -1; return; }
        if (hipOccupancyMaxActiveBlocksPerMultiprocessor(&per_cu, (const void*)mega_fwd, NWAVES * 64, LDS_BYTES) != hipSuccess || per_cu < 1) fprintf(stderr, "kernel_launch: occupancy query says %d blocks per CU\n", per_cu);
        (void)hipGetLastError();
        grid = cus;
    }
    if (grid < 0) return;
    (void)hipMemsetAsync((char*)d_ws + WS_CTL, 0, CTL_ZERO_BYTES, stream);
    Args a{}; for (int i = 0; i < 32; ++i) a.p.in[i] = (const float*)d_in[i]; a.p.out = (float*)d_out; a.p.ws = (unsigned char*)d_ws;
#if MK_CUTS
    for (int ph = 0; ph < 24; ++ph) { a.ph_lo = ph; a.ph_hi = ph + 1; hipLaunchKernelGGL(mega_fwd, dim3(grid), dim3(NWAVES * 64), LDS_BYTES, stream, a); }
#else
    a.ph_lo = 0; a.ph_hi = 21;
    hipLaunchKernelGGL(mega_fwd, dim3(grid), dim3(NWAVES * 64), LDS_BYTES, stream, a);
#endif
}
```

```cpp
#include <hip/hip_runtime.h>
#include <stdint.h>
#include <cstdio>

typedef unsigned short bf16_t;
typedef float f32x4 __attribute__((ext_vector_type(4)));
typedef unsigned u32x4 __attribute__((ext_vector_type(4)));
typedef unsigned u32x2 __attribute__((ext_vector_type(2)));

constexpr int D = 1024, NB = 2, SEQ = 8192, CTX = 256, TL = NB * SEQ, TC = NB * CTX, MALL = TL + TC;
constexpr int NIN = 2144, NINP = 2304, DFF = 2816, NE = 8, DFFE = 3584, KEYS = CTX + SEQ;
constexpr int OFF_AQ = 0, OFF_AK = 256, OFF_AV = 384, OFF_BQ = 512, OFF_BK = 768, OFF_BV = 896, OFF_CQ = 1024, OFF_CK = 1280,
              OFF_CV = 1536, OFF_DCQ = 1792, OFF_DCKV = 1984, OFF_DKR = 2112;
constexpr int MOE_ROWS = 34816;
constexpr float EPS = 1e-6f;

constexpr size_t MiB = 1u << 20;
constexpr size_t WS_CTL = 0;
constexpr size_t WS_MOD = 1 * MiB;
constexpr size_t WS_ROPE = WS_MOD + 256 * 1024;
constexpr size_t WS_TOKE = WS_ROPE + 64 * 1024;
constexpr size_t WS_TOKP = WS_TOKE + TL * 8;
constexpr size_t WS_TOKG = WS_TOKP + TL * 8;
constexpr size_t WS_TEXP = WS_TOKG + TL * 8;
constexpr size_t WS_TOKS = WS_TEXP + 1024;
constexpr size_t WS_HCTX = 2 * MiB;
constexpr size_t WS_WMGU = 6 * MiB;
constexpr size_t WS_WMDN = WS_WMGU + 112 * MiB;
constexpr size_t WS_WDEAD = WS_WMDN + 56 * MiB;
constexpr size_t WS_WIN = WS_WDEAD;
constexpr size_t WS_WOUT = WS_WIN + 9 * MiB;
constexpr size_t WS_WUQ = WS_WOUT + 4 * MiB;
constexpr size_t WS_WUKV = WS_WUQ + 512 * 1024;
constexpr size_t WS_WFGU = WS_WUKV + 512 * 1024;
constexpr size_t WS_WFDN = WS_WFGU + 11 * MiB;
constexpr size_t WS_ACT = 205 * MiB;
static_assert(WS_WFDN + (size_t)1024 * 2816 * 2 <= WS_ACT, "weights fit");
constexpr size_t WS_ACT1 = WS_ACT;
constexpr size_t WS_P = WS_ACT + 33 * MiB;
constexpr size_t WS_QKV = WS_ACT + 108 * MiB;
constexpr size_t WS_PART = WS_ACT + 128 * MiB;
constexpr size_t WS_HIDF = WS_P;
constexpr size_t WS_HIDM = WS_WDEAD;
constexpr size_t WS_ASORT = WS_HIDM + 238 * MiB;
constexpr size_t WS_END = WS_ASORT + 68 * MiB;
static_assert(WS_QKV + 91 * MiB <= WS_END, "qkv fits");

struct Params { const float* in[32]; float* out; unsigned char* ws; };

struct QKVB { bf16_t *QA, *KA, *VA, *QB, *KB, *VB, *QC, *KC, *VC, *QD, *KD, *VD, *QAc, *QBc, *QCc, *QDc; };
__host__ __device__ inline QKVB make_qkv(unsigned char* ws) {
    QKVB q; bf16_t* p = (bf16_t*)(ws + WS_QKV);
    q.QA = p; p += (size_t)NB * 4 * SEQ * 64; q.KA = p; p += (size_t)NB * 2 * KEYS * 64; q.VA = p; p += (size_t)NB * 2 * KEYS * 64;
    q.QB = p; p += (size_t)NB * 4 * SEQ * 64; q.KB = p; p += (size_t)NB * 2 * KEYS * 64; q.VB = p; p += (size_t)NB * 2 * KEYS * 64;
    q.QC = p; p += (size_t)NB * 4 * SEQ * 64; q.KC = p; p += (size_t)NB * 4 * KEYS * 64; q.VC = p; p += (size_t)NB * 4 * KEYS * 64;
    q.QD = p; p += (size_t)NB * 4 * SEQ * 96; q.KD = p; p += (size_t)NB * 4 * KEYS * 96; q.VD = p; p += (size_t)NB * 4 * KEYS * 64;
    q.QAc = p; p += (size_t)NB * 4 * CTX * 64; q.QBc = p; p += (size_t)NB * 4 * CTX * 64; q.QCc = p; p += (size_t)NB * 4 * CTX * 64;
    q.QDc = p; p += (size_t)NB * 4 * CTX * 96;
    return q;
}

__device__ __forceinline__ float bf2f(unsigned v) { return __uint_as_float(v << 16); }
__device__ __forceinline__ float bflo(unsigned w) { return __uint_as_float(w << 16); }
__device__ __forceinline__ float bfhi(unsigned w) { return __uint_as_float(w & 0xffff0000u); }
__device__ __forceinline__ unsigned f2bf(float f) { unsigned u = __float_as_uint(f); return (u + 0x7fffu + ((u >> 16) & 1u)) >> 16; }
typedef float pk_f32x2 __attribute__((ext_vector_type(2))); typedef __bf16 pk_bf16x2 __attribute__((ext_vector_type(2)));
__device__ __forceinline__ unsigned pk2(float lo, float hi) { pk_f32x2 v = {lo, hi}; pk_bf16x2 b = __builtin_convertvector(v, pk_bf16x2); return __builtin_bit_cast(unsigned, b); }
template <int X> __device__ __forceinline__ float swz_xor(float v) { return __int_as_float(__builtin_amdgcn_ds_swizzle(__float_as_int(v), 0x1f | (X << 10))); }
__device__ __forceinline__ float half_sum(float v) { auto rr = __builtin_amdgcn_permlane32_swap(__float_as_uint(v), __float_as_uint(v), false, false); return __uint_as_float(rr[0]) + __uint_as_float(rr[1]); }
__device__ __forceinline__ float half_other(float v, int lane) { auto rr = __builtin_amdgcn_permlane32_swap(__float_as_uint(v), __float_as_uint(v), false, false); return __uint_as_float((lane & 32) ? rr[0] : rr[1]); }
__device__ __forceinline__ float wave_sum(float v) { v += swz_xor<1>(v); v += swz_xor<2>(v); v += swz_xor<4>(v); v += swz_xor<8>(v); v += swz_xor<16>(v); return half_sum(v); }
__device__ __forceinline__ int opq(int v) { asm volatile("" : "+v"(v)); return v; }
template <class T> __device__ __forceinline__ T* opqp(T* p) { asm volatile("" : "+s"(p)); return p; }
__device__ __forceinline__ int opqs(int v) { asm volatile("" : "+s"(v)); return v; }
__device__ __forceinline__ float silu_f(float x) { return x / (1.f + expf(-x)); }
__device__ __forceinline__ float silu_fast(float x) { return x * __builtin_amdgcn_rcpf(1.f + __builtin_amdgcn_exp2f(-1.4426950408889634f * x)); }

constexpr int RT_R64 = 0, RT_C64 = 2048, RT_R32 = 3072, RT_C32 = 4096, RT_N = 4608;

namespace pg8 {
#define PG8_LAS __attribute__((address_space(3)))
typedef unsigned short bf16_t;
typedef short bf16x8 __attribute__((ext_vector_type(8)));
typedef float f32x4 __attribute__((ext_vector_type(4)));
typedef unsigned u32x4 __attribute__((ext_vector_type(4)));
constexpr int BM = 256, BK = 64, HALF = 128, HTB = HALF * BK * 2  , STAGE_BYTES = 8 * HTB, NXCD = 8, WGM = 8;

__host__ __device__ __forceinline__ int lds_byte(int r, int c) { const int st = (r >> 4) * 2 + (c >> 5), rr = r & 15, cc = c & 31, ob = rr * 64 + cc * 2; return st * 1024 + (ob ^ (((ob >> 9) & 1) << 5)); }
__host__ __device__ __forceinline__ void stage_rc(int b, int& R, int& C) { const int st = b / 1024, sb = b % 1024, swz = sb ^ (((sb >> 9) & 1) << 5); R = (st >> 1) * 16 + swz / 64; C = (st & 1) * 32 + (swz % 64) / 2; }
__host__ __device__ __forceinline__ int perm32(int rho) { const int n = rho >> 4, i = rho & 15; return 8 * (i >> 2) + 4 * n + (i & 3); }

struct Unit { int pm, pn, e, ks; };
struct Gemm { const bf16_t* A; const bf16_t* Bt; int K; size_t estride; int Kloop; };

struct StaticOrder {
    int nM, nN, nwg, G, c, S, pm0; const int* texp;
    __host__ __device__ void init(int nM_, int nN_, int G_, int c_, const int* texp_, int S_ = 1, int pm0_ = 0) { nM = nM_; nN = nN_; nwg = nM * nN; G = G_; c = c_; texp = texp_; S = S_; pm0 = pm0_; }
    __host__ __device__ bool next(int i, Unit& u) const {
        const long L = (long)i * G + c; if (L >= (long)nwg * S) return false;
        u.ks = (int)(L % S); int wgid = (int)(L / S); { const int q = nwg / NXCD, r = nwg % NXCD, xcd = wgid % NXCD, off = wgid / NXCD; wgid = (xcd < r ? xcd * (q + 1) : r * (q + 1) + (xcd - r) * q) + off; }
        const int nig = WGM * nN, gid = wgid / nig, fm = gid * WGM, gsz = (nM - fm) < WGM ? (nM - fm) : WGM;
        u.pm = fm + ((wgid % nig) % gsz); u.pn = (wgid % nig) / gsz; u.e = texp ? texp[u.pm] : 0; u.pm += pm0; return true;
    }
    __device__ __forceinline__ void a_ready(const Unit&) const {}
    __device__ __forceinline__ void done(const Unit&) const {}
};

template <class Epi, class Sched, bool ALIGN_EPI = false, bool SP2 = false>
__device__ __forceinline__ void gemm_phase(PG8_LAS unsigned char* lds, const Gemm g, const Sched& S, const Epi& E) {
    const int tid = opq((int)threadIdx.x), wid = __builtin_amdgcn_readfirstlane(tid >> 6), lane = tid & 63, wr = wid >> 2, wc = wid & 3, fr = lane & 15, fq = lane >> 4;
    const int K = g.K, nt = g.Kloop / BK;
    unsigned voffA[2], voffB[2];
#pragma unroll
    for (int i = 0; i < 2; ++i) { int R, C; stage_rc(tid * 16 + i * 8192, R, C); const int Rb = Epi::PERM ? ((R & ~31) + perm32(R & 31)) : R;
        voffA[i] = (unsigned)(R * K + C) * 2u; voffB[i] = (unsigned)(Rb * K + C) * 2u; }
    const size_t kstep = (size_t)(BK * 2);
    const size_t hstep = (size_t)HALF * K * 2;
    const size_t tstep = 2 * hstep;
    const unsigned ldsw = (unsigned)wid * 1024u;
    const int aoff = lds_byte(wr * 64 + fr, fq * 8), boff = lds_byte(wc * 32 + fr, fq * 8);
#define PG8_SA(b, h) (((b) * 2 + (h)) * HTB)
#define PG8_SB(b, h) ((4 + (b) * 2 + (h)) * HTB)
#define PG8_STAGE(bufoff, gbase, voff) do { _Pragma("unroll") for (int _i = 0; _i < 2; ++_i) \
        __builtin_amdgcn_global_load_lds((const unsigned*)((const char*)(gbase) + (voff)[_i]), (PG8_LAS unsigned*)(lds + (bufoff) + ldsw + _i * 8192), 16, 0, 0); } while (0)
#define PG8_LDA(dst, b, h) do { _Pragma("unroll") for (int m = 0; m < 4; ++m) _Pragma("unroll") for (int k = 0; k < 2; ++k) dst[m][k] = *(const PG8_LAS bf16x8*)(lds + PG8_SA(b, h) + aoff + m * 2048 + k * 1024); } while (0)
#define PG8_LDB(dst, b, h) do { _Pragma("unroll") for (int n = 0; n < 2; ++n) _Pragma("unroll") for (int k = 0; k < 2; ++k) dst[n][k] = *(const PG8_LAS bf16x8*)(lds + PG8_SB(b, h) + boff + n * 2048 + k * 1024); } while (0)
#define PG8_MMA(ai, bj, At, Bt) do { __builtin_amdgcn_s_setprio(1); _Pragma("unroll") for (int m = 0; m < 4; ++m) _Pragma("unroll") for (int n = 0; n < 2; ++n) _Pragma("unroll") for (int k = 0; k < 2; ++k) \
        acc[ai][bj][m][n] = __builtin_amdgcn_mfma_f32_16x16x32_bf16(Bt[n][k], At[m][k], acc[ai][bj][m][n], 0, 0, 0); __builtin_amdgcn_s_setprio(0); } while (0)
#define PG8_WAIT_V(n) asm volatile("s_waitcnt vmcnt(" #n ")" ::: "memory")
#define PG8_WAIT_L(n) asm volatile("s_waitcnt lgkmcnt(" #n ")" ::: "memory")
#define PG8_BAR __builtin_amdgcn_s_barrier()
#define PG8_SCHED __builtin_amdgcn_sched_barrier(0)
    Unit cur, nxt; int ui = 0;
    if (!S.next(0, cur)) return;
    f32x4 acc[2][2][4][2];
#pragma unroll
    for (int a = 0; a < 2; ++a)
#pragma unroll
        for (int b = 0; b < 2; ++b)
#pragma unroll
            for (int m = 0; m < 4; ++m)
#pragma unroll
                for (int n = 0; n < 2; ++n) acc[a][b][m][n] = (f32x4){0.f, 0.f, 0.f, 0.f};
    bf16x8 At[4][2], B0[2][2], B1[2][2];
    const char* cA = (const char*)g.A + (size_t)cur.pm * tstep + (size_t)cur.ks * g.Kloop * 2; const char* cB = (const char*)g.Bt + (size_t)cur.e * g.estride + (size_t)cur.pn * tstep + (size_t)cur.ks * g.Kloop * 2;
    S.a_ready(cur);
    if constexpr (SP2) {
        PG8_STAGE(PG8_SB(0, 0), cB, voffB); PG8_STAGE(PG8_SB(0, 1), cB + hstep, voffB); PG8_STAGE(PG8_SA(0, 0), cA, voffA); PG8_STAGE(PG8_SA(0, 1), cA + hstep, voffA);
        if (wr == 1) PG8_BAR;
        PG8_WAIT_V(2); PG8_BAR;
        PG8_STAGE(PG8_SB(1, 0), cB + kstep, voffB); PG8_STAGE(PG8_SA(1, 0), cA + kstep, voffA); PG8_STAGE(PG8_SB(1, 1), cB + hstep + kstep, voffB);
        PG8_WAIT_V(6); PG8_BAR;
    } else {
        PG8_STAGE(PG8_SB(0, 0), cB, voffB); PG8_STAGE(PG8_SA(0, 0), cA, voffA); PG8_STAGE(PG8_SB(0, 1), cB + hstep, voffB); PG8_STAGE(PG8_SA(0, 1), cA + hstep, voffA);
        if (wr == 1) PG8_BAR;
        PG8_WAIT_V(4); PG8_BAR;
        PG8_STAGE(PG8_SB(1, 0), cB + kstep, voffB); PG8_STAGE(PG8_SA(1, 0), cA + kstep, voffA); PG8_STAGE(PG8_SB(1, 1), cB + hstep + kstep, voffB);
        PG8_WAIT_V(6); PG8_BAR;
    }
    for (;;) {
        const bool has_next = S.next(ui + 1, nxt);
        const char* nA = has_next ? (const char*)g.A + (size_t)nxt.pm * tstep + (size_t)nxt.ks * g.Kloop * 2 : cA; const char* nB = has_next ? (const char*)g.Bt + (size_t)nxt.e * g.estride + (size_t)nxt.pn * tstep + (size_t)nxt.ks * g.Kloop * 2 : cB;
        for (int t = 0; t < nt; t += 2) {
            const bool last = (t == nt - 2);
            const char* a1 = cA + (size_t)(t + 1) * kstep;
            const char* a2 = last ? nA : cA + (size_t)(t + 2) * kstep; const char* b2 = last ? nB : cB + (size_t)(t + 2) * kstep;
            const char* a3 = a2 + kstep; const char* b3 = b2 + kstep;
            if (last && has_next) S.a_ready(nxt);
            if constexpr (SP2) {
            PG8_LDB(B0, 0, 0); PG8_LDB(B1, 0, 1); PG8_SCHED; PG8_LDA(At, 0, 0); PG8_STAGE(PG8_SA(1, 1), a1 + hstep, voffA);
            PG8_WAIT_V(8); PG8_WAIT_L(0); PG8_BAR; PG8_MMA(0, 0, At, B0); PG8_MMA(0, 1, At, B1); PG8_BAR; PG8_SCHED;
            PG8_LDA(At, 0, 1); PG8_STAGE(PG8_SB(0, 0), b2, voffB); PG8_STAGE(PG8_SB(0, 1), b2 + hstep, voffB); PG8_STAGE(PG8_SA(0, 0), a2, voffA);
            PG8_WAIT_V(8); PG8_WAIT_L(0); PG8_BAR; PG8_MMA(1, 0, At, B0); PG8_MMA(1, 1, At, B1); PG8_BAR; PG8_SCHED;
            PG8_LDB(B0, 1, 0); PG8_LDB(B1, 1, 1); PG8_SCHED; PG8_LDA(At, 1, 0); PG8_STAGE(PG8_SA(0, 1), a2 + hstep, voffA);
            PG8_WAIT_V(8); PG8_WAIT_L(0); PG8_BAR; PG8_MMA(0, 0, At, B0); PG8_MMA(0, 1, At, B1); PG8_BAR; PG8_SCHED;
            PG8_LDA(At, 1, 1); PG8_STAGE(PG8_SB(1, 0), b3, voffB); PG8_STAGE(PG8_SB(1, 1), b3 + hstep, voffB); PG8_STAGE(PG8_SA(1, 0), a3, voffA);
            PG8_WAIT_V(8); PG8_WAIT_L(0); PG8_BAR; PG8_MMA(1, 0, At, B0); PG8_MMA(1, 1, At, B1); PG8_BAR; PG8_SCHED;
            } else {
            PG8_LDB(B0, 0, 0); PG8_SCHED; PG8_LDA(At, 0, 0); PG8_STAGE(PG8_SA(1, 1), a1 + hstep, voffA);
            PG8_WAIT_L(8); PG8_BAR; PG8_WAIT_L(0); PG8_MMA(0, 0, At, B0); PG8_BAR; PG8_SCHED;
            PG8_LDB(B1, 0, 1); PG8_STAGE(PG8_SB(0, 0), b2, voffB);
            PG8_BAR; PG8_WAIT_L(0); PG8_MMA(0, 1, At, B1); PG8_BAR;
            PG8_LDA(At, 0, 1); PG8_STAGE(PG8_SA(0, 0), a2, voffA);
            PG8_BAR; PG8_WAIT_L(0); PG8_MMA(1, 0, At, B0); PG8_BAR; PG8_SCHED;
            PG8_STAGE(PG8_SB(0, 1), b2 + hstep, voffB);
            PG8_WAIT_V(6); PG8_BAR; PG8_MMA(1, 1, At, B1); PG8_BAR;
            PG8_LDB(B0, 1, 0); PG8_SCHED; PG8_LDA(At, 1, 0); PG8_STAGE(PG8_SA(0, 1), a2 + hstep, voffA);
            PG8_WAIT_L(8); PG8_BAR; PG8_WAIT_L(0); PG8_MMA(0, 0, At, B0); PG8_BAR; PG8_SCHED;
            PG8_LDB(B1, 1, 1); PG8_STAGE(PG8_SB(1, 0), b3, voffB);
            PG8_BAR; PG8_WAIT_L(0); PG8_MMA(0, 1, At, B1); PG8_BAR;
            PG8_LDA(At, 1, 1); PG8_STAGE(PG8_SA(1, 0), a3, voffA);
            PG8_BAR; PG8_WAIT_L(0); PG8_MMA(1, 0, At, B0); PG8_BAR; PG8_SCHED;
            PG8_STAGE(PG8_SB(1, 1), b3 + hstep, voffB);
            PG8_WAIT_V(6); PG8_BAR; PG8_MMA(1, 1, At, B1); PG8_BAR;
            }
        }
        if constexpr (ALIGN_EPI) { if (wr == 0) PG8_BAR; }
        if constexpr (!Epi::AFTER_DRAIN) { E(acc, cur, wr, wc, fr, fq); S.done(cur); }
        if (!has_next) break;
#pragma unroll
        for (int a = 0; a < 2; ++a)
#pragma unroll
            for (int b = 0; b < 2; ++b)
#pragma unroll
                for (int m = 0; m < 4; ++m)
#pragma unroll
                    for (int n = 0; n < 2; ++n) acc[a][b][m][n] = (f32x4){0.f, 0.f, 0.f, 0.f};
        cur = nxt; cA = nA; cB = nB; ++ui;
        if constexpr (ALIGN_EPI) { if (wr == 1) PG8_BAR; }
    }
    PG8_WAIT_V(0);
    if constexpr (!ALIGN_EPI) { if (wr == 0) PG8_BAR; }
    PG8_BAR;
    if constexpr (Epi::AFTER_DRAIN) { E.fused(acc, cur, wr, wc, fr, fq, lds, wid, lane); S.done(cur); }
#undef PG8_SA
#undef PG8_SB
#undef PG8_STAGE
#undef PG8_LDA
#undef PG8_LDB
#undef PG8_MMA
#undef PG8_WAIT_V
#undef PG8_WAIT_L
#undef PG8_BAR
#undef PG8_SCHED
}
}

#define GAS __attribute__((address_space(1)))
#define LAS __attribute__((address_space(3)))
typedef GAS unsigned gu32;
#define RLX_AGENT __ATOMIC_RELAXED, __HIP_MEMORY_SCOPE_AGENT
constexpr int NWAVES = 8;
constexpr int CW_BAR = 4096;
constexpr int RING_BYTES = 131072, LDSCTL_OFF = RING_BYTES, MISC_OFF = LDSCTL_OFF + 320, LDS_BYTES = 147456;
constexpr size_t CTL_ZERO_BYTES = 65536;

#define XB_TMO      128
#define XB_XCNT(j)  (256  + 64 * (j))
#define XB_XSUB(j)  (1280 + 64 * (j))
#define XB_XGEN(j)  (2304 + 64 * (j))
#define XB_TOP      3328
#define XB_TOPGEN   3392
#define XCD_BAR_WORDS 3456
#define XB_SPIN_CAP (1u << 18)

__device__ __forceinline__ unsigned xb_ld(unsigned* p)              { return __hip_atomic_load(p, __ATOMIC_RELAXED, __HIP_MEMORY_SCOPE_AGENT); }
__device__ __forceinline__ unsigned xb_add(unsigned* p, unsigned v) { return __hip_atomic_fetch_add(p, v, __ATOMIC_RELAXED, __HIP_MEMORY_SCOPE_AGENT); }
__device__ __forceinline__ unsigned xb_xcc_id() { return (unsigned)__builtin_amdgcn_s_getreg((3 << 11) | 20) & 0xFu; }
#define XB_SPIN(cond, bar) do { unsigned _sp = 0; while (cond) { __builtin_amdgcn_s_sleep(1); \
    if ((++_sp & 255u) == 0u) { if (xb_ld(&(bar)[XB_TMO])) break; if (_sp > XB_SPIN_CAP) { atomicAdd(&(bar)[XB_TMO], 1u); break; } } } } while (0)

struct XcdBarrier {
    unsigned* bar; unsigned x;
    volatile LAS unsigned* st;
};

__device__ __forceinline__ XcdBarrier xcd_barrier_post(unsigned* bar, volatile LAS unsigned* st) {
    XcdBarrier b; b.bar = bar; b.x = xb_xcc_id(); b.st = st;
    if (threadIdx.x == 0) (void)xb_add(&bar[XB_XCNT(b.x)], 1u);
    return b;
}
__device__ __forceinline__ void xcd_barrier_complete(unsigned* bar, unsigned x, unsigned& nloc, unsigned& nx) {
    const unsigned G = gridDim.x * gridDim.y * gridDim.z;
    unsigned sum, cnt, mine, sp = 0u;
    for (;;) {
        sum = 0u; cnt = 0u; mine = 0u;
#pragma unroll
        for (unsigned j = 0; j < 16; ++j) { const unsigned c = xb_ld(&bar[XB_XCNT(j)]); sum += c; cnt += (c > 0u) ? 1u : 0u; mine = (j == x) ? c : mine; }
        if (sum == G) break;
        __builtin_amdgcn_s_sleep(1);
        if ((++sp & 255u) == 0u) { if (xb_ld(&bar[XB_TMO])) break; if (sp > XB_SPIN_CAP) { atomicAdd(&bar[XB_TMO], 1u); break; } }
    }
    nloc = mine > 0u ? mine : 1u; nx = cnt > 0u ? cnt : 1u;
}

__device__ __forceinline__ void xcd_barrier(const XcdBarrier& b) {
    asm volatile("s_waitcnt vmcnt(0)" ::: "memory");
    __syncthreads();
    if (threadIdx.x == 0) {
        unsigned* bar = b.bar;
        __builtin_amdgcn_s_waitcnt(0);
        unsigned nloc = b.st[0], nx = b.st[1];
        if (nloc == 0u) { xcd_barrier_complete(bar, b.x, nloc, nx); b.st[0] = nloc; b.st[1] = nx; }
        const unsigned old = xb_add(&bar[XB_XSUB(b.x)], 1u);
        const unsigned gen = old / nloc;
        if (old + 1u == (gen + 1u) * nloc) {
            __builtin_amdgcn_fence(__ATOMIC_RELEASE, "agent");
            asm volatile("s_waitcnt vmcnt(0)" ::: "memory");
            const unsigned og = xb_add(&bar[XB_TOP], 1u);
            const unsigned tg = og / nx;
            if (og + 1u == (tg + 1u) * nx) xb_add(&bar[XB_TOPGEN], 1u);
            else XB_SPIN(xb_ld(&bar[XB_TOPGEN]) == tg, bar);
            __builtin_amdgcn_fence(__ATOMIC_ACQUIRE, "agent");
            xb_add(&bar[XB_XGEN(b.x)], 1u);
            asm volatile("s_waitcnt vmcnt(0)" ::: "memory");
        } else {
            XB_SPIN(xb_ld(&bar[XB_XGEN(b.x)]) == gen, bar);
            __builtin_amdgcn_fence(__ATOMIC_ACQUIRE, "agent");
            asm volatile("s_waitcnt vmcnt(0)" ::: "memory");
        }
    }
    __syncthreads();
}


template <class F> struct EpiAdapt {
    static constexpr bool PERM = false, AFTER_DRAIN = false; F f;
    __device__ __forceinline__ void operator()(const pg8::f32x4 (&acc)[2][2][4][2], const pg8::Unit& u, int wr, int wc, int fr, int fq) const {
#pragma unroll
        for (int ai = 0; ai < 2; ++ai)
#pragma unroll
            for (int m = 0; m < 4; ++m) { const int row = u.pm * 256 + ai * 128 + wr * 64 + m * 16 + fr;
#pragma unroll
                for (int bj = 0; bj < 2; ++bj) f(row, u.pn * 8 + bj * 4 + wc, fq, acc[ai][bj][m][0], acc[ai][bj][m][1], u.ks);
                asm volatile("" ::: "memory"); }
    }
};
struct EpiBf16Perm { bf16_t* O; int ldo; int pad;
    __device__ __forceinline__ void operator()(int row, int g, int fq, f32x4 v0, f32x4 v1, int) const {
        u32x4 w; w.x = pk2(v0.x, v0.y); w.y = pk2(v0.z, v0.w); w.z = pk2(v1.x, v1.y); w.w = pk2(v1.z, v1.w);
        *(u32x4*)(O + (size_t)row * ldo + 32 * g + 8 * fq) = w; } };
struct EpiResid { const float* hl_in; const float* hc_in; float* hl_out; float* hc_out; const float* mod; int goff; int split;
    __device__ __forceinline__ void operator()(int row, int g, int fq, f32x4 v0, f32x4 v1, int ks) const {
        const int c0 = 32 * g + 4 * fq; const float* hin; float* hout; const float* gv;
        if (row < TL) { hin = hl_in + (size_t)row * D; hout = hl_out + (size_t)row * D; gv = mod + (row / SEQ) * 6144 + goff; }
        else { hin = hc_in + (size_t)(row - TL) * D; hout = hc_out + (size_t)(row - TL) * D; gv = mod + 2 * 6144 + goff; }
        if (split) { float* po = hout + (size_t)ks * TC * D; *(f32x4*)(po + c0) = *(const f32x4*)(gv + c0) * v0; *(f32x4*)(po + c0 + 16) = *(const f32x4*)(gv + c0 + 16) * v1; return; }
        *(f32x4*)(hout + c0) = *(const f32x4*)(hin + c0) + *(const f32x4*)(gv + c0) * v0;
        *(f32x4*)(hout + c0 + 16) = *(const f32x4*)(hin + c0 + 16) + *(const f32x4*)(gv + c0 + 16) * v1; } };
struct EpiSwiglu { bf16_t* H; int ldh; int pad;
    __device__ __forceinline__ void operator()(int row, int g, int fq, f32x4 v0, f32x4 v1, int) const {
        u32x2 w; w.x = pk2(silu_fast(v0.x) * v1.x, silu_fast(v0.y) * v1.y); w.y = pk2(silu_fast(v0.z) * v1.z, silu_fast(v0.w) * v1.w);
        *(u32x2*)(H + (size_t)row * ldh + 16 * g + 4 * fq) = w; } };

template <class F> __device__ __forceinline__ void run_gemm(LAS unsigned char* lds, const bf16_t* A, const bf16_t* Bt, int K, int nM, int nN, const int* texp, size_t estride_bytes, const F& f, int slices = 1, int pm0 = 0) {
    pg8::Gemm g{A, Bt, K, estride_bytes, K / slices}; pg8::StaticOrder S; S.init(nM, nN, opqs((int)gridDim.x), opqs((int)blockIdx.x), texp, slices, pm0);
    EpiAdapt<F> E{f};
    pg8::gemm_phase<EpiAdapt<F>, pg8::StaticOrder, true, true>(lds, g, S, E);
}
__device__ __forceinline__ bool gemm_tail_idle(int nwg) { const int G = opqs((int)gridDim.x), r = nwg % G; return r != 0 && opqs((int)blockIdx.x) >= r; }

__device__ __forceinline__ float conv_src(const Params& p, int mode, const float* W0, const float* W1, int N, int nvalid, int k, int nb) {
    if (mode == 0) return W0[(size_t)k * N + nb];
    if (mode == 1) { const int col = (nb & ~31) + 8 * ((nb >> 2) & 3) + 4 * ((nb >> 4) & 1) + (nb & 3); return col < nvalid ? W0[(size_t)k * N + col] : 0.f; }
    const int col = 16 * (nb >> 5) + (nb & 15); return ((nb >> 4) & 1) ? W1[(size_t)k * N + col] : W0[(size_t)k * N + col];
}
constexpr int CT_WIN = 0, CT_WOUT = 2304, CT_WUQ = 3328, CT_WUKV = 3400, CT_WFGU = 3464, CT_WFDN = 6280, CT_WMGU = 7688, CT_WMDN = 36360, CT_END = 50696;
constexpr int IT_MODS = 192, IT_ROPE = 9;
__device__ __forceinline__ void conv_item(const Params& p, int it, float* scr, int lane) {
    int t = it;
    bf16_t* dst; const float* W0; const float* W1 = nullptr; int K, N, nvalid = 0, mode;
    if (t < CT_WOUT) { const int l = t / 1152; t %= 1152; dst = (bf16_t*)(p.ws + WS_WIN) + (size_t)l * NINP * D; W0 = p.in[8] + (size_t)l * D * NIN; K = D; N = NIN; nvalid = NIN; mode = 1; }
    else if (t < CT_WUQ) { t -= CT_WOUT; const int l = t / 512; t %= 512; dst = (bf16_t*)(p.ws + WS_WOUT) + (size_t)l * D * D; W0 = p.in[24] + (size_t)l * D * D; K = D; N = D; mode = 0; }
    else if (t < CT_WUKV) { t -= CT_WUQ; const int l = t / 36; t %= 36; dst = (bf16_t*)(p.ws + WS_WUQ) + (size_t)l * 384 * 192; W0 = p.in[18] + (size_t)l * 192 * 384; K = 192; N = 384; mode = 0; }
    else if (t < CT_WFGU) { t -= CT_WUKV; const int l = t / 32; t %= 32; dst = (bf16_t*)(p.ws + WS_WUKV) + (size_t)l * 512 * 128; W0 = p.in[20] + (size_t)l * 128 * 512; K = 128; N = 512; mode = 0; }
    else if (t < CT_WFDN) { t -= CT_WFGU; dst = (bf16_t*)(p.ws + WS_WFGU); W0 = p.in[25]; W1 = p.in[26]; K = D; N = DFF; mode = 2; }
    else if (t < CT_WMGU) { t -= CT_WFDN; dst = (bf16_t*)(p.ws + WS_WFDN); W0 = p.in[27]; K = DFF; N = D; mode = 0; }
    else if (t < CT_WMDN) { t -= CT_WMGU; const int e = t / 3584; t %= 3584; dst = (bf16_t*)(p.ws + WS_WMGU) + (size_t)e * 2 * DFFE * D; W0 = p.in[29] + (size_t)e * D * DFFE; W1 = p.in[30] + (size_t)e * D * DFFE; K = D; N = DFFE; mode = 2; }
    else { t -= CT_WMDN; const int e = t / 1792; t %= 1792; dst = (bf16_t*)(p.ws + WS_WMDN) + (size_t)e * D * DFFE; W0 = p.in[31] + (size_t)e * DFFE * D; K = DFFE; N = D; nvalid = D; mode = 1; }
    const int ktl = K / 64, n0 = (t / ktl) * 32, k0 = (t % ktl) * 64;
    const int n4 = lane & 7; const float* src; bool valid = true; int ln;
    if (mode == 0) { src = W0 + n0 + 4 * n4; ln = 4 * n4; }
    else if (mode == 1) { const int col = n0 + 4 * n4; valid = col < nvalid; src = W0 + (valid ? col : 0); ln = 16 * (n4 & 1) + 4 * (n4 >> 1); }
    else { src = ((n4 >> 2) ? W1 : W0) + 16 * (n0 >> 5) + 4 * (n4 & 3); ln = 16 * (n4 >> 2) + 4 * (n4 & 3); }
    src += (size_t)(k0 + (lane >> 3)) * N;
    f32x4 v[8];
#pragma unroll
    for (int i = 0; i < 8; ++i) v[i] = valid ? *(const f32x4*)(src + (size_t)(8 * i) * N) : (f32x4){0.f, 0.f, 0.f, 0.f};
#pragma unroll
    for (int i = 0; i < 8; ++i) *(f32x4*)(scr + ((lane >> 3) + 8 * i) * 36 + ln) = v[i];
    const int c = lane & 7;
#pragma unroll
    for (int j = 0; j < 4; ++j) { const int n = (lane >> 3) + 8 * j; const float* sp = scr + (8 * c) * 36 + n;
        u32x4 o; o.x = pk2(sp[0 * 36], sp[1 * 36]); o.y = pk2(sp[2 * 36], sp[3 * 36]); o.z = pk2(sp[4 * 36], sp[5 * 36]); o.w = pk2(sp[6 * 36], sp[7 * 36]);
        *(u32x4*)(dst + (size_t)(n0 + n) * K + k0 + 8 * c) = o; }
}
constexpr int CW_FILL = 1024;
__device__ __forceinline__ void fill_moe(const Params& p, float* lds, int quota) {
    const int tid = opq((int)threadIdx.x), lane = tid & 63, wv = tid >> 6;
    float* scr = lds + wv * (64 * 36); volatile int* slot = (volatile int*)(lds + 8 * 64 * 36);
    constexpr int NIT = CT_END - CT_WMGU;
    for (;;) {
        const int claim = quota > 64 ? 4 : quota;
        __syncthreads();
        if (tid == 0) *slot = (int)atomicAdd((unsigned*)(p.ws + WS_CTL) + CW_FILL, 8u * (unsigned)claim);
        __syncthreads();
        const int idx = *slot;
        if (idx >= NIT) break;
        const int end = min(idx + 8 * claim, NIT);
        for (int it = idx + wv; it < end; it += 8) conv_item(p, CT_WMGU + it, scr, lane);
        if (quota <= 64) break;
    }
    __syncthreads();
}
__device__ __forceinline__ void ph_prologue(const Params& p, float* lds) {
    const int tid = opq((int)threadIdx.x), lane = tid & 63, wv = tid >> 6;
    for (int it = blockIdx.x; it < IT_MODS + IT_ROPE; it += gridDim.x) {
        if (it < IT_MODS) {
            const int l = it / 96, n0 = (it % 96) * 64, nn = tid & 63, kc = tid >> 6;
            float* sv = lds; float* red = lds + 3 * 1024;
            __syncthreads();
            for (int i = tid; i < 3 * 1024; i += 512) { const int v = i >> 10, k = i & 1023; const float x = (v < 2) ? p.in[1][v * D + k] : p.in[3][k]; sv[i] = silu_f(x); }
            __syncthreads();
            const float* w = p.in[4] + ((size_t)l * D + kc * 128) * 6144 + n0 + nn;
            float a0 = 0.f, a1 = 0.f, a2 = 0.f;
#pragma unroll 8
            for (int k = 0; k < 128; ++k) { const float wv_ = w[(size_t)k * 6144]; a0 += sv[kc * 128 + k] * wv_; a1 += sv[1024 + kc * 128 + k] * wv_; a2 += sv[2048 + kc * 128 + k] * wv_; }
            red[(kc * 3 + 0) * 64 + nn] = a0; red[(kc * 3 + 1) * 64 + nn] = a1; red[(kc * 3 + 2) * 64 + nn] = a2;
            __syncthreads();
            if (tid < 192) { const int v = tid >> 6; float s = p.in[5][l * 6144 + n0 + nn];
#pragma unroll
                for (int q = 0; q < 8; ++q) s += red[(q * 3 + v) * 64 + nn];
                ((float*)(p.ws + WS_MOD))[((size_t)l * 3 + v) * 6144 + n0 + nn] = s; }
        } else {
            const int idx = (it - IT_MODS) * 512 + tid;
            if (idx < RT_N) {
                int pos, i, nf;
                if (idx < RT_C64) { pos = idx / 16; i = idx % 16; nf = 16; }
                else if (idx < RT_R32) { pos = (idx - RT_C64) / 16; i = idx % 16; nf = 16; }
                else if (idx < RT_C32) { pos = (idx - RT_R32) / 8; i = idx % 8; nf = 8; }
                else { pos = (idx - RT_C32) / 8; i = idx % 8; nf = 8; }
                const float inv = powf(10000.0f, -(float)i / (float)nf);
                const float ang = (float)pos * inv;
                const float rev = ang * 0.15915494309189535f;
                ((float2*)(p.ws + WS_ROPE))[idx] = make_float2(__builtin_amdgcn_cosf(rev), __builtin_amdgcn_sinf(rev));
            }
        }
    }
    __syncthreads();
    for (int i = blockIdx.x * 512 + tid; i < TC * D / 4; i += gridDim.x * 512) ((f32x4*)(p.ws + WS_HCTX))[i] = ((const f32x4*)p.in[2])[i];
    float* scr = lds + wv * (64 * 36);
    for (int it = wv * gridDim.x + blockIdx.x; it < CT_WMGU; it += 8 * gridDim.x) conv_item(p, it, scr, lane);
    __syncthreads();
}

template <int WHICH, bool ROUTER> __device__ __forceinline__ void ph_norm(const Params& p, int layer, int nrows, unsigned* lcnt, int nslab) {
    const int tx = opq((int)threadIdx.x), lane = tx & 63, gw = (blockIdx.x * 512 + tx) >> 6, ngw = (gridDim.x * 512) >> 6;
    if (ROUTER) { if (tx < 16) lcnt[tx] = 0u; __syncthreads(); }
    const float* hl = (layer == 0 && WHICH == 1) ? p.in[0] : p.out;
    const float* hc = (layer == 0 && WHICH == 1) ? p.in[2] : (const float*)(p.ws + WS_HCTX);
    const float* gain = p.in[WHICH == 1 ? 6 : 7] + layer * D;
    const float* mod = (const float*)(p.ws + WS_MOD) + (size_t)layer * 3 * 6144;
    bf16_t* dst = (bf16_t*)(p.ws + WS_ACT1);
    for (int m = gw; m < nrows; m += ngw) {
        const float* src = (m < TL) ? hl + (size_t)m * D : hc + (size_t)(m - TL) * D;
        const float* mv = mod + (m < TL ? m / SEQ : 2) * 6144;
        const float* shp = mv + (WHICH == 1 ? 0 : 3) * D; const float* scp = mv + (WHICH == 1 ? 1 : 4) * D;
        f32x4 v[4]; float ss = 0.f;
#pragma unroll
        for (int j = 0; j < 4; ++j) v[j] = *(const f32x4*)(src + 256 * j + 4 * lane);
        if (!ROUTER && m >= TL && nslab > 0) {
            const float* pp = (const float*)(p.ws + WS_PART) + (size_t)(m - TL) * D + 4 * lane;
            for (int sl = 0; sl < nslab; ++sl) {
#pragma unroll
                for (int j = 0; j < 4; ++j) v[j] = v[j] + *(const f32x4*)(pp + (size_t)sl * TC * D + 256 * j); }
#pragma unroll
            for (int j = 0; j < 4; ++j) *(f32x4*)((float*)(p.ws + WS_HCTX) + (size_t)(m - TL) * D + 256 * j + 4 * lane) = v[j];
        }
#pragma unroll
        for (int j = 0; j < 4; ++j) ss += v[j].x * v[j].x + v[j].y * v[j].y + v[j].z * v[j].z + v[j].w * v[j].w;
        const float rstd = rsqrtf(wave_sum(ss) * (1.f / D) + EPS);
        float lg[8];
#pragma unroll
        for (int e = 0; e < 8; ++e) lg[e] = 0.f;
#pragma unroll
        for (int j = 0; j < 4; ++j) {
            const int c = 256 * j + 4 * lane;
            const f32x4 g = *(const f32x4*)(gain + c), sh = *(const f32x4*)(shp + c), sc = *(const f32x4*)(scp + c);
            f32x4 f = v[j] * rstd * g * (sc + 1.f) + sh;
            u32x2 w; w.x = pk2(f.x, f.y); w.y = pk2(f.z, f.w);
            *(u32x2*)(dst + (size_t)m * D + c) = w;
            if (ROUTER) {
                const float* rt = p.in[28] + (size_t)c * 8;
#pragma unroll
                for (int i = 0; i < 4; ++i) { const f32x4 r0 = *(const f32x4*)(rt + 8 * i), r1 = *(const f32x4*)(rt + 8 * i + 4); const float fv = f[i];
                    lg[0] += fv * r0.x; lg[1] += fv * r0.y; lg[2] += fv * r0.z; lg[3] += fv * r0.w; lg[4] += fv * r1.x; lg[5] += fv * r1.y; lg[6] += fv * r1.z; lg[7] += fv * r1.w; }
            }
        }
        if (ROUTER) {
#pragma unroll
            for (int e = 0; e < 8; ++e) lg[e] = wave_sum(lg[e]);
            if (lane == 0) {
                int e0 = 0; float v0 = lg[0];
#pragma unroll
                for (int e = 1; e < 8; ++e) if (lg[e] > v0) { v0 = lg[e]; e0 = e; }
                int e1 = -1; float v1 = -INFINITY;
#pragma unroll
                for (int e = 0; e < 8; ++e) if (e != e0 && lg[e] > v1) { v1 = lg[e]; e1 = e; }
                const float t = expf(v1 - v0), g0 = 1.f / (1.f + t), g1 = t / (1.f + t);
                const int p0 = (int)atomicAdd(&lcnt[e0], 1u), p1 = (int)atomicAdd(&lcnt[e1], 1u);
                ((int2*)(p.ws + WS_TOKE))[m] = make_int2(e0, e1); ((int2*)(p.ws + WS_TOKP))[m] = make_int2(p0, p1); ((float2*)(p.ws + WS_TOKG))[m] = make_float2(g0, g1);
            }
        }
    }
    if (ROUTER) {
        __syncthreads();
        if (tx < 8) lcnt[8 + tx] = atomicAdd((unsigned*)(p.ws + WS_CTL) + 64 * tx, lcnt[tx]);
        __syncthreads();
        if (lane == 0) for (int m = gw; m < nrows; m += ngw) {
            const int2 e = ((const int2*)(p.ws + WS_TOKE))[m]; int2 ps = ((const int2*)(p.ws + WS_TOKP))[m];
            ps.x += (int)lcnt[8 + e.x]; ps.y += (int)lcnt[8 + e.y]; ((int2*)(p.ws + WS_TOKP))[m] = ps; }
        __syncthreads();
    }
}


typedef short pp_bf16x8 __attribute__((ext_vector_type(8)));
__device__ __forceinline__ float quad_sum(float v) { v += swz_xor<1>(v); v += swz_xor<2>(v); return v; }
__device__ __forceinline__ float kg_sum(float v) { v += swz_xor<16>(v); return half_sum(v); }
constexpr float QS64 = 0.125f * 1.4426950408889634f, QS96 = 0.10206207261596575f * 1.4426950408889634f;

template <int HS> __device__ __forceinline__ void pp_head(const Params& p, const QKVB& qb, int layer, const bf16_t* prow, bool lat, int b, int s, int key, int sub,
                                                          const float2 (&rr)[4], const float2 (&rc)[4]) {
    constexpr bool ISV = HS >= 20;
    constexpr int col = HS < 4 ? OFF_AQ + 64 * HS : HS < 6 ? OFF_AK + 64 * (HS - 4) : HS < 10 ? OFF_BQ + 64 * (HS - 6) : HS < 12 ? OFF_BK + 64 * (HS - 10) : HS < 16 ? OFF_CQ + 64 * (HS - 12) :
                        HS < 20 ? OFF_CK + 64 * (HS - 16) : HS < 22 ? OFF_AV + 64 * (HS - 20) : HS < 24 ? OFF_BV + 64 * (HS - 22) : OFF_CV + 64 * (HS - 24);
    constexpr bool ISQ = HS < 4 || (HS >= 6 && HS < 10) || (HS >= 12 && HS < 16);
    constexpr bool ROPE = HS < 12;
    constexpr int GIN = HS < 4 ? 9 : HS < 6 ? 10 : HS < 10 ? 12 : HS < 12 ? 13 : HS < 16 ? 14 : 15;
    bf16_t* dst;
    if (HS < 4) dst = lat ? qb.QA + ((size_t)(b * 4 + HS) * SEQ + s) * 64 : qb.QAc + ((size_t)(b * 4 + HS) * CTX + s) * 64;
    else if (HS < 6) dst = qb.KA + ((size_t)(b * 2 + HS - 4) * KEYS + key) * 64;
    else if (HS < 10) dst = lat ? qb.QB + ((size_t)(b * 4 + HS - 6) * SEQ + s) * 64 : qb.QBc + ((size_t)(b * 4 + HS - 6) * CTX + s) * 64;
    else if (HS < 12) dst = qb.KB + ((size_t)(b * 2 + HS - 10) * KEYS + key) * 64;
    else if (HS < 16) dst = lat ? qb.QC + ((size_t)(b * 4 + HS - 12) * SEQ + s) * 64 : qb.QCc + ((size_t)(b * 4 + HS - 12) * CTX + s) * 64;
    else if (HS < 20) dst = qb.KC + ((size_t)(b * 4 + HS - 16) * KEYS + key) * 64;
    else if (HS < 22) dst = qb.VA + ((size_t)(b * 2 + HS - 20) * KEYS + key) * 64;
    else if (HS < 24) dst = qb.VB + ((size_t)(b * 2 + HS - 22) * KEYS + key) * 64;
    else dst = qb.VC + ((size_t)(b * 4 + HS - 24) * KEYS + key) * 64;
    u32x2 w[4];
#pragma unroll
    for (int c = 0; c < 4; ++c) w[c] = *(const u32x2*)(prow + col + 16 * c + 4 * sub);
    if (!ISV) {
        f32x4 x[4]; float ss = 0.f;
#pragma unroll
        for (int c = 0; c < 4; ++c) { x[c] = (f32x4){bflo(w[c].x), bfhi(w[c].x), bflo(w[c].y), bfhi(w[c].y)}; ss += x[c].x * x[c].x + x[c].y * x[c].y + x[c].z * x[c].z + x[c].w * x[c].w; }
        const float r = rsqrtf(quad_sum(ss) * (1.f / 64.f) + EPS) * (ISQ ? QS64 : 1.f);
        const float* g = p.in[GIN] + layer * 64 + 4 * sub;
#pragma unroll
        for (int c = 0; c < 4; ++c) x[c] = x[c] * r * *(const f32x4*)(g + 16 * c);
        if (ROPE && lat) {
#pragma unroll
            for (int i = 0; i < 4; ++i) { const float a = x[0][i], bq = x[1][i]; x[0][i] = a * rr[i].x - bq * rr[i].y; x[1][i] = bq * rr[i].x + a * rr[i].y;
                const float c1 = x[2][i], c2 = x[3][i]; x[2][i] = c1 * rc[i].x - c2 * rc[i].y; x[3][i] = c2 * rc[i].x + c1 * rc[i].y; }
        }
#pragma unroll
        for (int c = 0; c < 4; ++c) { w[c].x = pk2(x[c].x, x[c].y); w[c].y = pk2(x[c].z, x[c].w); }
    }
#pragma unroll
    for (int c = 0; c < 4; ++c) *(u32x2*)(dst + 16 * c + 4 * sub) = w[c];
}
template <int HS> struct PPHeads { static __device__ __forceinline__ void run(const Params& p, const QKVB& qb, int layer, const bf16_t* prow, bool lat, int b, int s, int key, int sub, const float2 (&rr)[4], const float2 (&rc)[4]) {
    pp_head<HS>(p, qb, layer, prow, lat, b, s, key, sub, rr, rc); PPHeads<HS + 1>::run(p, qb, layer, prow, lat, b, s, key, sub, rr, rc); } };
template <> struct PPHeads<28> { static __device__ __forceinline__ void run(const Params&, const QKVB&, int, const bf16_t*, bool, int, int, int, int, const float2 (&)[4], const float2 (&)[4]) {} };

__device__ __forceinline__ void f8_from_bf(const u32x4 v, float (&x)[8]) { x[0] = bflo(v.x); x[1] = bfhi(v.x); x[2] = bflo(v.y); x[3] = bfhi(v.y); x[4] = bflo(v.z); x[5] = bfhi(v.z); x[6] = bflo(v.w); x[7] = bfhi(v.w); }

__device__ __forceinline__ void ph_postproj2(const Params& p, int layer) {
    const int tx = opq((int)threadIdx.x), lane = tx & 63, gw = (tx >> 6) * gridDim.x + blockIdx.x, ngw = gridDim.x * 8;
    const bf16_t* P = (const bf16_t*)(p.ws + WS_P);
    const QKVB qb = make_qkv(p.ws);
    const bf16_t* Wuq = (const bf16_t*)(p.ws + WS_WUQ) + (size_t)layer * 384 * 192;
    const bf16_t* Wukv = (const bf16_t*)(p.ws + WS_WUKV) + (size_t)layer * 512 * 128;
    const float2* rope = (const float2*)(p.ws + WS_ROPE);
    for (int u = gw; u < MALL / 16; u += ngw) {
        const int m0 = u * 16; const bool lat = m0 < TL;
        {
            const int t = lane >> 2, sub = lane & 3, m = m0 + t;
            const int b = lat ? m / SEQ : (m - TL) / CTX, s = lat ? m % SEQ : (m - TL) % CTX, key = lat ? CTX + s : s;
            float2 rr[4], rc[4];
#pragma unroll
            for (int i = 0; i < 4; ++i) { rr[i] = lat ? rope[RT_R64 + (s >> 6) * 16 + 4 * sub + i] : make_float2(1.f, 0.f); rc[i] = lat ? rope[RT_C64 + (s & 63) * 16 + 4 * sub + i] : make_float2(1.f, 0.f); }
            PPHeads<0>::run(p, qb, layer, P + (size_t)m * NINP, lat, b, s, key, sub, rr, rc);
        }
        {
            const int tk = lane & 15, kg = lane >> 4, m = m0 + tk;
            const int b = lat ? m / SEQ : (m - TL) / CTX, s = lat ? m % SEQ : (m - TL) % CTX, key = lat ? CTX + s : s;
            const bf16_t* prow = P + (size_t)m * NINP;
            pp_bf16x8 aq[6];
            { float x[6][8]; float ss = 0.f;
#pragma unroll
                for (int ks = 0; ks < 6; ++ks) { f8_from_bf(*(const u32x4*)(prow + OFF_DCQ + 32 * ks + 8 * kg), x[ks]);
#pragma unroll
                    for (int j = 0; j < 8; ++j) ss += x[ks][j] * x[ks][j]; }
                const float r = rsqrtf(kg_sum(ss) * (1.f / 192.f) + EPS);
                const float* g = p.in[17] + layer * 192 + 8 * kg;
#pragma unroll
                for (int ks = 0; ks < 6; ++ks) { const f32x4 g0 = *(const f32x4*)(g + 32 * ks), g1 = *(const f32x4*)(g + 32 * ks + 4);
                    u32x4 w; w.x = pk2(x[ks][0] * r * g0.x, x[ks][1] * r * g0.y); w.y = pk2(x[ks][2] * r * g0.z, x[ks][3] * r * g0.w); w.z = pk2(x[ks][4] * r * g1.x, x[ks][5] * r * g1.y); w.w = pk2(x[ks][6] * r * g1.z, x[ks][7] * r * g1.w);
                    aq[ks] = __builtin_bit_cast(pp_bf16x8, w); } }
            float2 qr_[4], qc_[4];
#pragma unroll
            for (int reg = 0; reg < 4; ++reg) { const int i = (4 * kg + reg) & 7; qr_[reg] = lat ? rope[RT_R32 + (s >> 6) * 8 + i] : make_float2(1.f, 0.f); qc_[reg] = lat ? rope[RT_C32 + (s & 63) * 8 + i] : make_float2(1.f, 0.f); }
#pragma unroll 1
            for (int h = 0; h < 4; ++h) {
                f32x4 acc[6];
#pragma unroll
                for (int nb = 0; nb < 6; ++nb) { acc[nb] = (f32x4){0.f, 0.f, 0.f, 0.f};
                    const bf16_t* wp = Wuq + (size_t)(96 * h + 16 * nb + tk) * 192 + 8 * kg;
#pragma unroll
                    for (int ks = 0; ks < 6; ++ks) acc[nb] = __builtin_amdgcn_mfma_f32_16x16x32_bf16(*(const pp_bf16x8*)(wp + 32 * ks), aq[ks], acc[nb], 0, 0, 0); }
                float ss = 0.f;
#pragma unroll
                for (int nb = 0; nb < 6; ++nb) ss += acc[nb].x * acc[nb].x + acc[nb].y * acc[nb].y + acc[nb].z * acc[nb].z + acc[nb].w * acc[nb].w;
                const float r = rsqrtf(kg_sum(ss) * (1.f / 96.f) + EPS) * QS96;
                const float* g = p.in[21] + layer * 96 + 4 * kg;
                bf16_t* dst = (lat ? qb.QD + ((size_t)(b * 4 + h) * SEQ + s) * 96 : qb.QDc + ((size_t)(b * 4 + h) * CTX + s) * 96) + 4 * kg;
#pragma unroll
                for (int nb = 0; nb < 6; ++nb) { f32x4 y = acc[nb] * r * *(const f32x4*)(g + 16 * nb);
                    if (nb >= 4 && lat) {
#pragma unroll
                        for (int reg = 0; reg < 4; ++reg) { const float other = half_other(y[reg], lane); const float2 cs = nb == 4 ? qr_[reg] : qc_[reg];
                            y[reg] = (kg < 2) ? y[reg] * cs.x - other * cs.y : y[reg] * cs.x + other * cs.y; } }
                    u32x2 w; w.x = pk2(y.x, y.y); w.y = pk2(y.z, y.w); *(u32x2*)(dst + 16 * nb) = w; }
            }
            pp_bf16x8 akv[4];
            { float x[4][8]; float ss = 0.f;
#pragma unroll
                for (int ks = 0; ks < 4; ++ks) { f8_from_bf(*(const u32x4*)(prow + OFF_DCKV + 32 * ks + 8 * kg), x[ks]);
#pragma unroll
                    for (int j = 0; j < 8; ++j) ss += x[ks][j] * x[ks][j]; }
                const float r = rsqrtf(kg_sum(ss) * (1.f / 128.f) + EPS);
                const float* g = p.in[19] + layer * 128 + 8 * kg;
#pragma unroll
                for (int ks = 0; ks < 4; ++ks) { const f32x4 g0 = *(const f32x4*)(g + 32 * ks), g1 = *(const f32x4*)(g + 32 * ks + 4);
                    u32x4 w; w.x = pk2(x[ks][0] * r * g0.x, x[ks][1] * r * g0.y); w.y = pk2(x[ks][2] * r * g0.z, x[ks][3] * r * g0.w); w.z = pk2(x[ks][4] * r * g1.x, x[ks][5] * r * g1.y); w.w = pk2(x[ks][6] * r * g1.z, x[ks][7] * r * g1.w);
                    akv[ks] = __builtin_bit_cast(pp_bf16x8, w); } }
            float kr[8]; f8_from_bf(*(const u32x4*)(prow + OFF_DKR + 8 * kg), kr);
            float krss = 0.f;
#pragma unroll
            for (int j = 0; j < 8; ++j) krss += kr[j] * kr[j];
            float2 kcs[8];
#pragma unroll
            for (int j = 0; j < 8; ++j) kcs[j] = !lat ? make_float2(1.f, 0.f) : (kg < 2 ? rope[RT_R32 + (s >> 6) * 8 + j] : rope[RT_C32 + (s & 63) * 8 + j]);
#pragma unroll 1
            for (int h = 0; h < 4; ++h) {
                f32x4 acc[8];
#pragma unroll
                for (int nb = 0; nb < 8; ++nb) { acc[nb] = (f32x4){0.f, 0.f, 0.f, 0.f};
                    const bf16_t* wp = Wukv + (size_t)(128 * h + 16 * nb + tk) * 128 + 8 * kg;
#pragma unroll
                    for (int ks = 0; ks < 4; ++ks) acc[nb] = __builtin_amdgcn_mfma_f32_16x16x32_bf16(*(const pp_bf16x8*)(wp + 32 * ks), akv[ks], acc[nb], 0, 0, 0); }
                float ss = krss;
#pragma unroll
                for (int nb = 0; nb < 4; ++nb) ss += acc[nb].x * acc[nb].x + acc[nb].y * acc[nb].y + acc[nb].z * acc[nb].z + acc[nb].w * acc[nb].w;
                const float r = rsqrtf(kg_sum(ss) * (1.f / 96.f) + EPS);
                const float* g = p.in[22] + layer * 96;
                bf16_t* kd = qb.KD + ((size_t)(b * 4 + h) * KEYS + key) * 96; bf16_t* vd = qb.VD + ((size_t)(b * 4 + h) * KEYS + key) * 64;
#pragma unroll
                for (int nb = 0; nb < 4; ++nb) { const f32x4 y = acc[nb] * r * *(const f32x4*)(g + 16 * nb + 4 * kg); u32x2 w; w.x = pk2(y.x, y.y); w.y = pk2(y.z, y.w); *(u32x2*)(kd + 16 * nb + 4 * kg) = w; }
                { float y[8];
#pragma unroll
                    for (int j = 0; j < 8; ++j) y[j] = kr[j] * r * g[64 + 8 * kg + j];
#pragma unroll
                    for (int j = 0; j < 8; ++j) { const float other = swz_xor<16>(y[j]); y[j] = (kg & 1) == 0 ? y[j] * kcs[j].x - other * kcs[j].y : y[j] * kcs[j].x + other * kcs[j].y; }
                    u32x4 w; w.x = pk2(y[0], y[1]); w.y = pk2(y[2], y[3]); w.z = pk2(y[4], y[5]); w.w = pk2(y[6], y[7]); *(u32x4*)(kd + 64 + 8 * kg) = w; }
#pragma unroll
                for (int nb = 4; nb < 8; ++nb) { const f32x4 y = acc[nb]; u32x2 w; w.x = pk2(y.x, y.y); w.y = pk2(y.z, y.w); *(u32x2*)(vd + 16 * (nb - 4) + 4 * kg) = w; }
            }
        }
    }
}

namespace fa {
typedef short bf16x8 __attribute__((ext_vector_type(8)));
typedef short s16x4 __attribute__((ext_vector_type(4)));
typedef float f32x16 __attribute__((ext_vector_type(16)));
typedef __attribute__((address_space(3))) const char* lds_cptr;
typedef short v4i16_t __attribute__((ext_vector_type(4)));
constexpr int KSTG = 12288, VSTG = 8192, STG = KSTG + VSTG;
constexpr int LDS_WS = 2 * STG, LDS_OST = LDS_WS + 8 * 256, LDS_RPB = LDS_OST + 8 * 4096, LDS_TOTAL = LDS_RPB + 2048;
constexpr float LOG2E = 1.4426950408889634f;
constexpr float THR = 6.0f;
__device__ __forceinline__ int crow(int r, int hi) { return (r & 3) + 8 * (r >> 2) + 4 * hi; }
__device__ __forceinline__ void glds16(const void* gsrc, unsigned lds_dst) { unsigned keep;
    asm volatile("s_mov_b32 %0, m0\n\ts_mov_b32 m0, %2\n\ts_nop 0\n\tglobal_load_lds_dwordx4 %1, off\n\ts_mov_b32 m0, %0" : "=&s"(keep) : "v"(gsrc), "s"(lds_dst) : "memory"); }
__device__ __forceinline__ s16x4 vtr(lds_cptr p) { return __builtin_bit_cast(s16x4, __builtin_amdgcn_ds_read_tr16_b64_v4i16((__attribute__((address_space(3))) v4i16_t*)p)); }
typedef float f32x2_t __attribute__((ext_vector_type(2))); typedef __bf16 bf16x2_t __attribute__((ext_vector_type(2)));
__device__ __forceinline__ unsigned cvtpk(float lo, float hi) { f32x2_t v = {lo, hi}; bf16x2_t b = __builtin_convertvector(v, bf16x2_t); return __builtin_bit_cast(unsigned, b); }
__device__ __forceinline__ float xhalf_max(float m) { auto rr = __builtin_amdgcn_permlane32_swap(__float_as_uint(m), __float_as_uint(m), false, false); return fmaxf(__uint_as_float(rr[0]), __uint_as_float(rr[1])); }
__device__ __forceinline__ float xhalf_sum(float m) { auto rr = __builtin_amdgcn_permlane32_swap(__float_as_uint(m), __float_as_uint(m), false, false); return __uint_as_float(rr[0]) + __uint_as_float(rr[1]); }
#define FA_WAIT_BAR() asm volatile("s_waitcnt vmcnt(0) lgkmcnt(0)\n\ts_barrier" ::: "memory")

template <int DQK, int MODE>
__device__ __forceinline__ void attn_unit(const bf16_t* Qg, const bf16_t* Kg, const bf16_t* Vg, bf16_t* Og, int q0, float sink2, const float* rpb, char* shm) {
    const int tid = opq((int)threadIdx.x), lane = tid & 63, r32 = lane & 31, hi = lane >> 5; const int wid = __builtin_amdgcn_readfirstlane(tid >> 6);
    const unsigned lds0 = (unsigned)(uintptr_t)shm;
    float* wsf = (float*)(shm + LDS_WS) + wid * 64;
    constexpr int NCH = DQK / 8, ND0 = DQK / 16;
    int NT, wbase = 0;
    if (MODE == 0) NT = KEYS / 64; else if (MODE == 3) NT = 4;
    else if (MODE == 1) { wbase = max(0, q0 - 128); const int we = min(SEQ, q0 + 256 + 128); NT = 4 + (we - wbase) / 64; }
    else { const int r0 = q0 >> 6; wbase = min(max(r0 - 4, 0), 120); const int kre = min(max(r0 - 1, 0), 120) + 8; NT = 4 + (kre - wbase); }
#define FA_KEY0(t) ((MODE == 0 || MODE == 3 || (t) < 4) ? 64 * (t) : (MODE == 1 ? CTX + wbase + 64 * ((t) - 4) : CTX + (wbase + (t) - 4) * 64))
    const bf16_t* ksrc = Kg + (size_t)lane * DQK; const bf16_t* vsrc = Vg + (size_t)(16 * (wid & 3) + (lane >> 2)) * 64 + (wid >> 2) * 32 + (lane & 3) * 8;
#define FA_DMA(t, s) do { const int k0_ = FA_KEY0(t); \
        _Pragma("unroll") for (int c_ = 0; c_ < 2; ++c_) { const int ch_ = wid + 8 * c_; if (ch_ < NCH) glds16(ksrc + (size_t)k0_ * DQK + ch_ * 8, (unsigned)__builtin_amdgcn_readfirstlane(lds0 + (s) * STG + ch_ * 1024)); } \
        glds16(vsrc + (size_t)k0_ * 64, (unsigned)__builtin_amdgcn_readfirstlane(lds0 + (s) * STG + KSTG + wid * 1024)); } while (0)
    FA_DMA(0, 0);
    if (MODE == 2) { float* rp = (float*)(shm + LDS_RPB); for (int i = tid; i < 15 * 31; i += 512) rp[i] = rpb[i] * LOG2E; }
    bf16x8 qr[ND0];
#pragma unroll
    for (int d0 = 0; d0 < ND0; ++d0) qr[d0] = *reinterpret_cast<const bf16x8*>(Qg + (size_t)(wid * 32 + r32) * DQK + d0 * 16 + hi * 8);
    float mhat = -1e30f, l_reg = 0.f; f32x16 o[2];
#pragma unroll
    for (int r = 0; r < 16; ++r) { o[0][r] = 0.f; o[1][r] = 0.f; }
    const int qpos = q0 + wid * 32 + r32;
    const int rq = (q0 >> 6) + (wid >> 1), jq = 32 * (wid & 1) + r32;
    const int rs = min(max(rq - 4, 0), 120), cs = min(max(jq - 8, 0), 48);
    const lds_cptr shm3 = (lds_cptr)shm;
    FA_WAIT_BAR();
    for (int t = 0; t < NT; ++t) {
        const int s = t & 1;
        if (t + 1 < NT) FA_DMA(t + 1, s ^ 1);
        bool active = true;
        if (MODE == 1 && t >= 4) { const int kp0 = wbase + 64 * (t - 4), qw0 = q0 + wid * 32; active = (kp0 + 63 >= qw0 - 128) && (kp0 <= qw0 + 31 + 128); }
        if (MODE == 2 && t >= 4) { const int kr = wbase + t - 4; active = (kr >= rs) && (kr < rs + 8); }
        if (active) {
            const lds_cptr kb = shm3 + s * STG + hi * 1024 + r32 * 16;
            f32x16 p0, p1;
#pragma unroll
            for (int r = 0; r < 16; ++r) { p0[r] = 0.f; p1[r] = 0.f; }
#pragma unroll
            for (int d0 = 0; d0 < ND0; ++d0) {
                const bf16x8 b0 = *(const __attribute__((address_space(3))) bf16x8*)(kb + d0 * 2048);
                const bf16x8 b1 = *(const __attribute__((address_space(3))) bf16x8*)(kb + d0 * 2048 + 512);
                p0 = __builtin_amdgcn_mfma_f32_32x32x16_bf16(b0, qr[d0], p0, 0, 0, 0);
                p1 = __builtin_amdgcn_mfma_f32_32x32x16_bf16(b1, qr[d0], p1, 0, 0, 0);
            }
            if (MODE == 1 && t >= 4) { const int kp0 = wbase + 64 * (t - 4) - qpos;
#pragma unroll
                for (int r = 0; r < 16; ++r) { const int d0_ = kp0 + crow(r, hi), d1_ = d0_ + 32; if (d0_ < -128 || d0_ > 128) p0[r] = -INFINITY; if (d1_ < -128 || d1_ > 128) p1[r] = -INFINITY; } }
            if (MODE == 2 && t >= 4) { const int kr = wbase + t - 4; const float* rp = (const float*)(shm + LDS_RPB) + (kr - rq + 7) * 31 + 15 - jq;
#pragma unroll
                for (int r = 0; r < 16; ++r) { const int kc0 = crow(r, hi), kc1 = kc0 + 32;
                    const bool v0 = (kc0 >= cs) && (kc0 < cs + 16), v1 = (kc1 >= cs) && (kc1 < cs + 16);
                    p0[r] = v0 ? p0[r] + rp[v0 ? kc0 : jq] : -INFINITY; p1[r] = v1 ? p1[r] + rp[v1 ? kc1 : jq] : -INFINITY; } }
            float rm = fmaxf(p0[0], p1[0]);
#pragma unroll
            for (int r = 1; r < 16; ++r) rm = fmaxf(rm, fmaxf(p0[r], p1[r]));
            rm = xhalf_max(rm);
            if (__any(rm - mhat > THR)) {
                const float mn = fmaxf(mhat, rm), f = __builtin_amdgcn_exp2f(mhat - mn); mhat = mn; l_reg *= f;
                if (hi == 0) wsf[r32] = f;
#pragma unroll
                for (int r = 0; r < 16; ++r) { const float fr = wsf[crow(r, hi)]; o[0][r] *= fr; o[1][r] *= fr; }
            }
            float sacc = 0.f;
#pragma unroll
            for (int r = 0; r < 16; ++r) { p0[r] = __builtin_amdgcn_exp2f(p0[r] - mhat); p1[r] = __builtin_amdgcn_exp2f(p1[r] - mhat); sacc += p0[r] + p1[r]; }
            l_reg += sacc;
            u32x4 pw0, pw1, pw2, pw3;
            pw0 = (u32x4){cvtpk(p0[0], p0[1]), cvtpk(p0[2], p0[3]), cvtpk(p0[4], p0[5]), cvtpk(p0[6], p0[7])};
            pw1 = (u32x4){cvtpk(p0[8], p0[9]), cvtpk(p0[10], p0[11]), cvtpk(p0[12], p0[13]), cvtpk(p0[14], p0[15])};
            pw2 = (u32x4){cvtpk(p1[0], p1[1]), cvtpk(p1[2], p1[3]), cvtpk(p1[4], p1[5]), cvtpk(p1[6], p1[7])};
            pw3 = (u32x4){cvtpk(p1[8], p1[9]), cvtpk(p1[10], p1[11]), cvtpk(p1[12], p1[13]), cvtpk(p1[14], p1[15])};
            const lds_cptr vp = shm3 + s * STG + KSTG + ((lane >> 4) & 1) * 32 + (lane & 3) * 8 + (4 * hi + ((lane & 15) >> 2)) * 64;
#pragma unroll
            for (int dh = 0; dh < 2; ++dh) {
                s16x4 vlo[4], vhi[4];
#pragma unroll
                for (int ks = 0; ks < 4; ++ks) { vlo[ks] = vtr(vp + dh * 4096 + ks * 1024); vhi[ks] = vtr(vp + dh * 4096 + ks * 1024 + 512); }
#define FA_VFR(k) (bf16x8){vlo[k][0], vlo[k][1], vlo[k][2], vlo[k][3], vhi[k][0], vhi[k][1], vhi[k][2], vhi[k][3]}
                o[dh] = __builtin_amdgcn_mfma_f32_32x32x16_bf16(__builtin_bit_cast(bf16x8, pw0), FA_VFR(0), o[dh], 0, 0, 0);
                o[dh] = __builtin_amdgcn_mfma_f32_32x32x16_bf16(__builtin_bit_cast(bf16x8, pw1), FA_VFR(1), o[dh], 0, 0, 0);
                o[dh] = __builtin_amdgcn_mfma_f32_32x32x16_bf16(__builtin_bit_cast(bf16x8, pw2), FA_VFR(2), o[dh], 0, 0, 0);
                o[dh] = __builtin_amdgcn_mfma_f32_32x32x16_bf16(__builtin_bit_cast(bf16x8, pw3), FA_VFR(3), o[dh], 0, 0, 0);
#undef FA_VFR
            }
        }
        FA_WAIT_BAR();
    }
    l_reg = xhalf_sum(l_reg);
    if (MODE == 1 || MODE == 3) l_reg += __builtin_amdgcn_exp2f(sink2 - mhat);
    if (hi == 0) wsf[32 + r32] = 1.0f / l_reg;
    float rli[16];
#pragma unroll
    for (int r = 0; r < 16; ++r) rli[r] = wsf[32 + crow(r, hi)];
    bf16_t* stg = (bf16_t*)(shm + LDS_OST) + wid * 2048;
#pragma unroll
    for (int r = 0; r < 16; ++r) { const int orow = crow(r, hi);
#pragma unroll
        for (int dh = 0; dh < 2; ++dh) stg[orow * 64 + dh * 32 + r32] = (bf16_t)f2bf(o[dh][r] * rli[r]); }
#pragma unroll
    for (int i = 0; i < 4; ++i) { const int row = i * 8 + (lane >> 3), ch = lane & 7; const u32x4 v = *(const u32x4*)(stg + row * 64 + ch * 8); *(u32x4*)(Og + (size_t)(wid * 32 + row) * D + ch * 8) = v; }
    asm volatile("s_waitcnt lgkmcnt(0)\n\ts_barrier" ::: "memory");
#undef FA_DMA
#undef FA_KEY0
}
#undef FA_WAIT_BAR
}


namespace fa2 {
using fa::bf16x8; using fa::s16x4; using fa::f32x16; using fa::lds_cptr; using fa::crow; using fa::glds16; using fa::vtr; using fa::cvtpk; using fa::LOG2E;
constexpr int KSL = 12288, VSL = 8192, VBASE = 4 * KSL, LDS_WS = VBASE + 3 * VSL, LDS_OST = LDS_WS + 8 * 256, LDS_RPB = LDS_OST + 8 * 4096, LDS_TOTAL = LDS_RPB + 2048;
static_assert(LDS_TOTAL <= 131072, "attention LDS");
#define SBAR() __builtin_amdgcn_sched_barrier(0)
#define PIN(x) asm volatile("" : "+v"(x))
template <int DQK, int MODE, int THRL>
__device__ __forceinline__ void attn_unit(const bf16_t* Qg, const bf16_t* Kg, const bf16_t* Vg, bf16_t* Og, int q0, float sink2, const float* rpb, char* shm) {
    const int tid = opq((int)threadIdx.x), lane = tid & 63, r32 = lane & 31, hi = lane >> 5; const int wid = __builtin_amdgcn_readfirstlane(tid >> 6);
    const unsigned lds0 = (unsigned)(uintptr_t)shm;
    float* wsf = (float*)(shm + LDS_WS) + wid * 64;
    constexpr int NCH = DQK / 8, ND0 = DQK / 16;
    int NT, wbase = 0;
    if (MODE == 0) NT = KEYS / 64; else if (MODE == 3) NT = 4;
    else if (MODE == 1) { wbase = max(0, q0 - 128); const int we = min(SEQ, q0 + 256 + 128); NT = 4 + (we - wbase) / 64; }
    else { const int r0 = q0 >> 6; wbase = min(max(r0 - 4, 0), 120); const int kre = min(max(r0 - 1, 0), 120) + 8; NT = 4 + (kre - wbase); }
#define FA_KEY0(t) ((MODE == 0 || MODE == 3 || (t) < 4) ? 64 * (t) : (MODE == 1 ? CTX + wbase + 64 * ((t) - 4) : CTX + (wbase + (t) - 4) * 64))
    const bf16_t* ksrc = Kg + (size_t)lane * DQK; const bf16_t* vsrc = Vg + (size_t)(16 * (wid & 3) + (lane >> 2)) * 64 + (wid >> 2) * 32 + (lane & 3) * 8;
#define DMA_K(t, slotoff) do { const int tt_ = (t) < NT ? (t) : NT - 1; const int k0_ = FA_KEY0(tt_); \
        glds16(ksrc + (size_t)k0_ * DQK + wid * 8, (unsigned)__builtin_amdgcn_readfirstlane(lds0 + (slotoff) + wid * 1024)); \
        if (NCH > 8) { if (wid < NCH - 8) glds16(ksrc + (size_t)k0_ * DQK + (wid + 8) * 8, (unsigned)__builtin_amdgcn_readfirstlane(lds0 + (slotoff) + (wid + 8) * 1024)); } } while (0)
#define DMA_V(t, slotoff) do { const int tt_ = (t) < NT ? (t) : NT - 1; const int k0_ = FA_KEY0(tt_); \
        glds16(vsrc + (size_t)k0_ * 64, (unsigned)__builtin_amdgcn_readfirstlane(lds0 + VBASE + (slotoff) + wid * 1024)); } while (0)
#define WAIT_STEP() do { if (NCH > 8 && wid < NCH - 8) asm volatile("s_waitcnt vmcnt(3) lgkmcnt(0)\n\ts_barrier" ::: "memory"); else asm volatile("s_waitcnt vmcnt(2) lgkmcnt(0)\n\ts_barrier" ::: "memory"); } while (0)
    DMA_K(0, 0); DMA_V(0, 0); DMA_K(1, KSL); DMA_K(2, 2 * KSL);
    if (MODE == 2) { float* rp = (float*)(shm + LDS_RPB); for (int i = tid; i < 15 * 31; i += 512) rp[i] = rpb[i] * LOG2E; }
    bf16x8 qr[ND0];
#pragma unroll
    for (int d0 = 0; d0 < ND0; ++d0) qr[d0] = *reinterpret_cast<const bf16x8*>(Qg + (size_t)(wid * 32 + r32) * DQK + d0 * 16 + hi * 8);
    float mhat = 0.f, l_reg = 0.f; f32x16 o[2]; f32x16 negm;
#pragma unroll
    for (int r = 0; r < 16; ++r) { o[0][r] = 0.f; o[1][r] = 0.f; negm[r] = 0.f; }
    PIN(negm);
    const int qpos = q0 + wid * 32 + r32;
    const int rq = (q0 >> 6) + (wid >> 1), jq = 32 * (wid & 1) + r32;
    const int rs = min(max(rq - 4, 0), 120), cs = min(max(jq - 8, 0), 48);
    const lds_cptr shm3 = (lds_cptr)shm;
    const lds_cptr kp0 = shm3 + hi * 1024 + r32 * 16;
    const lds_cptr vp0 = shm3 + VBASE + ((lane >> 4) & 1) * 32 + (lane & 3) * 8 + (4 * hi + ((lane & 15) >> 2)) * 64;
#define MASK(C0, C1, t) do { \
        if (MODE == 1 && (t) >= 4) { const int kp0_ = wbase + 64 * ((t) - 4) - qpos; \
            _Pragma("unroll") for (int r = 0; r < 16; ++r) { const int d0_ = kp0_ + crow(r, hi), d1_ = d0_ + 32; if (d0_ < -128 || d0_ > 128) C0[r] = -INFINITY; if (d1_ < -128 || d1_ > 128) C1[r] = -INFINITY; } } \
        if (MODE == 2 && (t) >= 4) { const int kr_ = wbase + (t) - 4; const bool rowok_ = (kr_ >= rs) && (kr_ < rs + 8); const int ro_ = min(max(kr_ - rq + 7, 0), 14); \
            const float* rp_ = (const float*)(shm + LDS_RPB) + ro_ * 31 + 15 - jq; \
            _Pragma("unroll") for (int r = 0; r < 16; ++r) { const int kc0 = crow(r, hi), kc1 = kc0 + 32; \
                const bool v0 = rowok_ && (kc0 >= cs) && (kc0 < cs + 16), v1 = rowok_ && (kc1 >= cs) && (kc1 < cs + 16); \
                C0[r] = v0 ? C0[r] + rp_[v0 ? kc0 : jq] : -INFINITY; C1[r] = v1 ? C1[r] + rp_[v1 ? kc1 : jq] : -INFINITY; } } } while (0)
#define ROWMAX(C0, C1, rm) do { float a_ = fmaxf(fmaxf(C0[0], C0[1]), C1[0]), b_ = fmaxf(fmaxf(C0[2], C0[3]), C1[1]); a_ = fmaxf(fmaxf(a_, C1[2]), C1[3]); \
        _Pragma("unroll") for (int r = 4; r < 16; r += 4) { a_ = fmaxf(fmaxf(a_, C0[r]), C0[r + 1]); b_ = fmaxf(fmaxf(b_, C0[r + 2]), C0[r + 3]); a_ = fmaxf(fmaxf(a_, C1[r]), C1[r + 1]); b_ = fmaxf(fmaxf(b_, C1[r + 2]), C1[r + 3]); } \
        rm = fa::xhalf_max(fmaxf(a_, b_)); } while (0)
    bf16x8 kf[8]; bf16x8 kf2[4];
#define KLOAD(j, slotoff) do { kf[2 * (j)] = *(const __attribute__((address_space(3))) bf16x8*)(kp0 + (slotoff) + (j) * 2048); kf[2 * (j) + 1] = *(const __attribute__((address_space(3))) bf16x8*)(kp0 + (slotoff) + (j) * 2048 + 512); } while (0)
#define KLOAD2(slotoff) do { if (ND0 > 4) { kf2[0] = *(const __attribute__((address_space(3))) bf16x8*)(kp0 + (slotoff) + 4 * 2048); kf2[1] = *(const __attribute__((address_space(3))) bf16x8*)(kp0 + (slotoff) + 4 * 2048 + 512); \
        kf2[2] = *(const __attribute__((address_space(3))) bf16x8*)(kp0 + (slotoff) + 5 * 2048); kf2[3] = *(const __attribute__((address_space(3))) bf16x8*)(kp0 + (slotoff) + 5 * 2048 + 512); } } while (0)
    asm volatile("s_waitcnt vmcnt(0) lgkmcnt(0)\n\ts_barrier" ::: "memory");
    f32x16 pA0, pA1, pB0, pB1;
    int ks_cur = 0, ks_next = KSL, ks_nn = 2 * KSL, ks_tgt = 3 * KSL;
    int vs_prev = 2 * VSL, vs_cur = 0, vs_next = VSL;
#define ROT() do { const int k_ = ks_cur; ks_cur = ks_next; ks_next = ks_nn; ks_nn = ks_tgt; ks_tgt = k_; const int v_ = vs_prev; vs_prev = vs_cur; vs_cur = vs_next; vs_next = v_; } while (0)
    bool resc = false;
#define RESC() do { if (resc) { _Pragma("unroll") for (int r = 0; r < 16; ++r) { const float fr_ = wsf[crow(r, hi)]; o[0][r] *= fr_; o[1][r] *= fr_; } } } while (0)
    KLOAD(0, 0); KLOAD(1, 0); KLOAD(2, 0); KLOAD(3, 0); KLOAD2(0);
    {
#pragma unroll
        for (int d0 = 0; d0 < 4; ++d0) { pA0 = __builtin_amdgcn_mfma_f32_32x32x16_bf16(kf[2 * d0], qr[d0], d0 == 0 ? negm : pA0, 0, 0, 0); pA1 = __builtin_amdgcn_mfma_f32_32x32x16_bf16(kf[2 * d0 + 1], qr[d0], d0 == 0 ? negm : pA1, 0, 0, 0); }
        if (ND0 > 4) { pA0 = __builtin_amdgcn_mfma_f32_32x32x16_bf16(kf2[0], qr[ND0 > 4 ? 4 : 0], pA0, 0, 0, 0); pA1 = __builtin_amdgcn_mfma_f32_32x32x16_bf16(kf2[1], qr[ND0 > 4 ? 4 : 0], pA1, 0, 0, 0);
                       pA0 = __builtin_amdgcn_mfma_f32_32x32x16_bf16(kf2[2], qr[ND0 > 4 ? 5 : 0], pA0, 0, 0, 0); pA1 = __builtin_amdgcn_mfma_f32_32x32x16_bf16(kf2[3], qr[ND0 > 4 ? 5 : 0], pA1, 0, 0, 0); }
        DMA_K(3, 3 * KSL); DMA_V(1, VSL);
        float rm; ROWMAX(pA0, pA1, rm);
        mhat = rm;
#pragma unroll
        for (int r = 0; r < 16; ++r) { pA0[r] = __builtin_amdgcn_exp2f(pA0[r] - rm); pA1[r] = __builtin_amdgcn_exp2f(pA1[r] - rm); negm[r] = -mhat; }
        PIN(negm);
        KLOAD(0, KSL); KLOAD(1, KSL); KLOAD(2, KSL); KLOAD(3, KSL);
        WAIT_STEP();
    }
    s16x4 vlo[8], vhi[8]; u32x4 pw0, pw1, pw2, pw3;
#define VRD(i) do { vlo[i] = vtr(vp_ + (((i) >> 2) * 4096 + ((i) & 3) * 1024)); vhi[i] = vtr(vp_ + (((i) >> 2) * 4096 + ((i) & 3) * 1024 + 512)); } while (0)
#define VFR(i) (bf16x8){vlo[i][0], vlo[i][1], vlo[i][2], vlo[i][3], vhi[i][0], vhi[i][1], vhi[i][2], vhi[i][3]}
#define PAF(k) __builtin_bit_cast(bf16x8, pw##k)
#define GAPA(MF, A0, A1, A2, A3, W0, W1, PW) do { MF; sacc += A0; sacc += A1; sacc += A2; sacc += A3; PIN(sacc); W0; W1; PIN(PW); SBAR(); } while (0)
#define EX(v) __builtin_amdgcn_exp2f(v)
#define GAPB(MF, X, B) do { MF; X[B] = EX(X[B]); X[B + 1] = EX(X[B + 1]); X[B + 2] = EX(X[B + 2]); X[B + 3] = EX(X[B + 3]); PIN(X); SBAR(); } while (0)
#define KRD(j) do { KLOAD(j, ks_nn_); SBAR(); } while (0)
#define STEP(C0, C1, P0, P1, t) do { SBAR(); \
        const lds_cptr vp_ = vp0 + vs_prev; const int ks_cur_ = ks_cur; (void)ks_cur_; \
        KLOAD2(ks_cur_); \
        VRD(0); SBAR(); float sacc = (P0[0] + P0[1]); \
        GAPA(C0 = __builtin_amdgcn_mfma_f32_32x32x16_bf16(kf[0], qr[0], negm, 0, 0, 0), P0[2], P0[3], P0[4], P0[5], pw0[0] = cvtpk(P0[0], P0[1]), pw0[1] = cvtpk(P0[2], P0[3]), pw0); \
        VRD(4); SBAR(); GAPA(C1 = __builtin_amdgcn_mfma_f32_32x32x16_bf16(kf[1], qr[0], negm, 0, 0, 0), P0[6], P0[7], P0[8], P0[9], pw0[2] = cvtpk(P0[4], P0[5]), pw0[3] = cvtpk(P0[6], P0[7]), pw0); \
        VRD(1); SBAR(); GAPA(C0 = __builtin_amdgcn_mfma_f32_32x32x16_bf16(kf[2], qr[1], C0, 0, 0, 0), P0[10], P0[11], P0[12], P0[13], pw1[0] = cvtpk(P0[8], P0[9]), pw1[1] = cvtpk(P0[10], P0[11]), pw1); \
        VRD(5); SBAR(); GAPA(C1 = __builtin_amdgcn_mfma_f32_32x32x16_bf16(kf[3], qr[1], C1, 0, 0, 0), P0[14], P0[15], P1[0], P1[1], pw1[2] = cvtpk(P0[12], P0[13]), pw1[3] = cvtpk(P0[14], P0[15]), pw1); \
        VRD(2); SBAR(); GAPA(C0 = __builtin_amdgcn_mfma_f32_32x32x16_bf16(kf[4], qr[2], C0, 0, 0, 0), P1[2], P1[3], P1[4], P1[5], pw2[0] = cvtpk(P1[0], P1[1]), pw2[1] = cvtpk(P1[2], P1[3]), pw2); \
        VRD(6); SBAR(); GAPA(C1 = __builtin_amdgcn_mfma_f32_32x32x16_bf16(kf[5], qr[2], C1, 0, 0, 0), P1[6], P1[7], P1[8], P1[9], pw2[2] = cvtpk(P1[4], P1[5]), pw2[3] = cvtpk(P1[6], P1[7]), pw2); \
        VRD(3); SBAR(); GAPA(C0 = __builtin_amdgcn_mfma_f32_32x32x16_bf16(kf[6], qr[3], C0, 0, 0, 0), P1[10], P1[11], P1[12], P1[13], pw3[0] = cvtpk(P1[8], P1[9]), pw3[1] = cvtpk(P1[10], P1[11]), pw3); \
        VRD(7); SBAR(); GAPA(C1 = __builtin_amdgcn_mfma_f32_32x32x16_bf16(kf[7], qr[3], C1, 0, 0, 0), P1[14], P1[15], 0.f, 0.f, pw3[2] = cvtpk(P1[12], P1[13]), pw3[3] = cvtpk(P1[14], P1[15]), pw3); \
        if (ND0 > 4) { C0 = __builtin_amdgcn_mfma_f32_32x32x16_bf16(kf2[0], qr[ND0 > 4 ? 4 : 0], C0, 0, 0, 0); C1 = __builtin_amdgcn_mfma_f32_32x32x16_bf16(kf2[1], qr[ND0 > 4 ? 4 : 0], C1, 0, 0, 0); \
                       C0 = __builtin_amdgcn_mfma_f32_32x32x16_bf16(kf2[2], qr[ND0 > 4 ? 5 : 0], C0, 0, 0, 0); C1 = __builtin_amdgcn_mfma_f32_32x32x16_bf16(kf2[3], qr[ND0 > 4 ? 5 : 0], C1, 0, 0, 0); SBAR(); } \
        l_reg += sacc; \
        DMA_K((t) + 3, ks_tgt); DMA_V((t) + 1, vs_next); \
        MASK(C0, C1, t); \
        { float rm; ROWMAX(C0, C1, rm); resc = false; \
          if (__builtin_expect(__any(rm > (float)THRL), 0)) { const float dl = fmaxf(rm, 0.f); mhat += dl; \
              _Pragma("unroll") for (int r = 0; r < 16; ++r) { C0[r] -= dl; C1[r] -= dl; } \
              _Pragma("unroll") for (int r = 0; r < 16; ++r) negm[r] = -mhat; PIN(negm); \
              const float f = __builtin_amdgcn_exp2f(-dl); l_reg *= f; if (hi == 0) wsf[r32] = f; resc = true; } } \
        SBAR(); \
        const int ks_nn_ = ks_next; \
        GAPB(o[0] = __builtin_amdgcn_mfma_f32_32x32x16_bf16(PAF(0), VFR(0), o[0], 0, 0, 0), C0, 0); \
        GAPB(o[1] = __builtin_amdgcn_mfma_f32_32x32x16_bf16(PAF(0), VFR(4), o[1], 0, 0, 0), C0, 4); \
        KRD(0); GAPB(o[0] = __builtin_amdgcn_mfma_f32_32x32x16_bf16(PAF(1), VFR(1), o[0], 0, 0, 0), C0, 8); \
        KRD(1); GAPB(o[1] = __builtin_amdgcn_mfma_f32_32x32x16_bf16(PAF(1), VFR(5), o[1], 0, 0, 0), C0, 12); \
        KRD(2); GAPB(o[0] = __builtin_amdgcn_mfma_f32_32x32x16_bf16(PAF(2), VFR(2), o[0], 0, 0, 0), C1, 0); \
        KRD(3); GAPB(o[1] = __builtin_amdgcn_mfma_f32_32x32x16_bf16(PAF(2), VFR(6), o[1], 0, 0, 0), C1, 4); \
        GAPB(o[0] = __builtin_amdgcn_mfma_f32_32x32x16_bf16(PAF(3), VFR(3), o[0], 0, 0, 0), C1, 8); \
        GAPB(o[1] = __builtin_amdgcn_mfma_f32_32x32x16_bf16(PAF(3), VFR(7), o[1], 0, 0, 0), C1, 12); \
    } while (0)
    ROT();
    int t = 1;
    for (; t + 1 < NT; t += 2) {
        STEP(pB0, pB1, pA0, pA1, t);     WAIT_STEP(); RESC(); ROT();
        STEP(pA0, pA1, pB0, pB1, t + 1); WAIT_STEP(); RESC(); ROT();
    }
    if (t < NT) {
        STEP(pB0, pB1, pA0, pA1, t);     WAIT_STEP(); RESC(); ROT();
        pA0 = pB0; pA1 = pB1;
    }
    {
        float sacc = 0.f;
#pragma unroll
        for (int r = 0; r < 16; ++r) sacc += pA0[r] + pA1[r];
        l_reg += sacc;
        pw0 = (u32x4){cvtpk(pA0[0], pA0[1]), cvtpk(pA0[2], pA0[3]), cvtpk(pA0[4], pA0[5]), cvtpk(pA0[6], pA0[7])};
        pw1 = (u32x4){cvtpk(pA0[8], pA0[9]), cvtpk(pA0[10], pA0[11]), cvtpk(pA0[12], pA0[13]), cvtpk(pA0[14], pA0[15])};
        pw2 = (u32x4){cvtpk(pA1[0], pA1[1]), cvtpk(pA1[2], pA1[3]), cvtpk(pA1[4], pA1[5]), cvtpk(pA1[6], pA1[7])};
        pw3 = (u32x4){cvtpk(pA1[8], pA1[9]), cvtpk(pA1[10], pA1[11]), cvtpk(pA1[12], pA1[13]), cvtpk(pA1[14], pA1[15])};
        const lds_cptr vp_ = vp0 + vs_prev;
#pragma unroll
        for (int i = 0; i < 8; ++i) VRD(i);
        o[0] = __builtin_amdgcn_mfma_f32_32x32x16_bf16(PAF(0), VFR(0), o[0], 0, 0, 0); o[1] = __builtin_amdgcn_mfma_f32_32x32x16_bf16(PAF(0), VFR(4), o[1], 0, 0, 0);
        o[0] = __builtin_amdgcn_mfma_f32_32x32x16_bf16(PAF(1), VFR(1), o[0], 0, 0, 0); o[1] = __builtin_amdgcn_mfma_f32_32x32x16_bf16(PAF(1), VFR(5), o[1], 0, 0, 0);
        o[0] = __builtin_amdgcn_mfma_f32_32x32x16_bf16(PAF(2), VFR(2), o[0], 0, 0, 0); o[1] = __builtin_amdgcn_mfma_f32_32x32x16_bf16(PAF(2), VFR(6), o[1], 0, 0, 0);
        o[0] = __builtin_amdgcn_mfma_f32_32x32x16_bf16(PAF(3), VFR(3), o[0], 0, 0, 0); o[1] = __builtin_amdgcn_mfma_f32_32x32x16_bf16(PAF(3), VFR(7), o[1], 0, 0, 0);
    }
    l_reg = fa::xhalf_sum(l_reg);
    if (MODE == 1 || MODE == 3) l_reg += __builtin_amdgcn_exp2f(sink2 - mhat);
    if (hi == 0) wsf[32 + r32] = 1.0f / l_reg;
    float rli[16];
#pragma unroll
    for (int r = 0; r < 16; ++r) rli[r] = wsf[32 + crow(r, hi)];
    bf16_t* stg = (bf16_t*)(shm + LDS_OST) + wid * 2048;
#pragma unroll
    for (int r = 0; r < 16; ++r) { const int orow = crow(r, hi);
#pragma unroll
        for (int dh = 0; dh < 2; ++dh) stg[orow * 64 + dh * 32 + r32] = (bf16_t)f2bf(o[dh][r] * rli[r]); }
#pragma unroll
    for (int i = 0; i < 4; ++i) { const int row = i * 8 + (lane >> 3), ch = lane & 7; const u32x4 v = *(const u32x4*)(stg + row * 64 + ch * 8); *(u32x4*)(Og + (size_t)(wid * 32 + row) * D + ch * 8) = v; }
    asm volatile("s_waitcnt vmcnt(0) lgkmcnt(0)\n\ts_barrier" ::: "memory");
#undef FA_KEY0
#undef DMA_K
#undef DMA_V
#undef WAIT_STEP
#undef MASK
#undef ROWMAX
#undef KLOAD
#undef KLOAD2
#undef ROT
#undef RESC
#undef VRD
#undef VFR
#undef PAF
#undef GAPA
#undef EX
#undef GAPB
#undef KRD
#undef STEP
}
#undef SBAR
#undef PIN
}

constexpr float SCALE_MLA = 0.10206207261596575f;
__device__ __forceinline__ void ph_attn(const Params& p, int layer, bool with_ctx, char* shm) {
    const QKVB qb = make_qkv(p.ws);
    bf16_t* O = (bf16_t*)(p.ws + WS_P);
    const int G = gridDim.x;
    const float NEG = -INFINITY;
    for (int u = blockIdx.x; u < 256; u += G) { const int bh = u & 7, b = bh >> 2, h = bh & 3, qbk = u >> 3;
        fa2::attn_unit<96, 0, 6>(qb.QD + ((size_t)bh * SEQ + qbk * 256) * 96, qb.KD + (size_t)bh * KEYS * 96, qb.VD + (size_t)bh * KEYS * 64, O + (size_t)(b * SEQ + qbk * 256) * D + 768 + h * 64, qbk * 256, NEG, nullptr, shm); }
    for (int u = blockIdx.x; u < 256; u += G) { const int bh = u & 7, b = bh >> 2, h = bh & 3, qbk = u >> 3;
        fa2::attn_unit<64, 0, 6>(qb.QB + ((size_t)bh * SEQ + qbk * 256) * 64, qb.KB + (size_t)(b * 2 + (h >> 1)) * KEYS * 64, qb.VB + (size_t)(b * 2 + (h >> 1)) * KEYS * 64, O + (size_t)(b * SEQ + qbk * 256) * D + 256 + h * 64, qbk * 256, NEG, nullptr, shm); }
    for (int u = blockIdx.x; u < 256; u += G) { const int bh = u & 7, b = bh >> 2, h = bh & 3, qbk = u >> 3;
        fa2::attn_unit<64, 1, 6>(qb.QA + ((size_t)bh * SEQ + qbk * 256) * 64, qb.KA + (size_t)(b * 2 + (h >> 1)) * KEYS * 64, qb.VA + (size_t)(b * 2 + (h >> 1)) * KEYS * 64, O + (size_t)(b * SEQ + qbk * 256) * D + 0 + h * 64, qbk * 256, p.in[11][layer * 4 + h] * fa::LOG2E, nullptr, shm); }
    for (int u = blockIdx.x; u < 256; u += G) { const int bh = u & 7, b = bh >> 2, h = bh & 3, qbk = u >> 3;
        fa2::attn_unit<64, 2, 6>(qb.QC + ((size_t)bh * SEQ + qbk * 256) * 64, qb.KC + (size_t)bh * KEYS * 64, qb.VC + (size_t)bh * KEYS * 64, O + (size_t)(b * SEQ + qbk * 256) * D + 512 + h * 64, qbk * 256, NEG, p.in[16] + ((size_t)layer * 4 + h) * 15 * 31, shm); }
    if (with_ctx) for (int u = blockIdx.x; u < 32; u += G) { const int ty = u >> 3, bh = u & 7, b = bh >> 2, h = bh & 3;
        bf16_t* Oc = O + (size_t)(TL + b * CTX) * D + ty * 256 + h * 64;
        if (ty == 0) fa2::attn_unit<64, 3, 6>(qb.QAc + (size_t)bh * CTX * 64, qb.KA + (size_t)(b * 2 + (h >> 1)) * KEYS * 64, qb.VA + (size_t)(b * 2 + (h >> 1)) * KEYS * 64, Oc, 0, p.in[11][layer * 4 + h] * fa::LOG2E, nullptr, shm);
        else if (ty == 1) fa2::attn_unit<64, 3, 6>(qb.QBc + (size_t)bh * CTX * 64, qb.KB + (size_t)(b * 2 + (h >> 1)) * KEYS * 64, qb.VB + (size_t)(b * 2 + (h >> 1)) * KEYS * 64, Oc, 0, NEG, nullptr, shm);
        else if (ty == 2) fa2::attn_unit<64, 3, 6>(qb.QCc + (size_t)bh * CTX * 64, qb.KC + (size_t)bh * KEYS * 64, qb.VC + (size_t)bh * KEYS * 64, Oc, 0, NEG, nullptr, shm);
        else fa2::attn_unit<96, 3, 6>(qb.QDc + (size_t)bh * CTX * 96, qb.KD + (size_t)bh * KEYS * 96, qb.VD + (size_t)bh * KEYS * 64, Oc, 0, NEG, nullptr, shm); }
}

__device__ __forceinline__ void ph_gnorm(const Params& p, int layer, int nrows) {
    const int tx = opq((int)threadIdx.x), lane = tx & 63, gw = (blockIdx.x * 512 + tx) >> 6, ngw = (gridDim.x * 512) >> 6;
    const bf16_t* O = (const bf16_t*)(p.ws + WS_P); bf16_t* Y = (bf16_t*)(p.ws + WS_ACT1); const float* g = p.in[23] + layer * D;
    for (int m = gw; m < nrows; m += ngw) {
#pragma unroll
        for (int grp = 0; grp < 4; ++grp) { const int c = grp * 256 + 4 * lane; const u32x2 w = *(const u32x2*)(O + (size_t)m * D + c);
            const float a0 = bflo(w.x), a1 = bfhi(w.x), a2 = bflo(w.y), a3 = bfhi(w.y);
            const float r = rsqrtf(wave_sum(a0 * a0 + a1 * a1 + a2 * a2 + a3 * a3) * (1.f / 256.f) + EPS);
            const f32x4 gv = *(const f32x4*)(g + c); u32x2 o; o.x = pk2(a0 * r * gv.x, a1 * r * gv.y); o.y = pk2(a2 * r * gv.z, a3 * r * gv.w);
            *(u32x2*)(Y + (size_t)m * D + c) = o; }
    }
}

__device__ __forceinline__ void moe_bases(const unsigned* cnt, int (&base)[9]) {
    int acc = 0;
#pragma unroll
    for (int e = 0; e < 8; ++e) { base[e] = acc; acc += ((int)cnt[64 * e] + 255) / 256 * 256; }
    base[8] = acc;
}
__device__ __forceinline__ void ph_moe_gather(const Params& p) {
    const int tx = opq((int)threadIdx.x), lane = tx & 63, gw = (blockIdx.x * 512 + tx) >> 6, ngw = (gridDim.x * 512) >> 6;
    const unsigned* cnt = (const unsigned*)(p.ws + WS_CTL); int base[9]; moe_bases(cnt, base);
    if (blockIdx.x == 0 && tx < 136) { const int r = tx * 256; int e = -1;
#pragma unroll
        for (int i = 0; i < 8; ++i) if (r >= base[i] && r < base[i + 1]) e = i;
        ((int*)(p.ws + WS_TEXP))[tx] = e < 0 ? 0 : e; }
    const bf16_t* F = (const bf16_t*)(p.ws + WS_ACT1); bf16_t* A = (bf16_t*)(p.ws + WS_ASORT);
    for (int m = gw; m < TL; m += ngw) {
        const int2 e = ((const int2*)(p.ws + WS_TOKE))[m]; const int2 ps = ((const int2*)(p.ws + WS_TOKP))[m];
        int b0 = 0, b1 = 0;
#pragma unroll
        for (int i = 0; i < 8; ++i) { if (e.x == i) b0 = base[i]; if (e.y == i) b1 = base[i]; }
        const int s0 = b0 + ps.x, s1 = b1 + ps.y;
        const u32x4 v0 = *(const u32x4*)(F + (size_t)m * D + lane * 16), v1 = *(const u32x4*)(F + (size_t)m * D + lane * 16 + 8);
        *(u32x4*)(A + (size_t)s0 * D + lane * 16) = v0; *(u32x4*)(A + (size_t)s0 * D + lane * 16 + 8) = v1;
        *(u32x4*)(A + (size_t)s1 * D + lane * 16) = v0; *(u32x4*)(A + (size_t)s1 * D + lane * 16 + 8) = v1;
        if (lane == 0) ((int2*)(p.ws + WS_TOKS))[m] = make_int2(s0, s1);
    }
}
__device__ __forceinline__ void ph_moe_combine(const Params& p, int layer) {
    const size_t nthr = (size_t)gridDim.x * 512;
    for (size_t idx = (size_t)blockIdx.x * 512 + opq((int)threadIdx.x); idx < (size_t)TL * 256; idx += nthr) {
        const int m = (int)(idx >> 8), c = (int)(idx & 255) * 4;
        const int2 sl = ((const int2*)(p.ws + WS_TOKS))[m]; const float2 g = ((const float2*)(p.ws + WS_TOKG))[m];
        const bf16_t* Y = (const bf16_t*)(p.ws + WS_ASORT);
        const u32x2 a = *(const u32x2*)(Y + (size_t)sl.x * D + c), b = *(const u32x2*)(Y + (size_t)sl.y * D + c);
        const f32x4 ya = {bflo(a.x), bfhi(a.x), bflo(a.y), bfhi(a.y)}, yb = {bflo(b.x), bfhi(b.x), bflo(b.y), bfhi(b.y)};
        const float* mod = (const float*)(p.ws + WS_MOD) + (size_t)layer * 3 * 6144 + (m / SEQ) * 6144 + 5 * D;
        f32x4* o = (f32x4*)(p.out + (size_t)m * D + c);
        *o = *o + *(const f32x4*)(mod + c) * (ya * g.x + yb * g.y);
    }
}

#ifndef DBL_PHASE
#define DBL_PHASE (-1)
#endif
#ifndef FILL_Q_IN
#define FILL_Q_IN 0
#define FILL_Q_OUT 0
#define FILL_Q_UP 0
#define FILL_Q_DN 0
#endif
struct Args { Params p; int ph_lo, ph_hi; };
__global__ void __launch_bounds__(NWAVES * 64, 2) mega_fwd(Args args) {
    extern __shared__ __attribute__((aligned(16))) unsigned char lds[];
    LAS unsigned char* ldsl = (LAS unsigned char*)lds;
    for (int u = threadIdx.x; u < (LDS_BYTES - LDSCTL_OFF) / 4; u += NWAVES * 64) ((LAS unsigned*)(ldsl + LDSCTL_OFF))[u] = 0u;
    __syncthreads();
    XcdBarrier bar = xcd_barrier_post((unsigned*)(args.p.ws + WS_CTL) + CW_BAR, (volatile LAS unsigned*)(ldsl + MISC_OFF) + 8);
    const int lo = args.ph_lo, hi = args.ph_hi;
#pragma unroll 1
    for (int ph = lo; ph < hi; ++ph) {
      const int nrep = (ph == DBL_PHASE) ? 2 : 1;
#pragma unroll 1
      for (int rep_ = 0; rep_ < nrep; ++rep_) {
        if (rep_) xcd_barrier(bar);
        Params q = args.p; q.ws = opqp(args.p.ws); q.out = opqp(args.p.out);
        LAS unsigned char* ldq = (LAS unsigned char*)lds;
        const int l = ph >= 10 ? 1 : 0, st = ph == 0 ? -1 : (l ? ph - 10 : ph - 1);
        const bool last = (l == 1); const int nrows = last ? TL : MALL;
        const float* qmod = (const float*)(q.ws + WS_MOD) + (size_t)l * 3 * 6144;
        int fillq = 0, fill_nwg = 1;
        if (st == -1) ph_prologue(q, (float*)lds);
        else if (st == 0) ph_norm<1, false>(q, l, MALL, (unsigned*)lds, l ? 11 : 0);
        else if (st == 1) { run_gemm(ldq, (const bf16_t*)(q.ws + WS_ACT1), (const bf16_t*)(q.ws + WS_WIN) + (size_t)l * NINP * D, D, MALL / 256, NINP / 256, nullptr, 0, EpiBf16Perm{(bf16_t*)(q.ws + WS_P), NINP, 0});
                            fillq = FILL_Q_IN; fill_nwg = (MALL / 256) * (NINP / 256); }
        else if (st == 2) ph_postproj2(q, l);
        else if (st == 3) ph_attn(q, l, !last, (char*)lds);
        else if (st == 4) ph_gnorm(q, l, nrows);
        else if (st == 5 || (st == 8 && !last)) {
            const bool op = (st == 5);
            const bf16_t* A_ = (const bf16_t*)(q.ws + (op ? WS_ACT1 : WS_HIDF)); const bf16_t* B_ = op ? (const bf16_t*)(q.ws + WS_WOUT) + (size_t)l * D * D : (const bf16_t*)(q.ws + WS_WFDN);
            const int K_ = op ? D : DFF, goff_ = op ? 2 * D : 5 * D;
            const float* hl_in_ = (op && l == 0) ? q.in[0] : q.out;
#pragma unroll 1
            for (int pass = 0; pass < (last ? 1 : 2); ++pass)
                run_gemm(ldq, A_, B_, K_, pass ? 2 : 64, D / 256, nullptr, 0, EpiResid{hl_in_, (const float*)(q.ws + WS_HCTX), q.out, pass ? (float*)(q.ws + WS_PART) : (float*)(q.ws + WS_HCTX), qmod, goff_, pass}, pass ? (op ? 8 : 11) : 1, pass ? 64 : 0);
        }
        else if (!last) {
            if (st == 6) ph_norm<2, false>(q, l, MALL, (unsigned*)lds, 8);
            else if (st == 7) { run_gemm(ldq, (const bf16_t*)(q.ws + WS_ACT1), (const bf16_t*)(q.ws + WS_WFGU), D, MALL / 256, 2 * DFF / 256, nullptr, 0, EpiSwiglu{(bf16_t*)(q.ws + WS_HIDF), DFF, 0});
                                fillq = FILL_Q_UP; fill_nwg = (MALL / 256) * (2 * DFF / 256); }
            else {}
        } else {
            if (st == 6) ph_norm<2, true>(q, l, TL, (unsigned*)lds, 0);
            else if (st == 7) { ph_moe_gather(q); fillq = 1 << 30; fill_nwg = 0; }
            else if (st == 8) { int base[9]; moe_bases((const unsigned*)(q.ws + WS_CTL), base); run_gemm(ldq, (const bf16_t*)(q.ws + WS_ASORT), (const bf16_t*)(q.ws + WS_WMGU), D, __builtin_amdgcn_readfirstlane(base[8] / 256), 2 * DFFE / 256, (const int*)(q.ws + WS_TEXP), (size_t)2 * DFFE * D * 2, EpiSwiglu{(bf16_t*)(q.ws + WS_HIDM), DFFE, 0}); }
            else if (st == 9) { int base[9]; moe_bases((const unsigned*)(q.ws + WS_CTL), base); run_gemm(ldq, (const bf16_t*)(q.ws + WS_HIDM), (const bf16_t*)(q.ws + WS_WMDN), DFFE, __builtin_amdgcn_readfirstlane(base[8] / 256), D / 256, (const int*)(q.ws + WS_TEXP), (size_t)D * DFFE * 2, EpiBf16Perm{(bf16_t*)(q.ws + WS_ASORT), D, 0}); }
            else ph_moe_combine(q, l);
        }
        if (fillq > 0 && (fill_nwg == 0 || gemm_tail_idle(fill_nwg))) fill_moe(q, (float*)lds, fillq);
      }
      if (ph + 1 < hi) xcd_barrier(bar);
    }
}

#ifndef MK_CUTS
#define MK_CUTS 0
#endif
extern "C" void kernel_launch(void* const* d_in, const int* in_sizes, int n_in, void* d_out, int out_size, void* d_ws, size_t ws_size, hipStream_t stream) {
    static int grid = 0;
    if (grid == 0) {
        if (n_in != 32 || ws_size < WS_END) { fprintf(stderr, "kernel_launch: need 32 inputs and %zu bytes of workspace (got %d, %zu)\n", (size_t)WS_END, n_in, ws_size); grid = -1; return; }
        int dev = 0, cus = 0, per_cu = 0;
        if (hipGetDevice(&dev) != hipSuccess || hipDeviceGetAttribute(&cus, hipDeviceAttributeMultiprocessorCount, dev) != hipSuccess) { grid = -1; return; }
        if (hipFuncSetAttribute((const void*)mega_fwd, hipFuncAttributeMaxDynamicSharedMemorySize, LDS_BYTES) != hipSuccess) { fprintf(stderr, "kernel_launch: hipFuncSetAttribute failed\n"); grid = -1; return; }
        if (hipOccupancyMaxActiveBlocksPerMultiprocessor(&per_cu, (const void*)mega_fwd, NWAVES * 64, LDS_BYTES) != hipSuccess || per_cu < 1) fprintf(stderr, "kernel_launch: occupancy query says %d blocks per CU\n", per_cu);
        (void)hipGetLastError();
        grid = cus;
    }
    if (grid < 0) return;
    (void)hipMemsetAsync((char*)d_ws + WS_CTL, 0, CTL_ZERO_BYTES, stream);
    Args a{}; for (int i = 0; i < 32; ++i) a.p.in[i] = (const float*)d_in[i]; a.p.out = (float*)d_out; a.p.ws = (unsigned char*)d_ws;
#if MK_CUTS
    for (int ph = 0; ph < 24; ++ph) { a.ph_lo = ph; a.ph_hi = ph + 1; hipLaunchKernelGGL(mega_fwd, dim3(grid), dim3(NWAVES * 64), LDS_BYTES, stream, a); }
#else
    a.ph_lo = 0; a.ph_hi = 21;
    hipLaunchKernelGGL(mega_fwd, dim3(grid), dim3(NWAVES * 64), LDS_BYTES, stream, a);
#endif
}
```

```cpp
#include <hip/hip_runtime.h>
#include <stdint.h>
#include <cstdio>

typedef unsigned short bf16_t;
typedef float f32x4 __attribute__((ext_vector_type(4)));
typedef unsigned u32x4 __attribute__((ext_vector_type(4)));
typedef unsigned u32x2 __attribute__((ext_vector_type(2)));

constexpr int D = 1024, NB = 2, SEQ = 8192, CTX = 256, TL = NB * SEQ, TC = NB * CTX, MALL = TL + TC;
constexpr int NIN = 2144, NINP = 2304, DFF = 2816, NE = 8, DFFE = 3584, KEYS = CTX + SEQ;
constexpr int OFF_AQ = 0, OFF_AK = 256, OFF_AV = 384, OFF_BQ = 512, OFF_BK = 768, OFF_BV = 896, OFF_CQ = 1024, OFF_CK = 1280,
              OFF_CV = 1536, OFF_DCQ = 1792, OFF_DCKV = 1984, OFF_DKR = 2112;
constexpr int MOE_ROWS = 34816;
constexpr float EPS = 1e-6f;

constexpr size_t MiB = 1u << 20;
constexpr size_t WS_CTL = 0;
constexpr size_t WS_MOD = 1 * MiB;
constexpr size_t WS_ROPE = WS_MOD + 256 * 1024;
constexpr size_t WS_TOKE = WS_ROPE + 64 * 1024;
constexpr size_t WS_TOKP = WS_TOKE + TL * 8;
constexpr size_t WS_TOKG = WS_TOKP + TL * 8;
constexpr size_t WS_TEXP = WS_TOKG + TL * 8;
constexpr size_t WS_TOKS = WS_TEXP + 1024;
constexpr size_t WS_HCTX = 2 * MiB;
constexpr size_t WS_WMGU = 6 * MiB;
constexpr size_t WS_WMDN = WS_WMGU + 112 * MiB;
constexpr size_t WS_WDEAD = WS_WMDN + 56 * MiB;
constexpr size_t WS_WIN = WS_WDEAD;
constexpr size_t WS_WOUT = WS_WIN + 9 * MiB;
constexpr size_t WS_WUQ = WS_WOUT + 4 * MiB;
constexpr size_t WS_WUKV = WS_WUQ + 512 * 1024;
constexpr size_t WS_WFGU = WS_WUKV + 512 * 1024;
constexpr size_t WS_WFDN = WS_WFGU + 11 * MiB;
constexpr size_t WS_ACT = 205 * MiB;
static_assert(WS_WFDN + (size_t)1024 * 2816 * 2 <= WS_ACT, "weights fit");
constexpr size_t WS_ACT1 = WS_ACT;
constexpr size_t WS_P = WS_ACT + 33 * MiB;
constexpr size_t WS_QKV = WS_ACT + 108 * MiB;
constexpr size_t WS_PART = WS_ACT + 128 * MiB;
constexpr size_t WS_HIDF = WS_P;
constexpr size_t WS_HIDM = WS_WDEAD;
constexpr size_t WS_ASORT = WS_HIDM + 238 * MiB;
constexpr size_t WS_END = WS_ASORT + 68 * MiB;
static_assert(WS_QKV + 91 * MiB <= WS_END, "qkv fits");

struct Params { const float* in[32]; float* out; unsigned char* ws; };

struct QKVB { bf16_t *QA, *KA, *VA, *QB, *KB, *VB, *QC, *KC, *VC, *QD, *KD, *VD, *QAc, *QBc, *QCc, *QDc; };
__host__ __device__ inline QKVB make_qkv(unsigned char* ws) {
    QKVB q; bf16_t* p = (bf16_t*)(ws + WS_QKV);
    q.QA = p; p += (size_t)NB * 4 * SEQ * 64; q.KA = p; p += (size_t)NB * 2 * KEYS * 64; q.VA = p; p += (size_t)NB * 2 * KEYS * 64;
    q.QB = p; p += (size_t)NB * 4 * SEQ * 64; q.KB = p; p += (size_t)NB * 2 * KEYS * 64; q.VB = p; p += (size_t)NB * 2 * KEYS * 64;
    q.QC = p; p += (size_t)NB * 4 * SEQ * 64; q.KC = p; p += (size_t)NB * 4 * KEYS * 64; q.VC = p; p += (size_t)NB * 4 * KEYS * 64;
    q.QD = p; p += (size_t)NB * 4 * SEQ * 96; q.KD = p; p += (size_t)NB * 4 * KEYS * 96; q.VD = p; p += (size_t)NB * 4 * KEYS * 64;
    q.QAc = p; p += (size_t)NB * 4 * CTX * 64; q.QBc = p; p += (size_t)NB * 4 * CTX * 64; q.QCc = p; p += (size_t)NB * 4 * CTX * 64;
    q.QDc = p; p += (size_t)NB * 4 * CTX * 96;
    return q;
}

__device__ __forceinline__ float bf2f(unsigned v) { return __uint_as_float(v << 16); }
__device__ __forceinline__ float bflo(unsigned w) { return __uint_as_float(w << 16); }
__device__ __forceinline__ float bfhi(unsigned w) { return __uint_as_float(w & 0xffff0000u); }
__device__ __forceinline__ unsigned f2bf(float f) { unsigned u = __float_as_uint(f); return (u + 0x7fffu + ((u >> 16) & 1u)) >> 16; }
typedef float pk_f32x2 __attribute__((ext_vector_type(2))); typedef __bf16 pk_bf16x2 __attribute__((ext_vector_type(2)));
__device__ __forceinline__ unsigned pk2(float lo, float hi) { pk_f32x2 v = {lo, hi}; pk_bf16x2 b = __builtin_convertvector(v, pk_bf16x2); return __builtin_bit_cast(unsigned, b); }
template <int X> __device__ __forceinline__ float swz_xor(float v) { return __int_as_float(__builtin_amdgcn_ds_swizzle(__float_as_int(v), 0x1f | (X << 10))); }
__device__ __forceinline__ float half_sum(float v) { auto rr = __builtin_amdgcn_permlane32_swap(__float_as_uint(v), __float_as_uint(v), false, false); return __uint_as_float(rr[0]) + __uint_as_float(rr[1]); }
__device__ __forceinline__ float half_other(float v, int lane) { auto rr = __builtin_amdgcn_permlane32_swap(__float_as_uint(v), __float_as_uint(v), false, false); return __uint_as_float((lane & 32) ? rr[0] : rr[1]); }
__device__ __forceinline__ float wave_sum(float v) { v += swz_xor<1>(v); v += swz_xor<2>(v); v += swz_xor<4>(v); v += swz_xor<8>(v); v += swz_xor<16>(v); return half_sum(v); }
__device__ __forceinline__ int opq(int v) { asm volatile("" : "+v"(v)); return v; }
template <class T> __device__ __forceinline__ T* opqp(T* p) { asm volatile("" : "+s"(p)); return p; }
__device__ __forceinline__ int opqs(int v) { asm volatile("" : "+s"(v)); return v; }
__device__ __forceinline__ float silu_f(float x) { return x / (1.f + expf(-x)); }
__device__ __forceinline__ float silu_fast(float x) { return x * __builtin_amdgcn_rcpf(1.f + __builtin_amdgcn_exp2f(-1.4426950408889634f * x)); }

constexpr int RT_R64 = 0, RT_C64 = 2048, RT_R32 = 3072, RT_C32 = 4096, RT_N = 4608;

namespace pg8 {
#define PG8_LAS __attribute__((address_space(3)))
typedef unsigned short bf16_t;
typedef short bf16x8 __attribute__((ext_vector_type(8)));
typedef float f32x4 __attribute__((ext_vector_type(4)));
typedef unsigned u32x4 __attribute__((ext_vector_type(4)));
constexpr int BM = 256, BK = 64, HALF = 128, HTB = HALF * BK * 2  , STAGE_BYTES = 8 * HTB, NXCD = 8, WGM = 8;

__host__ __device__ __forceinline__ int lds_byte(int r, int c) { const int st = (r >> 4) * 2 + (c >> 5), rr = r & 15, cc = c & 31, ob = rr * 64 + cc * 2; return st * 1024 + (ob ^ (((ob >> 9) & 1) << 5)); }
__host__ __device__ __forceinline__ void stage_rc(int b, int& R, int& C) { const int st = b / 1024, sb = b % 1024, swz = sb ^ (((sb >> 9) & 1) << 5); R = (st >> 1) * 16 + swz / 64; C = (st & 1) * 32 + (swz % 64) / 2; }
__host__ __device__ __forceinline__ int perm32(int rho) { const int n = rho >> 4, i = rho & 15; return 8 * (i >> 2) + 4 * n + (i & 3); }

struct Unit { int pm, pn, e, ks; };
struct Gemm { const bf16_t* A; const bf16_t* Bt; int K; size_t estride; int Kloop; };

struct StaticOrder {
    int nM, nN, nwg, G, c, S, pm0; const int* texp;
    __host__ __device__ void init(int nM_, int nN_, int G_, int c_, const int* texp_, int S_ = 1, int pm0_ = 0) { nM = nM_; nN = nN_; nwg = nM * nN; G = G_; c = c_; texp = texp_; S = S_; pm0 = pm0_; }
    __host__ __device__ bool next(int i, Unit& u) const {
        const long L = (long)i * G + c; if (L >= (long)nwg * S) return false;
        u.ks = (int)(L % S); int wgid = (int)(L / S); { const int q = nwg / NXCD, r = nwg % NXCD, xcd = wgid % NXCD, off = wgid / NXCD; wgid = (xcd < r ? xcd * (q + 1) : r * (q + 1) + (xcd - r) * q) + off; }
        const int nig = WGM * nN, gid = wgid / nig, fm = gid * WGM, gsz = (nM - fm) < WGM ? (nM - fm) : WGM;
        u.pm = fm + ((wgid % nig) % gsz); u.pn = (wgid % nig) / gsz; u.e = texp ? texp[u.pm] : 0; u.pm += pm0; return true;
    }
    __device__ __forceinline__ void a_ready(const Unit&) const {}
    __device__ __forceinline__ void done(const Unit&) const {}
};

template <class Epi, class Sched, bool ALIGN_EPI = false, bool SP2 = false>
__device__ __forceinline__ void gemm_phase(PG8_LAS unsigned char* lds, const Gemm g, const Sched& S, const Epi& E) {
    const int tid = opq((int)threadIdx.x), wid = __builtin_amdgcn_readfirstlane(tid >> 6), lane = tid & 63, wr = wid >> 2, wc = wid & 3, fr = lane & 15, fq = lane >> 4;
    const int K = g.K, nt = g.Kloop / BK;
    unsigned voffA[2], voffB[2];
#pragma unroll
    for (int i = 0; i < 2; ++i) { int R, C; stage_rc(tid * 16 + i * 8192, R, C); const int Rb = Epi::PERM ? ((R & ~31) + perm32(R & 31)) : R;
        voffA[i] = (unsigned)(R * K + C) * 2u; voffB[i] = (unsigned)(Rb * K + C) * 2u; }
    const size_t kstep = (size_t)(BK * 2);
    const size_t hstep = (size_t)HALF * K * 2;
    const size_t tstep = 2 * hstep;
    const unsigned ldsw = (unsigned)wid * 1024u;
    const int aoff = lds_byte(wr * 64 + fr, fq * 8), boff = lds_byte(wc * 32 + fr, fq * 8);
#define PG8_SA(b, h) (((b) * 2 + (h)) * HTB)
#define PG8_SB(b, h) ((4 + (b) * 2 + (h)) * HTB)
#define PG8_STAGE(bufoff, gbase, voff) do { _Pragma("unroll") for (int _i = 0; _i < 2; ++_i) \
        __builtin_amdgcn_global_load_lds((const unsigned*)((const char*)(gbase) + (voff)[_i]), (PG8_LAS unsigned*)(lds + (bufoff) + ldsw + _i * 8192), 16, 0, 0); } while (0)
#define PG8_LDA(dst, b, h) do { _Pragma("unroll") for (int m = 0; m < 4; ++m) _Pragma("unroll") for (int k = 0; k < 2; ++k) dst[m][k] = *(const PG8_LAS bf16x8*)(lds + PG8_SA(b, h) + aoff + m * 2048 + k * 1024); } while (0)
#define PG8_LDB(dst, b, h) do { _Pragma("unroll") for (int n = 0; n < 2; ++n) _Pragma("unroll") for (int k = 0; k < 2; ++k) dst[n][k] = *(const PG8_LAS bf16x8*)(lds + PG8_SB(b, h) + boff + n * 2048 + k * 1024); } while (0)
#define PG8_MMA(ai, bj, At, Bt) do { __builtin_amdgcn_s_setprio(1); _Pragma("unroll") for (int m = 0; m < 4; ++m) _Pragma("unroll") for (int n = 0; n < 2; ++n) _Pragma("unroll") for (int k = 0; k < 2; ++k) \
        acc[ai][bj][m][n] = __builtin_amdgcn_mfma_f32_16x16x32_bf16(Bt[n][k], At[m][k], acc[ai][bj][m][n], 0, 0, 0); __builtin_amdgcn_s_setprio(0); } while (0)
#define PG8_WAIT_V(n) asm volatile("s_waitcnt vmcnt(" #n ")" ::: "memory")
#define PG8_WAIT_L(n) asm volatile("s_waitcnt lgkmcnt(" #n ")" ::: "memory")
#define PG8_BAR __builtin_amdgcn_s_barrier()
#define PG8_SCHED __builtin_amdgcn_sched_barrier(0)
    Unit cur, nxt; int ui = 0;
    if (!S.next(0, cur)) return;
    f32x4 acc[2][2][4][2];
#pragma unroll
    for (int a = 0; a < 2; ++a)
#pragma unroll
        for (int b = 0; b < 2; ++b)
#pragma unroll
            for (int m = 0; m < 4; ++m)
#pragma unroll
                for (int n = 0; n < 2; ++n) acc[a][b][m][n] = (f32x4){0.f, 0.f, 0.f, 0.f};
    bf16x8 At[4][2], B0[2][2], B1[2][2];
    const char* cA = (const char*)g.A + (size_t)cur.pm * tstep + (size_t)cur.ks * g.Kloop * 2; const char* cB = (const char*)g.Bt + (size_t)cur.e * g.estride + (size_t)cur.pn * tstep + (size_t)cur.ks * g.Kloop * 2;
    S.a_ready(cur);
    if constexpr (SP2) {
        PG8_STAGE(PG8_SB(0, 0), cB, voffB); PG8_STAGE(PG8_SB(0, 1), cB + hstep, voffB); PG8_STAGE(PG8_SA(0, 0), cA, voffA); PG8_STAGE(PG8_SA(0, 1), cA + hstep, voffA);
        if (wr == 1) PG8_BAR;
        PG8_WAIT_V(2); PG8_BAR;
        PG8_STAGE(PG8_SB(1, 0), cB + kstep, voffB); PG8_STAGE(PG8_SA(1, 0), cA + kstep, voffA); PG8_STAGE(PG8_SB(1, 1), cB + hstep + kstep, voffB);
        PG8_WAIT_V(6); PG8_BAR;
    } else {
        PG8_STAGE(PG8_SB(0, 0), cB, voffB); PG8_STAGE(PG8_SA(0, 0), cA, voffA); PG8_STAGE(PG8_SB(0, 1), cB + hstep, voffB); PG8_STAGE(PG8_SA(0, 1), cA + hstep, voffA);
        if (wr == 1) PG8_BAR;
        PG8_WAIT_V(4); PG8_BAR;
        PG8_STAGE(PG8_SB(1, 0), cB + kstep, voffB); PG8_STAGE(PG8_SA(1, 0), cA + kstep, voffA); PG8_STAGE(PG8_SB(1, 1), cB + hstep + kstep, voffB);
        PG8_WAIT_V(6); PG8_BAR;
    }
    for (;;) {
        const bool has_next = S.next(ui + 1, nxt);
        const char* nA = has_next ? (const char*)g.A + (size_t)nxt.pm * tstep + (size_t)nxt.ks * g.Kloop * 2 : cA; const char* nB = has_next ? (const char*)g.Bt + (size_t)nxt.e * g.estride + (size_t)nxt.pn * tstep + (size_t)nxt.ks * g.Kloop * 2 : cB;
        for (int t = 0; t < nt; t += 2) {
            const bool last = (t == nt - 2);
            const char* a1 = cA + (size_t)(t + 1) * kstep;
            const char* a2 = last ? nA : cA + (size_t)(t + 2) * kstep; const char* b2 = last ? nB : cB + (size_t)(t + 2) * kstep;
            const char* a3 = a2 + kstep; const char* b3 = b2 + kstep;
            if (last && has_next) S.a_ready(nxt);
            if constexpr (SP2) {
            PG8_LDB(B0, 0, 0); PG8_LDB(B1, 0, 1); PG8_SCHED; PG8_LDA(At, 0, 0); PG8_STAGE(PG8_SA(1, 1), a1 + hstep, voffA);
            PG8_WAIT_V(8); PG8_WAIT_L(0); PG8_BAR; PG8_MMA(0, 0, At, B0); PG8_MMA(0, 1, At, B1); PG8_BAR; PG8_SCHED;
            PG8_LDA(At, 0, 1); PG8_STAGE(PG8_SB(0, 0), b2, voffB); PG8_STAGE(PG8_SB(0, 1), b2 + hstep, voffB); PG8_STAGE(PG8_SA(0, 0), a2, voffA);
            PG8_WAIT_V(8); PG8_WAIT_L(0); PG8_BAR; PG8_MMA(1, 0, At, B0); PG8_MMA(1, 1, At, B1); PG8_BAR; PG8_SCHED;
            PG8_LDB(B0, 1, 0); PG8_LDB(B1, 1, 1); PG8_SCHED; PG8_LDA(At, 1, 0); PG8_STAGE(PG8_SA(0, 1), a2 + hstep, voffA);
            PG8_WAIT_V(8); PG8_WAIT_L(0); PG8_BAR; PG8_MMA(0, 0, At, B0); PG8_MMA(0, 1, At, B1); PG8_BAR; PG8_SCHED;
            PG8_LDA(At, 1, 1); PG8_STAGE(PG8_SB(1, 0), b3, voffB); PG8_STAGE(PG8_SB(1, 1), b3 + hstep, voffB); PG8_STAGE(PG8_SA(1, 0), a3, voffA);
            PG8_WAIT_V(8); PG8_WAIT_L(0); PG8_BAR; PG8_MMA(1, 0, At, B0); PG8_MMA(1, 1, At, B1); PG8_BAR; PG8_SCHED;
            } else {
            PG8_LDB(B0, 0, 0); PG8_SCHED; PG8_LDA(At, 0, 0); PG8_STAGE(PG8_SA(1, 1), a1 + hstep, voffA);
            PG8_WAIT_L(8); PG8_BAR; PG8_WAIT_L(0); PG8_MMA(0, 0, At, B0); PG8_BAR; PG8_SCHED;
            PG8_LDB(B1, 0, 1); PG8_STAGE(PG8_SB(0, 0), b2, voffB);
            PG8_BAR; PG8_WAIT_L(0); PG8_MMA(0, 1, At, B1); PG8_BAR;
            PG8_LDA(At, 0, 1); PG8_STAGE(PG8_SA(0, 0), a2, voffA);
            PG8_BAR; PG8_WAIT_L(0); PG8_MMA(1, 0, At, B0); PG8_BAR; PG8_SCHED;
            PG8_STAGE(PG8_SB(0, 1), b2 + hstep, voffB);
            PG8_WAIT_V(6); PG8_BAR; PG8_MMA(1, 1, At, B1); PG8_BAR;
            PG8_LDB(B0, 1, 0); PG8_SCHED; PG8_LDA(At, 1, 0); PG8_STAGE(PG8_SA(0, 1), a2 + hstep, voffA);
            PG8_WAIT_L(8); PG8_BAR; PG8_WAIT_L(0); PG8_MMA(0, 0, At, B0); PG8_BAR; PG8_SCHED;
            PG8_LDB(B1, 1, 1); PG8_STAGE(PG8_SB(1, 0), b3, voffB);
            PG8_BAR; PG8_WAIT_L(0); PG8_MMA(0, 1, At, B1); PG8_BAR;
            PG8_LDA(At, 1, 1); PG8_STAGE(PG8_SA(1, 0), a3, voffA);
            PG8_BAR; PG8_WAIT_L(0); PG8_MMA(1, 0, At, B0); PG8_BAR; PG8_SCHED;
            PG8_STAGE(PG8_SB(1, 1), b3 + hstep, voffB);
            PG8_WAIT_V(6); PG8_BAR; PG8_MMA(1, 1, At, B1); PG8_BAR;
            }
        }
        if constexpr (ALIGN_EPI) { if (wr == 0) PG8_BAR; }
        if constexpr (!Epi::AFTER_DRAIN) { E(acc, cur, wr, wc, fr, fq); S.done(cur); }
        if (!has_next) break;
#pragma unroll
        for (int a = 0; a < 2; ++a)
#pragma unroll
            for (int b = 0; b < 2; ++b)
#pragma unroll
                for (int m = 0; m < 4; ++m)
#pragma unroll
                    for (int n = 0; n < 2; ++n) acc[a][b][m][n] = (f32x4){0.f, 0.f, 0.f, 0.f};
        cur = nxt; cA = nA; cB = nB; ++ui;
        if constexpr (ALIGN_EPI) { if (wr == 1) PG8_BAR; }
    }
    PG8_WAIT_V(0);
    if constexpr (!ALIGN_EPI) { if (wr == 0) PG8_BAR; }
    PG8_BAR;
    if constexpr (Epi::AFTER_DRAIN) { E.fused(acc, cur, wr, wc, fr, fq, lds, wid, lane); S.done(cur); }
#undef PG8_SA
#undef PG8_SB
#undef PG8_STAGE
#undef PG8_LDA
#undef PG8_LDB
#undef PG8_MMA
#undef PG8_WAIT_V
#undef PG8_WAIT_L
#undef PG8_BAR
#undef PG8_SCHED
}
}

#define GAS __attribute__((address_space(1)))
#define LAS __attribute__((address_space(3)))
typedef GAS unsigned gu32;
#define RLX_AGENT __ATOMIC_RELAXED, __HIP_MEMORY_SCOPE_AGENT
constexpr int NWAVES = 8;
constexpr int CW_BAR = 4096;
constexpr int RING_BYTES = 131072, LDSCTL_OFF = RING_BYTES, MISC_OFF = LDSCTL_OFF + 320, LDS_BYTES = 147456;
constexpr size_t CTL_ZERO_BYTES = 65536;

#define XB_TMO      128
#define XB_XCNT(j)  (256  + 64 * (j))
#define XB_XSUB(j)  (1280 + 64 * (j))
#define XB_XGEN(j)  (2304 + 64 * (j))
#define XB_TOP      3328
#define XB_TOPGEN   3392
#define XCD_BAR_WORDS 3456
#define XB_SPIN_CAP (1u << 18)

__device__ __forceinline__ unsigned xb_ld(unsigned* p)              { return __hip_atomic_load(p, __ATOMIC_RELAXED, __HIP_MEMORY_SCOPE_AGENT); }
__device__ __forceinline__ unsigned xb_add(unsigned* p, unsigned v) { return __hip_atomic_fetch_add(p, v, __ATOMIC_RELAXED, __HIP_MEMORY_SCOPE_AGENT); }
__device__ __forceinline__ unsigned xb_xcc_id() { return (unsigned)__builtin_amdgcn_s_getreg((3 << 11) | 20) & 0xFu; }
#define XB_SPIN(cond, bar) do { unsigned _sp = 0; while (cond) { __builtin_amdgcn_s_sleep(1); \
    if ((++_sp & 255u) == 0u) { if (xb_ld(&(bar)[XB_TMO])) break; if (_sp > XB_SPIN_CAP) { atomicAdd(&(bar)[XB_TMO], 1u); break; } } } } while (0)

struct XcdBarrier {
    unsigned* bar; unsigned x;
    volatile LAS unsigned* st;
};

__device__ __forceinline__ XcdBarrier xcd_barrier_post(unsigned* bar, volatile LAS unsigned* st) {
    XcdBarrier b; b.bar = bar; b.x = xb_xcc_id(); b.st = st;
    if (threadIdx.x == 0) (void)xb_add(&bar[XB_XCNT(b.x)], 1u);
    return b;
}
__device__ __forceinline__ void xcd_barrier_complete(unsigned* bar, unsigned x, unsigned& nloc, unsigned& nx) {
    const unsigned G = gridDim.x * gridDim.y * gridDim.z;
    unsigned sum, cnt, mine, sp = 0u;
    for (;;) {
        sum = 0u; cnt = 0u; mine = 0u;
#pragma unroll
        for (unsigned j = 0; j < 16; ++j) { const unsigned c = xb_ld(&bar[XB_XCNT(j)]); sum += c; cnt += (c > 0u) ? 1u : 0u; mine = (j == x) ? c : mine; }
        if (sum == G) break;
        __builtin_amdgcn_s_sleep(1);
        if ((++sp & 255u) == 0u) { if (xb_ld(&bar[XB_TMO])) break; if (sp > XB_SPIN_CAP) { atomicAdd(&bar[XB_TMO], 1u); break; } }
    }
    nloc = mine > 0u ? mine : 1u; nx = cnt > 0u ? cnt : 1u;
}

__device__ __forceinline__ void xcd_barrier(const XcdBarrier& b) {
    asm volatile("s_waitcnt vmcnt(0)" ::: "memory");
    __syncthreads();
    if (threadIdx.x == 0) {
        unsigned* bar = b.bar;
        __builtin_amdgcn_s_waitcnt(0);
        unsigned nloc = b.st[0], nx = b.st[1];
        if (nloc == 0u) { xcd_barrier_complete(bar, b.x, nloc, nx); b.st[0] = nloc; b.st[1] = nx; }
        const unsigned old = xb_add(&bar[XB_XSUB(b.x)], 1u);
        const unsigned gen = old / nloc;
        if (old + 1u == (gen + 1u) * nloc) {
            __builtin_amdgcn_fence(__ATOMIC_RELEASE, "agent");
            asm volatile("s_waitcnt vmcnt(0)" ::: "memory");
            const unsigned og = xb_add(&bar[XB_TOP], 1u);
            const unsigned tg = og / nx;
            if (og + 1u == (tg + 1u) * nx) xb_add(&bar[XB_TOPGEN], 1u);
            else XB_SPIN(xb_ld(&bar[XB_TOPGEN]) == tg, bar);
            __builtin_amdgcn_fence(__ATOMIC_ACQUIRE, "agent");
            xb_add(&bar[XB_XGEN(b.x)], 1u);
            asm volatile("s_waitcnt vmcnt(0)" ::: "memory");
        } else {
            XB_SPIN(xb_ld(&bar[XB_XGEN(b.x)]) == gen, bar);
            __builtin_amdgcn_fence(__ATOMIC_ACQUIRE, "agent");
            asm volatile("s_waitcnt vmcnt(0)" ::: "memory");
        }
    }
    __syncthreads();
}


template <class F> struct EpiAdapt {
    static constexpr bool PERM = false, AFTER_DRAIN = false; F f;
    __device__ __forceinline__ void operator()(const pg8::f32x4 (&acc)[2][2][4][2], const pg8::Unit& u, int wr, int wc, int fr, int fq) const {
#pragma unroll
        for (int ai = 0; ai < 2; ++ai)
#pragma unroll
            for (int m = 0; m < 4; ++m) { const int row = u.pm * 256 + ai * 128 + wr * 64 + m * 16 + fr;
#pragma unroll
                for (int bj = 0; bj < 2; ++bj) f(row, u.pn * 8 + bj * 4 + wc, fq, acc[ai][bj][m][0], acc[ai][bj][m][1], u.ks);
                asm volatile("" ::: "memory"); }
    }
};
struct EpiBf16Perm { bf16_t* O; int ldo; int pad;
    __device__ __forceinline__ void operator()(int row, int g, int fq, f32x4 v0, f32x4 v1, int) const {
        u32x4 w; w.x = pk2(v0.x, v0.y); w.y = pk2(v0.z, v0.w); w.z = pk2(v1.x, v1.y); w.w = pk2(v1.z, v1.w);
        *(u32x4*)(O + (size_t)row * ldo + 32 * g + 8 * fq) = w; } };
struct EpiResid { const float* hl_in; const float* hc_in; float* hl_out; float* hc_out; const float* mod; int goff; int split;
    __device__ __forceinline__ void operator()(int row, int g, int fq, f32x4 v0, f32x4 v1, int ks) const {
        const int c0 = 32 * g + 4 * fq; const float* hin; float* hout; const float* gv;
        if (row < TL) { hin = hl_in + (size_t)row * D; hout = hl_out + (size_t)row * D; gv = mod + (row / SEQ) * 6144 + goff; }
        else { hin = hc_in + (size_t)(row - TL) * D; hout = hc_out + (size_t)(row - TL) * D; gv = mod + 2 * 6144 + goff; }
        if (split) { float* po = hout + (size_t)ks * TC * D; *(f32x4*)(po + c0) = *(const f32x4*)(gv + c0) * v0; *(f32x4*)(po + c0 + 16) = *(const f32x4*)(gv + c0 + 16) * v1; return; }
        *(f32x4*)(hout + c0) = *(const f32x4*)(hin + c0) + *(const f32x4*)(gv + c0) * v0;
        *(f32x4*)(hout + c0 + 16) = *(const f32x4*)(hin + c0 + 16) + *(const f32x4*)(gv + c0 + 16) * v1; } };
struct EpiSwiglu { bf16_t* H; int ldh; int pad;
    __device__ __forceinline__ void operator()(int row, int g, int fq, f32x4 v0, f32x4 v1, int) const {
        u32x2 w; w.x = pk2(silu_fast(v0.x) * v1.x, silu_fast(v0.y) * v1.y); w.y = pk2(silu_fast(v0.z) * v1.z, silu_fast(v0.w) * v1.w);
        *(u32x2*)(H + (size_t)row * ldh + 16 * g + 4 * fq) = w; } };

template <class F> __device__ __forceinline__ void run_gemm(LAS unsigned char* lds, const bf16_t* A, const bf16_t* Bt, int K, int nM, int nN, const int* texp, size_t estride_bytes, const F& f, int slices = 1, int pm0 = 0) {
    pg8::Gemm g{A, Bt, K, estride_bytes, K / slices}; pg8::StaticOrder S; S.init(nM, nN, opqs((int)gridDim.x), opqs((int)blockIdx.x), texp, slices, pm0);
    EpiAdapt<F> E{f};
    pg8::gemm_phase<EpiAdapt<F>, pg8::StaticOrder, true, true>(lds, g, S, E);
}
__device__ __forceinline__ bool gemm_tail_idle(int nwg) { const int G = opqs((int)gridDim.x), r = nwg % G; return r != 0 && opqs((int)blockIdx.x) >= r; }

__device__ __forceinline__ float conv_src(const Params& p, int mode, const float* W0, const float* W1, int N, int nvalid, int k, int nb) {
    if (mode == 0) return W0[(size_t)k * N + nb];
    if (mode == 1) { const int col = (nb & ~31) + 8 * ((nb >> 2) & 3) + 4 * ((nb >> 4) & 1) + (nb & 3); return col < nvalid ? W0[(size_t)k * N + col] : 0.f; }
    const int col = 16 * (nb >> 5) + (nb & 15); return ((nb >> 4) & 1) ? W1[(size_t)k * N + col] : W0[(size_t)k * N + col];
}
constexpr int CT_WIN = 0, CT_WOUT = 2304, CT_WUQ = 3328, CT_WUKV = 3400, CT_WFGU = 3464, CT_WFDN = 6280, CT_WMGU = 7688, CT_WMDN = 36360, CT_END = 50696;
constexpr int IT_MODS = 192, IT_ROPE = 9;
__device__ __forceinline__ void conv_item(const Params& p, int it, float* scr, int lane) {
    int t = it;
    bf16_t* dst; const float* W0; const float* W1 = nullptr; int K, N, nvalid = 0, mode;
    if (t < CT_WOUT) { const int l = t / 1152; t %= 1152; dst = (bf16_t*)(p.ws + WS_WIN) + (size_t)l * NINP * D; W0 = p.in[8] + (size_t)l * D * NIN; K = D; N = NIN; nvalid = NIN; mode = 1; }
    else if (t < CT_WUQ) { t -= CT_WOUT; const int l = t / 512; t %= 512; dst = (bf16_t*)(p.ws + WS_WOUT) + (size_t)l * D * D; W0 = p.in[24] + (size_t)l * D * D; K = D; N = D; mode = 0; }
    else if (t < CT_WUKV) { t -= CT_WUQ; const int l = t / 36; t %= 36; dst = (bf16_t*)(p.ws + WS_WUQ) + (size_t)l * 384 * 192; W0 = p.in[18] + (size_t)l * 192 * 384; K = 192; N = 384; mode = 0; }
    else if (t < CT_WFGU) { t -= CT_WUKV; const int l = t / 32; t %= 32; dst = (bf16_t*)(p.ws + WS_WUKV) + (size_t)l * 512 * 128; W0 = p.in[20] + (size_t)l * 128 * 512; K = 128; N = 512; mode = 0; }
    else if (t < CT_WFDN) { t -= CT_WFGU; dst = (bf16_t*)(p.ws + WS_WFGU); W0 = p.in[25]; W1 = p.in[26]; K = D; N = DFF; mode = 2; }
    else if (t < CT_WMGU) { t -= CT_WFDN; dst = (bf16_t*)(p.ws + WS_WFDN); W0 = p.in[27]; K = DFF; N = D; mode = 0; }
    else if (t < CT_WMDN) { t -= CT_WMGU; const int e = t / 3584; t %= 3584; dst = (bf16_t*)(p.ws + WS_WMGU) + (size_t)e * 2 * DFFE * D; W0 = p.in[29] + (size_t)e * D * DFFE; W1 = p.in[30] + (size_t)e * D * DFFE; K = D; N = DFFE; mode = 2; }
    else { t -= CT_WMDN; const int e = t / 1792; t %= 1792; dst = (bf16_t*)(p.ws + WS_WMDN) + (size_t)e * D * DFFE; W0 = p.in[31] + (size_t)e * DFFE * D; K = DFFE; N = D; nvalid = D; mode = 1; }
    const int ktl = K / 64, n0 = (t / ktl) * 32, k0 = (t % ktl) * 64;
    const int n4 = lane & 7; const float* src; bool valid = true; int ln;
    if (mode == 0) { src = W0 + n0 + 4 * n4; ln = 4 * n4; }
    else if (mode == 1) { const int col = n0 + 4 * n4; valid = col < nvalid; src = W0 + (valid ? col : 0); ln = 16 * (n4 & 1) + 4 * (n4 >> 1); }
    else { src = ((n4 >> 2) ? W1 : W0) + 16 * (n0 >> 5) + 4 * (n4 & 3); ln = 16 * (n4 >> 2) + 4 * (n4 & 3); }
    src += (size_t)(k0 + (lane >> 3)) * N;
    f32x4 v[8];
#pragma unroll
    for (int i = 0; i < 8; ++i) v[i] = valid ? *(const f32x4*)(src + (size_t)(8 * i) * N) : (f32x4){0.f, 0.f, 0.f, 0.f};
#pragma unroll
    for (int i = 0; i < 8; ++i) *(f32x4*)(scr + ((lane >> 3) + 8 * i) * 36 + ln) = v[i];
    const int c = lane & 7;
#pragma unroll
    for (int j = 0; j < 4; ++j) { const int n = (lane >> 3) + 8 * j; const float* sp = scr + (8 * c) * 36 + n;
        u32x4 o; o.x = pk2(sp[0 * 36], sp[1 * 36]); o.y = pk2(sp[2 * 36], sp[3 * 36]); o.z = pk2(sp[4 * 36], sp[5 * 36]); o.w = pk2(sp[6 * 36], sp[7 * 36]);
        *(u32x4*)(dst + (size_t)(n0 + n) * K + k0 + 8 * c) = o; }
}
constexpr int CW_FILL = 1024;
__device__ __forceinline__ void fill_moe(const Params& p, float* lds, int quota) {
    const int tid = opq((int)threadIdx.x), lane = tid & 63, wv = tid >> 6;
    float* scr = lds + wv * (64 * 36); volatile int* slot = (volatile int*)(lds + 8 * 64 * 36);
    constexpr int NIT = CT_END - CT_WMGU;
    for (;;) {
        const int claim = quota > 64 ? 4 : quota;
        __syncthreads();
        if (tid == 0) *slot = (int)atomicAdd((unsigned*)(p.ws + WS_CTL) + CW_FILL, 8u * (unsigned)claim);
        __syncthreads();
        const int idx = *slot;
        if (idx >= NIT) break;
        const int end = min(idx + 8 * claim, NIT);
        for (int it = idx + wv; it < end; it += 8) conv_item(p, CT_WMGU + it, scr, lane);
        if (quota <= 64) break;
    }
    __syncthreads();
}
__device__ __forceinline__ void ph_prologue(const Params& p, float* lds) {
    const int tid = opq((int)threadIdx.x), lane = tid & 63, wv = tid >> 6;
    for (int it = blockIdx.x; it < IT_MODS + IT_ROPE; it += gridDim.x) {
        if (it < IT_MODS) {
            const int l = it / 96, n0 = (it % 96) * 64, nn = tid & 63, kc = tid >> 6;
            float* sv = lds; float* red = lds + 3 * 1024;
            __syncthreads();
            for (int i = tid; i < 3 * 1024; i += 512) { const int v = i >> 10, k = i & 1023; const float x = (v < 2) ? p.in[1][v * D + k] : p.in[3][k]; sv[i] = silu_f(x); }
            __syncthreads();
            const float* w = p.in[4] + ((size_t)l * D + kc * 128) * 6144 + n0 + nn;
            float a0 = 0.f, a1 = 0.f, a2 = 0.f;
#pragma unroll 8
            for (int k = 0; k < 128; ++k) { const float wv_ = w[(size_t)k * 6144]; a0 += sv[kc * 128 + k] * wv_; a1 += sv[1024 + kc * 128 + k] * wv_; a2 += sv[2048 + kc * 128 + k] * wv_; }
            red[(kc * 3 + 0) * 64 + nn] = a0; red[(kc * 3 + 1) * 64 + nn] = a1; red[(kc * 3 + 2) * 64 + nn] = a2;
            __syncthreads();
            if (tid < 192) { const int v = tid >> 6; float s = p.in[5][l * 6144 + n0 + nn];
#pragma unroll
                for (int q = 0; q < 8; ++q) s += red[(q * 3 + v) * 64 + nn];
                ((float*)(p.ws + WS_MOD))[((size_t)l * 3 + v) * 6144 + n0 + nn] = s; }
        } else {
            const int idx = (it - IT_MODS) * 512 + tid;
            if (idx < RT_N) {
                int pos, i, nf;
                if (idx < RT_C64) { pos = idx / 16; i = idx % 16; nf = 16; }
                else if (idx < RT_R32) { pos = (idx - RT_C64) / 16; i = idx % 16; nf = 16; }
                else if (idx < RT_C32) { pos = (idx - RT_R32) / 8; i = idx % 8; nf = 8; }
                else { pos = (idx - RT_C32) / 8; i = idx % 8; nf = 8; }
                const float inv = powf(10000.0f, -(float)i / (float)nf);
                const float ang = (float)pos * inv;
                const float rev = ang * 0.15915494309189535f;
                ((float2*)(p.ws + WS_ROPE))[idx] = make_float2(__builtin_amdgcn_cosf(rev), __builtin_amdgcn_sinf(rev));
            }
        }
    }
    __syncthreads();
    for (int i = blockIdx.x * 512 + tid; i < TC * D / 4; i += gridDim.x * 512) ((f32x4*)(p.ws + WS_HCTX))[i] = ((const f32x4*)p.in[2])[i];
    float* scr = lds + wv * (64 * 36);
    for (int it = wv * gridDim.x + blockIdx.x; it < CT_WMGU; it += 8 * gridDim.x) conv_item(p, it, scr, lane);
    __syncthreads();
}

template <int WHICH, bool ROUTER> __device__ __forceinline__ void ph_norm(const Params& p, int layer, int nrows, unsigned* lcnt, int nslab) {
    const int tx = opq((int)threadIdx.x), lane = tx & 63, gw = (blockIdx.x * 512 + tx) >> 6, ngw = (gridDim.x * 512) >> 6;
    if (ROUTER) { if (tx < 16) lcnt[tx] = 0u; __syncthreads(); }
    const float* hl = (layer == 0 && WHICH == 1) ? p.in[0] : p.out;
    const float* hc = (layer == 0 && WHICH == 1) ? p.in[2] : (const float*)(p.ws + WS_HCTX);
    const float* gain = p.in[WHICH == 1 ? 6 : 7] + layer * D;
    const float* mod = (const float*)(p.ws + WS_MOD) + (size_t)layer * 3 * 6144;
    bf16_t* dst = (bf16_t*)(p.ws + WS_ACT1);
    for (int m = gw; m < nrows; m += ngw) {
        const float* src = (m < TL) ? hl + (size_t)m * D : hc + (size_t)(m - TL) * D;
        const float* mv = mod + (m < TL ? m / SEQ : 2) * 6144;
        const float* shp = mv + (WHICH == 1 ? 0 : 3) * D; const float* scp = mv + (WHICH == 1 ? 1 : 4) * D;
        f32x4 v[4]; float ss = 0.f;
#pragma unroll
        for (int j = 0; j < 4; ++j) v[j] = *(const f32x4*)(src + 256 * j + 4 * lane);
        if (!ROUTER && m >= TL && nslab > 0) {
            const float* pp = (const float*)(p.ws + WS_PART) + (size_t)(m - TL) * D + 4 * lane;
            for (int sl = 0; sl < nslab; ++sl) {
#pragma unroll
                for (int j = 0; j < 4; ++j) v[j] = v[j] + *(const f32x4*)(pp + (size_t)sl * TC * D + 256 * j); }
#pragma unroll
            for (int j = 0; j < 4; ++j) *(f32x4*)((float*)(p.ws + WS_HCTX) + (size_t)(m - TL) * D + 256 * j + 4 * lane) = v[j];
        }
#pragma unroll
        for (int j = 0; j < 4; ++j) ss += v[j].x * v[j].x + v[j].y * v[j].y + v[j].z * v[j].z + v[j].w * v[j].w;
        const float rstd = rsqrtf(wave_sum(ss) * (1.f / D) + EPS);
        float lg[8];
#pragma unroll
        for (int e = 0; e < 8; ++e) lg[e] = 0.f;
#pragma unroll
        for (int j = 0; j < 4; ++j) {
            const int c = 256 * j + 4 * lane;
            const f32x4 g = *(const f32x4*)(gain + c), sh = *(const f32x4*)(shp + c), sc = *(const f32x4*)(scp + c);
            f32x4 f = v[j] * rstd * g * (sc + 1.f) + sh;
            u32x2 w; w.x = pk2(f.x, f.y); w.y = pk2(f.z, f.w);
            *(u32x2*)(dst + (size_t)m * D + c) = w;
            if (ROUTER) {
                const float* rt = p.in[28] + (size_t)c * 8;
#pragma unroll
                for (int i = 0; i < 4; ++i) { const f32x4 r0 = *(const f32x4*)(rt + 8 * i), r1 = *(const f32x4*)(rt + 8 * i + 4); const float fv = f[i];
                    lg[0] += fv * r0.x; lg[1] += fv * r0.y; lg[2] += fv * r0.z; lg[3] += fv * r0.w; lg[4] += fv * r1.x; lg[5] += fv * r1.y; lg[6] += fv * r1.z; lg[7] += fv * r1.w; }
            }
        }
        if (ROUTER) {
#pragma unroll
            for (int e = 0; e < 8; ++e) lg[e] = wave_sum(lg[e]);
            if (lane == 0) {
                int e0 = 0; float v0 = lg[0];
#pragma unroll
                for (int e = 1; e < 8; ++e) if (lg[e] > v0) { v0 = lg[e]; e0 = e; }
                int e1 = -1; float v1 = -INFINITY;
#pragma unroll
                for (int e = 0; e < 8; ++e) if (e != e0 && lg[e] > v1) { v1 = lg[e]; e1 = e; }
                const float t = expf(v1 - v0), g0 = 1.f / (1.f + t), g1 = t / (1.f + t);
                const int p0 = (int)atomicAdd(&lcnt[e0], 1u), p1 = (int)atomicAdd(&lcnt[e1], 1u);
                ((int2*)(p.ws + WS_TOKE))[m] = make_int2(e0, e1); ((int2*)(p.ws + WS_TOKP))[m] = make_int2(p0, p1); ((float2*)(p.ws + WS_TOKG))[m] = make_float2(g0, g1);
            }
        }
    }
    if (ROUTER) {
        __syncthreads();
        if (tx < 8) lcnt[8 + tx] = atomicAdd((unsigned*)(p.ws + WS_CTL) + 64 * tx, lcnt[tx]);
        __syncthreads();
        if (lane == 0) for (int m = gw; m < nrows; m += ngw) {
            const int2 e = ((const int2*)(p.ws + WS_TOKE))[m]; int2 ps = ((const int2*)(p.ws + WS_TOKP))[m];
            ps.x += (int)lcnt[8 + e.x]; ps.y += (int)lcnt[8 + e.y]; ((int2*)(p.ws + WS_TOKP))[m] = ps; }
        __syncthreads();
    }
}


typedef short pp_bf16x8 __attribute__((ext_vector_type(8)));
__device__ __forceinline__ float quad_sum(float v) { v += swz_xor<1>(v); v += swz_xor<2>(v); return v; }
__device__ __forceinline__ float kg_sum(float v) { v += swz_xor<16>(v); return half_sum(v); }
constexpr float QS64 = 0.125f * 1.4426950408889634f, QS96 = 0.10206207261596575f * 1.4426950408889634f;

template <int HS> __device__ __forceinline__ void pp_head(const Params& p, const QKVB& qb, int layer, const bf16_t* prow, bool lat, int b, int s, int key, int sub,
                                                          const float2 (&rr)[4], const float2 (&rc)[4]) {
    constexpr bool ISV = HS >= 20;
    constexpr int col = HS < 4 ? OFF_AQ + 64 * HS : HS < 6 ? OFF_AK + 64 * (HS - 4) : HS < 10 ? OFF_BQ + 64 * (HS - 6) : HS < 12 ? OFF_BK + 64 * (HS - 10) : HS < 16 ? OFF_CQ + 64 * (HS - 12) :
                        HS < 20 ? OFF_CK + 64 * (HS - 16) : HS < 22 ? OFF_AV + 64 * (HS - 20) : HS < 24 ? OFF_BV + 64 * (HS - 22) : OFF_CV + 64 * (HS - 24);
    constexpr bool ISQ = HS < 4 || (HS >= 6 && HS < 10) || (HS >= 12 && HS < 16);
    constexpr bool ROPE = HS < 12;
    constexpr int GIN = HS < 4 ? 9 : HS < 6 ? 10 : HS < 10 ? 12 : HS < 12 ? 13 : HS < 16 ? 14 : 15;
    bf16_t* dst;
    if (HS < 4) dst = lat ? qb.QA + ((size_t)(b * 4 + HS) * SEQ + s) * 64 : qb.QAc + ((size_t)(b * 4 + HS) * CTX + s) * 64;
    else if (HS < 6) dst = qb.KA + ((size_t)(b * 2 + HS - 4) * KEYS + key) * 64;
    else if (HS < 10) dst = lat ? qb.QB + ((size_t)(b * 4 + HS - 6) * SEQ + s) * 64 : qb.QBc + ((size_t)(b * 4 + HS - 6) * CTX + s) * 64;
    else if (HS < 12) dst = qb.KB + ((size_t)(b * 2 + HS - 10) * KEYS + key) * 64;
    else if (HS < 16) dst = lat ? qb.QC + ((size_t)(b * 4 + HS - 12) * SEQ + s) * 64 : qb.QCc + ((size_t)(b * 4 + HS - 12) * CTX + s) * 64;
    else if (HS < 20) dst = qb.KC + ((size_t)(b * 4 + HS - 16) * KEYS + key) * 64;
    else if (HS < 22) dst = qb.VA + ((size_t)(b * 2 + HS - 20) * KEYS + key) * 64;
    else if (HS < 24) dst = qb.VB + ((size_t)(b * 2 + HS - 22) * KEYS + key) * 64;
    else dst = qb.VC + ((size_t)(b * 4 + HS - 24) * KEYS + key) * 64;
    u32x2 w[4];
#pragma unroll
    for (int c = 0; c < 4; ++c) w[c] = *(const u32x2*)(prow + col + 16 * c + 4 * sub);
    if (!ISV) {
        f32x4 x[4]; float ss = 0.f;
#pragma unroll
        for (int c = 0; c < 4; ++c) { x[c] = (f32x4){bflo(w[c].x), bfhi(w[c].x), bflo(w[c].y), bfhi(w[c].y)}; ss += x[c].x * x[c].x + x[c].y * x[c].y + x[c].z * x[c].z + x[c].w * x[c].w; }
        const float r = rsqrtf(quad_sum(ss) * (1.f / 64.f) + EPS) * (ISQ ? QS64 : 1.f);
        const float* g = p.in[GIN] + layer * 64 + 4 * sub;
#pragma unroll
        for (int c = 0; c < 4; ++c) x[c] = x[c] * r * *(const f32x4*)(g + 16 * c);
        if (ROPE && lat) {
#pragma unroll
            for (int i = 0; i < 4; ++i) { const float a = x[0][i], bq = x[1][i]; x[0][i] = a * rr[i].x - bq * rr[i].y; x[1][i] = bq * rr[i].x + a * rr[i].y;
                const float c1 = x[2][i], c2 = x[3][i]; x[2][i] = c1 * rc[i].x - c2 * rc[i].y; x[3][i] = c2 * rc[i].x + c1 * rc[i].y; }
        }
#pragma unroll
        for (int c = 0; c < 4; ++c) { w[c].x = pk2(x[c].x, x[c].y); w[c].y = pk2(x[c].z, x[c].w); }
    }
#pragma unroll
    for (int c = 0; c < 4; ++c) *(u32x2*)(dst + 16 * c + 4 * sub) = w[c];
}
template <int HS> struct PPHeads { static __device__ __forceinline__ void run(const Params& p, const QKVB& qb, int layer, const bf16_t* prow, bool lat, int b, int s, int key, int sub, const float2 (&rr)[4], const float2 (&rc)[4]) {
    pp_head<HS>(p, qb, layer, prow, lat, b, s, key, sub, rr, rc); PPHeads<HS + 1>::run(p, qb, layer, prow, lat, b, s, key, sub, rr, rc); } };
template <> struct PPHeads<28> { static __device__ __forceinline__ void run(const Params&, const QKVB&, int, const bf16_t*, bool, int, int, int, int, const float2 (&)[4], const float2 (&)[4]) {} };

__device__ __forceinline__ void f8_from_bf(const u32x4 v, float (&x)[8]) { x[0] = bflo(v.x); x[1] = bfhi(v.x); x[2] = bflo(v.y); x[3] = bfhi(v.y); x[4] = bflo(v.z); x[5] = bfhi(v.z); x[6] = bflo(v.w); x[7] = bfhi(v.w); }

__device__ __forceinline__ void ph_postproj2(const Params& p, int layer) {
    const int tx = opq((int)threadIdx.x), lane = tx & 63, gw = (tx >> 6) * gridDim.x + blockIdx.x, ngw = gridDim.x * 8;
    const bf16_t* P = (const bf16_t*)(p.ws + WS_P);
    const QKVB qb = make_qkv(p.ws);
    const bf16_t* Wuq = (const bf16_t*)(p.ws + WS_WUQ) + (size_t)layer * 384 * 192;
    const bf16_t* Wukv = (const bf16_t*)(p.ws + WS_WUKV) + (size_t)layer * 512 * 128;
    const float2* rope = (const float2*)(p.ws + WS_ROPE);
    for (int su = gw; su < 5 * (MALL / 16); su += ngw) {
        const int kind = __builtin_amdgcn_readfirstlane(su / (MALL / 16)), u = su - kind * (MALL / 16);
        const int m0 = u * 16; const bool lat = m0 < TL;
        if (kind == 0) {
            const int t = lane >> 2, sub = lane & 3, m = m0 + t;
            const int b = lat ? m / SEQ : (m - TL) / CTX, s = lat ? m % SEQ : (m - TL) % CTX, key = lat ? CTX + s : s;
            float2 rr[4], rc[4];
#pragma unroll
            for (int i = 0; i < 4; ++i) { rr[i] = lat ? rope[RT_R64 + (s >> 6) * 16 + 4 * sub + i] : make_float2(1.f, 0.f); rc[i] = lat ? rope[RT_C64 + (s & 63) * 16 + 4 * sub + i] : make_float2(1.f, 0.f); }
            PPHeads<0>::run(p, qb, layer, P + (size_t)m * NINP, lat, b, s, key, sub, rr, rc);
        }
        else {
            const int tk = lane & 15, kg = lane >> 4, m = m0 + tk;
            const int b = lat ? m / SEQ : (m - TL) / CTX, s = lat ? m % SEQ : (m - TL) % CTX, key = lat ? CTX + s : s;
            const bf16_t* prow = P + (size_t)m * NINP;
            if (kind <= 2) {
            pp_bf16x8 aq[6];
            { float x[6][8]; float ss = 0.f;
#pragma unroll
                for (int ks = 0; ks < 6; ++ks) { f8_from_bf(*(const u32x4*)(prow + OFF_DCQ + 32 * ks + 8 * kg), x[ks]);
#pragma unroll
                    for (int j = 0; j < 8; ++j) ss += x[ks][j] * x[ks][j]; }
                const float r = rsqrtf(kg_sum(ss) * (1.f / 192.f) + EPS);
                const float* g = p.in[17] + layer * 192 + 8 * kg;
#pragma unroll
                for (int ks = 0; ks < 6; ++ks) { const f32x4 g0 = *(const f32x4*)(g + 32 * ks), g1 = *(const f32x4*)(g + 32 * ks + 4);
                    u32x4 w; w.x = pk2(x[ks][0] * r * g0.x, x[ks][1] * r * g0.y); w.y = pk2(x[ks][2] * r * g0.z, x[ks][3] * r * g0.w); w.z = pk2(x[ks][4] * r * g1.x, x[ks][5] * r * g1.y); w.w = pk2(x[ks][6] * r * g1.z, x[ks][7] * r * g1.w);
                    aq[ks] = __builtin_bit_cast(pp_bf16x8, w); } }
            float2 qr_[4], qc_[4];
#pragma unroll
            for (int reg = 0; reg < 4; ++reg) { const int i = (4 * kg + reg) & 7; qr_[reg] = lat ? rope[RT_R32 + (s >> 6) * 8 + i] : make_float2(1.f, 0.f); qc_[reg] = lat ? rope[RT_C32 + (s & 63) * 8 + i] : make_float2(1.f, 0.f); }
#pragma unroll 1
            for (int h = 2 * (kind - 1); h < 2 * kind; ++h) {
                f32x4 acc[6];
#pragma unroll
                for (int nb = 0; nb < 6; ++nb) { acc[nb] = (f32x4){0.f, 0.f, 0.f, 0.f};
                    const bf16_t* wp = Wuq + (size_t)(96 * h + 16 * nb + tk) * 192 + 8 * kg;
#pragma unroll
                    for (int ks = 0; ks < 6; ++ks) acc[nb] = __builtin_amdgcn_mfma_f32_16x16x32_bf16(*(const pp_bf16x8*)(wp + 32 * ks), aq[ks], acc[nb], 0, 0, 0); }
                float ss = 0.f;
#pragma unroll
                for (int nb = 0; nb < 6; ++nb) ss += acc[nb].x * acc[nb].x + acc[nb].y * acc[nb].y + acc[nb].z * acc[nb].z + acc[nb].w * acc[nb].w;
                const float r = rsqrtf(kg_sum(ss) * (1.f / 96.f) + EPS) * QS96;
                const float* g = p.in[21] + layer * 96 + 4 * kg;
                bf16_t* dst = (lat ? qb.QD + ((size_t)(b * 4 + h) * SEQ + s) * 96 : qb.QDc + ((size_t)(b * 4 + h) * CTX + s) * 96) + 4 * kg;
#pragma unroll
                for (int nb = 0; nb < 6; ++nb) { f32x4 y = acc[nb] * r * *(const f32x4*)(g + 16 * nb);
                    if (nb >= 4 && lat) {
#pragma unroll
                        for (int reg = 0; reg < 4; ++reg) { const float other = half_other(y[reg], lane); const float2 cs = nb == 4 ? qr_[reg] : qc_[reg];
                            y[reg] = (kg < 2) ? y[reg] * cs.x - other * cs.y : y[reg] * cs.x + other * cs.y; } }
                    u32x2 w; w.x = pk2(y.x, y.y); w.y = pk2(y.z, y.w); *(u32x2*)(dst + 16 * nb) = w; }
            }
            } else {
            pp_bf16x8 akv[4];
            { float x[4][8]; float ss = 0.f;
#pragma unroll
                for (int ks = 0; ks < 4; ++ks) { f8_from_bf(*(const u32x4*)(prow + OFF_DCKV + 32 * ks + 8 * kg), x[ks]);
#pragma unroll
                    for (int j = 0; j < 8; ++j) ss += x[ks][j] * x[ks][j]; }
                const float r = rsqrtf(kg_sum(ss) * (1.f / 128.f) + EPS);
                const float* g = p.in[19] + layer * 128 + 8 * kg;
#pragma unroll
                for (int ks = 0; ks < 4; ++ks) { const f32x4 g0 = *(const f32x4*)(g + 32 * ks), g1 = *(const f32x4*)(g + 32 * ks + 4);
                    u32x4 w; w.x = pk2(x[ks][0] * r * g0.x, x[ks][1] * r * g0.y); w.y = pk2(x[ks][2] * r * g0.z, x[ks][3] * r * g0.w); w.z = pk2(x[ks][4] * r * g1.x, x[ks][5] * r * g1.y); w.w = pk2(x[ks][6] * r * g1.z, x[ks][7] * r * g1.w);
                    akv[ks] = __builtin_bit_cast(pp_bf16x8, w); } }
            float kr[8]; f8_from_bf(*(const u32x4*)(prow + OFF_DKR + 8 * kg), kr);
            float krss = 0.f;
#pragma unroll
            for (int j = 0; j < 8; ++j) krss += kr[j] * kr[j];
            float2 kcs[8];
#pragma unroll
            for (int j = 0; j < 8; ++j) kcs[j] = !lat ? make_float2(1.f, 0.f) : (kg < 2 ? rope[RT_R32 + (s >> 6) * 8 + j] : rope[RT_C32 + (s & 63) * 8 + j]);
#pragma unroll 1
            for (int h = 2 * (kind - 3); h < 2 * (kind - 2); ++h) {
                f32x4 acc[8];
#pragma unroll
                for (int nb = 0; nb < 8; ++nb) { acc[nb] = (f32x4){0.f, 0.f, 0.f, 0.f};
                    const bf16_t* wp = Wukv + (size_t)(128 * h + 16 * nb + tk) * 128 + 8 * kg;
#pragma unroll
                    for (int ks = 0; ks < 4; ++ks) acc[nb] = __builtin_amdgcn_mfma_f32_16x16x32_bf16(*(const pp_bf16x8*)(wp + 32 * ks), akv[ks], acc[nb], 0, 0, 0); }
                float ss = krss;
#pragma unroll
                for (int nb = 0; nb < 4; ++nb) ss += acc[nb].x * acc[nb].x + acc[nb].y * acc[nb].y + acc[nb].z * acc[nb].z + acc[nb].w * acc[nb].w;
                const float r = rsqrtf(kg_sum(ss) * (1.f / 96.f) + EPS);
                const float* g = p.in[22] + layer * 96;
                bf16_t* kd = qb.KD + ((size_t)(b * 4 + h) * KEYS + key) * 96; bf16_t* vd = qb.VD + ((size_t)(b * 4 + h) * KEYS + key) * 64;
#pragma unroll
                for (int nb = 0; nb < 4; ++nb) { const f32x4 y = acc[nb] * r * *(const f32x4*)(g + 16 * nb + 4 * kg); u32x2 w; w.x = pk2(y.x, y.y); w.y = pk2(y.z, y.w); *(u32x2*)(kd + 16 * nb + 4 * kg) = w; }
                { float y[8];
#pragma unroll
                    for (int j = 0; j < 8; ++j) y[j] = kr[j] * r * g[64 + 8 * kg + j];
#pragma unroll
                    for (int j = 0; j < 8; ++j) { const float other = swz_xor<16>(y[j]); y[j] = (kg & 1) == 0 ? y[j] * kcs[j].x - other * kcs[j].y : y[j] * kcs[j].x + other * kcs[j].y; }
                    u32x4 w; w.x = pk2(y[0], y[1]); w.y = pk2(y[2], y[3]); w.z = pk2(y[4], y[5]); w.w = pk2(y[6], y[7]); *(u32x4*)(kd + 64 + 8 * kg) = w; }
#pragma unroll
                for (int nb = 4; nb < 8; ++nb) { const f32x4 y = acc[nb]; u32x2 w; w.x = pk2(y.x, y.y); w.y = pk2(y.z, y.w); *(u32x2*)(vd + 16 * (nb - 4) + 4 * kg) = w; }
            }
            }
        }
    }
}

namespace fa {
typedef short bf16x8 __attribute__((ext_vector_type(8)));
typedef short s16x4 __attribute__((ext_vector_type(4)));
typedef float f32x16 __attribute__((ext_vector_type(16)));
typedef __attribute__((address_space(3))) const char* lds_cptr;
typedef short v4i16_t __attribute__((ext_vector_type(4)));
constexpr int KSTG = 12288, VSTG = 8192, STG = KSTG + VSTG;
constexpr int LDS_WS = 2 * STG, LDS_OST = LDS_WS + 8 * 256, LDS_RPB = LDS_OST + 8 * 4096, LDS_TOTAL = LDS_RPB + 2048;
constexpr float LOG2E = 1.4426950408889634f;
constexpr float THR = 6.0f;
__device__ __forceinline__ int crow(int r, int hi) { return (r & 3) + 8 * (r >> 2) + 4 * hi; }
__device__ __forceinline__ void glds16(const void* gsrc, unsigned lds_dst) { unsigned keep;
    asm volatile("s_mov_b32 %0, m0\n\ts_mov_b32 m0, %2\n\ts_nop 0\n\tglobal_load_lds_dwordx4 %1, off\n\ts_mov_b32 m0, %0" : "=&s"(keep) : "v"(gsrc), "s"(lds_dst) : "memory"); }
__device__ __forceinline__ s16x4 vtr(lds_cptr p) { return __builtin_bit_cast(s16x4, __builtin_amdgcn_ds_read_tr16_b64_v4i16((__attribute__((address_space(3))) v4i16_t*)p)); }
typedef float f32x2_t __attribute__((ext_vector_type(2))); typedef __bf16 bf16x2_t __attribute__((ext_vector_type(2)));
__device__ __forceinline__ unsigned cvtpk(float lo, float hi) { f32x2_t v = {lo, hi}; bf16x2_t b = __builtin_convertvector(v, bf16x2_t); return __builtin_bit_cast(unsigned, b); }
__device__ __forceinline__ float xhalf_max(float m) { auto rr = __builtin_amdgcn_permlane32_swap(__float_as_uint(m), __float_as_uint(m), false, false); return fmaxf(__uint_as_float(rr[0]), __uint_as_float(rr[1])); }
__device__ __forceinline__ float xhalf_sum(float m) { auto rr = __builtin_amdgcn_permlane32_swap(__float_as_uint(m), __float_as_uint(m), false, false); return __uint_as_float(rr[0]) + __uint_as_float(rr[1]); }
#define FA_WAIT_BAR() asm volatile("s_waitcnt vmcnt(0) lgkmcnt(0)\n\ts_barrier" ::: "memory")

template <int DQK, int MODE>
__device__ __forceinline__ void attn_unit(const bf16_t* Qg, const bf16_t* Kg, const bf16_t* Vg, bf16_t* Og, int q0, float sink2, const float* rpb, char* shm) {
    const int tid = opq((int)threadIdx.x), lane = tid & 63, r32 = lane & 31, hi = lane >> 5; const int wid = __builtin_amdgcn_readfirstlane(tid >> 6);
    const unsigned lds0 = (unsigned)(uintptr_t)shm;
    float* wsf = (float*)(shm + LDS_WS) + wid * 64;
    constexpr int NCH = DQK / 8, ND0 = DQK / 16;
    int NT, wbase = 0;
    if (MODE == 0) NT = KEYS / 64; else if (MODE == 3) NT = 4;
    else if (MODE == 1) { wbase = max(0, q0 - 128); const int we = min(SEQ, q0 + 256 + 128); NT = 4 + (we - wbase) / 64; }
    else { const int r0 = q0 >> 6; wbase = min(max(r0 - 4, 0), 120); const int kre = min(max(r0 - 1, 0), 120) + 8; NT = 4 + (kre - wbase); }
#define FA_KEY0(t) ((MODE == 0 || MODE == 3 || (t) < 4) ? 64 * (t) : (MODE == 1 ? CTX + wbase + 64 * ((t) - 4) : CTX + (wbase + (t) - 4) * 64))
    const bf16_t* ksrc = Kg + (size_t)lane * DQK; const bf16_t* vsrc = Vg + (size_t)(16 * (wid & 3) + (lane >> 2)) * 64 + (wid >> 2) * 32 + (lane & 3) * 8;
#define FA_DMA(t, s) do { const int k0_ = FA_KEY0(t); \
        _Pragma("unroll") for (int c_ = 0; c_ < 2; ++c_) { const int ch_ = wid + 8 * c_; if (ch_ < NCH) glds16(ksrc + (size_t)k0_ * DQK + ch_ * 8, (unsigned)__builtin_amdgcn_readfirstlane(lds0 + (s) * STG + ch_ * 1024)); } \
        glds16(vsrc + (size_t)k0_ * 64, (unsigned)__builtin_amdgcn_readfirstlane(lds0 + (s) * STG + KSTG + wid * 1024)); } while (0)
    FA_DMA(0, 0);
    if (MODE == 2) { float* rp = (float*)(shm + LDS_RPB); for (int i = tid; i < 15 * 31; i += 512) rp[i] = rpb[i] * LOG2E; }
    bf16x8 qr[ND0];
#pragma unroll
    for (int d0 = 0; d0 < ND0; ++d0) qr[d0] = *reinterpret_cast<const bf16x8*>(Qg + (size_t)(wid * 32 + r32) * DQK + d0 * 16 + hi * 8);
    float mhat = -1e30f, l_reg = 0.f; f32x16 o[2];
#pragma unroll
    for (int r = 0; r < 16; ++r) { o[0][r] = 0.f; o[1][r] = 0.f; }
    const int qpos = q0 + wid * 32 + r32;
    const int rq = (q0 >> 6) + (wid >> 1), jq = 32 * (wid & 1) + r32;
    const int rs = min(max(rq - 4, 0), 120), cs = min(max(jq - 8, 0), 48);
    const lds_cptr shm3 = (lds_cptr)shm;
    FA_WAIT_BAR();
    for (int t = 0; t < NT; ++t) {
        const int s = t & 1;
        if (t + 1 < NT) FA_DMA(t + 1, s ^ 1);
        bool active = true;
        if (MODE == 1 && t >= 4) { const int kp0 = wbase + 64 * (t - 4), qw0 = q0 + wid * 32; active = (kp0 + 63 >= qw0 - 128) && (kp0 <= qw0 + 31 + 128); }
        if (MODE == 2 && t >= 4) { const int kr = wbase + t - 4; active = (kr >= rs) && (kr < rs + 8); }
        if (active) {
            const lds_cptr kb = shm3 + s * STG + hi * 1024 + r32 * 16;
            f32x16 p0, p1;
#pragma unroll
            for (int r = 0; r < 16; ++r) { p0[r] = 0.f; p1[r] = 0.f; }
#pragma unroll
            for (int d0 = 0; d0 < ND0; ++d0) {
                const bf16x8 b0 = *(const __attribute__((address_space(3))) bf16x8*)(kb + d0 * 2048);
                const bf16x8 b1 = *(const __attribute__((address_space(3))) bf16x8*)(kb + d0 * 2048 + 512);
                p0 = __builtin_amdgcn_mfma_f32_32x32x16_bf16(b0, qr[d0], p0, 0, 0, 0);
                p1 = __builtin_amdgcn_mfma_f32_32x32x16_bf16(b1, qr[d0], p1, 0, 0, 0);
            }
            if (MODE == 1 && t >= 4) { const int kp0 = wbase + 64 * (t - 4) - qpos;
#pragma unroll
                for (int r = 0; r < 16; ++r) { const int d0_ = kp0 + crow(r, hi), d1_ = d0_ + 32; if (d0_ < -128 || d0_ > 128) p0[r] = -INFINITY; if (d1_ < -128 || d1_ > 128) p1[r] = -INFINITY; } }
            if (MODE == 2 && t >= 4) { const int kr = wbase + t - 4; const float* rp = (const float*)(shm + LDS_RPB) + (kr - rq + 7) * 31 + 15 - jq;
#pragma unroll
                for (int r = 0; r < 16; ++r) { const int kc0 = crow(r, hi), kc1 = kc0 + 32;
                    const bool v0 = (kc0 >= cs) && (kc0 < cs + 16), v1 = (kc1 >= cs) && (kc1 < cs + 16);
                    p0[r] = v0 ? p0[r] + rp[v0 ? kc0 : jq] : -INFINITY; p1[r] = v1 ? p1[r] + rp[v1 ? kc1 : jq] : -INFINITY; } }
            float rm = fmaxf(p0[0], p1[0]);
#pragma unroll
            for (int r = 1; r < 16; ++r) rm = fmaxf(rm, fmaxf(p0[r], p1[r]));
            rm = xhalf_max(rm);
            if (__any(rm - mhat > THR)) {
                const float mn = fmaxf(mhat, rm), f = __builtin_amdgcn_exp2f(mhat - mn); mhat = mn; l_reg *= f;
                if (hi == 0) wsf[r32] = f;
#pragma unroll
                for (int r = 0; r < 16; ++r) { const float fr = wsf[crow(r, hi)]; o[0][r] *= fr; o[1][r] *= fr; }
            }
            float sacc = 0.f;
#pragma unroll
            for (int r = 0; r < 16; ++r) { p0[r] = __builtin_amdgcn_exp2f(p0[r] - mhat); p1[r] = __builtin_amdgcn_exp2f(p1[r] - mhat); sacc += p0[r] + p1[r]; }
            l_reg += sacc;
            u32x4 pw0, pw1, pw2, pw3;
            pw0 = (u32x4){cvtpk(p0[0], p0[1]), cvtpk(p0[2], p0[3]), cvtpk(p0[4], p0[5]), cvtpk(p0[6], p0[7])};
            pw1 = (u32x4){cvtpk(p0[8], p0[9]), cvtpk(p0[10], p0[11]), cvtpk(p0[12], p0[13]), cvtpk(p0[14], p0[15])};
            pw2 = (u32x4){cvtpk(p1[0], p1[1]), cvtpk(p1[2], p1[3]), cvtpk(p1[4], p1[5]), cvtpk(p1[6], p1[7])};
            pw3 = (u32x4){cvtpk(p1[8], p1[9]), cvtpk(p1[10], p1[11]), cvtpk(p1[12], p1[13]), cvtpk(p1[14], p1[15])};
            const lds_cptr vp = shm3 + s * STG + KSTG + ((lane >> 4) & 1) * 32 + (lane & 3) * 8 + (4 * hi + ((lane & 15) >> 2)) * 64;
#pragma unroll
            for (int dh = 0; dh < 2; ++dh) {
                s16x4 vlo[4], vhi[4];
#pragma unroll
                for (int ks = 0; ks < 4; ++ks) { vlo[ks] = vtr(vp + dh * 4096 + ks * 1024); vhi[ks] = vtr(vp + dh * 4096 + ks * 1024 + 512); }
#define FA_VFR(k) (bf16x8){vlo[k][0], vlo[k][1], vlo[k][2], vlo[k][3], vhi[k][0], vhi[k][1], vhi[k][2], vhi[k][3]}
                o[dh] = __builtin_amdgcn_mfma_f32_32x32x16_bf16(__builtin_bit_cast(bf16x8, pw0), FA_VFR(0), o[dh], 0, 0, 0);
                o[dh] = __builtin_amdgcn_mfma_f32_32x32x16_bf16(__builtin_bit_cast(bf16x8, pw1), FA_VFR(1), o[dh], 0, 0, 0);
                o[dh] = __builtin_amdgcn_mfma_f32_32x32x16_bf16(__builtin_bit_cast(bf16x8, pw2), FA_VFR(2), o[dh], 0, 0, 0);
                o[dh] = __builtin_amdgcn_mfma_f32_32x32x16_bf16(__builtin_bit_cast(bf16x8, pw3), FA_VFR(3), o[dh], 0, 0, 0);
#undef FA_VFR
            }
        }
        FA_WAIT_BAR();
    }
    l_reg = xhalf_sum(l_reg);
    if (MODE == 1 || MODE == 3) l_reg += __builtin_amdgcn_exp2f(sink2 - mhat);
    if (hi == 0) wsf[32 + r32] = 1.0f / l_reg;
    float rli[16];
#pragma unroll
    for (int r = 0; r < 16; ++r) rli[r] = wsf[32 + crow(r, hi)];
    bf16_t* stg = (bf16_t*)(shm + LDS_OST) + wid * 2048;
#pragma unroll
    for (int r = 0; r < 16; ++r) { const int orow = crow(r, hi);
#pragma unroll
        for (int dh = 0; dh < 2; ++dh) stg[orow * 64 + dh * 32 + r32] = (bf16_t)f2bf(o[dh][r] * rli[r]); }
#pragma unroll
    for (int i = 0; i < 4; ++i) { const int row = i * 8 + (lane >> 3), ch = lane & 7; const u32x4 v = *(const u32x4*)(stg + row * 64 + ch * 8); *(u32x4*)(Og + (size_t)(wid * 32 + row) * D + ch * 8) = v; }
    asm volatile("s_waitcnt lgkmcnt(0)\n\ts_barrier" ::: "memory");
#undef FA_DMA
#undef FA_KEY0
}
#undef FA_WAIT_BAR
}


namespace fa2 {
using fa::bf16x8; using fa::s16x4; using fa::f32x16; using fa::lds_cptr; using fa::crow; using fa::glds16; using fa::vtr; using fa::cvtpk; using fa::LOG2E;
constexpr int KSL = 12288, VSL = 8192, VBASE = 4 * KSL, LDS_WS = VBASE + 3 * VSL, LDS_OST = LDS_WS + 8 * 256, LDS_RPB = LDS_OST + 8 * 4096, LDS_TOTAL = LDS_RPB + 2048;
static_assert(LDS_TOTAL <= 131072, "attention LDS");
#define SBAR() __builtin_amdgcn_sched_barrier(0)
#define PIN(x) asm volatile("" : "+v"(x))
template <int DQK, int MODE, int THRL>
__device__ __forceinline__ void attn_unit(const bf16_t* Qg, const bf16_t* Kg, const bf16_t* Vg, bf16_t* Og, int q0, float sink2, const float* rpb, char* shm) {
    const int tid = opq((int)threadIdx.x), lane = tid & 63, r32 = lane & 31, hi = lane >> 5; const int wid = __builtin_amdgcn_readfirstlane(tid >> 6);
    const unsigned lds0 = (unsigned)(uintptr_t)shm;
    float* wsf = (float*)(shm + LDS_WS) + wid * 64;
    constexpr int NCH = DQK / 8, ND0 = DQK / 16;
    int NT, wbase = 0;
    if (MODE == 0) NT = KEYS / 64; else if (MODE == 3) NT = 4;
    else if (MODE == 1) { wbase = max(0, q0 - 128); const int we = min(SEQ, q0 + 256 + 128); NT = 4 + (we - wbase) / 64; }
    else { const int r0 = q0 >> 6; wbase = min(max(r0 - 4, 0), 120); const int kre = min(max(r0 - 1, 0), 120) + 8; NT = 4 + (kre - wbase); }
#define FA_KEY0(t) ((MODE == 0 || MODE == 3 || (t) < 4) ? 64 * (t) : (MODE == 1 ? CTX + wbase + 64 * ((t) - 4) : CTX + (wbase + (t) - 4) * 64))
    const bf16_t* ksrc = Kg + (size_t)lane * DQK; const bf16_t* vsrc = Vg + (size_t)(16 * (wid & 3) + (lane >> 2)) * 64 + (wid >> 2) * 32 + (lane & 3) * 8;
#define DMA_K(t, slotoff) do { const int tt_ = (t) < NT ? (t) : NT - 1; const int k0_ = FA_KEY0(tt_); \
        glds16(ksrc + (size_t)k0_ * DQK + wid * 8, (unsigned)__builtin_amdgcn_readfirstlane(lds0 + (slotoff) + wid * 1024)); \
        if (NCH > 8) { if (wid < NCH - 8) glds16(ksrc + (size_t)k0_ * DQK + (wid + 8) * 8, (unsigned)__builtin_amdgcn_readfirstlane(lds0 + (slotoff) + (wid + 8) * 1024)); } } while (0)
#define DMA_V(t, slotoff) do { const int tt_ = (t) < NT ? (t) : NT - 1; const int k0_ = FA_KEY0(tt_); \
        glds16(vsrc + (size_t)k0_ * 64, (unsigned)__builtin_amdgcn_readfirstlane(lds0 + VBASE + (slotoff) + wid * 1024)); } while (0)
#define WAIT_STEP() do { if (NCH > 8 && wid < NCH - 8) asm volatile("s_waitcnt vmcnt(3) lgkmcnt(0)\n\ts_barrier" ::: "memory"); else asm volatile("s_waitcnt vmcnt(2) lgkmcnt(0)\n\ts_barrier" ::: "memory"); } while (0)
    DMA_K(0, 0); DMA_V(0, 0); DMA_K(1, KSL); DMA_K(2, 2 * KSL);
    if (MODE == 2) { float* rp = (float*)(shm + LDS_RPB); for (int i = tid; i < 15 * 31; i += 512) rp[i] = rpb[i] * LOG2E; }
    bf16x8 qr[ND0];
#pragma unroll
    for (int d0 = 0; d0 < ND0; ++d0) qr[d0] = *reinterpret_cast<const bf16x8*>(Qg + (size_t)(wid * 32 + r32) * DQK + d0 * 16 + hi * 8);
    float mhat = 0.f, l_reg = 0.f; f32x16 o[2]; f32x16 negm;
#pragma unroll
    for (int r = 0; r < 16; ++r) { o[0][r] = 0.f; o[1][r] = 0.f; negm[r] = 0.f; }
    PIN(negm);
    const int qpos = q0 + wid * 32 + r32;
    const int rq = (q0 >> 6) + (wid >> 1), jq = 32 * (wid & 1) + r32;
    const int rs = min(max(rq - 4, 0), 120), cs = min(max(jq - 8, 0), 48);
    const lds_cptr shm3 = (lds_cptr)shm;
    const lds_cptr kp0 = shm3 + hi * 1024 + r32 * 16;
    const lds_cptr vp0 = shm3 + VBASE + ((lane >> 4) & 1) * 32 + (lane & 3) * 8 + (4 * hi + ((lane & 15) >> 2)) * 64;
#define MASK(C0, C1, t) do { \
        if (MODE == 1 && (t) >= 4) { const int kp0_ = wbase + 64 * ((t) - 4) - qpos; \
            _Pragma("unroll") for (int r = 0; r < 16; ++r) { const int d0_ = kp0_ + crow(r, hi), d1_ = d0_ + 32; if (d0_ < -128 || d0_ > 128) C0[r] = -INFINITY; if (d1_ < -128 || d1_ > 128) C1[r] = -INFINITY; } } \
        if (MODE == 2 && (t) >= 4) { const int kr_ = wbase + (t) - 4; const bool rowok_ = (kr_ >= rs) && (kr_ < rs + 8); const int ro_ = min(max(kr_ - rq + 7, 0), 14); \
            const float* rp_ = (const float*)(shm + LDS_RPB) + ro_ * 31 + 15 - jq; \
            _Pragma("unroll") for (int r = 0; r < 16; ++r) { const int kc0 = crow(r, hi), kc1 = kc0 + 32; \
                const bool v0 = rowok_ && (kc0 >= cs) && (kc0 < cs + 16), v1 = rowok_ && (kc1 >= cs) && (kc1 < cs + 16); \
                C0[r] = v0 ? C0[r] + rp_[v0 ? kc0 : jq] : -INFINITY; C1[r] = v1 ? C1[r] + rp_[v1 ? kc1 : jq] : -INFINITY; } } } while (0)
#define ROWMAX(C0, C1, rm) do { float a_ = fmaxf(fmaxf(C0[0], C0[1]), C1[0]), b_ = fmaxf(fmaxf(C0[2], C0[3]), C1[1]); a_ = fmaxf(fmaxf(a_, C1[2]), C1[3]); \
        _Pragma("unroll") for (int r = 4; r < 16; r += 4) { a_ = fmaxf(fmaxf(a_, C0[r]), C0[r + 1]); b_ = fmaxf(fmaxf(b_, C0[r + 2]), C0[r + 3]); a_ = fmaxf(fmaxf(a_, C1[r]), C1[r + 1]); b_ = fmaxf(fmaxf(b_, C1[r + 2]), C1[r + 3]); } \
        rm = fa::xhalf_max(fmaxf(a_, b_)); } while (0)
    bf16x8 kf[8]; bf16x8 kf2[4];
#define KLOAD(j, slotoff) do { kf[2 * (j)] = *(const __attribute__((address_space(3))) bf16x8*)(kp0 + (slotoff) + (j) * 2048); kf[2 * (j) + 1] = *(const __attribute__((address_space(3))) bf16x8*)(kp0 + (slotoff) + (j) * 2048 + 512); } while (0)
#define KLOAD2(slotoff) do { if (ND0 > 4) { kf2[0] = *(const __attribute__((address_space(3))) bf16x8*)(kp0 + (slotoff) + 4 * 2048); kf2[1] = *(const __attribute__((address_space(3))) bf16x8*)(kp0 + (slotoff) + 4 * 2048 + 512); \
        kf2[2] = *(const __attribute__((address_space(3))) bf16x8*)(kp0 + (slotoff) + 5 * 2048); kf2[3] = *(const __attribute__((address_space(3))) bf16x8*)(kp0 + (slotoff) + 5 * 2048 + 512); } } while (0)
    asm volatile("s_waitcnt vmcnt(0) lgkmcnt(0)\n\ts_barrier" ::: "memory");
    f32x16 pA0, pA1, pB0, pB1;
    int ks_cur = 0, ks_next = KSL, ks_nn = 2 * KSL, ks_tgt = 3 * KSL;
    int vs_prev = 2 * VSL, vs_cur = 0, vs_next = VSL;
#define ROT() do { const int k_ = ks_cur; ks_cur = ks_next; ks_next = ks_nn; ks_nn = ks_tgt; ks_tgt = k_; const int v_ = vs_prev; vs_prev = vs_cur; vs_cur = vs_next; vs_next = v_; } while (0)
    bool resc = false;
#define RESC() do { if (resc) { _Pragma("unroll") for (int r = 0; r < 16; ++r) { const float fr_ = wsf[crow(r, hi)]; o[0][r] *= fr_; o[1][r] *= fr_; } } } while (0)
    KLOAD(0, 0); KLOAD(1, 0); KLOAD(2, 0); KLOAD(3, 0); KLOAD2(0);
    {
#pragma unroll
        for (int d0 = 0; d0 < 4; ++d0) { pA0 = __builtin_amdgcn_mfma_f32_32x32x16_bf16(kf[2 * d0], qr[d0], d0 == 0 ? negm : pA0, 0, 0, 0); pA1 = __builtin_amdgcn_mfma_f32_32x32x16_bf16(kf[2 * d0 + 1], qr[d0], d0 == 0 ? negm : pA1, 0, 0, 0); }
        if (ND0 > 4) { pA0 = __builtin_amdgcn_mfma_f32_32x32x16_bf16(kf2[0], qr[ND0 > 4 ? 4 : 0], pA0, 0, 0, 0); pA1 = __builtin_amdgcn_mfma_f32_32x32x16_bf16(kf2[1], qr[ND0 > 4 ? 4 : 0], pA1, 0, 0, 0);
                       pA0 = __builtin_amdgcn_mfma_f32_32x32x16_bf16(kf2[2], qr[ND0 > 4 ? 5 : 0], pA0, 0, 0, 0); pA1 = __builtin_amdgcn_mfma_f32_32x32x16_bf16(kf2[3], qr[ND0 > 4 ? 5 : 0], pA1, 0, 0, 0); }
        DMA_K(3, 3 * KSL); DMA_V(1, VSL);
        float rm; ROWMAX(pA0, pA1, rm);
        mhat = rm;
#pragma unroll
        for (int r = 0; r < 16; ++r) { pA0[r] = __builtin_amdgcn_exp2f(pA0[r] - rm); pA1[r] = __builtin_amdgcn_exp2f(pA1[r] - rm); negm[r] = -mhat; }
        PIN(negm);
        KLOAD(0, KSL); KLOAD(1, KSL); KLOAD(2, KSL); KLOAD(3, KSL);
        WAIT_STEP();
    }
    s16x4 vlo[8], vhi[8]; u32x4 pw0, pw1, pw2, pw3;
#define VRD(i) do { vlo[i] = vtr(vp_ + (((i) >> 2) * 4096 + ((i) & 3) * 1024)); vhi[i] = vtr(vp_ + (((i) >> 2) * 4096 + ((i) & 3) * 1024 + 512)); } while (0)
#define VFR(i) (bf16x8){vlo[i][0], vlo[i][1], vlo[i][2], vlo[i][3], vhi[i][0], vhi[i][1], vhi[i][2], vhi[i][3]}
#define PAF(k) __builtin_bit_cast(bf16x8, pw##k)
#define GAPA(MF, A0, A1, A2, A3, W0, W1, PW) do { MF; sacc += A0; sacc += A1; sacc += A2; sacc += A3; PIN(sacc); W0; W1; PIN(PW); SBAR(); } while (0)
#define EX(v) __builtin_amdgcn_exp2f(v)
#define GAPB(MF, X, B) do { MF; X[B] = EX(X[B]); X[B + 1] = EX(X[B + 1]); X[B + 2] = EX(X[B + 2]); X[B + 3] = EX(X[B + 3]); PIN(X); SBAR(); } while (0)
#define KRD(j) do { KLOAD(j, ks_nn_); SBAR(); } while (0)
#define STEP(C0, C1, P0, P1, t) do { SBAR(); \
        const lds_cptr vp_ = vp0 + vs_prev; const int ks_cur_ = ks_cur; (void)ks_cur_; \
        KLOAD2(ks_cur_); \
        VRD(0); SBAR(); float sacc = (P0[0] + P0[1]); \
        GAPA(C0 = __builtin_amdgcn_mfma_f32_32x32x16_bf16(kf[0], qr[0], negm, 0, 0, 0), P0[2], P0[3], P0[4], P0[5], pw0[0] = cvtpk(P0[0], P0[1]), pw0[1] = cvtpk(P0[2], P0[3]), pw0); \
        VRD(4); SBAR(); GAPA(C1 = __builtin_amdgcn_mfma_f32_32x32x16_bf16(kf[1], qr[0], negm, 0, 0, 0), P0[6], P0[7], P0[8], P0[9], pw0[2] = cvtpk(P0[4], P0[5]), pw0[3] = cvtpk(P0[6], P0[7]), pw0); \
        VRD(1); SBAR(); GAPA(C0 = __builtin_amdgcn_mfma_f32_32x32x16_bf16(kf[2], qr[1], C0, 0, 0, 0), P0[10], P0[11], P0[12], P0[13], pw1[0] = cvtpk(P0[8], P0[9]), pw1[1] = cvtpk(P0[10], P0[11]), pw1); \
        VRD(5); SBAR(); GAPA(C1 = __builtin_amdgcn_mfma_f32_32x32x16_bf16(kf[3], qr[1], C1, 0, 0, 0), P0[14], P0[15], P1[0], P1[1], pw1[2] = cvtpk(P0[12], P0[13]), pw1[3] = cvtpk(P0[14], P0[15]), pw1); \
        VRD(2); SBAR(); GAPA(C0 = __builtin_amdgcn_mfma_f32_32x32x16_bf16(kf[4], qr[2], C0, 0, 0, 0), P1[2], P1[3], P1[4], P1[5], pw2[0] = cvtpk(P1[0], P1[1]), pw2[1] = cvtpk(P1[2], P1[3]), pw2); \
        VRD(6); SBAR(); GAPA(C1 = __builtin_amdgcn_mfma_f32_32x32x16_bf16(kf[5], qr[2], C1, 0, 0, 0), P1[6], P1[7], P1[8], P1[9], pw2[2] = cvtpk(P1[4], P1[5]), pw2[3] = cvtpk(P1[6], P1[7]), pw2); \
        VRD(3); SBAR(); GAPA(C0 = __builtin_amdgcn_mfma_f32_32x32x16_bf16(kf[6], qr[3], C0, 0, 0, 0), P1[10], P1[11], P1[12], P1[13], pw3[0] = cvtpk(P1[8], P1[9]), pw3[1] = cvtpk(P1[10], P1[11]), pw3); \
        VRD(7); SBAR(); GAPA(C1 = __builtin_amdgcn_mfma_f32_32x32x16_bf16(kf[7], qr[3], C1, 0, 0, 0), P1[14], P1[15], 0.f, 0.f, pw3[2] = cvtpk(P1[12], P1[13]), pw3[3] = cvtpk(P1[14], P1[15]), pw3); \
        if (ND0 > 4) { C0 = __builtin_amdgcn_mfma_f32_32x32x16_bf16(kf2[0], qr[ND0 > 4 ? 4 : 0], C0, 0, 0, 0); C1 = __builtin_amdgcn_mfma_f32_32x32x16_bf16(kf2[1], qr[ND0 > 4 ? 4 : 0], C1, 0, 0, 0); \
                       C0 = __builtin_amdgcn_mfma_f32_32x32x16_bf16(kf2[2], qr[ND0 > 4 ? 5 : 0], C0, 0, 0, 0); C1 = __builtin_amdgcn_mfma_f32_32x32x16_bf16(kf2[3], qr[ND0 > 4 ? 5 : 0], C1, 0, 0, 0); SBAR(); } \
        l_reg += sacc; \
        DMA_K((t) + 3, ks_tgt); DMA_V((t) + 1, vs_next); \
        MASK(C0, C1, t); \
        { float rm; ROWMAX(C0, C1, rm); resc = false; \
          if (__builtin_expect(__any(rm > (float)THRL), 0)) { const float dl = fmaxf(rm, 0.f); mhat += dl; \
              _Pragma("unroll") for (int r = 0; r < 16; ++r) { C0[r] -= dl; C1[r] -= dl; } \
              _Pragma("unroll") for (int r = 0; r < 16; ++r) negm[r] = -mhat; PIN(negm); \
              const float f = __builtin_amdgcn_exp2f(-dl); l_reg *= f; if (hi == 0) wsf[r32] = f; resc = true; } } \
        SBAR(); \
        const int ks_nn_ = ks_next; \
        GAPB(o[0] = __builtin_amdgcn_mfma_f32_32x32x16_bf16(PAF(0), VFR(0), o[0], 0, 0, 0), C0, 0); \
        GAPB(o[1] = __builtin_amdgcn_mfma_f32_32x32x16_bf16(PAF(0), VFR(4), o[1], 0, 0, 0), C0, 4); \
        KRD(0); GAPB(o[0] = __builtin_amdgcn_mfma_f32_32x32x16_bf16(PAF(1), VFR(1), o[0], 0, 0, 0), C0, 8); \
        KRD(1); GAPB(o[1] = __builtin_amdgcn_mfma_f32_32x32x16_bf16(PAF(1), VFR(5), o[1], 0, 0, 0), C0, 12); \
        KRD(2); GAPB(o[0] = __builtin_amdgcn_mfma_f32_32x32x16_bf16(PAF(2), VFR(2), o[0], 0, 0, 0), C1, 0); \
        KRD(3); GAPB(o[1] = __builtin_amdgcn_mfma_f32_32x32x16_bf16(PAF(2), VFR(6), o[1], 0, 0, 0), C1, 4); \
        GAPB(o[0] = __builtin_amdgcn_mfma_f32_32x32x16_bf16(PAF(3), VFR(3), o[0], 0, 0, 0), C1, 8); \
        GAPB(o[1] = __builtin_amdgcn_mfma_f32_32x32x16_bf16(PAF(3), VFR(7), o[1], 0, 0, 0), C1, 12); \
    } while (0)
    ROT();
    int t = 1;
    for (; t + 1 < NT; t += 2) {
        STEP(pB0, pB1, pA0, pA1, t);     WAIT_STEP(); RESC(); ROT();
        STEP(pA0, pA1, pB0, pB1, t + 1); WAIT_STEP(); RESC(); ROT();
    }
    if (t < NT) {
        STEP(pB0, pB1, pA0, pA1, t);     WAIT_STEP(); RESC(); ROT();
        pA0 = pB0; pA1 = pB1;
    }
    {
        float sacc = 0.f;
#pragma unroll
        for (int r = 0; r < 16; ++r) sacc += pA0[r] + pA1[r];
        l_reg += sacc;
        pw0 = (u32x4){cvtpk(pA0[0], pA0[1]), cvtpk(pA0[2], pA0[3]), cvtpk(pA0[4], pA0[5]), cvtpk(pA0[6], pA0[7])};
        pw1 = (u32x4){cvtpk(pA0[8], pA0[9]), cvtpk(pA0[10], pA0[11]), cvtpk(pA0[12], pA0[13]), cvtpk(pA0[14], pA0[15])};
        pw2 = (u32x4){cvtpk(pA1[0], pA1[1]), cvtpk(pA1[2], pA1[3]), cvtpk(pA1[4], pA1[5]), cvtpk(pA1[6], pA1[7])};
        pw3 = (u32x4){cvtpk(pA1[8], pA1[9]), cvtpk(pA1[10], pA1[11]), cvtpk(pA1[12], pA1[13]), cvtpk(pA1[14], pA1[15])};
        const lds_cptr vp_ = vp0 + vs_prev;
#pragma unroll
        for (int i = 0; i < 8; ++i) VRD(i);
        o[0] = __builtin_amdgcn_mfma_f32_32x32x16_bf16(PAF(0), VFR(0), o[0], 0, 0, 0); o[1] = __builtin_amdgcn_mfma_f32_32x32x16_bf16(PAF(0), VFR(4), o[1], 0, 0, 0);
        o[0] = __builtin_amdgcn_mfma_f32_32x32x16_bf16(PAF(1), VFR(1), o[0], 0, 0, 0); o[1] = __builtin_amdgcn_mfma_f32_32x32x16_bf16(PAF(1), VFR(5), o[1], 0, 0, 0);
        o[0] = __builtin_amdgcn_mfma_f32_32x32x16_bf16(PAF(2), VFR(2), o[0], 0, 0, 0); o[1] = __builtin_amdgcn_mfma_f32_32x32x16_bf16(PAF(2), VFR(6), o[1], 0, 0, 0);
        o[0] = __builtin_amdgcn_mfma_f32_32x32x16_bf16(PAF(3), VFR(3), o[0], 0, 0, 0); o[1] = __builtin_amdgcn_mfma_f32_32x32x16_bf16(PAF(3), VFR(7), o[1], 0, 0, 0);
    }
    l_reg = fa::xhalf_sum(l_reg);
    if (MODE == 1 || MODE == 3) l_reg += __builtin_amdgcn_exp2f(sink2 - mhat);
    if (hi == 0) wsf[32 + r32] = 1.0f / l_reg;
    float rli[16];
#pragma unroll
    for (int r = 0; r < 16; ++r) rli[r] = wsf[32 + crow(r, hi)];
    bf16_t* stg = (bf16_t*)(shm + LDS_OST) + wid * 2048;
#pragma unroll
    for (int r = 0; r < 16; ++r) { const int orow = crow(r, hi);
#pragma unroll
        for (int dh = 0; dh < 2; ++dh) stg[orow * 64 + dh * 32 + r32] = (bf16_t)f2bf(o[dh][r] * rli[r]); }
#pragma unroll
    for (int i = 0; i < 4; ++i) { const int row = i * 8 + (lane >> 3), ch = lane & 7; const u32x4 v = *(const u32x4*)(stg + row * 64 + ch * 8); *(u32x4*)(Og + (size_t)(wid * 32 + row) * D + ch * 8) = v; }
    asm volatile("s_waitcnt vmcnt(0) lgkmcnt(0)\n\ts_barrier" ::: "memory");
#undef FA_KEY0
#undef DMA_K
#undef DMA_V
#undef WAIT_STEP
#undef MASK
#undef ROWMAX
#undef KLOAD
#undef KLOAD2
#undef ROT
#undef RESC
#undef VRD
#undef VFR
#undef PAF
#undef GAPA
#undef EX
#undef GAPB
#undef KRD
#undef STEP
}
#undef SBAR
#undef PIN
}

constexpr float SCALE_MLA = 0.10206207261596575f;
__device__ __forceinline__ void ph_attn(const Params& p, int layer, bool with_ctx, char* shm) {
    const QKVB qb = make_qkv(p.ws);
    bf16_t* O = (bf16_t*)(p.ws + WS_P);
    const int G = gridDim.x;
    const float NEG = -INFINITY;
    for (int u = blockIdx.x; u < 256; u += G) { const int bh = u & 7, b = bh >> 2, h = bh & 3, qbk = u >> 3;
        fa2::attn_unit<96, 0, 6>(qb.QD + ((size_t)bh * SEQ + qbk * 256) * 96, qb.KD + (size_t)bh * KEYS * 96, qb.VD + (size_t)bh * KEYS * 64, O + (size_t)(b * SEQ + qbk * 256) * D + 768 + h * 64, qbk * 256, NEG, nullptr, shm); }
    for (int u = blockIdx.x; u < 256; u += G) { const int bh = u & 7, b = bh >> 2, h = bh & 3, qbk = u >> 3;
        fa2::attn_unit<64, 0, 6>(qb.QB + ((size_t)bh * SEQ + qbk * 256) * 64, qb.KB + (size_t)(b * 2 + (h >> 1)) * KEYS * 64, qb.VB + (size_t)(b * 2 + (h >> 1)) * KEYS * 64, O + (size_t)(b * SEQ + qbk * 256) * D + 256 + h * 64, qbk * 256, NEG, nullptr, shm); }
    for (int u = blockIdx.x; u < 256; u += G) { const int bh = u & 7, b = bh >> 2, h = bh & 3, qbk = u >> 3;
        fa2::attn_unit<64, 1, 6>(qb.QA + ((size_t)bh * SEQ + qbk * 256) * 64, qb.KA + (size_t)(b * 2 + (h >> 1)) * KEYS * 64, qb.VA + (size_t)(b * 2 + (h >> 1)) * KEYS * 64, O + (size_t)(b * SEQ + qbk * 256) * D + 0 + h * 64, qbk * 256, p.in[11][layer * 4 + h] * fa::LOG2E, nullptr, shm); }
    for (int u = blockIdx.x; u < 256; u += G) { const int bh = u & 7, b = bh >> 2, h = bh & 3, qbk = u >> 3;
        fa2::attn_unit<64, 2, 6>(qb.QC + ((size_t)bh * SEQ + qbk * 256) * 64, qb.KC + (size_t)bh * KEYS * 64, qb.VC + (size_t)bh * KEYS * 64, O + (size_t)(b * SEQ + qbk * 256) * D + 512 + h * 64, qbk * 256, NEG, p.in[16] + ((size_t)layer * 4 + h) * 15 * 31, shm); }
    if (with_ctx) for (int u = blockIdx.x; u < 32; u += G) { const int ty = u >> 3, bh = u & 7, b = bh >> 2, h = bh & 3;
        bf16_t* Oc = O + (size_t)(TL + b * CTX) * D + ty * 256 + h * 64;
        if (ty == 0) fa2::attn_unit<64, 3, 6>(qb.QAc + (size_t)bh * CTX * 64, qb.KA + (size_t)(b * 2 + (h >> 1)) * KEYS * 64, qb.VA + (size_t)(b * 2 + (h >> 1)) * KEYS * 64, Oc, 0, p.in[11][layer * 4 + h] * fa::LOG2E, nullptr, shm);
        else if (ty == 1) fa2::attn_unit<64, 3, 6>(qb.QBc + (size_t)bh * CTX * 64, qb.KB + (size_t)(b * 2 + (h >> 1)) * KEYS * 64, qb.VB + (size_t)(b * 2 + (h >> 1)) * KEYS * 64, Oc, 0, NEG, nullptr, shm);
        else if (ty == 2) fa2::attn_unit<64, 3, 6>(qb.QCc + (size_t)bh * CTX * 64, qb.KC + (size_t)bh * KEYS * 64, qb.VC + (size_t)bh * KEYS * 64, Oc, 0, NEG, nullptr, shm);
        else fa2::attn_unit<96, 3, 6>(qb.QDc + (size_t)bh * CTX * 96, qb.KD + (size_t)bh * KEYS * 96, qb.VD + (size_t)bh * KEYS * 64, Oc, 0, NEG, nullptr, shm); }
}

__device__ __forceinline__ void ph_gnorm(const Params& p, int layer, int nrows) {
    const int tx = opq((int)threadIdx.x), lane = tx & 63, gw = (blockIdx.x * 512 + tx) >> 6, ngw = (gridDim.x * 512) >> 6;
    const bf16_t* O = (const bf16_t*)(p.ws + WS_P); bf16_t* Y = (bf16_t*)(p.ws + WS_ACT1); const float* g = p.in[23] + layer * D;
    for (int m = gw; m < nrows; m += ngw) {
#pragma unroll
        for (int grp = 0; grp < 4; ++grp) { const int c = grp * 256 + 4 * lane; const u32x2 w = *(const u32x2*)(O + (size_t)m * D + c);
            const float a0 = bflo(w.x), a1 = bfhi(w.x), a2 = bflo(w.y), a3 = bfhi(w.y);
            const float r = rsqrtf(wave_sum(a0 * a0 + a1 * a1 + a2 * a2 + a3 * a3) * (1.f / 256.f) + EPS);
            const f32x4 gv = *(const f32x4*)(g + c); u32x2 o; o.x = pk2(a0 * r * gv.x, a1 * r * gv.y); o.y = pk2(a2 * r * gv.z, a3 * r * gv.w);
            *(u32x2*)(Y + (size_t)m * D + c) = o; }
    }
}

__device__ __forceinline__ void moe_bases(const unsigned* cnt, int (&base)[9]) {
    int acc = 0;
#pragma unroll
    for (int e = 0; e < 8; ++e) { base[e] = acc; acc += ((int)cnt[64 * e] + 255) / 256 * 256; }
    base[8] = acc;
}
__device__ __forceinline__ void ph_moe_gather(const Params& p) {
    const int tx = opq((int)threadIdx.x), lane = tx & 63, gw = (blockIdx.x * 512 + tx) >> 6, ngw = (gridDim.x * 512) >> 6;
    const unsigned* cnt = (const unsigned*)(p.ws + WS_CTL); int base[9]; moe_bases(cnt, base);
    if (blockIdx.x == 0 && tx < 136) { const int r = tx * 256; int e = -1;
#pragma unroll
        for (int i = 0; i < 8; ++i) if (r >= base[i] && r < base[i + 1]) e = i;
        ((int*)(p.ws + WS_TEXP))[tx] = e < 0 ? 0 : e; }
    const bf16_t* F = (const bf16_t*)(p.ws + WS_ACT1); bf16_t* A = (bf16_t*)(p.ws + WS_ASORT);
    for (int m = gw; m < TL; m += ngw) {
        const int2 e = ((const int2*)(p.ws + WS_TOKE))[m]; const int2 ps = ((const int2*)(p.ws + WS_TOKP))[m];
        int b0 = 0, b1 = 0;
#pragma unroll
        for (int i = 0; i < 8; ++i) { if (e.x == i) b0 = base[i]; if (e.y == i) b1 = base[i]; }
        const int s0 = b0 + ps.x, s1 = b1 + ps.y;
        const u32x4 v0 = *(const u32x4*)(F + (size_t)m * D + lane * 16), v1 = *(const u32x4*)(F + (size_t)m * D + lane * 16 + 8);
        *(u32x4*)(A + (size_t)s0 * D + lane * 16) = v0; *(u32x4*)(A + (size_t)s0 * D + lane * 16 + 8) = v1;
        *(u32x4*)(A + (size_t)s1 * D + lane * 16) = v0; *(u32x4*)(A + (size_t)s1 * D + lane * 16 + 8) = v1;
        if (lane == 0) ((int2*)(p.ws + WS_TOKS))[m] = make_int2(s0, s1);
    }
}
__device__ __forceinline__ void ph_moe_combine(const Params& p, int layer) {
    const size_t nthr = (size_t)gridDim.x * 512;
    for (size_t idx = (size_t)blockIdx.x * 512 + opq((int)threadIdx.x); idx < (size_t)TL * 256; idx += nthr) {
        const int m = (int)(idx >> 8), c = (int)(idx & 255) * 4;
        const int2 sl = ((const int2*)(p.ws + WS_TOKS))[m]; const float2 g = ((const float2*)(p.ws + WS_TOKG))[m];
        const bf16_t* Y = (const bf16_t*)(p.ws + WS_ASORT);
        const u32x2 a = *(const u32x2*)(Y + (size_t)sl.x * D + c), b = *(const u32x2*)(Y + (size_t)sl.y * D + c);
        const f32x4 ya = {bflo(a.x), bfhi(a.x), bflo(a.y), bfhi(a.y)}, yb = {bflo(b.x), bfhi(b.x), bflo(b.y), bfhi(b.y)};
        const float* mod = (const float*)(p.ws + WS_MOD) + (size_t)layer * 3 * 6144 + (m / SEQ) * 6144 + 5 * D;
        f32x4* o = (f32x4*)(p.out + (size_t)m * D + c);
        *o = *o + *(const f32x4*)(mod + c) * (ya * g.x + yb * g.y);
    }
}

#ifndef DBL_PHASE
#define DBL_PHASE (-1)
#endif
#ifndef FILL_Q_IN
#define FILL_Q_IN 0
#define FILL_Q_OUT 0
#define FILL_Q_UP 0
#define FILL_Q_DN 0
#endif
struct Args { Params p; int ph_lo, ph_hi; };
__global__ void __launch_bounds__(NWAVES * 64, 2) mega_fwd(Args args) {
    extern __shared__ __attribute__((aligned(16))) unsigned char lds[];
    LAS unsigned char* ldsl = (LAS unsigned char*)lds;
    for (int u = threadIdx.x; u < (LDS_BYTES - LDSCTL_OFF) / 4; u += NWAVES * 64) ((LAS unsigned*)(ldsl + LDSCTL_OFF))[u] = 0u;
    __syncthreads();
    XcdBarrier bar = xcd_barrier_post((unsigned*)(args.p.ws + WS_CTL) + CW_BAR, (volatile LAS unsigned*)(ldsl + MISC_OFF) + 8);
    const int lo = args.ph_lo, hi = args.ph_hi;
#pragma unroll 1
    for (int ph = lo; ph < hi; ++ph) {
      const int nrep = (ph == DBL_PHASE) ? 2 : 1;
#pragma unroll 1
      for (int rep_ = 0; rep_ < nrep; ++rep_) {
        if (rep_) xcd_barrier(bar);
        Params q = args.p; q.ws = opqp(args.p.ws); q.out = opqp(args.p.out);
        LAS unsigned char* ldq = (LAS unsigned char*)lds;
        const int l = ph >= 10 ? 1 : 0, st = ph == 0 ? -1 : (l ? ph - 10 : ph - 1);
        const bool last = (l == 1); const int nrows = last ? TL : MALL;
        const float* qmod = (const float*)(q.ws + WS_MOD) + (size_t)l * 3 * 6144;
        int fillq = 0, fill_nwg = 1;
        if (st == -1) ph_prologue(q, (float*)lds);
        else if (st == 0) ph_norm<1, false>(q, l, MALL, (unsigned*)lds, l ? 11 : 0);
        else if (st == 1) { run_gemm(ldq, (const bf16_t*)(q.ws + WS_ACT1), (const bf16_t*)(q.ws + WS_WIN) + (size_t)l * NINP * D, D, MALL / 256, NINP / 256, nullptr, 0, EpiBf16Perm{(bf16_t*)(q.ws + WS_P), NINP, 0});
                            fillq = FILL_Q_IN; fill_nwg = (MALL / 256) * (NINP / 256); }
        else if (st == 2) ph_postproj2(q, l);
        else if (st == 3) ph_attn(q, l, !last, (char*)lds);
        else if (st == 4) ph_gnorm(q, l, nrows);
        else if (st == 5 || (st == 8 && !last)) {
            const bool op = (st == 5);
            const bf16_t* A_ = (const bf16_t*)(q.ws + (op ? WS_ACT1 : WS_HIDF)); const bf16_t* B_ = op ? (const bf16_t*)(q.ws + WS_WOUT) + (size_t)l * D * D : (const bf16_t*)(q.ws + WS_WFDN);
            const int K_ = op ? D : DFF, goff_ = op ? 2 * D : 5 * D;
            const float* hl_in_ = (op && l == 0) ? q.in[0] : q.out;
#pragma unroll 1
            for (int pass = 0; pass < (last ? 1 : 2); ++pass)
                run_gemm(ldq, A_, B_, K_, pass ? 2 : 64, D / 256, nullptr, 0, EpiResid{hl_in_, (const float*)(q.ws + WS_HCTX), q.out, pass ? (float*)(q.ws + WS_PART) : (float*)(q.ws + WS_HCTX), qmod, goff_, pass}, pass ? (op ? 8 : 11) : 1, pass ? 64 : 0);
        }
        else if (!last) {
            if (st == 6) ph_norm<2, false>(q, l, MALL, (unsigned*)lds, 8);
            else if (st == 7) { run_gemm(ldq, (const bf16_t*)(q.ws + WS_ACT1), (const bf16_t*)(q.ws + WS_WFGU), D, MALL / 256, 2 * DFF / 256, nullptr, 0, EpiSwiglu{(bf16_t*)(q.ws + WS_HIDF), DFF, 0});
                                fillq = FILL_Q_UP; fill_nwg = (MALL / 256) * (2 * DFF / 256); }
            else {}
        } else {
            if (st == 6) ph_norm<2, true>(q, l, TL, (unsigned*)lds, 0);
            else if (st == 7) { ph_moe_gather(q); fillq = 1 << 30; fill_nwg = 0; }
            else if (st == 8) { int base[9]; moe_bases((const unsigned*)(q.ws + WS_CTL), base); run_gemm(ldq, (const bf16_t*)(q.ws + WS_ASORT), (const bf16_t*)(q.ws + WS_WMGU), D, __builtin_amdgcn_readfirstlane(base[8] / 256), 2 * DFFE / 256, (const int*)(q.ws + WS_TEXP), (size_t)2 * DFFE * D * 2, EpiSwiglu{(bf16_t*)(q.ws + WS_HIDM), DFFE, 0}); }
            else if (st == 9) { int base[9]; moe_bases((const unsigned*)(q.ws + WS_CTL), base); run_gemm(ldq, (const bf16_t*)(q.ws + WS_HIDM), (const bf16_t*)(q.ws + WS_WMDN), DFFE, __builtin_amdgcn_readfirstlane(base[8] / 256), D / 256, (const int*)(q.ws + WS_TEXP), (size_t)D * DFFE * 2, EpiBf16Perm{(bf16_t*)(q.ws + WS_ASORT), D, 0}); }
            else ph_moe_combine(q, l);
        }
        if (fillq > 0 && (fill_nwg == 0 || gemm_tail_idle(fill_nwg))) fill_moe(q, (float*)lds, fillq);
      }
      if (ph + 1 < hi) xcd_barrier(bar);
    }
}

#ifndef MK_CUTS
#define MK_CUTS 0
#endif
extern "C" void kernel_launch(void* const* d_in, const int* in_sizes, int n_in, void* d_out, int out_size, void* d_ws, size_t ws_size, hipStream_t stream) {
    static int grid = 0;
    if (grid == 0) {
        if (n_in != 32 || ws_size < WS_END) { fprintf(stderr, "kernel_launch: need 32 inputs and %zu bytes of workspace (got %d, %zu)\n", (size_t)WS_END, n_in, ws_size); grid = -1; return; }
        int dev = 0, cus = 0, per_cu = 0;
        if (hipGetDevice(&dev) != hipSuccess || hipDeviceGetAttribute(&cus, hipDeviceAttributeMultiprocessorCount, dev) != hipSuccess) { grid = -1; return; }
        if (hipFuncSetAttribute((const void*)mega_fwd, hipFuncAttributeMaxDynamicSharedMemorySize, LDS_BYTES) != hipSuccess) { fprintf(stderr, "kernel_launch: hipFuncSetAttribute failed\n"); grid = -1; return; }
        if (hipOccupancyMaxActiveBlocksPerMultiprocessor(&per_cu, (const void*)mega_fwd, NWAVES * 64, LDS_BYTES) != hipSuccess || per_cu < 1) fprintf(stderr, "kernel_launch: occupancy query says %d blocks per CU\n", per_cu);
        (void)hipGetLastError();
        grid = cus;
    }
    if (grid < 0) return;
    (void)hipMemsetAsync((char*)d_ws + WS_CTL, 0, CTL_ZERO_BYTES, stream);
    Args a{}; for (int i = 0; i < 32; ++i) a.p.in[i] = (const float*)d_in[i]; a.p.out = (float*)d_out; a.p.ws = (unsigned char*)d_ws;
#if MK_CUTS
    for (int ph = 0; ph < 24; ++ph) { a.ph_lo = ph; a.ph_hi = ph + 1; hipLaunchKernelGGL(mega_fwd, dim3(grid), dim3(NWAVES * 64), LDS_BYTES, stream, a); }
#else
    a.ph_lo = 0; a.ph_hi = 21;
    hipLaunchKernelGGL(mega_fwd, dim3(grid), dim3(NWAVES * 64), LDS_BYTES, stream, a);
#endif
}
```

```cpp
#include <hip/hip_runtime.h>
#include <stdint.h>
#include <cstdio>

typedef unsigned short bf16_t;
typedef float f32x4 __attribute__((ext_vector_type(4)));
typedef unsigned u32x4 __attribute__((ext_vector_type(4)));
typedef unsigned u32x2 __attribute__((ext_vector_type(2)));

constexpr int D = 1024, NB = 2, SEQ = 8192, CTX = 256, TL = NB * SEQ, TC = NB * CTX, MALL = TL + TC;
constexpr int NIN = 2144, NINP = 2304, DFF = 2816, NE = 8, DFFE = 3584, KEYS = CTX + SEQ;
constexpr int OFF_AQ = 0, OFF_AK = 256, OFF_AV = 384, OFF_BQ = 512, OFF_BK = 768, OFF_BV = 896, OFF_CQ = 1024, OFF_CK = 1280,
              OFF_CV = 1536, OFF_DCQ = 1792, OFF_DCKV = 1984, OFF_DKR = 2112;
constexpr int MOE_ROWS = 34816;
constexpr float EPS = 1e-6f;

constexpr size_t MiB = 1u << 20;
constexpr size_t WS_CTL = 0;
constexpr size_t WS_MOD = 1 * MiB;
constexpr size_t WS_ROPE = WS_MOD + 256 * 1024;
constexpr size_t WS_TOKE = WS_ROPE + 64 * 1024;
constexpr size_t WS_TOKP = WS_TOKE + TL * 8;
constexpr size_t WS_TOKG = WS_TOKP + TL * 8;
constexpr size_t WS_TEXP = WS_TOKG + TL * 8;
constexpr size_t WS_TOKS = WS_TEXP + 1024;
constexpr size_t WS_HCTX = 2 * MiB;
constexpr size_t WS_WMGU = 6 * MiB;
constexpr size_t WS_WMDN = WS_WMGU + 112 * MiB;
constexpr size_t WS_WDEAD = WS_WMDN + 56 * MiB;
constexpr size_t WS_WIN = WS_WDEAD;
constexpr size_t WS_WOUT = WS_WIN + 9 * MiB;
constexpr size_t WS_WUQ = WS_WOUT + 4 * MiB;
constexpr size_t WS_WUKV = WS_WUQ + 512 * 1024;
constexpr size_t WS_WFGU = WS_WUKV + 512 * 1024;
constexpr size_t WS_WFDN = WS_WFGU + 11 * MiB;
constexpr size_t WS_ACT = 205 * MiB;
static_assert(WS_WFDN + (size_t)1024 * 2816 * 2 <= WS_ACT, "weights fit");
constexpr size_t WS_ACT1 = WS_ACT;
constexpr size_t WS_P = WS_ACT + 33 * MiB;
constexpr size_t WS_QKV = WS_ACT + 108 * MiB;
constexpr size_t WS_PART = WS_ACT + 128 * MiB;
constexpr size_t WS_HIDF = WS_P;
constexpr size_t WS_HIDM = WS_WDEAD;
constexpr size_t WS_ASORT = WS_HIDM + 238 * MiB;
constexpr size_t WS_END = WS_ASORT + 68 * MiB;
static_assert(WS_QKV + 91 * MiB <= WS_END, "qkv fits");

struct Params { const float* in[32]; float* out; unsigned char* ws; };

struct QKVB { bf16_t *QA, *KA, *VA, *QB, *KB, *VB, *QC, *KC, *VC, *QD, *KD, *VD, *QAc, *QBc, *QCc, *QDc; };
__host__ __device__ inline QKVB make_qkv(unsigned char* ws) {
    QKVB q; bf16_t* p = (bf16_t*)(ws + WS_QKV);
    q.QA = p; p += (size_t)NB * 4 * SEQ * 64; q.KA = p; p += (size_t)NB * 2 * KEYS * 64; q.VA = p; p += (size_t)NB * 2 * KEYS * 64;
    q.QB = p; p += (size_t)NB * 4 * SEQ * 64; q.KB = p; p += (size_t)NB * 2 * KEYS * 64; q.VB = p; p += (size_t)NB * 2 * KEYS * 64;
    q.QC = p; p += (size_t)NB * 4 * SEQ * 64; q.KC = p; p += (size_t)NB * 4 * KEYS * 64; q.VC = p; p += (size_t)NB * 4 * KEYS * 64;
    q.QD = p; p += (size_t)NB * 4 * SEQ * 96; q.KD = p; p += (size_t)NB * 4 * KEYS * 96; q.VD = p; p += (size_t)NB * 4 * KEYS * 64;
    q.QAc = p; p += (size_t)NB * 4 * CTX * 64; q.QBc = p; p += (size_t)NB * 4 * CTX * 64; q.QCc = p; p += (size_t)NB * 4 * CTX * 64;
    q.QDc = p; p += (size_t)NB * 4 * CTX * 96;
    return q;
}

__device__ __forceinline__ float bf2f(unsigned v) { return __uint_as_float(v << 16); }
__device__ __forceinline__ float bflo(unsigned w) { return __uint_as_float(w << 16); }
__device__ __forceinline__ float bfhi(unsigned w) { return __uint_as_float(w & 0xffff0000u); }
__device__ __forceinline__ unsigned f2bf(float f) { unsigned u = __float_as_uint(f); return (u + 0x7fffu + ((u >> 16) & 1u)) >> 16; }
typedef float pk_f32x2 __attribute__((ext_vector_type(2))); typedef __bf16 pk_bf16x2 __attribute__((ext_vector_type(2)));
__device__ __forceinline__ unsigned pk2(float lo, float hi) { pk_f32x2 v = {lo, hi}; pk_bf16x2 b = __builtin_convertvector(v, pk_bf16x2); return __builtin_bit_cast(unsigned, b); }
template <int X> __device__ __forceinline__ float swz_xor(float v) { return __int_as_float(__builtin_amdgcn_ds_swizzle(__float_as_int(v), 0x1f | (X << 10))); }
__device__ __forceinline__ float half_sum(float v) { auto rr = __builtin_amdgcn_permlane32_swap(__float_as_uint(v), __float_as_uint(v), false, false); return __uint_as_float(rr[0]) + __uint_as_float(rr[1]); }
__device__ __forceinline__ float half_other(float v, int lane) { auto rr = __builtin_amdgcn_permlane32_swap(__float_as_uint(v), __float_as_uint(v), false, false); return __uint_as_float((lane & 32) ? rr[0] : rr[1]); }
__device__ __forceinline__ float wave_sum(float v) { v += swz_xor<1>(v); v += swz_xor<2>(v); v += swz_xor<4>(v); v += swz_xor<8>(v); v += swz_xor<16>(v); return half_sum(v); }
__device__ __forceinline__ float half_max(float v) { auto rr = __builtin_amdgcn_permlane32_swap(__float_as_uint(v), __float_as_uint(v), false, false); return fmaxf(__uint_as_float(rr[0]), __uint_as_float(rr[1])); }
__device__ __forceinline__ int opq(int v) { asm volatile("" : "+v"(v)); return v; }
template <class T> __device__ __forceinline__ T* opqp(T* p) { asm volatile("" : "+s"(p)); return p; }
__device__ __forceinline__ int opqs(int v) { asm volatile("" : "+s"(v)); return v; }
__device__ __forceinline__ float silu_f(float x) { return x / (1.f + expf(-x)); }
__device__ __forceinline__ float silu_fast(float x) { return x * __builtin_amdgcn_rcpf(1.f + __builtin_amdgcn_exp2f(-1.4426950408889634f * x)); }

constexpr int RT_R64 = 0, RT_C64 = 2048, RT_R32 = 3072, RT_C32 = 4096, RT_N = 4608;

namespace pg8 {
#define PG8_LAS __attribute__((address_space(3)))
typedef unsigned short bf16_t;
typedef short bf16x8 __attribute__((ext_vector_type(8)));
typedef float f32x4 __attribute__((ext_vector_type(4)));
typedef unsigned u32x4 __attribute__((ext_vector_type(4)));
constexpr int BM = 256, BK = 64, HALF = 128, HTB = HALF * BK * 2  , STAGE_BYTES = 8 * HTB, NXCD = 8, WGM = 8;

__host__ __device__ __forceinline__ int lds_byte(int r, int c) { const int st = (r >> 4) * 2 + (c >> 5), rr = r & 15, cc = c & 31, ob = rr * 64 + cc * 2; return st * 1024 + (ob ^ (((ob >> 9) & 1) << 5)); }
__host__ __device__ __forceinline__ void stage_rc(int b, int& R, int& C) { const int st = b / 1024, sb = b % 1024, swz = sb ^ (((sb >> 9) & 1) << 5); R = (st >> 1) * 16 + swz / 64; C = (st & 1) * 32 + (swz % 64) / 2; }
__host__ __device__ __forceinline__ int perm32(int rho) { const int n = rho >> 4, i = rho & 15; return 8 * (i >> 2) + 4 * n + (i & 3); }

struct Unit { int pm, pn, e, ks; };
struct Gemm { const bf16_t* A; const bf16_t* Bt; int K; size_t estride; int Kloop; };

struct StaticOrder {
    int nM, nN, nwg, G, c, S, pm0; const int* texp;
    __host__ __device__ void init(int nM_, int nN_, int G_, int c_, const int* texp_, int S_ = 1, int pm0_ = 0) { nM = nM_; nN = nN_; nwg = nM * nN; G = G_; c = c_; texp = texp_; S = S_; pm0 = pm0_; }
    __host__ __device__ bool next(int i, Unit& u) const {
        const long L = (long)i * G + c; if (L >= (long)nwg * S) return false;
        u.ks = (int)(L % S); int wgid = (int)(L / S); { const int q = nwg / NXCD, r = nwg % NXCD, xcd = wgid % NXCD, off = wgid / NXCD; wgid = (xcd < r ? xcd * (q + 1) : r * (q + 1) + (xcd - r) * q) + off; }
        const int nig = WGM * nN, gid = wgid / nig, fm = gid * WGM, gsz = (nM - fm) < WGM ? (nM - fm) : WGM;
        u.pm = fm + ((wgid % nig) % gsz); u.pn = (wgid % nig) / gsz; u.e = texp ? texp[u.pm] : 0; u.pm += pm0; return true;
    }
    __device__ __forceinline__ void a_ready(const Unit&) const {}
    __device__ __forceinline__ void done(const Unit&) const {}
};

template <class Epi, class Sched, bool ALIGN_EPI = false, bool SP2 = false>
__device__ __forceinline__ void gemm_phase(PG8_LAS unsigned char* lds, const Gemm g, const Sched& S, const Epi& E) {
    const int tid = opq((int)threadIdx.x), wid = __builtin_amdgcn_readfirstlane(tid >> 6), lane = tid & 63, wr = wid >> 2, wc = wid & 3, fr = lane & 15, fq = lane >> 4;
    const int K = g.K, nt = g.Kloop / BK;
    unsigned voffA[2], voffB[2];
#pragma unroll
    for (int i = 0; i < 2; ++i) { int R, C; stage_rc(tid * 16 + i * 8192, R, C); const int Rb = Epi::PERM ? ((R & ~31) + perm32(R & 31)) : R;
        voffA[i] = (unsigned)(R * K + C) * 2u; voffB[i] = (unsigned)(Rb * K + C) * 2u; }
    const size_t kstep = (size_t)(BK * 2);
    const size_t hstep = (size_t)HALF * K * 2;
    const size_t tstep = 2 * hstep;
    const unsigned ldsw = (unsigned)wid * 1024u;
    const int aoff = lds_byte(wr * 64 + fr, fq * 8), boff = lds_byte(wc * 32 + fr, fq * 8);
#define PG8_SA(b, h) (((b) * 2 + (h)) * HTB)
#define PG8_SB(b, h) ((4 + (b) * 2 + (h)) * HTB)
#define PG8_STAGE(bufoff, gbase, voff) do { _Pragma("unroll") for (int _i = 0; _i < 2; ++_i) \
        __builtin_amdgcn_global_load_lds((const unsigned*)((const char*)(gbase) + (voff)[_i]), (PG8_LAS unsigned*)(lds + (bufoff) + ldsw + _i * 8192), 16, 0, 0); } while (0)
#define PG8_LDA(dst, b, h) do { _Pragma("unroll") for (int m = 0; m < 4; ++m) _Pragma("unroll") for (int k = 0; k < 2; ++k) dst[m][k] = *(const PG8_LAS bf16x8*)(lds + PG8_SA(b, h) + aoff + m * 2048 + k * 1024); } while (0)
#define PG8_LDB(dst, b, h) do { _Pragma("unroll") for (int n = 0; n < 2; ++n) _Pragma("unroll") for (int k = 0; k < 2; ++k) dst[n][k] = *(const PG8_LAS bf16x8*)(lds + PG8_SB(b, h) + boff + n * 2048 + k * 1024); } while (0)
#define PG8_MMA(ai, bj, At, Bt) do { __builtin_amdgcn_s_setprio(1); _Pragma("unroll") for (int m = 0; m < 4; ++m) _Pragma("unroll") for (int n = 0; n < 2; ++n) _Pragma("unroll") for (int k = 0; k < 2; ++k) \
        acc[ai][bj][m][n] = __builtin_amdgcn_mfma_f32_16x16x32_bf16(Bt[n][k], At[m][k], acc[ai][bj][m][n], 0, 0, 0); __builtin_amdgcn_s_setprio(0); } while (0)
#define PG8_WAIT_V(n) asm volatile("s_waitcnt vmcnt(" #n ")" ::: "memory")
#define PG8_WAIT_L(n) asm volatile("s_waitcnt lgkmcnt(" #n ")" ::: "memory")
#define PG8_BAR __builtin_amdgcn_s_barrier()
#define PG8_SCHED __builtin_amdgcn_sched_barrier(0)
    Unit cur, nxt; int ui = 0;
    if (!S.next(0, cur)) return;
    f32x4 acc[2][2][4][2];
#pragma unroll
    for (int a = 0; a < 2; ++a)
#pragma unroll
        for (int b = 0; b < 2; ++b)
#pragma unroll
            for (int m = 0; m < 4; ++m)
#pragma unroll
                for (int n = 0; n < 2; ++n) acc[a][b][m][n] = (f32x4){0.f, 0.f, 0.f, 0.f};
    bf16x8 At[4][2], B0[2][2], B1[2][2];
    const char* cA = (const char*)g.A + (size_t)cur.pm * tstep + (size_t)cur.ks * g.Kloop * 2; const char* cB = (const char*)g.Bt + (size_t)cur.e * g.estride + (size_t)cur.pn * tstep + (size_t)cur.ks * g.Kloop * 2;
    S.a_ready(cur);
    if constexpr (SP2) {
        PG8_STAGE(PG8_SB(0, 0), cB, voffB); PG8_STAGE(PG8_SB(0, 1), cB + hstep, voffB); PG8_STAGE(PG8_SA(0, 0), cA, voffA); PG8_STAGE(PG8_SA(0, 1), cA + hstep, voffA);
        if (wr == 1) PG8_BAR;
        PG8_WAIT_V(2); PG8_BAR;
        PG8_STAGE(PG8_SB(1, 0), cB + kstep, voffB); PG8_STAGE(PG8_SA(1, 0), cA + kstep, voffA); PG8_STAGE(PG8_SB(1, 1), cB + hstep + kstep, voffB);
        PG8_WAIT_V(6); PG8_BAR;
    } else {
        PG8_STAGE(PG8_SB(0, 0), cB, voffB); PG8_STAGE(PG8_SA(0, 0), cA, voffA); PG8_STAGE(PG8_SB(0, 1), cB + hstep, voffB); PG8_STAGE(PG8_SA(0, 1), cA + hstep, voffA);
        if (wr == 1) PG8_BAR;
        PG8_WAIT_V(4); PG8_BAR;
        PG8_STAGE(PG8_SB(1, 0), cB + kstep, voffB); PG8_STAGE(PG8_SA(1, 0), cA + kstep, voffA); PG8_STAGE(PG8_SB(1, 1), cB + hstep + kstep, voffB);
        PG8_WAIT_V(6); PG8_BAR;
    }
    for (;;) {
        const bool has_next = S.next(ui + 1, nxt);
        const char* nA = has_next ? (const char*)g.A + (size_t)nxt.pm * tstep + (size_t)nxt.ks * g.Kloop * 2 : cA; const char* nB = has_next ? (const char*)g.Bt + (size_t)nxt.e * g.estride + (size_t)nxt.pn * tstep + (size_t)nxt.ks * g.Kloop * 2 : cB;
        for (int t = 0; t < nt; t += 2) {
            const bool last = (t == nt - 2);
            const char* a1 = cA + (size_t)(t + 1) * kstep;
            const char* a2 = last ? nA : cA + (size_t)(t + 2) * kstep; const char* b2 = last ? nB : cB + (size_t)(t + 2) * kstep;
            const char* a3 = a2 + kstep; const char* b3 = b2 + kstep;
            if (last && has_next) S.a_ready(nxt);
            if constexpr (SP2) {
            PG8_LDB(B0, 0, 0); PG8_LDB(B1, 0, 1); PG8_SCHED; PG8_LDA(At, 0, 0); PG8_STAGE(PG8_SA(1, 1), a1 + hstep, voffA);
            PG8_WAIT_V(8); PG8_WAIT_L(0); PG8_BAR; PG8_MMA(0, 0, At, B0); PG8_MMA(0, 1, At, B1); PG8_BAR; PG8_SCHED;
            PG8_LDA(At, 0, 1); PG8_STAGE(PG8_SB(0, 0), b2, voffB); PG8_STAGE(PG8_SB(0, 1), b2 + hstep, voffB); PG8_STAGE(PG8_SA(0, 0), a2, voffA);
            PG8_WAIT_V(8); PG8_WAIT_L(0); PG8_BAR; PG8_MMA(1, 0, At, B0); PG8_MMA(1, 1, At, B1); PG8_BAR; PG8_SCHED;
            PG8_LDB(B0, 1, 0); PG8_LDB(B1, 1, 1); PG8_SCHED; PG8_LDA(At, 1, 0); PG8_STAGE(PG8_SA(0, 1), a2 + hstep, voffA);
            PG8_WAIT_V(8); PG8_WAIT_L(0); PG8_BAR; PG8_MMA(0, 0, At, B0); PG8_MMA(0, 1, At, B1); PG8_BAR; PG8_SCHED;
            PG8_LDA(At, 1, 1); PG8_STAGE(PG8_SB(1, 0), b3, voffB); PG8_STAGE(PG8_SB(1, 1), b3 + hstep, voffB); PG8_STAGE(PG8_SA(1, 0), a3, voffA);
            PG8_WAIT_V(8); PG8_WAIT_L(0); PG8_BAR; PG8_MMA(1, 0, At, B0); PG8_MMA(1, 1, At, B1); PG8_BAR; PG8_SCHED;
            } else {
            PG8_LDB(B0, 0, 0); PG8_SCHED; PG8_LDA(At, 0, 0); PG8_STAGE(PG8_SA(1, 1), a1 + hstep, voffA);
            PG8_WAIT_L(8); PG8_BAR; PG8_WAIT_L(0); PG8_MMA(0, 0, At, B0); PG8_BAR; PG8_SCHED;
            PG8_LDB(B1, 0, 1); PG8_STAGE(PG8_SB(0, 0), b2, voffB);
            PG8_BAR; PG8_WAIT_L(0); PG8_MMA(0, 1, At, B1); PG8_BAR;
            PG8_LDA(At, 0, 1); PG8_STAGE(PG8_SA(0, 0), a2, voffA);
            PG8_BAR; PG8_WAIT_L(0); PG8_MMA(1, 0, At, B0); PG8_BAR; PG8_SCHED;
            PG8_STAGE(PG8_SB(0, 1), b2 + hstep, voffB);
            PG8_WAIT_V(6); PG8_BAR; PG8_MMA(1, 1, At, B1); PG8_BAR;
            PG8_LDB(B0, 1, 0); PG8_SCHED; PG8_LDA(At, 1, 0); PG8_STAGE(PG8_SA(0, 1), a2 + hstep, voffA);
            PG8_WAIT_L(8); PG8_BAR; PG8_WAIT_L(0); PG8_MMA(0, 0, At, B0); PG8_BAR; PG8_SCHED;
            PG8_LDB(B1, 1, 1); PG8_STAGE(PG8_SB(1, 0), b3, voffB);
            PG8_BAR; PG8_WAIT_L(0); PG8_MMA(0, 1, At, B1); PG8_BAR;
            PG8_LDA(At, 1, 1); PG8_STAGE(PG8_SA(1, 0), a3, voffA);
            PG8_BAR; PG8_WAIT_L(0); PG8_MMA(1, 0, At, B0); PG8_BAR; PG8_SCHED;
            PG8_STAGE(PG8_SB(1, 1), b3 + hstep, voffB);
            PG8_WAIT_V(6); PG8_BAR; PG8_MMA(1, 1, At, B1); PG8_BAR;
            }
        }
        if constexpr (ALIGN_EPI) { if (wr == 0) PG8_BAR; }
        if constexpr (!Epi::AFTER_DRAIN) { E(acc, cur, wr, wc, fr, fq); S.done(cur); }
        if (!has_next) break;
#pragma unroll
        for (int a = 0; a < 2; ++a)
#pragma unroll
            for (int b = 0; b < 2; ++b)
#pragma unroll
                for (int m = 0; m < 4; ++m)
#pragma unroll
                    for (int n = 0; n < 2; ++n) acc[a][b][m][n] = (f32x4){0.f, 0.f, 0.f, 0.f};
        cur = nxt; cA = nA; cB = nB; ++ui;
        if constexpr (ALIGN_EPI) { if (wr == 1) PG8_BAR; }
    }
    PG8_WAIT_V(0);
    if constexpr (!ALIGN_EPI) { if (wr == 0) PG8_BAR; }
    PG8_BAR;
    if constexpr (Epi::AFTER_DRAIN) { E.fused(acc, cur, wr, wc, fr, fq, lds, wid, lane); S.done(cur); }
#undef PG8_SA
#undef PG8_SB
#undef PG8_STAGE
#undef PG8_LDA
#undef PG8_LDB
#undef PG8_MMA
#undef PG8_WAIT_V
#undef PG8_WAIT_L
#undef PG8_BAR
#undef PG8_SCHED
}
}

#define GAS __attribute__((address_space(1)))
#define LAS __attribute__((address_space(3)))
typedef GAS unsigned gu32;
#define RLX_AGENT __ATOMIC_RELAXED, __HIP_MEMORY_SCOPE_AGENT
constexpr int NWAVES = 8;
constexpr int CW_BAR = 4096;
constexpr int RING_BYTES = 131072, LDSCTL_OFF = RING_BYTES, MISC_OFF = LDSCTL_OFF + 320, LDS_BYTES = 147456;
constexpr size_t CTL_ZERO_BYTES = 65536;

#define XB_TMO      128
#define XB_XCNT(j)  (256  + 64 * (j))
#define XB_XSUB(j)  (1280 + 64 * (j))
#define XB_XGEN(j)  (2304 + 64 * (j))
#define XB_TOP      3328
#define XB_TOPGEN   3392
#define XCD_BAR_WORDS 3456
#define XB_SPIN_CAP (1u << 18)

__device__ __forceinline__ unsigned xb_ld(unsigned* p)              { return __hip_atomic_load(p, __ATOMIC_RELAXED, __HIP_MEMORY_SCOPE_AGENT); }
__device__ __forceinline__ unsigned xb_add(unsigned* p, unsigned v) { return __hip_atomic_fetch_add(p, v, __ATOMIC_RELAXED, __HIP_MEMORY_SCOPE_AGENT); }
__device__ __forceinline__ unsigned xb_xcc_id() { return (unsigned)__builtin_amdgcn_s_getreg((3 << 11) | 20) & 0xFu; }
#define XB_SPIN(cond, bar) do { unsigned _sp = 0; while (cond) { __builtin_amdgcn_s_sleep(1); \
    if ((++_sp & 255u) == 0u) { if (xb_ld(&(bar)[XB_TMO])) break; if (_sp > XB_SPIN_CAP) { atomicAdd(&(bar)[XB_TMO], 1u); break; } } } } while (0)

struct XcdBarrier {
    unsigned* bar; unsigned x;
    volatile LAS unsigned* st;
};

__device__ __forceinline__ XcdBarrier xcd_barrier_post(unsigned* bar, volatile LAS unsigned* st) {
    XcdBarrier b; b.bar = bar; b.x = xb_xcc_id(); b.st = st;
    if (threadIdx.x == 0) (void)xb_add(&bar[XB_XCNT(b.x)], 1u);
    return b;
}
__device__ __forceinline__ void xcd_barrier_complete(unsigned* bar, unsigned x, unsigned& nloc, unsigned& nx) {
    const unsigned G = gridDim.x * gridDim.y * gridDim.z;
    unsigned sum, cnt, mine, sp = 0u;
    for (;;) {
        sum = 0u; cnt = 0u; mine = 0u;
#pragma unroll
        for (unsigned j = 0; j < 16; ++j) { const unsigned c = xb_ld(&bar[XB_XCNT(j)]); sum += c; cnt += (c > 0u) ? 1u : 0u; mine = (j == x) ? c : mine; }
        if (sum == G) break;
        __builtin_amdgcn_s_sleep(1);
        if ((++sp & 255u) == 0u) { if (xb_ld(&bar[XB_TMO])) break; if (sp > XB_SPIN_CAP) { atomicAdd(&bar[XB_TMO], 1u); break; } }
    }
    nloc = mine > 0u ? mine : 1u; nx = cnt > 0u ? cnt : 1u;
}

__device__ __forceinline__ void xcd_barrier(const XcdBarrier& b) {
    asm volatile("s_waitcnt vmcnt(0)" ::: "memory");
    __syncthreads();
    if (threadIdx.x == 0) {
        unsigned* bar = b.bar;
        __builtin_amdgcn_s_waitcnt(0);
        unsigned nloc = b.st[0], nx = b.st[1];
        if (nloc == 0u) { xcd_barrier_complete(bar, b.x, nloc, nx); b.st[0] = nloc; b.st[1] = nx; }
        const unsigned old = xb_add(&bar[XB_XSUB(b.x)], 1u);
        const unsigned gen = old / nloc;
        if (old + 1u == (gen + 1u) * nloc) {
            __builtin_amdgcn_fence(__ATOMIC_RELEASE, "agent");
            asm volatile("s_waitcnt vmcnt(0)" ::: "memory");
            const unsigned og = xb_add(&bar[XB_TOP], 1u);
            const unsigned tg = og / nx;
            if (og + 1u == (tg + 1u) * nx) xb_add(&bar[XB_TOPGEN], 1u);
            else XB_SPIN(xb_ld(&bar[XB_TOPGEN]) == tg, bar);
            __builtin_amdgcn_fence(__ATOMIC_ACQUIRE, "agent");
            xb_add(&bar[XB_XGEN(b.x)], 1u);
            asm volatile("s_waitcnt vmcnt(0)" ::: "memory");
        } else {
            XB_SPIN(xb_ld(&bar[XB_XGEN(b.x)]) == gen, bar);
            __builtin_amdgcn_fence(__ATOMIC_ACQUIRE, "agent");
            asm volatile("s_waitcnt vmcnt(0)" ::: "memory");
        }
    }
    __syncthreads();
}


template <class F> struct EpiAdapt {
    static constexpr bool PERM = false, AFTER_DRAIN = false; F f;
    __device__ __forceinline__ void operator()(const pg8::f32x4 (&acc)[2][2][4][2], const pg8::Unit& u, int wr, int wc, int fr, int fq) const {
#pragma unroll
        for (int ai = 0; ai < 2; ++ai)
#pragma unroll
            for (int m = 0; m < 4; ++m) { const int row = u.pm * 256 + ai * 128 + wr * 64 + m * 16 + fr;
#pragma unroll
                for (int bj = 0; bj < 2; ++bj) f(row, u.pn * 8 + bj * 4 + wc, fq, acc[ai][bj][m][0], acc[ai][bj][m][1], u.ks);
                asm volatile("" ::: "memory"); }
    }
};
struct EpiBf16Perm { bf16_t* O; int ldo; int pad;
    __device__ __forceinline__ void operator()(int row, int g, int fq, f32x4 v0, f32x4 v1, int) const {
        u32x4 w; w.x = pk2(v0.x, v0.y); w.y = pk2(v0.z, v0.w); w.z = pk2(v1.x, v1.y); w.w = pk2(v1.z, v1.w);
        *(u32x4*)(O + (size_t)row * ldo + 32 * g + 8 * fq) = w; } };
struct EpiResid { const float* hl_in; const float* hc_in; float* hl_out; float* hc_out; const float* mod; int goff; int split;
    __device__ __forceinline__ void operator()(int row, int g, int fq, f32x4 v0, f32x4 v1, int ks) const {
        const int c0 = 32 * g + 4 * fq; const float* hin; float* hout; const float* gv;
        if (row < TL) { hin = hl_in + (size_t)row * D; hout = hl_out + (size_t)row * D; gv = mod + (row / SEQ) * 6144 + goff; }
        else { hin = hc_in + (size_t)(row - TL) * D; hout = hc_out + (size_t)(row - TL) * D; gv = mod + 2 * 6144 + goff; }
        if (split) { float* po = hout + (size_t)ks * TC * D; *(f32x4*)(po + c0) = *(const f32x4*)(gv + c0) * v0; *(f32x4*)(po + c0 + 16) = *(const f32x4*)(gv + c0 + 16) * v1; return; }
        *(f32x4*)(hout + c0) = *(const f32x4*)(hin + c0) + *(const f32x4*)(gv + c0) * v0;
        *(f32x4*)(hout + c0 + 16) = *(const f32x4*)(hin + c0 + 16) + *(const f32x4*)(gv + c0 + 16) * v1; } };
struct EpiSwiglu { bf16_t* H; int ldh; int pad;
    __device__ __forceinline__ void operator()(int row, int g, int fq, f32x4 v0, f32x4 v1, int) const {
        u32x2 w; w.x = pk2(silu_fast(v0.x) * v1.x, silu_fast(v0.y) * v1.y); w.y = pk2(silu_fast(v0.z) * v1.z, silu_fast(v0.w) * v1.w);
        *(u32x2*)(H + (size_t)row * ldh + 16 * g + 4 * fq) = w; } };

template <class F> __device__ __forceinline__ void run_gemm(LAS unsigned char* lds, const bf16_t* A, const bf16_t* Bt, int K, int nM, int nN, const int* texp, size_t estride_bytes, const F& f, int slices = 1, int pm0 = 0) {
    pg8::Gemm g{A, Bt, K, estride_bytes, K / slices}; pg8::StaticOrder S; S.init(nM, nN, opqs((int)gridDim.x), opqs((int)blockIdx.x), texp, slices, pm0);
    EpiAdapt<F> E{f};
    pg8::gemm_phase<EpiAdapt<F>, pg8::StaticOrder, true, true>(lds, g, S, E);
}
__device__ __forceinline__ bool gemm_tail_idle(int nwg) { const int G = opqs((int)gridDim.x), r = nwg % G; return r != 0 && opqs((int)blockIdx.x) >= r; }

__device__ __forceinline__ float conv_src(const Params& p, int mode, const float* W0, const float* W1, int N, int nvalid, int k, int nb) {
    if (mode == 0) return W0[(size_t)k * N + nb];
    if (mode == 1) { const int col = (nb & ~31) + 8 * ((nb >> 2) & 3) + 4 * ((nb >> 4) & 1) + (nb & 3); return col < nvalid ? W0[(size_t)k * N + col] : 0.f; }
    const int col = 16 * (nb >> 5) + (nb & 15); return ((nb >> 4) & 1) ? W1[(size_t)k * N + col] : W0[(size_t)k * N + col];
}
constexpr int CT_WIN = 0, CT_WOUT = 2304, CT_WUQ = 3328, CT_WUKV = 3400, CT_WFGU = 3464, CT_WFDN = 6280, CT_WMGU = 7688, CT_WMDN = 36360, CT_END = 50696;
constexpr int IT_MODS = 192, IT_ROPE = 9;
__device__ __forceinline__ void conv_item(const Params& p, int it, float* scr, int lane) {
    int t = it;
    bf16_t* dst; const float* W0; const float* W1 = nullptr; int K, N, nvalid = 0, mode;
    if (t < CT_WOUT) { const int l = t / 1152; t %= 1152; dst = (bf16_t*)(p.ws + WS_WIN) + (size_t)l * NINP * D; W0 = p.in[8] + (size_t)l * D * NIN; K = D; N = NIN; nvalid = NIN; mode = 1; }
    else if (t < CT_WUQ) { t -= CT_WOUT; const int l = t / 512; t %= 512; dst = (bf16_t*)(p.ws + WS_WOUT) + (size_t)l * D * D; W0 = p.in[24] + (size_t)l * D * D; K = D; N = D; mode = 0; }
    else if (t < CT_WUKV) { t -= CT_WUQ; const int l = t / 36; t %= 36; dst = (bf16_t*)(p.ws + WS_WUQ) + (size_t)l * 384 * 192; W0 = p.in[18] + (size_t)l * 192 * 384; K = 192; N = 384; mode = 0; }
    else if (t < CT_WFGU) { t -= CT_WUKV; const int l = t / 32; t %= 32; dst = (bf16_t*)(p.ws + WS_WUKV) + (size_t)l * 512 * 128; W0 = p.in[20] + (size_t)l * 128 * 512; K = 128; N = 512; mode = 0; }
    else if (t < CT_WFDN) { t -= CT_WFGU; dst = (bf16_t*)(p.ws + WS_WFGU); W0 = p.in[25]; W1 = p.in[26]; K = D; N = DFF; mode = 2; }
    else if (t < CT_WMGU) { t -= CT_WFDN; dst = (bf16_t*)(p.ws + WS_WFDN); W0 = p.in[27]; K = DFF; N = D; mode = 0; }
    else if (t < CT_WMDN) { t -= CT_WMGU; const int e = t / 3584; t %= 3584; dst = (bf16_t*)(p.ws + WS_WMGU) + (size_t)e * 2 * DFFE * D; W0 = p.in[29] + (size_t)e * D * DFFE; W1 = p.in[30] + (size_t)e * D * DFFE; K = D; N = DFFE; mode = 2; }
    else { t -= CT_WMDN; const int e = t / 1792; t %= 1792; dst = (bf16_t*)(p.ws + WS_WMDN) + (size_t)e * D * DFFE; W0 = p.in[31] + (size_t)e * DFFE * D; K = DFFE; N = D; nvalid = D; mode = 1; }
    const int ktl = K / 64, n0 = (t / ktl) * 32, k0 = (t % ktl) * 64;
    const int n4 = lane & 7; const float* src; bool valid = true; int ln;
    if (mode == 0) { src = W0 + n0 + 4 * n4; ln = 4 * n4; }
    else if (mode == 1) { const int col = n0 + 4 * n4; valid = col < nvalid; src = W0 + (valid ? col : 0); ln = 16 * (n4 & 1) + 4 * (n4 >> 1); }
    else { src = ((n4 >> 2) ? W1 : W0) + 16 * (n0 >> 5) + 4 * (n4 & 3); ln = 16 * (n4 >> 2) + 4 * (n4 & 3); }
    src += (size_t)(k0 + (lane >> 3)) * N;
    f32x4 v[8];
#pragma unroll
    for (int i = 0; i < 8; ++i) v[i] = valid ? *(const f32x4*)(src + (size_t)(8 * i) * N) : (f32x4){0.f, 0.f, 0.f, 0.f};
#pragma unroll
    for (int i = 0; i < 8; ++i) *(f32x4*)(scr + ((lane >> 3) + 8 * i) * 36 + ln) = v[i];
    const int c = lane & 7;
#pragma unroll
    for (int j = 0; j < 4; ++j) { const int n = (lane >> 3) + 8 * j; const float* sp = scr + (8 * c) * 36 + n;
        u32x4 o; o.x = pk2(sp[0 * 36], sp[1 * 36]); o.y = pk2(sp[2 * 36], sp[3 * 36]); o.z = pk2(sp[4 * 36], sp[5 * 36]); o.w = pk2(sp[6 * 36], sp[7 * 36]);
        *(u32x4*)(dst + (size_t)(n0 + n) * K + k0 + 8 * c) = o; }
}
constexpr int CW_FILL = 1024;
__device__ __forceinline__ void fill_moe(const Params& p, float* lds, int quota) {
    const int tid = opq((int)threadIdx.x), lane = tid & 63, wv = tid >> 6;
    float* scr = lds + wv * (64 * 36); volatile int* slot = (volatile int*)(lds + 8 * 64 * 36);
    constexpr int NIT = CT_END - CT_WMGU;
    for (;;) {
        const int claim = quota > 64 ? 4 : quota;
        __syncthreads();
        if (tid == 0) *slot = (int)atomicAdd((unsigned*)(p.ws + WS_CTL) + CW_FILL, 8u * (unsigned)claim);
        __syncthreads();
        const int idx = *slot;
        if (idx >= NIT) break;
        const int end = min(idx + 8 * claim, NIT);
        for (int it = idx + wv; it < end; it += 8) conv_item(p, CT_WMGU + it, scr, lane);
        if (quota <= 64) break;
    }
    __syncthreads();
}
__device__ __forceinline__ void ph_prologue(const Params& p, float* lds) {
    const int tid = opq((int)threadIdx.x), lane = tid & 63, wv = tid >> 6;
    for (int it = blockIdx.x; it < IT_MODS + IT_ROPE; it += gridDim.x) {
        if (it < IT_MODS) {
            const int l = it / 96, n0 = (it % 96) * 64, nn = tid & 63, kc = tid >> 6;
            float* sv = lds; float* red = lds + 3 * 1024;
            __syncthreads();
            for (int i = tid; i < 3 * 1024; i += 512) { const int v = i >> 10, k = i & 1023; const float x = (v < 2) ? p.in[1][v * D + k] : p.in[3][k]; sv[i] = silu_f(x); }
            __syncthreads();
            const float* w = p.in[4] + ((size_t)l * D + kc * 128) * 6144 + n0 + nn;
            float a0 = 0.f, a1 = 0.f, a2 = 0.f;
#pragma unroll 8
            for (int k = 0; k < 128; ++k) { const float wv_ = w[(size_t)k * 6144]; a0 += sv[kc * 128 + k] * wv_; a1 += sv[1024 + kc * 128 + k] * wv_; a2 += sv[2048 + kc * 128 + k] * wv_; }
            red[(kc * 3 + 0) * 64 + nn] = a0; red[(kc * 3 + 1) * 64 + nn] = a1; red[(kc * 3 + 2) * 64 + nn] = a2;
            __syncthreads();
            if (tid < 192) { const int v = tid >> 6; float s = p.in[5][l * 6144 + n0 + nn];
#pragma unroll
                for (int q = 0; q < 8; ++q) s += red[(q * 3 + v) * 64 + nn];
                ((float*)(p.ws + WS_MOD))[((size_t)l * 3 + v) * 6144 + n0 + nn] = s; }
        } else {
            const int idx = (it - IT_MODS) * 512 + tid;
            if (idx < RT_N) {
                int pos, i, nf;
                if (idx < RT_C64) { pos = idx / 16; i = idx % 16; nf = 16; }
                else if (idx < RT_R32) { pos = (idx - RT_C64) / 16; i = idx % 16; nf = 16; }
                else if (idx < RT_C32) { pos = (idx - RT_R32) / 8; i = idx % 8; nf = 8; }
                else { pos = (idx - RT_C32) / 8; i = idx % 8; nf = 8; }
                const float inv = powf(10000.0f, -(float)i / (float)nf);
                const float ang = (float)pos * inv;
                const float rev = ang * 0.15915494309189535f;
                ((float2*)(p.ws + WS_ROPE))[idx] = make_float2(__builtin_amdgcn_cosf(rev), __builtin_amdgcn_sinf(rev));
            }
        }
    }
    __syncthreads();
    for (int i = blockIdx.x * 512 + tid; i < TC * D / 4; i += gridDim.x * 512) ((f32x4*)(p.ws + WS_HCTX))[i] = ((const f32x4*)p.in[2])[i];
    float* scr = lds + wv * (64 * 36);
    for (int it = wv * gridDim.x + blockIdx.x; it < CT_WMGU; it += 8 * gridDim.x) conv_item(p, it, scr, lane);
    __syncthreads();
}

template <int WHICH, bool ROUTER> __device__ __forceinline__ void ph_norm(const Params& p, int layer, int nrows, unsigned* lcnt, int nslab) {
    const int tx = opq((int)threadIdx.x), lane = tx & 63, gw = (blockIdx.x * 512 + tx) >> 6, ngw = (gridDim.x * 512) >> 6;
    if (ROUTER) { if (tx < 16) lcnt[tx] = 0u; __syncthreads(); }
    const float* hl = (layer == 0 && WHICH == 1) ? p.in[0] : p.out;
    const float* hc = (layer == 0 && WHICH == 1) ? p.in[2] : (const float*)(p.ws + WS_HCTX);
    const float* gain = p.in[WHICH == 1 ? 6 : 7] + layer * D;
    const float* mod = (const float*)(p.ws + WS_MOD) + (size_t)layer * 3 * 6144;
    bf16_t* dst = (bf16_t*)(p.ws + WS_ACT1);
    for (int m = gw; m < nrows; m += ngw) {
        const float* src = (m < TL) ? hl + (size_t)m * D : hc + (size_t)(m - TL) * D;
        const float* mv = mod + (m < TL ? m / SEQ : 2) * 6144;
        const float* shp = mv + (WHICH == 1 ? 0 : 3) * D; const float* scp = mv + (WHICH == 1 ? 1 : 4) * D;
        f32x4 v[4]; float ss = 0.f;
#pragma unroll
        for (int j = 0; j < 4; ++j) v[j] = *(const f32x4*)(src + 256 * j + 4 * lane);
        if (!ROUTER && m >= TL && nslab > 0) {
            const float* pp = (const float*)(p.ws + WS_PART) + (size_t)(m - TL) * D + 4 * lane;
            for (int sl = 0; sl < nslab; ++sl) {
#pragma unroll
                for (int j = 0; j < 4; ++j) v[j] = v[j] + *(const f32x4*)(pp + (size_t)sl * TC * D + 256 * j); }
#pragma unroll
            for (int j = 0; j < 4; ++j) *(f32x4*)((float*)(p.ws + WS_HCTX) + (size_t)(m - TL) * D + 256 * j + 4 * lane) = v[j];
        }
#pragma unroll
        for (int j = 0; j < 4; ++j) ss += v[j].x * v[j].x + v[j].y * v[j].y + v[j].z * v[j].z + v[j].w * v[j].w;
        const float rstd = rsqrtf(wave_sum(ss) * (1.f / D) + EPS);
        float lg[8];
#pragma unroll
        for (int e = 0; e < 8; ++e) lg[e] = 0.f;
#pragma unroll
        for (int j = 0; j < 4; ++j) {
            const int c = 256 * j + 4 * lane;
            const f32x4 g = *(const f32x4*)(gain + c), sh = *(const f32x4*)(shp + c), sc = *(const f32x4*)(scp + c);
            f32x4 f = v[j] * rstd * g * (sc + 1.f) + sh;
            u32x2 w; w.x = pk2(f.x, f.y); w.y = pk2(f.z, f.w);
            *(u32x2*)(dst + (size_t)m * D + c) = w;
            if (ROUTER) {
                const float* rt = p.in[28] + (size_t)c * 8;
#pragma unroll
                for (int i = 0; i < 4; ++i) { const f32x4 r0 = *(const f32x4*)(rt + 8 * i), r1 = *(const f32x4*)(rt + 8 * i + 4); const float fv = f[i];
                    lg[0] += fv * r0.x; lg[1] += fv * r0.y; lg[2] += fv * r0.z; lg[3] += fv * r0.w; lg[4] += fv * r1.x; lg[5] += fv * r1.y; lg[6] += fv * r1.z; lg[7] += fv * r1.w; }
            }
        }
        if (ROUTER) {
#pragma unroll
            for (int e = 0; e < 8; ++e) lg[e] = wave_sum(lg[e]);
            if (lane == 0) {
                int e0 = 0; float v0 = lg[0];
#pragma unroll
                for (int e = 1; e < 8; ++e) if (lg[e] > v0) { v0 = lg[e]; e0 = e; }
                int e1 = -1; float v1 = -INFINITY;
#pragma unroll
                for (int e = 0; e < 8; ++e) if (e != e0 && lg[e] > v1) { v1 = lg[e]; e1 = e; }
                const float t = expf(v1 - v0), g0 = 1.f / (1.f + t), g1 = t / (1.f + t);
                const int p0 = (int)atomicAdd(&lcnt[e0], 1u), p1 = (int)atomicAdd(&lcnt[e1], 1u);
                ((int2*)(p.ws + WS_TOKE))[m] = make_int2(e0, e1); ((int2*)(p.ws + WS_TOKP))[m] = make_int2(p0, p1); ((float2*)(p.ws + WS_TOKG))[m] = make_float2(g0, g1);
            }
        }
    }
    if (ROUTER) {
        __syncthreads();
        if (tx < 8) lcnt[8 + tx] = atomicAdd((unsigned*)(p.ws + WS_CTL) + 64 * tx, lcnt[tx]);
        __syncthreads();
        if (lane == 0) for (int m = gw; m < nrows; m += ngw) {
            const int2 e = ((const int2*)(p.ws + WS_TOKE))[m]; int2 ps = ((const int2*)(p.ws + WS_TOKP))[m];
            ps.x += (int)lcnt[8 + e.x]; ps.y += (int)lcnt[8 + e.y]; ((int2*)(p.ws + WS_TOKP))[m] = ps; }
        __syncthreads();
    }
}


typedef short pp_bf16x8 __attribute__((ext_vector_type(8)));
__device__ __forceinline__ float quad_sum(float v) { v += swz_xor<1>(v); v += swz_xor<2>(v); return v; }
__device__ __forceinline__ float kg_sum(float v) { v += swz_xor<16>(v); return half_sum(v); }
constexpr float QS64 = 0.125f * 1.4426950408889634f, QS96 = 0.10206207261596575f * 1.4426950408889634f;

template <int HS> __device__ __forceinline__ void pp_head(const Params& p, const QKVB& qb, int layer, const bf16_t* prow, bool lat, int b, int s, int key, int sub,
                                                          const float2 (&rr)[4], const float2 (&rc)[4]) {
    constexpr bool ISV = HS >= 20;
    constexpr int col = HS < 4 ? OFF_AQ + 64 * HS : HS < 6 ? OFF_AK + 64 * (HS - 4) : HS < 10 ? OFF_BQ + 64 * (HS - 6) : HS < 12 ? OFF_BK + 64 * (HS - 10) : HS < 16 ? OFF_CQ + 64 * (HS - 12) :
                        HS < 20 ? OFF_CK + 64 * (HS - 16) : HS < 22 ? OFF_AV + 64 * (HS - 20) : HS < 24 ? OFF_BV + 64 * (HS - 22) : OFF_CV + 64 * (HS - 24);
    constexpr bool ISQ = HS < 4 || (HS >= 6 && HS < 10) || (HS >= 12 && HS < 16);
    constexpr bool ROPE = HS < 12;
    constexpr int GIN = HS < 4 ? 9 : HS < 6 ? 10 : HS < 10 ? 12 : HS < 12 ? 13 : HS < 16 ? 14 : 15;
    bf16_t* dst;
    if (HS < 4) dst = lat ? qb.QA + ((size_t)(b * 4 + HS) * SEQ + s) * 64 : qb.QAc + ((size_t)(b * 4 + HS) * CTX + s) * 64;
    else if (HS < 6) dst = qb.KA + ((size_t)(b * 2 + HS - 4) * KEYS + key) * 64;
    else if (HS < 10) dst = lat ? qb.QB + ((size_t)(b * 4 + HS - 6) * SEQ + s) * 64 : qb.QBc + ((size_t)(b * 4 + HS - 6) * CTX + s) * 64;
    else if (HS < 12) dst = qb.KB + ((size_t)(b * 2 + HS - 10) * KEYS + key) * 64;
    else if (HS < 16) dst = lat ? qb.QC + ((size_t)(b * 4 + HS - 12) * SEQ + s) * 64 : qb.QCc + ((size_t)(b * 4 + HS - 12) * CTX + s) * 64;
    else if (HS < 20) dst = qb.KC + ((size_t)(b * 4 + HS - 16) * KEYS + key) * 64;
    else if (HS < 22) dst = qb.VA + ((size_t)(b * 2 + HS - 20) * KEYS + key) * 64;
    else if (HS < 24) dst = qb.VB + ((size_t)(b * 2 + HS - 22) * KEYS + key) * 64;
    else dst = qb.VC + ((size_t)(b * 4 + HS - 24) * KEYS + key) * 64;
    u32x2 w[4];
#pragma unroll
    for (int c = 0; c < 4; ++c) w[c] = *(const u32x2*)(prow + col + 16 * c + 4 * sub);
    if (!ISV) {
        f32x4 x[4]; float ss = 0.f;
#pragma unroll
        for (int c = 0; c < 4; ++c) { x[c] = (f32x4){bflo(w[c].x), bfhi(w[c].x), bflo(w[c].y), bfhi(w[c].y)}; ss += x[c].x * x[c].x + x[c].y * x[c].y + x[c].z * x[c].z + x[c].w * x[c].w; }
        const float r = rsqrtf(quad_sum(ss) * (1.f / 64.f) + EPS) * (ISQ ? QS64 : 1.f);
        const float* g = p.in[GIN] + layer * 64 + 4 * sub;
#pragma unroll
        for (int c = 0; c < 4; ++c) x[c] = x[c] * r * *(const f32x4*)(g + 16 * c);
        if (ROPE && lat) {
#pragma unroll
            for (int i = 0; i < 4; ++i) { const float a = x[0][i], bq = x[1][i]; x[0][i] = a * rr[i].x - bq * rr[i].y; x[1][i] = bq * rr[i].x + a * rr[i].y;
                const float c1 = x[2][i], c2 = x[3][i]; x[2][i] = c1 * rc[i].x - c2 * rc[i].y; x[3][i] = c2 * rc[i].x + c1 * rc[i].y; }
        }
#pragma unroll
        for (int c = 0; c < 4; ++c) { w[c].x = pk2(x[c].x, x[c].y); w[c].y = pk2(x[c].z, x[c].w); }
    }
#pragma unroll
    for (int c = 0; c < 4; ++c) *(u32x2*)(dst + 16 * c + 4 * sub) = w[c];
}
template <int HS> struct PPHeads { static __device__ __forceinline__ void run(const Params& p, const QKVB& qb, int layer, const bf16_t* prow, bool lat, int b, int s, int key, int sub, const float2 (&rr)[4], const float2 (&rc)[4]) {
    pp_head<HS>(p, qb, layer, prow, lat, b, s, key, sub, rr, rc); PPHeads<HS + 1>::run(p, qb, layer, prow, lat, b, s, key, sub, rr, rc); } };
template <> struct PPHeads<28> { static __device__ __forceinline__ void run(const Params&, const QKVB&, int, const bf16_t*, bool, int, int, int, int, const float2 (&)[4], const float2 (&)[4]) {} };

__device__ __forceinline__ void f8_from_bf(const u32x4 v, float (&x)[8]) { x[0] = bflo(v.x); x[1] = bfhi(v.x); x[2] = bflo(v.y); x[3] = bfhi(v.y); x[4] = bflo(v.z); x[5] = bfhi(v.z); x[6] = bflo(v.w); x[7] = bfhi(v.w); }

__device__ __forceinline__ void ph_postproj2(const Params& p, int layer) {
    const int tx = opq((int)threadIdx.x), lane = tx & 63, gw = (tx >> 6) * gridDim.x + blockIdx.x, ngw = gridDim.x * 8;
    const bf16_t* P = (const bf16_t*)(p.ws + WS_P);
    const QKVB qb = make_qkv(p.ws);
    const bf16_t* Wuq = (const bf16_t*)(p.ws + WS_WUQ) + (size_t)layer * 384 * 192;
    const bf16_t* Wukv = (const bf16_t*)(p.ws + WS_WUKV) + (size_t)layer * 512 * 128;
    const float2* rope = (const float2*)(p.ws + WS_ROPE);
    for (int su = gw; su < 5 * (MALL / 16); su += ngw) {
        const int kind = __builtin_amdgcn_readfirstlane(su / (MALL / 16)), u = su - kind * (MALL / 16);
        const int m0 = u * 16; const bool lat = m0 < TL;
        if (kind == 0) {
            const int t = lane >> 2, sub = lane & 3, m = m0 + t;
            const int b = lat ? m / SEQ : (m - TL) / CTX, s = lat ? m % SEQ : (m - TL) % CTX, key = lat ? CTX + s : s;
            float2 rr[4], rc[4];
#pragma unroll
            for (int i = 0; i < 4; ++i) { rr[i] = lat ? rope[RT_R64 + (s >> 6) * 16 + 4 * sub + i] : make_float2(1.f, 0.f); rc[i] = lat ? rope[RT_C64 + (s & 63) * 16 + 4 * sub + i] : make_float2(1.f, 0.f); }
            PPHeads<0>::run(p, qb, layer, P + (size_t)m * NINP, lat, b, s, key, sub, rr, rc);
        }
        else {
            const int tk = lane & 15, kg = lane >> 4, m = m0 + tk;
            const int b = lat ? m / SEQ : (m - TL) / CTX, s = lat ? m % SEQ : (m - TL) % CTX, key = lat ? CTX + s : s;
            const bf16_t* prow = P + (size_t)m * NINP;
            if (kind <= 2) {
            pp_bf16x8 aq[6];
            { float x[6][8]; float ss = 0.f;
#pragma unroll
                for (int ks = 0; ks < 6; ++ks) { f8_from_bf(*(const u32x4*)(prow + OFF_DCQ + 32 * ks + 8 * kg), x[ks]);
#pragma unroll
                    for (int j = 0; j < 8; ++j) ss += x[ks][j] * x[ks][j]; }
                const float r = rsqrtf(kg_sum(ss) * (1.f / 192.f) + EPS);
                const float* g = p.in[17] + layer * 192 + 8 * kg;
#pragma unroll
                for (int ks = 0; ks < 6; ++ks) { const f32x4 g0 = *(const f32x4*)(g + 32 * ks), g1 = *(const f32x4*)(g + 32 * ks + 4);
                    u32x4 w; w.x = pk2(x[ks][0] * r * g0.x, x[ks][1] * r * g0.y); w.y = pk2(x[ks][2] * r * g0.z, x[ks][3] * r * g0.w); w.z = pk2(x[ks][4] * r * g1.x, x[ks][5] * r * g1.y); w.w = pk2(x[ks][6] * r * g1.z, x[ks][7] * r * g1.w);
                    aq[ks] = __builtin_bit_cast(pp_bf16x8, w); } }
            float2 qr_[4], qc_[4];
#pragma unroll
            for (int reg = 0; reg < 4; ++reg) { const int i = (4 * kg + reg) & 7; qr_[reg] = lat ? rope[RT_R32 + (s >> 6) * 8 + i] : make_float2(1.f, 0.f); qc_[reg] = lat ? rope[RT_C32 + (s & 63) * 8 + i] : make_float2(1.f, 0.f); }
#pragma unroll 1
            for (int h = 2 * (kind - 1); h < 2 * kind; ++h) {
                f32x4 acc[6];
#pragma unroll
                for (int nb = 0; nb < 6; ++nb) { acc[nb] = (f32x4){0.f, 0.f, 0.f, 0.f};
                    const bf16_t* wp = Wuq + (size_t)(96 * h + 16 * nb + tk) * 192 + 8 * kg;
#pragma unroll
                    for (int ks = 0; ks < 6; ++ks) acc[nb] = __builtin_amdgcn_mfma_f32_16x16x32_bf16(*(const pp_bf16x8*)(wp + 32 * ks), aq[ks], acc[nb], 0, 0, 0); }
                float ss = 0.f;
#pragma unroll
                for (int nb = 0; nb < 6; ++nb) ss += acc[nb].x * acc[nb].x + acc[nb].y * acc[nb].y + acc[nb].z * acc[nb].z + acc[nb].w * acc[nb].w;
                const float r = rsqrtf(kg_sum(ss) * (1.f / 96.f) + EPS) * QS96;
                const float* g = p.in[21] + layer * 96 + 4 * kg;
                bf16_t* dst = (lat ? qb.QD + ((size_t)(b * 4 + h) * SEQ + s) * 96 : qb.QDc + ((size_t)(b * 4 + h) * CTX + s) * 96) + 4 * kg;
#pragma unroll
                for (int nb = 0; nb < 6; ++nb) { f32x4 y = acc[nb] * r * *(const f32x4*)(g + 16 * nb);
                    if (nb >= 4 && lat) {
#pragma unroll
                        for (int reg = 0; reg < 4; ++reg) { const float other = half_other(y[reg], lane); const float2 cs = nb == 4 ? qr_[reg] : qc_[reg];
                            y[reg] = (kg < 2) ? y[reg] * cs.x - other * cs.y : y[reg] * cs.x + other * cs.y; } }
                    u32x2 w; w.x = pk2(y.x, y.y); w.y = pk2(y.z, y.w); *(u32x2*)(dst + 16 * nb) = w; }
            }
            } else {
            pp_bf16x8 akv[4];
            { float x[4][8]; float ss = 0.f;
#pragma unroll
                for (int ks = 0; ks < 4; ++ks) { f8_from_bf(*(const u32x4*)(prow + OFF_DCKV + 32 * ks + 8 * kg), x[ks]);
#pragma unroll
                    for (int j = 0; j < 8; ++j) ss += x[ks][j] * x[ks][j]; }
                const float r = rsqrtf(kg_sum(ss) * (1.f / 128.f) + EPS);
                const float* g = p.in[19] + layer * 128 + 8 * kg;
#pragma unroll
                for (int ks = 0; ks < 4; ++ks) { const f32x4 g0 = *(const f32x4*)(g + 32 * ks), g1 = *(const f32x4*)(g + 32 * ks + 4);
                    u32x4 w; w.x = pk2(x[ks][0] * r * g0.x, x[ks][1] * r * g0.y); w.y = pk2(x[ks][2] * r * g0.z, x[ks][3] * r * g0.w); w.z = pk2(x[ks][4] * r * g1.x, x[ks][5] * r * g1.y); w.w = pk2(x[ks][6] * r * g1.z, x[ks][7] * r * g1.w);
                    akv[ks] = __builtin_bit_cast(pp_bf16x8, w); } }
            float kr[8]; f8_from_bf(*(const u32x4*)(prow + OFF_DKR + 8 * kg), kr);
            float krss = 0.f;
#pragma unroll
            for (int j = 0; j < 8; ++j) krss += kr[j] * kr[j];
            float2 kcs[8];
#pragma unroll
            for (int j = 0; j < 8; ++j) kcs[j] = !lat ? make_float2(1.f, 0.f) : (kg < 2 ? rope[RT_R32 + (s >> 6) * 8 + j] : rope[RT_C32 + (s & 63) * 8 + j]);
#pragma unroll 1
            for (int h = 2 * (kind - 3); h < 2 * (kind - 2); ++h) {
                f32x4 acc[8];
#pragma unroll
                for (int nb = 0; nb < 8; ++nb) { acc[nb] = (f32x4){0.f, 0.f, 0.f, 0.f};
                    const bf16_t* wp = Wukv + (size_t)(128 * h + 16 * nb + tk) * 128 + 8 * kg;
#pragma unroll
                    for (int ks = 0; ks < 4; ++ks) acc[nb] = __builtin_amdgcn_mfma_f32_16x16x32_bf16(*(const pp_bf16x8*)(wp + 32 * ks), akv[ks], acc[nb], 0, 0, 0); }
                float ss = krss;
#pragma unroll
                for (int nb = 0; nb < 4; ++nb) ss += acc[nb].x * acc[nb].x + acc[nb].y * acc[nb].y + acc[nb].z * acc[nb].z + acc[nb].w * acc[nb].w;
                const float r = rsqrtf(kg_sum(ss) * (1.f / 96.f) + EPS);
                const float* g = p.in[22] + layer * 96;
                bf16_t* kd = qb.KD + ((size_t)(b * 4 + h) * KEYS + key) * 96; bf16_t* vd = qb.VD + ((size_t)(b * 4 + h) * KEYS + key) * 64;
#pragma unroll
                for (int nb = 0; nb < 4; ++nb) { const f32x4 y = acc[nb] * r * *(const f32x4*)(g + 16 * nb + 4 * kg); u32x2 w; w.x = pk2(y.x, y.y); w.y = pk2(y.z, y.w); *(u32x2*)(kd + 16 * nb + 4 * kg) = w; }
                { float y[8];
#pragma unroll
                    for (int j = 0; j < 8; ++j) y[j] = kr[j] * r * g[64 + 8 * kg + j];
#pragma unroll
                    for (int j = 0; j < 8; ++j) { const float other = swz_xor<16>(y[j]); y[j] = (kg & 1) == 0 ? y[j] * kcs[j].x - other * kcs[j].y : y[j] * kcs[j].x + other * kcs[j].y; }
                    u32x4 w; w.x = pk2(y[0], y[1]); w.y = pk2(y[2], y[3]); w.z = pk2(y[4], y[5]); w.w = pk2(y[6], y[7]); *(u32x4*)(kd + 64 + 8 * kg) = w; }
#pragma unroll
                for (int nb = 4; nb < 8; ++nb) { const f32x4 y = acc[nb]; u32x2 w; w.x = pk2(y.x, y.y); w.y = pk2(y.z, y.w); *(u32x2*)(vd + 16 * (nb - 4) + 4 * kg) = w; }
            }
            }
        }
    }
}

namespace fa {
typedef short bf16x8 __attribute__((ext_vector_type(8)));
typedef short s16x4 __attribute__((ext_vector_type(4)));
typedef float f32x16 __attribute__((ext_vector_type(16)));
typedef __attribute__((address_space(3))) const char* lds_cptr;
typedef short v4i16_t __attribute__((ext_vector_type(4)));
constexpr int KSTG = 12288, VSTG = 8192, STG = KSTG + VSTG;
constexpr int LDS_WS = 2 * STG, LDS_OST = LDS_WS + 8 * 256, LDS_RPB = LDS_OST + 8 * 4096, LDS_TOTAL = LDS_RPB + 2048;
constexpr float LOG2E = 1.4426950408889634f;
constexpr float THR = 6.0f;
__device__ __forceinline__ int crow(int r, int hi) { return (r & 3) + 8 * (r >> 2) + 4 * hi; }
__device__ __forceinline__ void glds16(const void* gsrc, unsigned lds_dst) { unsigned keep;
    asm volatile("s_mov_b32 %0, m0\n\ts_mov_b32 m0, %2\n\ts_nop 0\n\tglobal_load_lds_dwordx4 %1, off\n\ts_mov_b32 m0, %0" : "=&s"(keep) : "v"(gsrc), "s"(lds_dst) : "memory"); }
__device__ __forceinline__ s16x4 vtr(lds_cptr p) { return __builtin_bit_cast(s16x4, __builtin_amdgcn_ds_read_tr16_b64_v4i16((__attribute__((address_space(3))) v4i16_t*)p)); }
typedef float f32x2_t __attribute__((ext_vector_type(2))); typedef __bf16 bf16x2_t __attribute__((ext_vector_type(2)));
__device__ __forceinline__ unsigned cvtpk(float lo, float hi) { f32x2_t v = {lo, hi}; bf16x2_t b = __builtin_convertvector(v, bf16x2_t); return __builtin_bit_cast(unsigned, b); }
__device__ __forceinline__ float xhalf_max(float m) { auto rr = __builtin_amdgcn_permlane32_swap(__float_as_uint(m), __float_as_uint(m), false, false); return fmaxf(__uint_as_float(rr[0]), __uint_as_float(rr[1])); }
__device__ __forceinline__ float xhalf_sum(float m) { auto rr = __builtin_amdgcn_permlane32_swap(__float_as_uint(m), __float_as_uint(m), false, false); return __uint_as_float(rr[0]) + __uint_as_float(rr[1]); }
#define FA_WAIT_BAR() asm volatile("s_waitcnt vmcnt(0) lgkmcnt(0)\n\ts_barrier" ::: "memory")

template <int DQK, int MODE>
__device__ __forceinline__ void attn_unit(const bf16_t* Qg, const bf16_t* Kg, const bf16_t* Vg, bf16_t* Og, int q0, float sink2, const float* rpb, char* shm) {
    const int tid = opq((int)threadIdx.x), lane = tid & 63, r32 = lane & 31, hi = lane >> 5; const int wid = __builtin_amdgcn_readfirstlane(tid >> 6);
    const unsigned lds0 = (unsigned)(uintptr_t)shm;
    float* wsf = (float*)(shm + LDS_WS) + wid * 64;
    constexpr int NCH = DQK / 8, ND0 = DQK / 16;
    int NT, wbase = 0;
    if (MODE == 0) NT = KEYS / 64; else if (MODE == 3) NT = 4;
    else if (MODE == 1) { wbase = max(0, q0 - 128); const int we = min(SEQ, q0 + 256 + 128); NT = 4 + (we - wbase) / 64; }
    else { const int r0 = q0 >> 6; wbase = min(max(r0 - 4, 0), 120); const int kre = min(max(r0 - 1, 0), 120) + 8; NT = 4 + (kre - wbase); }
#define FA_KEY0(t) ((MODE == 0 || MODE == 3 || (t) < 4) ? 64 * (t) : (MODE == 1 ? CTX + wbase + 64 * ((t) - 4) : CTX + (wbase + (t) - 4) * 64))
    const bf16_t* ksrc = Kg + (size_t)lane * DQK; const bf16_t* vsrc = Vg + (size_t)(16 * (wid & 3) + (lane >> 2)) * 64 + (wid >> 2) * 32 + (lane & 3) * 8;
#define FA_DMA(t, s) do { const int k0_ = FA_KEY0(t); \
        _Pragma("unroll") for (int c_ = 0; c_ < 2; ++c_) { const int ch_ = wid + 8 * c_; if (ch_ < NCH) glds16(ksrc + (size_t)k0_ * DQK + ch_ * 8, (unsigned)__builtin_amdgcn_readfirstlane(lds0 + (s) * STG + ch_ * 1024)); } \
        glds16(vsrc + (size_t)k0_ * 64, (unsigned)__builtin_amdgcn_readfirstlane(lds0 + (s) * STG + KSTG + wid * 1024)); } while (0)
    FA_DMA(0, 0);
    if (MODE == 2) { float* rp = (float*)(shm + LDS_RPB); for (int i = tid; i < 15 * 31; i += 512) rp[i] = rpb[i] * LOG2E; }
    bf16x8 qr[ND0];
#pragma unroll
    for (int d0 = 0; d0 < ND0; ++d0) qr[d0] = *reinterpret_cast<const bf16x8*>(Qg + (size_t)(wid * 32 + r32) * DQK + d0 * 16 + hi * 8);
    float mhat = -1e30f, l_reg = 0.f; f32x16 o[2];
#pragma unroll
    for (int r = 0; r < 16; ++r) { o[0][r] = 0.f; o[1][r] = 0.f; }
    const int qpos = q0 + wid * 32 + r32;
    const int rq = (q0 >> 6) + (wid >> 1), jq = 32 * (wid & 1) + r32;
    const int rs = min(max(rq - 4, 0), 120), cs = min(max(jq - 8, 0), 48);
    const lds_cptr shm3 = (lds_cptr)shm;
    FA_WAIT_BAR();
    for (int t = 0; t < NT; ++t) {
        const int s = t & 1;
        if (t + 1 < NT) FA_DMA(t + 1, s ^ 1);
        bool active = true;
        if (MODE == 1 && t >= 4) { const int kp0 = wbase + 64 * (t - 4), qw0 = q0 + wid * 32; active = (kp0 + 63 >= qw0 - 128) && (kp0 <= qw0 + 31 + 128); }
        if (MODE == 2 && t >= 4) { const int kr = wbase + t - 4; active = (kr >= rs) && (kr < rs + 8); }
        if (active) {
            const lds_cptr kb = shm3 + s * STG + hi * 1024 + r32 * 16;
            f32x16 p0, p1;
#pragma unroll
            for (int r = 0; r < 16; ++r) { p0[r] = 0.f; p1[r] = 0.f; }
#pragma unroll
            for (int d0 = 0; d0 < ND0; ++d0) {
                const bf16x8 b0 = *(const __attribute__((address_space(3))) bf16x8*)(kb + d0 * 2048);
                const bf16x8 b1 = *(const __attribute__((address_space(3))) bf16x8*)(kb + d0 * 2048 + 512);
                p0 = __builtin_amdgcn_mfma_f32_32x32x16_bf16(b0, qr[d0], p0, 0, 0, 0);
                p1 = __builtin_amdgcn_mfma_f32_32x32x16_bf16(b1, qr[d0], p1, 0, 0, 0);
            }
            if (MODE == 1 && t >= 4) { const int kp0 = wbase + 64 * (t - 4) - qpos;
#pragma unroll
                for (int r = 0; r < 16; ++r) { const int d0_ = kp0 + crow(r, hi), d1_ = d0_ + 32; if (d0_ < -128 || d0_ > 128) p0[r] = -INFINITY; if (d1_ < -128 || d1_ > 128) p1[r] = -INFINITY; } }
            if (MODE == 2 && t >= 4) { const int kr = wbase + t - 4; const float* rp = (const float*)(shm + LDS_RPB) + (kr - rq + 7) * 31 + 15 - jq;
#pragma unroll
                for (int r = 0; r < 16; ++r) { const int kc0 = crow(r, hi), kc1 = kc0 + 32;
                    const bool v0 = (kc0 >= cs) && (kc0 < cs + 16), v1 = (kc1 >= cs) && (kc1 < cs + 16);
                    p0[r] = v0 ? p0[r] + rp[v0 ? kc0 : jq] : -INFINITY; p1[r] = v1 ? p1[r] + rp[v1 ? kc1 : jq] : -INFINITY; } }
            float rm = fmaxf(p0[0], p1[0]);
#pragma unroll
            for (int r = 1; r < 16; ++r) rm = fmaxf(rm, fmaxf(p0[r], p1[r]));
            rm = xhalf_max(rm);
            if (__any(rm - mhat > THR)) {
                const float mn = fmaxf(mhat, rm), f = __builtin_amdgcn_exp2f(mhat - mn); mhat = mn; l_reg *= f;
                if (hi == 0) wsf[r32] = f;
#pragma unroll
                for (int r = 0; r < 16; ++r) { const float fr = wsf[crow(r, hi)]; o[0][r] *= fr; o[1][r] *= fr; }
            }
            float sacc = 0.f;
#pragma unroll
            for (int r = 0; r < 16; ++r) { p0[r] = __builtin_amdgcn_exp2f(p0[r] - mhat); p1[r] = __builtin_amdgcn_exp2f(p1[r] - mhat); sacc += p0[r] + p1[r]; }
            l_reg += sacc;
            u32x4 pw0, pw1, pw2, pw3;
            pw0 = (u32x4){cvtpk(p0[0], p0[1]), cvtpk(p0[2], p0[3]), cvtpk(p0[4], p0[5]), cvtpk(p0[6], p0[7])};
            pw1 = (u32x4){cvtpk(p0[8], p0[9]), cvtpk(p0[10], p0[11]), cvtpk(p0[12], p0[13]), cvtpk(p0[14], p0[15])};
            pw2 = (u32x4){cvtpk(p1[0], p1[1]), cvtpk(p1[2], p1[3]), cvtpk(p1[4], p1[5]), cvtpk(p1[6], p1[7])};
            pw3 = (u32x4){cvtpk(p1[8], p1[9]), cvtpk(p1[10], p1[11]), cvtpk(p1[12], p1[13]), cvtpk(p1[14], p1[15])};
            const lds_cptr vp = shm3 + s * STG + KSTG + ((lane >> 4) & 1) * 32 + (lane & 3) * 8 + (4 * hi + ((lane & 15) >> 2)) * 64;
#pragma unroll
            for (int dh = 0; dh < 2; ++dh) {
                s16x4 vlo[4], vhi[4];
#pragma unroll
                for (int ks = 0; ks < 4; ++ks) { vlo[ks] = vtr(vp + dh * 4096 + ks * 1024); vhi[ks] = vtr(vp + dh * 4096 + ks * 1024 + 512); }
#define FA_VFR(k) (bf16x8){vlo[k][0], vlo[k][1], vlo[k][2], vlo[k][3], vhi[k][0], vhi[k][1], vhi[k][2], vhi[k][3]}
                o[dh] = __builtin_amdgcn_mfma_f32_32x32x16_bf16(__builtin_bit_cast(bf16x8, pw0), FA_VFR(0), o[dh], 0, 0, 0);
                o[dh] = __builtin_amdgcn_mfma_f32_32x32x16_bf16(__builtin_bit_cast(bf16x8, pw1), FA_VFR(1), o[dh], 0, 0, 0);
                o[dh] = __builtin_amdgcn_mfma_f32_32x32x16_bf16(__builtin_bit_cast(bf16x8, pw2), FA_VFR(2), o[dh], 0, 0, 0);
                o[dh] = __builtin_amdgcn_mfma_f32_32x32x16_bf16(__builtin_bit_cast(bf16x8, pw3), FA_VFR(3), o[dh], 0, 0, 0);
#undef FA_VFR
            }
        }
        FA_WAIT_BAR();
    }
    l_reg = xhalf_sum(l_reg);
    if (MODE == 1 || MODE == 3) l_reg += __builtin_amdgcn_exp2f(sink2 - mhat);
    if (hi == 0) wsf[32 + r32] = 1.0f / l_reg;
    float rli[16];
#pragma unroll
    for (int r = 0; r < 16; ++r) rli[r] = wsf[32 + crow(r, hi)];
    bf16_t* stg = (bf16_t*)(shm + LDS_OST) + wid * 2048;
#pragma unroll
    for (int r = 0; r < 16; ++r) { const int orow = crow(r, hi);
#pragma unroll
        for (int dh = 0; dh < 2; ++dh) stg[orow * 64 + dh * 32 + r32] = (bf16_t)f2bf(o[dh][r] * rli[r]); }
#pragma unroll
    for (int i = 0; i < 4; ++i) { const int row = i * 8 + (lane >> 3), ch = lane & 7; const u32x4 v = *(const u32x4*)(stg + row * 64 + ch * 8); *(u32x4*)(Og + (size_t)(wid * 32 + row) * D + ch * 8) = v; }
    asm volatile("s_waitcnt lgkmcnt(0)\n\ts_barrier" ::: "memory");
#undef FA_DMA
#undef FA_KEY0
}
#undef FA_WAIT_BAR
}


namespace fa2 {
using fa::bf16x8; using fa::s16x4; using fa::f32x16; using fa::lds_cptr; using fa::crow; using fa::glds16; using fa::vtr; using fa::cvtpk; using fa::LOG2E;
constexpr int KSL = 12288, VSL = 8192, VBASE = 4 * KSL, LDS_WS = VBASE + 3 * VSL, LDS_OST = LDS_WS + 8 * 256, LDS_RPB = LDS_OST + 8 * 4096, LDS_TOTAL = LDS_RPB + 2048;
static_assert(LDS_TOTAL <= 131072, "attention LDS");
#define SBAR() __builtin_amdgcn_sched_barrier(0)
#define PIN(x) asm volatile("" : "+v"(x))
template <int DQK, int MODE, int THRL>
__device__ __forceinline__ void attn_unit(const bf16_t* Qg, const bf16_t* Kg, const bf16_t* Vg, bf16_t* Og, int q0, float sink2, const float* rpb, char* shm, float kmax2) {
    const int tid = opq((int)threadIdx.x), lane = tid & 63, r32 = lane & 31, hi = lane >> 5; const int wid = __builtin_amdgcn_readfirstlane(tid >> 6);
    const unsigned lds0 = (unsigned)(uintptr_t)shm;
    float* wsf = (float*)(shm + LDS_WS) + wid * 64;
    constexpr int NCH = DQK / 8, ND0 = DQK / 16;
    int NT, wbase = 0;
    if (MODE == 0) NT = KEYS / 64; else if (MODE == 3) NT = 4;
    else if (MODE == 1) { wbase = max(0, q0 - 128); const int we = min(SEQ, q0 + 256 + 128); NT = 4 + (we - wbase) / 64; }
    else { const int r0 = q0 >> 6; wbase = min(max(r0 - 4, 0), 120); const int kre = min(max(r0 - 1, 0), 120) + 8; NT = 4 + (kre - wbase); }
#define FA_KEY0(t) ((MODE == 0 || MODE == 3 || (t) < 4) ? 64 * (t) : (MODE == 1 ? CTX + wbase + 64 * ((t) - 4) : CTX + (wbase + (t) - 4) * 64))
    const bf16_t* ksrc = Kg + (size_t)lane * DQK; const bf16_t* vsrc = Vg + (size_t)(16 * (wid & 3) + (lane >> 2)) * 64 + (wid >> 2) * 32 + (lane & 3) * 8;
#define DMA_K(t, slotoff) do { const int tt_ = (t) < NT ? (t) : NT - 1; const int k0_ = FA_KEY0(tt_); \
        glds16(ksrc + (size_t)k0_ * DQK + wid * 8, (unsigned)__builtin_amdgcn_readfirstlane(lds0 + (slotoff) + wid * 1024)); \
        if (NCH > 8) { if (wid < NCH - 8) glds16(ksrc + (size_t)k0_ * DQK + (wid + 8) * 8, (unsigned)__builtin_amdgcn_readfirstlane(lds0 + (slotoff) + (wid + 8) * 1024)); } } while (0)
#define DMA_V(t, slotoff) do { const int tt_ = (t) < NT ? (t) : NT - 1; const int k0_ = FA_KEY0(tt_); \
        glds16(vsrc + (size_t)k0_ * 64, (unsigned)__builtin_amdgcn_readfirstlane(lds0 + VBASE + (slotoff) + wid * 1024)); } while (0)
#define WAIT_STEP() do { if (NCH > 8 && wid < NCH - 8) asm volatile("s_waitcnt vmcnt(3) lgkmcnt(0)\n\ts_barrier" ::: "memory"); else asm volatile("s_waitcnt vmcnt(2) lgkmcnt(0)\n\ts_barrier" ::: "memory"); } while (0)
    DMA_K(0, 0); DMA_V(0, 0); DMA_K(1, KSL); DMA_K(2, 2 * KSL);
    if (MODE == 2) { float* rp = (float*)(shm + LDS_RPB); unsigned* bm = (unsigned*)(shm + LDS_RPB) + 480; if (tid == 0) *bm = 0u;
        __syncthreads();
        for (int i = tid; i < 15 * 31; i += 512) { const float v = rpb[i] * LOG2E; rp[i] = v; atomicMax(bm, __float_as_uint(fabsf(v))); } }
    bf16x8 qr[ND0];
#pragma unroll
    for (int d0 = 0; d0 < ND0; ++d0) qr[d0] = *reinterpret_cast<const bf16x8*>(Qg + (size_t)(wid * 32 + r32) * DQK + d0 * 16 + hi * 8);
    float q2 = 0.f;
#pragma unroll
    for (int d0 = 0; d0 < ND0; ++d0) {
#pragma unroll
        for (int j = 0; j < 8; ++j) { const float qv = __uint_as_float(((unsigned)(unsigned short)qr[d0][j]) << 16); q2 += qv * qv; } }
    q2 = fa::xhalf_sum(q2);
    float l_reg = 0.f; f32x16 o[2]; f32x16 negm;
#pragma unroll
    for (int r = 0; r < 16; ++r) { o[0][r] = 0.f; o[1][r] = 0.f; }
    const int qpos = q0 + wid * 32 + r32;
    const int rq = (q0 >> 6) + (wid >> 1), jq = 32 * (wid & 1) + r32;
    const int rs = min(max(rq - 4, 0), 120), cs = min(max(jq - 8, 0), 48);
    const lds_cptr shm3 = (lds_cptr)shm;
    const lds_cptr kp0 = shm3 + hi * 1024 + r32 * 16;
    const lds_cptr vp0 = shm3 + VBASE + ((lane >> 4) & 1) * 32 + (lane & 3) * 8 + (4 * hi + ((lane & 15) >> 2)) * 64;
#define MASK(C0, C1, t) do { \
        if (MODE == 1 && (t) >= 4) { const int kp0_ = wbase + 64 * ((t) - 4) - qpos; \
            _Pragma("unroll") for (int r = 0; r < 16; ++r) { const int d0_ = kp0_ + crow(r, hi), d1_ = d0_ + 32; if (d0_ < -128 || d0_ > 128) C0[r] = -INFINITY; if (d1_ < -128 || d1_ > 128) C1[r] = -INFINITY; } } \
        if (MODE == 2 && (t) >= 4) { const int kr_ = wbase + (t) - 4; const bool rowok_ = (kr_ >= rs) && (kr_ < rs + 8); const int ro_ = min(max(kr_ - rq + 7, 0), 14); \
            const float* rp_ = (const float*)(shm + LDS_RPB) + ro_ * 31 + 15 - jq; \
            _Pragma("unroll") for (int r = 0; r < 16; ++r) { const int kc0 = crow(r, hi), kc1 = kc0 + 32; \
                const bool v0 = rowok_ && (kc0 >= cs) && (kc0 < cs + 16), v1 = rowok_ && (kc1 >= cs) && (kc1 < cs + 16); \
                C0[r] = v0 ? C0[r] + rp_[v0 ? kc0 : jq] : -INFINITY; C1[r] = v1 ? C1[r] + rp_[v1 ? kc1 : jq] : -INFINITY; } } } while (0)
#define ROWMAX(C0, C1, rm) do { float a_ = fmaxf(fmaxf(C0[0], C0[1]), C1[0]), b_ = fmaxf(fmaxf(C0[2], C0[3]), C1[1]); a_ = fmaxf(fmaxf(a_, C1[2]), C1[3]); \
        _Pragma("unroll") for (int r = 4; r < 16; r += 4) { a_ = fmaxf(fmaxf(a_, C0[r]), C0[r + 1]); b_ = fmaxf(fmaxf(b_, C0[r + 2]), C0[r + 3]); a_ = fmaxf(fmaxf(a_, C1[r]), C1[r + 1]); b_ = fmaxf(fmaxf(b_, C1[r + 2]), C1[r + 3]); } \
        rm = fa::xhalf_max(fmaxf(a_, b_)); } while (0)
    bf16x8 kf[8]; bf16x8 kf2[4];
#define KLOAD(j, slotoff) do { kf[2 * (j)] = *(const __attribute__((address_space(3))) bf16x8*)(kp0 + (slotoff) + (j) * 2048); kf[2 * (j) + 1] = *(const __attribute__((address_space(3))) bf16x8*)(kp0 + (slotoff) + (j) * 2048 + 512); } while (0)
#define KLOAD2(slotoff) do { if (ND0 > 4) { kf2[0] = *(const __attribute__((address_space(3))) bf16x8*)(kp0 + (slotoff) + 4 * 2048); kf2[1] = *(const __attribute__((address_space(3))) bf16x8*)(kp0 + (slotoff) + 4 * 2048 + 512); \
        kf2[2] = *(const __attribute__((address_space(3))) bf16x8*)(kp0 + (slotoff) + 5 * 2048); kf2[3] = *(const __attribute__((address_space(3))) bf16x8*)(kp0 + (slotoff) + 5 * 2048 + 512); } } while (0)
    asm volatile("s_waitcnt vmcnt(0) lgkmcnt(0)\n\ts_barrier" ::: "memory");
    float mhat = sqrtf(q2 * kmax2) * 1.01f + (MODE == 2 ? __uint_as_float(*((const unsigned*)(shm + LDS_RPB) + 480)) : 0.f);
#pragma unroll
    for (int r = 0; r < 16; ++r) negm[r] = 0.f;
    PIN(negm);
    f32x16 pA0, pA1, pB0, pB1;
    int ks_cur = 0, ks_next = KSL, ks_nn = 2 * KSL, ks_tgt = 3 * KSL;
    int vs_prev = 2 * VSL, vs_cur = 0, vs_next = VSL;
#define ROT() do { const int k_ = ks_cur; ks_cur = ks_next; ks_next = ks_nn; ks_nn = ks_tgt; ks_tgt = k_; const int v_ = vs_prev; vs_prev = vs_cur; vs_cur = vs_next; vs_next = v_; } while (0)
#define RESC() do { if (resc) { _Pragma("unroll") for (int r = 0; r < 16; ++r) { const float fr_ = wsf[crow(r, hi)]; o[0][r] *= fr_; o[1][r] *= fr_; } } } while (0)
    KLOAD(0, 0); KLOAD(1, 0); KLOAD(2, 0); KLOAD(3, 0); KLOAD2(0);
    {
#pragma unroll
        for (int d0 = 0; d0 < 4; ++d0) { pA0 = __builtin_amdgcn_mfma_f32_32x32x16_bf16(kf[2 * d0], qr[d0], d0 == 0 ? negm : pA0, 0, 0, 0); pA1 = __builtin_amdgcn_mfma_f32_32x32x16_bf16(kf[2 * d0 + 1], qr[d0], d0 == 0 ? negm : pA1, 0, 0, 0); }
        if (ND0 > 4) { pA0 = __builtin_amdgcn_mfma_f32_32x32x16_bf16(kf2[0], qr[ND0 > 4 ? 4 : 0], pA0, 0, 0, 0); pA1 = __builtin_amdgcn_mfma_f32_32x32x16_bf16(kf2[1], qr[ND0 > 4 ? 4 : 0], pA1, 0, 0, 0);
                       pA0 = __builtin_amdgcn_mfma_f32_32x32x16_bf16(kf2[2], qr[ND0 > 4 ? 5 : 0], pA0, 0, 0, 0); pA1 = __builtin_amdgcn_mfma_f32_32x32x16_bf16(kf2[3], qr[ND0 > 4 ? 5 : 0], pA1, 0, 0, 0); }
        DMA_K(3, 3 * KSL); DMA_V(1, VSL);
        { float rm; ROWMAX(pA0, pA1, rm); mhat = fminf(mhat, rm + 64.f); }
#pragma unroll
        for (int r = 0; r < 16; ++r) { pA0[r] = __builtin_amdgcn_exp2f(pA0[r] - mhat); pA1[r] = __builtin_amdgcn_exp2f(pA1[r] - mhat); negm[r] = -mhat; }
        PIN(negm);
        KLOAD(0, KSL); KLOAD(1, KSL); KLOAD(2, KSL); KLOAD(3, KSL);
        WAIT_STEP();
    }
    s16x4 vlo[8], vhi[8]; u32x4 pw0, pw1, pw2, pw3;
#define VRD(i) do { vlo[i] = vtr(vp_ + (((i) >> 2) * 4096 + ((i) & 3) * 1024)); vhi[i] = vtr(vp_ + (((i) >> 2) * 4096 + ((i) & 3) * 1024 + 512)); } while (0)
#define VFR(i) (bf16x8){vlo[i][0], vlo[i][1], vlo[i][2], vlo[i][3], vhi[i][0], vhi[i][1], vhi[i][2], vhi[i][3]}
#define PAF(k) __builtin_bit_cast(bf16x8, pw##k)
#define GAPA(MF, A0, A1, A2, A3, W0, W1, PW) do { MF; sacc += A0; sacc += A1; sacc += A2; sacc += A3; PIN(sacc); W0; W1; PIN(PW); SBAR(); } while (0)
#define EX(v) __builtin_amdgcn_exp2f(v)
#define GAPB(MF, X, B) do { MF; X[B] = EX(X[B]); X[B + 1] = EX(X[B + 1]); X[B + 2] = EX(X[B + 2]); X[B + 3] = EX(X[B + 3]); PIN(X); SBAR(); } while (0)
#define KRD(j) do { KLOAD(j, ks_nn_); SBAR(); } while (0)
#define STEP(C0, C1, P0, P1, t) do { SBAR(); \
        const lds_cptr vp_ = vp0 + vs_prev; const int ks_cur_ = ks_cur; (void)ks_cur_; \
        KLOAD2(ks_cur_); \
        VRD(0); SBAR(); float sacc = (P0[0] + P0[1]); \
        GAPA(C0 = __builtin_amdgcn_mfma_f32_32x32x16_bf16(kf[0], qr[0], negm, 0, 0, 0), P0[2], P0[3], P0[4], P0[5], pw0[0] = cvtpk(P0[0], P0[1]), pw0[1] = cvtpk(P0[2], P0[3]), pw0); \
        VRD(4); SBAR(); GAPA(C1 = __builtin_amdgcn_mfma_f32_32x32x16_bf16(kf[1], qr[0], negm, 0, 0, 0), P0[6], P0[7], P0[8], P0[9], pw0[2] = cvtpk(P0[4], P0[5]), pw0[3] = cvtpk(P0[6], P0[7]), pw0); \
        VRD(1); SBAR(); GAPA(C0 = __builtin_amdgcn_mfma_f32_32x32x16_bf16(kf[2], qr[1], C0, 0, 0, 0), P0[10], P0[11], P0[12], P0[13], pw1[0] = cvtpk(P0[8], P0[9]), pw1[1] = cvtpk(P0[10], P0[11]), pw1); \
        VRD(5); SBAR(); GAPA(C1 = __builtin_amdgcn_mfma_f32_32x32x16_bf16(kf[3], qr[1], C1, 0, 0, 0), P0[14], P0[15], P1[0], P1[1], pw1[2] = cvtpk(P0[12], P0[13]), pw1[3] = cvtpk(P0[14], P0[15]), pw1); \
        VRD(2); SBAR(); GAPA(C0 = __builtin_amdgcn_mfma_f32_32x32x16_bf16(kf[4], qr[2], C0, 0, 0, 0), P1[2], P1[3], P1[4], P1[5], pw2[0] = cvtpk(P1[0], P1[1]), pw2[1] = cvtpk(P1[2], P1[3]), pw2); \
        VRD(6); SBAR(); GAPA(C1 = __builtin_amdgcn_mfma_f32_32x32x16_bf16(kf[5], qr[2], C1, 0, 0, 0), P1[6], P1[7], P1[8], P1[9], pw2[2] = cvtpk(P1[4], P1[5]), pw2[3] = cvtpk(P1[6], P1[7]), pw2); \
        VRD(3); SBAR(); GAPA(C0 = __builtin_amdgcn_mfma_f32_32x32x16_bf16(kf[6], qr[3], C0, 0, 0, 0), P1[10], P1[11], P1[12], P1[13], pw3[0] = cvtpk(P1[8], P1[9]), pw3[1] = cvtpk(P1[10], P1[11]), pw3); \
        VRD(7); SBAR(); GAPA(C1 = __builtin_amdgcn_mfma_f32_32x32x16_bf16(kf[7], qr[3], C1, 0, 0, 0), P1[14], P1[15], 0.f, 0.f, pw3[2] = cvtpk(P1[12], P1[13]), pw3[3] = cvtpk(P1[14], P1[15]), pw3); \
        if (ND0 > 4) { C0 = __builtin_amdgcn_mfma_f32_32x32x16_bf16(kf2[0], qr[ND0 > 4 ? 4 : 0], C0, 0, 0, 0); C1 = __builtin_amdgcn_mfma_f32_32x32x16_bf16(kf2[1], qr[ND0 > 4 ? 4 : 0], C1, 0, 0, 0); \
                       C0 = __builtin_amdgcn_mfma_f32_32x32x16_bf16(kf2[2], qr[ND0 > 4 ? 5 : 0], C0, 0, 0, 0); C1 = __builtin_amdgcn_mfma_f32_32x32x16_bf16(kf2[3], qr[ND0 > 4 ? 5 : 0], C1, 0, 0, 0); SBAR(); } \
        l_reg += sacc; \
        DMA_K((t) + 3, ks_tgt); DMA_V((t) + 1, vs_next); \
        MASK(C0, C1, t); \
        SBAR(); \
        const int ks_nn_ = ks_next; \
        GAPB(o[0] = __builtin_amdgcn_mfma_f32_32x32x16_bf16(PAF(0), VFR(0), o[0], 0, 0, 0), C0, 0); \
        GAPB(o[1] = __builtin_amdgcn_mfma_f32_32x32x16_bf16(PAF(0), VFR(4), o[1], 0, 0, 0), C0, 4); \
        KRD(0); GAPB(o[0] = __builtin_amdgcn_mfma_f32_32x32x16_bf16(PAF(1), VFR(1), o[0], 0, 0, 0), C0, 8); \
        KRD(1); GAPB(o[1] = __builtin_amdgcn_mfma_f32_32x32x16_bf16(PAF(1), VFR(5), o[1], 0, 0, 0), C0, 12); \
        KRD(2); GAPB(o[0] = __builtin_amdgcn_mfma_f32_32x32x16_bf16(PAF(2), VFR(2), o[0], 0, 0, 0), C1, 0); \
        KRD(3); GAPB(o[1] = __builtin_amdgcn_mfma_f32_32x32x16_bf16(PAF(2), VFR(6), o[1], 0, 0, 0), C1, 4); \
        GAPB(o[0] = __builtin_amdgcn_mfma_f32_32x32x16_bf16(PAF(3), VFR(3), o[0], 0, 0, 0), C1, 8); \
        GAPB(o[1] = __builtin_amdgcn_mfma_f32_32x32x16_bf16(PAF(3), VFR(7), o[1], 0, 0, 0), C1, 12); \
    } while (0)
    ROT();
    int t = 1;
    for (; t + 1 < NT; t += 2) {
        STEP(pB0, pB1, pA0, pA1, t);     WAIT_STEP(); ROT();
        STEP(pA0, pA1, pB0, pB1, t + 1); WAIT_STEP(); ROT();
    }
    if (t < NT) {
        STEP(pB0, pB1, pA0, pA1, t);     WAIT_STEP(); ROT();
        pA0 = pB0; pA1 = pB1;
    }
    {
        float sacc = 0.f;
#pragma unroll
        for (int r = 0; r < 16; ++r) sacc += pA0[r] + pA1[r];
        l_reg += sacc;
        pw0 = (u32x4){cvtpk(pA0[0], pA0[1]), cvtpk(pA0[2], pA0[3]), cvtpk(pA0[4], pA0[5]), cvtpk(pA0[6], pA0[7])};
        pw1 = (u32x4){cvtpk(pA0[8], pA0[9]), cvtpk(pA0[10], pA0[11]), cvtpk(pA0[12], pA0[13]), cvtpk(pA0[14], pA0[15])};
        pw2 = (u32x4){cvtpk(pA1[0], pA1[1]), cvtpk(pA1[2], pA1[3]), cvtpk(pA1[4], pA1[5]), cvtpk(pA1[6], pA1[7])};
        pw3 = (u32x4){cvtpk(pA1[8], pA1[9]), cvtpk(pA1[10], pA1[11]), cvtpk(pA1[12], pA1[13]), cvtpk(pA1[14], pA1[15])};
        const lds_cptr vp_ = vp0 + vs_prev;
#pragma unroll
        for (int i = 0; i < 8; ++i) VRD(i);
        o[0] = __builtin_amdgcn_mfma_f32_32x32x16_bf16(PAF(0), VFR(0), o[0], 0, 0, 0); o[1] = __builtin_amdgcn_mfma_f32_32x32x16_bf16(PAF(0), VFR(4), o[1], 0, 0, 0);
        o[0] = __builtin_amdgcn_mfma_f32_32x32x16_bf16(PAF(1), VFR(1), o[0], 0, 0, 0); o[1] = __builtin_amdgcn_mfma_f32_32x32x16_bf16(PAF(1), VFR(5), o[1], 0, 0, 0);
        o[0] = __builtin_amdgcn_mfma_f32_32x32x16_bf16(PAF(2), VFR(2), o[0], 0, 0, 0); o[1] = __builtin_amdgcn_mfma_f32_32x32x16_bf16(PAF(2), VFR(6), o[1], 0, 0, 0);
        o[0] = __builtin_amdgcn_mfma_f32_32x32x16_bf16(PAF(3), VFR(3), o[0], 0, 0, 0); o[1] = __builtin_amdgcn_mfma_f32_32x32x16_bf16(PAF(3), VFR(7), o[1], 0, 0, 0);
    }
    l_reg = fa::xhalf_sum(l_reg);
    if (MODE == 1 || MODE == 3) l_reg += __builtin_amdgcn_exp2f(sink2 - mhat);
    if (hi == 0) wsf[32 + r32] = 1.0f / l_reg;
    float rli[16];
#pragma unroll
    for (int r = 0; r < 16; ++r) rli[r] = wsf[32 + crow(r, hi)];
    bf16_t* stg = (bf16_t*)(shm + LDS_OST) + wid * 2048;
#pragma unroll
    for (int r = 0; r < 16; ++r) { const int orow = crow(r, hi);
#pragma unroll
        for (int dh = 0; dh < 2; ++dh) stg[orow * 64 + dh * 32 + r32] = (bf16_t)f2bf(o[dh][r] * rli[r]); }
#pragma unroll
    for (int i = 0; i < 4; ++i) { const int row = i * 8 + (lane >> 3), ch = lane & 7; const u32x4 v = *(const u32x4*)(stg + row * 64 + ch * 8); *(u32x4*)(Og + (size_t)(wid * 32 + row) * D + ch * 8) = v; }
    asm volatile("s_waitcnt vmcnt(0) lgkmcnt(0)\n\ts_barrier" ::: "memory");
#undef FA_KEY0
#undef DMA_K
#undef DMA_V
#undef WAIT_STEP
#undef MASK
#undef ROWMAX
#undef KLOAD
#undef KLOAD2
#undef ROT
#undef RESC
#undef VRD
#undef VFR
#undef PAF
#undef GAPA
#undef EX
#undef GAPB
#undef KRD
#undef STEP
}
#undef SBAR
#undef PIN
}

constexpr float SCALE_MLA = 0.10206207261596575f;
__device__ __forceinline__ void ph_attn(const Params& p, int layer, bool with_ctx, char* shm) {
    const QKVB qb = make_qkv(p.ws);
    bf16_t* O = (bf16_t*)(p.ws + WS_P);
    const int G = gridDim.x;
    const float NEG = -INFINITY;
    float km2[4];
    { const float* gk[4] = {p.in[10] + layer * 64, p.in[13] + layer * 64, p.in[15] + layer * 64, p.in[22] + layer * 96};
#pragma unroll
      for (int mix = 0; mix < 4; ++mix) { float gm = 0.f; const int n = mix == 3 ? 96 : 64; for (int i = 0; i < n; ++i) gm = fmaxf(gm, fabsf(gk[mix][i])); km2[mix] = (float)n * gm * gm; } }
#define KMAX2(mix, bb, hk) km2[mix]
    for (int u = blockIdx.x; u < 256; u += G) { const int bh = u & 7, b = bh >> 2, h = bh & 3, qbk = u >> 3;
        fa2::attn_unit<96, 0, 6>(qb.QD + ((size_t)bh * SEQ + qbk * 256) * 96, qb.KD + (size_t)bh * KEYS * 96, qb.VD + (size_t)bh * KEYS * 64, O + (size_t)(b * SEQ + qbk * 256) * D + 768 + h * 64, qbk * 256, NEG, nullptr, shm, KMAX2(3, b, h)); }
    for (int u = blockIdx.x; u < 256; u += G) { const int bh = u & 7, b = bh >> 2, h = bh & 3, qbk = u >> 3;
        fa2::attn_unit<64, 0, 6>(qb.QB + ((size_t)bh * SEQ + qbk * 256) * 64, qb.KB + (size_t)(b * 2 + (h >> 1)) * KEYS * 64, qb.VB + (size_t)(b * 2 + (h >> 1)) * KEYS * 64, O + (size_t)(b * SEQ + qbk * 256) * D + 256 + h * 64, qbk * 256, NEG, nullptr, shm, KMAX2(1, b, h >> 1)); }
    for (int u = blockIdx.x; u < 256; u += G) { const int bh = u & 7, b = bh >> 2, h = bh & 3, qbk = u >> 3;
        fa2::attn_unit<64, 1, 6>(qb.QA + ((size_t)bh * SEQ + qbk * 256) * 64, qb.KA + (size_t)(b * 2 + (h >> 1)) * KEYS * 64, qb.VA + (size_t)(b * 2 + (h >> 1)) * KEYS * 64, O + (size_t)(b * SEQ + qbk * 256) * D + 0 + h * 64, qbk * 256, p.in[11][layer * 4 + h] * fa::LOG2E, nullptr, shm, KMAX2(0, b, h >> 1)); }
    for (int u = blockIdx.x; u < 256; u += G) { const int bh = u & 7, b = bh >> 2, h = bh & 3, qbk = u >> 3;
        fa2::attn_unit<64, 2, 6>(qb.QC + ((size_t)bh * SEQ + qbk * 256) * 64, qb.KC + (size_t)bh * KEYS * 64, qb.VC + (size_t)bh * KEYS * 64, O + (size_t)(b * SEQ + qbk * 256) * D + 512 + h * 64, qbk * 256, NEG, p.in[16] + ((size_t)layer * 4 + h) * 15 * 31, shm, KMAX2(2, b, h)); }
    if (with_ctx) for (int u = blockIdx.x; u < 32; u += G) { const int ty = u >> 3, bh = u & 7, b = bh >> 2, h = bh & 3;
        bf16_t* Oc = O + (size_t)(TL + b * CTX) * D + ty * 256 + h * 64;
        if (ty == 0) fa2::attn_unit<64, 3, 6>(qb.QAc + (size_t)bh * CTX * 64, qb.KA + (size_t)(b * 2 + (h >> 1)) * KEYS * 64, qb.VA + (size_t)(b * 2 + (h >> 1)) * KEYS * 64, Oc, 0, p.in[11][layer * 4 + h] * fa::LOG2E, nullptr, shm, KMAX2(0, b, h >> 1));
        else if (ty == 1) fa2::attn_unit<64, 3, 6>(qb.QBc + (size_t)bh * CTX * 64, qb.KB + (size_t)(b * 2 + (h >> 1)) * KEYS * 64, qb.VB + (size_t)(b * 2 + (h >> 1)) * KEYS * 64, Oc, 0, NEG, nullptr, shm, KMAX2(1, b, h >> 1));
        else if (ty == 2) fa2::attn_unit<64, 3, 6>(qb.QCc + (size_t)bh * CTX * 64, qb.KC + (size_t)bh * KEYS * 64, qb.VC + (size_t)bh * KEYS * 64, Oc, 0, NEG, nullptr, shm, KMAX2(2, b, h));
        else fa2::attn_unit<96, 3, 6>(qb.QDc + (size_t)bh * CTX * 96, qb.KD + (size_t)bh * KEYS * 96, qb.VD + (size_t)bh * KEYS * 64, Oc, 0, NEG, nullptr, shm, KMAX2(3, b, h)); }
}

__device__ __forceinline__ void ph_gnorm(const Params& p, int layer, int nrows) {
    const int tx = opq((int)threadIdx.x), lane = tx & 63, gw = (blockIdx.x * 512 + tx) >> 6, ngw = (gridDim.x * 512) >> 6;
    const bf16_t* O = (const bf16_t*)(p.ws + WS_P); bf16_t* Y = (bf16_t*)(p.ws + WS_ACT1); const float* g = p.in[23] + layer * D;
    for (int m = gw; m < nrows; m += ngw) {
#pragma unroll
        for (int grp = 0; grp < 4; ++grp) { const int c = grp * 256 + 4 * lane; const u32x2 w = *(const u32x2*)(O + (size_t)m * D + c);
            const float a0 = bflo(w.x), a1 = bfhi(w.x), a2 = bflo(w.y), a3 = bfhi(w.y);
            const float r = rsqrtf(wave_sum(a0 * a0 + a1 * a1 + a2 * a2 + a3 * a3) * (1.f / 256.f) + EPS);
            const f32x4 gv = *(const f32x4*)(g + c); u32x2 o; o.x = pk2(a0 * r * gv.x, a1 * r * gv.y); o.y = pk2(a2 * r * gv.z, a3 * r * gv.w);
            *(u32x2*)(Y + (size_t)m * D + c) = o; }
    }
}

__device__ __forceinline__ void moe_bases(const unsigned* cnt, int (&base)[9]) {
    int acc = 0;
#pragma unroll
    for (int e = 0; e < 8; ++e) { base[e] = acc; acc += ((int)cnt[64 * e] + 255) / 256 * 256; }
    base[8] = acc;
}
__device__ __forceinline__ void ph_moe_gather(const Params& p) {
    const int tx = opq((int)threadIdx.x), lane = tx & 63, gw = (blockIdx.x * 512 + tx) >> 6, ngw = (gridDim.x * 512) >> 6;
    const unsigned* cnt = (const unsigned*)(p.ws + WS_CTL); int base[9]; moe_bases(cnt, base);
    if (blockIdx.x == 0 && tx < 136) { const int r = tx * 256; int e = -1;
#pragma unroll
        for (int i = 0; i < 8; ++i) if (r >= base[i] && r < base[i + 1]) e = i;
        ((int*)(p.ws + WS_TEXP))[tx] = e < 0 ? 0 : e; }
    const bf16_t* F = (const bf16_t*)(p.ws + WS_ACT1); bf16_t* A = (bf16_t*)(p.ws + WS_ASORT);
    for (int m = gw; m < TL; m += ngw) {
        const int2 e = ((const int2*)(p.ws + WS_TOKE))[m]; const int2 ps = ((const int2*)(p.ws + WS_TOKP))[m];
        int b0 = 0, b1 = 0;
#pragma unroll
        for (int i = 0; i < 8; ++i) { if (e.x == i) b0 = base[i]; if (e.y == i) b1 = base[i]; }
        const int s0 = b0 + ps.x, s1 = b1 + ps.y;
        const u32x4 v0 = *(const u32x4*)(F + (size_t)m * D + lane * 16), v1 = *(const u32x4*)(F + (size_t)m * D + lane * 16 + 8);
        *(u32x4*)(A + (size_t)s0 * D + lane * 16) = v0; *(u32x4*)(A + (size_t)s0 * D + lane * 16 + 8) = v1;
        *(u32x4*)(A + (size_t)s1 * D + lane * 16) = v0; *(u32x4*)(A + (size_t)s1 * D + lane * 16 + 8) = v1;
        if (lane == 0) ((int2*)(p.ws + WS_TOKS))[m] = make_int2(s0, s1);
    }
}
__device__ __forceinline__ void ph_moe_combine(const Params& p, int layer) {
    const size_t nthr = (size_t)gridDim.x * 512;
    for (size_t idx = (size_t)blockIdx.x * 512 + opq((int)threadIdx.x); idx < (size_t)TL * 256; idx += nthr) {
        const int m = (int)(idx >> 8), c = (int)(idx & 255) * 4;
        const int2 sl = ((const int2*)(p.ws + WS_TOKS))[m]; const float2 g = ((const float2*)(p.ws + WS_TOKG))[m];
        const bf16_t* Y = (const bf16_t*)(p.ws + WS_ASORT);
        const u32x2 a = *(const u32x2*)(Y + (size_t)sl.x * D + c), b = *(const u32x2*)(Y + (size_t)sl.y * D + c);
        const f32x4 ya = {bflo(a.x), bfhi(a.x), bflo(a.y), bfhi(a.y)}, yb = {bflo(b.x), bfhi(b.x), bflo(b.y), bfhi(b.y)};
        const float* mod = (const float*)(p.ws + WS_MOD) + (size_t)layer * 3 * 6144 + (m / SEQ) * 6144 + 5 * D;
        f32x4* o = (f32x4*)(p.out + (size_t)m * D + c);
        *o = *o + *(const f32x4*)(mod + c) * (ya * g.x + yb * g.y);
    }
}

#ifndef DBL_PHASE
#define DBL_PHASE (-1)
#endif
#ifndef FILL_Q_IN
#define FILL_Q_IN 0
#define FILL_Q_OUT 0
#define FILL_Q_UP 0
#define FILL_Q_DN 0
#endif
struct Args { Params p; int ph_lo, ph_hi; };
__global__ void __launch_bounds__(NWAVES * 64, 2) mega_fwd(Args args) {
    extern __shared__ __attribute__((aligned(16))) unsigned char lds[];
    LAS unsigned char* ldsl = (LAS unsigned char*)lds;
    for (int u = threadIdx.x; u < (LDS_BYTES - LDSCTL_OFF) / 4; u += NWAVES * 64) ((LAS unsigned*)(ldsl + LDSCTL_OFF))[u] = 0u;
    __syncthreads();
    XcdBarrier bar = xcd_barrier_post((unsigned*)(args.p.ws + WS_CTL) + CW_BAR, (volatile LAS unsigned*)(ldsl + MISC_OFF) + 8);
    const int lo = args.ph_lo, hi = args.ph_hi;
#pragma unroll 1
    for (int ph = lo; ph < hi; ++ph) {
      const int nrep = (ph == DBL_PHASE) ? 2 : 1;
#pragma unroll 1
      for (int rep_ = 0; rep_ < nrep; ++rep_) {
        if (rep_) xcd_barrier(bar);
        Params q = args.p; q.ws = opqp(args.p.ws); q.out = opqp(args.p.out);
        LAS unsigned char* ldq = (LAS unsigned char*)lds;
        const int l = ph >= 10 ? 1 : 0, st = ph == 0 ? -1 : (l ? ph - 10 : ph - 1);
        const bool last = (l == 1); const int nrows = last ? TL : MALL;
        const float* qmod = (const float*)(q.ws + WS_MOD) + (size_t)l * 3 * 6144;
        int fillq = 0, fill_nwg = 1;
        if (st == -1) ph_prologue(q, (float*)lds);
        else if (st == 0) ph_norm<1, false>(q, l, MALL, (unsigned*)lds, l ? 11 : 0);
        else if (st == 1) { run_gemm(ldq, (const bf16_t*)(q.ws + WS_ACT1), (const bf16_t*)(q.ws + WS_WIN) + (size_t)l * NINP * D, D, MALL / 256, NINP / 256, nullptr, 0, EpiBf16Perm{(bf16_t*)(q.ws + WS_P), NINP, 0});
                            fillq = FILL_Q_IN; fill_nwg = (MALL / 256) * (NINP / 256); }
        else if (st == 2) ph_postproj2(q, l);
        else if (st == 3) ph_attn(q, l, !last, (char*)lds);
        else if (st == 4) ph_gnorm(q, l, nrows);
        else if (st == 5 || (st == 8 && !last)) {
            const bool op = (st == 5);
            const bf16_t* A_ = (const bf16_t*)(q.ws + (op ? WS_ACT1 : WS_HIDF)); const bf16_t* B_ = op ? (const bf16_t*)(q.ws + WS_WOUT) + (size_t)l * D * D : (const bf16_t*)(q.ws + WS_WFDN);
            const int K_ = op ? D : DFF, goff_ = op ? 2 * D : 5 * D;
            const float* hl_in_ = (op && l == 0) ? q.in[0] : q.out;
#pragma unroll 1
            for (int pass = 0; pass < (last ? 1 : 2); ++pass)
                run_gemm(ldq, A_, B_, K_, pass ? 2 : 64, D / 256, nullptr, 0, EpiResid{hl_in_, (const float*)(q.ws + WS_HCTX), q.out, pass ? (float*)(q.ws + WS_PART) : (float*)(q.ws + WS_HCTX), qmod, goff_, pass}, pass ? (op ? 8 : 11) : 1, pass ? 64 : 0);
        }
        else if (!last) {
            if (st == 6) ph_norm<2, false>(q, l, MALL, (unsigned*)lds, 8);
            else if (st == 7) { run_gemm(ldq, (const bf16_t*)(q.ws + WS_ACT1), (const bf16_t*)(q.ws + WS_WFGU), D, MALL / 256, 2 * DFF / 256, nullptr, 0, EpiSwiglu{(bf16_t*)(q.ws + WS_HIDF), DFF, 0});
                                fillq = FILL_Q_UP; fill_nwg = (MALL / 256) * (2 * DFF / 256); }
            else {}
        } else {
            if (st == 6) ph_norm<2, true>(q, l, TL, (unsigned*)lds, 0);
            else if (st == 7) { ph_moe_gather(q); fillq = 1 << 30; fill_nwg = 0; }
            else if (st == 8) { int base[9]; moe_bases((const unsigned*)(q.ws + WS_CTL), base); run_gemm(ldq, (const bf16_t*)(q.ws + WS_ASORT), (const bf16_t*)(q.ws + WS_WMGU), D, __builtin_amdgcn_readfirstlane(base[8] / 256), 2 * DFFE / 256, (const int*)(q.ws + WS_TEXP), (size_t)2 * DFFE * D * 2, EpiSwiglu{(bf16_t*)(q.ws + WS_HIDM), DFFE, 0}); }
            else if (st == 9) { int base[9]; moe_bases((const unsigned*)(q.ws + WS_CTL), base); run_gemm(ldq, (const bf16_t*)(q.ws + WS_HIDM), (const bf16_t*)(q.ws + WS_WMDN), DFFE, __builtin_amdgcn_readfirstlane(base[8] / 256), D / 256, (const int*)(q.ws + WS_TEXP), (size_t)D * DFFE * 2, EpiBf16Perm{(bf16_t*)(q.ws + WS_ASORT), D, 0}); }
            else ph_moe_combine(q, l);
        }
        if (fillq > 0 && (fill_nwg == 0 || gemm_tail_idle(fill_nwg))) fill_moe(q, (float*)lds, fillq);
      }
      if (ph + 1 < hi) xcd_barrier(bar);
    }
}

#ifndef MK_CUTS
#define MK_CUTS 0
#endif
extern "C" void kernel_launch(void* const* d_in, const int* in_sizes, int n_in, void* d_out, int out_size, void* d_ws, size_t ws_size, hipStream_t stream) {
    static int grid = 0;
    if (grid == 0) {
        if (n_in != 32 || ws_size < WS_END) { fprintf(stderr, "kernel_launch: need 32 inputs and %zu bytes of workspace (got %d, %zu)\n", (size_t)WS_END, n_in, ws_size); grid = -1; return; }
        int dev = 0, cus = 0, per_cu = 0;
        if (hipGetDevice(&dev) != hipSuccess || hipDeviceGetAttribute(&cus, hipDeviceAttributeMultiprocessorCount, dev) != hipSuccess) { grid = -1; return; }
        if (hipFuncSetAttribute((const void*)mega_fwd, hipFuncAttributeMaxDynamicSharedMemorySize, LDS_BYTES) != hipSuccess) { fprintf(stderr, "kernel_launch: hipFuncSetAttribute failed\n"); grid = -1; return; }
        if (hipOccupancyMaxActiveBlocksPerMultiprocessor(&per_cu, (const void*)mega_fwd, NWAVES * 64, LDS_BYTES) != hipSuccess || per_cu < 1) fprintf(stderr, "kernel_launch: occupancy query says %d blocks per CU\n", per_cu);
        (void)hipGetLastError();
        grid = cus;
    }
    if (grid < 0) return;
    (void)hipMemsetAsync((char*)d_ws + WS_CTL, 0, CTL_ZERO_BYTES, stream);
    Args a{}; for (int i = 0; i < 32; ++i) a.p.in[i] = (const float*)d_in[i]; a.p.out = (float*)d_out; a.p.ws = (unsigned char*)d_ws;
#if MK_CUTS
    for (int ph = 0; ph < 24; ++ph) { a.ph_lo = ph; a.ph_hi = ph + 1; hipLaunchKernelGGL(mega_fwd, dim3(grid), dim3(NWAVES * 64), LDS_BYTES, stream, a); }
#else
    a.ph_lo = 0; a.ph_hi = 21;
    hipLaunchKernelGGL(mega_fwd, dim3(grid), dim3(NWAVES * 64), LDS_BYTES, stream, a);
#endif
}
```

```cpp
#include <hip/hip_runtime.h>
#include <stdint.h>
#include <cstdio>

typedef unsigned short bf16_t;
typedef float f32x4 __attribute__((ext_vector_type(4)));
typedef unsigned u32x4 __attribute__((ext_vector_type(4)));
typedef unsigned u32x2 __attribute__((ext_vector_type(2)));

constexpr int D = 1024, NB = 2, SEQ = 8192, CTX = 256, TL = NB * SEQ, TC = NB * CTX, MALL = TL + TC;
constexpr int NIN = 2144, NINP = 2304, DFF = 2816, NE = 8, DFFE = 3584, KEYS = CTX + SEQ;
constexpr int OFF_AQ = 0, OFF_AK = 256, OFF_AV = 384, OFF_BQ = 512, OFF_BK = 768, OFF_BV = 896, OFF_CQ = 1024, OFF_CK = 1280,
              OFF_CV = 1536, OFF_DCQ = 1792, OFF_DCKV = 1984, OFF_DKR = 2112;
constexpr int MOE_ROWS = 34816;
constexpr float EPS = 1e-6f;

constexpr size_t MiB = 1u << 20;
constexpr size_t WS_CTL = 0;
constexpr size_t WS_MOD = 1 * MiB;
constexpr size_t WS_ROPE = WS_MOD + 256 * 1024;
constexpr size_t WS_TOKE = WS_ROPE + 64 * 1024;
constexpr size_t WS_TOKP = WS_TOKE + TL * 8;
constexpr size_t WS_TOKG = WS_TOKP + TL * 8;
constexpr size_t WS_TEXP = WS_TOKG + TL * 8;
constexpr size_t WS_TOKS = WS_TEXP + 1024;
constexpr size_t WS_KM2 = WS_TOKS + TL * 8;
constexpr size_t WS_HCTX = 2 * MiB;
constexpr size_t WS_WMGU = 6 * MiB;
constexpr size_t WS_WMDN = WS_WMGU + 112 * MiB;
constexpr size_t WS_WDEAD = WS_WMDN + 56 * MiB;
constexpr size_t WS_WIN = WS_WDEAD;
constexpr size_t WS_WOUT = WS_WIN + 9 * MiB;
constexpr size_t WS_WUQ = WS_WOUT + 4 * MiB;
constexpr size_t WS_WUKV = WS_WUQ + 512 * 1024;
constexpr size_t WS_WFGU = WS_WUKV + 512 * 1024;
constexpr size_t WS_WFDN = WS_WFGU + 11 * MiB;
constexpr size_t WS_ACT = 205 * MiB;
static_assert(WS_WFDN + (size_t)1024 * 2816 * 2 <= WS_ACT, "weights fit");
constexpr size_t WS_ACT1 = WS_ACT;
constexpr size_t WS_P = WS_ACT + 33 * MiB;
constexpr size_t WS_QKV = WS_ACT + 108 * MiB;
constexpr size_t WS_PART = WS_ACT + 128 * MiB;
constexpr size_t WS_HIDF = WS_P;
constexpr size_t WS_HIDM = WS_WDEAD;
constexpr size_t WS_ASORT = WS_HIDM + 238 * MiB;
constexpr size_t WS_END = WS_ASORT + 68 * MiB;
constexpr size_t WS_ASORT8 = WS_HIDM + 120 * MiB;
static_assert((size_t)MOE_ROWS * DFFE <= 120 * MiB && WS_ASORT8 + (size_t)MOE_ROWS * D <= WS_ASORT, "fp8 MoE buffers");
static_assert(WS_QKV + 91 * MiB <= WS_END, "qkv fits");

#ifndef FP8_IN1
#define FP8_IN1 1
#endif
#ifndef FP8_OUT1
#define FP8_OUT1 0
#endif
struct Params { const float* in[32]; float* out; unsigned char* ws; };

struct QKVB { bf16_t *QA, *KA, *VA, *QB, *KB, *VB, *QC, *KC, *VC, *QD, *KD, *VD, *QAc, *QBc, *QCc, *QDc; };
__host__ __device__ inline QKVB make_qkv(unsigned char* ws) {
    QKVB q; bf16_t* p = (bf16_t*)(ws + WS_QKV);
    q.QA = p; p += (size_t)NB * 4 * SEQ * 64; q.KA = p; p += (size_t)NB * 2 * KEYS * 64; q.VA = p; p += (size_t)NB * 2 * KEYS * 64;
    q.QB = p; p += (size_t)NB * 4 * SEQ * 64; q.KB = p; p += (size_t)NB * 2 * KEYS * 64; q.VB = p; p += (size_t)NB * 2 * KEYS * 64;
    q.QC = p; p += (size_t)NB * 4 * SEQ * 64; q.KC = p; p += (size_t)NB * 4 * KEYS * 64; q.VC = p; p += (size_t)NB * 4 * KEYS * 64;
    q.QD = p; p += (size_t)NB * 4 * SEQ * 96; q.KD = p; p += (size_t)NB * 4 * KEYS * 96; q.VD = p; p += (size_t)NB * 4 * KEYS * 64;
    q.QAc = p; p += (size_t)NB * 4 * CTX * 64; q.QBc = p; p += (size_t)NB * 4 * CTX * 64; q.QCc = p; p += (size_t)NB * 4 * CTX * 64;
    q.QDc = p; p += (size_t)NB * 4 * CTX * 96;
    return q;
}

__device__ __forceinline__ float bf2f(unsigned v) { return __uint_as_float(v << 16); }
__device__ __forceinline__ float bflo(unsigned w) { return __uint_as_float(w << 16); }
__device__ __forceinline__ float bfhi(unsigned w) { return __uint_as_float(w & 0xffff0000u); }
__device__ __forceinline__ unsigned f2bf(float f) { unsigned u = __float_as_uint(f); return (u + 0x7fffu + ((u >> 16) & 1u)) >> 16; }
typedef float pk_f32x2 __attribute__((ext_vector_type(2))); typedef __bf16 pk_bf16x2 __attribute__((ext_vector_type(2)));
__device__ __forceinline__ unsigned pk2(float lo, float hi) { pk_f32x2 v = {lo, hi}; pk_bf16x2 b = __builtin_convertvector(v, pk_bf16x2); return __builtin_bit_cast(unsigned, b); }
template <int X> __device__ __forceinline__ float swz_xor(float v) { return __int_as_float(__builtin_amdgcn_ds_swizzle(__float_as_int(v), 0x1f | (X << 10))); }
__device__ __forceinline__ float half_sum(float v) { auto rr = __builtin_amdgcn_permlane32_swap(__float_as_uint(v), __float_as_uint(v), false, false); return __uint_as_float(rr[0]) + __uint_as_float(rr[1]); }
__device__ __forceinline__ float half_other(float v, int lane) { auto rr = __builtin_amdgcn_permlane32_swap(__float_as_uint(v), __float_as_uint(v), false, false); return __uint_as_float((lane & 32) ? rr[0] : rr[1]); }
__device__ __forceinline__ float wave_sum(float v) { v += swz_xor<1>(v); v += swz_xor<2>(v); v += swz_xor<4>(v); v += swz_xor<8>(v); v += swz_xor<16>(v); return half_sum(v); }
__device__ __forceinline__ float half_max(float v) { auto rr = __builtin_amdgcn_permlane32_swap(__float_as_uint(v), __float_as_uint(v), false, false); return fmaxf(__uint_as_float(rr[0]), __uint_as_float(rr[1])); }
__device__ __forceinline__ int opq(int v) { asm volatile("" : "+v"(v)); return v; }
template <class T> __device__ __forceinline__ T* opqp(T* p) { asm volatile("" : "+s"(p)); return p; }
__device__ __forceinline__ int opqs(int v) { asm volatile("" : "+s"(v)); return v; }
__device__ __forceinline__ float silu_f(float x) { return x / (1.f + expf(-x)); }
__device__ __forceinline__ unsigned pk4_fp8(float a, float b, float c, float d) { unsigned w = 0; w = __builtin_amdgcn_cvt_pk_fp8_f32(a, b, w, false); w = __builtin_amdgcn_cvt_pk_fp8_f32(c, d, w, true); return w; }
__device__ __forceinline__ float silu_fast(float x) { return x * __builtin_amdgcn_rcpf(1.f + __builtin_amdgcn_exp2f(-1.4426950408889634f * x)); }

constexpr int RT_R64 = 0, RT_C64 = 2048, RT_R32 = 3072, RT_C32 = 4096, RT_N = 4608;

namespace pg8 {
#define PG8_LAS __attribute__((address_space(3)))
typedef unsigned short bf16_t;
typedef short bf16x8 __attribute__((ext_vector_type(8)));
typedef float f32x4 __attribute__((ext_vector_type(4)));
typedef unsigned u32x4 __attribute__((ext_vector_type(4)));
constexpr int BM = 256, BK = 64, HALF = 128, HTB = HALF * BK * 2  , STAGE_BYTES = 8 * HTB, NXCD = 8, WGM = 8;

__host__ __device__ __forceinline__ int lds_byte(int r, int c) { const int st = (r >> 4) * 2 + (c >> 5), rr = r & 15, cc = c & 31, ob = rr * 64 + cc * 2; return st * 1024 + (ob ^ (((ob >> 9) & 1) << 5)); }
__host__ __device__ __forceinline__ void stage_rc(int b, int& R, int& C) { const int st = b / 1024, sb = b % 1024, swz = sb ^ (((sb >> 9) & 1) << 5); R = (st >> 1) * 16 + swz / 64; C = (st & 1) * 32 + (swz % 64) / 2; }
__host__ __device__ __forceinline__ int perm32(int rho) { const int n = rho >> 4, i = rho & 15; return 8 * (i >> 2) + 4 * n + (i & 3); }

struct Unit { int pm, pn, e, ks; };
struct Gemm { const bf16_t* A; const bf16_t* Bt; int K; size_t estride; int Kloop; };

struct StaticOrder {
    int nM, nN, nwg, G, c, S, pm0; const int* texp;
    __host__ __device__ void init(int nM_, int nN_, int G_, int c_, const int* texp_, int S_ = 1, int pm0_ = 0) { nM = nM_; nN = nN_; nwg = nM * nN; G = G_; c = c_; texp = texp_; S = S_; pm0 = pm0_; }
    __host__ __device__ bool next(int i, Unit& u) const {
        const long L = (long)i * G + c; if (L >= (long)nwg * S) return false;
        u.ks = (int)(L % S); int wgid = (int)(L / S); { const int q = nwg / NXCD, r = nwg % NXCD, xcd = wgid % NXCD, off = wgid / NXCD; wgid = (xcd < r ? xcd * (q + 1) : r * (q + 1) + (xcd - r) * q) + off; }
        const int nig = WGM * nN, gid = wgid / nig, fm = gid * WGM, gsz = (nM - fm) < WGM ? (nM - fm) : WGM;
        u.pm = fm + ((wgid % nig) % gsz); u.pn = (wgid % nig) / gsz; u.e = texp ? __builtin_amdgcn_readfirstlane(texp[u.pm]) : 0; u.pm += pm0; return true;
    }
    __device__ __forceinline__ void a_ready(const Unit&) const {}
    __device__ __forceinline__ void done(const Unit&) const {}
};

template <class Epi, class Sched, bool ALIGN_EPI = false, bool SP2 = false, bool FP8 = false>
__device__ __forceinline__ void gemm_phase(PG8_LAS unsigned char* lds, const Gemm g, const Sched& S, const Epi& E) {
    const int tid = opq((int)threadIdx.x), wid = __builtin_amdgcn_readfirstlane(tid >> 6), lane = tid & 63, wr = wid >> 2, wc = wid & 3, fr = lane & 15, fq = lane >> 4;
    const int K = g.K, nt = g.Kloop / BK;
    unsigned voffA[2], voffB[2];
#pragma unroll
    for (int i = 0; i < 2; ++i) { int R, C; stage_rc(tid * 16 + i * 8192, R, C); const int Rb = Epi::PERM ? ((R & ~31) + perm32(R & 31)) : R;
        voffA[i] = (unsigned)(R * K + C) * 2u; voffB[i] = (unsigned)(Rb * K + C) * 2u; }
    const size_t kstep = (size_t)(BK * 2);
    const size_t hstep = (size_t)HALF * K * 2;
    const size_t tstep = 2 * hstep;
    const unsigned ldsw = (unsigned)wid * 1024u;
    const int aoff = lds_byte(wr * 64 + fr, fq * 8), boff = lds_byte(wc * 32 + fr, fq * 8);
#define PG8_SA(b, h) (((b) * 2 + (h)) * HTB)
#define PG8_SB(b, h) ((4 + (b) * 2 + (h)) * HTB)
#define PG8_STAGE(bufoff, gbase, voff) do { _Pragma("unroll") for (int _i = 0; _i < 2; ++_i) \
        __builtin_amdgcn_global_load_lds((const unsigned*)((const char*)(gbase) + (voff)[_i]), (PG8_LAS unsigned*)(lds + (bufoff) + ldsw + _i * 8192), 16, 0, 0); } while (0)
#define PG8_LDA(dst, b, h) do { _Pragma("unroll") for (int m = 0; m < 4; ++m) _Pragma("unroll") for (int k = 0; k < 2; ++k) dst[m][k] = *(const PG8_LAS bf16x8*)(lds + PG8_SA(b, h) + aoff + m * 2048 + k * 1024); } while (0)
#define PG8_LDB(dst, b, h) do { _Pragma("unroll") for (int n = 0; n < 2; ++n) _Pragma("unroll") for (int k = 0; k < 2; ++k) dst[n][k] = *(const PG8_LAS bf16x8*)(lds + PG8_SB(b, h) + boff + n * 2048 + k * 1024); } while (0)
#define PG8_MMA(ai, bj, At, Bt) do { __builtin_amdgcn_s_setprio(1); \
        if constexpr (FP8) { const int sc_ = 0x7f7f7f7f; _Pragma("unroll") for (int m = 0; m < 4; ++m) _Pragma("unroll") for (int n = 0; n < 2; ++n) { \
            typedef int v4i_ __attribute__((ext_vector_type(4))); typedef int v8i_ __attribute__((ext_vector_type(8))); \
            const v8i_ bo_ = __builtin_shufflevector(__builtin_bit_cast(v4i_, Bt[n][0]), __builtin_bit_cast(v4i_, Bt[n][1]), 0, 1, 2, 3, 4, 5, 6, 7); \
            const v8i_ ao_ = __builtin_shufflevector(__builtin_bit_cast(v4i_, At[m][0]), __builtin_bit_cast(v4i_, At[m][1]), 0, 1, 2, 3, 4, 5, 6, 7); \
            asm("s_nop 1\n\tv_mfma_scale_f32_16x16x128_f8f6f4 %0, %1, %2, %0, %3, %3 op_sel_hi:[0,0,0]" : "+v"(acc[ai][bj][m][n]) : "v"(bo_), "v"(ao_), "v"(sc_)); } } \
        else { _Pragma("unroll") for (int m = 0; m < 4; ++m) _Pragma("unroll") for (int n = 0; n < 2; ++n) _Pragma("unroll") for (int k = 0; k < 2; ++k) \
            acc[ai][bj][m][n] = __builtin_amdgcn_mfma_f32_16x16x32_bf16(Bt[n][k], At[m][k], acc[ai][bj][m][n], 0, 0, 0); } \
        __builtin_amdgcn_s_setprio(0); } while (0)
#define PG8_WAIT_V(n) asm volatile("s_waitcnt vmcnt(" #n ")" ::: "memory")
#define PG8_WAIT_L(n) asm volatile("s_waitcnt lgkmcnt(" #n ")" ::: "memory")
#define PG8_BAR __builtin_amdgcn_s_barrier()
#define PG8_SCHED __builtin_amdgcn_sched_barrier(0)
    Unit cur, nxt; int ui = 0;
    if (!S.next(0, cur)) return;
    f32x4 acc[2][2][4][2];
#pragma unroll
    for (int a = 0; a < 2; ++a)
#pragma unroll
        for (int b = 0; b < 2; ++b)
#pragma unroll
            for (int m = 0; m < 4; ++m)
#pragma unroll
                for (int n = 0; n < 2; ++n) acc[a][b][m][n] = (f32x4){0.f, 0.f, 0.f, 0.f};
    bf16x8 At[4][2], B0[2][2], B1[2][2];
    const char* cA = (const char*)g.A + (size_t)cur.pm * tstep + (size_t)cur.ks * g.Kloop * 2; const char* cB = (const char*)g.Bt + (size_t)cur.e * g.estride + (size_t)cur.pn * tstep + (size_t)cur.ks * g.Kloop * 2;
    S.a_ready(cur);
    if constexpr (SP2) {
        PG8_STAGE(PG8_SB(0, 0), cB, voffB); PG8_STAGE(PG8_SB(0, 1), cB + hstep, voffB); PG8_STAGE(PG8_SA(0, 0), cA, voffA); PG8_STAGE(PG8_SA(0, 1), cA + hstep, voffA);
        if (wr == 1) PG8_BAR;
        PG8_WAIT_V(2); PG8_BAR;
        PG8_STAGE(PG8_SB(1, 0), cB + kstep, voffB); PG8_STAGE(PG8_SA(1, 0), cA + kstep, voffA); PG8_STAGE(PG8_SB(1, 1), cB + hstep + kstep, voffB);
        PG8_WAIT_V(6); PG8_BAR;
    } else {
        PG8_STAGE(PG8_SB(0, 0), cB, voffB); PG8_STAGE(PG8_SA(0, 0), cA, voffA); PG8_STAGE(PG8_SB(0, 1), cB + hstep, voffB); PG8_STAGE(PG8_SA(0, 1), cA + hstep, voffA);
        if (wr == 1) PG8_BAR;
        PG8_WAIT_V(4); PG8_BAR;
        PG8_STAGE(PG8_SB(1, 0), cB + kstep, voffB); PG8_STAGE(PG8_SA(1, 0), cA + kstep, voffA); PG8_STAGE(PG8_SB(1, 1), cB + hstep + kstep, voffB);
        PG8_WAIT_V(6); PG8_BAR;
    }
    for (;;) {
        const bool has_next = S.next(ui + 1, nxt);
        const char* nA = has_next ? (const char*)g.A + (size_t)nxt.pm * tstep + (size_t)nxt.ks * g.Kloop * 2 : cA; const char* nB = has_next ? (const char*)g.Bt + (size_t)nxt.e * g.estride + (size_t)nxt.pn * tstep + (size_t)nxt.ks * g.Kloop * 2 : cB;
        for (int t = 0; t < nt; t += 2) {
            const bool last = (t == nt - 2);
            const char* a1 = cA + (size_t)(t + 1) * kstep;
            const char* a2 = last ? nA : cA + (size_t)(t + 2) * kstep; const char* b2 = last ? nB : cB + (size_t)(t + 2) * kstep;
            const char* a3 = a2 + kstep; const char* b3 = b2 + kstep;
            if (last && has_next) S.a_ready(nxt);
            if constexpr (SP2) {
            PG8_LDB(B0, 0, 0); PG8_LDB(B1, 0, 1); PG8_SCHED; PG8_LDA(At, 0, 0); PG8_STAGE(PG8_SA(1, 1), a1 + hstep, voffA);
            PG8_WAIT_V(8); PG8_WAIT_L(0); PG8_BAR; PG8_MMA(0, 0, At, B0); PG8_MMA(0, 1, At, B1); PG8_BAR; PG8_SCHED;
            PG8_LDA(At, 0, 1); PG8_STAGE(PG8_SB(0, 0), b2, voffB); PG8_STAGE(PG8_SB(0, 1), b2 + hstep, voffB); PG8_STAGE(PG8_SA(0, 0), a2, voffA);
            PG8_WAIT_V(8); PG8_WAIT_L(0); PG8_BAR; PG8_MMA(1, 0, At, B0); PG8_MMA(1, 1, At, B1); PG8_BAR; PG8_SCHED;
            PG8_LDB(B0, 1, 0); PG8_LDB(B1, 1, 1); PG8_SCHED; PG8_LDA(At, 1, 0); PG8_STAGE(PG8_SA(0, 1), a2 + hstep, voffA);
            PG8_WAIT_V(8); PG8_WAIT_L(0); PG8_BAR; PG8_MMA(0, 0, At, B0); PG8_MMA(0, 1, At, B1); PG8_BAR; PG8_SCHED;
            PG8_LDA(At, 1, 1); PG8_STAGE(PG8_SB(1, 0), b3, voffB); PG8_STAGE(PG8_SB(1, 1), b3 + hstep, voffB); PG8_STAGE(PG8_SA(1, 0), a3, voffA);
            PG8_WAIT_V(8); PG8_WAIT_L(0); PG8_BAR; PG8_MMA(1, 0, At, B0); PG8_MMA(1, 1, At, B1); PG8_BAR; PG8_SCHED;
            } else {
            PG8_LDB(B0, 0, 0); PG8_SCHED; PG8_LDA(At, 0, 0); PG8_STAGE(PG8_SA(1, 1), a1 + hstep, voffA);
            PG8_WAIT_L(8); PG8_BAR; PG8_WAIT_L(0); PG8_MMA(0, 0, At, B0); PG8_BAR; PG8_SCHED;
            PG8_LDB(B1, 0, 1); PG8_STAGE(PG8_SB(0, 0), b2, voffB);
            PG8_BAR; PG8_WAIT_L(0); PG8_MMA(0, 1, At, B1); PG8_BAR;
            PG8_LDA(At, 0, 1); PG8_STAGE(PG8_SA(0, 0), a2, voffA);
            PG8_BAR; PG8_WAIT_L(0); PG8_MMA(1, 0, At, B0); PG8_BAR; PG8_SCHED;
            PG8_STAGE(PG8_SB(0, 1), b2 + hstep, voffB);
            PG8_WAIT_V(6); PG8_BAR; PG8_MMA(1, 1, At, B1); PG8_BAR;
            PG8_LDB(B0, 1, 0); PG8_SCHED; PG8_LDA(At, 1, 0); PG8_STAGE(PG8_SA(0, 1), a2 + hstep, voffA);
            PG8_WAIT_L(8); PG8_BAR; PG8_WAIT_L(0); PG8_MMA(0, 0, At, B0); PG8_BAR; PG8_SCHED;
            PG8_LDB(B1, 1, 1); PG8_STAGE(PG8_SB(1, 0), b3, voffB);
            PG8_BAR; PG8_WAIT_L(0); PG8_MMA(0, 1, At, B1); PG8_BAR;
            PG8_LDA(At, 1, 1); PG8_STAGE(PG8_SA(1, 0), a3, voffA);
            PG8_BAR; PG8_WAIT_L(0); PG8_MMA(1, 0, At, B0); PG8_BAR; PG8_SCHED;
            PG8_STAGE(PG8_SB(1, 1), b3 + hstep, voffB);
            PG8_WAIT_V(6); PG8_BAR; PG8_MMA(1, 1, At, B1); PG8_BAR;
            }
        }
        if constexpr (ALIGN_EPI) { if (wr == 0) PG8_BAR; }
        if constexpr (FP8) {
            asm volatile("s_nop 15\n\ts_nop 7" ::: "memory");
#pragma unroll
            for (int a_ = 0; a_ < 2; ++a_)
#pragma unroll
                for (int b_ = 0; b_ < 2; ++b_)
#pragma unroll
                    for (int m_ = 0; m_ < 4; ++m_) asm volatile("" : "+v"(acc[a_][b_][m_][0]), "+v"(acc[a_][b_][m_][1]));
        }
        if constexpr (!Epi::AFTER_DRAIN) { E(acc, cur, wr, wc, fr, fq); S.done(cur); }
        if (!has_next) break;
#pragma unroll
        for (int a = 0; a < 2; ++a)
#pragma unroll
            for (int b = 0; b < 2; ++b)
#pragma unroll
                for (int m = 0; m < 4; ++m)
#pragma unroll
                    for (int n = 0; n < 2; ++n) acc[a][b][m][n] = (f32x4){0.f, 0.f, 0.f, 0.f};
        cur = nxt; cA = nA; cB = nB; ++ui;
        if constexpr (ALIGN_EPI) { if (wr == 1) PG8_BAR; }
    }
    PG8_WAIT_V(0);
    if constexpr (!ALIGN_EPI) { if (wr == 0) PG8_BAR; }
    PG8_BAR;
    if constexpr (Epi::AFTER_DRAIN) { E.fused(acc, cur, wr, wc, fr, fq, lds, wid, lane); S.done(cur); }
#undef PG8_SA
#undef PG8_SB
#undef PG8_STAGE
#undef PG8_LDA
#undef PG8_LDB
#undef PG8_MMA
#undef PG8_WAIT_V
#undef PG8_WAIT_L
#undef PG8_BAR
#undef PG8_SCHED
}
}

#define GAS __attribute__((address_space(1)))
#define LAS __attribute__((address_space(3)))
typedef GAS unsigned gu32;
#define RLX_AGENT __ATOMIC_RELAXED, __HIP_MEMORY_SCOPE_AGENT
constexpr int NWAVES = 8;
constexpr int CW_BAR = 4096;
constexpr int RING_BYTES = 131072, LDSCTL_OFF = RING_BYTES, MISC_OFF = LDSCTL_OFF + 320, LDS_BYTES = 147456;
constexpr size_t CTL_ZERO_BYTES = 65536;

#define XB_TMO      128
#define XB_XCNT(j)  (256  + 64 * (j))
#define XB_XSUB(j)  (1280 + 64 * (j))
#define XB_XGEN(j)  (2304 + 64 * (j))
#define XB_TOP      3328
#define XB_TOPGEN   3392
#define XCD_BAR_WORDS 3456
#define XB_SPIN_CAP (1u << 18)

__device__ __forceinline__ unsigned xb_ld(unsigned* p)              { return __hip_atomic_load(p, __ATOMIC_RELAXED, __HIP_MEMORY_SCOPE_AGENT); }
__device__ __forceinline__ unsigned xb_add(unsigned* p, unsigned v) { return __hip_atomic_fetch_add(p, v, __ATOMIC_RELAXED, __HIP_MEMORY_SCOPE_AGENT); }
__device__ __forceinline__ unsigned xb_xcc_id() { return (unsigned)__builtin_amdgcn_s_getreg((3 << 11) | 20) & 0xFu; }
#define XB_SPIN(cond, bar) do { unsigned _sp = 0; while (cond) { __builtin_amdgcn_s_sleep(1); \
    if ((++_sp & 255u) == 0u) { if (xb_ld(&(bar)[XB_TMO])) break; if (_sp > XB_SPIN_CAP) { atomicAdd(&(bar)[XB_TMO], 1u); break; } } } } while (0)

struct XcdBarrier {
    unsigned* bar; unsigned x;
    volatile LAS unsigned* st;
};

__device__ __forceinline__ XcdBarrier xcd_barrier_post(unsigned* bar, volatile LAS unsigned* st) {
    XcdBarrier b; b.bar = bar; b.x = xb_xcc_id(); b.st = st;
    if (threadIdx.x == 0) (void)xb_add(&bar[XB_XCNT(b.x)], 1u);
    return b;
}
__device__ __forceinline__ void xcd_barrier_complete(unsigned* bar, unsigned x, unsigned& nloc, unsigned& nx) {
    const unsigned G = gridDim.x * gridDim.y * gridDim.z;
    unsigned sum, cnt, mine, sp = 0u;
    for (;;) {
        sum = 0u; cnt = 0u; mine = 0u;
        unsigned cj[16];
#pragma unroll
        for (unsigned j = 0; j < 16; ++j) asm volatile("global_load_dword %0, %1, off sc1" : "=v"(cj[j]) : "v"(&bar[XB_XCNT(j)]) : "memory");
        asm volatile("s_waitcnt vmcnt(0)" : "+v"(cj[0]), "+v"(cj[1]), "+v"(cj[2]), "+v"(cj[3]), "+v"(cj[4]), "+v"(cj[5]), "+v"(cj[6]), "+v"(cj[7]), "+v"(cj[8]), "+v"(cj[9]), "+v"(cj[10]), "+v"(cj[11]), "+v"(cj[12]), "+v"(cj[13]), "+v"(cj[14]), "+v"(cj[15]) :: "memory");
#pragma unroll
        for (unsigned j = 0; j < 16; ++j) { const unsigned c = cj[j]; sum += c; cnt += (c > 0u) ? 1u : 0u; mine = (j == x) ? c : mine; }
        if (sum == G) break;
        __builtin_amdgcn_s_sleep(1);
        if ((++sp & 255u) == 0u) { if (xb_ld(&bar[XB_TMO])) break; if (sp > XB_SPIN_CAP) { atomicAdd(&bar[XB_TMO], 1u); break; } }
    }
    nloc = mine > 0u ? mine : 1u; nx = cnt > 0u ? cnt : 1u;
}

__device__ __forceinline__ void xcd_barrier(const XcdBarrier& b) {
    asm volatile("s_waitcnt vmcnt(0)" ::: "memory");
    __syncthreads();
    if (threadIdx.x == 0) {
        unsigned* bar = b.bar;
        __builtin_amdgcn_s_waitcnt(0);
        unsigned nloc = b.st[0], nx = b.st[1];
        if (nloc == 0u) { xcd_barrier_complete(bar, b.x, nloc, nx); b.st[0] = nloc; b.st[1] = nx; }
        const unsigned old = xb_add(&bar[XB_XSUB(b.x)], 1u);
        const unsigned gen = old / nloc;
        if (old + 1u == (gen + 1u) * nloc) {
            __builtin_amdgcn_fence(__ATOMIC_RELEASE, "agent");
            asm volatile("s_waitcnt vmcnt(0)" ::: "memory");
            const unsigned og = xb_add(&bar[XB_TOP], 1u);
            const unsigned tg = og / nx;
            if (og + 1u == (tg + 1u) * nx) xb_add(&bar[XB_TOPGEN], 1u);
            else XB_SPIN(xb_ld(&bar[XB_TOPGEN]) == tg, bar);
            __builtin_amdgcn_fence(__ATOMIC_ACQUIRE, "agent");
            xb_add(&bar[XB_XGEN(b.x)], 1u);
            asm volatile("s_waitcnt vmcnt(0)" ::: "memory");
        } else {
            XB_SPIN(xb_ld(&bar[XB_XGEN(b.x)]) == gen, bar);
            __builtin_amdgcn_fence(__ATOMIC_ACQUIRE, "agent");
            asm volatile("s_waitcnt vmcnt(0)" ::: "memory");
        }
    }
    __syncthreads();
}


template <class F> struct EpiAdapt {
    static constexpr bool PERM = false, AFTER_DRAIN = false; F f;
    __device__ __forceinline__ void operator()(const pg8::f32x4 (&acc)[2][2][4][2], const pg8::Unit& u, int wr, int wc, int fr, int fq) const {
#pragma unroll
        for (int ai = 0; ai < 2; ++ai)
#pragma unroll
            for (int m = 0; m < 4; ++m) { const int row = u.pm * 256 + ai * 128 + wr * 64 + m * 16 + fr;
                if constexpr (F::PAIR) f(row, u.pn * 128 + wc * 32 + fq * 8, acc[ai][0][m][0], acc[ai][0][m][1], acc[ai][1][m][0], acc[ai][1][m][1]);
                else { f(row, u.pn * 8 + wc, fq, acc[ai][0][m][0], acc[ai][0][m][1], u.ks); f(row, u.pn * 8 + 4 + wc, fq, acc[ai][1][m][0], acc[ai][1][m][1], u.ks); }
                asm volatile("" ::: "memory"); }
    }
};
struct EpiBf16Perm { static constexpr bool PAIR = false; bf16_t* O; int ldo; int pad;
    __device__ __forceinline__ void operator()(int row, int g, int fq, f32x4 v0, f32x4 v1, int) const {
        u32x4 w; w.x = pk2(v0.x, v0.y); w.y = pk2(v0.z, v0.w); w.z = pk2(v1.x, v1.y); w.w = pk2(v1.z, v1.w);
        *(u32x4*)(O + (size_t)row * ldo + 32 * g + 8 * fq) = w; } };
struct EpiResid { static constexpr bool PAIR = false; const float* hl_in; const float* hc_in; float* hl_out; float* hc_out; const float* mod; int goff; int split;
    __device__ __forceinline__ void operator()(int row, int g, int fq, f32x4 v0, f32x4 v1, int ks) const {
        const int c0 = 32 * g + 4 * fq; const float* hin; float* hout; const float* gv;
        if (row < TL) { hin = hl_in + (size_t)row * D; hout = hl_out + (size_t)row * D; gv = mod + (row / SEQ) * 6144 + goff; }
        else { hin = hc_in + (size_t)(row - TL) * D; hout = hc_out + (size_t)(row - TL) * D; gv = mod + 2 * 6144 + goff; }
        if (split) { float* po = hout + (size_t)ks * TC * D; *(f32x4*)(po + c0) = *(const f32x4*)(gv + c0) * v0; *(f32x4*)(po + c0 + 16) = *(const f32x4*)(gv + c0 + 16) * v1; return; }
        *(f32x4*)(hout + c0) = *(const f32x4*)(hin + c0) + *(const f32x4*)(gv + c0) * v0;
        *(f32x4*)(hout + c0 + 16) = *(const f32x4*)(hin + c0 + 16) + *(const f32x4*)(gv + c0 + 16) * v1; } };
template <> struct EpiAdapt<EpiResid> {
    static constexpr bool PERM = false, AFTER_DRAIN = false; EpiResid f;
    __device__ __forceinline__ void operator()(const pg8::f32x4 (&acc)[2][2][4][2], const pg8::Unit& u, int wr, int wc, int fr, int fq) const {
        const int row0 = u.pm * 256 + wr * 64 + fr, cb = 32 * (u.pn * 8 + wc) + 4 * fq;
        const bool latent = u.pm * 256 < TL;
        const float* gvp = f.mod + (latent ? (u.pm * 256) / SEQ : 2) * 6144 + f.goff + cb;
        const float* hin = latent ? f.hl_in + (size_t)row0 * D + cb : f.hc_in + (size_t)(row0 - TL) * D + cb;
        float* hout = latent ? f.hl_out + (size_t)row0 * D + cb : f.hc_out + (size_t)(row0 - TL) * D + cb + (f.split ? (size_t)u.ks * TC * D : 0);
        f32x4 gv[2][2];
#pragma unroll
        for (int bj = 0; bj < 2; ++bj)
#pragma unroll
            for (int h = 0; h < 2; ++h) gv[bj][h] = *(const f32x4*)(gvp + 128 * bj + 16 * h);
        if (f.split) {
#pragma unroll
            for (int ai = 0; ai < 2; ++ai)
#pragma unroll
                for (int m = 0; m < 4; ++m)
#pragma unroll
                    for (int bj = 0; bj < 2; ++bj)
#pragma unroll
                        for (int h = 0; h < 2; ++h) *(f32x4*)(hout + (size_t)(128 * ai + 16 * m) * D + 128 * bj + 16 * h) = gv[bj][h] * acc[ai][bj][m][h];
            return;
        }
#pragma unroll
        for (int ai = 0; ai < 2; ++ai)
#pragma unroll
            for (int mp = 0; mp < 4; mp += 2) {
                f32x4 hv[2][2][2];
#pragma unroll
                for (int m = 0; m < 2; ++m)
#pragma unroll
                    for (int bj = 0; bj < 2; ++bj)
#pragma unroll
                        for (int h = 0; h < 2; ++h) hv[m][bj][h] = *(const f32x4*)(hin + (size_t)(128 * ai + 16 * (mp + m)) * D + 128 * bj + 16 * h);
                __builtin_amdgcn_sched_barrier(0);
#pragma unroll
                for (int m = 0; m < 2; ++m)
#pragma unroll
                    for (int bj = 0; bj < 2; ++bj)
#pragma unroll
                        for (int h = 0; h < 2; ++h) *(f32x4*)(hout + (size_t)(128 * ai + 16 * (mp + m)) * D + 128 * bj + 16 * h) = hv[m][bj][h] + gv[bj][h] * acc[ai][bj][mp + m][h];
                __builtin_amdgcn_sched_barrier(0);
            }
    }
};
struct EpiSwiglu { static constexpr bool PAIR = true; bf16_t* H; int ldh; int pad;
    __device__ __forceinline__ void operator()(int row, int col, f32x4 g0, f32x4 u0, f32x4 g1, f32x4 u1) const {
        u32x4 w; w.x = pk2(silu_fast(g0.x) * u0.x, silu_fast(g0.y) * u0.y); w.y = pk2(silu_fast(g0.z) * u0.z, silu_fast(g0.w) * u0.w);
        w.z = pk2(silu_fast(g1.x) * u1.x, silu_fast(g1.y) * u1.y); w.w = pk2(silu_fast(g1.z) * u1.z, silu_fast(g1.w) * u1.w);
        *(u32x4*)(H + (size_t)row * ldh + col) = w; } };
struct EpiSwiglu8 { static constexpr bool PAIR = true; unsigned char* H; int ldh; int pad;
    __device__ __forceinline__ void operator()(int row, int col, f32x4 g0, f32x4 u0, f32x4 g1, f32x4 u1) const {
        u32x2 w; w.x = pk4_fp8(silu_fast(g0.x) * u0.x, silu_fast(g0.y) * u0.y, silu_fast(g0.z) * u0.z, silu_fast(g0.w) * u0.w);
        w.y = pk4_fp8(silu_fast(g1.x) * u1.x, silu_fast(g1.y) * u1.y, silu_fast(g1.z) * u1.z, silu_fast(g1.w) * u1.w);
        *(u32x2*)(H + (size_t)row * ldh + col) = w; } };
template <class F, bool FP8 = false> __device__ __forceinline__ void run_gemm(LAS unsigned char* lds, const bf16_t* A, const bf16_t* Bt, int K, int nM, int nN, const int* texp, size_t estride_bytes, const F& f, int slices = 1, int pm0 = 0) {
    pg8::Gemm g{A, Bt, K, estride_bytes, K / slices}; pg8::StaticOrder S; S.init(nM, nN, opqs((int)gridDim.x), opqs((int)blockIdx.x), texp, slices, pm0);
    EpiAdapt<F> E{f};
    pg8::gemm_phase<EpiAdapt<F>, pg8::StaticOrder, true, true, FP8>(lds, g, S, E);
}
__device__ __forceinline__ bool gemm_tail_idle(int nwg) { const int G = opqs((int)gridDim.x), r = nwg % G; return r != 0 && opqs((int)blockIdx.x) >= r; }

__device__ __forceinline__ float conv_src(const Params& p, int mode, const float* W0, const float* W1, int N, int nvalid, int k, int nb) {
    if (mode == 0) return W0[(size_t)k * N + nb];
    if (mode == 1) { const int col = (nb & ~31) + 8 * ((nb >> 2) & 3) + 4 * ((nb >> 4) & 1) + (nb & 3); return col < nvalid ? W0[(size_t)k * N + col] : 0.f; }
    const int col = 16 * (nb >> 5) + (nb & 15); return ((nb >> 4) & 1) ? W1[(size_t)k * N + col] : W0[(size_t)k * N + col];
}
constexpr int CT_WIN = 0, CT_WOUT = 2304, CT_WUQ = 3328, CT_WUKV = 3400, CT_WFGU = 3464, CT_WFDN = 6280, CT_WMGU = 7688, CT_WMDN = 36360, CT_END = 50696;
constexpr int IT_MODS = 192, IT_ROPE = 9;
__device__ __forceinline__ void conv_item(const Params& p, int it, float* scr, int lane) {
    int t = it;
    bf16_t* dst; const float* W0; const float* W1 = nullptr; int K, N, nvalid = 0, mode; bool f8 = it >= CT_WMGU;
    if (t < CT_WOUT) { const int l = t / 1152; t %= 1152; f8 = FP8_IN1 && l == 1; dst = (bf16_t*)(p.ws + WS_WIN) + (size_t)l * NINP * D; W0 = p.in[8] + (size_t)l * D * NIN; K = D; N = NIN; nvalid = NIN; mode = 1; }
    else if (t < CT_WUQ) { t -= CT_WOUT; const int l = t / 512; t %= 512; f8 = FP8_OUT1 && l == 1; dst = (bf16_t*)(p.ws + WS_WOUT) + (size_t)l * D * D; W0 = p.in[24] + (size_t)l * D * D; K = D; N = D; mode = 0; }
    else if (t < CT_WUKV) { t -= CT_WUQ; const int l = t / 36; t %= 36; dst = (bf16_t*)(p.ws + WS_WUQ) + (size_t)l * 384 * 192; W0 = p.in[18] + (size_t)l * 192 * 384; K = 192; N = 384; mode = 0; }
    else if (t < CT_WFGU) { t -= CT_WUKV; const int l = t / 32; t %= 32; dst = (bf16_t*)(p.ws + WS_WUKV) + (size_t)l * 512 * 128; W0 = p.in[20] + (size_t)l * 128 * 512; K = 128; N = 512; mode = 0; }
    else if (t < CT_WFDN) { t -= CT_WFGU; dst = (bf16_t*)(p.ws + WS_WFGU); W0 = p.in[25]; W1 = p.in[26]; K = D; N = DFF; mode = 2; }
    else if (t < CT_WMGU) { t -= CT_WFDN; dst = (bf16_t*)(p.ws + WS_WFDN); W0 = p.in[27]; K = DFF; N = D; mode = 0; }
    else if (t < CT_WMDN) { t -= CT_WMGU; const int e = t / 3584; t %= 3584; dst = (bf16_t*)(p.ws + WS_WMGU + (size_t)e * 2 * DFFE * D); W0 = p.in[29] + (size_t)e * D * DFFE; W1 = p.in[30] + (size_t)e * D * DFFE; K = D; N = DFFE; mode = 2; }
    else { t -= CT_WMDN; const int e = t / 1792; t %= 1792; dst = (bf16_t*)(p.ws + WS_WMDN + (size_t)e * D * DFFE); W0 = p.in[31] + (size_t)e * DFFE * D; K = DFFE; N = D; nvalid = D; mode = 1; }
    const int ktl = K / 64, n0 = (t / ktl) * 32, k0 = (t % ktl) * 64;
    const int n4 = lane & 7; const float* src; bool valid = true; int ln;
    if (mode == 0) { src = W0 + n0 + 4 * n4; ln = 4 * n4; }
    else if (mode == 1) { const int col = n0 + 4 * n4; valid = col < nvalid; src = W0 + (valid ? col : 0); ln = 16 * (n4 & 1) + 4 * (n4 >> 1); }
    else { src = ((n4 >> 2) ? W1 : W0) + 128 * (n0 >> 8) + 32 * ((n0 >> 5) & 3) + 8 * (n4 & 3) + 4 * ((n0 >> 7) & 1); ln = 16 * (n4 >> 2) + 4 * (n4 & 3); }
    src += (size_t)(k0 + (lane >> 3)) * N;
    f32x4 v[8];
#pragma unroll
    for (int i = 0; i < 8; ++i) v[i] = valid ? *(const f32x4*)(src + (size_t)(8 * i) * N) : (f32x4){0.f, 0.f, 0.f, 0.f};
#pragma unroll
    for (int i = 0; i < 8; ++i) *(f32x4*)(scr + ((lane >> 3) + 8 * i) * 36 + ln) = v[i];
    if (f8) {
        unsigned char* d8 = (unsigned char*)dst; const int c = lane & 3;
#pragma unroll
        for (int j = 0; j < 2; ++j) { const int n = (lane >> 2) + 16 * j; const float* sp = scr + (16 * c) * 36 + n;
            u32x4 o; o.x = pk4_fp8(sp[0 * 36], sp[1 * 36], sp[2 * 36], sp[3 * 36]); o.y = pk4_fp8(sp[4 * 36], sp[5 * 36], sp[6 * 36], sp[7 * 36]);
            o.z = pk4_fp8(sp[8 * 36], sp[9 * 36], sp[10 * 36], sp[11 * 36]); o.w = pk4_fp8(sp[12 * 36], sp[13 * 36], sp[14 * 36], sp[15 * 36]);
            *(u32x4*)(d8 + (size_t)(n0 + n) * K + k0 + 16 * c) = o; }
        return;
    }
    const int c = lane & 7;
#pragma unroll
    for (int j = 0; j < 4; ++j) { const int n = (lane >> 3) + 8 * j; const float* sp = scr + (8 * c) * 36 + n;
        u32x4 o; o.x = pk2(sp[0 * 36], sp[1 * 36]); o.y = pk2(sp[2 * 36], sp[3 * 36]); o.z = pk2(sp[4 * 36], sp[5 * 36]); o.w = pk2(sp[6 * 36], sp[7 * 36]);
        *(u32x4*)(dst + (size_t)(n0 + n) * K + k0 + 8 * c) = o; }
}
constexpr int CW_FILL = 1024;
__device__ __forceinline__ void fill_moe(const Params& p, float* lds, int quota) {
    const int tid = opq((int)threadIdx.x), lane = tid & 63, wv = tid >> 6;
    float* scr = lds + wv * (64 * 36); volatile int* slot = (volatile int*)(lds + 8 * 64 * 36);
    constexpr int NIT = CT_END - CT_WMGU;
    for (;;) {
        const int claim = quota > 64 ? 4 : quota;
        __syncthreads();
        if (tid == 0) *slot = (int)atomicAdd((unsigned*)(p.ws + WS_CTL) + CW_FILL, 8u * (unsigned)claim);
        __syncthreads();
        const int idx = *slot;
        if (idx >= NIT) break;
        const int end = min(idx + 8 * claim, NIT);
        for (int it = idx + wv; it < end; it += 8) conv_item(p, CT_WMGU + it, scr, lane);
        if (quota <= 64) break;
    }
    __syncthreads();
}
__device__ __forceinline__ void ph_prologue(const Params& p, float* lds) {
    const int tid = opq((int)threadIdx.x), lane = tid & 63, wv = tid >> 6;
    for (int it = blockIdx.x; it < IT_MODS + IT_ROPE; it += gridDim.x) {
        if (it < IT_MODS) {
            const int l = it / 96, n0 = (it % 96) * 64, nn = tid & 63, c4 = tid & 15, kc = tid >> 4;
            float* sv = lds; float* red = lds + 3 * 1024;
            __syncthreads();
            { float xs[6];
#pragma unroll
              for (int j = 0; j < 6; ++j) { const int i = tid + 512 * j, v = i >> 10, k = i & 1023; xs[j] = (v < 2) ? p.in[1][v * D + k] : p.in[3][k]; }
              __builtin_amdgcn_sched_barrier(0);
#pragma unroll
              for (int j = 0; j < 6; ++j) sv[tid + 512 * j] = silu_f(xs[j]); }
            const float bias_ = (tid < 192) ? p.in[5][l * 6144 + n0 + nn] : 0.f;
            __syncthreads();
            const float* w = p.in[4] + ((size_t)l * D + kc * 32) * 6144 + n0 + 4 * c4;
            f32x4 a0 = {0.f, 0.f, 0.f, 0.f}, a1 = a0, a2 = a0;
#pragma unroll 1
            for (int kh = 0; kh < 32; kh += 16) {
                f32x4 wv_[16];
#pragma unroll
                for (int k = 0; k < 16; ++k) wv_[k] = *(const f32x4*)(w + (size_t)(kh + k) * 6144);
                __builtin_amdgcn_sched_barrier(0);
#pragma unroll
                for (int k = 0; k < 16; ++k) { a0 += sv[kc * 32 + kh + k] * wv_[k]; a1 += sv[1024 + kc * 32 + kh + k] * wv_[k]; a2 += sv[2048 + kc * 32 + kh + k] * wv_[k]; }
                __builtin_amdgcn_sched_barrier(0);
            }
            *(f32x4*)(red + (kc * 3 + 0) * 64 + 4 * c4) = a0; *(f32x4*)(red + (kc * 3 + 1) * 64 + 4 * c4) = a1; *(f32x4*)(red + (kc * 3 + 2) * 64 + 4 * c4) = a2;
            __syncthreads();
            if (tid < 192) { const int v = tid >> 6; float s = bias_;
#pragma unroll
                for (int q = 0; q < 32; ++q) s += red[(q * 3 + v) * 64 + nn];
                ((float*)(p.ws + WS_MOD))[((size_t)l * 3 + v) * 6144 + n0 + nn] = s; }
        } else {
            const int idx = (it - IT_MODS) * 512 + tid;
            if (idx < RT_N) {
                int pos, i, nf;
                if (idx < RT_C64) { pos = idx / 16; i = idx % 16; nf = 16; }
                else if (idx < RT_R32) { pos = (idx - RT_C64) / 16; i = idx % 16; nf = 16; }
                else if (idx < RT_C32) { pos = (idx - RT_R32) / 8; i = idx % 8; nf = 8; }
                else { pos = (idx - RT_C32) / 8; i = idx % 8; nf = 8; }
                const float inv = powf(10000.0f, -(float)i / (float)nf);
                const float ang = (float)pos * inv;
                const float rev = ang * 0.15915494309189535f;
                ((float2*)(p.ws + WS_ROPE))[idx] = make_float2(__builtin_amdgcn_cosf(rev), __builtin_amdgcn_sinf(rev));
            }
        }
    }
    if (blockIdx.x == gridDim.x - 1) {
        const int l_ = wv >> 2, mix = wv & 3, n = mix == 3 ? 96 : 64; const float* gk = (mix == 0 ? p.in[10] : mix == 1 ? p.in[13] : mix == 2 ? p.in[15] : p.in[22]) + l_ * n;
        float gm = fabsf(gk[lane]); if (mix == 3 && lane < 32) gm = fmaxf(gm, fabsf(gk[64 + lane]));
        gm = fmaxf(gm, swz_xor<1>(gm)); gm = fmaxf(gm, swz_xor<2>(gm)); gm = fmaxf(gm, swz_xor<4>(gm)); gm = fmaxf(gm, swz_xor<8>(gm)); gm = fmaxf(gm, swz_xor<16>(gm)); gm = half_max(gm);
        if (lane == 0) ((float*)(p.ws + WS_KM2))[wv] = (float)n * gm * gm; }
    __syncthreads();
    for (int i = blockIdx.x * 512 + tid; i < TC * D / 4; i += gridDim.x * 512) ((f32x4*)(p.ws + WS_HCTX))[i] = ((const f32x4*)p.in[2])[i];
    float* scr = lds + wv * (64 * 36);
    for (int it = wv * gridDim.x + blockIdx.x; it < CT_WMGU; it += 8 * gridDim.x) conv_item(p, it, scr, lane);
    __syncthreads();
}

template <int WHICH, bool ROUTER> __device__ __forceinline__ void ph_norm(const Params& p, int layer, int nrows, unsigned* lcnt, int nslab) {
    const int tx = opq((int)threadIdx.x), lane = tx & 63, gw = (blockIdx.x * 512 + tx) >> 6, ngw = (gridDim.x * 512) >> 6;
    if (ROUTER) { if (tx < 16) lcnt[tx] = 0u; __syncthreads(); }
    const float* hl = (layer == 0 && WHICH == 1) ? p.in[0] : p.out;
    const float* hc = (layer == 0 && WHICH == 1) ? p.in[2] : (const float*)(p.ws + WS_HCTX);
    const float* gain = p.in[WHICH == 1 ? 6 : 7] + layer * D;
    const float* mod = (const float*)(p.ws + WS_MOD) + (size_t)layer * 3 * 6144;
    bf16_t* dst = (bf16_t*)(p.ws + WS_ACT1);
    f32x4 rtw[4][4][2];
    if (ROUTER) {
#pragma unroll
        for (int j = 0; j < 4; ++j)
#pragma unroll
            for (int i = 0; i < 4; ++i) { const float* rt = p.in[28] + (size_t)(256 * j + 4 * lane + i) * 8; rtw[j][i][0] = *(const f32x4*)rt; rtw[j][i][1] = *(const f32x4*)(rt + 4); }
    }
    f32x4 ga[4], sb[4]; int cur_var = -1;
    f32x4 v[4];
    if (gw < nrows) { const float* s0 = (gw < TL) ? hl + (size_t)gw * D : hc + (size_t)(gw - TL) * D;
#pragma unroll
        for (int j = 0; j < 4; ++j) v[j] = *(const f32x4*)(s0 + 256 * j + 4 * lane); }
    for (int m = gw; m < nrows; m += ngw) {
        f32x4 vn[4];
        { const int mc = (m + ngw < nrows) ? m + ngw : m; const float* sn = (mc < TL) ? hl + (size_t)mc * D : hc + (size_t)(mc - TL) * D;
#pragma unroll
          for (int j = 0; j < 4; ++j) vn[j] = *(const f32x4*)(sn + 256 * j + 4 * lane); }
        __builtin_amdgcn_sched_barrier(0);
        const int var = m < TL ? m / SEQ : 2;
        if (var != cur_var) { cur_var = var; const float* mv = mod + var * 6144; const float* shp = mv + (WHICH == 1 ? 0 : 3) * D; const float* scp = mv + (WHICH == 1 ? 1 : 4) * D;
#pragma unroll
            for (int j = 0; j < 4; ++j) { const int c = 256 * j + 4 * lane; ga[j] = *(const f32x4*)(gain + c) * (*(const f32x4*)(scp + c) + 1.f); sb[j] = *(const f32x4*)(shp + c); } }
        float ss = 0.f;
        if (!ROUTER && m >= TL && nslab > 0) {
            const float* pp = (const float*)(p.ws + WS_PART) + (size_t)(m - TL) * D + 4 * lane;
            for (int sl0 = 0; sl0 < nslab; sl0 += 4) {
                f32x4 t[4][4];
#pragma unroll
                for (int s4 = 0; s4 < 4; ++s4) { const float* ps = pp + (size_t)min(sl0 + s4, nslab - 1) * TC * D;
#pragma unroll
                    for (int j = 0; j < 4; ++j) t[s4][j] = *(const f32x4*)(ps + 256 * j); }
                __builtin_amdgcn_sched_barrier(0);
#pragma unroll
                for (int s4 = 0; s4 < 4; ++s4) { if (sl0 + s4 < nslab) {
#pragma unroll
                    for (int j = 0; j < 4; ++j) v[j] = v[j] + t[s4][j]; } }
                __builtin_amdgcn_sched_barrier(0);
            }
#pragma unroll
            for (int j = 0; j < 4; ++j) *(f32x4*)((float*)(p.ws + WS_HCTX) + (size_t)(m - TL) * D + 256 * j + 4 * lane) = v[j];
        }
#pragma unroll
        for (int j = 0; j < 4; ++j) ss += v[j].x * v[j].x + v[j].y * v[j].y + v[j].z * v[j].z + v[j].w * v[j].w;
        const float rstd = rsqrtf(wave_sum(ss) * (1.f / D) + EPS);
        float lg[8];
#pragma unroll
        for (int e = 0; e < 8; ++e) lg[e] = 0.f;
#pragma unroll
        for (int j = 0; j < 4; ++j) {
            const int c = 256 * j + 4 * lane;
            f32x4 f = v[j] * rstd * ga[j] + sb[j];
            if (FP8_IN1 && WHICH == 1 && layer == 1) *(unsigned*)((unsigned char*)dst + (size_t)m * D + c) = pk4_fp8(f.x, f.y, f.z, f.w);
            else { u32x2 w; w.x = pk2(f.x, f.y); w.y = pk2(f.z, f.w);
            *(u32x2*)(dst + (size_t)m * D + c) = w; }
            if (ROUTER) {
#pragma unroll
                for (int i = 0; i < 4; ++i) { const f32x4 r0 = rtw[j][i][0], r1 = rtw[j][i][1]; const float fv = f[i];
                    lg[0] += fv * r0.x; lg[1] += fv * r0.y; lg[2] += fv * r0.z; lg[3] += fv * r0.w; lg[4] += fv * r1.x; lg[5] += fv * r1.y; lg[6] += fv * r1.z; lg[7] += fv * r1.w; }
            }
        }
        if (ROUTER) {
#pragma unroll
            for (int e = 0; e < 8; ++e) lg[e] = wave_sum(lg[e]);
            if (lane == 0) {
                int e0 = 0; float v0 = lg[0];
#pragma unroll
                for (int e = 1; e < 8; ++e) if (lg[e] > v0) { v0 = lg[e]; e0 = e; }
                int e1 = -1; float v1 = -INFINITY;
#pragma unroll
                for (int e = 0; e < 8; ++e) if (e != e0 && lg[e] > v1) { v1 = lg[e]; e1 = e; }
                const float t = expf(v1 - v0), g0 = 1.f / (1.f + t), g1 = t / (1.f + t);
                const int p0 = (int)atomicAdd(&lcnt[e0], 1u), p1 = (int)atomicAdd(&lcnt[e1], 1u);
                ((int2*)(p.ws + WS_TOKE))[m] = make_int2(e0, e1); ((int2*)(p.ws + WS_TOKP))[m] = make_int2(p0, p1); ((float2*)(p.ws + WS_TOKG))[m] = make_float2(g0, g1);
            }
        }
#pragma unroll
        for (int j = 0; j < 4; ++j) v[j] = vn[j];
    }
    if (ROUTER) {
        __syncthreads();
        if (tx < 8) lcnt[8 + tx] = atomicAdd((unsigned*)(p.ws + WS_CTL) + 64 * tx, lcnt[tx]);
        __syncthreads();
        if (lane == 0) for (int m = gw; m < nrows; m += ngw) {
            const int2 e = ((const int2*)(p.ws + WS_TOKE))[m]; int2 ps = ((const int2*)(p.ws + WS_TOKP))[m];
            ps.x += (int)lcnt[8 + e.x]; ps.y += (int)lcnt[8 + e.y]; ((int2*)(p.ws + WS_TOKP))[m] = ps; }
        __syncthreads();
    }
}


typedef short pp_bf16x8 __attribute__((ext_vector_type(8)));
__device__ __forceinline__ float quad_sum(float v) { v += swz_xor<1>(v); v += swz_xor<2>(v); return v; }
__device__ __forceinline__ float kg_sum(float v) { v += swz_xor<16>(v); return half_sum(v); }
constexpr float QS64 = 0.125f * 1.4426950408889634f, QS96 = 0.10206207261596575f * 1.4426950408889634f;

template <int HS> struct PPH {
    static constexpr bool ISV = HS >= 20;
    static constexpr int col = HS < 4 ? OFF_AQ + 64 * HS : HS < 6 ? OFF_AK + 64 * (HS - 4) : HS < 10 ? OFF_BQ + 64 * (HS - 6) : HS < 12 ? OFF_BK + 64 * (HS - 10) : HS < 16 ? OFF_CQ + 64 * (HS - 12) :
                               HS < 20 ? OFF_CK + 64 * (HS - 16) : HS < 22 ? OFF_AV + 64 * (HS - 20) : HS < 24 ? OFF_BV + 64 * (HS - 22) : OFF_CV + 64 * (HS - 24);
    static constexpr bool ISQ = HS < 4 || (HS >= 6 && HS < 10) || (HS >= 12 && HS < 16);
    static constexpr bool ROPE = HS < 12;
    static constexpr int GIN = HS < 4 ? 9 : HS < 6 ? 10 : HS < 10 ? 12 : HS < 12 ? 13 : HS < 16 ? 14 : 15;
};
template <int HS> __device__ __forceinline__ void pp_loadw(const bf16_t* prow, int sub, u32x2 (&w)[4]) {
#pragma unroll
    for (int c = 0; c < 4; ++c) w[c] = *(const u32x2*)(prow + PPH<HS>::col + 16 * c + 4 * sub);
}
template <int HS> __device__ __forceinline__ void pp_loadg(const Params& p, int layer, int sub, f32x4 (&gv)[4]) {
    if constexpr (!PPH<HS>::ISV) { const float* g = p.in[PPH<HS>::GIN] + layer * 64 + 4 * sub;
#pragma unroll
        for (int c = 0; c < 4; ++c) gv[c] = *(const f32x4*)(g + 16 * c); }
}
template <int HS> __device__ __forceinline__ void pp_compute(const QKVB& qb, bool lat, int b, int s, int key, int sub, const float2 (&rr)[4], const float2 (&rc)[4], u32x2 (&w)[4], const f32x4 (&gv)[4]) {
    constexpr bool ISV = PPH<HS>::ISV, ISQ = PPH<HS>::ISQ, ROPE = PPH<HS>::ROPE;
    bf16_t* dst;
    if (HS < 4) dst = lat ? qb.QA + ((size_t)(b * 4 + HS) * SEQ + s) * 64 : qb.QAc + ((size_t)(b * 4 + HS) * CTX + s) * 64;
    else if (HS < 6) dst = qb.KA + ((size_t)(b * 2 + HS - 4) * KEYS + key) * 64;
    else if (HS < 10) dst = lat ? qb.QB + ((size_t)(b * 4 + HS - 6) * SEQ + s) * 64 : qb.QBc + ((size_t)(b * 4 + HS - 6) * CTX + s) * 64;
    else if (HS < 12) dst = qb.KB + ((size_t)(b * 2 + HS - 10) * KEYS + key) * 64;
    else if (HS < 16) dst = lat ? qb.QC + ((size_t)(b * 4 + HS - 12) * SEQ + s) * 64 : qb.QCc + ((size_t)(b * 4 + HS - 12) * CTX + s) * 64;
    else if (HS < 20) dst = qb.KC + ((size_t)(b * 4 + HS - 16) * KEYS + key) * 64;
    else if (HS < 22) dst = qb.VA + ((size_t)(b * 2 + HS - 20) * KEYS + key) * 64;
    else if (HS < 24) dst = qb.VB + ((size_t)(b * 2 + HS - 22) * KEYS + key) * 64;
    else dst = qb.VC + ((size_t)(b * 4 + HS - 24) * KEYS + key) * 64;
    if (!ISV) {
        f32x4 x[4]; float ss = 0.f;
#pragma unroll
        for (int c = 0; c < 4; ++c) { x[c] = (f32x4){bflo(w[c].x), bfhi(w[c].x), bflo(w[c].y), bfhi(w[c].y)}; ss += x[c].x * x[c].x + x[c].y * x[c].y + x[c].z * x[c].z + x[c].w * x[c].w; }
        const float r = rsqrtf(quad_sum(ss) * (1.f / 64.f) + EPS) * (ISQ ? QS64 : 1.f);
#pragma unroll
        for (int c = 0; c < 4; ++c) x[c] = x[c] * r * gv[c];
        if (ROPE && lat) {
#pragma unroll
            for (int i = 0; i < 4; ++i) { const float a = x[0][i], bq = x[1][i]; x[0][i] = a * rr[i].x - bq * rr[i].y; x[1][i] = bq * rr[i].x + a * rr[i].y;
                const float c1 = x[2][i], c2 = x[3][i]; x[2][i] = c1 * rc[i].x - c2 * rc[i].y; x[3][i] = c2 * rc[i].x + c1 * rc[i].y; }
        }
#pragma unroll
        for (int c = 0; c < 4; ++c) { w[c].x = pk2(x[c].x, x[c].y); w[c].y = pk2(x[c].z, x[c].w); }
    }
#pragma unroll
    for (int c = 0; c < 4; ++c) *(u32x2*)(dst + 16 * c + 4 * sub) = w[c];
}
template <int G, int GE> struct PPGrp { static __device__ __forceinline__ void run(const Params& p, const QKVB& qb, int layer, const bf16_t* prow, bool lat, int b, int s, int key, int sub, const float2 (&rr)[4], const float2 (&rc)[4], u32x2 (&wc)[4][4]) {
    u32x2 wn[4][4]; f32x4 gv[4][4];
    if constexpr (G + 1 < GE) { pp_loadw<4 * G + 4>(prow, sub, wn[0]); pp_loadw<4 * G + 5>(prow, sub, wn[1]); pp_loadw<4 * G + 6>(prow, sub, wn[2]); pp_loadw<4 * G + 7>(prow, sub, wn[3]); }
    pp_loadg<4 * G>(p, layer, sub, gv[0]); pp_loadg<4 * G + 1>(p, layer, sub, gv[1]); pp_loadg<4 * G + 2>(p, layer, sub, gv[2]); pp_loadg<4 * G + 3>(p, layer, sub, gv[3]);
    __builtin_amdgcn_sched_barrier(0);
    pp_compute<4 * G>(qb, lat, b, s, key, sub, rr, rc, wc[0], gv[0]); pp_compute<4 * G + 1>(qb, lat, b, s, key, sub, rr, rc, wc[1], gv[1]);
    pp_compute<4 * G + 2>(qb, lat, b, s, key, sub, rr, rc, wc[2], gv[2]); pp_compute<4 * G + 3>(qb, lat, b, s, key, sub, rr, rc, wc[3], gv[3]);
    __builtin_amdgcn_sched_barrier(0);
    if constexpr (G + 1 < GE) PPGrp<G + 1, GE>::run(p, qb, layer, prow, lat, b, s, key, sub, rr, rc, wn);
} };

__device__ __forceinline__ void f8_from_bf(const u32x4 v, float (&x)[8]) { x[0] = bflo(v.x); x[1] = bfhi(v.x); x[2] = bflo(v.y); x[3] = bfhi(v.y); x[4] = bflo(v.z); x[5] = bfhi(v.z); x[6] = bflo(v.w); x[7] = bfhi(v.w); }

__device__ __forceinline__ void ph_postproj2(const Params& p, int layer, LAS unsigned char* lds) {
    const int tx = opq((int)threadIdx.x), lane = tx & 63, wv = tx >> 6, G = opqs((int)gridDim.x), bk = opqs((int)blockIdx.x), ngw = G * 8;
    const bf16_t* P = (const bf16_t*)(p.ws + WS_P);
    const QKVB qb = make_qkv(p.ws);
    const bf16_t* Wuq = (const bf16_t*)(p.ws + WS_WUQ) + (size_t)layer * 384 * 192;
    const bf16_t* Wukv = (const bf16_t*)(p.ws + WS_WUKV) + (size_t)layer * 512 * 128;
    const float2* rope = (const float2*)(p.ws + WS_ROPE);
    constexpr int NU = MALL / 16, PQ = 200, PK = 136;
    const int nk = (G / 4) * 4, nb4 = nk / 4, km = 1 + (bk & 3), stride = nb4 * 8, ustart = (bk >> 2) * 8 + wv;
    const int nml = (bk < nk && ustart < NU) ? (NU - ustart + stride - 1) / stride : 0;
    const int k0 = ngw - 1 - (bk * 8 + wv);
    const LAS bf16_t* wl = (const LAS bf16_t*)lds;
    if (bk < nk) {
        LAS bf16_t* wst = (LAS bf16_t*)lds;
        if (km <= 2) { const bf16_t* src = Wuq + (size_t)192 * (km - 1) * 192; u32x4 t[9];
#pragma unroll
            for (int i = 0; i < 9; ++i) t[i] = *(const u32x4*)(src + (size_t)(tx + 512 * i) * 8);
            __builtin_amdgcn_sched_barrier(0);
#pragma unroll
            for (int i = 0; i < 9; ++i) { const int ch = tx + 512 * i; *(LAS u32x4*)(wst + (ch / 24) * PQ + (ch % 24) * 8) = t[i]; } }
        else { const bf16_t* src = Wukv + (size_t)256 * (km - 3) * 128; u32x4 t[8];
#pragma unroll
            for (int i = 0; i < 8; ++i) t[i] = *(const u32x4*)(src + (size_t)(tx + 512 * i) * 8);
            __builtin_amdgcn_sched_barrier(0);
#pragma unroll
            for (int i = 0; i < 8; ++i) { const int ch = tx + 512 * i; *(LAS u32x4*)(wst + (ch >> 4) * PK + (ch & 15) * 8) = t[i]; } }
    }
    __syncthreads();
    for (int it = 0; ; ++it) {
        int kind, u;
        int half = 0;
        if (it < nml) { kind = km; u = ustart + it * stride; } else { u = k0 + (it - nml) * ngw; if (u >= 2 * NU) break; kind = 0; half = u >= NU; u -= half * NU; }
        half = __builtin_amdgcn_readfirstlane(half);
        kind = __builtin_amdgcn_readfirstlane(kind);
        const int m0 = u * 16; const bool lat = m0 < TL;
        if (kind == 0) {
            const int t = lane >> 2, sub = lane & 3, m = m0 + t;
            const int b = lat ? m / SEQ : (m - TL) / CTX, s = lat ? m % SEQ : (m - TL) % CTX, key = lat ? CTX + s : s;
            const bf16_t* prow = P + (size_t)m * NINP;
            if (half) { float2 rr[4], rc[4];
#pragma unroll
                for (int i = 0; i < 4; ++i) { rr[i] = make_float2(1.f, 0.f); rc[i] = rr[i]; }
                u32x2 w0[4][4]; pp_loadw<16>(prow, sub, w0[0]); pp_loadw<17>(prow, sub, w0[1]); pp_loadw<18>(prow, sub, w0[2]); pp_loadw<19>(prow, sub, w0[3]);
                PPGrp<4, 7>::run(p, qb, layer, prow, lat, b, s, key, sub, rr, rc, w0); continue; }
            u32x2 w0[4][4]; pp_loadw<0>(prow, sub, w0[0]); pp_loadw<1>(prow, sub, w0[1]); pp_loadw<2>(prow, sub, w0[2]); pp_loadw<3>(prow, sub, w0[3]);
            float2 rr[4], rc[4];
#pragma unroll
            for (int i = 0; i < 4; ++i) { rr[i] = rope[RT_R64 + (s >> 6) * 16 + 4 * sub + i]; rc[i] = rope[RT_C64 + (s & 63) * 16 + 4 * sub + i]; }
#pragma unroll
            for (int i = 0; i < 4; ++i) asm volatile("" : "+v"(rr[i].x), "+v"(rr[i].y), "+v"(rc[i].x), "+v"(rc[i].y));
            PPGrp<0, 4>::run(p, qb, layer, prow, lat, b, s, key, sub, rr, rc, w0);
        }
        else {
            const int tk = lane & 15, kg = lane >> 4, m = m0 + tk;
            const int b = lat ? m / SEQ : (m - TL) / CTX, s = lat ? m % SEQ : (m - TL) % CTX, key = lat ? CTX + s : s;
            const bf16_t* prow = P + (size_t)m * NINP;
            if (kind <= 2) {
            pp_bf16x8 aq[6];
            { float x[6][8]; float ss = 0.f;
#pragma unroll
                for (int ks = 0; ks < 6; ++ks) { f8_from_bf(*(const u32x4*)(prow + OFF_DCQ + 32 * ks + 8 * kg), x[ks]);
#pragma unroll
                    for (int j = 0; j < 8; ++j) ss += x[ks][j] * x[ks][j]; }
                const float r = rsqrtf(kg_sum(ss) * (1.f / 192.f) + EPS);
                const float* g = p.in[17] + layer * 192 + 8 * kg;
#pragma unroll
                for (int ks = 0; ks < 6; ++ks) { const f32x4 g0 = *(const f32x4*)(g + 32 * ks), g1 = *(const f32x4*)(g + 32 * ks + 4);
                    u32x4 w; w.x = pk2(x[ks][0] * r * g0.x, x[ks][1] * r * g0.y); w.y = pk2(x[ks][2] * r * g0.z, x[ks][3] * r * g0.w); w.z = pk2(x[ks][4] * r * g1.x, x[ks][5] * r * g1.y); w.w = pk2(x[ks][6] * r * g1.z, x[ks][7] * r * g1.w);
                    aq[ks] = __builtin_bit_cast(pp_bf16x8, w); } }
            float2 qr_[4], qc_[4];
#pragma unroll
            for (int reg = 0; reg < 4; ++reg) { const int i = (4 * kg + reg) & 7; qr_[reg] = rope[RT_R32 + (s >> 6) * 8 + i]; qc_[reg] = rope[RT_C32 + (s & 63) * 8 + i]; }
            f32x4 gq[6];
            { const float* g = p.in[21] + layer * 96 + 4 * kg;
#pragma unroll
              for (int nb = 0; nb < 6; ++nb) gq[nb] = *(const f32x4*)(g + 16 * nb); }
#pragma unroll
            for (int reg = 0; reg < 4; ++reg) asm volatile("" : "+v"(qr_[reg].x), "+v"(qr_[reg].y), "+v"(qc_[reg].x), "+v"(qc_[reg].y));
#pragma unroll 1
            for (int h = 2 * (kind - 1); h < 2 * kind; ++h) {
                f32x4 acc[6];
#pragma unroll
                for (int nb0 = 0; nb0 < 6; nb0 += 3) {
                    pp_bf16x8 wf[3][6];
#pragma unroll
                    for (int i = 0; i < 3; ++i) { const LAS bf16_t* wp = wl + (96 * (h & 1) + 16 * (nb0 + i) + tk) * PQ + 8 * kg;
#pragma unroll
                        for (int ks = 0; ks < 6; ++ks) wf[i][ks] = *(const LAS pp_bf16x8*)(wp + 32 * ks); }
                    __builtin_amdgcn_sched_barrier(0);
#pragma unroll
                    for (int i = 0; i < 3; ++i) { acc[nb0 + i] = (f32x4){0.f, 0.f, 0.f, 0.f};
#pragma unroll
                        for (int ks = 0; ks < 6; ++ks) acc[nb0 + i] = __builtin_amdgcn_mfma_f32_16x16x32_bf16(wf[i][ks], aq[ks], acc[nb0 + i], 0, 0, 0); }
                    __builtin_amdgcn_sched_barrier(0);
                }
                float ss = 0.f;
#pragma unroll
                for (int nb = 0; nb < 6; ++nb) ss += acc[nb].x * acc[nb].x + acc[nb].y * acc[nb].y + acc[nb].z * acc[nb].z + acc[nb].w * acc[nb].w;
                const float r = rsqrtf(kg_sum(ss) * (1.f / 96.f) + EPS) * QS96;
                bf16_t* dst = (lat ? qb.QD + ((size_t)(b * 4 + h) * SEQ + s) * 96 : qb.QDc + ((size_t)(b * 4 + h) * CTX + s) * 96) + 4 * kg;
#pragma unroll
                for (int nb = 0; nb < 6; ++nb) { f32x4 y = acc[nb] * r * gq[nb];
                    if (nb >= 4 && lat) {
#pragma unroll
                        for (int reg = 0; reg < 4; ++reg) { const float other = half_other(y[reg], lane); const float2 cs = nb == 4 ? qr_[reg] : qc_[reg];
                            y[reg] = (kg < 2) ? y[reg] * cs.x - other * cs.y : y[reg] * cs.x + other * cs.y; } }
                    u32x2 w; w.x = pk2(y.x, y.y); w.y = pk2(y.z, y.w); *(u32x2*)(dst + 16 * nb) = w; }
            }
            } else {
            pp_bf16x8 akv[4];
            { float x[4][8]; float ss = 0.f;
#pragma unroll
                for (int ks = 0; ks < 4; ++ks) { f8_from_bf(*(const u32x4*)(prow + OFF_DCKV + 32 * ks + 8 * kg), x[ks]);
#pragma unroll
                    for (int j = 0; j < 8; ++j) ss += x[ks][j] * x[ks][j]; }
                const float r = rsqrtf(kg_sum(ss) * (1.f / 128.f) + EPS);
                const float* g = p.in[19] + layer * 128 + 8 * kg;
#pragma unroll
                for (int ks = 0; ks < 4; ++ks) { const f32x4 g0 = *(const f32x4*)(g + 32 * ks), g1 = *(const f32x4*)(g + 32 * ks + 4);
                    u32x4 w; w.x = pk2(x[ks][0] * r * g0.x, x[ks][1] * r * g0.y); w.y = pk2(x[ks][2] * r * g0.z, x[ks][3] * r * g0.w); w.z = pk2(x[ks][4] * r * g1.x, x[ks][5] * r * g1.y); w.w = pk2(x[ks][6] * r * g1.z, x[ks][7] * r * g1.w);
                    akv[ks] = __builtin_bit_cast(pp_bf16x8, w); } }
            float kr[8]; f8_from_bf(*(const u32x4*)(prow + OFF_DKR + 8 * kg), kr);
            float krss = 0.f;
#pragma unroll
            for (int j = 0; j < 8; ++j) krss += kr[j] * kr[j];
            float2 kcs[8];
#pragma unroll
            for (int j = 0; j < 8; ++j) kcs[j] = rope[kg < 2 ? RT_R32 + (s >> 6) * 8 + j : RT_C32 + (s & 63) * 8 + j];
#pragma unroll
            for (int j = 0; j < 8; ++j) { asm volatile("" : "+v"(kcs[j].x), "+v"(kcs[j].y)); if (!lat) kcs[j] = make_float2(1.f, 0.f); }
            f32x4 gk[4], gr2[2];
            { const float* g = p.in[22] + layer * 96;
#pragma unroll
              for (int nb = 0; nb < 4; ++nb) gk[nb] = *(const f32x4*)(g + 16 * nb + 4 * kg);
              gr2[0] = *(const f32x4*)(g + 64 + 8 * kg); gr2[1] = *(const f32x4*)(g + 64 + 8 * kg + 4); }
#pragma unroll
            for (int j = 0; j < 8; ++j) asm volatile("" : "+v"(kcs[j].x), "+v"(kcs[j].y));
#pragma unroll 1
            for (int h = 2 * (kind - 3); h < 2 * (kind - 2); ++h) {
                f32x4 acc[8];
#pragma unroll
                for (int nb0 = 0; nb0 < 8; nb0 += 4) {
                    pp_bf16x8 wf[4][4];
#pragma unroll
                    for (int i = 0; i < 4; ++i) { const LAS bf16_t* wp = wl + (128 * (h & 1) + 16 * (nb0 + i) + tk) * PK + 8 * kg;
#pragma unroll
                        for (int ks = 0; ks < 4; ++ks) wf[i][ks] = *(const LAS pp_bf16x8*)(wp + 32 * ks); }
                    __builtin_amdgcn_sched_barrier(0);
#pragma unroll
                    for (int i = 0; i < 4; ++i) { acc[nb0 + i] = (f32x4){0.f, 0.f, 0.f, 0.f};
#pragma unroll
                        for (int ks = 0; ks < 4; ++ks) acc[nb0 + i] = __builtin_amdgcn_mfma_f32_16x16x32_bf16(wf[i][ks], akv[ks], acc[nb0 + i], 0, 0, 0); }
                    __builtin_amdgcn_sched_barrier(0);
                }
                float ss = krss;
#pragma unroll
                for (int nb = 0; nb < 4; ++nb) ss += acc[nb].x * acc[nb].x + acc[nb].y * acc[nb].y + acc[nb].z * acc[nb].z + acc[nb].w * acc[nb].w;
                const float r = rsqrtf(kg_sum(ss) * (1.f / 96.f) + EPS);
                bf16_t* kd = qb.KD + ((size_t)(b * 4 + h) * KEYS + key) * 96; bf16_t* vd = qb.VD + ((size_t)(b * 4 + h) * KEYS + key) * 64;
#pragma unroll
                for (int nb = 0; nb < 4; ++nb) { const f32x4 y = acc[nb] * r * gk[nb]; u32x2 w; w.x = pk2(y.x, y.y); w.y = pk2(y.z, y.w); *(u32x2*)(kd + 16 * nb + 4 * kg) = w; }
                { float y[8];
#pragma unroll
                    for (int j = 0; j < 8; ++j) y[j] = kr[j] * r * gr2[j >> 2][j & 3];
#pragma unroll
                    for (int j = 0; j < 8; ++j) { const float other = swz_xor<16>(y[j]); y[j] = (kg & 1) == 0 ? y[j] * kcs[j].x - other * kcs[j].y : y[j] * kcs[j].x + other * kcs[j].y; }
                    u32x4 w; w.x = pk2(y[0], y[1]); w.y = pk2(y[2], y[3]); w.z = pk2(y[4], y[5]); w.w = pk2(y[6], y[7]); *(u32x4*)(kd + 64 + 8 * kg) = w; }
#pragma unroll
                for (int nb = 4; nb < 8; ++nb) { const f32x4 y = acc[nb]; u32x2 w; w.x = pk2(y.x, y.y); w.y = pk2(y.z, y.w); *(u32x2*)(vd + 16 * (nb - 4) + 4 * kg) = w; }
            }
            }
        }
    }
}

namespace fa {
typedef short bf16x8 __attribute__((ext_vector_type(8)));
typedef short s16x4 __attribute__((ext_vector_type(4)));
typedef float f32x16 __attribute__((ext_vector_type(16)));
typedef __attribute__((address_space(3))) const char* lds_cptr;
typedef short v4i16_t __attribute__((ext_vector_type(4)));
constexpr int KSTG = 12288, VSTG = 8192, STG = KSTG + VSTG;
constexpr int LDS_WS = 2 * STG, LDS_OST = LDS_WS + 8 * 256, LDS_RPB = LDS_OST + 8 * 4096, LDS_TOTAL = LDS_RPB + 2048;
constexpr float LOG2E = 1.4426950408889634f;
constexpr float THR = 6.0f;
__device__ __forceinline__ int crow(int r, int hi) { return (r & 3) + 8 * (r >> 2) + 4 * hi; }
__device__ __forceinline__ void glds16(const void* gsrc, unsigned lds_dst) { unsigned keep;
    asm volatile("s_mov_b32 %0, m0\n\ts_mov_b32 m0, %2\n\ts_nop 0\n\tglobal_load_lds_dwordx4 %1, off\n\ts_mov_b32 m0, %0" : "=&s"(keep) : "v"(gsrc), "s"(lds_dst) : "memory"); }
__device__ __forceinline__ s16x4 vtr(lds_cptr p) { return __builtin_bit_cast(s16x4, __builtin_amdgcn_ds_read_tr16_b64_v4i16((__attribute__((address_space(3))) v4i16_t*)p)); }
typedef float f32x2_t __attribute__((ext_vector_type(2))); typedef __bf16 bf16x2_t __attribute__((ext_vector_type(2)));
__device__ __forceinline__ unsigned cvtpk(float lo, float hi) { f32x2_t v = {lo, hi}; bf16x2_t b = __builtin_convertvector(v, bf16x2_t); return __builtin_bit_cast(unsigned, b); }
__device__ __forceinline__ float xhalf_max(float m) { auto rr = __builtin_amdgcn_permlane32_swap(__float_as_uint(m), __float_as_uint(m), false, false); return fmaxf(__uint_as_float(rr[0]), __uint_as_float(rr[1])); }
__device__ __forceinline__ float xhalf_sum(float m) { auto rr = __builtin_amdgcn_permlane32_swap(__float_as_uint(m), __float_as_uint(m), false, false); return __uint_as_float(rr[0]) + __uint_as_float(rr[1]); }
#define FA_WAIT_BAR() asm volatile("s_waitcnt vmcnt(0) lgkmcnt(0)\n\ts_barrier" ::: "memory")

#undef FA_WAIT_BAR
}


namespace fa2 {
using fa::bf16x8; using fa::s16x4; using fa::f32x16; using fa::lds_cptr; using fa::crow; using fa::glds16; using fa::vtr; using fa::cvtpk; using fa::LOG2E;
constexpr int KSL = 12288, VSL = 8192, VBASE = 4 * KSL, LDS_WS = VBASE + 3 * VSL, LDS_OST = LDS_WS + 8 * 256, LDS_RPB = LDS_OST + 8 * 4096, LDS_TOTAL = LDS_RPB + 2048;
static_assert(LDS_TOTAL <= 131072, "attention LDS");
#define SBAR() __builtin_amdgcn_sched_barrier(0)
#define PIN(x) asm volatile("" : "+v"(x))
template <int DQK, int MODE, int THRL>
__device__ __forceinline__ void attn_unit(const bf16_t* Qg, const bf16_t* Kg, const bf16_t* Vg, bf16_t* Og, int q0, float sink2, const float* rpb, char* shm, float kmax2) {
    const int tid = opq((int)threadIdx.x), lane = tid & 63, r32 = lane & 31, hi = lane >> 5; const int wid = __builtin_amdgcn_readfirstlane(tid >> 6);
    const unsigned lds0 = (unsigned)(uintptr_t)shm;
    float* wsf = (float*)(shm + LDS_WS) + wid * 64;
    constexpr int NCH = DQK / 8, ND0 = DQK / 16;
    int NT, wbase = 0;
    if (MODE == 0) NT = KEYS / 64; else if (MODE == 3) NT = 4;
    else if (MODE == 1) { wbase = max(0, q0 - 128); const int we = min(SEQ, q0 + 256 + 128); NT = 4 + (we - wbase) / 64; }
    else { const int r0 = q0 >> 6; wbase = min(max(r0 - 4, 0), 120); const int kre = min(max(r0 - 1, 0), 120) + 8; NT = 4 + (kre - wbase); }
#define FA_KEY0(t) ((MODE == 0 || MODE == 3 || (t) < 4) ? 64 * (t) : (MODE == 1 ? CTX + wbase + 64 * ((t) - 4) : CTX + (wbase + (t) - 4) * 64))
    const bf16_t* ksrc = Kg + (size_t)lane * DQK; const bf16_t* vsrc = Vg + (size_t)(16 * (wid & 3) + (lane >> 2)) * 64 + (wid >> 2) * 32 + (lane & 3) * 8;
#define DMA_K(t, slotoff) do { const int tt_ = (t) < NT ? (t) : NT - 1; const int k0_ = FA_KEY0(tt_); \
        glds16(ksrc + (size_t)k0_ * DQK + wid * 8, (unsigned)__builtin_amdgcn_readfirstlane(lds0 + (slotoff) + wid * 1024)); \
        if (NCH > 8) { if (wid < NCH - 8) glds16(ksrc + (size_t)k0_ * DQK + (wid + 8) * 8, (unsigned)__builtin_amdgcn_readfirstlane(lds0 + (slotoff) + (wid + 8) * 1024)); } } while (0)
#define DMA_V(t, slotoff) do { const int tt_ = (t) < NT ? (t) : NT - 1; const int k0_ = FA_KEY0(tt_); \
        glds16(vsrc + (size_t)k0_ * 64, (unsigned)__builtin_amdgcn_readfirstlane(lds0 + VBASE + (slotoff) + wid * 1024)); } while (0)
#define WAIT_STEP() do { if (NCH > 8 && wid < NCH - 8) asm volatile("s_waitcnt vmcnt(3) lgkmcnt(0)\n\ts_barrier" ::: "memory"); else asm volatile("s_waitcnt vmcnt(2) lgkmcnt(0)\n\ts_barrier" ::: "memory"); } while (0)
    DMA_K(0, 0); DMA_V(0, 0); DMA_K(1, KSL); DMA_K(2, 2 * KSL);
    if (MODE == 2) { float* rp = (float*)(shm + LDS_RPB); unsigned* bm = (unsigned*)(shm + LDS_RPB) + 480; if (tid == 0) *bm = 0u;
        __syncthreads();
        for (int i = tid; i < 15 * 31; i += 512) { const float v = rpb[i] * LOG2E; rp[i] = v; atomicMax(bm, __float_as_uint(fabsf(v))); } }
    bf16x8 qr[ND0];
#pragma unroll
    for (int d0 = 0; d0 < ND0; ++d0) qr[d0] = *reinterpret_cast<const bf16x8*>(Qg + (size_t)(wid * 32 + r32) * DQK + d0 * 16 + hi * 8);
    float q2 = 0.f;
#pragma unroll
    for (int d0 = 0; d0 < ND0; ++d0) {
#pragma unroll
        for (int j = 0; j < 8; ++j) { const float qv = __uint_as_float(((unsigned)(unsigned short)qr[d0][j]) << 16); q2 += qv * qv; } }
    q2 = fa::xhalf_sum(q2);
    float l_reg = 0.f; f32x16 o[2]; f32x16 negm;
#pragma unroll
    for (int r = 0; r < 16; ++r) { o[0][r] = 0.f; o[1][r] = 0.f; }
    const int qpos = q0 + wid * 32 + r32;
    const int rq = (q0 >> 6) + (wid >> 1), jq = 32 * (wid & 1) + r32;
    const int rs = min(max(rq - 4, 0), 120), cs = min(max(jq - 8, 0), 48);
    const lds_cptr shm3 = (lds_cptr)shm;
    const lds_cptr kp0 = shm3 + hi * 1024 + r32 * 16;
    const lds_cptr vp0 = shm3 + VBASE + ((lane >> 4) & 1) * 32 + (lane & 3) * 8 + (4 * hi + ((lane & 15) >> 2)) * 64;
#define MASK(C0, C1, t) do { \
        if (MODE == 1 && (t) >= 4) { const int kp0_ = wbase + 64 * ((t) - 4) - qpos; \
            _Pragma("unroll") for (int r = 0; r < 16; ++r) { const int d0_ = kp0_ + crow(r, hi), d1_ = d0_ + 32; if (d0_ < -128 || d0_ > 128) C0[r] = -INFINITY; if (d1_ < -128 || d1_ > 128) C1[r] = -INFINITY; } } \
        if (MODE == 2 && (t) >= 4) { const int kr_ = wbase + (t) - 4; const bool rowok_ = (kr_ >= rs) && (kr_ < rs + 8); const int ro_ = min(max(kr_ - rq + 7, 0), 14); \
            const float* rp_ = (const float*)(shm + LDS_RPB) + ro_ * 31 + 15 - jq; \
            _Pragma("unroll") for (int r = 0; r < 16; ++r) { const int kc0 = crow(r, hi), kc1 = kc0 + 32; \
                const bool v0 = rowok_ && (kc0 >= cs) && (kc0 < cs + 16), v1 = rowok_ && (kc1 >= cs) && (kc1 < cs + 16); \
                C0[r] = v0 ? C0[r] + rp_[v0 ? kc0 : jq] : -INFINITY; C1[r] = v1 ? C1[r] + rp_[v1 ? kc1 : jq] : -INFINITY; } } } while (0)
#define ROWMAX(C0, C1, rm) do { float a_ = fmaxf(fmaxf(C0[0], C0[1]), C1[0]), b_ = fmaxf(fmaxf(C0[2], C0[3]), C1[1]); a_ = fmaxf(fmaxf(a_, C1[2]), C1[3]); \
        _Pragma("unroll") for (int r = 4; r < 16; r += 4) { a_ = fmaxf(fmaxf(a_, C0[r]), C0[r + 1]); b_ = fmaxf(fmaxf(b_, C0[r + 2]), C0[r + 3]); a_ = fmaxf(fmaxf(a_, C1[r]), C1[r + 1]); b_ = fmaxf(fmaxf(b_, C1[r + 2]), C1[r + 3]); } \
        rm = fa::xhalf_max(fmaxf(a_, b_)); } while (0)
    bf16x8 kf[8]; bf16x8 kf2[4];
#define KLOAD(j, slotoff) do { kf[2 * (j)] = *(const __attribute__((address_space(3))) bf16x8*)(kp0 + (slotoff) + (j) * 2048); kf[2 * (j) + 1] = *(const __attribute__((address_space(3))) bf16x8*)(kp0 + (slotoff) + (j) * 2048 + 512); } while (0)
#define KLOAD2(slotoff) do { if (ND0 > 4) { kf2[0] = *(const __attribute__((address_space(3))) bf16x8*)(kp0 + (slotoff) + 4 * 2048); kf2[1] = *(const __attribute__((address_space(3))) bf16x8*)(kp0 + (slotoff) + 4 * 2048 + 512); \
        kf2[2] = *(const __attribute__((address_space(3))) bf16x8*)(kp0 + (slotoff) + 5 * 2048); kf2[3] = *(const __attribute__((address_space(3))) bf16x8*)(kp0 + (slotoff) + 5 * 2048 + 512); } } while (0)
    asm volatile("s_waitcnt vmcnt(0) lgkmcnt(0)\n\ts_barrier" ::: "memory");
    float mhat = sqrtf(q2 * kmax2) * 1.01f + (MODE == 2 ? __uint_as_float(*((const unsigned*)(shm + LDS_RPB) + 480)) : 0.f);
#pragma unroll
    for (int r = 0; r < 16; ++r) negm[r] = 0.f;
    PIN(negm);
    f32x16 pA0, pA1, pB0, pB1;
    int ks_cur = 0, ks_next = KSL, ks_nn = 2 * KSL, ks_tgt = 3 * KSL;
    int vs_prev = 2 * VSL, vs_cur = 0, vs_next = VSL;
#define ROT() do { const int k_ = ks_cur; ks_cur = ks_next; ks_next = ks_nn; ks_nn = ks_tgt; ks_tgt = k_; const int v_ = vs_prev; vs_prev = vs_cur; vs_cur = vs_next; vs_next = v_; } while (0)
#define RESC() do { if (resc) { _Pragma("unroll") for (int r = 0; r < 16; ++r) { const float fr_ = wsf[crow(r, hi)]; o[0][r] *= fr_; o[1][r] *= fr_; } } } while (0)
    KLOAD(0, 0); KLOAD(1, 0); KLOAD(2, 0); KLOAD(3, 0); KLOAD2(0);
    {
#pragma unroll
        for (int d0 = 0; d0 < 4; ++d0) { pA0 = __builtin_amdgcn_mfma_f32_32x32x16_bf16(kf[2 * d0], qr[d0], d0 == 0 ? negm : pA0, 0, 0, 0); pA1 = __builtin_amdgcn_mfma_f32_32x32x16_bf16(kf[2 * d0 + 1], qr[d0], d0 == 0 ? negm : pA1, 0, 0, 0); }
        if (ND0 > 4) { pA0 = __builtin_amdgcn_mfma_f32_32x32x16_bf16(kf2[0], qr[ND0 > 4 ? 4 : 0], pA0, 0, 0, 0); pA1 = __builtin_amdgcn_mfma_f32_32x32x16_bf16(kf2[1], qr[ND0 > 4 ? 4 : 0], pA1, 0, 0, 0);
                       pA0 = __builtin_amdgcn_mfma_f32_32x32x16_bf16(kf2[2], qr[ND0 > 4 ? 5 : 0], pA0, 0, 0, 0); pA1 = __builtin_amdgcn_mfma_f32_32x32x16_bf16(kf2[3], qr[ND0 > 4 ? 5 : 0], pA1, 0, 0, 0); }
        DMA_K(3, 3 * KSL); DMA_V(1, VSL);
        { float rm; ROWMAX(pA0, pA1, rm); mhat = fminf(mhat, rm + 64.f); }
#pragma unroll
        for (int r = 0; r < 16; ++r) { pA0[r] = __builtin_amdgcn_exp2f(pA0[r] - mhat); pA1[r] = __builtin_amdgcn_exp2f(pA1[r] - mhat); negm[r] = -mhat; }
        PIN(negm);
        KLOAD(0, KSL); KLOAD(1, KSL); KLOAD(2, KSL); KLOAD(3, KSL);
        WAIT_STEP();
    }
    s16x4 vlo[8], vhi[8]; u32x4 pw0, pw1, pw2, pw3;
#define VRD(i) do { vlo[i] = vtr(vp_ + (((i) >> 2) * 4096 + ((i) & 3) * 1024)); vhi[i] = vtr(vp_ + (((i) >> 2) * 4096 + ((i) & 3) * 1024 + 512)); } while (0)
#define VFR(i) (bf16x8){vlo[i][0], vlo[i][1], vlo[i][2], vlo[i][3], vhi[i][0], vhi[i][1], vhi[i][2], vhi[i][3]}
#define PAF(k) __builtin_bit_cast(bf16x8, pw##k)
#define GAPA(MF, A0, A1, A2, A3, W0, W1, PW) do { MF; sacc += A0; sacc += A1; sacc += A2; sacc += A3; PIN(sacc); W0; W1; PIN(PW); SBAR(); } while (0)
#define EX(v) __builtin_amdgcn_exp2f(v)
#define GAPB(MF, X, B) do { MF; X[B] = EX(X[B]); X[B + 1] = EX(X[B + 1]); X[B + 2] = EX(X[B + 2]); X[B + 3] = EX(X[B + 3]); PIN(X); SBAR(); } while (0)
#define KRD(j) do { KLOAD(j, ks_nn_); SBAR(); } while (0)
#define STEP(C0, C1, P0, P1, t) do { SBAR(); \
        const lds_cptr vp_ = vp0 + vs_prev; const int ks_cur_ = ks_cur; (void)ks_cur_; \
        KLOAD2(ks_cur_); \
        VRD(0); SBAR(); float sacc = (P0[0] + P0[1]); \
        GAPA(C0 = __builtin_amdgcn_mfma_f32_32x32x16_bf16(kf[0], qr[0], negm, 0, 0, 0), P0[2], P0[3], P0[4], P0[5], pw0[0] = cvtpk(P0[0], P0[1]), pw0[1] = cvtpk(P0[2], P0[3]), pw0); \
        VRD(4); SBAR(); GAPA(C1 = __builtin_amdgcn_mfma_f32_32x32x16_bf16(kf[1], qr[0], negm, 0, 0, 0), P0[6], P0[7], P0[8], P0[9], pw0[2] = cvtpk(P0[4], P0[5]), pw0[3] = cvtpk(P0[6], P0[7]), pw0); \
        VRD(1); SBAR(); GAPA(C0 = __builtin_amdgcn_mfma_f32_32x32x16_bf16(kf[2], qr[1], C0, 0, 0, 0), P0[10], P0[11], P0[12], P0[13], pw1[0] = cvtpk(P0[8], P0[9]), pw1[1] = cvtpk(P0[10], P0[11]), pw1); \
        VRD(5); SBAR(); GAPA(C1 = __builtin_amdgcn_mfma_f32_32x32x16_bf16(kf[3], qr[1], C1, 0, 0, 0), P0[14], P0[15], P1[0], P1[1], pw1[2] = cvtpk(P0[12], P0[13]), pw1[3] = cvtpk(P0[14], P0[15]), pw1); \
        VRD(2); SBAR(); GAPA(C0 = __builtin_amdgcn_mfma_f32_32x32x16_bf16(kf[4], qr[2], C0, 0, 0, 0), P1[2], P1[3], P1[4], P1[5], pw2[0] = cvtpk(P1[0], P1[1]), pw2[1] = cvtpk(P1[2], P1[3]), pw2); \
        VRD(6); SBAR(); GAPA(C1 = __builtin_amdgcn_mfma_f32_32x32x16_bf16(kf[5], qr[2], C1, 0, 0, 0), P1[6], P1[7], P1[8], P1[9], pw2[2] = cvtpk(P1[4], P1[5]), pw2[3] = cvtpk(P1[6], P1[7]), pw2); \
        VRD(3); SBAR(); GAPA(C0 = __builtin_amdgcn_mfma_f32_32x32x16_bf16(kf[6], qr[3], C0, 0, 0, 0), P1[10], P1[11], P1[12], P1[13], pw3[0] = cvtpk(P1[8], P1[9]), pw3[1] = cvtpk(P1[10], P1[11]), pw3); \
        VRD(7); SBAR(); GAPA(C1 = __builtin_amdgcn_mfma_f32_32x32x16_bf16(kf[7], qr[3], C1, 0, 0, 0), P1[14], P1[15], 0.f, 0.f, pw3[2] = cvtpk(P1[12], P1[13]), pw3[3] = cvtpk(P1[14], P1[15]), pw3); \
        if (ND0 > 4) { C0 = __builtin_amdgcn_mfma_f32_32x32x16_bf16(kf2[0], qr[ND0 > 4 ? 4 : 0], C0, 0, 0, 0); C1 = __builtin_amdgcn_mfma_f32_32x32x16_bf16(kf2[1], qr[ND0 > 4 ? 4 : 0], C1, 0, 0, 0); \
                       C0 = __builtin_amdgcn_mfma_f32_32x32x16_bf16(kf2[2], qr[ND0 > 4 ? 5 : 0], C0, 0, 0, 0); C1 = __builtin_amdgcn_mfma_f32_32x32x16_bf16(kf2[3], qr[ND0 > 4 ? 5 : 0], C1, 0, 0, 0); SBAR(); } \
        l_reg += sacc; \
        DMA_K((t) + 3, ks_tgt); DMA_V((t) + 1, vs_next); \
        MASK(C0, C1, t); \
        SBAR(); \
        const int ks_nn_ = ks_next; \
        GAPB(o[0] = __builtin_amdgcn_mfma_f32_32x32x16_bf16(PAF(0), VFR(0), o[0], 0, 0, 0), C0, 0); \
        GAPB(o[1] = __builtin_amdgcn_mfma_f32_32x32x16_bf16(PAF(0), VFR(4), o[1], 0, 0, 0), C0, 4); \
        KRD(0); GAPB(o[0] = __builtin_amdgcn_mfma_f32_32x32x16_bf16(PAF(1), VFR(1), o[0], 0, 0, 0), C0, 8); \
        KRD(1); GAPB(o[1] = __builtin_amdgcn_mfma_f32_32x32x16_bf16(PAF(1), VFR(5), o[1], 0, 0, 0), C0, 12); \
        KRD(2); GAPB(o[0] = __builtin_amdgcn_mfma_f32_32x32x16_bf16(PAF(2), VFR(2), o[0], 0, 0, 0), C1, 0); \
        KRD(3); GAPB(o[1] = __builtin_amdgcn_mfma_f32_32x32x16_bf16(PAF(2), VFR(6), o[1], 0, 0, 0), C1, 4); \
        GAPB(o[0] = __builtin_amdgcn_mfma_f32_32x32x16_bf16(PAF(3), VFR(3), o[0], 0, 0, 0), C1, 8); \
        GAPB(o[1] = __builtin_amdgcn_mfma_f32_32x32x16_bf16(PAF(3), VFR(7), o[1], 0, 0, 0), C1, 12); \
    } while (0)
    ROT();
    int t = 1;
    for (; t + 1 < NT; t += 2) {
        STEP(pB0, pB1, pA0, pA1, t);     WAIT_STEP(); ROT();
        STEP(pA0, pA1, pB0, pB1, t + 1); WAIT_STEP(); ROT();
    }
    if (t < NT) {
        STEP(pB0, pB1, pA0, pA1, t);     WAIT_STEP(); ROT();
        pA0 = pB0; pA1 = pB1;
    }
    {
        float sacc = 0.f;
#pragma unroll
        for (int r = 0; r < 16; ++r) sacc += pA0[r] + pA1[r];
        l_reg += sacc;
        pw0 = (u32x4){cvtpk(pA0[0], pA0[1]), cvtpk(pA0[2], pA0[3]), cvtpk(pA0[4], pA0[5]), cvtpk(pA0[6], pA0[7])};
        pw1 = (u32x4){cvtpk(pA0[8], pA0[9]), cvtpk(pA0[10], pA0[11]), cvtpk(pA0[12], pA0[13]), cvtpk(pA0[14], pA0[15])};
        pw2 = (u32x4){cvtpk(pA1[0], pA1[1]), cvtpk(pA1[2], pA1[3]), cvtpk(pA1[4], pA1[5]), cvtpk(pA1[6], pA1[7])};
        pw3 = (u32x4){cvtpk(pA1[8], pA1[9]), cvtpk(pA1[10], pA1[11]), cvtpk(pA1[12], pA1[13]), cvtpk(pA1[14], pA1[15])};
        const lds_cptr vp_ = vp0 + vs_prev;
#pragma unroll
        for (int i = 0; i < 8; ++i) VRD(i);
        o[0] = __builtin_amdgcn_mfma_f32_32x32x16_bf16(PAF(0), VFR(0), o[0], 0, 0, 0); o[1] = __builtin_amdgcn_mfma_f32_32x32x16_bf16(PAF(0), VFR(4), o[1], 0, 0, 0);
        o[0] = __builtin_amdgcn_mfma_f32_32x32x16_bf16(PAF(1), VFR(1), o[0], 0, 0, 0); o[1] = __builtin_amdgcn_mfma_f32_32x32x16_bf16(PAF(1), VFR(5), o[1], 0, 0, 0);
        o[0] = __builtin_amdgcn_mfma_f32_32x32x16_bf16(PAF(2), VFR(2), o[0], 0, 0, 0); o[1] = __builtin_amdgcn_mfma_f32_32x32x16_bf16(PAF(2), VFR(6), o[1], 0, 0, 0);
        o[0] = __builtin_amdgcn_mfma_f32_32x32x16_bf16(PAF(3), VFR(3), o[0], 0, 0, 0); o[1] = __builtin_amdgcn_mfma_f32_32x32x16_bf16(PAF(3), VFR(7), o[1], 0, 0, 0);
    }
    l_reg = fa::xhalf_sum(l_reg);
    if (MODE == 1 || MODE == 3) l_reg += __builtin_amdgcn_exp2f(sink2 - mhat);
    if (hi == 0) wsf[32 + r32] = 1.0f / l_reg;
    float rli[16];
#pragma unroll
    for (int r = 0; r < 16; ++r) rli[r] = wsf[32 + crow(r, hi)];
    bf16_t* stg = (bf16_t*)(shm + LDS_OST) + wid * 2048;
#pragma unroll
    for (int r = 0; r < 16; ++r) { const int orow = crow(r, hi);
#pragma unroll
        for (int dh = 0; dh < 2; ++dh) stg[orow * 64 + dh * 32 + r32] = (bf16_t)f2bf(o[dh][r] * rli[r]); }
#pragma unroll
    for (int i = 0; i < 4; ++i) { const int row = i * 8 + (lane >> 3), ch = lane & 7; const u32x4 v = *(const u32x4*)(stg + row * 64 + ch * 8); *(u32x4*)(Og + (size_t)(wid * 32 + row) * D + ch * 8) = v; }
    asm volatile("s_waitcnt vmcnt(0) lgkmcnt(0)\n\ts_barrier" ::: "memory");
#undef FA_KEY0
#undef DMA_K
#undef DMA_V
#undef WAIT_STEP
#undef MASK
#undef ROWMAX
#undef KLOAD
#undef KLOAD2
#undef ROT
#undef RESC
#undef VRD
#undef VFR
#undef PAF
#undef GAPA
#undef EX
#undef GAPB
#undef KRD
#undef STEP
}
#undef SBAR
#undef PIN
}

constexpr float SCALE_MLA = 0.10206207261596575f;
__device__ __forceinline__ void ph_attn(const Params& p, int layer, bool with_ctx, char* shm) {
    const QKVB qb = make_qkv(p.ws);
    bf16_t* O = (bf16_t*)(p.ws + WS_P);
    const int G = gridDim.x;
    const float NEG = -INFINITY;
    float km2[4];
#pragma unroll
    for (int mix = 0; mix < 4; ++mix) km2[mix] = ((const float*)(p.ws + WS_KM2))[layer * 4 + mix];
#define KMAX2(mix, bb, hk) km2[mix]
    for (int u = blockIdx.x; u < 256; u += G) { const int bh = u & 7, b = bh >> 2, h = bh & 3, qbk = u >> 3;
        fa2::attn_unit<96, 0, 6>(qb.QD + ((size_t)bh * SEQ + qbk * 256) * 96, qb.KD + (size_t)bh * KEYS * 96, qb.VD + (size_t)bh * KEYS * 64, O + (size_t)(b * SEQ + qbk * 256) * D + 768 + h * 64, qbk * 256, NEG, nullptr, shm, KMAX2(3, b, h)); }
    for (int u = blockIdx.x; u < 256; u += G) { const int bh = u & 7, b = bh >> 2, h = bh & 3, qbk = u >> 3;
        fa2::attn_unit<64, 0, 6>(qb.QB + ((size_t)bh * SEQ + qbk * 256) * 64, qb.KB + (size_t)(b * 2 + (h >> 1)) * KEYS * 64, qb.VB + (size_t)(b * 2 + (h >> 1)) * KEYS * 64, O + (size_t)(b * SEQ + qbk * 256) * D + 256 + h * 64, qbk * 256, NEG, nullptr, shm, KMAX2(1, b, h >> 1)); }
    for (int u = blockIdx.x; u < 256; u += G) { const int bh = u & 7, b = bh >> 2, h = bh & 3, qbk = u >> 3;
        fa2::attn_unit<64, 1, 6>(qb.QA + ((size_t)bh * SEQ + qbk * 256) * 64, qb.KA + (size_t)(b * 2 + (h >> 1)) * KEYS * 64, qb.VA + (size_t)(b * 2 + (h >> 1)) * KEYS * 64, O + (size_t)(b * SEQ + qbk * 256) * D + 0 + h * 64, qbk * 256, p.in[11][layer * 4 + h] * fa::LOG2E, nullptr, shm, KMAX2(0, b, h >> 1)); }
    for (int u = blockIdx.x; u < 256; u += G) { const int bh = u & 7, b = bh >> 2, h = bh & 3, qbk = u >> 3;
        fa2::attn_unit<64, 2, 6>(qb.QC + ((size_t)bh * SEQ + qbk * 256) * 64, qb.KC + (size_t)bh * KEYS * 64, qb.VC + (size_t)bh * KEYS * 64, O + (size_t)(b * SEQ + qbk * 256) * D + 512 + h * 64, qbk * 256, NEG, p.in[16] + ((size_t)layer * 4 + h) * 15 * 31, shm, KMAX2(2, b, h)); }
    if (with_ctx) for (int u = blockIdx.x; u < 32; u += G) { const int ty = u >> 3, bh = u & 7, b = bh >> 2, h = bh & 3;
        bf16_t* Oc = O + (size_t)(TL + b * CTX) * D + ty * 256 + h * 64;
        if (ty == 0) fa2::attn_unit<64, 3, 6>(qb.QAc + (size_t)bh * CTX * 64, qb.KA + (size_t)(b * 2 + (h >> 1)) * KEYS * 64, qb.VA + (size_t)(b * 2 + (h >> 1)) * KEYS * 64, Oc, 0, p.in[11][layer * 4 + h] * fa::LOG2E, nullptr, shm, KMAX2(0, b, h >> 1));
        else if (ty == 1) fa2::attn_unit<64, 3, 6>(qb.QBc + (size_t)bh * CTX * 64, qb.KB + (size_t)(b * 2 + (h >> 1)) * KEYS * 64, qb.VB + (size_t)(b * 2 + (h >> 1)) * KEYS * 64, Oc, 0, NEG, nullptr, shm, KMAX2(1, b, h >> 1));
        else if (ty == 2) fa2::attn_unit<64, 3, 6>(qb.QCc + (size_t)bh * CTX * 64, qb.KC + (size_t)bh * KEYS * 64, qb.VC + (size_t)bh * KEYS * 64, Oc, 0, NEG, nullptr, shm, KMAX2(2, b, h));
        else fa2::attn_unit<96, 3, 6>(qb.QDc + (size_t)bh * CTX * 96, qb.KD + (size_t)bh * KEYS * 96, qb.VD + (size_t)bh * KEYS * 64, Oc, 0, NEG, nullptr, shm, KMAX2(3, b, h)); }
}

__device__ __forceinline__ void ph_gnorm(const Params& p, int layer, int nrows) {
    const int tx = opq((int)threadIdx.x), lane = tx & 63, gw = (blockIdx.x * 512 + tx) >> 6, ngw = (gridDim.x * 512) >> 6;
    const bf16_t* O = (const bf16_t*)(p.ws + WS_P); bf16_t* Y = (bf16_t*)(p.ws + WS_ACT1); const float* g = p.in[23] + layer * D;
    f32x4 gv4[4];
#pragma unroll
    for (int grp = 0; grp < 4; ++grp) gv4[grp] = *(const f32x4*)(g + grp * 256 + 4 * lane);
    u32x2 wr_[4];
    if (gw < nrows) {
#pragma unroll
        for (int grp = 0; grp < 4; ++grp) wr_[grp] = *(const u32x2*)(O + (size_t)gw * D + grp * 256 + 4 * lane); }
    for (int m = gw; m < nrows; m += ngw) {
        u32x2 wn_[4]; { const int mc = (m + ngw < nrows) ? m + ngw : m;
#pragma unroll
            for (int grp = 0; grp < 4; ++grp) wn_[grp] = *(const u32x2*)(O + (size_t)mc * D + grp * 256 + 4 * lane); }
        __builtin_amdgcn_sched_barrier(0);
#pragma unroll
        for (int grp = 0; grp < 4; ++grp) { const int c = grp * 256 + 4 * lane; const u32x2 w = wr_[grp];
            const float a0 = bflo(w.x), a1 = bfhi(w.x), a2 = bflo(w.y), a3 = bfhi(w.y);
            const float r = rsqrtf(wave_sum(a0 * a0 + a1 * a1 + a2 * a2 + a3 * a3) * (1.f / 256.f) + EPS);
            const f32x4 gv = gv4[grp];
            if (FP8_OUT1 && layer == 1) *(unsigned*)((unsigned char*)Y + (size_t)m * D + c) = pk4_fp8(a0 * r * gv.x, a1 * r * gv.y, a2 * r * gv.z, a3 * r * gv.w);
            else { u32x2 o; o.x = pk2(a0 * r * gv.x, a1 * r * gv.y); o.y = pk2(a2 * r * gv.z, a3 * r * gv.w);
            *(u32x2*)(Y + (size_t)m * D + c) = o; } }
#pragma unroll
        for (int grp = 0; grp < 4; ++grp) wr_[grp] = wn_[grp];
    }
}

__device__ __forceinline__ void moe_bases(const unsigned* cnt, int (&base)[9]) {
    int acc = 0; unsigned c[8];
#pragma unroll
    for (int e = 0; e < 8; ++e) c[e] = cnt[64 * e];
    __builtin_amdgcn_sched_barrier(0);
#pragma unroll
    for (int e = 0; e < 8; ++e) { base[e] = acc; acc += ((int)c[e] + 255) / 256 * 256; }
    base[8] = acc;
}
__device__ __forceinline__ void ph_moe_gather(const Params& p) {
    const int tx = opq((int)threadIdx.x), lane = tx & 63, gw = (blockIdx.x * 512 + tx) >> 6, ngw = (gridDim.x * 512) >> 6;
    const unsigned* cnt = (const unsigned*)(p.ws + WS_CTL); int base[9]; moe_bases(cnt, base);
    if (blockIdx.x == 0 && tx < 136) { const int r = tx * 256; int e = -1;
#pragma unroll
        for (int i = 0; i < 8; ++i) if (r >= base[i] && r < base[i + 1]) e = i;
        ((int*)(p.ws + WS_TEXP))[tx] = e < 0 ? 0 : e; }
    const bf16_t* F = (const bf16_t*)(p.ws + WS_ACT1); unsigned char* A8 = p.ws + WS_ASORT8;
    int2 e, ps; u32x4 v0, v1;
    if (gw < TL) { e = ((const int2*)(p.ws + WS_TOKE))[gw]; ps = ((const int2*)(p.ws + WS_TOKP))[gw]; v0 = *(const u32x4*)(F + (size_t)gw * D + lane * 16); v1 = *(const u32x4*)(F + (size_t)gw * D + lane * 16 + 8); }
    for (int m = gw; m < TL; m += ngw) {
        const int mc = (m + ngw < TL) ? m + ngw : m;
        const int2 en = ((const int2*)(p.ws + WS_TOKE))[mc], psn = ((const int2*)(p.ws + WS_TOKP))[mc];
        const u32x4 v0n = *(const u32x4*)(F + (size_t)mc * D + lane * 16), v1n = *(const u32x4*)(F + (size_t)mc * D + lane * 16 + 8);
        __builtin_amdgcn_sched_barrier(0);
        int b0 = 0, b1 = 0;
#pragma unroll
        for (int i = 0; i < 8; ++i) { if (e.x == i) b0 = base[i]; if (e.y == i) b1 = base[i]; }
        const int s0 = b0 + ps.x, s1 = b1 + ps.y;
        u32x4 o; o.x = pk4_fp8(bflo(v0.x), bfhi(v0.x), bflo(v0.y), bfhi(v0.y)); o.y = pk4_fp8(bflo(v0.z), bfhi(v0.z), bflo(v0.w), bfhi(v0.w));
        o.z = pk4_fp8(bflo(v1.x), bfhi(v1.x), bflo(v1.y), bfhi(v1.y)); o.w = pk4_fp8(bflo(v1.z), bfhi(v1.z), bflo(v1.w), bfhi(v1.w));
        *(u32x4*)(A8 + (size_t)s0 * D + lane * 16) = o; *(u32x4*)(A8 + (size_t)s1 * D + lane * 16) = o;
        if (lane == 0) ((int2*)(p.ws + WS_TOKS))[m] = make_int2(s0, s1);
        e = en; ps = psn; v0 = v0n; v1 = v1n;
    }
}
__device__ __forceinline__ void ph_moe_combine(const Params& p, int layer) {
    const size_t nthr = (size_t)gridDim.x * 512, N = (size_t)TL * 256;
    const bf16_t* Y = (const bf16_t*)(p.ws + WS_ASORT);
    const float* modl = (const float*)(p.ws + WS_MOD) + (size_t)layer * 3 * 6144 + 5 * D;
    for (size_t idx0 = (size_t)blockIdx.x * 512 + opq((int)threadIdx.x); idx0 < N; idx0 += 4 * nthr) {
        int m[4], c[4]; bool ok[4]; int2 sl[4]; float2 g[4];
#pragma unroll
        for (int u = 0; u < 4; ++u) { const size_t idx = idx0 + u * nthr; ok[u] = idx < N; const size_t ix = ok[u] ? idx : idx0; m[u] = (int)(ix >> 8); c[u] = (int)(ix & 255) * 4;
            sl[u] = ((const int2*)(p.ws + WS_TOKS))[m[u]]; g[u] = ((const float2*)(p.ws + WS_TOKG))[m[u]]; }
        __builtin_amdgcn_sched_barrier(0);
        u32x2 a[4], b[4]; f32x4 o[4], md[4];
#pragma unroll
        for (int u = 0; u < 4; ++u) { a[u] = *(const u32x2*)(Y + (size_t)sl[u].x * D + c[u]); b[u] = *(const u32x2*)(Y + (size_t)sl[u].y * D + c[u]);
            o[u] = *(const f32x4*)(p.out + (size_t)m[u] * D + c[u]); md[u] = *(const f32x4*)(modl + (m[u] / SEQ) * 6144 + c[u]); }
        __builtin_amdgcn_sched_barrier(0);
#pragma unroll
        for (int u = 0; u < 4; ++u) { const f32x4 ya = {bflo(a[u].x), bfhi(a[u].x), bflo(a[u].y), bfhi(a[u].y)}, yb = {bflo(b[u].x), bfhi(b[u].x), bflo(b[u].y), bfhi(b[u].y)};
            if (ok[u]) *(f32x4*)(p.out + (size_t)m[u] * D + c[u]) = o[u] + md[u] * (ya * g[u].x + yb * g[u].y); }
        __builtin_amdgcn_sched_barrier(0);
    }
}

#ifndef DBL_PHASE
#define DBL_PHASE (-1)
#endif
#ifndef FILL_Q_IN
#define FILL_Q_IN 0
#define FILL_Q_OUT 0
#define FILL_Q_UP 0
#define FILL_Q_DN 0
#endif
struct Args { Params p; int ph_lo, ph_hi; };
__global__ void __launch_bounds__(NWAVES * 64, 2) mega_fwd(Args args) {
    extern __shared__ __attribute__((aligned(16))) unsigned char lds[];
    LAS unsigned char* ldsl = (LAS unsigned char*)lds;
    for (int u = threadIdx.x; u < (LDS_BYTES - LDSCTL_OFF) / 4; u += NWAVES * 64) ((LAS unsigned*)(ldsl + LDSCTL_OFF))[u] = 0u;
    __syncthreads();
    XcdBarrier bar = xcd_barrier_post((unsigned*)(args.p.ws + WS_CTL) + CW_BAR, (volatile LAS unsigned*)(ldsl + MISC_OFF) + 8);
    const int lo = args.ph_lo, hi = args.ph_hi;
#pragma unroll 1
    for (int ph = lo; ph < hi; ++ph) {
      const int nrep = (ph == DBL_PHASE) ? 2 : 1;
#pragma unroll 1
      for (int rep_ = 0; rep_ < nrep; ++rep_) {
        if (rep_) xcd_barrier(bar);
        Params q = args.p; { size_t z_ = 0; asm volatile("" : "+s"(z_)); q.ws = args.p.ws + z_; q.out = args.p.out + z_; }
        LAS unsigned char* ldq = (LAS unsigned char*)lds;
        const int l = ph >= 10 ? 1 : 0, st = ph == 0 ? -1 : (l ? ph - 10 : ph - 1);
        const bool last = (l == 1); const int nrows = last ? TL : MALL;
        const float* qmod = (const float*)(q.ws + WS_MOD) + (size_t)l * 3 * 6144;
        int fillq = 0, fill_nwg = 1;
        if (st == -1) ph_prologue(q, (float*)lds);
        else if (st == 0) ph_norm<1, false>(q, l, MALL, (unsigned*)lds, l ? 11 : 0);
        else if (st == 1) { if (FP8_IN1 && l == 1) run_gemm<EpiBf16Perm, true>(ldq, (const bf16_t*)(q.ws + WS_ACT1), (const bf16_t*)(q.ws + WS_WIN) + (size_t)l * NINP * D, D / 2, MALL / 256, NINP / 256, nullptr, 0, EpiBf16Perm{(bf16_t*)(q.ws + WS_P), NINP, 0});
                            else run_gemm(ldq, (const bf16_t*)(q.ws + WS_ACT1), (const bf16_t*)(q.ws + WS_WIN) + (size_t)l * NINP * D, D, MALL / 256, NINP / 256, nullptr, 0, EpiBf16Perm{(bf16_t*)(q.ws + WS_P), NINP, 0});
                            fillq = FILL_Q_IN; fill_nwg = (MALL / 256) * (NINP / 256); }
        else if (st == 2) ph_postproj2(q, l, ldq);
        else if (st == 3) ph_attn(q, l, !last, (char*)lds);
        else if (st == 4) ph_gnorm(q, l, nrows);
        else if (st == 5 || (st == 8 && !last)) {
            const bool op = (st == 5);
            const bf16_t* A_ = (const bf16_t*)(q.ws + (op ? WS_ACT1 : WS_HIDF)); const bf16_t* B_ = op ? (const bf16_t*)(q.ws + WS_WOUT) + (size_t)l * D * D : (const bf16_t*)(q.ws + WS_WFDN);
            const int K_ = op ? D : DFF, goff_ = op ? 2 * D : 5 * D;
            const float* hl_in_ = (op && l == 0) ? q.in[0] : q.out;
            if (FP8_OUT1 && last) run_gemm<EpiResid, true>(ldq, A_, B_, D / 2, 64, D / 256, nullptr, 0, EpiResid{hl_in_, (const float*)(q.ws + WS_HCTX), q.out, (float*)(q.ws + WS_HCTX), qmod, goff_, 0});
            else
#pragma unroll 1
            for (int pass = 0; pass < (last ? 1 : 2); ++pass)
                run_gemm(ldq, A_, B_, K_, pass ? 2 : 64, D / 256, nullptr, 0, EpiResid{hl_in_, (const float*)(q.ws + WS_HCTX), q.out, pass ? (float*)(q.ws + WS_PART) : (float*)(q.ws + WS_HCTX), qmod, goff_, pass}, pass ? (op ? 8 : 11) : 1, pass ? 64 : 0);
        }
        else if (!last) {
            if (st == 6) ph_norm<2, false>(q, l, MALL, (unsigned*)lds, 8);
            else if (st == 7) { run_gemm(ldq, (const bf16_t*)(q.ws + WS_ACT1), (const bf16_t*)(q.ws + WS_WFGU), D, MALL / 256, 2 * DFF / 256, nullptr, 0, EpiSwiglu{(bf16_t*)(q.ws + WS_HIDF), DFF, 0});
                                fillq = FILL_Q_UP; fill_nwg = (MALL / 256) * (2 * DFF / 256); }
            else {}
        } else {
            if (st == 6) ph_norm<2, true>(q, l, TL, (unsigned*)lds, 0);
            else if (st == 7) { ph_moe_gather(q); fillq = 1 << 30; fill_nwg = 0; }
            else if (st == 8) { int base[9]; moe_bases((const unsigned*)(q.ws + WS_CTL), base);
                run_gemm<EpiSwiglu8, true>(ldq, (const bf16_t*)(q.ws + WS_ASORT8), (const bf16_t*)(q.ws + WS_WMGU), D / 2, __builtin_amdgcn_readfirstlane(base[8] / 256), 2 * DFFE / 256, (const int*)(q.ws + WS_TEXP), (size_t)2 * DFFE * D, EpiSwiglu8{q.ws + WS_HIDM, DFFE, 0}); }
            else if (st == 9) { int base[9]; moe_bases((const unsigned*)(q.ws + WS_CTL), base);
                run_gemm<EpiBf16Perm, true>(ldq, (const bf16_t*)(q.ws + WS_HIDM), (const bf16_t*)(q.ws + WS_WMDN), DFFE / 2, __builtin_amdgcn_readfirstlane(base[8] / 256), D / 256, (const int*)(q.ws + WS_TEXP), (size_t)D * DFFE, EpiBf16Perm{(bf16_t*)(q.ws + WS_ASORT), D, 0}); }
            else ph_moe_combine(q, l);
        }
        if (fillq > 0 && (fill_nwg == 0 || gemm_tail_idle(fill_nwg))) fill_moe(q, (float*)lds, fillq);
      }
      if (ph + 1 < hi) xcd_barrier(bar);
    }
}

#ifndef MK_CUTS
#define MK_CUTS 0
#endif
extern "C" void kernel_launch(void* const* d_in, const int* in_sizes, int n_in, void* d_out, int out_size, void* d_ws, size_t ws_size, hipStream_t stream) {
    static int grid = 0;
    if (grid == 0) {
        if (n_in != 32 || ws_size < WS_END) { fprintf(stderr, "kernel_launch: need 32 inputs and %zu bytes of workspace (got %d, %zu)\n", (size_t)WS_END, n_in, ws_size); grid = -1; return; }
        int dev = 0, cus = 0, per_cu = 0;
        if (hipGetDevice(&dev) != hipSuccess || hipDeviceGetAttribute(&cus, hipDeviceAttributeMultiprocessorCount, dev) != hipSuccess) { grid = -1; return; }
        if (hipFuncSetAttribute((const void*)mega_fwd, hipFuncAttributeMaxDynamicSharedMemorySize, LDS_BYTES) != hipSuccess) { fprintf(stderr, "kernel_launch: hipFuncSetAttribute failed\n"); grid = -1; return; }
        if (hipOccupancyMaxActiveBlocksPerMultiprocessor(&per_cu, (const void*)mega_fwd, NWAVES * 64, LDS_BYTES) != hipSuccess || per_cu < 1) fprintf(stderr, "kernel_launch: occupancy query says %d blocks per CU\n", per_cu);
        (void)hipGetLastError();
        grid = cus;
    }
    if (grid < 0) return;
    (void)hipMemsetAsync((char*)d_ws + WS_CTL, 0, CTL_ZERO_BYTES, stream);
    Args a{}; for (int i = 0; i < 32; ++i) a.p.in[i] = (const float*)d_in[i]; a.p.out = (float*)d_out; a.p.ws = (unsigned char*)d_ws;
#if MK_CUTS
    for (int ph = 0; ph < 24; ++ph) { a.ph_lo = ph; a.ph_hi = ph + 1; hipLaunchKernelGGL(mega_fwd, dim3(grid), dim3(NWAVES * 64), LDS_BYTES, stream, a); }
#else
    a.ph_lo = 0; a.ph_hi = 21;
    hipLaunchKernelGGL(mega_fwd, dim3(grid), dim3(NWAVES * 64), LDS_BYTES, stream, a);
#endif
}
```

```cpp
#include <hip/hip_runtime.h>
#include <stdint.h>
#include <cstdio>

typedef unsigned short bf16_t;
typedef float f32x4 __attribute__((ext_vector_type(4)));
typedef unsigned u32x4 __attribute__((ext_vector_type(4)));
typedef unsigned u32x2 __attribute__((ext_vector_type(2)));

constexpr int D = 1024, NB = 2, SEQ = 8192, CTX = 256, TL = NB * SEQ, TC = NB * CTX, MALL = TL + TC;
constexpr int NIN = 2144, NINP = 2304, DFF = 2816, NE = 8, DFFE = 3584, KEYS = CTX + SEQ;
constexpr int OFF_AQ = 0, OFF_AK = 256, OFF_AV = 384, OFF_BQ = 512, OFF_BK = 768, OFF_BV = 896, OFF_CQ = 1024, OFF_CK = 1280,
              OFF_CV = 1536, OFF_DCQ = 1792, OFF_DCKV = 1984, OFF_DKR = 2112;
constexpr int MOE_ROWS = 34816;
constexpr float EPS = 1e-6f;

constexpr size_t MiB = 1u << 20;
constexpr size_t WS_CTL = 0;
constexpr size_t WS_MOD = 1 * MiB;
constexpr size_t WS_ROPE = WS_MOD + 256 * 1024;
constexpr size_t WS_TOKE = WS_ROPE + 64 * 1024;
constexpr size_t WS_TOKP = WS_TOKE + TL * 8;
constexpr size_t WS_TOKG = WS_TOKP + TL * 8;
constexpr size_t WS_TEXP = WS_TOKG + TL * 8;
constexpr size_t WS_TOKS = WS_TEXP + 1024;
constexpr size_t WS_KM2 = WS_TOKS + TL * 8;
constexpr size_t WS_HCTX = 2 * MiB;
constexpr size_t WS_WMGU = 6 * MiB;
constexpr size_t WS_WMDN = WS_WMGU + 112 * MiB;
constexpr size_t WS_WDEAD = WS_WMDN + 56 * MiB;
constexpr size_t WS_WIN = WS_WDEAD;
constexpr size_t WS_WOUT = WS_WIN + 9 * MiB;
constexpr size_t WS_WUQ = WS_WOUT + 4 * MiB;
constexpr size_t WS_WUKV = WS_WUQ + 512 * 1024;
constexpr size_t WS_WFGU = WS_WUKV + 512 * 1024;
constexpr size_t WS_WFDN = WS_WFGU + 11 * MiB;
constexpr size_t WS_ACT = 205 * MiB;
static_assert(WS_WFDN + (size_t)1024 * 2816 * 2 <= WS_ACT, "weights fit");
constexpr size_t WS_ACT1 = WS_ACT;
constexpr size_t WS_P = WS_ACT + 33 * MiB;
constexpr size_t WS_QKV = WS_ACT + 108 * MiB;
constexpr size_t WS_PART = WS_ACT + 128 * MiB;
constexpr size_t WS_HIDF = WS_P;
constexpr size_t WS_HIDM = WS_WDEAD;
constexpr size_t WS_ASORT = WS_HIDM + 238 * MiB;
constexpr size_t WS_END = WS_ASORT + 68 * MiB;
constexpr size_t WS_Y2S = 330 * MiB;
constexpr int MD_SL = 7, MD_TROWS = 2048;
constexpr size_t WS_ASORT8 = WS_HIDM + 120 * MiB;
static_assert((size_t)MOE_ROWS * DFFE <= 120 * MiB && WS_ASORT8 + (size_t)MOE_ROWS * D <= WS_ASORT, "fp8 MoE buffers");
static_assert(WS_QKV + 91 * MiB <= WS_END, "qkv fits");

#ifndef FP8_IN1
#define FP8_IN1 1
#endif
#ifndef FP8_OUT1
#define FP8_OUT1 0
#endif
struct Params { const float* in[32]; float* out; unsigned char* ws; };

struct QKVB { bf16_t *QA, *KA, *VA, *QB, *KB, *VB, *QC, *KC, *VC, *QD, *KD, *VD, *QAc, *QBc, *QCc, *QDc; };
__host__ __device__ inline QKVB make_qkv(unsigned char* ws) {
    QKVB q; bf16_t* p = (bf16_t*)(ws + WS_QKV);
    q.QA = p; p += (size_t)NB * 4 * SEQ * 64; q.KA = p; p += (size_t)NB * 2 * KEYS * 64; q.VA = p; p += (size_t)NB * 2 * KEYS * 64;
    q.QB = p; p += (size_t)NB * 4 * SEQ * 64; q.KB = p; p += (size_t)NB * 2 * KEYS * 64; q.VB = p; p += (size_t)NB * 2 * KEYS * 64;
    q.QC = p; p += (size_t)NB * 4 * SEQ * 64; q.KC = p; p += (size_t)NB * 4 * KEYS * 64; q.VC = p; p += (size_t)NB * 4 * KEYS * 64;
    q.QD = p; p += (size_t)NB * 4 * SEQ * 96; q.KD = p; p += (size_t)NB * 4 * KEYS * 96; q.VD = p; p += (size_t)NB * 4 * KEYS * 64;
    q.QAc = p; p += (size_t)NB * 4 * CTX * 64; q.QBc = p; p += (size_t)NB * 4 * CTX * 64; q.QCc = p; p += (size_t)NB * 4 * CTX * 64;
    q.QDc = p; p += (size_t)NB * 4 * CTX * 96;
    return q;
}

__device__ __forceinline__ float bf2f(unsigned v) { return __uint_as_float(v << 16); }
__device__ __forceinline__ float bflo(unsigned w) { return __uint_as_float(w << 16); }
__device__ __forceinline__ float bfhi(unsigned w) { return __uint_as_float(w & 0xffff0000u); }
__device__ __forceinline__ unsigned f2bf(float f) { unsigned u = __float_as_uint(f); return (u + 0x7fffu + ((u >> 16) & 1u)) >> 16; }
typedef float pk_f32x2 __attribute__((ext_vector_type(2))); typedef __bf16 pk_bf16x2 __attribute__((ext_vector_type(2)));
__device__ __forceinline__ unsigned pk2(float lo, float hi) { pk_f32x2 v = {lo, hi}; pk_bf16x2 b = __builtin_convertvector(v, pk_bf16x2); return __builtin_bit_cast(unsigned, b); }
template <int X> __device__ __forceinline__ float swz_xor(float v) { return __int_as_float(__builtin_amdgcn_ds_swizzle(__float_as_int(v), 0x1f | (X << 10))); }
__device__ __forceinline__ float half_sum(float v) { auto rr = __builtin_amdgcn_permlane32_swap(__float_as_uint(v), __float_as_uint(v), false, false); return __uint_as_float(rr[0]) + __uint_as_float(rr[1]); }
__device__ __forceinline__ float half_other(float v, int lane) { auto rr = __builtin_amdgcn_permlane32_swap(__float_as_uint(v), __float_as_uint(v), false, false); return __uint_as_float((lane & 32) ? rr[0] : rr[1]); }
__device__ __forceinline__ float wave_sum(float v) { v += swz_xor<1>(v); v += swz_xor<2>(v); v += swz_xor<4>(v); v += swz_xor<8>(v); v += swz_xor<16>(v); return half_sum(v); }
__device__ __forceinline__ float half_max(float v) { auto rr = __builtin_amdgcn_permlane32_swap(__float_as_uint(v), __float_as_uint(v), false, false); return fmaxf(__uint_as_float(rr[0]), __uint_as_float(rr[1])); }
__device__ __forceinline__ int opq(int v) { asm volatile("" : "+v"(v)); return v; }
template <class T> __device__ __forceinline__ T* opqp(T* p) { asm volatile("" : "+s"(p)); return p; }
__device__ __forceinline__ int opqs(int v) { asm volatile("" : "+s"(v)); return v; }
__device__ __forceinline__ float silu_f(float x) { return x / (1.f + expf(-x)); }
__device__ __forceinline__ unsigned pk4_fp8(float a, float b, float c, float d) { unsigned w = 0; w = __builtin_amdgcn_cvt_pk_fp8_f32(a, b, w, false); w = __builtin_amdgcn_cvt_pk_fp8_f32(c, d, w, true); return w; }
__device__ __forceinline__ float silu_fast(float x) { return x * __builtin_amdgcn_rcpf(1.f + __builtin_amdgcn_exp2f(-1.4426950408889634f * x)); }

constexpr int RT_R64 = 0, RT_C64 = 2048, RT_R32 = 3072, RT_C32 = 4096, RT_N = 4608;

namespace pg8 {
#define PG8_LAS __attribute__((address_space(3)))
typedef unsigned short bf16_t;
typedef short bf16x8 __attribute__((ext_vector_type(8)));
typedef float f32x4 __attribute__((ext_vector_type(4)));
typedef unsigned u32x4 __attribute__((ext_vector_type(4)));
constexpr int BM = 256, BK = 64, HALF = 128, HTB = HALF * BK * 2  , STAGE_BYTES = 8 * HTB, NXCD = 8, WGM = 8;

__host__ __device__ __forceinline__ int lds_byte(int r, int c) { const int st = (r >> 4) * 2 + (c >> 5), rr = r & 15, cc = c & 31, ob = rr * 64 + cc * 2; return st * 1024 + (ob ^ (((ob >> 9) & 1) << 5)); }
__host__ __device__ __forceinline__ void stage_rc(int b, int& R, int& C) { const int st = b / 1024, sb = b % 1024, swz = sb ^ (((sb >> 9) & 1) << 5); R = (st >> 1) * 16 + swz / 64; C = (st & 1) * 32 + (swz % 64) / 2; }
__host__ __device__ __forceinline__ int perm32(int rho) { const int n = rho >> 4, i = rho & 15; return 8 * (i >> 2) + 4 * n + (i & 3); }

struct Unit { int pm, pn, e, ks; };
struct Gemm { const bf16_t* A; const bf16_t* Bt; int K; size_t estride; int Kloop; };

struct StaticOrder {
    int nM, nN, nwg, G, c, S, pm0; const int* texp;
    __host__ __device__ void init(int nM_, int nN_, int G_, int c_, const int* texp_, int S_ = 1, int pm0_ = 0) { nM = nM_; nN = nN_; nwg = nM * nN; G = G_; c = c_; texp = texp_; S = S_; pm0 = pm0_; }
    __host__ __device__ bool next(int i, Unit& u) const {
        const long L = (long)i * G + c; if (L >= (long)nwg * S) return false;
        u.ks = (int)(L % S); int wgid = (int)(L / S); { const int q = nwg / NXCD, r = nwg % NXCD, xcd = wgid % NXCD, off = wgid / NXCD; wgid = (xcd < r ? xcd * (q + 1) : r * (q + 1) + (xcd - r) * q) + off; }
        const int nig = WGM * nN, gid = wgid / nig, fm = gid * WGM, gsz = (nM - fm) < WGM ? (nM - fm) : WGM;
        u.pm = fm + ((wgid % nig) % gsz); u.pn = (wgid % nig) / gsz; u.e = texp ? __builtin_amdgcn_readfirstlane(texp[u.pm]) : 0; u.pm += pm0; return true;
    }
    __device__ __forceinline__ void a_ready(const Unit&) const {}
    __device__ __forceinline__ void done(const Unit&) const {}
};

template <class Epi, class Sched, bool ALIGN_EPI = false, bool SP2 = false, bool FP8 = false>
__device__ __forceinline__ void gemm_phase(PG8_LAS unsigned char* lds, const Gemm g, const Sched& S, const Epi& E) {
    const int tid = opq((int)threadIdx.x), wid = __builtin_amdgcn_readfirstlane(tid >> 6), lane = tid & 63, wr = wid >> 2, wc = wid & 3, fr = lane & 15, fq = lane >> 4;
    const int K = g.K, nt = g.Kloop / BK;
    unsigned voffA[2], voffB[2];
#pragma unroll
    for (int i = 0; i < 2; ++i) { int R, C; stage_rc(tid * 16 + i * 8192, R, C); const int Rb = Epi::PERM ? ((R & ~31) + perm32(R & 31)) : R;
        voffA[i] = (unsigned)(R * K + C) * 2u; voffB[i] = (unsigned)(Rb * K + C) * 2u; }
    const size_t kstep = (size_t)(BK * 2);
    const size_t hstep = (size_t)HALF * K * 2;
    const size_t tstep = 2 * hstep;
    const unsigned ldsw = (unsigned)wid * 1024u;
    const int aoff = lds_byte(wr * 64 + fr, fq * 8), boff = lds_byte(wc * 32 + fr, fq * 8);
#define PG8_SA(b, h) (((b) * 2 + (h)) * HTB)
#define PG8_SB(b, h) ((4 + (b) * 2 + (h)) * HTB)
#define PG8_STAGE(bufoff, gbase, voff) do { _Pragma("unroll") for (int _i = 0; _i < 2; ++_i) \
        __builtin_amdgcn_global_load_lds((const unsigned*)((const char*)(gbase) + (voff)[_i]), (PG8_LAS unsigned*)(lds + (bufoff) + ldsw + _i * 8192), 16, 0, 0); } while (0)
#define PG8_LDA(dst, b, h) do { _Pragma("unroll") for (int m = 0; m < 4; ++m) _Pragma("unroll") for (int k = 0; k < 2; ++k) dst[m][k] = *(const PG8_LAS bf16x8*)(lds + PG8_SA(b, h) + aoff + m * 2048 + k * 1024); } while (0)
#define PG8_LDB(dst, b, h) do { _Pragma("unroll") for (int n = 0; n < 2; ++n) _Pragma("unroll") for (int k = 0; k < 2; ++k) dst[n][k] = *(const PG8_LAS bf16x8*)(lds + PG8_SB(b, h) + boff + n * 2048 + k * 1024); } while (0)
#define PG8_MMA(ai, bj, At, Bt) do { __builtin_amdgcn_s_setprio(1); \
        if constexpr (FP8) { const int sc_ = 0x7f7f7f7f; _Pragma("unroll") for (int m = 0; m < 4; ++m) _Pragma("unroll") for (int n = 0; n < 2; ++n) { \
            typedef int v4i_ __attribute__((ext_vector_type(4))); typedef int v8i_ __attribute__((ext_vector_type(8))); \
            const v8i_ bo_ = __builtin_shufflevector(__builtin_bit_cast(v4i_, Bt[n][0]), __builtin_bit_cast(v4i_, Bt[n][1]), 0, 1, 2, 3, 4, 5, 6, 7); \
            const v8i_ ao_ = __builtin_shufflevector(__builtin_bit_cast(v4i_, At[m][0]), __builtin_bit_cast(v4i_, At[m][1]), 0, 1, 2, 3, 4, 5, 6, 7); \
            asm("s_nop 1\n\tv_mfma_scale_f32_16x16x128_f8f6f4 %0, %1, %2, %0, %3, %3 op_sel_hi:[0,0,0]" : "+v"(acc[ai][bj][m][n]) : "v"(bo_), "v"(ao_), "v"(sc_)); } } \
        else { _Pragma("unroll") for (int m = 0; m < 4; ++m) _Pragma("unroll") for (int n = 0; n < 2; ++n) _Pragma("unroll") for (int k = 0; k < 2; ++k) \
            acc[ai][bj][m][n] = __builtin_amdgcn_mfma_f32_16x16x32_bf16(Bt[n][k], At[m][k], acc[ai][bj][m][n], 0, 0, 0); } \
        __builtin_amdgcn_s_setprio(0); } while (0)
#define PG8_WAIT_V(n) asm volatile("s_waitcnt vmcnt(" #n ")" ::: "memory")
#define PG8_WAIT_L(n) asm volatile("s_waitcnt lgkmcnt(" #n ")" ::: "memory")
#define PG8_BAR __builtin_amdgcn_s_barrier()
#define PG8_SCHED __builtin_amdgcn_sched_barrier(0)
    Unit cur, nxt; int ui = 0;
    if (!S.next(0, cur)) return;
    f32x4 acc[2][2][4][2];
#pragma unroll
    for (int a = 0; a < 2; ++a)
#pragma unroll
        for (int b = 0; b < 2; ++b)
#pragma unroll
            for (int m = 0; m < 4; ++m)
#pragma unroll
                for (int n = 0; n < 2; ++n) acc[a][b][m][n] = (f32x4){0.f, 0.f, 0.f, 0.f};
    bf16x8 At[4][2], B0[2][2], B1[2][2];
    const char* cA = (const char*)g.A + (size_t)cur.pm * tstep + (size_t)cur.ks * g.Kloop * 2; const char* cB = (const char*)g.Bt + (size_t)cur.e * g.estride + (size_t)cur.pn * tstep + (size_t)cur.ks * g.Kloop * 2;
    S.a_ready(cur);
    if constexpr (SP2) {
        PG8_STAGE(PG8_SB(0, 0), cB, voffB); PG8_STAGE(PG8_SB(0, 1), cB + hstep, voffB); PG8_STAGE(PG8_SA(0, 0), cA, voffA); PG8_STAGE(PG8_SA(0, 1), cA + hstep, voffA);
        if (wr == 1) PG8_BAR;
        PG8_WAIT_V(2); PG8_BAR;
        PG8_STAGE(PG8_SB(1, 0), cB + kstep, voffB); PG8_STAGE(PG8_SA(1, 0), cA + kstep, voffA); PG8_STAGE(PG8_SB(1, 1), cB + hstep + kstep, voffB);
        PG8_WAIT_V(6); PG8_BAR;
    } else {
        PG8_STAGE(PG8_SB(0, 0), cB, voffB); PG8_STAGE(PG8_SA(0, 0), cA, voffA); PG8_STAGE(PG8_SB(0, 1), cB + hstep, voffB); PG8_STAGE(PG8_SA(0, 1), cA + hstep, voffA);
        if (wr == 1) PG8_BAR;
        PG8_WAIT_V(4); PG8_BAR;
        PG8_STAGE(PG8_SB(1, 0), cB + kstep, voffB); PG8_STAGE(PG8_SA(1, 0), cA + kstep, voffA); PG8_STAGE(PG8_SB(1, 1), cB + hstep + kstep, voffB);
        PG8_WAIT_V(6); PG8_BAR;
    }
    for (;;) {
        const bool has_next = S.next(ui + 1, nxt);
        const char* nA = has_next ? (const char*)g.A + (size_t)nxt.pm * tstep + (size_t)nxt.ks * g.Kloop * 2 : cA; const char* nB = has_next ? (const char*)g.Bt + (size_t)nxt.e * g.estride + (size_t)nxt.pn * tstep + (size_t)nxt.ks * g.Kloop * 2 : cB;
        for (int t = 0; t < nt; t += 2) {
            const bool last = (t == nt - 2);
            const char* a1 = cA + (size_t)(t + 1) * kstep;
            const char* a2 = last ? nA : cA + (size_t)(t + 2) * kstep; const char* b2 = last ? nB : cB + (size_t)(t + 2) * kstep;
            const char* a3 = a2 + kstep; const char* b3 = b2 + kstep;
            if (last && has_next) S.a_ready(nxt);
            if constexpr (SP2) {
            PG8_LDB(B0, 0, 0); PG8_LDB(B1, 0, 1); PG8_SCHED; PG8_LDA(At, 0, 0); PG8_STAGE(PG8_SA(1, 1), a1 + hstep, voffA);
            PG8_WAIT_V(8); PG8_WAIT_L(0); PG8_BAR; PG8_MMA(0, 0, At, B0); PG8_MMA(0, 1, At, B1); PG8_BAR; PG8_SCHED;
            PG8_LDA(At, 0, 1); PG8_STAGE(PG8_SB(0, 0), b2, voffB); PG8_STAGE(PG8_SB(0, 1), b2 + hstep, voffB); PG8_STAGE(PG8_SA(0, 0), a2, voffA);
            PG8_WAIT_V(8); PG8_WAIT_L(0); PG8_BAR; PG8_MMA(1, 0, At, B0); PG8_MMA(1, 1, At, B1); PG8_BAR; PG8_SCHED;
            PG8_LDB(B0, 1, 0); PG8_LDB(B1, 1, 1); PG8_SCHED; PG8_LDA(At, 1, 0); PG8_STAGE(PG8_SA(0, 1), a2 + hstep, voffA);
            PG8_WAIT_V(8); PG8_WAIT_L(0); PG8_BAR; PG8_MMA(0, 0, At, B0); PG8_MMA(0, 1, At, B1); PG8_BAR; PG8_SCHED;
            PG8_LDA(At, 1, 1); PG8_STAGE(PG8_SB(1, 0), b3, voffB); PG8_STAGE(PG8_SB(1, 1), b3 + hstep, voffB); PG8_STAGE(PG8_SA(1, 0), a3, voffA);
            PG8_WAIT_V(8); PG8_WAIT_L(0); PG8_BAR; PG8_MMA(1, 0, At, B0); PG8_MMA(1, 1, At, B1); PG8_BAR; PG8_SCHED;
            } else {
            PG8_LDB(B0, 0, 0); PG8_SCHED; PG8_LDA(At, 0, 0); PG8_STAGE(PG8_SA(1, 1), a1 + hstep, voffA);
            PG8_WAIT_L(8); PG8_BAR; PG8_WAIT_L(0); PG8_MMA(0, 0, At, B0); PG8_BAR; PG8_SCHED;
            PG8_LDB(B1, 0, 1); PG8_STAGE(PG8_SB(0, 0), b2, voffB);
            PG8_BAR; PG8_WAIT_L(0); PG8_MMA(0, 1, At, B1); PG8_BAR;
            PG8_LDA(At, 0, 1); PG8_STAGE(PG8_SA(0, 0), a2, voffA);
            PG8_BAR; PG8_WAIT_L(0); PG8_MMA(1, 0, At, B0); PG8_BAR; PG8_SCHED;
            PG8_STAGE(PG8_SB(0, 1), b2 + hstep, voffB);
            PG8_WAIT_V(6); PG8_BAR; PG8_MMA(1, 1, At, B1); PG8_BAR;
            PG8_LDB(B0, 1, 0); PG8_SCHED; PG8_LDA(At, 1, 0); PG8_STAGE(PG8_SA(0, 1), a2 + hstep, voffA);
            PG8_WAIT_L(8); PG8_BAR; PG8_WAIT_L(0); PG8_MMA(0, 0, At, B0); PG8_BAR; PG8_SCHED;
            PG8_LDB(B1, 1, 1); PG8_STAGE(PG8_SB(1, 0), b3, voffB);
            PG8_BAR; PG8_WAIT_L(0); PG8_MMA(0, 1, At, B1); PG8_BAR;
            PG8_LDA(At, 1, 1); PG8_STAGE(PG8_SA(1, 0), a3, voffA);
            PG8_BAR; PG8_WAIT_L(0); PG8_MMA(1, 0, At, B0); PG8_BAR; PG8_SCHED;
            PG8_STAGE(PG8_SB(1, 1), b3 + hstep, voffB);
            PG8_WAIT_V(6); PG8_BAR; PG8_MMA(1, 1, At, B1); PG8_BAR;
            }
        }
        if constexpr (ALIGN_EPI) { if (wr == 0) PG8_BAR; }
        if constexpr (FP8) {
            asm volatile("s_nop 15\n\ts_nop 7" ::: "memory");
#pragma unroll
            for (int a_ = 0; a_ < 2; ++a_)
#pragma unroll
                for (int b_ = 0; b_ < 2; ++b_)
#pragma unroll
                    for (int m_ = 0; m_ < 4; ++m_) asm volatile("" : "+v"(acc[a_][b_][m_][0]), "+v"(acc[a_][b_][m_][1]));
        }
        if constexpr (!Epi::AFTER_DRAIN) { E(acc, cur, wr, wc, fr, fq); S.done(cur); }
        if (!has_next) break;
#pragma unroll
        for (int a = 0; a < 2; ++a)
#pragma unroll
            for (int b = 0; b < 2; ++b)
#pragma unroll
                for (int m = 0; m < 4; ++m)
#pragma unroll
                    for (int n = 0; n < 2; ++n) acc[a][b][m][n] = (f32x4){0.f, 0.f, 0.f, 0.f};
        cur = nxt; cA = nA; cB = nB; ++ui;
        if constexpr (ALIGN_EPI) { if (wr == 1) PG8_BAR; }
    }
    PG8_WAIT_V(0);
    if constexpr (!ALIGN_EPI) { if (wr == 0) PG8_BAR; }
    PG8_BAR;
    if constexpr (Epi::AFTER_DRAIN) { E.fused(acc, cur, wr, wc, fr, fq, lds, wid, lane); S.done(cur); }
#undef PG8_SA
#undef PG8_SB
#undef PG8_STAGE
#undef PG8_LDA
#undef PG8_LDB
#undef PG8_MMA
#undef PG8_WAIT_V
#undef PG8_WAIT_L
#undef PG8_BAR
#undef PG8_SCHED
}
}

#define GAS __attribute__((address_space(1)))
#define LAS __attribute__((address_space(3)))
typedef GAS unsigned gu32;
#define RLX_AGENT __ATOMIC_RELAXED, __HIP_MEMORY_SCOPE_AGENT
constexpr int NWAVES = 8;
constexpr int CW_BAR = 4096;
constexpr int RING_BYTES = 131072, LDSCTL_OFF = RING_BYTES, MISC_OFF = LDSCTL_OFF + 320, LDS_BYTES = 147456;
constexpr size_t CTL_ZERO_BYTES = 65536;

#define XB_TMO      128
#define XB_XCNT(j)  (256  + 64 * (j))
#define XB_XSUB(j)  (1280 + 64 * (j))
#define XB_XGEN(j)  (2304 + 64 * (j))
#define XB_TOP      3328
#define XB_TOPGEN   3392
#define XCD_BAR_WORDS 3456
#define XB_SPIN_CAP (1u << 18)

__device__ __forceinline__ unsigned xb_ld(unsigned* p)              { return __hip_atomic_load(p, __ATOMIC_RELAXED, __HIP_MEMORY_SCOPE_AGENT); }
__device__ __forceinline__ unsigned xb_add(unsigned* p, unsigned v) { return __hip_atomic_fetch_add(p, v, __ATOMIC_RELAXED, __HIP_MEMORY_SCOPE_AGENT); }
__device__ __forceinline__ unsigned xb_xcc_id() { return (unsigned)__builtin_amdgcn_s_getreg((3 << 11) | 20) & 0xFu; }
#define XB_SPIN(cond, bar) do { unsigned _sp = 0; while (cond) { __builtin_amdgcn_s_sleep(1); \
    if ((++_sp & 255u) == 0u) { if (xb_ld(&(bar)[XB_TMO])) break; if (_sp > XB_SPIN_CAP) { atomicAdd(&(bar)[XB_TMO], 1u); break; } } } } while (0)

struct XcdBarrier {
    unsigned* bar; unsigned x;
    volatile LAS unsigned* st;
};

__device__ __forceinline__ XcdBarrier xcd_barrier_post(unsigned* bar, volatile LAS unsigned* st) {
    XcdBarrier b; b.bar = bar; b.x = xb_xcc_id(); b.st = st;
    if (threadIdx.x == 0) (void)xb_add(&bar[XB_XCNT(b.x)], 1u);
    return b;
}
__device__ __forceinline__ void xcd_barrier_complete(unsigned* bar, unsigned x, unsigned& nloc, unsigned& nx) {
    const unsigned G = gridDim.x * gridDim.y * gridDim.z;
    unsigned sum, cnt, mine, sp = 0u;
    for (;;) {
        sum = 0u; cnt = 0u; mine = 0u;
        unsigned cj[16];
#pragma unroll
        for (unsigned j = 0; j < 16; ++j) asm volatile("global_load_dword %0, %1, off sc1" : "=v"(cj[j]) : "v"(&bar[XB_XCNT(j)]) : "memory");
        asm volatile("s_waitcnt vmcnt(0)" : "+v"(cj[0]), "+v"(cj[1]), "+v"(cj[2]), "+v"(cj[3]), "+v"(cj[4]), "+v"(cj[5]), "+v"(cj[6]), "+v"(cj[7]), "+v"(cj[8]), "+v"(cj[9]), "+v"(cj[10]), "+v"(cj[11]), "+v"(cj[12]), "+v"(cj[13]), "+v"(cj[14]), "+v"(cj[15]) :: "memory");
#pragma unroll
        for (unsigned j = 0; j < 16; ++j) { const unsigned c = cj[j]; sum += c; cnt += (c > 0u) ? 1u : 0u; mine = (j == x) ? c : mine; }
        if (sum == G) break;
        __builtin_amdgcn_s_sleep(1);
        if ((++sp & 255u) == 0u) { if (xb_ld(&bar[XB_TMO])) break; if (sp > XB_SPIN_CAP) { atomicAdd(&bar[XB_TMO], 1u); break; } }
    }
    nloc = mine > 0u ? mine : 1u; nx = cnt > 0u ? cnt : 1u;
}

__device__ __forceinline__ void xcd_barrier(const XcdBarrier& b) {
    asm volatile("s_waitcnt vmcnt(0)" ::: "memory");
    __syncthreads();
    if (threadIdx.x == 0) {
        unsigned* bar = b.bar;
        __builtin_amdgcn_s_waitcnt(0);
        unsigned nloc = b.st[0], nx = b.st[1];
        if (nloc == 0u) { xcd_barrier_complete(bar, b.x, nloc, nx); b.st[0] = nloc; b.st[1] = nx; }
        const unsigned old = xb_add(&bar[XB_XSUB(b.x)], 1u);
        const unsigned gen = old / nloc;
        if (old + 1u == (gen + 1u) * nloc) {
            __builtin_amdgcn_fence(__ATOMIC_RELEASE, "agent");
            asm volatile("s_waitcnt vmcnt(0)" ::: "memory");
            const unsigned og = xb_add(&bar[XB_TOP], 1u);
            const unsigned tg = og / nx;
            if (og + 1u == (tg + 1u) * nx) xb_add(&bar[XB_TOPGEN], 1u);
            else XB_SPIN(xb_ld(&bar[XB_TOPGEN]) == tg, bar);
            __builtin_amdgcn_fence(__ATOMIC_ACQUIRE, "agent");
            xb_add(&bar[XB_XGEN(b.x)], 1u);
            asm volatile("s_waitcnt vmcnt(0)" ::: "memory");
        } else {
            XB_SPIN(xb_ld(&bar[XB_XGEN(b.x)]) == gen, bar);
            __builtin_amdgcn_fence(__ATOMIC_ACQUIRE, "agent");
            asm volatile("s_waitcnt vmcnt(0)" ::: "memory");
        }
    }
    __syncthreads();
}


template <class F> struct EpiAdapt {
    static constexpr bool PERM = false, AFTER_DRAIN = false; F f;
    __device__ __forceinline__ void operator()(const pg8::f32x4 (&acc)[2][2][4][2], const pg8::Unit& u, int wr, int wc, int fr, int fq) const {
#pragma unroll
        for (int ai = 0; ai < 2; ++ai)
#pragma unroll
            for (int m = 0; m < 4; ++m) { const int row = u.pm * 256 + ai * 128 + wr * 64 + m * 16 + fr;
                if constexpr (F::PAIR) f(row, u.pn * 128 + wc * 32 + fq * 8, acc[ai][0][m][0], acc[ai][0][m][1], acc[ai][1][m][0], acc[ai][1][m][1]);
                else { f(row, u.pn * 8 + wc, fq, acc[ai][0][m][0], acc[ai][0][m][1], u.ks); f(row, u.pn * 8 + 4 + wc, fq, acc[ai][1][m][0], acc[ai][1][m][1], u.ks); }
                asm volatile("" ::: "memory"); }
    }
};
struct EpiBf16Perm { static constexpr bool PAIR = false; bf16_t* O; int ldo; int pad;
    __device__ __forceinline__ void operator()(int row, int g, int fq, f32x4 v0, f32x4 v1, int) const {
        u32x4 w; w.x = pk2(v0.x, v0.y); w.y = pk2(v0.z, v0.w); w.z = pk2(v1.x, v1.y); w.w = pk2(v1.z, v1.w);
        *(u32x4*)(O + (size_t)row * ldo + 32 * g + 8 * fq) = w; } };
struct EpiBf16Slab { static constexpr bool PAIR = false; bf16_t* O; int ldo; int r0;
    __device__ __forceinline__ void operator()(int row, int g, int fq, f32x4 v0, f32x4 v1, int ks) const {
        u32x4 w; w.x = pk2(v0.x, v0.y); w.y = pk2(v0.z, v0.w); w.z = pk2(v1.x, v1.y); w.w = pk2(v1.z, v1.w);
        *(u32x4*)(O + ((size_t)ks * MD_TROWS + (row - r0)) * ldo + 32 * g + 8 * fq) = w; } };
__device__ __forceinline__ int moe_down_main_tiles(int nM) { const int G = opqs((int)gridDim.x); if (G % 4) return nM; const int nMain = ((nM * 4) / G) * (G / 4), nT = nM - nMain; return (nT > 0 && nT <= MD_TROWS / 256 && nMain > 0) ? nMain : nM; }
struct EpiResid { static constexpr bool PAIR = false; const float* hl_in; const float* hc_in; float* hl_out; float* hc_out; const float* mod; int goff; int split;
    __device__ __forceinline__ void operator()(int row, int g, int fq, f32x4 v0, f32x4 v1, int ks) const {
        const int c0 = 32 * g + 4 * fq; const float* hin; float* hout; const float* gv;
        if (row < TL) { hin = hl_in + (size_t)row * D; hout = hl_out + (size_t)row * D; gv = mod + (row / SEQ) * 6144 + goff; }
        else { hin = hc_in + (size_t)(row - TL) * D; hout = hc_out + (size_t)(row - TL) * D; gv = mod + 2 * 6144 + goff; }
        if (split) { float* po = hout + (size_t)ks * TC * D; *(f32x4*)(po + c0) = *(const f32x4*)(gv + c0) * v0; *(f32x4*)(po + c0 + 16) = *(const f32x4*)(gv + c0 + 16) * v1; return; }
        *(f32x4*)(hout + c0) = *(const f32x4*)(hin + c0) + *(const f32x4*)(gv + c0) * v0;
        *(f32x4*)(hout + c0 + 16) = *(const f32x4*)(hin + c0 + 16) + *(const f32x4*)(gv + c0 + 16) * v1; } };
template <> struct EpiAdapt<EpiResid> {
    static constexpr bool PERM = false, AFTER_DRAIN = false; EpiResid f;
    __device__ __forceinline__ void operator()(const pg8::f32x4 (&acc)[2][2][4][2], const pg8::Unit& u, int wr, int wc, int fr, int fq) const {
        const int row0 = u.pm * 256 + wr * 64 + fr, cb = 32 * (u.pn * 8 + wc) + 4 * fq;
        const bool latent = u.pm * 256 < TL;
        const float* gvp = f.mod + (latent ? (u.pm * 256) / SEQ : 2) * 6144 + f.goff + cb;
        const float* hin = latent ? f.hl_in + (size_t)row0 * D + cb : f.hc_in + (size_t)(row0 - TL) * D + cb;
        float* hout = latent ? f.hl_out + (size_t)row0 * D + cb : f.hc_out + (size_t)(row0 - TL) * D + cb + (f.split ? (size_t)u.ks * TC * D : 0);
        f32x4 gv[2][2];
#pragma unroll
        for (int bj = 0; bj < 2; ++bj)
#pragma unroll
            for (int h = 0; h < 2; ++h) gv[bj][h] = *(const f32x4*)(gvp + 128 * bj + 16 * h);
        if (f.split) {
#pragma unroll
            for (int ai = 0; ai < 2; ++ai)
#pragma unroll
                for (int m = 0; m < 4; ++m)
#pragma unroll
                    for (int bj = 0; bj < 2; ++bj)
#pragma unroll
                        for (int h = 0; h < 2; ++h) *(f32x4*)(hout + (size_t)(128 * ai + 16 * m) * D + 128 * bj + 16 * h) = gv[bj][h] * acc[ai][bj][m][h];
            return;
        }
#pragma unroll
        for (int ai = 0; ai < 2; ++ai)
#pragma unroll
            for (int mp = 0; mp < 4; mp += 2) {
                f32x4 hv[2][2][2];
#pragma unroll
                for (int m = 0; m < 2; ++m)
#pragma unroll
                    for (int bj = 0; bj < 2; ++bj)
#pragma unroll
                        for (int h = 0; h < 2; ++h) hv[m][bj][h] = *(const f32x4*)(hin + (size_t)(128 * ai + 16 * (mp + m)) * D + 128 * bj + 16 * h);
                __builtin_amdgcn_sched_barrier(0);
#pragma unroll
                for (int m = 0; m < 2; ++m)
#pragma unroll
                    for (int bj = 0; bj < 2; ++bj)
#pragma unroll
                        for (int h = 0; h < 2; ++h) *(f32x4*)(hout + (size_t)(128 * ai + 16 * (mp + m)) * D + 128 * bj + 16 * h) = hv[m][bj][h] + gv[bj][h] * acc[ai][bj][mp + m][h];
                __builtin_amdgcn_sched_barrier(0);
            }
    }
};
struct EpiSwiglu { static constexpr bool PAIR = true; bf16_t* H; int ldh; int pad;
    __device__ __forceinline__ void operator()(int row, int col, f32x4 g0, f32x4 u0, f32x4 g1, f32x4 u1) const {
        u32x4 w; w.x = pk2(silu_fast(g0.x) * u0.x, silu_fast(g0.y) * u0.y); w.y = pk2(silu_fast(g0.z) * u0.z, silu_fast(g0.w) * u0.w);
        w.z = pk2(silu_fast(g1.x) * u1.x, silu_fast(g1.y) * u1.y); w.w = pk2(silu_fast(g1.z) * u1.z, silu_fast(g1.w) * u1.w);
        *(u32x4*)(H + (size_t)row * ldh + col) = w; } };
struct EpiSwiglu8 { static constexpr bool PAIR = true; unsigned char* H; int ldh; int pad;
    __device__ __forceinline__ void operator()(int row, int col, f32x4 g0, f32x4 u0, f32x4 g1, f32x4 u1) const {
        u32x2 w; w.x = pk4_fp8(silu_fast(g0.x) * u0.x, silu_fast(g0.y) * u0.y, silu_fast(g0.z) * u0.z, silu_fast(g0.w) * u0.w);
        w.y = pk4_fp8(silu_fast(g1.x) * u1.x, silu_fast(g1.y) * u1.y, silu_fast(g1.z) * u1.z, silu_fast(g1.w) * u1.w);
        *(u32x2*)(H + (size_t)row * ldh + col) = w; } };
template <class F, bool FP8 = false> __device__ __forceinline__ void run_gemm(LAS unsigned char* lds, const bf16_t* A, const bf16_t* Bt, int K, int nM, int nN, const int* texp, size_t estride_bytes, const F& f, int slices = 1, int pm0 = 0) {
    pg8::Gemm g{A, Bt, K, estride_bytes, K / slices}; pg8::StaticOrder S; S.init(nM, nN, opqs((int)gridDim.x), opqs((int)blockIdx.x), texp, slices, pm0);
    EpiAdapt<F> E{f};
    pg8::gemm_phase<EpiAdapt<F>, pg8::StaticOrder, true, true, FP8>(lds, g, S, E);
}
__device__ __forceinline__ bool gemm_tail_idle(int nwg) { const int G = opqs((int)gridDim.x), r = nwg % G; return r != 0 && opqs((int)blockIdx.x) >= r; }

__device__ __forceinline__ float conv_src(const Params& p, int mode, const float* W0, const float* W1, int N, int nvalid, int k, int nb) {
    if (mode == 0) return W0[(size_t)k * N + nb];
    if (mode == 1) { const int col = (nb & ~31) + 8 * ((nb >> 2) & 3) + 4 * ((nb >> 4) & 1) + (nb & 3); return col < nvalid ? W0[(size_t)k * N + col] : 0.f; }
    const int col = 16 * (nb >> 5) + (nb & 15); return ((nb >> 4) & 1) ? W1[(size_t)k * N + col] : W0[(size_t)k * N + col];
}
constexpr int CT_WIN = 0, CT_WOUT = 2304, CT_WUQ = 3328, CT_WUKV = 3400, CT_WFGU = 3464, CT_WFDN = 6280, CT_WMGU = 7688, CT_WMDN = 36360, CT_END = 50696;
constexpr int IT_MODS = 192, IT_ROPE = 9;
__device__ __forceinline__ void conv_item(const Params& p, int it, float* scr, int lane) {
    int t = it;
    bf16_t* dst; const float* W0; const float* W1 = nullptr; int K, N, nvalid = 0, mode; bool f8 = it >= CT_WMGU;
    if (t < CT_WOUT) { const int l = t / 1152; t %= 1152; f8 = FP8_IN1 && l == 1; dst = (bf16_t*)(p.ws + WS_WIN) + (size_t)l * NINP * D; W0 = p.in[8] + (size_t)l * D * NIN; K = D; N = NIN; nvalid = NIN; mode = 1; }
    else if (t < CT_WUQ) { t -= CT_WOUT; const int l = t / 512; t %= 512; f8 = FP8_OUT1 && l == 1; dst = (bf16_t*)(p.ws + WS_WOUT) + (size_t)l * D * D; W0 = p.in[24] + (size_t)l * D * D; K = D; N = D; mode = 0; }
    else if (t < CT_WUKV) { t -= CT_WUQ; const int l = t / 36; t %= 36; dst = (bf16_t*)(p.ws + WS_WUQ) + (size_t)l * 384 * 192; W0 = p.in[18] + (size_t)l * 192 * 384; K = 192; N = 384; mode = 0; }
    else if (t < CT_WFGU) { t -= CT_WUKV; const int l = t / 32; t %= 32; dst = (bf16_t*)(p.ws + WS_WUKV) + (size_t)l * 512 * 128; W0 = p.in[20] + (size_t)l * 128 * 512; K = 128; N = 512; mode = 0; }
    else if (t < CT_WFDN) { t -= CT_WFGU; dst = (bf16_t*)(p.ws + WS_WFGU); W0 = p.in[25]; W1 = p.in[26]; K = D; N = DFF; mode = 2; }
    else if (t < CT_WMGU) { t -= CT_WFDN; dst = (bf16_t*)(p.ws + WS_WFDN); W0 = p.in[27]; K = DFF; N = D; mode = 0; }
    else if (t < CT_WMDN) { t -= CT_WMGU; const int e = t / 3584; t %= 3584; dst = (bf16_t*)(p.ws + WS_WMGU + (size_t)e * 2 * DFFE * D); W0 = p.in[29] + (size_t)e * D * DFFE; W1 = p.in[30] + (size_t)e * D * DFFE; K = D; N = DFFE; mode = 2; }
    else { t -= CT_WMDN; const int e = t / 1792; t %= 1792; dst = (bf16_t*)(p.ws + WS_WMDN + (size_t)e * D * DFFE); W0 = p.in[31] + (size_t)e * DFFE * D; K = DFFE; N = D; nvalid = D; mode = 1; }
    const int ktl = K / 64, n0 = (t / ktl) * 32, k0 = (t % ktl) * 64;
    const int n4 = lane & 7; const float* src; bool valid = true; int ln;
    if (mode == 0) { src = W0 + n0 + 4 * n4; ln = 4 * n4; }
    else if (mode == 1) { const int col = n0 + 4 * n4; valid = col < nvalid; src = W0 + (valid ? col : 0); ln = 16 * (n4 & 1) + 4 * (n4 >> 1); }
    else { src = ((n4 >> 2) ? W1 : W0) + 128 * (n0 >> 8) + 32 * ((n0 >> 5) & 3) + 8 * (n4 & 3) + 4 * ((n0 >> 7) & 1); ln = 16 * (n4 >> 2) + 4 * (n4 & 3); }
    src += (size_t)(k0 + (lane >> 3)) * N;
    f32x4 v[8];
#pragma unroll
    for (int i = 0; i < 8; ++i) v[i] = valid ? *(const f32x4*)(src + (size_t)(8 * i) * N) : (f32x4){0.f, 0.f, 0.f, 0.f};
#pragma unroll
    for (int i = 0; i < 8; ++i) *(f32x4*)(scr + ((lane >> 3) + 8 * i) * 36 + ln) = v[i];
    if (f8) {
        unsigned char* d8 = (unsigned char*)dst; const int c = lane & 3;
#pragma unroll
        for (int j = 0; j < 2; ++j) { const int n = (lane >> 2) + 16 * j; const float* sp = scr + (16 * c) * 36 + n;
            u32x4 o; o.x = pk4_fp8(sp[0 * 36], sp[1 * 36], sp[2 * 36], sp[3 * 36]); o.y = pk4_fp8(sp[4 * 36], sp[5 * 36], sp[6 * 36], sp[7 * 36]);
            o.z = pk4_fp8(sp[8 * 36], sp[9 * 36], sp[10 * 36], sp[11 * 36]); o.w = pk4_fp8(sp[12 * 36], sp[13 * 36], sp[14 * 36], sp[15 * 36]);
            *(u32x4*)(d8 + (size_t)(n0 + n) * K + k0 + 16 * c) = o; }
        return;
    }
    const int c = lane & 7;
#pragma unroll
    for (int j = 0; j < 4; ++j) { const int n = (lane >> 3) + 8 * j; const float* sp = scr + (8 * c) * 36 + n;
        u32x4 o; o.x = pk2(sp[0 * 36], sp[1 * 36]); o.y = pk2(sp[2 * 36], sp[3 * 36]); o.z = pk2(sp[4 * 36], sp[5 * 36]); o.w = pk2(sp[6 * 36], sp[7 * 36]);
        *(u32x4*)(dst + (size_t)(n0 + n) * K + k0 + 8 * c) = o; }
}
constexpr int CW_FILL = 1024;
__device__ __forceinline__ void fill_moe(const Params& p, float* lds, int quota) {
    const int tid = opq((int)threadIdx.x), lane = tid & 63, wv = tid >> 6;
    float* scr = lds + wv * (64 * 36); volatile int* slot = (volatile int*)(lds + 8 * 64 * 36);
    constexpr int NIT = CT_END - CT_WMGU;
    for (;;) {
        const int claim = quota > 64 ? 4 : quota;
        __syncthreads();
        if (tid == 0) *slot = (int)atomicAdd((unsigned*)(p.ws + WS_CTL) + CW_FILL, 8u * (unsigned)claim);
        __syncthreads();
        const int idx = *slot;
        if (idx >= NIT) break;
        const int end = min(idx + 8 * claim, NIT);
        for (int it = idx + wv; it < end; it += 8) conv_item(p, CT_WMGU + it, scr, lane);
        if (quota <= 64) break;
    }
    __syncthreads();
}
__device__ __forceinline__ void ph_prologue(const Params& p, float* lds) {
    const int tid = opq((int)threadIdx.x), lane = tid & 63, wv = tid >> 6;
    for (int it = blockIdx.x; it < IT_MODS + IT_ROPE; it += gridDim.x) {
        if (it < IT_MODS) {
            const int l = it / 96, n0 = (it % 96) * 64, nn = tid & 63, c4 = tid & 15, kc = tid >> 4;
            float* sv = lds; float* red = lds + 3 * 1024;
            __syncthreads();
            for (int i = tid; i < 3 * 1024; i += 512) { const int v = i >> 10, k = i & 1023; const float x = (v < 2) ? p.in[1][v * D + k] : p.in[3][k]; sv[i] = silu_f(x); }
            __syncthreads();
            const float* w = p.in[4] + ((size_t)l * D + kc * 32) * 6144 + n0 + 4 * c4;
            f32x4 a0 = {0.f, 0.f, 0.f, 0.f}, a1 = a0, a2 = a0;
#pragma unroll 1
            for (int kh = 0; kh < 32; kh += 16) {
                f32x4 wv_[16];
#pragma unroll
                for (int k = 0; k < 16; ++k) wv_[k] = *(const f32x4*)(w + (size_t)(kh + k) * 6144);
                __builtin_amdgcn_sched_barrier(0);
#pragma unroll
                for (int k = 0; k < 16; ++k) { a0 += sv[kc * 32 + kh + k] * wv_[k]; a1 += sv[1024 + kc * 32 + kh + k] * wv_[k]; a2 += sv[2048 + kc * 32 + kh + k] * wv_[k]; }
                __builtin_amdgcn_sched_barrier(0);
            }
            *(f32x4*)(red + (kc * 3 + 0) * 64 + 4 * c4) = a0; *(f32x4*)(red + (kc * 3 + 1) * 64 + 4 * c4) = a1; *(f32x4*)(red + (kc * 3 + 2) * 64 + 4 * c4) = a2;
            __syncthreads();
            if (tid < 192) { const int v = tid >> 6; float s = p.in[5][l * 6144 + n0 + nn];
#pragma unroll
                for (int q = 0; q < 32; ++q) s += red[(q * 3 + v) * 64 + nn];
                ((float*)(p.ws + WS_MOD))[((size_t)l * 3 + v) * 6144 + n0 + nn] = s; }
        } else {
            const int idx = (it - IT_MODS) * 512 + tid;
            if (idx < RT_N) {
                int pos, i, nf;
                if (idx < RT_C64) { pos = idx / 16; i = idx % 16; nf = 16; }
                else if (idx < RT_R32) { pos = (idx - RT_C64) / 16; i = idx % 16; nf = 16; }
                else if (idx < RT_C32) { pos = (idx - RT_R32) / 8; i = idx % 8; nf = 8; }
                else { pos = (idx - RT_C32) / 8; i = idx % 8; nf = 8; }
                const float inv = powf(10000.0f, -(float)i / (float)nf);
                const float ang = (float)pos * inv;
                const float rev = ang * 0.15915494309189535f;
                ((float2*)(p.ws + WS_ROPE))[idx] = make_float2(__builtin_amdgcn_cosf(rev), __builtin_amdgcn_sinf(rev));
            }
        }
    }
    if (blockIdx.x == gridDim.x - 1) {
        const int l_ = wv >> 2, mix = wv & 3, n = mix == 3 ? 96 : 64; const float* gk = (mix == 0 ? p.in[10] : mix == 1 ? p.in[13] : mix == 2 ? p.in[15] : p.in[22]) + l_ * n;
        float gm = fabsf(gk[lane]); if (mix == 3 && lane < 32) gm = fmaxf(gm, fabsf(gk[64 + lane]));
        gm = fmaxf(gm, swz_xor<1>(gm)); gm = fmaxf(gm, swz_xor<2>(gm)); gm = fmaxf(gm, swz_xor<4>(gm)); gm = fmaxf(gm, swz_xor<8>(gm)); gm = fmaxf(gm, swz_xor<16>(gm)); gm = half_max(gm);
        if (lane == 0) ((float*)(p.ws + WS_KM2))[wv] = (float)n * gm * gm; }
    __syncthreads();
    for (int i = blockIdx.x * 512 + tid; i < TC * D / 4; i += gridDim.x * 512) ((f32x4*)(p.ws + WS_HCTX))[i] = ((const f32x4*)p.in[2])[i];
    float* scr = lds + wv * (64 * 36);
    for (int it = wv * gridDim.x + blockIdx.x; it < CT_WMGU; it += 8 * gridDim.x) conv_item(p, it, scr, lane);
    __syncthreads();
}

template <int WHICH, bool ROUTER> __device__ __forceinline__ void ph_norm(const Params& p, int layer, int nrows, unsigned* lcnt, int nslab) {
    const int tx = opq((int)threadIdx.x), lane = tx & 63, gw = (blockIdx.x * 512 + tx) >> 6, ngw = (gridDim.x * 512) >> 6;
    if (ROUTER) { if (tx < 16) lcnt[tx] = 0u; __syncthreads(); }
    const float* hl = (layer == 0 && WHICH == 1) ? p.in[0] : p.out;
    const float* hc = (layer == 0 && WHICH == 1) ? p.in[2] : (const float*)(p.ws + WS_HCTX);
    const float* gain = p.in[WHICH == 1 ? 6 : 7] + layer * D;
    const float* mod = (const float*)(p.ws + WS_MOD) + (size_t)layer * 3 * 6144;
    bf16_t* dst = (bf16_t*)(p.ws + WS_ACT1);
    f32x4 rtw[4][4][2];
    if (ROUTER) {
#pragma unroll
        for (int j = 0; j < 4; ++j)
#pragma unroll
            for (int i = 0; i < 4; ++i) { const float* rt = p.in[28] + (size_t)(256 * j + 4 * lane + i) * 8; rtw[j][i][0] = *(const f32x4*)rt; rtw[j][i][1] = *(const f32x4*)(rt + 4); }
    }
    f32x4 ga[4], sb[4]; int cur_var = -1;
    f32x4 v[4];
    if (gw < nrows) { const float* s0 = (gw < TL) ? hl + (size_t)gw * D : hc + (size_t)(gw - TL) * D;
#pragma unroll
        for (int j = 0; j < 4; ++j) v[j] = *(const f32x4*)(s0 + 256 * j + 4 * lane); }
    for (int m = gw; m < nrows; m += ngw) {
        f32x4 vn[4];
        { const int mc = (m + ngw < nrows) ? m + ngw : m; const float* sn = (mc < TL) ? hl + (size_t)mc * D : hc + (size_t)(mc - TL) * D;
#pragma unroll
          for (int j = 0; j < 4; ++j) vn[j] = *(const f32x4*)(sn + 256 * j + 4 * lane); }
        __builtin_amdgcn_sched_barrier(0);
        const int var = m < TL ? m / SEQ : 2;
        if (var != cur_var) { cur_var = var; const float* mv = mod + var * 6144; const float* shp = mv + (WHICH == 1 ? 0 : 3) * D; const float* scp = mv + (WHICH == 1 ? 1 : 4) * D;
#pragma unroll
            for (int j = 0; j < 4; ++j) { const int c = 256 * j + 4 * lane; ga[j] = *(const f32x4*)(gain + c) * (*(const f32x4*)(scp + c) + 1.f); sb[j] = *(const f32x4*)(shp + c); } }
        float ss = 0.f;
        if (!ROUTER && m >= TL && nslab > 0) {
            const float* pp = (const float*)(p.ws + WS_PART) + (size_t)(m - TL) * D + 4 * lane;
            for (int sl0 = 0; sl0 < nslab; sl0 += 4) {
                f32x4 t[4][4];
#pragma unroll
                for (int s4 = 0; s4 < 4; ++s4) { const float* ps = pp + (size_t)min(sl0 + s4, nslab - 1) * TC * D;
#pragma unroll
                    for (int j = 0; j < 4; ++j) t[s4][j] = *(const f32x4*)(ps + 256 * j); }
                __builtin_amdgcn_sched_barrier(0);
#pragma unroll
                for (int s4 = 0; s4 < 4; ++s4) { if (sl0 + s4 < nslab) {
#pragma unroll
                    for (int j = 0; j < 4; ++j) v[j] = v[j] + t[s4][j]; } }
                __builtin_amdgcn_sched_barrier(0);
            }
#pragma unroll
            for (int j = 0; j < 4; ++j) *(f32x4*)((float*)(p.ws + WS_HCTX) + (size_t)(m - TL) * D + 256 * j + 4 * lane) = v[j];
        }
#pragma unroll
        for (int j = 0; j < 4; ++j) ss += v[j].x * v[j].x + v[j].y * v[j].y + v[j].z * v[j].z + v[j].w * v[j].w;
        const float rstd = rsqrtf(wave_sum(ss) * (1.f / D) + EPS);
        float lg[8];
#pragma unroll
        for (int e = 0; e < 8; ++e) lg[e] = 0.f;
#pragma unroll
        for (int j = 0; j < 4; ++j) {
            const int c = 256 * j + 4 * lane;
            f32x4 f = v[j] * rstd * ga[j] + sb[j];
            if (FP8_IN1 && WHICH == 1 && layer == 1) *(unsigned*)((unsigned char*)dst + (size_t)m * D + c) = pk4_fp8(f.x, f.y, f.z, f.w);
            else { u32x2 w; w.x = pk2(f.x, f.y); w.y = pk2(f.z, f.w);
            *(u32x2*)(dst + (size_t)m * D + c) = w; }
            if (ROUTER) {
#pragma unroll
                for (int i = 0; i < 4; ++i) { const f32x4 r0 = rtw[j][i][0], r1 = rtw[j][i][1]; const float fv = f[i];
                    lg[0] += fv * r0.x; lg[1] += fv * r0.y; lg[2] += fv * r0.z; lg[3] += fv * r0.w; lg[4] += fv * r1.x; lg[5] += fv * r1.y; lg[6] += fv * r1.z; lg[7] += fv * r1.w; }
            }
        }
        if (ROUTER) {
#pragma unroll
            for (int e = 0; e < 8; ++e) lg[e] = wave_sum(lg[e]);
            if (lane == 0) {
                int e0 = 0; float v0 = lg[0];
#pragma unroll
                for (int e = 1; e < 8; ++e) if (lg[e] > v0) { v0 = lg[e]; e0 = e; }
                int e1 = -1; float v1 = -INFINITY;
#pragma unroll
                for (int e = 0; e < 8; ++e) if (e != e0 && lg[e] > v1) { v1 = lg[e]; e1 = e; }
                const float t = expf(v1 - v0), g0 = 1.f / (1.f + t), g1 = t / (1.f + t);
                const int p0 = (int)atomicAdd(&lcnt[e0], 1u), p1 = (int)atomicAdd(&lcnt[e1], 1u);
                ((int2*)(p.ws + WS_TOKE))[m] = make_int2(e0, e1); ((int2*)(p.ws + WS_TOKP))[m] = make_int2(p0, p1); ((float2*)(p.ws + WS_TOKG))[m] = make_float2(g0, g1);
            }
        }
#pragma unroll
        for (int j = 0; j < 4; ++j) v[j] = vn[j];
    }
    if (ROUTER) {
        __syncthreads();
        if (tx < 8) lcnt[8 + tx] = atomicAdd((unsigned*)(p.ws + WS_CTL) + 64 * tx, lcnt[tx]);
        __syncthreads();
        if (lane == 0) for (int m = gw; m < nrows; m += ngw) {
            const int2 e = ((const int2*)(p.ws + WS_TOKE))[m]; int2 ps = ((const int2*)(p.ws + WS_TOKP))[m];
            ps.x += (int)lcnt[8 + e.x]; ps.y += (int)lcnt[8 + e.y]; ((int2*)(p.ws + WS_TOKP))[m] = ps; }
        __syncthreads();
    }
}


typedef short pp_bf16x8 __attribute__((ext_vector_type(8)));
__device__ __forceinline__ float quad_sum(float v) { v += swz_xor<1>(v); v += swz_xor<2>(v); return v; }
__device__ __forceinline__ float kg_sum(float v) { v += swz_xor<16>(v); return half_sum(v); }
constexpr float QS64 = 0.125f * 1.4426950408889634f, QS96 = 0.10206207261596575f * 1.4426950408889634f;

template <int HS> struct PPH {
    static constexpr bool ISV = HS >= 20;
    static constexpr int col = HS < 4 ? OFF_AQ + 64 * HS : HS < 6 ? OFF_AK + 64 * (HS - 4) : HS < 10 ? OFF_BQ + 64 * (HS - 6) : HS < 12 ? OFF_BK + 64 * (HS - 10) : HS < 16 ? OFF_CQ + 64 * (HS - 12) :
                               HS < 20 ? OFF_CK + 64 * (HS - 16) : HS < 22 ? OFF_AV + 64 * (HS - 20) : HS < 24 ? OFF_BV + 64 * (HS - 22) : OFF_CV + 64 * (HS - 24);
    static constexpr bool ISQ = HS < 4 || (HS >= 6 && HS < 10) || (HS >= 12 && HS < 16);
    static constexpr bool ROPE = HS < 12;
    static constexpr int GIN = HS < 4 ? 9 : HS < 6 ? 10 : HS < 10 ? 12 : HS < 12 ? 13 : HS < 16 ? 14 : 15;
};
template <int HS> __device__ __forceinline__ void pp_loadw(const bf16_t* prow, int sub, u32x2 (&w)[4]) {
#pragma unroll
    for (int c = 0; c < 4; ++c) w[c] = *(const u32x2*)(prow + PPH<HS>::col + 16 * c + 4 * sub);
}
template <int HS> __device__ __forceinline__ void pp_loadg(const Params& p, int layer, int sub, f32x4 (&gv)[4]) {
    if constexpr (!PPH<HS>::ISV) { const float* g = p.in[PPH<HS>::GIN] + layer * 64 + 4 * sub;
#pragma unroll
        for (int c = 0; c < 4; ++c) gv[c] = *(const f32x4*)(g + 16 * c); }
}
template <int HS> __device__ __forceinline__ void pp_compute(const QKVB& qb, bool lat, int b, int s, int key, int sub, const float2 (&rr)[4], const float2 (&rc)[4], u32x2 (&w)[4], const f32x4 (&gv)[4]) {
    constexpr bool ISV = PPH<HS>::ISV, ISQ = PPH<HS>::ISQ, ROPE = PPH<HS>::ROPE;
    bf16_t* dst;
    if (HS < 4) dst = lat ? qb.QA + ((size_t)(b * 4 + HS) * SEQ + s) * 64 : qb.QAc + ((size_t)(b * 4 + HS) * CTX + s) * 64;
    else if (HS < 6) dst = qb.KA + ((size_t)(b * 2 + HS - 4) * KEYS + key) * 64;
    else if (HS < 10) dst = lat ? qb.QB + ((size_t)(b * 4 + HS - 6) * SEQ + s) * 64 : qb.QBc + ((size_t)(b * 4 + HS - 6) * CTX + s) * 64;
    else if (HS < 12) dst = qb.KB + ((size_t)(b * 2 + HS - 10) * KEYS + key) * 64;
    else if (HS < 16) dst = lat ? qb.QC + ((size_t)(b * 4 + HS - 12) * SEQ + s) * 64 : qb.QCc + ((size_t)(b * 4 + HS - 12) * CTX + s) * 64;
    else if (HS < 20) dst = qb.KC + ((size_t)(b * 4 + HS - 16) * KEYS + key) * 64;
    else if (HS < 22) dst = qb.VA + ((size_t)(b * 2 + HS - 20) * KEYS + key) * 64;
    else if (HS < 24) dst = qb.VB + ((size_t)(b * 2 + HS - 22) * KEYS + key) * 64;
    else dst = qb.VC + ((size_t)(b * 4 + HS - 24) * KEYS + key) * 64;
    if (!ISV) {
        f32x4 x[4]; float ss = 0.f;
#pragma unroll
        for (int c = 0; c < 4; ++c) { x[c] = (f32x4){bflo(w[c].x), bfhi(w[c].x), bflo(w[c].y), bfhi(w[c].y)}; ss += x[c].x * x[c].x + x[c].y * x[c].y + x[c].z * x[c].z + x[c].w * x[c].w; }
        const float r = rsqrtf(quad_sum(ss) * (1.f / 64.f) + EPS) * (ISQ ? QS64 : 1.f);
#pragma unroll
        for (int c = 0; c < 4; ++c) x[c] = x[c] * r * gv[c];
        if (ROPE && lat) {
#pragma unroll
            for (int i = 0; i < 4; ++i) { const float a = x[0][i], bq = x[1][i]; x[0][i] = a * rr[i].x - bq * rr[i].y; x[1][i] = bq * rr[i].x + a * rr[i].y;
                const float c1 = x[2][i], c2 = x[3][i]; x[2][i] = c1 * rc[i].x - c2 * rc[i].y; x[3][i] = c2 * rc[i].x + c1 * rc[i].y; }
        }
#pragma unroll
        for (int c = 0; c < 4; ++c) { w[c].x = pk2(x[c].x, x[c].y); w[c].y = pk2(x[c].z, x[c].w); }
    }
#pragma unroll
    for (int c = 0; c < 4; ++c) *(u32x2*)(dst + 16 * c + 4 * sub) = w[c];
}
template <int G, int GE> struct PPGrp { static __device__ __forceinline__ void run(const Params& p, const QKVB& qb, int layer, const bf16_t* prow, bool lat, int b, int s, int key, int sub, const float2 (&rr)[4], const float2 (&rc)[4], u32x2 (&wc)[4][4]) {
    u32x2 wn[4][4]; f32x4 gv[4][4];
    if constexpr (G + 1 < GE) { pp_loadw<4 * G + 4>(prow, sub, wn[0]); pp_loadw<4 * G + 5>(prow, sub, wn[1]); pp_loadw<4 * G + 6>(prow, sub, wn[2]); pp_loadw<4 * G + 7>(prow, sub, wn[3]); }
    pp_loadg<4 * G>(p, layer, sub, gv[0]); pp_loadg<4 * G + 1>(p, layer, sub, gv[1]); pp_loadg<4 * G + 2>(p, layer, sub, gv[2]); pp_loadg<4 * G + 3>(p, layer, sub, gv[3]);
    __builtin_amdgcn_sched_barrier(0);
    pp_compute<4 * G>(qb, lat, b, s, key, sub, rr, rc, wc[0], gv[0]); pp_compute<4 * G + 1>(qb, lat, b, s, key, sub, rr, rc, wc[1], gv[1]);
    pp_compute<4 * G + 2>(qb, lat, b, s, key, sub, rr, rc, wc[2], gv[2]); pp_compute<4 * G + 3>(qb, lat, b, s, key, sub, rr, rc, wc[3], gv[3]);
    __builtin_amdgcn_sched_barrier(0);
    if constexpr (G + 1 < GE) PPGrp<G + 1, GE>::run(p, qb, layer, prow, lat, b, s, key, sub, rr, rc, wn);
} };

__device__ __forceinline__ void f8_from_bf(const u32x4 v, float (&x)[8]) { x[0] = bflo(v.x); x[1] = bfhi(v.x); x[2] = bflo(v.y); x[3] = bfhi(v.y); x[4] = bflo(v.z); x[5] = bfhi(v.z); x[6] = bflo(v.w); x[7] = bfhi(v.w); }

__device__ __forceinline__ void ph_postproj2(const Params& p, int layer, LAS unsigned char* lds) {
    const int tx = opq((int)threadIdx.x), lane = tx & 63, wv = tx >> 6, G = opqs((int)gridDim.x), bk = opqs((int)blockIdx.x), ngw = G * 8;
    const bf16_t* P = (const bf16_t*)(p.ws + WS_P);
    const QKVB qb = make_qkv(p.ws);
    const bf16_t* Wuq = (const bf16_t*)(p.ws + WS_WUQ) + (size_t)layer * 384 * 192;
    const bf16_t* Wukv = (const bf16_t*)(p.ws + WS_WUKV) + (size_t)layer * 512 * 128;
    const float2* rope = (const float2*)(p.ws + WS_ROPE);
    constexpr int NU = MALL / 16, PQ = 200, PK = 136;
    const int nk = (G / 4) * 4, nb4 = nk / 4, km = 1 + (bk & 3), stride = nb4 * 8, ustart = (bk >> 2) * 8 + wv;
    const int nml = (bk < nk && ustart < NU) ? (NU - ustart + stride - 1) / stride : 0;
    const int k0 = ngw - 1 - (bk * 8 + wv);
    const LAS bf16_t* wl = (const LAS bf16_t*)lds;
    if (bk < nk) {
        LAS bf16_t* wst = (LAS bf16_t*)lds;
        if (km <= 2) { const bf16_t* src = Wuq + (size_t)192 * (km - 1) * 192; u32x4 t[9];
#pragma unroll
            for (int i = 0; i < 9; ++i) t[i] = *(const u32x4*)(src + (size_t)(tx + 512 * i) * 8);
            __builtin_amdgcn_sched_barrier(0);
#pragma unroll
            for (int i = 0; i < 9; ++i) { const int ch = tx + 512 * i; *(LAS u32x4*)(wst + (ch / 24) * PQ + (ch % 24) * 8) = t[i]; } }
        else { const bf16_t* src = Wukv + (size_t)256 * (km - 3) * 128; u32x4 t[8];
#pragma unroll
            for (int i = 0; i < 8; ++i) t[i] = *(const u32x4*)(src + (size_t)(tx + 512 * i) * 8);
            __builtin_amdgcn_sched_barrier(0);
#pragma unroll
            for (int i = 0; i < 8; ++i) { const int ch = tx + 512 * i; *(LAS u32x4*)(wst + (ch >> 4) * PK + (ch & 15) * 8) = t[i]; } }
    }
    __syncthreads();
    for (int it = 0; ; ++it) {
        int kind, u;
        int half = 0;
        if (it < nml) { kind = km; u = ustart + it * stride; } else { u = k0 + (it - nml) * ngw; if (u >= 2 * NU) break; kind = 0; half = u >= NU; u -= half * NU; }
        half = __builtin_amdgcn_readfirstlane(half);
        kind = __builtin_amdgcn_readfirstlane(kind);
        const int m0 = u * 16; const bool lat = m0 < TL;
        if (kind == 0) {
            const int t = lane >> 2, sub = lane & 3, m = m0 + t;
            const int b = lat ? m / SEQ : (m - TL) / CTX, s = lat ? m % SEQ : (m - TL) % CTX, key = lat ? CTX + s : s;
            const bf16_t* prow = P + (size_t)m * NINP;
            if (half) { float2 rr[4], rc[4];
#pragma unroll
                for (int i = 0; i < 4; ++i) { rr[i] = make_float2(1.f, 0.f); rc[i] = rr[i]; }
                u32x2 w0[4][4]; pp_loadw<16>(prow, sub, w0[0]); pp_loadw<17>(prow, sub, w0[1]); pp_loadw<18>(prow, sub, w0[2]); pp_loadw<19>(prow, sub, w0[3]);
                PPGrp<4, 7>::run(p, qb, layer, prow, lat, b, s, key, sub, rr, rc, w0); continue; }
            u32x2 w0[4][4]; pp_loadw<0>(prow, sub, w0[0]); pp_loadw<1>(prow, sub, w0[1]); pp_loadw<2>(prow, sub, w0[2]); pp_loadw<3>(prow, sub, w0[3]);
            float2 rr[4], rc[4];
#pragma unroll
            for (int i = 0; i < 4; ++i) { rr[i] = rope[RT_R64 + (s >> 6) * 16 + 4 * sub + i]; rc[i] = rope[RT_C64 + (s & 63) * 16 + 4 * sub + i]; }
#pragma unroll
            for (int i = 0; i < 4; ++i) asm volatile("" : "+v"(rr[i].x), "+v"(rr[i].y), "+v"(rc[i].x), "+v"(rc[i].y));
            PPGrp<0, 4>::run(p, qb, layer, prow, lat, b, s, key, sub, rr, rc, w0);
        }
        else {
            const int tk = lane & 15, kg = lane >> 4, m = m0 + tk;
            const int b = lat ? m / SEQ : (m - TL) / CTX, s = lat ? m % SEQ : (m - TL) % CTX, key = lat ? CTX + s : s;
            const bf16_t* prow = P + (size_t)m * NINP;
            if (kind <= 2) {
            pp_bf16x8 aq[6];
            { float x[6][8]; float ss = 0.f;
#pragma unroll
                for (int ks = 0; ks < 6; ++ks) { f8_from_bf(*(const u32x4*)(prow + OFF_DCQ + 32 * ks + 8 * kg), x[ks]);
#pragma unroll
                    for (int j = 0; j < 8; ++j) ss += x[ks][j] * x[ks][j]; }
                const float r = rsqrtf(kg_sum(ss) * (1.f / 192.f) + EPS);
                const float* g = p.in[17] + layer * 192 + 8 * kg;
#pragma unroll
                for (int ks = 0; ks < 6; ++ks) { const f32x4 g0 = *(const f32x4*)(g + 32 * ks), g1 = *(const f32x4*)(g + 32 * ks + 4);
                    u32x4 w; w.x = pk2(x[ks][0] * r * g0.x, x[ks][1] * r * g0.y); w.y = pk2(x[ks][2] * r * g0.z, x[ks][3] * r * g0.w); w.z = pk2(x[ks][4] * r * g1.x, x[ks][5] * r * g1.y); w.w = pk2(x[ks][6] * r * g1.z, x[ks][7] * r * g1.w);
                    aq[ks] = __builtin_bit_cast(pp_bf16x8, w); } }
            float2 qr_[4], qc_[4];
#pragma unroll
            for (int reg = 0; reg < 4; ++reg) { const int i = (4 * kg + reg) & 7; qr_[reg] = rope[RT_R32 + (s >> 6) * 8 + i]; qc_[reg] = rope[RT_C32 + (s & 63) * 8 + i]; }
            f32x4 gq[6];
            { const float* g = p.in[21] + layer * 96 + 4 * kg;
#pragma unroll
              for (int nb = 0; nb < 6; ++nb) gq[nb] = *(const f32x4*)(g + 16 * nb); }
#pragma unroll
            for (int reg = 0; reg < 4; ++reg) asm volatile("" : "+v"(qr_[reg].x), "+v"(qr_[reg].y), "+v"(qc_[reg].x), "+v"(qc_[reg].y));
#pragma unroll 1
            for (int h = 2 * (kind - 1); h < 2 * kind; ++h) {
                f32x4 acc[6];
#pragma unroll
                for (int nb0 = 0; nb0 < 6; nb0 += 3) {
                    pp_bf16x8 wf[3][6];
#pragma unroll
                    for (int i = 0; i < 3; ++i) { const LAS bf16_t* wp = wl + (96 * (h & 1) + 16 * (nb0 + i) + tk) * PQ + 8 * kg;
#pragma unroll
                        for (int ks = 0; ks < 6; ++ks) wf[i][ks] = *(const LAS pp_bf16x8*)(wp + 32 * ks); }
                    __builtin_amdgcn_sched_barrier(0);
#pragma unroll
                    for (int i = 0; i < 3; ++i) { acc[nb0 + i] = (f32x4){0.f, 0.f, 0.f, 0.f};
#pragma unroll
                        for (int ks = 0; ks < 6; ++ks) acc[nb0 + i] = __builtin_amdgcn_mfma_f32_16x16x32_bf16(wf[i][ks], aq[ks], acc[nb0 + i], 0, 0, 0); }
                    __builtin_amdgcn_sched_barrier(0);
                }
                float ss = 0.f;
#pragma unroll
                for (int nb = 0; nb < 6; ++nb) ss += acc[nb].x * acc[nb].x + acc[nb].y * acc[nb].y + acc[nb].z * acc[nb].z + acc[nb].w * acc[nb].w;
                const float r = rsqrtf(kg_sum(ss) * (1.f / 96.f) + EPS) * QS96;
                bf16_t* dst = (lat ? qb.QD + ((size_t)(b * 4 + h) * SEQ + s) * 96 : qb.QDc + ((size_t)(b * 4 + h) * CTX + s) * 96) + 4 * kg;
#pragma unroll
                for (int nb = 0; nb < 6; ++nb) { f32x4 y = acc[nb] * r * gq[nb];
                    if (nb >= 4 && lat) {
#pragma unroll
                        for (int reg = 0; reg < 4; ++reg) { const float other = half_other(y[reg], lane); const float2 cs = nb == 4 ? qr_[reg] : qc_[reg];
                            y[reg] = (kg < 2) ? y[reg] * cs.x - other * cs.y : y[reg] * cs.x + other * cs.y; } }
                    u32x2 w; w.x = pk2(y.x, y.y); w.y = pk2(y.z, y.w); *(u32x2*)(dst + 16 * nb) = w; }
            }
            } else {
            pp_bf16x8 akv[4];
            { float x[4][8]; float ss = 0.f;
#pragma unroll
                for (int ks = 0; ks < 4; ++ks) { f8_from_bf(*(const u32x4*)(prow + OFF_DCKV + 32 * ks + 8 * kg), x[ks]);
#pragma unroll
                    for (int j = 0; j < 8; ++j) ss += x[ks][j] * x[ks][j]; }
                const float r = rsqrtf(kg_sum(ss) * (1.f / 128.f) + EPS);
                const float* g = p.in[19] + layer * 128 + 8 * kg;
#pragma unroll
                for (int ks = 0; ks < 4; ++ks) { const f32x4 g0 = *(const f32x4*)(g + 32 * ks), g1 = *(const f32x4*)(g + 32 * ks + 4);
                    u32x4 w; w.x = pk2(x[ks][0] * r * g0.x, x[ks][1] * r * g0.y); w.y = pk2(x[ks][2] * r * g0.z, x[ks][3] * r * g0.w); w.z = pk2(x[ks][4] * r * g1.x, x[ks][5] * r * g1.y); w.w = pk2(x[ks][6] * r * g1.z, x[ks][7] * r * g1.w);
                    akv[ks] = __builtin_bit_cast(pp_bf16x8, w); } }
            float kr[8]; f8_from_bf(*(const u32x4*)(prow + OFF_DKR + 8 * kg), kr);
            float krss = 0.f;
#pragma unroll
            for (int j = 0; j < 8; ++j) krss += kr[j] * kr[j];
            float2 kcs[8];
#pragma unroll
            for (int j = 0; j < 8; ++j) kcs[j] = rope[kg < 2 ? RT_R32 + (s >> 6) * 8 + j : RT_C32 + (s & 63) * 8 + j];
#pragma unroll
            for (int j = 0; j < 8; ++j) { asm volatile("" : "+v"(kcs[j].x), "+v"(kcs[j].y)); if (!lat) kcs[j] = make_float2(1.f, 0.f); }
            f32x4 gk[4], gr2[2];
            { const float* g = p.in[22] + layer * 96;
#pragma unroll
              for (int nb = 0; nb < 4; ++nb) gk[nb] = *(const f32x4*)(g + 16 * nb + 4 * kg);
              gr2[0] = *(const f32x4*)(g + 64 + 8 * kg); gr2[1] = *(const f32x4*)(g + 64 + 8 * kg + 4); }
#pragma unroll
            for (int j = 0; j < 8; ++j) asm volatile("" : "+v"(kcs[j].x), "+v"(kcs[j].y));
#pragma unroll 1
            for (int h = 2 * (kind - 3); h < 2 * (kind - 2); ++h) {
                f32x4 acc[8];
#pragma unroll
                for (int nb0 = 0; nb0 < 8; nb0 += 4) {
                    pp_bf16x8 wf[4][4];
#pragma unroll
                    for (int i = 0; i < 4; ++i) { const LAS bf16_t* wp = wl + (128 * (h & 1) + 16 * (nb0 + i) + tk) * PK + 8 * kg;
#pragma unroll
                        for (int ks = 0; ks < 4; ++ks) wf[i][ks] = *(const LAS pp_bf16x8*)(wp + 32 * ks); }
                    __builtin_amdgcn_sched_barrier(0);
#pragma unroll
                    for (int i = 0; i < 4; ++i) { acc[nb0 + i] = (f32x4){0.f, 0.f, 0.f, 0.f};
#pragma unroll
                        for (int ks = 0; ks < 4; ++ks) acc[nb0 + i] = __builtin_amdgcn_mfma_f32_16x16x32_bf16(wf[i][ks], akv[ks], acc[nb0 + i], 0, 0, 0); }
                    __builtin_amdgcn_sched_barrier(0);
                }
                float ss = krss;
#pragma unroll
                for (int nb = 0; nb < 4; ++nb) ss += acc[nb].x * acc[nb].x + acc[nb].y * acc[nb].y + acc[nb].z * acc[nb].z + acc[nb].w * acc[nb].w;
                const float r = rsqrtf(kg_sum(ss) * (1.f / 96.f) + EPS);
                bf16_t* kd = qb.KD + ((size_t)(b * 4 + h) * KEYS + key) * 96; bf16_t* vd = qb.VD + ((size_t)(b * 4 + h) * KEYS + key) * 64;
#pragma unroll
                for (int nb = 0; nb < 4; ++nb) { const f32x4 y = acc[nb] * r * gk[nb]; u32x2 w; w.x = pk2(y.x, y.y); w.y = pk2(y.z, y.w); *(u32x2*)(kd + 16 * nb + 4 * kg) = w; }
                { float y[8];
#pragma unroll
                    for (int j = 0; j < 8; ++j) y[j] = kr[j] * r * gr2[j >> 2][j & 3];
#pragma unroll
                    for (int j = 0; j < 8; ++j) { const float other = swz_xor<16>(y[j]); y[j] = (kg & 1) == 0 ? y[j] * kcs[j].x - other * kcs[j].y : y[j] * kcs[j].x + other * kcs[j].y; }
                    u32x4 w; w.x = pk2(y[0], y[1]); w.y = pk2(y[2], y[3]); w.z = pk2(y[4], y[5]); w.w = pk2(y[6], y[7]); *(u32x4*)(kd + 64 + 8 * kg) = w; }
#pragma unroll
                for (int nb = 4; nb < 8; ++nb) { const f32x4 y = acc[nb]; u32x2 w; w.x = pk2(y.x, y.y); w.y = pk2(y.z, y.w); *(u32x2*)(vd + 16 * (nb - 4) + 4 * kg) = w; }
            }
            }
        }
    }
}

namespace fa {
typedef short bf16x8 __attribute__((ext_vector_type(8)));
typedef short s16x4 __attribute__((ext_vector_type(4)));
typedef float f32x16 __attribute__((ext_vector_type(16)));
typedef __attribute__((address_space(3))) const char* lds_cptr;
typedef short v4i16_t __attribute__((ext_vector_type(4)));
constexpr int KSTG = 12288, VSTG = 8192, STG = KSTG + VSTG;
constexpr int LDS_WS = 2 * STG, LDS_OST = LDS_WS + 8 * 256, LDS_RPB = LDS_OST + 8 * 4096, LDS_TOTAL = LDS_RPB + 2048;
constexpr float LOG2E = 1.4426950408889634f;
constexpr float THR = 6.0f;
__device__ __forceinline__ int crow(int r, int hi) { return (r & 3) + 8 * (r >> 2) + 4 * hi; }
__device__ __forceinline__ void glds16(const void* gsrc, unsigned lds_dst) { unsigned keep;
    asm volatile("s_mov_b32 %0, m0\n\ts_mov_b32 m0, %2\n\ts_nop 0\n\tglobal_load_lds_dwordx4 %1, off\n\ts_mov_b32 m0, %0" : "=&s"(keep) : "v"(gsrc), "s"(lds_dst) : "memory"); }
__device__ __forceinline__ s16x4 vtr(lds_cptr p) { return __builtin_bit_cast(s16x4, __builtin_amdgcn_ds_read_tr16_b64_v4i16((__attribute__((address_space(3))) v4i16_t*)p)); }
typedef float f32x2_t __attribute__((ext_vector_type(2))); typedef __bf16 bf16x2_t __attribute__((ext_vector_type(2)));
__device__ __forceinline__ unsigned cvtpk(float lo, float hi) { f32x2_t v = {lo, hi}; bf16x2_t b = __builtin_convertvector(v, bf16x2_t); return __builtin_bit_cast(unsigned, b); }
__device__ __forceinline__ float xhalf_max(float m) { auto rr = __builtin_amdgcn_permlane32_swap(__float_as_uint(m), __float_as_uint(m), false, false); return fmaxf(__uint_as_float(rr[0]), __uint_as_float(rr[1])); }
__device__ __forceinline__ float xhalf_sum(float m) { auto rr = __builtin_amdgcn_permlane32_swap(__float_as_uint(m), __float_as_uint(m), false, false); return __uint_as_float(rr[0]) + __uint_as_float(rr[1]); }
#define FA_WAIT_BAR() asm volatile("s_waitcnt vmcnt(0) lgkmcnt(0)\n\ts_barrier" ::: "memory")

#undef FA_WAIT_BAR
}


namespace fa2 {
using fa::bf16x8; using fa::s16x4; using fa::f32x16; using fa::lds_cptr; using fa::crow; using fa::glds16; using fa::vtr; using fa::cvtpk; using fa::LOG2E;
constexpr int KSL = 12288, VSL = 8192, VBASE = 4 * KSL, LDS_WS = VBASE + 3 * VSL, LDS_OST = LDS_WS + 8 * 256, LDS_RPB = LDS_OST + 8 * 4096, LDS_TOTAL = LDS_RPB + 2048;
static_assert(LDS_TOTAL <= 131072, "attention LDS");
#define SBAR() __builtin_amdgcn_sched_barrier(0)
#define PIN(x) asm volatile("" : "+v"(x))
template <int DQK, int MODE, int THRL>
__device__ __forceinline__ void attn_unit(const bf16_t* Qg, const bf16_t* Kg, const bf16_t* Vg, bf16_t* Og, int q0, float sink2, const float* rpb, char* shm, float kmax2) {
    const int tid = opq((int)threadIdx.x), lane = tid & 63, r32 = lane & 31, hi = lane >> 5; const int wid = __builtin_amdgcn_readfirstlane(tid >> 6);
    const unsigned lds0 = (unsigned)(uintptr_t)shm;
    float* wsf = (float*)(shm + LDS_WS) + wid * 64;
    constexpr int NCH = DQK / 8, ND0 = DQK / 16;
    int NT, wbase = 0;
    if (MODE == 0) NT = KEYS / 64; else if (MODE == 3) NT = 4;
    else if (MODE == 1) { wbase = max(0, q0 - 128); const int we = min(SEQ, q0 + 256 + 128); NT = 4 + (we - wbase) / 64; }
    else { const int r0 = q0 >> 6; wbase = min(max(r0 - 4, 0), 120); const int kre = min(max(r0 - 1, 0), 120) + 8; NT = 4 + (kre - wbase); }
#define FA_KEY0(t) ((MODE == 0 || MODE == 3 || (t) < 4) ? 64 * (t) : (MODE == 1 ? CTX + wbase + 64 * ((t) - 4) : CTX + (wbase + (t) - 4) * 64))
    const bf16_t* ksrc = Kg + (size_t)lane * DQK; const bf16_t* vsrc = Vg + (size_t)(16 * (wid & 3) + (lane >> 2)) * 64 + (wid >> 2) * 32 + (lane & 3) * 8;
#define DMA_K(t, slotoff) do { const int tt_ = (t) < NT ? (t) : NT - 1; const int k0_ = FA_KEY0(tt_); \
        glds16(ksrc + (size_t)k0_ * DQK + wid * 8, (unsigned)__builtin_amdgcn_readfirstlane(lds0 + (slotoff) + wid * 1024)); \
        if (NCH > 8) { if (wid < NCH - 8) glds16(ksrc + (size_t)k0_ * DQK + (wid + 8) * 8, (unsigned)__builtin_amdgcn_readfirstlane(lds0 + (slotoff) + (wid + 8) * 1024)); } } while (0)
#define DMA_V(t, slotoff) do { const int tt_ = (t) < NT ? (t) : NT - 1; const int k0_ = FA_KEY0(tt_); \
        glds16(vsrc + (size_t)k0_ * 64, (unsigned)__builtin_amdgcn_readfirstlane(lds0 + VBASE + (slotoff) + wid * 1024)); } while (0)
#define WAIT_STEP() do { if (NCH > 8 && wid < NCH - 8) asm volatile("s_waitcnt vmcnt(3) lgkmcnt(0)\n\ts_barrier" ::: "memory"); else asm volatile("s_waitcnt vmcnt(2) lgkmcnt(0)\n\ts_barrier" ::: "memory"); } while (0)
    DMA_K(0, 0); DMA_V(0, 0); DMA_K(1, KSL); DMA_K(2, 2 * KSL);
    if (MODE == 2) { float* rp = (float*)(shm + LDS_RPB); unsigned* bm = (unsigned*)(shm + LDS_RPB) + 480; if (tid == 0) *bm = 0u;
        __syncthreads();
        for (int i = tid; i < 15 * 31; i += 512) { const float v = rpb[i] * LOG2E; rp[i] = v; atomicMax(bm, __float_as_uint(fabsf(v))); } }
    bf16x8 qr[ND0];
#pragma unroll
    for (int d0 = 0; d0 < ND0; ++d0) qr[d0] = *reinterpret_cast<const bf16x8*>(Qg + (size_t)(wid * 32 + r32) * DQK + d0 * 16 + hi * 8);
    float q2 = 0.f;
#pragma unroll
    for (int d0 = 0; d0 < ND0; ++d0) {
#pragma unroll
        for (int j = 0; j < 8; ++j) { const float qv = __uint_as_float(((unsigned)(unsigned short)qr[d0][j]) << 16); q2 += qv * qv; } }
    q2 = fa::xhalf_sum(q2);
    float l_reg = 0.f; f32x16 o[2]; f32x16 negm;
#pragma unroll
    for (int r = 0; r < 16; ++r) { o[0][r] = 0.f; o[1][r] = 0.f; }
    const int qpos = q0 + wid * 32 + r32;
    const int rq = (q0 >> 6) + (wid >> 1), jq = 32 * (wid & 1) + r32;
    const int rs = min(max(rq - 4, 0), 120), cs = min(max(jq - 8, 0), 48);
    const lds_cptr shm3 = (lds_cptr)shm;
    const lds_cptr kp0 = shm3 + hi * 1024 + r32 * 16;
    const lds_cptr vp0 = shm3 + VBASE + ((lane >> 4) & 1) * 32 + (lane & 3) * 8 + (4 * hi + ((lane & 15) >> 2)) * 64;
#define MASK(C0, C1, t) do { \
        if (MODE == 1 && (t) >= 4) { const int kp0_ = wbase + 64 * ((t) - 4) - qpos; \
            _Pragma("unroll") for (int r = 0; r < 16; ++r) { const int d0_ = kp0_ + crow(r, hi), d1_ = d0_ + 32; if (d0_ < -128 || d0_ > 128) C0[r] = -INFINITY; if (d1_ < -128 || d1_ > 128) C1[r] = -INFINITY; } } \
        if (MODE == 2 && (t) >= 4) { const int kr_ = wbase + (t) - 4; const bool rowok_ = (kr_ >= rs) && (kr_ < rs + 8); const int ro_ = min(max(kr_ - rq + 7, 0), 14); \
            const float* rp_ = (const float*)(shm + LDS_RPB) + ro_ * 31 + 15 - jq; \
            _Pragma("unroll") for (int r = 0; r < 16; ++r) { const int kc0 = crow(r, hi), kc1 = kc0 + 32; \
                const bool v0 = rowok_ && (kc0 >= cs) && (kc0 < cs + 16), v1 = rowok_ && (kc1 >= cs) && (kc1 < cs + 16); \
                C0[r] = v0 ? C0[r] + rp_[v0 ? kc0 : jq] : -INFINITY; C1[r] = v1 ? C1[r] + rp_[v1 ? kc1 : jq] : -INFINITY; } } } while (0)
#define ROWMAX(C0, C1, rm) do { float a_ = fmaxf(fmaxf(C0[0], C0[1]), C1[0]), b_ = fmaxf(fmaxf(C0[2], C0[3]), C1[1]); a_ = fmaxf(fmaxf(a_, C1[2]), C1[3]); \
        _Pragma("unroll") for (int r = 4; r < 16; r += 4) { a_ = fmaxf(fmaxf(a_, C0[r]), C0[r + 1]); b_ = fmaxf(fmaxf(b_, C0[r + 2]), C0[r + 3]); a_ = fmaxf(fmaxf(a_, C1[r]), C1[r + 1]); b_ = fmaxf(fmaxf(b_, C1[r + 2]), C1[r + 3]); } \
        rm = fa::xhalf_max(fmaxf(a_, b_)); } while (0)
    bf16x8 kf[8]; bf16x8 kf2[4];
#define KLOAD(j, slotoff) do { kf[2 * (j)] = *(const __attribute__((address_space(3))) bf16x8*)(kp0 + (slotoff) + (j) * 2048); kf[2 * (j) + 1] = *(const __attribute__((address_space(3))) bf16x8*)(kp0 + (slotoff) + (j) * 2048 + 512); } while (0)
#define KLOAD2(slotoff) do { if (ND0 > 4) { kf2[0] = *(const __attribute__((address_space(3))) bf16x8*)(kp0 + (slotoff) + 4 * 2048); kf2[1] = *(const __attribute__((address_space(3))) bf16x8*)(kp0 + (slotoff) + 4 * 2048 + 512); \
        kf2[2] = *(const __attribute__((address_space(3))) bf16x8*)(kp0 + (slotoff) + 5 * 2048); kf2[3] = *(const __attribute__((address_space(3))) bf16x8*)(kp0 + (slotoff) + 5 * 2048 + 512); } } while (0)
    asm volatile("s_waitcnt vmcnt(0) lgkmcnt(0)\n\ts_barrier" ::: "memory");
    float mhat = sqrtf(q2 * kmax2) * 1.01f + (MODE == 2 ? __uint_as_float(*((const unsigned*)(shm + LDS_RPB) + 480)) : 0.f);
#pragma unroll
    for (int r = 0; r < 16; ++r) negm[r] = 0.f;
    PIN(negm);
    f32x16 pA0, pA1, pB0, pB1;
    int ks_cur = 0, ks_next = KSL, ks_nn = 2 * KSL, ks_tgt = 3 * KSL;
    int vs_prev = 2 * VSL, vs_cur = 0, vs_next = VSL;
#define ROT() do { const int k_ = ks_cur; ks_cur = ks_next; ks_next = ks_nn; ks_nn = ks_tgt; ks_tgt = k_; const int v_ = vs_prev; vs_prev = vs_cur; vs_cur = vs_next; vs_next = v_; } while (0)
#define RESC() do { if (resc) { _Pragma("unroll") for (int r = 0; r < 16; ++r) { const float fr_ = wsf[crow(r, hi)]; o[0][r] *= fr_; o[1][r] *= fr_; } } } while (0)
    KLOAD(0, 0); KLOAD(1, 0); KLOAD(2, 0); KLOAD(3, 0); KLOAD2(0);
    {
#pragma unroll
        for (int d0 = 0; d0 < 4; ++d0) { pA0 = __builtin_amdgcn_mfma_f32_32x32x16_bf16(kf[2 * d0], qr[d0], d0 == 0 ? negm : pA0, 0, 0, 0); pA1 = __builtin_amdgcn_mfma_f32_32x32x16_bf16(kf[2 * d0 + 1], qr[d0], d0 == 0 ? negm : pA1, 0, 0, 0); }
        if (ND0 > 4) { pA0 = __builtin_amdgcn_mfma_f32_32x32x16_bf16(kf2[0], qr[ND0 > 4 ? 4 : 0], pA0, 0, 0, 0); pA1 = __builtin_amdgcn_mfma_f32_32x32x16_bf16(kf2[1], qr[ND0 > 4 ? 4 : 0], pA1, 0, 0, 0);
                       pA0 = __builtin_amdgcn_mfma_f32_32x32x16_bf16(kf2[2], qr[ND0 > 4 ? 5 : 0], pA0, 0, 0, 0); pA1 = __builtin_amdgcn_mfma_f32_32x32x16_bf16(kf2[3], qr[ND0 > 4 ? 5 : 0], pA1, 0, 0, 0); }
        DMA_K(3, 3 * KSL); DMA_V(1, VSL);
        { float rm; ROWMAX(pA0, pA1, rm); mhat = fminf(mhat, rm + 64.f); }
#pragma unroll
        for (int r = 0; r < 16; ++r) { pA0[r] = __builtin_amdgcn_exp2f(pA0[r] - mhat); pA1[r] = __builtin_amdgcn_exp2f(pA1[r] - mhat); negm[r] = -mhat; }
        PIN(negm);
        KLOAD(0, KSL); KLOAD(1, KSL); KLOAD(2, KSL); KLOAD(3, KSL);
        WAIT_STEP();
    }
    s16x4 vlo[8], vhi[8]; u32x4 pw0, pw1, pw2, pw3;
#define VRD(i) do { vlo[i] = vtr(vp_ + (((i) >> 2) * 4096 + ((i) & 3) * 1024)); vhi[i] = vtr(vp_ + (((i) >> 2) * 4096 + ((i) & 3) * 1024 + 512)); } while (0)
#define VFR(i) (bf16x8){vlo[i][0], vlo[i][1], vlo[i][2], vlo[i][3], vhi[i][0], vhi[i][1], vhi[i][2], vhi[i][3]}
#define PAF(k) __builtin_bit_cast(bf16x8, pw##k)
#define GAPA(MF, A0, A1, A2, A3, W0, W1, PW) do { MF; sacc += A0; sacc += A1; sacc += A2; sacc += A3; PIN(sacc); W0; W1; PIN(PW); SBAR(); } while (0)
#define EX(v) __builtin_amdgcn_exp2f(v)
#define GAPB(MF, X, B) do { MF; X[B] = EX(X[B]); X[B + 1] = EX(X[B + 1]); X[B + 2] = EX(X[B + 2]); X[B + 3] = EX(X[B + 3]); PIN(X); SBAR(); } while (0)
#define KRD(j) do { KLOAD(j, ks_nn_); SBAR(); } while (0)
#define STEP(C0, C1, P0, P1, t) do { SBAR(); \
        const lds_cptr vp_ = vp0 + vs_prev; const int ks_cur_ = ks_cur; (void)ks_cur_; \
        KLOAD2(ks_cur_); \
        VRD(0); SBAR(); float sacc = (P0[0] + P0[1]); \
        GAPA(C0 = __builtin_amdgcn_mfma_f32_32x32x16_bf16(kf[0], qr[0], negm, 0, 0, 0), P0[2], P0[3], P0[4], P0[5], pw0[0] = cvtpk(P0[0], P0[1]), pw0[1] = cvtpk(P0[2], P0[3]), pw0); \
        VRD(4); SBAR(); GAPA(C1 = __builtin_amdgcn_mfma_f32_32x32x16_bf16(kf[1], qr[0], negm, 0, 0, 0), P0[6], P0[7], P0[8], P0[9], pw0[2] = cvtpk(P0[4], P0[5]), pw0[3] = cvtpk(P0[6], P0[7]), pw0); \
        VRD(1); SBAR(); GAPA(C0 = __builtin_amdgcn_mfma_f32_32x32x16_bf16(kf[2], qr[1], C0, 0, 0, 0), P0[10], P0[11], P0[12], P0[13], pw1[0] = cvtpk(P0[8], P0[9]), pw1[1] = cvtpk(P0[10], P0[11]), pw1); \
        VRD(5); SBAR(); GAPA(C1 = __builtin_amdgcn_mfma_f32_32x32x16_bf16(kf[3], qr[1], C1, 0, 0, 0), P0[14], P0[15], P1[0], P1[1], pw1[2] = cvtpk(P0[12], P0[13]), pw1[3] = cvtpk(P0[14], P0[15]), pw1); \
        VRD(2); SBAR(); GAPA(C0 = __builtin_amdgcn_mfma_f32_32x32x16_bf16(kf[4], qr[2], C0, 0, 0, 0), P1[2], P1[3], P1[4], P1[5], pw2[0] = cvtpk(P1[0], P1[1]), pw2[1] = cvtpk(P1[2], P1[3]), pw2); \
        VRD(6); SBAR(); GAPA(C1 = __builtin_amdgcn_mfma_f32_32x32x16_bf16(kf[5], qr[2], C1, 0, 0, 0), P1[6], P1[7], P1[8], P1[9], pw2[2] = cvtpk(P1[4], P1[5]), pw2[3] = cvtpk(P1[6], P1[7]), pw2); \
        VRD(3); SBAR(); GAPA(C0 = __builtin_amdgcn_mfma_f32_32x32x16_bf16(kf[6], qr[3], C0, 0, 0, 0), P1[10], P1[11], P1[12], P1[13], pw3[0] = cvtpk(P1[8], P1[9]), pw3[1] = cvtpk(P1[10], P1[11]), pw3); \
        VRD(7); SBAR(); GAPA(C1 = __builtin_amdgcn_mfma_f32_32x32x16_bf16(kf[7], qr[3], C1, 0, 0, 0), P1[14], P1[15], 0.f, 0.f, pw3[2] = cvtpk(P1[12], P1[13]), pw3[3] = cvtpk(P1[14], P1[15]), pw3); \
        if (ND0 > 4) { C0 = __builtin_amdgcn_mfma_f32_32x32x16_bf16(kf2[0], qr[ND0 > 4 ? 4 : 0], C0, 0, 0, 0); C1 = __builtin_amdgcn_mfma_f32_32x32x16_bf16(kf2[1], qr[ND0 > 4 ? 4 : 0], C1, 0, 0, 0); \
                       C0 = __builtin_amdgcn_mfma_f32_32x32x16_bf16(kf2[2], qr[ND0 > 4 ? 5 : 0], C0, 0, 0, 0); C1 = __builtin_amdgcn_mfma_f32_32x32x16_bf16(kf2[3], qr[ND0 > 4 ? 5 : 0], C1, 0, 0, 0); SBAR(); } \
        l_reg += sacc; \
        DMA_K((t) + 3, ks_tgt); DMA_V((t) + 1, vs_next); \
        MASK(C0, C1, t); \
        SBAR(); \
        const int ks_nn_ = ks_next; \
        GAPB(o[0] = __builtin_amdgcn_mfma_f32_32x32x16_bf16(PAF(0), VFR(0), o[0], 0, 0, 0), C0, 0); \
        GAPB(o[1] = __builtin_amdgcn_mfma_f32_32x32x16_bf16(PAF(0), VFR(4), o[1], 0, 0, 0), C0, 4); \
        KRD(0); GAPB(o[0] = __builtin_amdgcn_mfma_f32_32x32x16_bf16(PAF(1), VFR(1), o[0], 0, 0, 0), C0, 8); \
        KRD(1); GAPB(o[1] = __builtin_amdgcn_mfma_f32_32x32x16_bf16(PAF(1), VFR(5), o[1], 0, 0, 0), C0, 12); \
        KRD(2); GAPB(o[0] = __builtin_amdgcn_mfma_f32_32x32x16_bf16(PAF(2), VFR(2), o[0], 0, 0, 0), C1, 0); \
        KRD(3); GAPB(o[1] = __builtin_amdgcn_mfma_f32_32x32x16_bf16(PAF(2), VFR(6), o[1], 0, 0, 0), C1, 4); \
        GAPB(o[0] = __builtin_amdgcn_mfma_f32_32x32x16_bf16(PAF(3), VFR(3), o[0], 0, 0, 0), C1, 8); \
        GAPB(o[1] = __builtin_amdgcn_mfma_f32_32x32x16_bf16(PAF(3), VFR(7), o[1], 0, 0, 0), C1, 12); \
    } while (0)
    ROT();
    int t = 1;
    for (; t + 1 < NT; t += 2) {
        STEP(pB0, pB1, pA0, pA1, t);     WAIT_STEP(); ROT();
        STEP(pA0, pA1, pB0, pB1, t + 1); WAIT_STEP(); ROT();
    }
    if (t < NT) {
        STEP(pB0, pB1, pA0, pA1, t);     WAIT_STEP(); ROT();
        pA0 = pB0; pA1 = pB1;
    }
    {
        float sacc = 0.f;
#pragma unroll
        for (int r = 0; r < 16; ++r) sacc += pA0[r] + pA1[r];
        l_reg += sacc;
        pw0 = (u32x4){cvtpk(pA0[0], pA0[1]), cvtpk(pA0[2], pA0[3]), cvtpk(pA0[4], pA0[5]), cvtpk(pA0[6], pA0[7])};
        pw1 = (u32x4){cvtpk(pA0[8], pA0[9]), cvtpk(pA0[10], pA0[11]), cvtpk(pA0[12], pA0[13]), cvtpk(pA0[14], pA0[15])};
        pw2 = (u32x4){cvtpk(pA1[0], pA1[1]), cvtpk(pA1[2], pA1[3]), cvtpk(pA1[4], pA1[5]), cvtpk(pA1[6], pA1[7])};
        pw3 = (u32x4){cvtpk(pA1[8], pA1[9]), cvtpk(pA1[10], pA1[11]), cvtpk(pA1[12], pA1[13]), cvtpk(pA1[14], pA1[15])};
        const lds_cptr vp_ = vp0 + vs_prev;
#pragma unroll
        for (int i = 0; i < 8; ++i) VRD(i);
        o[0] = __builtin_amdgcn_mfma_f32_32x32x16_bf16(PAF(0), VFR(0), o[0], 0, 0, 0); o[1] = __builtin_amdgcn_mfma_f32_32x32x16_bf16(PAF(0), VFR(4), o[1], 0, 0, 0);
        o[0] = __builtin_amdgcn_mfma_f32_32x32x16_bf16(PAF(1), VFR(1), o[0], 0, 0, 0); o[1] = __builtin_amdgcn_mfma_f32_32x32x16_bf16(PAF(1), VFR(5), o[1], 0, 0, 0);
        o[0] = __builtin_amdgcn_mfma_f32_32x32x16_bf16(PAF(2), VFR(2), o[0], 0, 0, 0); o[1] = __builtin_amdgcn_mfma_f32_32x32x16_bf16(PAF(2), VFR(6), o[1], 0, 0, 0);
        o[0] = __builtin_amdgcn_mfma_f32_32x32x16_bf16(PAF(3), VFR(3), o[0], 0, 0, 0); o[1] = __builtin_amdgcn_mfma_f32_32x32x16_bf16(PAF(3), VFR(7), o[1], 0, 0, 0);
    }
    l_reg = fa::xhalf_sum(l_reg);
    if (MODE == 1 || MODE == 3) l_reg += __builtin_amdgcn_exp2f(sink2 - mhat);
    if (hi == 0) wsf[32 + r32] = 1.0f / l_reg;
    float rli[16];
#pragma unroll
    for (int r = 0; r < 16; ++r) rli[r] = wsf[32 + crow(r, hi)];
    bf16_t* stg = (bf16_t*)(shm + LDS_OST) + wid * 2048;
#pragma unroll
    for (int r = 0; r < 16; ++r) { const int orow = crow(r, hi);
#pragma unroll
        for (int dh = 0; dh < 2; ++dh) stg[orow * 64 + dh * 32 + r32] = (bf16_t)f2bf(o[dh][r] * rli[r]); }
#pragma unroll
    for (int i = 0; i < 4; ++i) { const int row = i * 8 + (lane >> 3), ch = lane & 7; const u32x4 v = *(const u32x4*)(stg + row * 64 + ch * 8); *(u32x4*)(Og + (size_t)(wid * 32 + row) * D + ch * 8) = v; }
    asm volatile("s_waitcnt vmcnt(0) lgkmcnt(0)\n\ts_barrier" ::: "memory");
#undef FA_KEY0
#undef DMA_K
#undef DMA_V
#undef WAIT_STEP
#undef MASK
#undef ROWMAX
#undef KLOAD
#undef KLOAD2
#undef ROT
#undef RESC
#undef VRD
#undef VFR
#undef PAF
#undef GAPA
#undef EX
#undef GAPB
#undef KRD
#undef STEP
}
#undef SBAR
#undef PIN
}

constexpr float SCALE_MLA = 0.10206207261596575f;
__device__ __forceinline__ void ph_attn(const Params& p, int layer, bool with_ctx, char* shm) {
    const QKVB qb = make_qkv(p.ws);
    bf16_t* O = (bf16_t*)(p.ws + WS_P);
    const int G = gridDim.x;
    const float NEG = -INFINITY;
    float km2[4];
#pragma unroll
    for (int mix = 0; mix < 4; ++mix) km2[mix] = ((const float*)(p.ws + WS_KM2))[layer * 4 + mix];
#define KMAX2(mix, bb, hk) km2[mix]
    for (int u = blockIdx.x; u < 256; u += G) { const int bh = u & 7, b = bh >> 2, h = bh & 3, qbk = u >> 3;
        fa2::attn_unit<96, 0, 6>(qb.QD + ((size_t)bh * SEQ + qbk * 256) * 96, qb.KD + (size_t)bh * KEYS * 96, qb.VD + (size_t)bh * KEYS * 64, O + (size_t)(b * SEQ + qbk * 256) * D + 768 + h * 64, qbk * 256, NEG, nullptr, shm, KMAX2(3, b, h)); }
    for (int u = blockIdx.x; u < 256; u += G) { const int bh = u & 7, b = bh >> 2, h = bh & 3, qbk = u >> 3;
        fa2::attn_unit<64, 0, 6>(qb.QB + ((size_t)bh * SEQ + qbk * 256) * 64, qb.KB + (size_t)(b * 2 + (h >> 1)) * KEYS * 64, qb.VB + (size_t)(b * 2 + (h >> 1)) * KEYS * 64, O + (size_t)(b * SEQ + qbk * 256) * D + 256 + h * 64, qbk * 256, NEG, nullptr, shm, KMAX2(1, b, h >> 1)); }
    for (int u = blockIdx.x; u < 256; u += G) { const int bh = u & 7, b = bh >> 2, h = bh & 3, qbk = u >> 3;
        fa2::attn_unit<64, 1, 6>(qb.QA + ((size_t)bh * SEQ + qbk * 256) * 64, qb.KA + (size_t)(b * 2 + (h >> 1)) * KEYS * 64, qb.VA + (size_t)(b * 2 + (h >> 1)) * KEYS * 64, O + (size_t)(b * SEQ + qbk * 256) * D + 0 + h * 64, qbk * 256, p.in[11][layer * 4 + h] * fa::LOG2E, nullptr, shm, KMAX2(0, b, h >> 1)); }
    for (int u = blockIdx.x; u < 256; u += G) { const int bh = u & 7, b = bh >> 2, h = bh & 3, qbk = u >> 3;
        fa2::attn_unit<64, 2, 6>(qb.QC + ((size_t)bh * SEQ + qbk * 256) * 64, qb.KC + (size_t)bh * KEYS * 64, qb.VC + (size_t)bh * KEYS * 64, O + (size_t)(b * SEQ + qbk * 256) * D + 512 + h * 64, qbk * 256, NEG, p.in[16] + ((size_t)layer * 4 + h) * 15 * 31, shm, KMAX2(2, b, h)); }
    if (with_ctx) for (int u = blockIdx.x; u < 32; u += G) { const int ty = u >> 3, bh = u & 7, b = bh >> 2, h = bh & 3;
        bf16_t* Oc = O + (size_t)(TL + b * CTX) * D + ty * 256 + h * 64;
        if (ty == 0) fa2::attn_unit<64, 3, 6>(qb.QAc + (size_t)bh * CTX * 64, qb.KA + (size_t)(b * 2 + (h >> 1)) * KEYS * 64, qb.VA + (size_t)(b * 2 + (h >> 1)) * KEYS * 64, Oc, 0, p.in[11][layer * 4 + h] * fa::LOG2E, nullptr, shm, KMAX2(0, b, h >> 1));
        else if (ty == 1) fa2::attn_unit<64, 3, 6>(qb.QBc + (size_t)bh * CTX * 64, qb.KB + (size_t)(b * 2 + (h >> 1)) * KEYS * 64, qb.VB + (size_t)(b * 2 + (h >> 1)) * KEYS * 64, Oc, 0, NEG, nullptr, shm, KMAX2(1, b, h >> 1));
        else if (ty == 2) fa2::attn_unit<64, 3, 6>(qb.QCc + (size_t)bh * CTX * 64, qb.KC + (size_t)bh * KEYS * 64, qb.VC + (size_t)bh * KEYS * 64, Oc, 0, NEG, nullptr, shm, KMAX2(2, b, h));
        else fa2::attn_unit<96, 3, 6>(qb.QDc + (size_t)bh * CTX * 96, qb.KD + (size_t)bh * KEYS * 96, qb.VD + (size_t)bh * KEYS * 64, Oc, 0, NEG, nullptr, shm, KMAX2(3, b, h)); }
}

__device__ __forceinline__ void ph_gnorm(const Params& p, int layer, int nrows) {
    const int tx = opq((int)threadIdx.x), lane = tx & 63, gw = (blockIdx.x * 512 + tx) >> 6, ngw = (gridDim.x * 512) >> 6;
    const bf16_t* O = (const bf16_t*)(p.ws + WS_P); bf16_t* Y = (bf16_t*)(p.ws + WS_ACT1); const float* g = p.in[23] + layer * D;
    f32x4 gv4[4];
#pragma unroll
    for (int grp = 0; grp < 4; ++grp) gv4[grp] = *(const f32x4*)(g + grp * 256 + 4 * lane);
    u32x2 wr_[4];
    if (gw < nrows) {
#pragma unroll
        for (int grp = 0; grp < 4; ++grp) wr_[grp] = *(const u32x2*)(O + (size_t)gw * D + grp * 256 + 4 * lane); }
    for (int m = gw; m < nrows; m += ngw) {
        u32x2 wn_[4]; { const int mc = (m + ngw < nrows) ? m + ngw : m;
#pragma unroll
            for (int grp = 0; grp < 4; ++grp) wn_[grp] = *(const u32x2*)(O + (size_t)mc * D + grp * 256 + 4 * lane); }
        __builtin_amdgcn_sched_barrier(0);
#pragma unroll
        for (int grp = 0; grp < 4; ++grp) { const int c = grp * 256 + 4 * lane; const u32x2 w = wr_[grp];
            const float a0 = bflo(w.x), a1 = bfhi(w.x), a2 = bflo(w.y), a3 = bfhi(w.y);
            const float r = rsqrtf(wave_sum(a0 * a0 + a1 * a1 + a2 * a2 + a3 * a3) * (1.f / 256.f) + EPS);
            const f32x4 gv = gv4[grp];
            if (FP8_OUT1 && layer == 1) *(unsigned*)((unsigned char*)Y + (size_t)m * D + c) = pk4_fp8(a0 * r * gv.x, a1 * r * gv.y, a2 * r * gv.z, a3 * r * gv.w);
            else { u32x2 o; o.x = pk2(a0 * r * gv.x, a1 * r * gv.y); o.y = pk2(a2 * r * gv.z, a3 * r * gv.w);
            *(u32x2*)(Y + (size_t)m * D + c) = o; } }
#pragma unroll
        for (int grp = 0; grp < 4; ++grp) wr_[grp] = wn_[grp];
    }
}

__device__ __forceinline__ void moe_bases(const unsigned* cnt, int (&base)[9]) {
    int acc = 0; unsigned c[8];
#pragma unroll
    for (int e = 0; e < 8; ++e) c[e] = cnt[64 * e];
    __builtin_amdgcn_sched_barrier(0);
#pragma unroll
    for (int e = 0; e < 8; ++e) { base[e] = acc; acc += ((int)c[e] + 255) / 256 * 256; }
    base[8] = acc;
}
__device__ __forceinline__ void ph_moe_gather(const Params& p) {
    const int tx = opq((int)threadIdx.x), lane = tx & 63, gw = (blockIdx.x * 512 + tx) >> 6, ngw = (gridDim.x * 512) >> 6;
    const unsigned* cnt = (const unsigned*)(p.ws + WS_CTL); int base[9]; moe_bases(cnt, base);
    if (blockIdx.x == 0 && tx < 136) { const int r = tx * 256; int e = -1;
#pragma unroll
        for (int i = 0; i < 8; ++i) if (r >= base[i] && r < base[i + 1]) e = i;
        ((int*)(p.ws + WS_TEXP))[tx] = e < 0 ? 0 : e; }
    const bf16_t* F = (const bf16_t*)(p.ws + WS_ACT1); unsigned char* A8 = p.ws + WS_ASORT8;
    int2 e, ps; u32x4 v0, v1;
    if (gw < TL) { e = ((const int2*)(p.ws + WS_TOKE))[gw]; ps = ((const int2*)(p.ws + WS_TOKP))[gw]; v0 = *(const u32x4*)(F + (size_t)gw * D + lane * 16); v1 = *(const u32x4*)(F + (size_t)gw * D + lane * 16 + 8); }
    for (int m = gw; m < TL; m += ngw) {
        const int mc = (m + ngw < TL) ? m + ngw : m;
        const int2 en = ((const int2*)(p.ws + WS_TOKE))[mc], psn = ((const int2*)(p.ws + WS_TOKP))[mc];
        const u32x4 v0n = *(const u32x4*)(F + (size_t)mc * D + lane * 16), v1n = *(const u32x4*)(F + (size_t)mc * D + lane * 16 + 8);
        __builtin_amdgcn_sched_barrier(0);
        int b0 = 0, b1 = 0;
#pragma unroll
        for (int i = 0; i < 8; ++i) { if (e.x == i) b0 = base[i]; if (e.y == i) b1 = base[i]; }
        const int s0 = b0 + ps.x, s1 = b1 + ps.y;
        u32x4 o; o.x = pk4_fp8(bflo(v0.x), bfhi(v0.x), bflo(v0.y), bfhi(v0.y)); o.y = pk4_fp8(bflo(v0.z), bfhi(v0.z), bflo(v0.w), bfhi(v0.w));
        o.z = pk4_fp8(bflo(v1.x), bfhi(v1.x), bflo(v1.y), bfhi(v1.y)); o.w = pk4_fp8(bflo(v1.z), bfhi(v1.z), bflo(v1.w), bfhi(v1.w));
        *(u32x4*)(A8 + (size_t)s0 * D + lane * 16) = o; *(u32x4*)(A8 + (size_t)s1 * D + lane * 16) = o;
        if (lane == 0) ((int2*)(p.ws + WS_TOKS))[m] = make_int2(s0, s1);
        e = en; ps = psn; v0 = v0n; v1 = v1n;
    }
}
__device__ __forceinline__ void ph_moe_combine(const Params& p, int layer) {
    const size_t nthr = (size_t)gridDim.x * 512, N = (size_t)TL * 256;
    const bf16_t* Y = (const bf16_t*)(p.ws + WS_ASORT);
    const float* modl = (const float*)(p.ws + WS_MOD) + (size_t)layer * 3 * 6144 + 5 * D;
    int r0t; { int base[9]; moe_bases((const unsigned*)(p.ws + WS_CTL), base); const int nM = base[8] / 256, nMain = moe_down_main_tiles(nM); r0t = nMain < nM ? 256 * nMain : (1 << 30); }
    const bf16_t* Y2S = (const bf16_t*)(p.ws + WS_Y2S);
    for (size_t idx0 = (size_t)blockIdx.x * 512 + opq((int)threadIdx.x); idx0 < N; idx0 += 4 * nthr) {
        int m[4], c[4]; bool ok[4]; int2 sl[4]; float2 g[4];
#pragma unroll
        for (int u = 0; u < 4; ++u) { const size_t idx = idx0 + u * nthr; ok[u] = idx < N; const size_t ix = ok[u] ? idx : idx0; m[u] = (int)(ix >> 8); c[u] = (int)(ix & 255) * 4;
            sl[u] = ((const int2*)(p.ws + WS_TOKS))[m[u]]; g[u] = ((const float2*)(p.ws + WS_TOKG))[m[u]]; }
        __builtin_amdgcn_sched_barrier(0);
        u32x2 a[4], b[4]; f32x4 o[4], md[4];
#pragma unroll
        for (int u = 0; u < 4; ++u) { a[u] = *(const u32x2*)(Y + (size_t)sl[u].x * D + c[u]); b[u] = *(const u32x2*)(Y + (size_t)sl[u].y * D + c[u]);
            o[u] = *(const f32x4*)(p.out + (size_t)m[u] * D + c[u]); md[u] = *(const f32x4*)(modl + (m[u] / SEQ) * 6144 + c[u]); }
        __builtin_amdgcn_sched_barrier(0);
#pragma unroll
        for (int u = 0; u < 4; ++u) { f32x4 ya = {bflo(a[u].x), bfhi(a[u].x), bflo(a[u].y), bfhi(a[u].y)}, yb = {bflo(b[u].x), bfhi(b[u].x), bflo(b[u].y), bfhi(b[u].y)};
            if (sl[u].x >= r0t || sl[u].y >= r0t) {
                if (sl[u].x >= r0t) { ya = (f32x4){0.f, 0.f, 0.f, 0.f};
                    for (int ks = 0; ks < MD_SL; ++ks) { const u32x2 t = *(const u32x2*)(Y2S + ((size_t)ks * MD_TROWS + (sl[u].x - r0t)) * D + c[u]); ya += (f32x4){bflo(t.x), bfhi(t.x), bflo(t.y), bfhi(t.y)}; } }
                if (sl[u].y >= r0t) { yb = (f32x4){0.f, 0.f, 0.f, 0.f};
                    for (int ks = 0; ks < MD_SL; ++ks) { const u32x2 t = *(const u32x2*)(Y2S + ((size_t)ks * MD_TROWS + (sl[u].y - r0t)) * D + c[u]); yb += (f32x4){bflo(t.x), bfhi(t.x), bflo(t.y), bfhi(t.y)}; } }
            }
            if (ok[u]) *(f32x4*)(p.out + (size_t)m[u] * D + c[u]) = o[u] + md[u] * (ya * g[u].x + yb * g[u].y); }
        __builtin_amdgcn_sched_barrier(0);
    }
}

#ifndef DBL_PHASE
#define DBL_PHASE (-1)
#endif
#ifndef FILL_Q_IN
#define FILL_Q_IN 0
#define FILL_Q_OUT 0
#define FILL_Q_UP 0
#define FILL_Q_DN 0
#endif
struct Args { Params p; int ph_lo, ph_hi; };
__global__ void __launch_bounds__(NWAVES * 64, 2) mega_fwd(Args args) {
    extern __shared__ __attribute__((aligned(16))) unsigned char lds[];
    LAS unsigned char* ldsl = (LAS unsigned char*)lds;
    for (int u = threadIdx.x; u < (LDS_BYTES - LDSCTL_OFF) / 4; u += NWAVES * 64) ((LAS unsigned*)(ldsl + LDSCTL_OFF))[u] = 0u;
    __syncthreads();
    XcdBarrier bar = xcd_barrier_post((unsigned*)(args.p.ws + WS_CTL) + CW_BAR, (volatile LAS unsigned*)(ldsl + MISC_OFF) + 8);
    const int lo = args.ph_lo, hi = args.ph_hi;
#pragma unroll 1
    for (int ph = lo; ph < hi; ++ph) {
      const int nrep = (ph == DBL_PHASE) ? 2 : 1;
#pragma unroll 1
      for (int rep_ = 0; rep_ < nrep; ++rep_) {
        if (rep_) xcd_barrier(bar);
        Params q = args.p; { size_t z_ = 0; asm volatile("" : "+s"(z_)); q.ws = args.p.ws + z_; q.out = args.p.out + z_; }
        LAS unsigned char* ldq = (LAS unsigned char*)lds;
        const int l = ph >= 10 ? 1 : 0, st = ph == 0 ? -1 : (l ? ph - 10 : ph - 1);
        const bool last = (l == 1); const int nrows = last ? TL : MALL;
        const float* qmod = (const float*)(q.ws + WS_MOD) + (size_t)l * 3 * 6144;
        int fillq = 0, fill_nwg = 1;
        if (st == -1) ph_prologue(q, (float*)lds);
        else if (st == 0) ph_norm<1, false>(q, l, MALL, (unsigned*)lds, l ? 11 : 0);
        else if (st == 1) { if (FP8_IN1 && l == 1) run_gemm<EpiBf16Perm, true>(ldq, (const bf16_t*)(q.ws + WS_ACT1), (const bf16_t*)(q.ws + WS_WIN) + (size_t)l * NINP * D, D / 2, MALL / 256, NINP / 256, nullptr, 0, EpiBf16Perm{(bf16_t*)(q.ws + WS_P), NINP, 0});
                            else run_gemm(ldq, (const bf16_t*)(q.ws + WS_ACT1), (const bf16_t*)(q.ws + WS_WIN) + (size_t)l * NINP * D, D, MALL / 256, NINP / 256, nullptr, 0, EpiBf16Perm{(bf16_t*)(q.ws + WS_P), NINP, 0});
                            fillq = FILL_Q_IN; fill_nwg = (MALL / 256) * (NINP / 256); }
        else if (st == 2) ph_postproj2(q, l, ldq);
        else if (st == 3) ph_attn(q, l, !last, (char*)lds);
        else if (st == 4) ph_gnorm(q, l, nrows);
        else if (st == 5 || (st == 8 && !last)) {
            const bool op = (st == 5);
            const bf16_t* A_ = (const bf16_t*)(q.ws + (op ? WS_ACT1 : WS_HIDF)); const bf16_t* B_ = op ? (const bf16_t*)(q.ws + WS_WOUT) + (size_t)l * D * D : (const bf16_t*)(q.ws + WS_WFDN);
            const int K_ = op ? D : DFF, goff_ = op ? 2 * D : 5 * D;
            const float* hl_in_ = (op && l == 0) ? q.in[0] : q.out;
            if (FP8_OUT1 && last) run_gemm<EpiResid, true>(ldq, A_, B_, D / 2, 64, D / 256, nullptr, 0, EpiResid{hl_in_, (const float*)(q.ws + WS_HCTX), q.out, (float*)(q.ws + WS_HCTX), qmod, goff_, 0});
            else
#pragma unroll 1
            for (int pass = 0; pass < (last ? 1 : 2); ++pass)
                run_gemm(ldq, A_, B_, K_, pass ? 2 : 64, D / 256, nullptr, 0, EpiResid{hl_in_, (const float*)(q.ws + WS_HCTX), q.out, pass ? (float*)(q.ws + WS_PART) : (float*)(q.ws + WS_HCTX), qmod, goff_, pass}, pass ? (op ? 8 : 11) : 1, pass ? 64 : 0);
        }
        else if (!last) {
            if (st == 6) ph_norm<2, false>(q, l, MALL, (unsigned*)lds, 8);
            else if (st == 7) { run_gemm(ldq, (const bf16_t*)(q.ws + WS_ACT1), (const bf16_t*)(q.ws + WS_WFGU), D, MALL / 256, 2 * DFF / 256, nullptr, 0, EpiSwiglu{(bf16_t*)(q.ws + WS_HIDF), DFF, 0});
                                fillq = FILL_Q_UP; fill_nwg = (MALL / 256) * (2 * DFF / 256); }
            else {}
        } else {
            if (st == 6) ph_norm<2, true>(q, l, TL, (unsigned*)lds, 0);
            else if (st == 7) { ph_moe_gather(q); fillq = 1 << 30; fill_nwg = 0; }
            else if (st == 8) { int base[9]; moe_bases((const unsigned*)(q.ws + WS_CTL), base);
                run_gemm<EpiSwiglu8, true>(ldq, (const bf16_t*)(q.ws + WS_ASORT8), (const bf16_t*)(q.ws + WS_WMGU), D / 2, __builtin_amdgcn_readfirstlane(base[8] / 256), 2 * DFFE / 256, (const int*)(q.ws + WS_TEXP), (size_t)2 * DFFE * D, EpiSwiglu8{q.ws + WS_HIDM, DFFE, 0}); }
            else if (st == 9) { int base[9]; moe_bases((const unsigned*)(q.ws + WS_CTL), base);
                const int nM_ = __builtin_amdgcn_readfirstlane(base[8] / 256), nMain_ = moe_down_main_tiles(nM_);
                run_gemm<EpiBf16Perm, true>(ldq, (const bf16_t*)(q.ws + WS_HIDM), (const bf16_t*)(q.ws + WS_WMDN), DFFE / 2, nMain_, D / 256, (const int*)(q.ws + WS_TEXP), (size_t)D * DFFE, EpiBf16Perm{(bf16_t*)(q.ws + WS_ASORT), D, 0});
                if (nMain_ < nM_) run_gemm<EpiBf16Slab, true>(ldq, (const bf16_t*)(q.ws + WS_HIDM), (const bf16_t*)(q.ws + WS_WMDN), DFFE / 2, nM_ - nMain_, D / 256, (const int*)(q.ws + WS_TEXP) + nMain_, (size_t)D * DFFE,
                                                               EpiBf16Slab{(bf16_t*)(q.ws + WS_Y2S), D, 256 * nMain_}, MD_SL, nMain_); }
            else ph_moe_combine(q, l);
        }
        if (fillq > 0 && (fill_nwg == 0 || gemm_tail_idle(fill_nwg))) fill_moe(q, (float*)lds, fillq);
      }
      if (ph + 1 < hi) xcd_barrier(bar);
    }
}

#ifndef MK_CUTS
#define MK_CUTS 0
#endif
extern "C" void kernel_launch(void* const* d_in, const int* in_sizes, int n_in, void* d_out, int out_size, void* d_ws, size_t ws_size, hipStream_t stream) {
    static int grid = 0;
    if (grid == 0) {
        if (n_in != 32 || ws_size < WS_END) { fprintf(stderr, "kernel_launch: need 32 inputs and %zu bytes of workspace (got %d, %zu)\n", (size_t)WS_END, n_in, ws_size); grid = -1; return; }
        int dev = 0, cus = 0, per_cu = 0;
        if (hipGetDevice(&dev) != hipSuccess || hipDeviceGetAttribute(&cus, hipDeviceAttributeMultiprocessorCount, dev) != hipSuccess) { grid = -1; return; }
        if (hipFuncSetAttribute((const void*)mega_fwd, hipFuncAttributeMaxDynamicSharedMemorySize, LDS_BYTES) != hipSuccess) { fprintf(stderr, "kernel_launch: hipFuncSetAttribute failed\n"); grid = -1; return; }
        if (hipOccupancyMaxActiveBlocksPerMultiprocessor(&per_cu, (const void*)mega_fwd, NWAVES * 64, LDS_BYTES) != hipSuccess || per_cu < 1) fprintf(stderr, "kernel_launch: occupancy query says %d blocks per CU\n", per_cu);
        (void)hipGetLastError();
        grid = cus;
    }
    if (grid < 0) return;
    (void)hipMemsetAsync((char*)d_ws + WS_CTL, 0, CTL_ZERO_BYTES, stream);
    Args a{}; for (int i = 0; i < 32; ++i) a.p.in[i] = (const float*)d_in[i]; a.p.out = (float*)d_out; a.p.ws = (unsigned char*)d_ws;
#if MK_CUTS
    for (int ph = 0; ph < 24; ++ph) { a.ph_lo = ph; a.ph_hi = ph + 1; hipLaunchKernelGGL(mega_fwd, dim3(grid), dim3(NWAVES * 64), LDS_BYTES, stream, a); }
#else
    a.ph_lo = 0; a.ph_hi = 21;
    hipLaunchKernelGGL(mega_fwd, dim3(grid), dim3(NWAVES * 64), LDS_BYTES, stream, a);
#endif
}
```
